# Optimizing an MI355X kernel written in HIP

```python
import math
import jax
import jax.numpy as jnp
from jax import lax
import numpy as np

D_MODEL = 1024
BATCH = 16
SEQ = 4096
DEPTH = 2

MEM_LEN = 256
EPS = 1e-6
N_HEADS = 8
N_KV_HEADS = 2
HEAD_DIM = 64
ATTN_WIDTH = N_HEADS * HEAD_DIM
KV_WIDTH = N_KV_HEADS * HEAD_DIM
WINDOW = 128
BLOCK = 128
ROPE_THETA = 10000.0
HY_WIDTH = D_MODEL - ATTN_WIDTH
HY_ORDER = 2
HY_SHORT = 3
HY_EMB = 33
HY_BANDS = (HY_EMB - 1) // 2
HY_FILTER_HIDDEN = 64
HY_TARGET = 1e-2
HY_FAST_DECAY = 0.3
HY_SLOW_DECAY = 1.5
HY_MIN_DECAY = math.log(HY_TARGET) / HY_SLOW_DECAY
HY_MAX_DECAY = math.log(HY_TARGET) / HY_FAST_DECAY
MIX_WIDTH = ATTN_WIDTH + HY_WIDTH
Q_END = ATTN_WIDTH
K_END = Q_END + KV_WIDTH
V_END = K_END + KV_WIDTH
IN_COLS = V_END + (HY_ORDER + 1) * HY_WIDTH
X_HEADS = 4
X_HEAD_DIM = 128
X_WIDTH = X_HEADS * X_HEAD_DIM
D_FF = 2816
N_EXPERTS = 8
TOP_K = 2
D_FF_EXPERT = 3584
MOE_BLOCK = 512
N_DENSE = (DEPTH + 1) // 2
N_MOE = DEPTH // 2

kernel_name = 'hymba_attn_hyena_moe_encoder'


def rms_norm(x, g):
    xf = x.astype(jnp.float32)
    y = xf * lax.rsqrt(jnp.mean(xf * xf, axis=-1, keepdims=True) + EPS)
    return (y * g.astype(jnp.float32)).astype(x.dtype)


def rope_tables(seq):
    pos = jnp.arange(seq, dtype=jnp.float32)
    inv = ROPE_THETA ** (-jnp.arange(0, HEAD_DIM, 2, dtype=jnp.float32) / HEAD_DIM)
    ang = pos[:, None] * inv[None, :]
    return jnp.cos(ang), jnp.sin(ang)


def apply_rope(x, cos, sin):
    x1, x2 = jnp.split(x.astype(jnp.float32), 2, axis=-1)
    c = cos[None, :, None, :]
    s = sin[None, :, None, :]
    return jnp.concatenate([x1 * c - x2 * s, x2 * c + x1 * s], axis=-1).astype(x.dtype)


def band_attention(q, k, v, sink):
    B, S, H, Dh = q.shape
    nb = S // BLOCK
    G = H // N_KV_HEADS
    scale = Dh ** -0.5
    qb = q.reshape(B, nb, BLOCK, N_KV_HEADS, G, Dh).transpose(1, 0, 2, 3, 4, 5)
    kp = jnp.pad(k, ((0, 0), (BLOCK, BLOCK), (0, 0), (0, 0)))
    vp = jnp.pad(v, ((0, 0), (BLOCK, BLOCK), (0, 0), (0, 0)))
    sink_l = jnp.broadcast_to(sink.astype(jnp.float32).reshape(1, N_KV_HEADS, G, 1, 1),
                              (B, N_KV_HEADS, G, BLOCK, 1))
    neg = jnp.finfo(jnp.float32).min

    def one_block(args):
        i, qi = args
        kk = lax.dynamic_slice_in_dim(kp, i * BLOCK, 3 * BLOCK, axis=1)
        vv = lax.dynamic_slice_in_dim(vp, i * BLOCK, 3 * BLOCK, axis=1)
        s = jnp.einsum('bqkgd,bskd->bkgqs', qi, kk, preferred_element_type=jnp.float32) * scale
        qpos = i * BLOCK + jnp.arange(BLOCK)
        kpos = (i - 1) * BLOCK + jnp.arange(3 * BLOCK)
        mask = (jnp.abs(kpos[None, :] - qpos[:, None]) <= WINDOW) & (kpos[None, :] >= 0) & (kpos[None, :] < S)
        s = jnp.where(mask[None, None, None], s, neg)
        p = jax.nn.softmax(jnp.concatenate([s, sink_l], axis=-1), axis=-1)[..., :-1]
        return jnp.einsum('bkgqs,bskd->bqkgd', p.astype(vv.dtype), vv)

    o = lax.map(one_block, (jnp.arange(nb), qb))
    return o.transpose(1, 0, 2, 3, 4, 5).reshape(B, S, H * Dh)


def hyena_pos_features(L):
    t = jnp.linspace(0.0, 1.0, L, dtype=jnp.float32)[:, None]
    w = 2.0 * math.pi * jnp.arange(L, dtype=jnp.float32)[:, None] / L
    f = jnp.linspace(1e-4, HY_BANDS - 1, HY_BANDS, dtype=jnp.float32)[None, :]
    z = jnp.concatenate([t, jnp.cos(f * w), -jnp.sin(f * w)], axis=-1)
    return z, t


def hyena_filters(z, t, f_w1, f_b1, f_freq1, f_w2, f_b2, f_freq2, f_w3):
    L = z.shape[0]
    h = jnp.sin(f_freq1 * (z @ f_w1 + f_b1))
    h = jnp.sin(f_freq2 * (h @ f_w2 + f_b2))
    h = (h @ f_w3).astype(jnp.float32).reshape(L, 2, HY_ORDER, HY_WIDTH)
    deltas = jnp.linspace(HY_MIN_DECAY, HY_MAX_DECAY, HY_ORDER * HY_WIDTH,
                          dtype=jnp.float32).reshape(HY_ORDER, HY_WIDTH)
    h = h * jnp.exp(-t[:, :, None, None] * jnp.abs(deltas))
    fwd = h[:, 0]
    bwd = h[1:, 1]
    return jnp.concatenate([fwd, jnp.zeros((1,) + fwd.shape[1:], jnp.float32), bwd[::-1]], axis=0)


def hyena_mixer(u, conv_w, conv_b, k_long, skip):
    L = u.shape[1]
    up = jnp.pad(u, ((0, 0), (1, 1), (0, 0)))
    u = up[:, :-2] * conv_w[0] + up[:, 1:-1] * conv_w[1] + up[:, 2:] * conv_w[2] + conv_b
    x1, x2, v = jnp.split(u, HY_ORDER + 1, axis=-1)
    K = jnp.fft.rfft(k_long, axis=0)

    def long_conv(zin, Ko, d):
        zf32 = zin.astype(jnp.float32)
        zf = jnp.fft.rfft(zf32, n=2 * L, axis=1)
        y = jnp.fft.irfft(zf * Ko[None], n=2 * L, axis=1)[:, :L]
        return (y + zf32 * d.astype(jnp.float32)).astype(zin.dtype)

    zz = x1 * long_conv(v, K[:, 0], skip[0])
    return x2 * long_conv(zz, K[:, 1], skip[1])


def memory_attention(h, m, w_q, w_k, w_v, w_o):
    B, S, _ = h.shape
    q = (h @ w_q).reshape(B, S, X_HEADS, X_HEAD_DIM)
    k = (m @ w_k).reshape(B, -1, X_HEADS, X_HEAD_DIM)
    v = (m @ w_v).reshape(B, -1, X_HEADS, X_HEAD_DIM)
    s = jnp.einsum('bqhd,bkhd->bhqk', q, k, preferred_element_type=jnp.float32) * (X_HEAD_DIM ** -0.5)
    p = jax.nn.softmax(s, axis=-1).astype(v.dtype)
    o = jnp.einsum('bhqk,bkhd->bqhd', p, v).reshape(B, S, X_WIDTH)
    return o @ w_o


def swiglu(h, w_gate, w_up, w_down):
    return (jax.nn.silu(h @ w_gate) * (h @ w_up)) @ w_down


def moe_swiglu(h, w_router, w_gate, w_up, w_down):
    B, S, D = h.shape
    t = h.reshape(B * S, D)
    n_tok = B * S
    n_asg = n_tok * TOP_K
    logits = jnp.dot(t.astype(jnp.float32), w_router.astype(jnp.float32))
    top_v, top_i = lax.top_k(logits, TOP_K)
    top_w = jax.nn.softmax(top_v, axis=-1)
    flat_e = top_i.reshape(-1)
    flat_tok = jnp.repeat(jnp.arange(n_tok, dtype=jnp.int32), TOP_K)
    flat_w = top_w.reshape(-1)
    order = jnp.argsort(flat_e)
    sorted_e = flat_e[order]
    counts = jnp.bincount(flat_e, length=N_EXPERTS)
    padded = (counts + MOE_BLOCK - 1) // MOE_BLOCK * MOE_BLOCK
    pad_end = jnp.cumsum(padded)
    pad_start = pad_end - padded
    seg_start = jnp.cumsum(counts) - counts
    dest = pad_start[sorted_e] + jnp.arange(n_asg, dtype=jnp.int32) - seg_start[sorted_e]
    n_blk = -(-(n_asg + N_EXPERTS * (MOE_BLOCK - 1)) // MOE_BLOCK)
    buf_tok = jnp.zeros((n_blk * MOE_BLOCK,), jnp.int32).at[dest].set(flat_tok[order])
    buf_w = jnp.zeros((n_blk * MOE_BLOCK,), jnp.float32).at[dest].set(flat_w[order])
    blk_e = jnp.minimum(jnp.searchsorted(pad_end, jnp.arange(n_blk, dtype=jnp.int32) * MOE_BLOCK, side='right'),
                        N_EXPERTS - 1)

    def run_block(args):
        e, tok, wt = args
        xb = t[tok]
        yb = swiglu(xb, w_gate[e], w_up[e], w_down[e])
        return yb * wt[:, None].astype(yb.dtype)

    y = lax.map(run_block, (blk_e, buf_tok.reshape(n_blk, MOE_BLOCK), buf_w.reshape(n_blk, MOE_BLOCK)))
    out = jnp.zeros_like(t).at[buf_tok].add(y.reshape(-1, D))
    return out.reshape(B, S, D)


def setup_inputs(seed: int = 0) -> dict:
    key = jax.random.key(seed)
    ks = iter(jax.random.split(key, 40))

    def nrm(shape, scale):
        return scale * jax.random.normal(next(ks), shape, jnp.float32)

    def gain(shape):
        return 1.0 + 0.05 * jax.random.normal(next(ks), shape, jnp.float32)

    D = D_MODEL
    C3 = (HY_ORDER + 1) * HY_WIDTH
    return {
        'x': nrm((BATCH, SEQ, D), 1.0),
        'mem': nrm((BATCH, MEM_LEN, D), 1.0),
        'mem_norm': gain((D,)),
        'mix_norm': gain((DEPTH, D)),
        'w_in': nrm((DEPTH, D, IN_COLS), D ** -0.5),
        'attn_sink': nrm((DEPTH, N_HEADS), 0.5),
        'hy_conv_w': nrm((DEPTH, HY_SHORT, C3), HY_SHORT ** -0.5),
        'hy_conv_b': nrm((DEPTH, C3), 0.02),
        'hy_f_w1': nrm((DEPTH, HY_EMB, HY_FILTER_HIDDEN), HY_EMB ** -0.5),
        'hy_f_b1': nrm((DEPTH, HY_FILTER_HIDDEN), 0.1),
        'hy_f_freq1': gain((DEPTH, HY_FILTER_HIDDEN)),
        'hy_f_w2': nrm((DEPTH, HY_FILTER_HIDDEN, HY_FILTER_HIDDEN), HY_FILTER_HIDDEN ** -0.5),
        'hy_f_b2': nrm((DEPTH, HY_FILTER_HIDDEN), 0.1),
        'hy_f_freq2': gain((DEPTH, HY_FILTER_HIDDEN)),
        'hy_f_w3': nrm((DEPTH, HY_FILTER_HIDDEN, 2 * HY_ORDER * HY_WIDTH), 0.05 * HY_FILTER_HIDDEN ** -0.5),
        'hy_skip': nrm((DEPTH, HY_ORDER, HY_WIDTH), 0.5),
        'attn_out_norm': gain((DEPTH, ATTN_WIDTH)),
        'hy_out_norm': gain((DEPTH, HY_WIDTH)),
        'w_out': nrm((DEPTH, MIX_WIDTH, D), MIX_WIDTH ** -0.5),
        'xattn_norm': gain((DEPTH, D)),
        'xw_q': nrm((DEPTH, D, X_WIDTH), D ** -0.5),
        'xw_k': nrm((DEPTH, D, X_WIDTH), D ** -0.5),
        'xw_v': nrm((DEPTH, D, X_WIDTH), D ** -0.5),
        'xw_o': nrm((DEPTH, X_WIDTH, D), X_WIDTH ** -0.5),
        'ffn_norm': gain((DEPTH, D)),
        'ffn_w_gate': nrm((N_DENSE, D, D_FF), D ** -0.5),
        'ffn_w_up': nrm((N_DENSE, D, D_FF), D ** -0.5),
        'ffn_w_down': nrm((N_DENSE, D_FF, D), D_FF ** -0.5),
        'moe_router': nrm((N_MOE, D, N_EXPERTS), D ** -0.5),
        'moe_w_gate': nrm((N_MOE, N_EXPERTS, D, D_FF_EXPERT), D ** -0.5),
        'moe_w_up': nrm((N_MOE, N_EXPERTS, D, D_FF_EXPERT), D ** -0.5),
        'moe_w_down': nrm((N_MOE, N_EXPERTS, D_FF_EXPERT, D), D_FF_EXPERT ** -0.5),
        'final_norm': gain((D,)),
    }


def reference(x, mem, mem_norm, mix_norm, w_in, attn_sink, hy_conv_w, hy_conv_b,
              hy_f_w1, hy_f_b1, hy_f_freq1, hy_f_w2, hy_f_b2, hy_f_freq2, hy_f_w3, hy_skip,
              attn_out_norm, hy_out_norm, w_out, xattn_norm, xw_q, xw_k, xw_v, xw_o,
              ffn_norm, ffn_w_gate, ffn_w_up, ffn_w_down,
              moe_router, moe_w_gate, moe_w_up, moe_w_down, final_norm):
    B, S, _ = x.shape
    cos, sin = rope_tables(S)
    z_pos, t_pos = hyena_pos_features(S)
    m = rms_norm(mem, mem_norm)
    for l in range(DEPTH):
        h = rms_norm(x, mix_norm[l])
        proj = h @ w_in[l]
        q, k, v, u = jnp.split(proj, [Q_END, K_END, V_END], axis=-1)
        q = apply_rope(q.reshape(B, S, N_HEADS, HEAD_DIM), cos, sin)
        k = apply_rope(k.reshape(B, S, N_KV_HEADS, HEAD_DIM), cos, sin)
        v = v.reshape(B, S, N_KV_HEADS, HEAD_DIM)
        a = band_attention(q, k, v, attn_sink[l])
        k_long = hyena_filters(z_pos, t_pos, hy_f_w1[l], hy_f_b1[l], hy_f_freq1[l],
                               hy_f_w2[l], hy_f_b2[l], hy_f_freq2[l], hy_f_w3[l])
        y = hyena_mixer(u, hy_conv_w[l], hy_conv_b[l], k_long, hy_skip[l])
        mixed = jnp.concatenate([rms_norm(a, attn_out_norm[l]), rms_norm(y, hy_out_norm[l])], axis=-1)
        x = x + mixed @ w_out[l]
        x = x + memory_attention(rms_norm(x, xattn_norm[l]), m, xw_q[l], xw_k[l], xw_v[l], xw_o[l])
        h = rms_norm(x, ffn_norm[l])
        if l % 2 == 0:
            j = l // 2
            x = x + swiglu(h, ffn_w_gate[j], ffn_w_up[j], ffn_w_down[j])
        else:
            j = l // 2
            x = x + moe_swiglu(h, moe_router[j], moe_w_gate[j], moe_w_up[j], moe_w_down[j])
    return rms_norm(x, final_norm)
```

```cpp
#include <hip/hip_runtime.h>
#include <cstdio>
#include <cstdint>
#ifndef HD
#define HD __host__ __device__ __forceinline__
#endif
__device__ __forceinline__ int opq_tid() { int t = (int)threadIdx.x; asm volatile("" : "+v"(t)); return t; }
typedef float f32x2_cv __attribute__((ext_vector_type(2))); typedef __bf16 bf16x2_cv __attribute__((ext_vector_type(2)));
__device__ __forceinline__ unsigned cvtpk_hw(float lo, float hi) { f32x2_cv v = {lo, hi}; bf16x2_cv b = __builtin_convertvector(v, bf16x2_cv); return __builtin_bit_cast(unsigned, b); }

struct cf { float x, y; };
HD cf mk(float a, float b) { cf r; r.x = a; r.y = b; return r; }
HD cf cadd(cf a, cf b) { return mk(a.x + b.x, a.y + b.y); }
HD cf csub(cf a, cf b) { return mk(a.x - b.x, a.y - b.y); }
HD cf cmul(cf a, cf b) { return mk(a.x * b.x - a.y * b.y, a.x * b.y + a.y * b.x); }
HD cf cmulc(cf a, cf b) { return mk(a.x * b.x + a.y * b.y, a.y * b.x - a.x * b.y); }
template <bool INV> HD cf cmulw(cf a, cf w) { return INV ? cmulc(a, w) : cmul(a, w); }
HD cf cscale(cf a, float s) { return mk(a.x * s, a.y * s); }

template <bool INV> HD void dft4(cf& a0, cf& a1, cf& a2, cf& a3) {
    const cf t0 = cadd(a0, a2), t1 = csub(a0, a2), t2 = cadd(a1, a3), t3 = csub(a1, a3);
    a0 = cadd(t0, t2); a2 = csub(t0, t2);
    const cf mit3 = mk(t3.y, -t3.x);
    if (!INV) { a1 = cadd(t1, mit3); a3 = csub(t1, mit3); }
    else      { a1 = csub(t1, mit3); a3 = cadd(t1, mit3); }
}
template <bool INV> HD void dft16(cf (&x)[16]) {
#pragma unroll
    for (int n1 = 0; n1 < 4; ++n1) dft4<INV>(x[n1], x[n1 + 4], x[n1 + 8], x[n1 + 12]);
    const float c1 = 0.92387953251128674f, s1 = 0.38268343236508977f, r2 = 0.70710678118654752f;
    const cf W1 = mk(c1, -s1), W2 = mk(r2, -r2), W3 = mk(s1, -c1), W6 = mk(-r2, -r2), W9 = mk(-c1, s1);
    x[1 + 4 * 1] = cmulw<INV>(x[1 + 4 * 1], W1);
    x[1 + 4 * 2] = cmulw<INV>(x[1 + 4 * 2], W2);
    x[1 + 4 * 3] = cmulw<INV>(x[1 + 4 * 3], W3);
    x[2 + 4 * 1] = cmulw<INV>(x[2 + 4 * 1], W2);
    { const cf t = x[2 + 4 * 2]; x[2 + 4 * 2] = INV ? mk(-t.y, t.x) : mk(t.y, -t.x); }
    x[2 + 4 * 3] = cmulw<INV>(x[2 + 4 * 3], W6);
    x[3 + 4 * 1] = cmulw<INV>(x[3 + 4 * 1], W3);
    x[3 + 4 * 2] = cmulw<INV>(x[3 + 4 * 2], W6);
    x[3 + 4 * 3] = cmulw<INV>(x[3 + 4 * 3], W9);
#pragma unroll
    for (int k2 = 0; k2 < 4; ++k2) dft4<INV>(x[0 + 4 * k2], x[1 + 4 * k2], x[2 + 4 * k2], x[3 + 4 * k2]);
    cf t;
    t = x[1]; x[1] = x[4]; x[4] = t;   t = x[2]; x[2] = x[8]; x[8] = t;   t = x[3]; x[3] = x[12]; x[12] = t;
    t = x[6]; x[6] = x[9]; x[9] = t;   t = x[7]; x[7] = x[13]; x[13] = t; t = x[11]; x[11] = x[14]; x[14] = t;
}
template <bool INV> HD void twiddle16(cf (&x)[16], cf w1) {
    cf w = w1;
#pragma unroll
    for (int k = 1; k < 16; ++k) { x[k] = cmulw<INV>(x[k], w); if (k < 15) w = cmul(w, w1); }
}
constexpr int FFT_HALF = 4352;
constexpr int FFT_WORK = 2 * FFT_HALF;
HD int fphys(int h, int idx) { return h * FFT_HALF + idx + (idx >> 4); }

HD void geo1(int tid, int& h, int& j) { const int w = tid >> 6, l = tid & 63; h = l >> 5; j = 32 * w + (l & 31); }
HD void geo2(int tid, int& h, int& k1, int& j2) { h = tid >> 8; k1 = (tid >> 4) & 15; j2 = tid & 15; }
HD void geo3(int tid, int& h, int& blk) { h = tid >> 8; blk = tid & 255; }

HD int fbase1(int h, int j) { return h * FFT_HALF + j + (j >> 4); }
HD int fbase2(int h, int k1, int j2) { return h * FFT_HALF + 272 * k1 + j2; }
HD int fbase3(int h, int blk) { return h * FFT_HALF + 17 * blk; }
template <class L> HD void fwd_pass1(L lds, int b1, cf w4096j, cf (&x)[16]) {
    dft16<false>(x); twiddle16<false>(x, w4096j);
#pragma unroll
    for (int k = 0; k < 16; ++k) lds.st(b1 + 272 * k, x[k]);
}
template <class L> HD void fwd_pass2(L lds, int b2, cf w256j) {
    cf x[16];
#pragma unroll
    for (int m = 0; m < 16; ++m) x[m] = lds.ld(b2 + 17 * m);
    dft16<false>(x); twiddle16<false>(x, w256j);
#pragma unroll
    for (int k = 0; k < 16; ++k) lds.st(b2 + 17 * k, x[k]);
}
template <class L> HD void fwd_pass3_keep(L lds, int b3, cf (&x)[16]) {
#pragma unroll
    for (int m = 0; m < 16; ++m) x[m] = lds.ld(b3 + m);
    dft16<false>(x);
}
template <class L> HD void mid_pass3(L lds, int b3, const cf (&K)[16]) {
    cf x[16];
#pragma unroll
    for (int m = 0; m < 16; ++m) x[m] = lds.ld(b3 + m);
    dft16<false>(x);
#pragma unroll
    for (int k = 0; k < 16; ++k) x[k] = cmul(x[k], K[k]);
    dft16<true>(x);
#pragma unroll
    for (int m = 0; m < 16; ++m) lds.st(b3 + m, x[m]);
}
template <class L> HD void inv_pass2(L lds, int b2, cf w256j) {
    cf x[16];
#pragma unroll
    for (int k = 0; k < 16; ++k) x[k] = lds.ld(b2 + 17 * k);
    twiddle16<true>(x, w256j); dft16<true>(x);
#pragma unroll
    for (int m = 0; m < 16; ++m) lds.st(b2 + 17 * m, x[m]);
}
template <class L> HD void inv_pass1(L lds, int b1, cf w4096j, cf (&x)[16]) {
#pragma unroll
    for (int k = 0; k < 16; ++k) x[k] = lds.ld(b1 + 272 * k);
    twiddle16<true>(x, w4096j); dft16<true>(x);
}
#ifndef PG8_WGM
#define PG8_WGM 8
#endif
namespace pg8 {
#define PG8_LAS __attribute__((address_space(3)))
typedef unsigned short bf16_t;
typedef short bf16x8 __attribute__((ext_vector_type(8)));
typedef float f32x4 __attribute__((ext_vector_type(4)));
typedef unsigned u32x4 __attribute__((ext_vector_type(4)));
constexpr int BM = 256, BK = 64, HALF = 128, HTB = HALF * BK * 2  , STAGE_BYTES = 8 * HTB, NXCD = 8, WGM = PG8_WGM;

__host__ __device__ __forceinline__ int lds_byte(int r, int c) { const int st = (r >> 4) * 2 + (c >> 5), rr = r & 15, cc = c & 31, ob = rr * 64 + cc * 2; return st * 1024 + (ob ^ (((ob >> 9) & 1) << 5)); }
__host__ __device__ __forceinline__ void stage_rc(int b, int& R, int& C) { const int st = b / 1024, sb = b % 1024, swz = sb ^ (((sb >> 9) & 1) << 5); R = (st >> 1) * 16 + swz / 64; C = (st & 1) * 32 + (swz % 64) / 2; }
__host__ __device__ __forceinline__ int perm32(int rho) { const int n = rho >> 4, i = rho & 15; return 8 * (i >> 2) + 4 * n + (i & 3); }

struct Unit { int pm, pn; };
struct Gemm { const bf16_t* A; const bf16_t* Bt; int M, N, K; };

struct StaticOrder {
    int nM, nN, nwg, G, c;
    __host__ __device__ void init(int M, int N, int G_, int c_) { nM = M / BM; nN = N / BM; nwg = nM * nN; G = G_; c = c_; }
    __host__ __device__ bool next(int i, Unit& u) const {
        const long L = (long)i * G + c; if (L >= nwg) return false;
        int wgid = (int)L; { const int q = nwg / NXCD, r = nwg % NXCD, xcd = wgid % NXCD, off = wgid / NXCD; wgid = (xcd < r ? xcd * (q + 1) : r * (q + 1) + (xcd - r) * q) + off; }
        const int nig = WGM * nN, gid = wgid / nig, fm = gid * WGM, gsz = (nM - fm) < WGM ? (nM - fm) : WGM;
        u.pm = fm + ((wgid % nig) % gsz); u.pn = (wgid % nig) / gsz; return true;
    }
    __device__ __forceinline__ size_t boff(const Unit&) const { return 0; }
    __device__ __forceinline__ void a_ready(const Unit&) const {}
    __device__ __forceinline__ void done(const Unit&) const {}
};

__device__ __forceinline__ unsigned cvt_pk_bf16(float lo, float hi) { unsigned r; asm volatile("v_cvt_pk_bf16_f32 %0, %1, %2" : "=v"(r) : "v"(lo), "v"(hi)); return r; }
typedef float f32x2 __attribute__((ext_vector_type(2)));
typedef unsigned u32x2 __attribute__((ext_vector_type(2)));
__device__ __forceinline__ float row_rs(const float* ssp, int row, int fq) {
    if (!ssp) return 1.0f;
    const f32x4 q = *(const f32x4*)(ssp + (size_t)row * 16 + 4 * fq); float s = (q[0] + q[1]) + (q[2] + q[3]);
    s += __shfl_xor(s, 16); s += __shfl_xor(s, 32);
    return __builtin_amdgcn_rsqf(s * (1.0f / 1024.0f) + 1e-6f);
}
__device__ __forceinline__ void row_rs8(const float* ssp, int row0, int fq, float (&rs)[2][4]) {
    if (!ssp) {
#pragma unroll
        for (int ai = 0; ai < 2; ++ai)
#pragma unroll
            for (int m = 0; m < 4; ++m) rs[ai][m] = 1.0f;
        return; }
    f32x4 q[2][4];
#pragma unroll
    for (int ai = 0; ai < 2; ++ai)
#pragma unroll
        for (int m = 0; m < 4; ++m) q[ai][m] = *(const f32x4*)(ssp + (size_t)(row0 + ai * HALF + m * 16) * 16 + 4 * fq);
#pragma unroll
    for (int ai = 0; ai < 2; ++ai)
#pragma unroll
        for (int m = 0; m < 4; ++m) { float s = (q[ai][m][0] + q[ai][m][1]) + (q[ai][m][2] + q[ai][m][3]); s += __shfl_xor(s, 16); s += __shfl_xor(s, 32); rs[ai][m] = __builtin_amdgcn_rsqf(s * (1.0f / 1024.0f) + 1e-6f); }
}
__device__ __forceinline__ f32x4 row_rs4_swap(const float* ssp, int rowbase, int fr, int fq) {
    if (!ssp) return (f32x4){1.f, 1.f, 1.f, 1.f};
    const f32x4 q = *(const f32x4*)(ssp + (size_t)(rowbase + 4 * fq + (fr >> 2)) * 16 + 4 * (fr & 3)); float s = (q[0] + q[1]) + (q[2] + q[3]);
    s += __shfl_xor(s, 1); s += __shfl_xor(s, 2);
    const float rs = __builtin_amdgcn_rsqf(s * (1.0f / 1024.0f) + 1e-6f);
    f32x4 o;
#pragma unroll
    for (int r = 0; r < 4; ++r) o[r] = __shfl(rs, 16 * fq + 4 * r);
    return o;
}
struct EpiBf16 {
    static constexpr bool PERM = true, AFTER_DRAIN = false, SWAP = false;
    bf16_t* O; int ldc; const float* ss;
    __device__ __forceinline__ void operator()(const f32x4 (&acc)[2][2][4][2], const Unit& u, int wr, int wc, int fr, int fq) const {
        const int row0 = u.pm * BM + wr * 64 + fr, col0 = u.pn * BM + wc * 32 + 8 * fq;
        float rsa[2][4]; row_rs8(ss, row0, fq, rsa);
#pragma unroll
        for (int ai = 0; ai < 2; ++ai)
#pragma unroll
            for (int m = 0; m < 4; ++m) { bf16_t* rowp = O + (size_t)(row0 + ai * HALF + m * 16) * ldc + col0; const float rs = rsa[ai][m];
#pragma unroll
                for (int bj = 0; bj < 2; ++bj) { const f32x4 v0 = acc[ai][bj][m][0] * rs, v1 = acc[ai][bj][m][1] * rs;
                    u32x4 w; w.x = cvt_pk_bf16(v0[0], v0[1]); w.y = cvt_pk_bf16(v0[2], v0[3]); w.z = cvt_pk_bf16(v1[0], v1[1]); w.w = cvt_pk_bf16(v1[2], v1[3]);
                    *(u32x4*)(rowp + bj * HALF) = w; } }
    }
};
struct EpiQKV {
    static constexpr bool PERM = true, AFTER_DRAIN = false, SWAP = false;
    bf16_t* Q; bf16_t* Kb; bf16_t* Vb; const float* cosT; const float* sinT; const float* ss;
    __device__ __forceinline__ void operator()(const f32x4 (&acc)[2][2][4][2], const Unit& u, int wr, int wc, int fr, int fq) const {
        const int row0 = u.pm * BM + wr * 64 + fr;
        float rsa[2][4]; row_rs8(ss, row0, fq, rsa);
#pragma unroll
        for (int bj = 0; bj < 2; ++bj) {
            const int slot0 = u.pn * BM + bj * HALF + wc * 32 + 8 * fq;
            if (slot0 < 640) {
                const int head = slot0 >> 6, j4 = ((slot0 & 63) >> 3) * 4;
#pragma unroll
                for (int am = 0; am < 4; ++am) {
                    f32x4 c[2], sn[2];
                    const int tofs = ((row0 & 4095) + (am >> 1) * HALF + 2 * (am & 1) * 16) * 32 + j4;
                    const float* cb = cosT + tofs; const float* sb = sinT + tofs; asm volatile("" : "+v"(cb), "+v"(sb));
#pragma unroll
                    for (int h = 0; h < 2; ++h) { c[h] = *(const f32x4*)(cb + h * 512); sn[h] = *(const f32x4*)(sb + h * 512); }
#pragma unroll
                    for (int h = 0; h < 2; ++h) { const int ai = am >> 1, m = 2 * (am & 1) + h; const int row = row0 + ai * HALF + m * 16;
                        const float rs = rsa[ai][m]; const f32x4 lo = acc[ai][bj][m][0] * rs, hi = acc[ai][bj][m][1] * rs;
                        const f32x4 olo = lo * c[h] - hi * sn[h], ohi = hi * c[h] + lo * sn[h];
                        bf16_t* dst = head < 8 ? Q + (size_t)row * 512 + head * 64 + j4 : Kb + (size_t)row * 128 + (head - 8) * 64 + j4;
                        u32x2 w0, w1; w0.x = cvt_pk_bf16(olo[0], olo[1]); w0.y = cvt_pk_bf16(olo[2], olo[3]); w1.x = cvt_pk_bf16(ohi[0], ohi[1]); w1.y = cvt_pk_bf16(ohi[2], ohi[3]);
                        *(u32x2*)dst = w0; *(u32x2*)(dst + 32) = w1; } }
            } else {
#pragma unroll
                for (int ai = 0; ai < 2; ++ai)
#pragma unroll
                    for (int m = 0; m < 4; ++m) { const int row = row0 + ai * HALF + m * 16; const float rs = rsa[ai][m]; const f32x4 v0 = acc[ai][bj][m][0] * rs, v1 = acc[ai][bj][m][1] * rs;
                        u32x4 w; w.x = cvt_pk_bf16(v0[0], v0[1]); w.y = cvt_pk_bf16(v0[2], v0[3]); w.z = cvt_pk_bf16(v1[0], v1[1]); w.w = cvt_pk_bf16(v1[2], v1[3]);
                        *(u32x4*)(Vb + (size_t)row * 128 + (slot0 - 640)) = w; }
            }
        }
    }
};
struct EpiT {
    static constexpr bool PERM = false, AFTER_DRAIN = false, SWAP = true;
    bf16_t* O; int nch; int ts_shift; const float* ss;
    __device__ __forceinline__ void operator()(const f32x4 (&acc)[2][2][4][2], const Unit& u, int wr, int wc, int fr, int fq) const {
        const int rowt = u.pm * BM, b = rowt >> ts_shift, tb = (rowt & ((1 << ts_shift) - 1)) + wr * 64 + 4 * fq;
#pragma unroll
        for (int ai = 0; ai < 2; ++ai) {
            f32x4 rsv[4];
#pragma unroll
            for (int m = 0; m < 4; ++m) rsv[m] = row_rs4_swap(ss, rowt + wr * 64 + ai * HALF + m * 16, fr, fq);
#pragma unroll
            for (int bj = 0; bj < 2; ++bj)
#pragma unroll
                for (int n = 0; n < 2; ++n) { const int ch = u.pn * BM + bj * HALF + wc * 32 + 16 * n + fr; bf16_t* chp = O + (((size_t)(b * nch + ch)) << ts_shift) + tb + ai * HALF;
#pragma unroll
                    for (int m = 0; m < 4; ++m) { const f32x4 v = acc[ai][bj][m][n] * rsv[m]; u32x2 w; w.x = cvt_pk_bf16(v[0], v[1]); w.y = cvt_pk_bf16(v[2], v[3]);
                        *(u32x2*)(chp + m * 16) = w; } } }
    }
};
struct EpiResB {
    static constexpr bool PERM = true, AFTER_DRAIN = false, SWAP = false;
    bf16_t* xb; int ldc; float* ss; bf16_t* dst;
    __device__ __forceinline__ void operator()(const f32x4 (&acc)[2][2][4][2], const Unit& u, int wr, int wc, int fr, int fq) const {
        const int row0 = u.pm * BM + wr * 64 + fr, col0 = u.pn * BM + wc * 32 + 8 * fq;
#pragma unroll
        for (int ai = 0; ai < 2; ++ai) {
            u32x4 b[4][2];
#pragma unroll
            for (int m = 0; m < 4; ++m)
#pragma unroll
                for (int bj = 0; bj < 2; ++bj) b[m][bj] = *(const u32x4*)(xb + (size_t)(row0 + ai * HALF + m * 16) * ldc + col0 + bj * HALF);
#pragma unroll
            for (int m = 0; m < 4; ++m) { const int row = row0 + ai * HALF + m * 16; bf16_t* dstp = dst + (size_t)row * ldc + col0; float sq = 0.f;
#pragma unroll
                for (int bj = 0; bj < 2; ++bj) { const f32x4 a0 = acc[ai][bj][m][0], a1 = acc[ai][bj][m][1]; const u32x4 bb = b[m][bj]; float o[8];
                    o[0] = __builtin_bit_cast(float, bb.x << 16) + a0[0]; o[1] = __builtin_bit_cast(float, bb.x & 0xffff0000u) + a0[1];
                    o[2] = __builtin_bit_cast(float, bb.y << 16) + a0[2]; o[3] = __builtin_bit_cast(float, bb.y & 0xffff0000u) + a0[3];
                    o[4] = __builtin_bit_cast(float, bb.z << 16) + a1[0]; o[5] = __builtin_bit_cast(float, bb.z & 0xffff0000u) + a1[1];
                    o[6] = __builtin_bit_cast(float, bb.w << 16) + a1[2]; o[7] = __builtin_bit_cast(float, bb.w & 0xffff0000u) + a1[3];
#pragma unroll
                    for (int i = 0; i < 8; ++i) sq += o[i] * o[i];
                    u32x4 w; w.x = cvt_pk_bf16(o[0], o[1]); w.y = cvt_pk_bf16(o[2], o[3]); w.z = cvt_pk_bf16(o[4], o[5]); w.w = cvt_pk_bf16(o[6], o[7]);
                    *(u32x4*)(dstp + bj * HALF) = w; }
                if (ss) { sq += __shfl_xor(sq, 16); sq += __shfl_xor(sq, 32); if (fq == 0) ss[(size_t)row * 16 + u.pn * 4 + wc] = sq; } } }
    }
};
typedef float f32x2e __attribute__((ext_vector_type(2)));
__device__ __forceinline__ f32x2e silu_mul_pk(f32x2e g, f32x2e up) {
    const f32x2e t = g * (-1.44269504088896f); f32x2e e; e.x = __builtin_amdgcn_exp2f(t.x); e.y = __builtin_amdgcn_exp2f(t.y);
    const f32x2e d = e + 1.0f; f32x2e r; r.x = __builtin_amdgcn_rcpf(d.x); r.y = __builtin_amdgcn_rcpf(d.y);
    return (g * r) * up;
}
template <bool SCALE> struct EpiSwiglu {
    static constexpr bool PERM = true, AFTER_DRAIN = false, SWAP = false;
    bf16_t* O; int ldc; const float* ss;
    __device__ __forceinline__ void operator()(const f32x4 (&acc)[2][2][4][2], const Unit& u, int wr, int wc, int fr, int fq) const {
        const int row0 = u.pm * BM + wr * 64 + fr, col0 = u.pn * 128 + wc * 16 + 4 * fq;
        float rsa[2][4]; if (SCALE) row_rs8(ss, row0, fq, rsa);
#pragma unroll
        for (int ai = 0; ai < 2; ++ai)
#pragma unroll
            for (int m = 0; m < 4; ++m) { bf16_t* rowp = O + (size_t)(row0 + ai * HALF + m * 16) * ldc + col0; const float rs = SCALE ? rsa[ai][m] : 1.0f;
#pragma unroll
                for (int bj = 0; bj < 2; ++bj) { f32x4 g = acc[ai][bj][m][0], up = acc[ai][bj][m][1]; if (SCALE) { g = g * rs; up = up * rs; }
                    const f32x2e o0 = silu_mul_pk((f32x2e){g[0], g[1]}, (f32x2e){up[0], up[1]}), o1 = silu_mul_pk((f32x2e){g[2], g[3]}, (f32x2e){up[2], up[3]});
                    u32x2 w; w.x = cvt_pk_bf16(o0.x, o0.y); w.y = cvt_pk_bf16(o1.x, o1.y);
                    *(u32x2*)(rowp + bj * 64) = w; } }
    }
};
template <class Epi, class Sched, bool ALIGN_EPI = false, bool SP2 = false>
__device__ __forceinline__ void gemm_phase(PG8_LAS unsigned char* lds, const Gemm g, const Sched& S, const Epi& E) {
    const int tid = opq_tid(), wid = __builtin_amdgcn_readfirstlane(tid >> 6), lane = tid & 63, wr = wid >> 2, wc = wid & 3, fr = lane & 15, fq = lane >> 4;
    const int K = g.K, nt = K / BK;
    unsigned voffA[2], voffB[2];
#pragma unroll
    for (int i = 0; i < 2; ++i) { int R, C; stage_rc(tid * 16 + i * 8192, R, C); const int Rb = Epi::PERM ? ((R & ~31) + perm32(R & 31)) : R;
        voffA[i] = (unsigned)(R * K + C) * 2u; voffB[i] = (unsigned)(Rb * K + C) * 2u; }
    const size_t kstep = (size_t)(BK * 2);
    const size_t hstep = (size_t)HALF * K * 2;
    const size_t tstep = 2 * hstep;
    const unsigned ldsw = (unsigned)wid * 1024u;
    const int aoff = lds_byte(wr * 64 + fr, fq * 8), boff = lds_byte(wc * 32 + fr, fq * 8);
#define PG8_SA(b, h) (((b) * 2 + (h)) * HTB)
#define PG8_SB(b, h) ((4 + (b) * 2 + (h)) * HTB)
#define PG8_STAGE(bufoff, gbase, voff) do { _Pragma("unroll") for (int _i = 0; _i < 2; ++_i) \
        __builtin_amdgcn_global_load_lds((const unsigned*)((const char*)(gbase) + (voff)[_i]), (PG8_LAS unsigned*)(lds + (bufoff) + ldsw + _i * 8192), 16, 0, 0); } while (0)
#define PG8_LDA(dst, b, h) do { _Pragma("unroll") for (int m = 0; m < 4; ++m) _Pragma("unroll") for (int k = 0; k < 2; ++k) dst[m][k] = *(const PG8_LAS bf16x8*)(lds + PG8_SA(b, h) + aoff + m * 2048 + k * 1024); } while (0)
#define PG8_LDB(dst, b, h) do { _Pragma("unroll") for (int n = 0; n < 2; ++n) _Pragma("unroll") for (int k = 0; k < 2; ++k) dst[n][k] = *(const PG8_LAS bf16x8*)(lds + PG8_SB(b, h) + boff + n * 2048 + k * 1024); } while (0)
#define PG8_MMA(ai, bj, At, Bt) do { __builtin_amdgcn_s_setprio(1); _Pragma("unroll") for (int m = 0; m < 4; ++m) _Pragma("unroll") for (int n = 0; n < 2; ++n) _Pragma("unroll") for (int k = 0; k < 2; ++k) \
        acc[ai][bj][m][n] = Epi::SWAP ? __builtin_amdgcn_mfma_f32_16x16x32_bf16(At[m][k], Bt[n][k], acc[ai][bj][m][n], 0, 0, 0) : __builtin_amdgcn_mfma_f32_16x16x32_bf16(Bt[n][k], At[m][k], acc[ai][bj][m][n], 0, 0, 0); __builtin_amdgcn_s_setprio(0); } while (0)
#define PG8_WAIT_V(n) asm volatile("s_waitcnt vmcnt(" #n ")" ::: "memory")
#define PG8_WAIT_L(n) asm volatile("s_waitcnt lgkmcnt(" #n ")" ::: "memory")
#define PG8_BAR __builtin_amdgcn_s_barrier()
#define PG8_SCHED __builtin_amdgcn_sched_barrier(0)
    Unit cur, nxt; int ui = 0;
    if (!S.next(0, cur)) return;
    f32x4 acc[2][2][4][2];
#pragma unroll
    for (int a = 0; a < 2; ++a)
#pragma unroll
        for (int b = 0; b < 2; ++b)
#pragma unroll
            for (int m = 0; m < 4; ++m)
#pragma unroll
                for (int n = 0; n < 2; ++n) acc[a][b][m][n] = (f32x4){0.f, 0.f, 0.f, 0.f};
    bf16x8 At[4][2], B0[2][2], B1[2][2];
    const char* cA = (const char*)g.A + (size_t)cur.pm * tstep; const char* cB = (const char*)g.Bt + S.boff(cur) + (size_t)cur.pn * tstep;
    S.a_ready(cur);
    if constexpr (SP2) {
        PG8_STAGE(PG8_SB(0, 0), cB, voffB); PG8_STAGE(PG8_SB(0, 1), cB + hstep, voffB); PG8_STAGE(PG8_SA(0, 0), cA, voffA); PG8_STAGE(PG8_SA(0, 1), cA + hstep, voffA);
        if (wr == 1) PG8_BAR;
        PG8_WAIT_V(2); PG8_BAR;
        PG8_STAGE(PG8_SB(1, 0), cB + kstep, voffB); PG8_STAGE(PG8_SA(1, 0), cA + kstep, voffA); PG8_STAGE(PG8_SB(1, 1), cB + hstep + kstep, voffB);
        PG8_WAIT_V(6); PG8_BAR;
    } else {
        PG8_STAGE(PG8_SB(0, 0), cB, voffB); PG8_STAGE(PG8_SA(0, 0), cA, voffA); PG8_STAGE(PG8_SB(0, 1), cB + hstep, voffB); PG8_STAGE(PG8_SA(0, 1), cA + hstep, voffA);
        if (wr == 1) PG8_BAR;
        PG8_WAIT_V(4); PG8_BAR;
        PG8_STAGE(PG8_SB(1, 0), cB + kstep, voffB); PG8_STAGE(PG8_SA(1, 0), cA + kstep, voffA); PG8_STAGE(PG8_SB(1, 1), cB + hstep + kstep, voffB);
        PG8_WAIT_V(6); PG8_BAR;
    }
    for (;;) {
        const bool has_next = S.next(ui + 1, nxt);
        const char* nA = has_next ? (const char*)g.A + (size_t)nxt.pm * tstep : cA; const char* nB = has_next ? (const char*)g.Bt + S.boff(nxt) + (size_t)nxt.pn * tstep : cB;
        for (int t = 0; t < nt; t += 2) {
            const bool last = (t == nt - 2);
            const char* a1 = cA + (size_t)(t + 1) * kstep;
            const char* a2 = last ? nA : cA + (size_t)(t + 2) * kstep; const char* b2 = last ? nB : cB + (size_t)(t + 2) * kstep;
            const char* a3 = a2 + kstep; const char* b3 = b2 + kstep;
            if (last && has_next) S.a_ready(nxt);
            if constexpr (SP2) {
            PG8_LDB(B0, 0, 0); PG8_LDB(B1, 0, 1); PG8_SCHED; PG8_LDA(At, 0, 0); PG8_STAGE(PG8_SA(1, 1), a1 + hstep, voffA);
            PG8_WAIT_V(8); PG8_WAIT_L(0); PG8_BAR; PG8_MMA(0, 0, At, B0); PG8_MMA(0, 1, At, B1); PG8_BAR; PG8_SCHED;
            PG8_LDA(At, 0, 1); PG8_STAGE(PG8_SB(0, 0), b2, voffB); PG8_STAGE(PG8_SB(0, 1), b2 + hstep, voffB); PG8_STAGE(PG8_SA(0, 0), a2, voffA);
            PG8_WAIT_V(8); PG8_WAIT_L(0); PG8_BAR; PG8_MMA(1, 0, At, B0); PG8_MMA(1, 1, At, B1); PG8_BAR; PG8_SCHED;
            PG8_LDB(B0, 1, 0); PG8_LDB(B1, 1, 1); PG8_SCHED; PG8_LDA(At, 1, 0); PG8_STAGE(PG8_SA(0, 1), a2 + hstep, voffA);
            PG8_WAIT_V(8); PG8_WAIT_L(0); PG8_BAR; PG8_MMA(0, 0, At, B0); PG8_MMA(0, 1, At, B1); PG8_BAR; PG8_SCHED;
            PG8_LDA(At, 1, 1); PG8_STAGE(PG8_SB(1, 0), b3, voffB); PG8_STAGE(PG8_SB(1, 1), b3 + hstep, voffB); PG8_STAGE(PG8_SA(1, 0), a3, voffA);
            PG8_WAIT_V(8); PG8_WAIT_L(0); PG8_BAR; PG8_MMA(1, 0, At, B0); PG8_MMA(1, 1, At, B1); PG8_BAR; PG8_SCHED;
            } else {
            PG8_LDB(B0, 0, 0); PG8_SCHED; PG8_LDA(At, 0, 0); PG8_STAGE(PG8_SA(1, 1), a1 + hstep, voffA);
            PG8_WAIT_L(8); PG8_BAR; PG8_WAIT_L(0); PG8_MMA(0, 0, At, B0); PG8_BAR; PG8_SCHED;
            PG8_LDB(B1, 0, 1); PG8_STAGE(PG8_SB(0, 0), b2, voffB);
            PG8_BAR; PG8_WAIT_L(0); PG8_MMA(0, 1, At, B1); PG8_BAR;
            PG8_LDA(At, 0, 1); PG8_STAGE(PG8_SA(0, 0), a2, voffA);
            PG8_BAR; PG8_WAIT_L(0); PG8_MMA(1, 0, At, B0); PG8_BAR; PG8_SCHED;
            PG8_STAGE(PG8_SB(0, 1), b2 + hstep, voffB);
            PG8_WAIT_V(6); PG8_BAR; PG8_MMA(1, 1, At, B1); PG8_BAR;
            PG8_LDB(B0, 1, 0); PG8_SCHED; PG8_LDA(At, 1, 0); PG8_STAGE(PG8_SA(0, 1), a2 + hstep, voffA);
            PG8_WAIT_L(8); PG8_BAR; PG8_WAIT_L(0); PG8_MMA(0, 0, At, B0); PG8_BAR; PG8_SCHED;
            PG8_LDB(B1, 1, 1); PG8_STAGE(PG8_SB(1, 0), b3, voffB);
            PG8_BAR; PG8_WAIT_L(0); PG8_MMA(0, 1, At, B1); PG8_BAR;
            PG8_LDA(At, 1, 1); PG8_STAGE(PG8_SA(1, 0), a3, voffA);
            PG8_BAR; PG8_WAIT_L(0); PG8_MMA(1, 0, At, B0); PG8_BAR; PG8_SCHED;
            PG8_STAGE(PG8_SB(1, 1), b3 + hstep, voffB);
            PG8_WAIT_V(6); PG8_BAR; PG8_MMA(1, 1, At, B1); PG8_BAR;
            }
        }
        if constexpr (ALIGN_EPI) { if (wr == 0) PG8_BAR; }
#ifndef EPI_REP
#define EPI_REP 1
#endif
        if constexpr (!Epi::AFTER_DRAIN) { _Pragma("unroll 1") for (int er_ = 0; er_ < EPI_REP; ++er_) E(acc, cur, wr, wc, fr, fq); S.done(cur); }
        if (!has_next) break;
#pragma unroll
        for (int a = 0; a < 2; ++a)
#pragma unroll
            for (int b = 0; b < 2; ++b)
#pragma unroll
                for (int m = 0; m < 4; ++m)
#pragma unroll
                    for (int n = 0; n < 2; ++n) acc[a][b][m][n] = (f32x4){0.f, 0.f, 0.f, 0.f};
        cur = nxt; cA = nA; cB = nB; ++ui;
        if constexpr (ALIGN_EPI) { if (wr == 1) PG8_BAR; }
    }
    PG8_WAIT_V(0);
    if constexpr (!ALIGN_EPI) { if (wr == 0) PG8_BAR; }
    PG8_BAR;
    if constexpr (Epi::AFTER_DRAIN) { E.fused(acc, cur, wr, wc, fr, fq, lds, wid, lane); S.done(cur); }
#undef PG8_SA
#undef PG8_SB
#undef PG8_STAGE
#undef PG8_LDA
#undef PG8_LDB
#undef PG8_MMA
#undef PG8_WAIT_V
#undef PG8_WAIT_L
#undef PG8_BAR
#undef PG8_SCHED
}
}
#ifndef PG8_SP2
#define PG8_SP2 true
#endif
#ifndef PG8_ALIGN
#define PG8_ALIGN true
#endif
constexpr int NB = 16, SEQ = 4096, D = 1024, M = NB * SEQ;
constexpr int NH = 8, NKV = 2, HDIM = 64, AW = 512, KVW = 128;
constexpr int HYW = 512, C3 = 1536, INC = 2304;
constexpr int XH = 4, XHD = 128, XW = 512, MEML = 256, MROWS = NB * MEML;
constexpr int FF = 2816, NE = 8, FFE = 3584;
constexpr float EPS = 1e-6f;
constexpr int NWAVES = 8, NTHR = 512;
constexpr int MOE_CH_TILES = 128, MOE_MAX_TILES = 520, MOE_MAX_ROWS = MOE_MAX_TILES * 256, MOE_ACT_TILES = 136;

constexpr size_t al256(size_t x) { return (x + 255) & ~(size_t)255; }
constexpr size_t WS_CTL = 0, CTL_ZERO_BYTES = 1u << 20;
constexpr size_t WS_SS = CTL_ZERO_BYTES, SS_STRIDE = (size_t)M * 16;
constexpr size_t WS_COS = WS_SS + 5 * SS_STRIDE * 4, WS_SIN = WS_COS + (size_t)SEQ * 32 * 4, WS_H2 = WS_SIN + (size_t)SEQ * 32 * 4;
constexpr size_t WS_TOKE = WS_H2 + (size_t)2 * SEQ * 64 * 4, WS_TOKW = WS_TOKE + (size_t)M * 2 * 4, WS_TOKP = WS_TOKW + (size_t)M * 2 * 4;
constexpr size_t WS_ROWTOK = WS_TOKP + (size_t)M * 2 * 4, WS_TILEE = WS_ROWTOK + al256((size_t)MOE_MAX_ROWS * 4), WS_WGCNT = WS_TILEE + 4096, WS_RSROW = WS_WGCNT + (size_t)1024 * 8 * 4, WS_META = WS_RSROW + (size_t)M * 4;
constexpr size_t WS_WINA = al256(WS_META + 4096);
constexpr size_t WS_WINB = WS_WINA + (size_t)2 * 768 * D * 2;
constexpr size_t WS_WOUT = WS_WINB + (size_t)2 * C3 * D * 2;
constexpr size_t WS_XQ = WS_WOUT + (size_t)2 * D * D * 2;
constexpr size_t WS_XK = WS_XQ + (size_t)2 * XW * D * 2;
constexpr size_t WS_XV = WS_XK + (size_t)2 * XW * D * 2;
constexpr size_t WS_XO = WS_XV + (size_t)2 * XW * D * 2;
constexpr size_t WS_FGU = WS_XO + (size_t)2 * D * XW * 2;
constexpr size_t WS_FDN = WS_FGU + (size_t)2 * FF * D * 2;
constexpr size_t WS_MGU = WS_FDN + (size_t)D * FF * 2;
constexpr size_t WS_MDN = WS_MGU + (size_t)NE * 2 * FFE * D * 2;
constexpr size_t WS_KFILT = WS_MDN + (size_t)NE * D * FFE * 2;
constexpr size_t WS_MB = WS_KFILT + (size_t)2 * 2 * HYW * 8192 * 4;
constexpr size_t WS_KMEM = WS_MB + (size_t)MROWS * D * 2;
constexpr size_t WS_VMEMT = WS_KMEM + (size_t)MROWS * 1024 * 2;
constexpr size_t WS_HB = WS_VMEMT + (size_t)1024 * MROWS * 2;
constexpr size_t WS_R = WS_HB + (size_t)M * D * 2;
constexpr size_t WS_QB = WS_R, WS_KB = WS_QB + (size_t)M * AW * 2, WS_VB = WS_KB + (size_t)M * KVW * 2, WS_UT = WS_VB + (size_t)M * KVW * 2;
constexpr size_t WS_MIXED = WS_UT;
constexpr size_t WS_AB = WS_UT + (size_t)M * C3 * 2, WS_YT = WS_AB + (size_t)M * AW * 2, WS_KSPEC = WS_YT + (size_t)M * HYW * 2, WS_MIXEND = WS_KSPEC + (size_t)2 * 2 * HYW * 16384 * 4;
constexpr size_t WS_XQB = WS_R, WS_XOB = WS_XQB + (size_t)M * XW * 2;
constexpr size_t WS_ACT = WS_R;
constexpr size_t WS_XG = WS_R;
constexpr size_t WS_MACT = WS_XG + (size_t)MOE_MAX_ROWS * D * 2;
constexpr size_t WS_MOEEND = WS_MACT + (size_t)MOE_ACT_TILES * 256 * FFE * 2;
constexpr size_t cmax(size_t a, size_t b) { return a > b ? a : b; }
constexpr size_t WS_END = cmax(cmax(WS_MIXEND, WS_ACT + (size_t)M * FF * 2), WS_MOEEND);
static_assert(WS_END <= (size_t)1073741824, "workspace map exceeds 1 GiB");
static_assert(WS_ACT + (size_t)M * FF * 2 <= WS_KSPEC && WS_XOB + (size_t)M * XW * 2 <= WS_KSPEC, "layer 0's later phases must not touch the filter spectra");
constexpr int CW_TMO = 0, CW_CODE = 1, CW_BAR = 4096;

constexpr int PHASE_LDS = 139264;
constexpr int LDSCTL_OFF = PHASE_LDS, MISC_OFF = LDSCTL_OFF + 64;
constexpr int LDS_BYTES = PHASE_LDS + 512;

#define GAS __attribute__((address_space(1)))
#define LAS __attribute__((address_space(3)))
typedef unsigned short bf16;
typedef unsigned v4u __attribute__((ext_vector_type(4)));
typedef unsigned v2u __attribute__((ext_vector_type(2)));
typedef float f32x4 __attribute__((ext_vector_type(4)));
typedef short bf16x8 __attribute__((ext_vector_type(8)));
typedef short s16x4 __attribute__((ext_vector_type(4)));
typedef GAS unsigned gu32;
#define RLX_AGENT __ATOMIC_RELAXED, __HIP_MEMORY_SCOPE_AGENT
#define LDS_WAIT() asm volatile("s_waitcnt lgkmcnt(0)" ::: "memory")
#define VM_WAIT() asm volatile("s_waitcnt vmcnt(0)" ::: "memory")
__device__ __forceinline__ unsigned f2bf(float f) { unsigned u = __builtin_bit_cast(unsigned, f); return (u + 0x7fffu + ((u >> 16) & 1u)) >> 16; }
__device__ __forceinline__ unsigned pk2(float lo, float hi) { return cvtpk_hw(lo, hi); }
__device__ __forceinline__ float bflo(unsigned w) { return __builtin_bit_cast(float, w << 16); }
__device__ __forceinline__ float bfhi(unsigned w) { return __builtin_bit_cast(float, w & 0xffff0000u); }
__device__ __forceinline__ float bf1(unsigned short h) { return __builtin_bit_cast(float, ((unsigned)h) << 16); }
#define XB_TMO      128
#define XB_XCNT(j)  (256  + 64 * (j))
#define XB_XSUB(j)  (1280 + 64 * (j))
#define XB_XGEN(j)  (2304 + 64 * (j))
#define XB_TOP      3328
#define XB_TOPGEN   3392
#define XCD_BAR_WORDS 3456
#define XB_SPIN_CAP (1u << 22)

__device__ __forceinline__ unsigned xb_ld(unsigned* p)              { return __hip_atomic_load(p, __ATOMIC_RELAXED, __HIP_MEMORY_SCOPE_AGENT); }
__device__ __forceinline__ unsigned xb_add(unsigned* p, unsigned v) { return __hip_atomic_fetch_add(p, v, __ATOMIC_RELAXED, __HIP_MEMORY_SCOPE_AGENT); }
__device__ __forceinline__ unsigned xb_xcc_id() { return (unsigned)__builtin_amdgcn_s_getreg((3 << 11) | 20) & 0xFu; }
#define XB_SPIN(cond, bar) do { unsigned _sp = 0; while (cond) { __builtin_amdgcn_s_sleep(1); \
    if ((++_sp & 255u) == 0u) { if (xb_ld(&(bar)[XB_TMO])) break; if (_sp > XB_SPIN_CAP) { atomicAdd(&(bar)[XB_TMO], 1u); break; } } } } while (0)

struct XcdBarrier {
    unsigned* bar; unsigned x;
    volatile LAS unsigned* st;
};

__device__ __forceinline__ XcdBarrier xcd_barrier_post(unsigned* bar, volatile LAS unsigned* st) {
    XcdBarrier b; b.bar = bar; b.x = xb_xcc_id(); b.st = st;
    if (threadIdx.x == 0) (void)xb_add(&bar[XB_XCNT(b.x)], 1u);
    return b;
}
__device__ __forceinline__ void xcd_barrier_complete(unsigned* bar, unsigned x, unsigned& nloc, unsigned& nx) {
    const unsigned G = gridDim.x * gridDim.y * gridDim.z;
    unsigned sum, cnt, mine, sp = 0u;
    for (;;) {
        sum = 0u; cnt = 0u; mine = 0u;
#pragma unroll
        for (unsigned j = 0; j < 16; ++j) { const unsigned c = xb_ld(&bar[XB_XCNT(j)]); sum += c; cnt += (c > 0u) ? 1u : 0u; mine = (j == x) ? c : mine; }
        if (sum == G) break;
        __builtin_amdgcn_s_sleep(1);
        if ((++sp & 255u) == 0u) { if (xb_ld(&bar[XB_TMO])) break; if (sp > XB_SPIN_CAP) { atomicAdd(&bar[XB_TMO], 1u); break; } }
    }
    nloc = mine > 0u ? mine : 1u; nx = cnt > 0u ? cnt : 1u;
}

__device__ __forceinline__ void xcd_barrier(const XcdBarrier& b) {
    asm volatile("s_waitcnt vmcnt(0)" ::: "memory");
    __syncthreads();
    if (threadIdx.x == 0) {
        unsigned* bar = b.bar;
        __builtin_amdgcn_s_waitcnt(0);
        unsigned nloc = b.st[0], nx = b.st[1];
        if (nloc == 0u) { xcd_barrier_complete(bar, b.x, nloc, nx); b.st[0] = nloc; b.st[1] = nx; }
        const unsigned old = xb_add(&bar[XB_XSUB(b.x)], 1u);
        const unsigned gen = old / nloc;
        if (old + 1u == (gen + 1u) * nloc) {
            __builtin_amdgcn_fence(__ATOMIC_RELEASE, "agent");
            asm volatile("s_waitcnt vmcnt(0)" ::: "memory");
            const unsigned og = xb_add(&bar[XB_TOP], 1u);
            const unsigned tg = og / nx;
            if (og + 1u == (tg + 1u) * nx) xb_add(&bar[XB_TOPGEN], 1u);
            else XB_SPIN(xb_ld(&bar[XB_TOPGEN]) == tg, bar);
            __builtin_amdgcn_fence(__ATOMIC_ACQUIRE, "agent");
            xb_add(&bar[XB_XGEN(b.x)], 1u);
            asm volatile("s_waitcnt vmcnt(0)" ::: "memory");
        } else {
            XB_SPIN(xb_ld(&bar[XB_XGEN(b.x)]) == gen, bar);
            __builtin_amdgcn_fence(__ATOMIC_ACQUIRE, "agent");
            asm volatile("s_waitcnt vmcnt(0)" ::: "memory");
        }
    }
    __syncthreads();
}
struct Args { const float* in[33]; float* out; unsigned char* ws; int ph_lo, ph_hi, use_bar, pad; };
enum InIdx { I_X = 0, I_MEM, I_MEMNORM, I_MIXNORM, I_WIN, I_SINK, I_CONVW, I_CONVB, I_FW1, I_FB1, I_FFR1, I_FW2, I_FB2, I_FFR2, I_FW3, I_SKIP, I_ANORM, I_YNORM, I_WOUT, I_XNORM,
             I_XWQ, I_XWK, I_XWV, I_XWO, I_FNORM, I_FGATE, I_FUP, I_FDOWN, I_ROUTER, I_MGATE, I_MUP, I_MDOWN, I_FINAL };

__device__ __forceinline__ float wave_sum(float v) {
#pragma unroll
    for (int o = 1; o < 64; o <<= 1) v += __shfl_xor(v, o);
    return v;
}
__device__ __forceinline__ void wg_sync() { __builtin_amdgcn_sched_barrier(0); asm volatile("s_waitcnt vmcnt(0) lgkmcnt(0)" ::: "memory"); __builtin_amdgcn_s_barrier(); asm volatile("" ::: "memory"); __builtin_amdgcn_sched_barrier(0); }

template <int MODE> __device__ __forceinline__ int rowmap(int n) {
    if (MODE == 1) return n < 640 ? ((n & ~63) + 8 * ((n & 31) >> 2) + (n & 3) + 4 * ((n >> 5) & 1)) : n;
    if (MODE == 2) return 8 * (n >> 2) + (n & 3);
    if (MODE == 3) return 8 * (n >> 2) + 4 + (n & 3);
    return n;
}
__device__ __forceinline__ int rowmap_rt(int mode, int n) { return mode == 1 ? rowmap<1>(n) : mode == 2 ? rowmap<2>(n) : mode == 3 ? rowmap<3>(n) : n; }
__device__ __forceinline__ void tr_item(const float* W, int ldw, int K, int col0, int ncols, bf16* WT, int mode, const float* gk, int item, LAS float* scr, int lane) {
    const int nblk = ncols / 32, kb = item / nblk, nb = item % nblk, k0 = 64 * kb, n0 = 32 * nb;
    f32x4 tv[8];
#pragma unroll
    for (int i = 0; i < 8; ++i) { const int kk = 8 * i + (lane >> 3); tv[i] = *(const f32x4*)(W + (size_t)(k0 + kk) * ldw + col0 + n0 + 4 * (lane & 7)); }
#pragma unroll
    for (int i = 0; i < 8; ++i) { const int kk = 8 * i + (lane >> 3); const float gv = gk ? gk[k0 + kk] : 1.0f; LAS float* d = scr + kk * 33 + 4 * (lane & 7);
        d[0] = gv * tv[i][0]; d[1] = gv * tv[i][1]; d[2] = gv * tv[i][2]; d[3] = gv * tv[i][3]; }
    LDS_WAIT(); asm volatile("" ::: "memory");
    const int c = lane & 7;
#pragma unroll
    for (int j = 0; j < 4; ++j) { const int n = (lane >> 3) + 8 * j; const LAS float* sp = scr + (8 * c) * 33 + n;
        v4u o; o.x = pk2(sp[0 * 33], sp[1 * 33]); o.y = pk2(sp[2 * 33], sp[3 * 33]); o.z = pk2(sp[4 * 33], sp[5 * 33]); o.w = pk2(sp[6 * 33], sp[7 * 33]);
        *(v4u*)(WT + (size_t)rowmap_rt(mode, n0 + n) * K + k0 + 8 * c) = o; }
    LDS_WAIT(); asm volatile("" ::: "memory");
}
__device__ __forceinline__ void rms_row(const float* xrow, const float* gain, int lane, f32x4 (&v)[4]) {
    const f32x4* xr = (const f32x4*)xrow + lane; float s = 0.f;
#pragma unroll
    for (int j = 0; j < 4; ++j) { v[j] = xr[64 * j]; s += (v[j].x * v[j].x + v[j].y * v[j].y) + (v[j].z * v[j].z + v[j].w * v[j].w); }
    const float rs = 1.0f / sqrtf(wave_sum(s) * (1.f / 1024.f) + EPS);
    const f32x4* gr = (const f32x4*)gain + lane;
#pragma unroll
    for (int j = 0; j < 4; ++j) v[j] = v[j] * rs * gr[64 * j];
}
__device__ __forceinline__ void store_row_bf16(bf16* orow, int lane, const f32x4 (&v)[4]) {
    unsigned long long* o8 = (unsigned long long*)orow + lane;
#pragma unroll
    for (int j = 0; j < 4; ++j) o8[64 * j] = (unsigned long long)pk2(v[j].x, v[j].y) | ((unsigned long long)pk2(v[j].z, v[j].w) << 32);
}
__device__ __forceinline__ void xb_rows(const float* x, bf16* o, float* ss, int nrows, int gw, int NGW, int lane) {
    for (int r = gw; r < nrows; r += NGW) { const f32x4* xr = (const f32x4*)(x + (size_t)r * D) + lane; f32x4 v[4]; float s = 0.f;
#pragma unroll
        for (int j = 0; j < 4; ++j) { v[j] = xr[64 * j]; s += (v[j].x * v[j].x + v[j].y * v[j].y) + (v[j].z * v[j].z + v[j].w * v[j].w); }
        s = wave_sum(s); store_row_bf16(o + (size_t)r * D, lane, v); if (lane < 16) ss[(size_t)r * 16 + lane] = lane == 0 ? s : 0.f; }
}
__device__ __forceinline__ void norm_rows(const float* x, const float* gain, bf16* o, int nrows, int gw, int NGW, int lane) {
    for (int r = gw; r < nrows; r += NGW) { f32x4 v[4]; rms_row(x + (size_t)r * D, gain, lane, v); store_row_bf16(o + (size_t)r * D, lane, v); }
}

constexpr int BA_KS = 72, BA_VS = 408, BA_KROWS = 400;
constexpr int BA_K_BYTES = BA_KROWS * BA_KS * 2, BA_V_BYTES = 64 * BA_VS * 2;
static_assert(BA_K_BYTES % 16 == 0 && BA_K_BYTES + BA_V_BYTES <= PHASE_LDS, "band attention LDS");
__device__ __forceinline__ bf16x8 cat4(s16x4 a, s16x4 b) { return __builtin_shufflevector(a, b, 0, 1, 2, 3, 4, 5, 6, 7); }
__device__ __forceinline__ unsigned cvtpk(float lo, float hi) { unsigned r; asm volatile("v_cvt_pk_bf16_f32 %0, %1, %2" : "=v"(r) : "v"(lo), "v"(hi)); return r; }

__device__ __forceinline__ void band_attention_phase(LAS unsigned char* lds, const bf16* Q, const bf16* Kb, const bf16* Vb, bf16* Ao, const float* sink, int G) {
    const int tid = opq_tid(), lane = tid & 63, wave = __builtin_amdgcn_readfirstlane(tid >> 6), fr = lane & 15, fq = lane >> 4;
    LAS bf16* Ks = (LAS bf16*)lds; LAS bf16* VTs = (LAS bf16*)(lds + BA_K_BYTES);
    for (int unit = blockIdx.x; unit < NB * 32 * NKV; unit += G) {
        const int kh = unit & 1, ib = (unit >> 1) & 31, b = unit >> 6;
        const int kbase = 128 * (ib - 1);
        for (int c = tid; c < BA_KROWS * 8; c += NTHR) { const int row = c >> 3, c8 = c & 7, kpos = kbase + row;
            v4u val = (v4u){0u, 0u, 0u, 0u};
            if (row < 384 && kpos >= 0 && kpos < SEQ) val = *(const v4u*)(Kb + ((size_t)(b * SEQ + kpos)) * KVW + kh * 64 + c8 * 8);
            *(LAS v4u*)(Ks + row * BA_KS + c8 * 8) = val; }
        for (int c = tid; c < BA_KROWS * 8; c += NTHR) { const int c8 = c / BA_KROWS, key = c % BA_KROWS, kpos = kbase + key;
            v4u val = (v4u){0u, 0u, 0u, 0u};
            if (key < 384 && kpos >= 0 && kpos < SEQ) val = *(const v4u*)(Vb + ((size_t)(b * SEQ + kpos)) * KVW + kh * 64 + c8 * 8);
            LAS bf16* dst = VTs + (c8 * 8) * BA_VS + key;
            dst[0 * BA_VS] = (bf16)(val.x & 0xffffu); dst[1 * BA_VS] = (bf16)(val.x >> 16); dst[2 * BA_VS] = (bf16)(val.y & 0xffffu); dst[3 * BA_VS] = (bf16)(val.y >> 16);
            dst[4 * BA_VS] = (bf16)(val.z & 0xffffu); dst[5 * BA_VS] = (bf16)(val.z >> 16); dst[6 * BA_VS] = (bf16)(val.w & 0xffffu); dst[7 * BA_VS] = (bf16)(val.w >> 16); }
        wg_sync();
        const int g = wave >> 1, half = wave & 1, head = kh * 4 + g;
        const float snk = sink[head];
        bf16x8 qn[2];
        { const size_t t0 = (size_t)b * SEQ + 128 * ib + 64 * half;
#pragma unroll
          for (int ks = 0; ks < 2; ++ks) qn[ks] = *(const bf16x8*)(Q + (t0 + fr) * AW + head * 64 + 32 * ks + 8 * fq); }
#pragma unroll 1
        for (int qt = 0; qt < 4; ++qt) {
            const int p0 = 64 * half + 16 * qt;
            const size_t t0 = (size_t)b * SEQ + 128 * ib + p0;
            bf16x8 qf[2]; qf[0] = qn[0]; qf[1] = qn[1];
            if (qt < 3) {
#pragma unroll
                for (int ks = 0; ks < 2; ++ks) qn[ks] = *(const bf16x8*)(Q + (t0 + 16 + fr) * AW + head * 64 + 32 * ks + 8 * fq); }
            f32x4 s[18];
            const LAS bf16* kbase_p = Ks + (p0 + fr) * BA_KS + 8 * fq;
            bf16x8 kfa[3][2], kfb[3][2];
#pragma unroll
            for (int jj = 0; jj < 3; ++jj)
#pragma unroll
                for (int ks = 0; ks < 2; ++ks) kfa[jj][ks] = *(const LAS bf16x8*)(kbase_p + (16 * jj) * BA_KS + 32 * ks);
#pragma unroll
            for (int gq = 0; gq < 6; ++gq) {
                if (gq < 5) {
#pragma unroll
                    for (int jj = 0; jj < 3; ++jj)
#pragma unroll
                        for (int ks = 0; ks < 2; ++ks) { const bf16x8 t = *(const LAS bf16x8*)(kbase_p + (16 * (3 * (gq + 1) + jj)) * BA_KS + 32 * ks); if (gq & 1) kfa[jj][ks] = t; else kfb[jj][ks] = t; } }
                __builtin_amdgcn_sched_barrier(0);
#pragma unroll
                for (int jj = 0; jj < 3; ++jj) { const int j = 3 * gq + jj; s[j] = (f32x4){0.f, 0.f, 0.f, 0.f};
#pragma unroll
                    for (int ks = 0; ks < 2; ++ks) s[j] = __builtin_amdgcn_mfma_f32_16x16x32_bf16((gq & 1) ? kfb[jj][ks] : kfa[jj][ks], qf[ks], s[j], 0, 0, 0); }
                __builtin_amdgcn_sched_barrier(0);
            }
            float mx = -1e30f;
#pragma unroll
            for (int j = 0; j < 18; ++j)
#pragma unroll
                for (int r = 0; r < 4; ++r) { const int rel = 16 * j + 4 * fq + r - fr, idx = p0 + 16 * j + 4 * fq + r;
                    const bool ok = rel >= 0 && rel <= 256 && (ib > 0 || idx >= 128) && (ib < 31 || idx < 256);
                    const float v = ok ? s[j][r] * 0.125f : -1e30f; s[j][r] = v; mx = fmaxf(mx, v); }
            mx = fmaxf(mx, __shfl_xor(mx, 16)); mx = fmaxf(mx, __shfl_xor(mx, 32)); mx = fmaxf(mx, snk);
            float l = 0.f;
#pragma unroll
            for (int j = 0; j < 18; ++j)
#pragma unroll
                for (int r = 0; r < 4; ++r) { const float p = __expf(s[j][r] - mx); s[j][r] = p; l += p; }
            l += __shfl_xor(l, 16); l += __shfl_xor(l, 32); l += __expf(snk - mx);
            const float inv = 1.0f / l;
            f32x4 o[4];
#pragma unroll
            for (int dt = 0; dt < 4; ++dt) o[dt] = (f32x4){0.f, 0.f, 0.f, 0.f};
            const LAS bf16* vbase_p = VTs + fr * BA_VS + p0 + 4 * fq;
            s16x4 va[4][2], vb[4][2];
#pragma unroll
            for (int dt = 0; dt < 4; ++dt) { va[dt][0] = *(const LAS s16x4*)(vbase_p + (16 * dt) * BA_VS); va[dt][1] = *(const LAS s16x4*)(vbase_p + (16 * dt) * BA_VS + 16); }
#pragma unroll
            for (int kk = 0; kk < 9; ++kk) {
                if (kk < 8) {
#pragma unroll
                    for (int dt = 0; dt < 4; ++dt) { const s16x4 t0_ = *(const LAS s16x4*)(vbase_p + (16 * dt) * BA_VS + 32 * (kk + 1)), t1_ = *(const LAS s16x4*)(vbase_p + (16 * dt) * BA_VS + 32 * (kk + 1) + 16);
                        if (kk & 1) { va[dt][0] = t0_; va[dt][1] = t1_; } else { vb[dt][0] = t0_; vb[dt][1] = t1_; } } }
                v4u pw; pw.x = cvtpk(s[2 * kk][0], s[2 * kk][1]); pw.y = cvtpk(s[2 * kk][2], s[2 * kk][3]); pw.z = cvtpk(s[2 * kk + 1][0], s[2 * kk + 1][1]); pw.w = cvtpk(s[2 * kk + 1][2], s[2 * kk + 1][3]);
                const bf16x8 pf = __builtin_bit_cast(bf16x8, pw);
                __builtin_amdgcn_sched_barrier(0);
#pragma unroll
                for (int dt = 0; dt < 4; ++dt) { const bf16x8 vf = (kk & 1) ? cat4(vb[dt][0], vb[dt][1]) : cat4(va[dt][0], va[dt][1]);
                    o[dt] = __builtin_amdgcn_mfma_f32_16x16x32_bf16(vf, pf, o[dt], 0, 0, 0); }
                __builtin_amdgcn_sched_barrier(0);
            }
#pragma unroll
            for (int dt = 0; dt < 4; ++dt) { const f32x4 ov = o[dt] * inv; v2u w; w.x = cvtpk(ov[0], ov[1]); w.y = cvtpk(ov[2], ov[3]);
                *(v2u*)(Ao + (t0 + fr) * AW + head * 64 + 16 * dt + 4 * fq) = w; }
        }
        wg_sync();
    }
}

constexpr int XA_KS = 136, XA_VS = 264;
constexpr int XA_K_BYTES = MEML * XA_KS * 2, XA_V_BYTES = XHD * XA_VS * 2;
static_assert(XA_K_BYTES % 16 == 0 && XA_K_BYTES + XA_V_BYTES <= PHASE_LDS, "cross attention LDS");
__device__ __forceinline__ void cross_attention_phase(LAS unsigned char* lds, const bf16* Qx, const bf16* Kmem, const bf16* VmemT, bf16* Ox, int layer, int G) {
    const int tid = opq_tid(), lane = tid & 63, wave = __builtin_amdgcn_readfirstlane(tid >> 6), fr = lane & 15, fq = lane >> 4;
    LAS bf16* Ks = (LAS bf16*)lds; LAS bf16* VTs = (LAS bf16*)(lds + XA_K_BYTES);
    for (int unit = blockIdx.x; unit < 256; unit += G) {
        const int quarter = unit & 3, head = (unit >> 2) & 3, b = unit >> 4;
        for (int c = tid; c < MEML * 16; c += NTHR) { const int key = c >> 4, c8 = c & 15;
            *(LAS v4u*)(Ks + key * XA_KS + c8 * 8) = *(const v4u*)(Kmem + (size_t)(b * MEML + key) * 1024 + layer * 512 + head * 128 + c8 * 8); }
        for (int c = tid; c < XHD * 32; c += NTHR) { const int d = c >> 5, c8 = c & 31;
            *(LAS v4u*)(VTs + d * XA_VS + c8 * 8) = *(const v4u*)(VmemT + (size_t)(layer * 512 + head * 128 + d) * MROWS + b * MEML + c8 * 8); }
        wg_sync();
        bf16x8 qn[4];
        { const size_t t0 = (size_t)b * SEQ + (quarter * 4) * 256 + wave * 32;
#pragma unroll
          for (int ks = 0; ks < 4; ++ks) qn[ks] = *(const bf16x8*)(Qx + (t0 + fr) * XW + head * 128 + 32 * ks + 8 * fq); }
#pragma unroll 1
        for (int qi = 0; qi < 8; ++qi) {
            const size_t t0 = (size_t)b * SEQ + (quarter * 4 + (qi >> 1)) * 256 + wave * 32 + 16 * (qi & 1);
            bf16x8 qf[4];
#pragma unroll
            for (int ks = 0; ks < 4; ++ks) qf[ks] = qn[ks];
            if (qi < 7) { const size_t t1 = (size_t)b * SEQ + (quarter * 4 + ((qi + 1) >> 1)) * 256 + wave * 32 + 16 * ((qi + 1) & 1);
#pragma unroll
                for (int ks = 0; ks < 4; ++ks) qn[ks] = *(const bf16x8*)(Qx + (t1 + fr) * XW + head * 128 + 32 * ks + 8 * fq); }
            f32x4 s[16];
            const LAS bf16* kbase_p = Ks + fr * XA_KS + 8 * fq;
            bf16x8 kfa[2][4], kfb[2][4];
#pragma unroll
            for (int jj = 0; jj < 2; ++jj)
#pragma unroll
                for (int ks = 0; ks < 4; ++ks) kfa[jj][ks] = *(const LAS bf16x8*)(kbase_p + (16 * jj) * XA_KS + 32 * ks);
#pragma unroll
            for (int gq = 0; gq < 8; ++gq) {
                if (gq < 7) {
#pragma unroll
                    for (int jj = 0; jj < 2; ++jj)
#pragma unroll
                        for (int ks = 0; ks < 4; ++ks) { const bf16x8 t = *(const LAS bf16x8*)(kbase_p + (16 * (2 * (gq + 1) + jj)) * XA_KS + 32 * ks); if (gq & 1) kfa[jj][ks] = t; else kfb[jj][ks] = t; } }
                __builtin_amdgcn_sched_barrier(0);
#pragma unroll
                for (int jj = 0; jj < 2; ++jj) { const int j = 2 * gq + jj; s[j] = (f32x4){0.f, 0.f, 0.f, 0.f};
#pragma unroll
                    for (int ks = 0; ks < 4; ++ks) s[j] = __builtin_amdgcn_mfma_f32_16x16x32_bf16((gq & 1) ? kfb[jj][ks] : kfa[jj][ks], qf[ks], s[j], 0, 0, 0); }
                __builtin_amdgcn_sched_barrier(0);
            }
            float mx = -1e30f;
#pragma unroll
            for (int j = 0; j < 16; ++j)
#pragma unroll
                for (int r = 0; r < 4; ++r) { const float v = s[j][r] * 0.08838834764831845f; s[j][r] = v; mx = fmaxf(mx, v); }
            mx = fmaxf(mx, __shfl_xor(mx, 16)); mx = fmaxf(mx, __shfl_xor(mx, 32));
            float l = 0.f;
#pragma unroll
            for (int j = 0; j < 16; ++j)
#pragma unroll
                for (int r = 0; r < 4; ++r) { const float p = __expf(s[j][r] - mx); s[j][r] = p; l += p; }
            l += __shfl_xor(l, 16); l += __shfl_xor(l, 32);
            const float inv = 1.0f / l;
            f32x4 o[8];
#pragma unroll
            for (int dt = 0; dt < 8; ++dt) o[dt] = (f32x4){0.f, 0.f, 0.f, 0.f};
            const LAS bf16* vbase_p = VTs + fr * XA_VS + 4 * fq;
            s16x4 va[8][2], vb[8][2];
#pragma unroll
            for (int dt = 0; dt < 8; ++dt) { va[dt][0] = *(const LAS s16x4*)(vbase_p + (16 * dt) * XA_VS); va[dt][1] = *(const LAS s16x4*)(vbase_p + (16 * dt) * XA_VS + 16); }
#pragma unroll
            for (int kk = 0; kk < 8; ++kk) {
                if (kk < 7) {
#pragma unroll
                    for (int dt = 0; dt < 8; ++dt) { const s16x4 t0_ = *(const LAS s16x4*)(vbase_p + (16 * dt) * XA_VS + 32 * (kk + 1)), t1_ = *(const LAS s16x4*)(vbase_p + (16 * dt) * XA_VS + 32 * (kk + 1) + 16);
                        if (kk & 1) { va[dt][0] = t0_; va[dt][1] = t1_; } else { vb[dt][0] = t0_; vb[dt][1] = t1_; } } }
                v4u pw; pw.x = cvtpk(s[2 * kk][0], s[2 * kk][1]); pw.y = cvtpk(s[2 * kk][2], s[2 * kk][3]); pw.z = cvtpk(s[2 * kk + 1][0], s[2 * kk + 1][1]); pw.w = cvtpk(s[2 * kk + 1][2], s[2 * kk + 1][3]);
                const bf16x8 pf = __builtin_bit_cast(bf16x8, pw);
                __builtin_amdgcn_sched_barrier(0);
#pragma unroll
                for (int dt = 0; dt < 8; ++dt) { const bf16x8 vf = (kk & 1) ? cat4(vb[dt][0], vb[dt][1]) : cat4(va[dt][0], va[dt][1]);
                    o[dt] = __builtin_amdgcn_mfma_f32_16x16x32_bf16(vf, pf, o[dt], 0, 0, 0); }
                __builtin_amdgcn_sched_barrier(0);
            }
#pragma unroll
            for (int dt = 0; dt < 8; ++dt) { const f32x4 ov = o[dt] * inv; v2u w; w.x = cvtpk(ov[0], ov[1]); w.y = cvtpk(ov[2], ov[3]);
                *(v2u*)(Ox + (t0 + fr) * XW + head * 128 + 16 * dt + 4 * fq) = w; }
        }
        wg_sync();
    }
}
constexpr float HY_MIN_DECAY = -3.0701134573253944f;
constexpr float HY_MAX_DECAY = -15.350567286626972f;
__device__ __forceinline__ void h2_rows(const Args& a, float* H2, int gw, int NGW, int lane) {
    for (int idx = gw; idx < 2 * SEQ; idx += NGW) {
        const int l = idx >> 12, j = idx & 4095;
        const float* w1 = a.in[I_FW1] + l * 33 * 64; const float* b1 = a.in[I_FB1] + l * 64; const float* fr1 = a.in[I_FFR1] + l * 64;
        const float* w2 = a.in[I_FW2] + l * 64 * 64; const float* b2 = a.in[I_FB2] + l * 64; const float* fr2 = a.in[I_FFR2] + l * 64;
        const float w = 6.283185307179586f * (float)j / 4096.0f;
        const int mm = (lane - 1) & 15; const float f = 1e-4f + (float)mm * ((15.0f - 1e-4f) / 15.0f); const float ang = f * w;
        float zq = lane == 0 ? (float)j / 4095.0f : (lane <= 16 ? cosf(ang) : -sinf(ang));
        float acc = b1[lane];
#pragma unroll
        for (int q = 0; q < 33; ++q) acc += __shfl(zq, q) * w1[q * 64 + lane];
        const float h1 = sinf(fr1[lane] * acc);
        acc = b2[lane];
#pragma unroll
        for (int q = 0; q < 64; ++q) acc += __shfl(h1, q) * w2[q * 64 + lane];
        H2[(size_t)idx * 64 + lane] = sinf(fr2[lane] * acc);
    }
}
__device__ __forceinline__ void kfilt_phase(LAS unsigned char* lds, const float* H2, const float* w3all, float* KF, int G) {
    LAS float* ws = (LAS float*)lds;
    const int tid = opq_tid(), jj = tid & 63, cg = __builtin_amdgcn_readfirstlane(tid >> 6);
    for (int unit = blockIdx.x; unit < 2 * 64 * 32; unit += G) {
        const int cb = unit & 31, jb = (unit >> 5) & 63, l = unit >> 11;
        const float* w3 = w3all + (size_t)l * 64 * 2048;
        for (int e = tid; e < 4096; e += NTHR) ws[e] = w3[(size_t)(e >> 6) * 2048 + cb * 64 + (e & 63)];
        wg_sync();
        const int j = jb * 64 + jj;
        const f32x4* hr = (const f32x4*)(H2 + ((size_t)l * SEQ + j) * 64);
        float acc[8];
#pragma unroll
        for (int e = 0; e < 8; ++e) acc[e] = 0.f;
#pragma unroll
        for (int q = 0; q < 16; ++q) { const f32x4 hv = hr[q];
#pragma unroll
            for (int i = 0; i < 4; ++i) { const LAS f32x4* wp = (const LAS f32x4*)(ws + (4 * q + i) * 64 + cg * 8); const f32x4 wa = wp[0], wb = wp[1];
                acc[0] += hv[i] * wa[0]; acc[1] += hv[i] * wa[1]; acc[2] += hv[i] * wa[2]; acc[3] += hv[i] * wa[3];
                acc[4] += hv[i] * wb[0]; acc[5] += hv[i] * wb[1]; acc[6] += hv[i] * wb[2]; acc[7] += hv[i] * wb[3]; } }
        const float tj = (float)j / 4095.0f;
#pragma unroll
        for (int e = 0; e < 8; ++e) { const int col = cb * 64 + cg * 8 + e, dir = col >> 10, oc = col & 1023;
            const float delta = HY_MIN_DECAY + (float)oc * ((HY_MAX_DECAY - HY_MIN_DECAY) / 1023.0f);
            float val = acc[e] * expf(-tj * fabsf(delta));
            int n = dir == 0 ? j : 8192 - j;
            if (dir == 1 && j == 0) { n = 4096; val = 0.f; }
            KF[((size_t)(l * 1024 + oc)) * 8192 + n] = val; }
        wg_sync();
    }
}

constexpr int HY_RAWS = 4112;
constexpr int HY_RAW_OFF = FFT_WORK * 8;
static_assert(HY_RAW_OFF % 16 == 0 && HY_RAW_OFF + 6 * HY_RAWS * 2 <= PHASE_LDS && 4096 * 8 <= 4 * HY_RAWS * 2, "hyena LDS: work buffer | v rows (2) | x1 rows (2) | x2 rows (2); the gated signal (4096 complex f32) overlays the v and x1 rows");
typedef float f32x2v __attribute__((ext_vector_type(2)));
struct LdsCf { LAS f32x2v* p; __device__ __forceinline__ cf ld(int i) const { const f32x2v t = p[i]; return mk(t.x, t.y); } __device__ __forceinline__ void st(int i, cf v) const { p[i] = (f32x2v){v.x, v.y}; } };

__device__ __forceinline__ void hy_stage_rows(LAS bf16* raw, const bf16* UT, int b0, int ch, int tid) {
#pragma unroll
    for (int i = 0; i < 2; ++i) { const int q = tid + NTHR * i, row = q >> 9, cc = q & 511;
        *(LAS v4u*)(raw + row * HY_RAWS + 8 + cc * 8) = *(const v4u*)(UT + (((size_t)((b0 + row) * C3 + ch)) << 12) + cc * 8); }
    if (tid < 2) { raw[tid * HY_RAWS + 7] = 0; raw[tid * HY_RAWS + 8 + 4096] = 0; }
}
__device__ __forceinline__ float hy_conv(const LAS bf16* ldsh, int e, float w0, float w1, float w2, float bias) {
    return w0 * bf1(ldsh[e - 1]) + w1 * bf1(ldsh[e]) + w2 * bf1(ldsh[e + 1]) + bias;
}
__device__ __forceinline__ int opqi(int v) { asm volatile("" : "+v"(v)); return v; }
template <class T> __device__ __forceinline__ T* opqp(T* p) { asm volatile("" : "+v"(p)); return p; }
__device__ __forceinline__ cf opq(cf w) { asm volatile("" : "+v"(w.x), "+v"(w.y)); return w; }
__device__ __forceinline__ cf csel(bool c, cf a, cf b) { return mk(c ? a.x : b.x, c ? a.y : b.y); }
__device__ __forceinline__ float uni(float v) { return __builtin_bit_cast(float, __builtin_amdgcn_readfirstlane(__builtin_bit_cast(int, v))); }
__device__ __forceinline__ void wave_lds_fence() { __builtin_amdgcn_sched_barrier(0); asm volatile("s_waitcnt lgkmcnt(0)" ::: "memory"); __builtin_amdgcn_sched_barrier(0); }
__device__ __forceinline__ cf shfl_cf(cf v) { return mk(__shfl_xor(v.x, 32), __shfl_xor(v.y, 32)); }

__device__ __forceinline__ void kspec_phase(LAS unsigned char* lds, const float* KF, float* KSP, int G) {
    const int tid = opq_tid();
    LdsCf W; W.p = (LAS f32x2v*)lds;
    int h1, j1, h2, k1, j2, h3, blk; geo1(tid, h1, j1); geo2(tid, h2, k1, j2); geo3(tid, h3, blk);
    const int fb1 = opqi(fbase1(h1, j1)), fb2 = opqi(fbase2(h2, k1, j2)), fb3 = opqi(fbase3(h3, blk)), jo = opqi(j1);
    float sv, cv;
    sincospif(-(float)j1 / 4096.0f, &sv, &cv); const cf w8192j = mk(cv, sv);
    sincospif(-(float)j1 / 2048.0f, &sv, &cv); const cf w4096j = mk(cv, sv);
    sincospif(-(float)j2 / 128.0f, &sv, &cv);  const cf w256j = mk(cv, sv);
    const cf w32 = mk(0.98078528040323043f, -0.19509032201612825f);
#pragma unroll 1
    for (int unit = blockIdx.x; unit < 2 * 2 * HYW; unit += G) {
        const float* kf = KF + (size_t)unit * 8192;
        cf x[16]; cf wp = opq(w8192j);
#pragma unroll
        for (int m = 0; m < 16; ++m) { const float* kp = kf + opqi(jo + 1024 * (m >> 2)); const float ka = kp[256 * (m & 3)]; const float* kq = kp + opqi(4096); const float kb = kq[256 * (m & 3)];
            x[m] = csel(h1 == 0, mk(ka + kb, 0.f), cscale(wp, ka - kb)); wp = cmul(wp, w32); }
        fwd_pass1(W, fb1, opq(w4096j), x); wg_sync();
        fwd_pass2(W, fb2, opq(w256j)); wave_lds_fence();
        { cf kk[16]; fwd_pass3_keep(W, fb3, kk); f32x4* kd = opqp((f32x4*)(KSP + (size_t)unit * 16384 + tid * 32));
#pragma unroll
          for (int q = 0; q < 8; ++q) kd[q] = (f32x4){kk[2 * q].x, kk[2 * q].y, kk[2 * q + 1].x, kk[2 * q + 1].y}; }
        wg_sync();
    }
}
__device__ __forceinline__ void mid_pass3g(LdsCf lds, int b3, const f32x4* Kp) {
    f32x4 kv[8];
#pragma unroll
    for (int q = 0; q < 8; ++q) kv[q] = Kp[q];
    cf x[16];
#pragma unroll
    for (int m = 0; m < 16; ++m) x[m] = lds.ld(b3 + m);
    dft16<false>(x);
#pragma unroll
    for (int q = 0; q < 8; ++q) { x[2 * q] = cmul(x[2 * q], mk(kv[q][0], kv[q][1])); x[2 * q + 1] = cmul(x[2 * q + 1], mk(kv[q][2], kv[q][3])); }
    dft16<true>(x);
#pragma unroll
    for (int m = 0; m < 16; ++m) lds.st(b3 + m, x[m]);
}
__device__ __forceinline__ void hyena_phase(LAS unsigned char* lds, const Args& a, int layer, const bf16* UT, const float* KSP, bf16* YT, int G) {
    const int tid = opq_tid();
    LdsCf W; W.p = (LAS f32x2v*)lds;
    LAS bf16* raw = (LAS bf16*)(lds + HY_RAW_OFF);
    int h1, j1, h2, k1, j2, h3, blk; geo1(tid, h1, j1); geo2(tid, h2, k1, j2); geo3(tid, h3, blk);
    const int fb1 = opqi(fbase1(h1, j1)), fb2 = opqi(fbase2(h2, k1, j2)), fb3 = opqi(fbase3(h3, blk));
    const int jo = opqi(j1), jh = opqi(j1 + 2048 * h1);
    LdsCf ZB; ZB.p = (LAS f32x2v*)lds; const int zo = opqi(HY_RAW_OFF / 8 + j1), zh = opqi(HY_RAW_OFF / 8 + j1 + 2048 * h1);
    const LAS bf16* ldsh = (const LAS bf16*)lds; const int ro = opqi(HY_RAW_OFF / 2 + 8 + j1), rh = opqi(HY_RAW_OFF / 2 + 8 + j1 + 2048 * h1);
    float sv, cv;
    sincospif(-(float)j1 / 4096.0f, &sv, &cv); const cf w8192j = mk(cv, sv);
    sincospif(-(float)j1 / 2048.0f, &sv, &cv); const cf w4096j = mk(cv, sv);
    sincospif(-(float)j2 / 128.0f, &sv, &cv);  const cf w256j = mk(cv, sv);
    const cf w32 = mk(0.98078528040323043f, -0.19509032201612825f);
    const float* cw = a.in[I_CONVW] + layer * 3 * C3; const float* cbv = a.in[I_CONVB] + layer * C3; const float* skp = a.in[I_SKIP] + layer * 2 * HYW;
    for (int c = blockIdx.x; c < HYW; c += G) {
        const float x1w0 = uni(cw[c]), x1w1 = uni(cw[C3 + c]), x1w2 = uni(cw[2 * C3 + c]), x1b = uni(cbv[c]);
        const float x2w0 = uni(cw[512 + c]), x2w1 = uni(cw[C3 + 512 + c]), x2w2 = uni(cw[2 * C3 + 512 + c]), x2b = uni(cbv[512 + c]);
        const float vw0 = uni(cw[1024 + c]), vw1 = uni(cw[C3 + 1024 + c]), vw2 = uni(cw[2 * C3 + 1024 + c]), vb = uni(cbv[1024 + c]);
        const float skip0 = uni(skp[c]), skip1 = uni(skp[HYW + c]);
        const float* KS0 = KSP + ((size_t)((layer * 2 + 0) * HYW + c)) * 16384 + tid * 32;
        const float* KS1 = KSP + ((size_t)((layer * 2 + 1) * HYW + c)) * 16384 + tid * 32;
#pragma unroll 1
        for (int pr = 0; pr < 8; ++pr) {
            const int b0 = 2 * pr;
            hy_stage_rows(raw, UT, b0, 1024 + c, tid);
            hy_stage_rows(raw + 2 * HY_RAWS, UT, b0, c, tid);
            hy_stage_rows(raw + 4 * HY_RAWS, UT, b0, 512 + c, tid);
            wg_sync();
            cf x[16];
            { cf wp = opq(w8192j);
#pragma unroll
              for (int m = 0; m < 16; ++m) {
                  const cf z = mk(hy_conv(ldsh, ro + 256 * m, vw0, vw1, vw2, vb), hy_conv(ldsh, ro + 256 * m + HY_RAWS, vw0, vw1, vw2, vb));
                  x[m] = csel(h1 == 0, z, cmul(z, wp)); wp = cmul(wp, w32); } }
            fwd_pass1(W, fb1, opq(w4096j), x); wg_sync();
            fwd_pass2(W, fb2, opq(w256j)); wave_lds_fence();
            mid_pass3g(W, fb3, opqp((const f32x4*)KS0)); wave_lds_fence();
            inv_pass2(W, fb2, opq(w256j)); wg_sync();
            inv_pass1(W, fb1, opq(w4096j), x);
            cf zz[8];
            { cf wp = opq(w8192j);
#pragma unroll
              for (int m = 0; m < 16; ++m) { x[m] = csel(h1 == 1, cmulc(x[m], wp), x[m]); wp = cmul(wp, w32); }
#pragma unroll
              for (int i = 0; i < 8; ++i) { const cf xa_ = x[i], xb_ = x[8 + i]; const cf mine = csel(h1 == 1, xb_, xa_), send = csel(h1 == 1, xa_, xb_); const cf r = cscale(cadd(mine, shfl_cf(send)), 1.0f / 8192.0f);
                  const float va = hy_conv(ldsh, rh + 256 * i, vw0, vw1, vw2, vb), vbb = hy_conv(ldsh, rh + 256 * i + HY_RAWS, vw0, vw1, vw2, vb);
                  const float xa = hy_conv(ldsh, rh + 256 * i + 2 * HY_RAWS, x1w0, x1w1, x1w2, x1b), xb = hy_conv(ldsh, rh + 256 * i + 3 * HY_RAWS, x1w0, x1w1, x1w2, x1b);
                  zz[i] = mk(xa * (r.x + skip0 * va), xb * (r.y + skip0 * vbb)); } }
            wg_sync();
#pragma unroll
            for (int i = 0; i < 8; ++i) ZB.st(zh + 256 * i, zz[i]);
            wg_sync();
            { cf wp = opq(w8192j);
#pragma unroll
              for (int m = 0; m < 16; ++m) { const cf full = ZB.ld(zo + 256 * m); x[m] = csel(h1 == 0, full, cmul(full, wp)); wp = cmul(wp, w32); } }
            fwd_pass1(W, fb1, opq(w4096j), x); wg_sync();
            fwd_pass2(W, fb2, opq(w256j)); wave_lds_fence();
            mid_pass3g(W, fb3, opqp((const f32x4*)KS1)); wave_lds_fence();
            inv_pass2(W, fb2, opq(w256j)); wg_sync();
            inv_pass1(W, fb1, opq(w4096j), x);
            { cf wp = opq(w8192j);
#pragma unroll
              for (int m = 0; m < 16; ++m) { x[m] = csel(h1 == 1, cmulc(x[m], wp), x[m]); wp = cmul(wp, w32); }
#pragma unroll
              for (int i = 0; i < 8; ++i) { const cf xa_ = x[i], xb_ = x[8 + i]; const cf mine = csel(h1 == 1, xb_, xa_), send = csel(h1 == 1, xa_, xb_); const cf r = cscale(cadd(mine, shfl_cf(send)), 1.0f / 8192.0f);
                  const int p = jh + 256 * i; const cf zv = ZB.ld(zh + 256 * i);
                  const float xa = hy_conv(ldsh, rh + 256 * i + 4 * HY_RAWS, x2w0, x2w1, x2w2, x2b), xb = hy_conv(ldsh, rh + 256 * i + 5 * HY_RAWS, x2w0, x2w1, x2w2, x2b);
                  const float ya = xa * (r.x + skip1 * zv.x), yb = xb * (r.y + skip1 * zv.y);
                  YT[(((size_t)(b0 * HYW + c)) << 12) + p] = (bf16)f2bf(ya);
                  YT[(((size_t)((b0 + 1) * HYW + c)) << 12) + p] = (bf16)f2bf(yb); } }
            wg_sync();
        }
    }
}
constexpr int MN_STRIDE = 66;
static_assert(HYW * MN_STRIDE * 2 <= PHASE_LDS, "mix-norm LDS");
__device__ __forceinline__ void mixnorm_phase(LAS unsigned char* lds, const bf16* Ab, const bf16* YT, const float* ga, const float* gy, bf16* mixed, int G) {
    const int tid = opq_tid(), lane = tid & 63, wave = __builtin_amdgcn_readfirstlane(tid >> 6);
    LAS unsigned* tile32 = (LAS unsigned*)lds; const LAS bf16* tile16 = (const LAS bf16*)lds;
    f32x4 gav[2], gyv[2];
    gav[0] = *(const f32x4*)(ga + lane * 8); gav[1] = *(const f32x4*)(ga + lane * 8 + 4); gyv[0] = *(const f32x4*)(gy + lane * 8); gyv[1] = *(const f32x4*)(gy + lane * 8 + 4);
    v4u R[8];
    int unit = blockIdx.x;
    if (unit < M / 64) { const bf16* src = YT + (((size_t)((unit >> 6) * HYW + tid)) << 12) + (unit & 63) * 64;
#pragma unroll
        for (int q = 0; q < 8; ++q) R[q] = *(const v4u*)(src + 8 * q); }
#pragma unroll 1
    for (; unit < M / 64; unit += G) {
        const int b = unit >> 6, t0 = (unit & 63) * 64;
#pragma unroll
        for (int q = 0; q < 8; ++q) { LAS unsigned* d = tile32 + tid * (MN_STRIDE / 2) + 4 * q; d[0] = R[q].x; d[1] = R[q].y; d[2] = R[q].z; d[3] = R[q].w; }
        wg_sync();
        const int nu = unit + G;
        if (nu < M / 64) { const bf16* src = YT + (((size_t)((nu >> 6) * HYW + tid)) << 12) + (nu & 63) * 64;
#pragma unroll
            for (int q = 0; q < 8; ++q) R[q] = *(const v4u*)(src + 8 * q); }
        const size_t row0 = (size_t)b * SEQ + t0 + wave * 8;
        v4u av[8];
#pragma unroll
        for (int i = 0; i < 8; ++i) av[i] = *(const v4u*)(Ab + (row0 + i) * AW + lane * 8);
#pragma unroll
        for (int i = 0; i < 8; ++i) { const int tt = wave * 8 + i;
            float y[8]; float ss = 0.f;
#pragma unroll
            for (int e = 0; e < 8; ++e) { y[e] = bf1(tile16[(lane * 8 + e) * MN_STRIDE + tt]); ss += y[e] * y[e]; }
            const float rs = __builtin_amdgcn_rsqf(wave_sum(ss) * (1.f / 512.f) + EPS);
            v4u o; o.x = pk2(y[0] * rs * gyv[0][0], y[1] * rs * gyv[0][1]); o.y = pk2(y[2] * rs * gyv[0][2], y[3] * rs * gyv[0][3]);
            o.z = pk2(y[4] * rs * gyv[1][0], y[5] * rs * gyv[1][1]); o.w = pk2(y[6] * rs * gyv[1][2], y[7] * rs * gyv[1][3]);
            *(v4u*)(mixed + (row0 + i) * D + 512 + lane * 8) = o; }
#pragma unroll
        for (int i = 0; i < 8; ++i) {
            const float x[8] = {bflo(av[i].x), bfhi(av[i].x), bflo(av[i].y), bfhi(av[i].y), bflo(av[i].z), bfhi(av[i].z), bflo(av[i].w), bfhi(av[i].w)};
            float ss = 0.f;
#pragma unroll
            for (int e = 0; e < 8; ++e) ss += x[e] * x[e];
            const float rs = __builtin_amdgcn_rsqf(wave_sum(ss) * (1.f / 512.f) + EPS);
            v4u o; o.x = pk2(x[0] * rs * gav[0][0], x[1] * rs * gav[0][1]); o.y = pk2(x[2] * rs * gav[0][2], x[3] * rs * gav[0][3]);
            o.z = pk2(x[4] * rs * gav[1][0], x[5] * rs * gav[1][1]); o.w = pk2(x[6] * rs * gav[1][2], x[7] * rs * gav[1][3]);
            *(v4u*)(mixed + (row0 + i) * D + lane * 8) = o; }
        wg_sync();
    }
}

__device__ __forceinline__ void moe_norm_router_phase(LAS unsigned char* lds, const bf16* xb, const float* gain, const float* wr, float* rsrow, int* toke, float* tokw, int* wgcnt, int G) {
    const int tid = opq_tid(), lane = tid & 63, wave = __builtin_amdgcn_readfirstlane(tid >> 6);
    LAS int* cnt = (LAS int*)lds;
    if (tid < 8) cnt[tid] = 0;
    wg_sync();
    const int TPW = M / G;
    f32x4 wra[4][4], wrb[4][4];
#pragma unroll
    for (int j = 0; j < 4; ++j) { const f32x4 gv = *(const f32x4*)(gain + 4 * lane + 256 * j);
#pragma unroll
        for (int q = 0; q < 4; ++q) { const int k = 4 * lane + q + 256 * j; wra[j][q] = *(const f32x4*)(wr + k * 8) * gv[q]; wrb[j][q] = *(const f32x4*)(wr + k * 8 + 4) * gv[q]; } }
#pragma unroll 1
    for (int i = wave; i < TPW; i += NWAVES) {
        const int t = blockIdx.x * TPW + i;
        const v2u* xr = (const v2u*)(xb + (size_t)t * D) + lane;
        f32x4 v[4]; float s = 0.f;
#pragma unroll
        for (int j = 0; j < 4; ++j) { const v2u a = xr[64 * j]; v[j] = (f32x4){bflo(a.x), bfhi(a.x), bflo(a.y), bfhi(a.y)}; s += (v[j].x * v[j].x + v[j].y * v[j].y) + (v[j].z * v[j].z + v[j].w * v[j].w); }
        const float rs = 1.0f / sqrtf(wave_sum(s) * (1.f / 1024.f) + EPS);
        float lg[8];
#pragma unroll
        for (int e = 0; e < 8; ++e) lg[e] = 0.f;
#pragma unroll
        for (int j = 0; j < 4; ++j)
#pragma unroll
            for (int q = 0; q < 4; ++q) { const f32x4 wa = wra[j][q], wb = wrb[j][q]; const float hv = v[j][q];
                lg[0] += hv * wa[0]; lg[1] += hv * wa[1]; lg[2] += hv * wa[2]; lg[3] += hv * wa[3]; lg[4] += hv * wb[0]; lg[5] += hv * wb[1]; lg[6] += hv * wb[2]; lg[7] += hv * wb[3]; }
        { const bool b5 = lane & 32, b4 = lane & 16, b3 = lane & 8; float k4[4], k2[2], k1;
#pragma unroll
          for (int i = 0; i < 4; ++i) { const float send = b5 ? lg[i] : lg[4 + i], keep = b5 ? lg[4 + i] : lg[i]; k4[i] = keep + __shfl_xor(send, 32); }
#pragma unroll
          for (int i = 0; i < 2; ++i) { const float send = b4 ? k4[i] : k4[2 + i], keep = b4 ? k4[2 + i] : k4[i]; k2[i] = keep + __shfl_xor(send, 16); }
          { const float send = b3 ? k2[0] : k2[1], keep = b3 ? k2[1] : k2[0]; k1 = keep + __shfl_xor(send, 8); }
          k1 += __shfl_xor(k1, 4); k1 += __shfl_xor(k1, 2); k1 += __shfl_xor(k1, 1);
#pragma unroll
          for (int e = 0; e < 8; ++e) lg[e] = __builtin_bit_cast(float, __builtin_amdgcn_readlane(__builtin_bit_cast(int, k1), 8 * e)) * rs; }
        int i0 = 0; float v0 = lg[0];
#pragma unroll
        for (int e = 1; e < 8; ++e) if (lg[e] > v0) { v0 = lg[e]; i0 = e; }
        int i1 = -1; float v1 = -3.0e38f;
#pragma unroll
        for (int e = 0; e < 8; ++e) if (e != i0 && lg[e] > v1) { v1 = lg[e]; i1 = e; }
        const float e1 = __expf(v1 - v0), w0 = 1.0f / (1.0f + e1), w1 = e1 * w0;
        if (lane == 0) { toke[2 * t] = i0; toke[2 * t + 1] = i1; tokw[2 * t] = w0; tokw[2 * t + 1] = w1; rsrow[t] = rs; __hip_atomic_fetch_add(cnt + i0, 1, __ATOMIC_RELAXED, __HIP_MEMORY_SCOPE_WORKGROUP); __hip_atomic_fetch_add(cnt + i1, 1, __ATOMIC_RELAXED, __HIP_MEMORY_SCOPE_WORKGROUP); }
    }
    wg_sync();
    if (tid < 8) wgcnt[blockIdx.x * 8 + tid] = cnt[tid];
    wg_sync();
}
__device__ __forceinline__ void moe_slot_phase(LAS unsigned char* lds, const int* toke, const int* wgcnt, int* tokp, int* rowtok, int* tilee, int* meta, int G) {
    const int tid = opq_tid(), lane = tid & 63, wave = __builtin_amdgcn_readfirstlane(tid >> 6);
    LAS int* arr = (LAS int*)lds;
    LAS int* pre = arr + 1024 * 8;
    LAS int* wcnt = pre + 32;
    for (int i = tid; i < G * 8; i += NTHR) arr[i] = wgcnt[i];
    wg_sync();
    if (tid < 8) { int p = 0, tot = 0; for (int w = 0; w < G; ++w) { const int c = arr[w * 8 + tid]; if (w < (int)blockIdx.x) p += c; tot += c; } pre[tid] = p; pre[8 + tid] = tot; }
    wg_sync();
    if (tid == 0) { int ps = 0; for (int e = 0; e < 8; ++e) { pre[16 + e] = ps; ps += ((pre[8 + e] + 255) >> 8) << 8; } pre[24] = ps; }
    wg_sync();
    const int TPW = M / G;
    int e_mine = -1, t = 0, rank = 0;
    if (tid < 2 * TPW) { t = blockIdx.x * TPW + (tid >> 1); e_mine = toke[2 * t + (tid & 1)]; }
#pragma unroll
    for (int e = 0; e < 8; ++e) { const unsigned long long mk_ = __ballot(e_mine == e); if (e_mine == e) rank = __popcll(mk_ & ((1ull << lane) - 1ull)); if (lane == 0) wcnt[wave * 8 + e] = __popcll(mk_); }
    wg_sync();
    if (e_mine >= 0) { int base = pre[16 + e_mine] + pre[e_mine]; for (int w = 0; w < wave; ++w) base += wcnt[w * 8 + e_mine];
        const int slot = base + rank; rowtok[slot] = t; tokp[2 * t + (tid & 1)] = slot; }
    if ((int)blockIdx.x < 8) { const int e = blockIdx.x, s0 = pre[16 + e] + pre[8 + e], s1 = pre[16 + e] + (((pre[8 + e] + 255) >> 8) << 8);
        for (int s = s0 + tid; s < s1; s += NTHR) rowtok[s] = 0; }
    if (blockIdx.x == 0) { const int ntiles = pre[24] >> 8;
        for (int ti = tid; ti < ntiles; ti += NTHR) { int e = 0;
#pragma unroll
            for (int q = 1; q < 8; ++q) if (ti * 256 >= pre[16 + q]) e = q;
            tilee[ti] = e; }
        if (tid == 0) meta[0] = ntiles; }
    wg_sync();
}
__device__ __forceinline__ void moe_gather_phase(const bf16* xb, const float* rsrow, const float* gain, const int* rowtok, bf16* XG, int nrows, int gw, int NGW, int lane) {
    f32x4 g[4];
#pragma unroll
    for (int q = 0; q < 4; ++q) g[q] = *(const f32x4*)(gain + (q >> 1) * 512 + 8 * lane + 4 * (q & 1));
    for (int r = gw; r < nrows; r += NGW) { const int t = rowtok[r]; const float rs = rsrow[t]; const v4u* src = (const v4u*)(xb + (size_t)t * D); v4u* dst = (v4u*)(XG + (size_t)r * D);
#pragma unroll
        for (int h = 0; h < 2; ++h) { const v4u a = src[64 * h + lane]; v4u o;
            o.x = pk2(bflo(a.x) * rs * g[2 * h][0], bfhi(a.x) * rs * g[2 * h][1]); o.y = pk2(bflo(a.y) * rs * g[2 * h][2], bfhi(a.y) * rs * g[2 * h][3]);
            o.z = pk2(bflo(a.z) * rs * g[2 * h + 1][0], bfhi(a.z) * rs * g[2 * h + 1][1]); o.w = pk2(bflo(a.w) * rs * g[2 * h + 1][2], bfhi(a.w) * rs * g[2 * h + 1][3]);
            dst[64 * h + lane] = o; } }
}
__device__ __forceinline__ void moe_combine_final_phase(const bf16* xb, float* out, const bf16* YB, const int* tokp, const float* tokw, const float* gain, int gw, int NGW, int lane) {
    f32x4 g[4];
#pragma unroll
    for (int q = 0; q < 4; ++q) g[q] = *(const f32x4*)(gain + (q >> 1) * 512 + 8 * lane + 4 * (q & 1));
#pragma unroll 1
    for (int t0 = gw; t0 < M; t0 += 2 * NGW) {
        v4u xa[2][2], ya[2][2], yb[2][2]; float w0[2], w1[2]; bool on[2];
#pragma unroll
        for (int u = 0; u < 2; ++u) { const int t = t0 + u * NGW; on[u] = t < M; const int tt = on[u] ? t : t0;
            const int p0 = tokp[2 * tt], p1 = tokp[2 * tt + 1]; w0[u] = tokw[2 * tt]; w1[u] = tokw[2 * tt + 1];
            const v4u* xr = (const v4u*)(xb + (size_t)tt * D) + lane; const v4u* y0 = (const v4u*)(YB + (size_t)p0 * D) + lane; const v4u* y1 = (const v4u*)(YB + (size_t)p1 * D) + lane;
#pragma unroll
            for (int h = 0; h < 2; ++h) { xa[u][h] = xr[64 * h]; ya[u][h] = y0[64 * h]; yb[u][h] = y1[64 * h]; } }
#pragma unroll
        for (int u = 0; u < 2; ++u) { const int t = t0 + u * NGW; float v[2][8]; float s = 0.f;
#pragma unroll
            for (int h = 0; h < 2; ++h) { const unsigned xw[4] = {xa[u][h].x, xa[u][h].y, xa[u][h].z, xa[u][h].w}, aw[4] = {ya[u][h].x, ya[u][h].y, ya[u][h].z, ya[u][h].w}, bw[4] = {yb[u][h].x, yb[u][h].y, yb[u][h].z, yb[u][h].w};
#pragma unroll
                for (int q = 0; q < 4; ++q) { v[h][2 * q] = bflo(xw[q]) + w0[u] * bflo(aw[q]) + w1[u] * bflo(bw[q]); v[h][2 * q + 1] = bfhi(xw[q]) + w0[u] * bfhi(aw[q]) + w1[u] * bfhi(bw[q]);
                    s += v[h][2 * q] * v[h][2 * q] + v[h][2 * q + 1] * v[h][2 * q + 1]; } }
            const float rs = 1.0f / sqrtf(wave_sum(s) * (1.f / 1024.f) + EPS);
            if (on[u]) { f32x4* orow = (f32x4*)(out + (size_t)t * D);
#pragma unroll
                for (int h = 0; h < 2; ++h) { orow[128 * h + 2 * lane] = (f32x4){v[h][0], v[h][1], v[h][2], v[h][3]} * rs * g[2 * h]; orow[128 * h + 2 * lane + 1] = (f32x4){v[h][4], v[h][5], v[h][6], v[h][7]} * rs * g[2 * h + 1]; } } }
    }
}
struct MoeOrder : pg8::StaticOrder {
    const int* tilee; int tile0; size_t bstride;
    __device__ __forceinline__ size_t boff(const pg8::Unit& u) const { return (size_t)tilee[tile0 + u.pm] * bstride; }
};
#ifndef LB_WAVES
#define LB_WAVES 2
#endif
__global__ void __launch_bounds__(NTHR, LB_WAVES) fwd_kernel(Args args) {
    extern __shared__ __attribute__((aligned(16))) unsigned char lds_raw[];
    LAS unsigned char* lds = (LAS unsigned char*)lds_raw;
    const int tid0 = threadIdx.x;
    const int G = gridDim.x, NGW = G * NWAVES;
    unsigned char* ws = args.ws;
    gu32* ctl = (gu32*)(ws + WS_CTL);
    volatile LAS unsigned* MISC = (volatile LAS unsigned*)(lds + MISC_OFF);
    for (int u = tid0; u < (LDS_BYTES - LDSCTL_OFF) / 4; u += NTHR) ((LAS unsigned*)(lds + LDSCTL_OFF))[u] = 0u;
    __syncthreads();
    XcdBarrier bar; bar.bar = (unsigned*)(ctl + CW_BAR); bar.x = 0; bar.st = nullptr;
    if (args.use_bar) bar = xcd_barrier_post((unsigned*)(ctl + CW_BAR), MISC + 8);
    const int lo = args.ph_lo, hi = args.ph_hi;
    int ph = 0;
#ifndef PHMASK
#define PHMASK 0xffffffffu
#endif
#define EN(k) (((PHMASK) >> (k)) & 1u)
#define PH_ON() (ph >= lo && ph < hi)
#define LOCAL_IDS() const int tid = opq_tid(), lane = tid & 63, wave = __builtin_amdgcn_readfirstlane(tid >> 6), gw = blockIdx.x * NWAVES + wave; (void)lane; (void)gw
#ifndef DUPMASK
#define DUPMASK 0u
#endif
#define RES_DST(k) ((NREP(k) > 1 && rep_ + 1 < NREP(k)) ? (bf16*)args.out : HB)
#ifndef DUPN
#define DUPN 2
#endif
#define NREP(k) ((((DUPMASK) >> (k)) & 1u) ? DUPN : 1)
#define PH_END_K(k) do { if (args.use_bar && (ph + 1 < hi || rep_ + 1 < NREP(k))) xcd_barrier(bar); } while (0)

    float* cosT = (float*)(ws + WS_COS); float* sinT = (float*)(ws + WS_SIN); float* H2 = (float*)(ws + WS_H2);
    int* toke = (int*)(ws + WS_TOKE); float* tokw = (float*)(ws + WS_TOKW); int* tokp = (int*)(ws + WS_TOKP); int* rowtok = (int*)(ws + WS_ROWTOK);
    int* tilee = (int*)(ws + WS_TILEE); int* wgcnt = (int*)(ws + WS_WGCNT); int* meta = (int*)(ws + WS_META); float* rsrow = (float*)(ws + WS_RSROW);
    bf16* WINA = (bf16*)(ws + WS_WINA); bf16* WINB = (bf16*)(ws + WS_WINB); bf16* WOUT = (bf16*)(ws + WS_WOUT); bf16* XQ = (bf16*)(ws + WS_XQ); bf16* XK = (bf16*)(ws + WS_XK);
    bf16* XV = (bf16*)(ws + WS_XV); bf16* XO = (bf16*)(ws + WS_XO); bf16* FGU = (bf16*)(ws + WS_FGU); bf16* FDN = (bf16*)(ws + WS_FDN); bf16* MGU = (bf16*)(ws + WS_MGU); bf16* MDN = (bf16*)(ws + WS_MDN);
    float* KF = (float*)(ws + WS_KFILT); bf16* MB = (bf16*)(ws + WS_MB); bf16* KMEM = (bf16*)(ws + WS_KMEM); bf16* VMEMT = (bf16*)(ws + WS_VMEMT); bf16* HB = (bf16*)(ws + WS_HB);
    bf16* QB = (bf16*)(ws + WS_QB); bf16* KB = (bf16*)(ws + WS_KB); bf16* VB = (bf16*)(ws + WS_VB); bf16* UT = (bf16*)(ws + WS_UT); bf16* AB = (bf16*)(ws + WS_AB); bf16* YT = (bf16*)(ws + WS_YT);
    bf16* MIXED = (bf16*)(ws + WS_MIXED); float* SS = (float*)(ws + WS_SS);
    bf16* XQB = (bf16*)(ws + WS_XQB); bf16* XOB = (bf16*)(ws + WS_XOB); bf16* ACT = (bf16*)(ws + WS_ACT); bf16* XG = (bf16*)(ws + WS_XG); bf16* MACT = (bf16*)(ws + WS_MACT);
    const float* const* in = args.in;

    if (EN(0) && PH_ON()) for (int rep_ = 0; rep_ < NREP(0); ++rep_) { asm volatile("; PHASE_MARK 0"); LOCAL_IDS();
        LAS float* scr = (LAS float*)(lds + wave * 8704);
        constexpr int IT_L = 384 + 768 + 512 + 4 * 256, IT_D = 3 * 1408, IT_E = 3 * 1792, IT_ALL = 2 * IT_L + IT_D + NE * IT_E;
#pragma unroll 1
        for (int it = gw; it < IT_ALL; it += NGW) {
            const float* W; int ldw, K, col0 = 0, ncols, mode = 0; bf16* WT; const float* gk = nullptr; int r = it;
            if (r < 2 * IT_L) { const int l = r / IT_L; r -= l * IT_L;
                if (r < 384) { W = in[I_WIN] + (size_t)l * D * INC; ldw = INC; K = D; ncols = 768; WT = WINA + (size_t)l * 768 * D; mode = 1; gk = in[I_MIXNORM] + l * D; }
                else if ((r -= 384) < 768) { W = in[I_WIN] + (size_t)l * D * INC; ldw = INC; K = D; col0 = 768; ncols = C3; WT = WINB + (size_t)l * C3 * D; gk = in[I_MIXNORM] + l * D; }
                else if ((r -= 768) < 512) { W = in[I_WOUT] + (size_t)l * D * D; ldw = D; K = D; ncols = D; WT = WOUT + (size_t)l * D * D; }
                else if ((r -= 512) < 256) { W = in[I_XWQ] + (size_t)l * D * XW; ldw = XW; K = D; ncols = XW; WT = XQ + (size_t)l * XW * D; gk = in[I_XNORM] + l * D; }
                else if ((r -= 256) < 256) { W = in[I_XWK] + (size_t)l * D * XW; ldw = XW; K = D; ncols = XW; WT = XK + (size_t)l * XW * D; }
                else if ((r -= 256) < 256) { W = in[I_XWV] + (size_t)l * D * XW; ldw = XW; K = D; ncols = XW; WT = XV + (size_t)l * XW * D; }
                else { r -= 256; W = in[I_XWO] + (size_t)l * XW * D; ldw = D; K = XW; ncols = D; WT = XO + (size_t)l * D * XW; }
            } else if ((r -= 2 * IT_L) < IT_D) {
                if (r < 1408) { W = in[I_FGATE]; ldw = FF; K = D; ncols = FF; WT = FGU; mode = 2; gk = in[I_FNORM]; }
                else if ((r -= 1408) < 1408) { W = in[I_FUP]; ldw = FF; K = D; ncols = FF; WT = FGU; mode = 3; gk = in[I_FNORM]; }
                else { r -= 1408; W = in[I_FDOWN]; ldw = D; K = FF; ncols = D; WT = FDN; }
            } else { r -= IT_D; const int e = r / IT_E; r -= e * IT_E;
                if (r < 1792) { W = in[I_MGATE] + (size_t)e * D * FFE; ldw = FFE; K = D; ncols = FFE; WT = MGU + (size_t)e * 2 * FFE * D; mode = 2; }
                else if ((r -= 1792) < 1792) { W = in[I_MUP] + (size_t)e * D * FFE; ldw = FFE; K = D; ncols = FFE; WT = MGU + (size_t)e * 2 * FFE * D; mode = 3; }
                else { r -= 1792; W = in[I_MDOWN] + (size_t)e * FFE * D; ldw = D; K = FFE; ncols = D; WT = MDN + (size_t)e * D * FFE; }
            }
            tr_item(W, ldw, K, col0, ncols, WT, mode, gk, r, scr, lane);
        }
        for (int i = blockIdx.x * NTHR + tid; i < SEQ * 32; i += G * NTHR) { const int pos = i >> 5, f = i & 31;
            const float inv = (float)pow(10000.0, -(double)f / 32.0); const float ang = (float)pos * inv;
            cosT[i] = (float)cos((double)ang); sinT[i] = (float)sin((double)ang); }
        h2_rows(args, H2, gw, NGW, lane);
        norm_rows(in[I_MEM], in[I_MEMNORM], MB, MROWS, gw, NGW, lane);
        xb_rows(in[I_X], HB, SS, M, gw, NGW, lane);
        PH_END_K(0);
    }
    ++ph;
    if (EN(1) && PH_ON()) for (int rep_ = 0; rep_ < NREP(1); ++rep_) { asm volatile("; PHASE_MARK 1"); LOCAL_IDS();
        kfilt_phase(lds, H2, in[I_FW3], KF, G);
        PH_END_K(1);
    }
    ++ph;

#pragma unroll 1
    for (int l = 0; l < 2; ++l) {
        if (EN(2) && PH_ON()) for (int rep_ = 0; rep_ < NREP(2); ++rep_) { asm volatile("; PHASE_MARK 2"); LOCAL_IDS();
            if (l == 0) {
                kspec_phase(lds, KF, (float*)(ws + WS_KSPEC), G);
                { pg8::Gemm g{MB, XK, MROWS, 1024, D}; pg8::StaticOrder S; S.init(MROWS, 1024, G, (int)blockIdx.x); pg8::EpiBf16 E{KMEM, 1024, nullptr};
                  pg8::gemm_phase<pg8::EpiBf16, pg8::StaticOrder, PG8_ALIGN, PG8_SP2>(lds, g, S, E); }
                { pg8::Gemm g{MB, XV, MROWS, 1024, D}; pg8::StaticOrder S; S.init(MROWS, 1024, G, G >= 128 ? (int)((blockIdx.x + G - 64) % G) : (int)blockIdx.x); pg8::EpiT E{VMEMT, 1024, 12, nullptr};
                  pg8::gemm_phase<pg8::EpiT, pg8::StaticOrder, PG8_ALIGN, PG8_SP2>(lds, g, S, E); }
            }
            { pg8::Gemm g{HB, WINA + (size_t)l * 768 * D, M, 768, D}; pg8::StaticOrder S; S.init(M, 768, G, (int)blockIdx.x); pg8::EpiQKV E{QB, KB, VB, cosT, sinT, SS + (size_t)(3 * l) * SS_STRIDE};
              pg8::gemm_phase<pg8::EpiQKV, pg8::StaticOrder, PG8_ALIGN, PG8_SP2>(lds, g, S, E); }
            { pg8::Gemm g{HB, WINB + (size_t)l * C3 * D, M, C3, D}; pg8::StaticOrder S; S.init(M, C3, G, (int)blockIdx.x); pg8::EpiT E{UT, C3, 12, SS + (size_t)(3 * l) * SS_STRIDE};
              pg8::gemm_phase<pg8::EpiT, pg8::StaticOrder, PG8_ALIGN, PG8_SP2>(lds, g, S, E); }
            PH_END_K(2);
        }
        ++ph;
        if (EN(3) && PH_ON()) for (int rep_ = 0; rep_ < NREP(3); ++rep_) { asm volatile("; PHASE_MARK 3"); LOCAL_IDS();
#ifndef BA_REP
#define BA_REP 1
#endif
#ifndef HY_REP
#define HY_REP 1
#endif
#pragma unroll 1
            for (int r_ = 0; r_ < BA_REP; ++r_) band_attention_phase(lds, QB, KB, VB, AB, in[I_SINK] + l * NH, G);
#pragma unroll 1
            for (int r_ = 0; r_ < HY_REP; ++r_) hyena_phase(lds, args, l, UT, (const float*)(ws + WS_KSPEC), YT, G);
            PH_END_K(3);
        }
        ++ph;
        if (EN(4) && PH_ON()) for (int rep_ = 0; rep_ < NREP(4); ++rep_) { asm volatile("; PHASE_MARK 4"); LOCAL_IDS(); mixnorm_phase(lds, AB, YT, in[I_ANORM] + l * AW, in[I_YNORM] + l * HYW, MIXED, G); PH_END_K(4); }
        ++ph;
        if (EN(5) && PH_ON()) for (int rep_ = 0; rep_ < NREP(5); ++rep_) { asm volatile("; PHASE_MARK 5"); LOCAL_IDS();
            pg8::Gemm g{MIXED, WOUT + (size_t)l * D * D, M, D, D}; pg8::StaticOrder S; S.init(M, D, G, (int)blockIdx.x); pg8::EpiResB E{HB, D, SS + (size_t)(3 * l + 1) * SS_STRIDE, RES_DST(5)};
            pg8::gemm_phase<pg8::EpiResB, pg8::StaticOrder, PG8_ALIGN, PG8_SP2>(lds, g, S, E);
            PH_END_K(5);
        }
        ++ph;
        if (EN(7) && PH_ON()) for (int rep_ = 0; rep_ < NREP(7); ++rep_) { asm volatile("; PHASE_MARK 7"); LOCAL_IDS();
            pg8::Gemm g{HB, XQ + (size_t)l * XW * D, M, XW, D}; pg8::StaticOrder S; S.init(M, XW, G, (int)blockIdx.x); pg8::EpiBf16 E{XQB, XW, SS + (size_t)(3 * l + 1) * SS_STRIDE};
            pg8::gemm_phase<pg8::EpiBf16, pg8::StaticOrder, PG8_ALIGN, PG8_SP2>(lds, g, S, E);
            PH_END_K(7);
        }
        ++ph;
        if (EN(8) && PH_ON()) for (int rep_ = 0; rep_ < NREP(8); ++rep_) { asm volatile("; PHASE_MARK 8"); LOCAL_IDS(); cross_attention_phase(lds, XQB, KMEM, VMEMT, XOB, l, G); PH_END_K(8); }
        ++ph;
        if (EN(9) && PH_ON()) for (int rep_ = 0; rep_ < NREP(9); ++rep_) { asm volatile("; PHASE_MARK 9"); LOCAL_IDS();
            pg8::Gemm g{XOB, XO + (size_t)l * D * XW, M, D, XW}; pg8::StaticOrder S; S.init(M, D, G, (int)blockIdx.x); pg8::EpiResB E{HB, D, l == 0 ? SS + (size_t)2 * SS_STRIDE : nullptr, RES_DST(9)};
            pg8::gemm_phase<pg8::EpiResB, pg8::StaticOrder, PG8_ALIGN, PG8_SP2>(lds, g, S, E);
            PH_END_K(9);
        }
        ++ph;
        if (l == 0) {
            if (EN(11) && PH_ON()) for (int rep_ = 0; rep_ < NREP(11); ++rep_) { asm volatile("; PHASE_MARK 11"); LOCAL_IDS();
                pg8::Gemm g{HB, FGU, M, 2 * FF, D}; pg8::StaticOrder S; S.init(M, 2 * FF, G, (int)blockIdx.x); pg8::EpiSwiglu<true> E{ACT, FF, SS + (size_t)2 * SS_STRIDE};
                pg8::gemm_phase<pg8::EpiSwiglu<true>, pg8::StaticOrder, PG8_ALIGN, PG8_SP2>(lds, g, S, E);
                PH_END_K(11);
            }
            ++ph;
            if (EN(12) && PH_ON()) for (int rep_ = 0; rep_ < NREP(12); ++rep_) { asm volatile("; PHASE_MARK 12"); LOCAL_IDS();
                pg8::Gemm g{ACT, FDN, M, D, FF}; pg8::StaticOrder S; S.init(M, D, G, (int)blockIdx.x); pg8::EpiResB E{HB, D, SS + (size_t)3 * SS_STRIDE, RES_DST(12)};
                pg8::gemm_phase<pg8::EpiResB, pg8::StaticOrder, PG8_ALIGN, PG8_SP2>(lds, g, S, E);
                PH_END_K(12);
            }
            ++ph;
        } else {
            if (EN(14) && PH_ON()) for (int rep_ = 0; rep_ < NREP(14); ++rep_) { asm volatile("; PHASE_MARK 14"); LOCAL_IDS(); moe_norm_router_phase(lds, HB, in[I_FNORM] + D, in[I_ROUTER], rsrow, toke, tokw, wgcnt, G); PH_END_K(14); }
            ++ph;
            if (EN(15) && PH_ON()) for (int rep_ = 0; rep_ < NREP(15); ++rep_) { asm volatile("; PHASE_MARK 15"); LOCAL_IDS(); moe_slot_phase(lds, toke, wgcnt, tokp, rowtok, tilee, meta, G); PH_END_K(15); }
            ++ph;
            if (EN(16) && PH_ON()) for (int rep_ = 0; rep_ < NREP(16); ++rep_) { asm volatile("; PHASE_MARK 16"); LOCAL_IDS(); const int ntiles = meta[0]; moe_gather_phase(HB, rsrow, in[I_FNORM] + D, rowtok, XG, ntiles * 256, gw, NGW, lane); PH_END_K(16); }
            ++ph;
#pragma unroll 1
            for (int ci = 0; ci < 4; ++ci) {
                if (EN(17) && PH_ON()) for (int rep_ = 0; rep_ < NREP(17); ++rep_) { asm volatile("; PHASE_MARK 17"); LOCAL_IDS();
                    const int ntiles = meta[0], tile0 = ci * MOE_CH_TILES, nt = ci < 3 ? MOE_CH_TILES : ntiles - 3 * MOE_CH_TILES;
                    pg8::Gemm g{XG + (size_t)tile0 * 256 * D, MGU, nt * 256, 2 * FFE, D};
                    MoeOrder S; S.init(nt * 256, 2 * FFE, G, (int)blockIdx.x); S.tilee = tilee; S.tile0 = tile0; S.bstride = (size_t)2 * FFE * D * 2;
                    pg8::EpiSwiglu<false> E{MACT, FFE, nullptr};
                    pg8::gemm_phase<pg8::EpiSwiglu<false>, MoeOrder, PG8_ALIGN, PG8_SP2>(lds, g, S, E);
                    PH_END_K(17);
                }
                ++ph;
                if (EN(18) && PH_ON()) for (int rep_ = 0; rep_ < NREP(18); ++rep_) { asm volatile("; PHASE_MARK 18"); LOCAL_IDS();
                    const int ntiles = meta[0], tile0 = ci * MOE_CH_TILES, nt = ci < 3 ? MOE_CH_TILES : ntiles - 3 * MOE_CH_TILES;
                    pg8::Gemm g{MACT, MDN, nt * 256, D, FFE};
                    MoeOrder S; S.init(nt * 256, D, G, (int)blockIdx.x); S.tilee = tilee; S.tile0 = tile0; S.bstride = (size_t)D * FFE * 2;
                    pg8::EpiBf16 E{XG + (size_t)tile0 * 256 * D, D, nullptr};
                    pg8::gemm_phase<pg8::EpiBf16, MoeOrder, PG8_ALIGN, PG8_SP2>(lds, g, S, E);
                    PH_END_K(18);
                }
                ++ph;
            }
            if (EN(19) && PH_ON()) for (int rep_ = 0; rep_ < NREP(19); ++rep_) { asm volatile("; PHASE_MARK 19"); LOCAL_IDS(); moe_combine_final_phase(HB, args.out, XG, tokp, tokw, in[I_FINAL], gw, NGW, lane); PH_END_K(19); }
            ++ph;
        }
    }
#undef PH_ON
}
constexpr int N_PHASES = 2 + 7 + 2 + 7 + 3 + 8 + 1;

#ifndef MK_PER_PHASE
#define MK_PER_PHASE 0
#endif
extern "C" void kernel_launch(void* const* d_in, const int* in_sizes, int n_in, void* d_out, int out_size, void* d_ws, size_t ws_size, hipStream_t stream) {
    static int grid = 0;
    if (grid == 0) {
        if (n_in != 33 || in_sizes[0] != M * D || out_size != M * D || ws_size < WS_END) {
            fprintf(stderr, "kernel_launch: unexpected problem: n_in %d in0 %d out %d ws %zu (need %zu); nothing launched\n", n_in, n_in > 0 ? in_sizes[0] : -1, out_size, ws_size, (size_t)WS_END); grid = -1; return; }
        int dev = 0, cus = 0, per_cu = 0;
        if (hipGetDevice(&dev) != hipSuccess || hipDeviceGetAttribute(&cus, hipDeviceAttributeMultiprocessorCount, dev) != hipSuccess) { fprintf(stderr, "kernel_launch: device query failed\n"); grid = -1; return; }
        if (hipFuncSetAttribute((const void*)fwd_kernel, hipFuncAttributeMaxDynamicSharedMemorySize, LDS_BYTES) != hipSuccess) { fprintf(stderr, "kernel_launch: hipFuncSetAttribute failed\n"); grid = -1; return; }
        if (hipOccupancyMaxActiveBlocksPerMultiprocessor(&per_cu, (const void*)fwd_kernel, NTHR, LDS_BYTES) != hipSuccess || per_cu < 1) { fprintf(stderr, "kernel_launch: occupancy query reports %d\n", per_cu); }
        (void)hipGetLastError();
        grid = cus;
        if (grid > 256) grid = 256;
        while (grid > 1 && (M % grid != 0 || M / grid > 256)) --grid;
        if (grid != 256) fprintf(stderr, "kernel_launch: note: grid %d\n", grid);
    }
    if (grid < 0) return;
    if (hipMemsetAsync((char*)d_ws + WS_CTL, 0, CTL_ZERO_BYTES, stream) != hipSuccess) { fprintf(stderr, "kernel_launch: memset failed\n"); return; }
    Args a{};
    for (int i = 0; i < 33; ++i) a.in[i] = (const float*)d_in[i];
    a.out = (float*)d_out; a.ws = (unsigned char*)d_ws;
#if MK_PER_PHASE
    for (int p = 0; p < N_PHASES; ++p) { a.ph_lo = p; a.ph_hi = p + 1; a.use_bar = 0; a.pad = 0; hipLaunchKernelGGL(fwd_kernel, dim3(grid), dim3(NTHR), LDS_BYTES, stream, a); }
#else
    a.ph_lo = 0; a.ph_hi = N_PHASES; a.use_bar = 1; a.pad = 0;
    hipLaunchKernelGGL(fwd_kernel, dim3(grid), dim3(NTHR), LDS_BYTES, stream, a);
#endif
    const hipError_t le = hipPeekAtLastError();
    if (le != hipSuccess) fprintf(stderr, "kernel_launch: launch failed: %s\n", hipGetErrorName(le));
}
```

```cpp
#include <hip/hip_runtime.h>
#include <cstdio>
#include <cstdint>
#ifndef HD
#define HD __host__ __device__ __forceinline__
#endif
__device__ __forceinline__ int opq_tid() { int t = (int)threadIdx.x; asm volatile("" : "+v"(t)); return t; }
typedef float f32x2_cv __attribute__((ext_vector_type(2))); typedef __bf16 bf16x2_cv __attribute__((ext_vector_type(2)));
__device__ __forceinline__ unsigned cvtpk_hw(float lo, float hi) { f32x2_cv v = {lo, hi}; bf16x2_cv b = __builtin_convertvector(v, bf16x2_cv); return __builtin_bit_cast(unsigned, b); }

struct cf { float x, y; };
HD cf mk(float a, float b) { cf r; r.x = a; r.y = b; return r; }
HD cf cadd(cf a, cf b) { return mk(a.x + b.x, a.y + b.y); }
HD cf csub(cf a, cf b) { return mk(a.x - b.x, a.y - b.y); }
HD cf cmul(cf a, cf b) { return mk(a.x * b.x - a.y * b.y, a.x * b.y + a.y * b.x); }
HD cf cmulc(cf a, cf b) { return mk(a.x * b.x + a.y * b.y, a.y * b.x - a.x * b.y); }
template <bool INV> HD cf cmulw(cf a, cf w) { return INV ? cmulc(a, w) : cmul(a, w); }
HD cf cscale(cf a, float s) { return mk(a.x * s, a.y * s); }

template <bool INV> HD void dft4(cf& a0, cf& a1, cf& a2, cf& a3) {
    const cf t0 = cadd(a0, a2), t1 = csub(a0, a2), t2 = cadd(a1, a3), t3 = csub(a1, a3);
    a0 = cadd(t0, t2); a2 = csub(t0, t2);
    const cf mit3 = mk(t3.y, -t3.x);
    if (!INV) { a1 = cadd(t1, mit3); a3 = csub(t1, mit3); }
    else      { a1 = csub(t1, mit3); a3 = cadd(t1, mit3); }
}
template <bool INV> HD void dft16(cf (&x)[16]) {
#pragma unroll
    for (int n1 = 0; n1 < 4; ++n1) dft4<INV>(x[n1], x[n1 + 4], x[n1 + 8], x[n1 + 12]);
    const float c1 = 0.92387953251128674f, s1 = 0.38268343236508977f, r2 = 0.70710678118654752f;
    const cf W1 = mk(c1, -s1), W2 = mk(r2, -r2), W3 = mk(s1, -c1), W6 = mk(-r2, -r2), W9 = mk(-c1, s1);
    x[1 + 4 * 1] = cmulw<INV>(x[1 + 4 * 1], W1);
    x[1 + 4 * 2] = cmulw<INV>(x[1 + 4 * 2], W2);
    x[1 + 4 * 3] = cmulw<INV>(x[1 + 4 * 3], W3);
    x[2 + 4 * 1] = cmulw<INV>(x[2 + 4 * 1], W2);
    { const cf t = x[2 + 4 * 2]; x[2 + 4 * 2] = INV ? mk(-t.y, t.x) : mk(t.y, -t.x); }
    x[2 + 4 * 3] = cmulw<INV>(x[2 + 4 * 3], W6);
    x[3 + 4 * 1] = cmulw<INV>(x[3 + 4 * 1], W3);
    x[3 + 4 * 2] = cmulw<INV>(x[3 + 4 * 2], W6);
    x[3 + 4 * 3] = cmulw<INV>(x[3 + 4 * 3], W9);
#pragma unroll
    for (int k2 = 0; k2 < 4; ++k2) dft4<INV>(x[0 + 4 * k2], x[1 + 4 * k2], x[2 + 4 * k2], x[3 + 4 * k2]);
    cf t;
    t = x[1]; x[1] = x[4]; x[4] = t;   t = x[2]; x[2] = x[8]; x[8] = t;   t = x[3]; x[3] = x[12]; x[12] = t;
    t = x[6]; x[6] = x[9]; x[9] = t;   t = x[7]; x[7] = x[13]; x[13] = t; t = x[11]; x[11] = x[14]; x[14] = t;
}
template <bool INV> HD void twiddle16(cf (&x)[16], cf w1) {
    cf w = w1;
#pragma unroll
    for (int k = 1; k < 16; ++k) { x[k] = cmulw<INV>(x[k], w); if (k < 15) w = cmul(w, w1); }
}
constexpr int FFT_HALF = 4352;
constexpr int FFT_WORK = 2 * FFT_HALF;
HD int fphys(int h, int idx) { return h * FFT_HALF + idx + (idx >> 4); }

HD void geo1(int tid, int& h, int& j) { const int w = tid >> 6, l = tid & 63; h = l >> 5; j = 32 * w + (l & 31); }
HD void geo2(int tid, int& h, int& k1, int& j2) { h = tid >> 8; k1 = (tid >> 4) & 15; j2 = tid & 15; }
HD void geo3(int tid, int& h, int& blk) { h = tid >> 8; blk = tid & 255; }

HD int fbase1(int h, int j) { return h * FFT_HALF + j + (j >> 4); }
HD int fbase2(int h, int k1, int j2) { return h * FFT_HALF + 272 * k1 + j2; }
HD int fbase3(int h, int blk) { return h * FFT_HALF + 17 * blk; }
template <class L> HD void fwd_pass1(L lds, int b1, cf w4096j, cf (&x)[16]) {
    dft16<false>(x); twiddle16<false>(x, w4096j);
#pragma unroll
    for (int k = 0; k < 16; ++k) lds.st(b1 + 272 * k, x[k]);
}
template <class L> HD void fwd_pass2(L lds, int b2, cf w256j) {
    cf x[16];
#pragma unroll
    for (int m = 0; m < 16; ++m) x[m] = lds.ld(b2 + 17 * m);
    dft16<false>(x); twiddle16<false>(x, w256j);
#pragma unroll
    for (int k = 0; k < 16; ++k) lds.st(b2 + 17 * k, x[k]);
}
template <class L> HD void fwd_pass3_keep(L lds, int b3, cf (&x)[16]) {
#pragma unroll
    for (int m = 0; m < 16; ++m) x[m] = lds.ld(b3 + m);
    dft16<false>(x);
}
template <class L> HD void mid_pass3(L lds, int b3, const cf (&K)[16]) {
    cf x[16];
#pragma unroll
    for (int m = 0; m < 16; ++m) x[m] = lds.ld(b3 + m);
    dft16<false>(x);
#pragma unroll
    for (int k = 0; k < 16; ++k) x[k] = cmul(x[k], K[k]);
    dft16<true>(x);
#pragma unroll
    for (int m = 0; m < 16; ++m) lds.st(b3 + m, x[m]);
}
template <class L> HD void inv_pass2(L lds, int b2, cf w256j) {
    cf x[16];
#pragma unroll
    for (int k = 0; k < 16; ++k) x[k] = lds.ld(b2 + 17 * k);
    twiddle16<true>(x, w256j); dft16<true>(x);
#pragma unroll
    for (int m = 0; m < 16; ++m) lds.st(b2 + 17 * m, x[m]);
}
template <class L> HD void inv_pass1(L lds, int b1, cf w4096j, cf (&x)[16]) {
#pragma unroll
    for (int k = 0; k < 16; ++k) x[k] = lds.ld(b1 + 272 * k);
    twiddle16<true>(x, w4096j); dft16<true>(x);
}
#ifndef PG8_WGM
#define PG8_WGM 8
#endif
namespace pg8 {
#define PG8_LAS __attribute__((address_space(3)))
typedef unsigned short bf16_t;
typedef short bf16x8 __attribute__((ext_vector_type(8)));
typedef float f32x4 __attribute__((ext_vector_type(4)));
typedef unsigned u32x4 __attribute__((ext_vector_type(4)));
constexpr int BM = 256, BK = 64, HALF = 128, HTB = HALF * BK * 2  , STAGE_BYTES = 8 * HTB, NXCD = 8, WGM = PG8_WGM;

__host__ __device__ __forceinline__ int lds_byte(int r, int c) { const int st = (r >> 4) * 2 + (c >> 5), rr = r & 15, cc = c & 31, ob = rr * 64 + cc * 2; return st * 1024 + (ob ^ (((ob >> 9) & 1) << 5)); }
__host__ __device__ __forceinline__ void stage_rc(int b, int& R, int& C) { const int st = b / 1024, sb = b % 1024, swz = sb ^ (((sb >> 9) & 1) << 5); R = (st >> 1) * 16 + swz / 64; C = (st & 1) * 32 + (swz % 64) / 2; }
__host__ __device__ __forceinline__ int perm32(int rho) { const int n = rho >> 4, i = rho & 15; return 8 * (i >> 2) + 4 * n + (i & 3); }

struct Unit { int pm, pn; };
struct Gemm { const bf16_t* A; const bf16_t* Bt; int M, N, K; };

struct StaticOrder {
    int nM, nN, nwg, G, c;
    __host__ __device__ void init(int M, int N, int G_, int c_) { nM = M / BM; nN = N / BM; nwg = nM * nN; G = G_; c = c_; }
    __host__ __device__ bool next(int i, Unit& u) const {
        const long L = (long)i * G + c; if (L >= nwg) return false;
        int wgid = (int)L; { const int q = nwg / NXCD, r = nwg % NXCD, xcd = wgid % NXCD, off = wgid / NXCD; wgid = (xcd < r ? xcd * (q + 1) : r * (q + 1) + (xcd - r) * q) + off; }
        const int nig = WGM * nN, gid = wgid / nig, fm = gid * WGM, gsz = (nM - fm) < WGM ? (nM - fm) : WGM;
        u.pm = fm + ((wgid % nig) % gsz); u.pn = (wgid % nig) / gsz; return true;
    }
    __device__ __forceinline__ size_t boff(const Unit&) const { return 0; }
    __device__ __forceinline__ void a_ready(const Unit&) const {}
    __device__ __forceinline__ void done(const Unit&) const {}
};

__device__ __forceinline__ unsigned cvt_pk_bf16(float lo, float hi) { unsigned r; asm volatile("v_cvt_pk_bf16_f32 %0, %1, %2" : "=v"(r) : "v"(lo), "v"(hi)); return r; }
typedef float f32x2 __attribute__((ext_vector_type(2)));
typedef unsigned u32x2 __attribute__((ext_vector_type(2)));
__device__ __forceinline__ float row_rs(const float* ssp, int row, int fq) {
    if (!ssp) return 1.0f;
    const f32x4 q = *(const f32x4*)(ssp + (size_t)row * 16 + 4 * fq); float s = (q[0] + q[1]) + (q[2] + q[3]);
    s += __shfl_xor(s, 16); s += __shfl_xor(s, 32);
    return __builtin_amdgcn_rsqf(s * (1.0f / 1024.0f) + 1e-6f);
}
__device__ __forceinline__ void row_rs8(const float* ssp, int row0, int fq, float (&rs)[2][4]) {
    if (!ssp) {
#pragma unroll
        for (int ai = 0; ai < 2; ++ai)
#pragma unroll
            for (int m = 0; m < 4; ++m) rs[ai][m] = 1.0f;
        return; }
    f32x4 q[2][4];
#pragma unroll
    for (int ai = 0; ai < 2; ++ai)
#pragma unroll
        for (int m = 0; m < 4; ++m) q[ai][m] = *(const f32x4*)(ssp + (size_t)(row0 + ai * HALF + m * 16) * 16 + 4 * fq);
#pragma unroll
    for (int ai = 0; ai < 2; ++ai)
#pragma unroll
        for (int m = 0; m < 4; ++m) { float s = (q[ai][m][0] + q[ai][m][1]) + (q[ai][m][2] + q[ai][m][3]); s += __shfl_xor(s, 16); s += __shfl_xor(s, 32); rs[ai][m] = __builtin_amdgcn_rsqf(s * (1.0f / 1024.0f) + 1e-6f); }
}
__device__ __forceinline__ f32x4 row_rs4_swap(const float* ssp, int rowbase, int fr, int fq) {
    if (!ssp) return (f32x4){1.f, 1.f, 1.f, 1.f};
    const f32x4 q = *(const f32x4*)(ssp + (size_t)(rowbase + 4 * fq + (fr >> 2)) * 16 + 4 * (fr & 3)); float s = (q[0] + q[1]) + (q[2] + q[3]);
    s += __shfl_xor(s, 1); s += __shfl_xor(s, 2);
    const float rs = __builtin_amdgcn_rsqf(s * (1.0f / 1024.0f) + 1e-6f);
    f32x4 o;
#pragma unroll
    for (int r = 0; r < 4; ++r) o[r] = __shfl(rs, 16 * fq + 4 * r);
    return o;
}
struct EpiBf16 {
    static constexpr bool PERM = true, AFTER_DRAIN = false, SWAP = false;
    bf16_t* O; int ldc; const float* ss;
    __device__ __forceinline__ void operator()(const f32x4 (&acc)[2][2][4][2], const Unit& u, int wr, int wc, int fr, int fq) const {
        const int row0 = u.pm * BM + wr * 64 + fr, col0 = u.pn * BM + wc * 32 + 8 * fq;
        float rsa[2][4]; row_rs8(ss, row0, fq, rsa);
#pragma unroll
        for (int ai = 0; ai < 2; ++ai)
#pragma unroll
            for (int m = 0; m < 4; ++m) { bf16_t* rowp = O + (size_t)(row0 + ai * HALF + m * 16) * ldc + col0; const float rs = rsa[ai][m];
#pragma unroll
                for (int bj = 0; bj < 2; ++bj) { const f32x4 v0 = acc[ai][bj][m][0] * rs, v1 = acc[ai][bj][m][1] * rs;
                    u32x4 w; w.x = cvt_pk_bf16(v0[0], v0[1]); w.y = cvt_pk_bf16(v0[2], v0[3]); w.z = cvt_pk_bf16(v1[0], v1[1]); w.w = cvt_pk_bf16(v1[2], v1[3]);
                    *(u32x4*)(rowp + bj * HALF) = w; } }
    }
};
struct EpiQKV {
    static constexpr bool PERM = true, AFTER_DRAIN = false, SWAP = false;
    bf16_t* Q; bf16_t* Kb; bf16_t* Vb; const float* cosT; const float* sinT; const float* ss;
    __device__ __forceinline__ void operator()(const f32x4 (&acc)[2][2][4][2], const Unit& u, int wr, int wc, int fr, int fq) const {
        const int row0 = u.pm * BM + wr * 64 + fr;
        float rsa[2][4]; row_rs8(ss, row0, fq, rsa);
#pragma unroll
        for (int bj = 0; bj < 2; ++bj) {
            const int slot0 = u.pn * BM + bj * HALF + wc * 32 + 8 * fq;
            if (slot0 < 640) {
                const int head = slot0 >> 6, j4 = ((slot0 & 63) >> 3) * 4;
#pragma unroll
                for (int am = 0; am < 4; ++am) {
                    f32x4 c[2], sn[2];
                    const int tofs = ((row0 & 4095) + (am >> 1) * HALF + 2 * (am & 1) * 16) * 32 + j4;
                    const float* cb = cosT + tofs; const float* sb = sinT + tofs; asm volatile("" : "+v"(cb), "+v"(sb));
#pragma unroll
                    for (int h = 0; h < 2; ++h) { c[h] = *(const f32x4*)(cb + h * 512); sn[h] = *(const f32x4*)(sb + h * 512); }
#pragma unroll
                    for (int h = 0; h < 2; ++h) { const int ai = am >> 1, m = 2 * (am & 1) + h; const int row = row0 + ai * HALF + m * 16;
                        const float rs = rsa[ai][m]; const f32x4 lo = acc[ai][bj][m][0] * rs, hi = acc[ai][bj][m][1] * rs;
                        const f32x4 olo = lo * c[h] - hi * sn[h], ohi = hi * c[h] + lo * sn[h];
                        bf16_t* dst = head < 8 ? Q + (size_t)row * 512 + head * 64 + j4 : Kb + (size_t)row * 128 + (head - 8) * 64 + j4;
                        u32x2 w0, w1; w0.x = cvt_pk_bf16(olo[0], olo[1]); w0.y = cvt_pk_bf16(olo[2], olo[3]); w1.x = cvt_pk_bf16(ohi[0], ohi[1]); w1.y = cvt_pk_bf16(ohi[2], ohi[3]);
                        *(u32x2*)dst = w0; *(u32x2*)(dst + 32) = w1; } }
            } else {
#pragma unroll
                for (int ai = 0; ai < 2; ++ai)
#pragma unroll
                    for (int m = 0; m < 4; ++m) { const int row = row0 + ai * HALF + m * 16; const float rs = rsa[ai][m]; const f32x4 v0 = acc[ai][bj][m][0] * rs, v1 = acc[ai][bj][m][1] * rs;
                        u32x4 w; w.x = cvt_pk_bf16(v0[0], v0[1]); w.y = cvt_pk_bf16(v0[2], v0[3]); w.z = cvt_pk_bf16(v1[0], v1[1]); w.w = cvt_pk_bf16(v1[2], v1[3]);
                        *(u32x4*)(Vb + (size_t)row * 128 + (slot0 - 640)) = w; }
            }
        }
    }
};
struct EpiT {
    static constexpr bool PERM = false, AFTER_DRAIN = false, SWAP = true;
    bf16_t* O; int nch; int ts_shift; const float* ss;
    __device__ __forceinline__ void operator()(const f32x4 (&acc)[2][2][4][2], const Unit& u, int wr, int wc, int fr, int fq) const {
        const int rowt = u.pm * BM, b = rowt >> ts_shift, tb = (rowt & ((1 << ts_shift) - 1)) + wr * 64 + 4 * fq;
#pragma unroll
        for (int ai = 0; ai < 2; ++ai) {
            f32x4 rsv[4];
#pragma unroll
            for (int m = 0; m < 4; ++m) rsv[m] = row_rs4_swap(ss, rowt + wr * 64 + ai * HALF + m * 16, fr, fq);
#pragma unroll
            for (int bj = 0; bj < 2; ++bj)
#pragma unroll
                for (int n = 0; n < 2; ++n) { const int ch = u.pn * BM + bj * HALF + wc * 32 + 16 * n + fr; bf16_t* chp = O + (((size_t)(b * nch + ch)) << ts_shift) + tb + ai * HALF;
#pragma unroll
                    for (int m = 0; m < 4; ++m) { const f32x4 v = acc[ai][bj][m][n] * rsv[m]; u32x2 w; w.x = cvt_pk_bf16(v[0], v[1]); w.y = cvt_pk_bf16(v[2], v[3]);
                        *(u32x2*)(chp + m * 16) = w; } } }
    }
};
struct EpiResB {
    static constexpr bool PERM = true, AFTER_DRAIN = false, SWAP = false;
    bf16_t* xb; int ldc; float* ss; bf16_t* dst;
    __device__ __forceinline__ void operator()(const f32x4 (&acc)[2][2][4][2], const Unit& u, int wr, int wc, int fr, int fq) const {
        const int row0 = u.pm * BM + wr * 64 + fr, col0 = u.pn * BM + wc * 32 + 8 * fq;
#pragma unroll
        for (int ai = 0; ai < 2; ++ai) {
            u32x4 b[4][2];
#pragma unroll
            for (int m = 0; m < 4; ++m)
#pragma unroll
                for (int bj = 0; bj < 2; ++bj) b[m][bj] = *(const u32x4*)(xb + (size_t)(row0 + ai * HALF + m * 16) * ldc + col0 + bj * HALF);
#pragma unroll
            for (int m = 0; m < 4; ++m) { const int row = row0 + ai * HALF + m * 16; bf16_t* dstp = dst + (size_t)row * ldc + col0; float sq = 0.f;
#pragma unroll
                for (int bj = 0; bj < 2; ++bj) { const f32x4 a0 = acc[ai][bj][m][0], a1 = acc[ai][bj][m][1]; const u32x4 bb = b[m][bj]; float o[8];
                    o[0] = __builtin_bit_cast(float, bb.x << 16) + a0[0]; o[1] = __builtin_bit_cast(float, bb.x & 0xffff0000u) + a0[1];
                    o[2] = __builtin_bit_cast(float, bb.y << 16) + a0[2]; o[3] = __builtin_bit_cast(float, bb.y & 0xffff0000u) + a0[3];
                    o[4] = __builtin_bit_cast(float, bb.z << 16) + a1[0]; o[5] = __builtin_bit_cast(float, bb.z & 0xffff0000u) + a1[1];
                    o[6] = __builtin_bit_cast(float, bb.w << 16) + a1[2]; o[7] = __builtin_bit_cast(float, bb.w & 0xffff0000u) + a1[3];
#pragma unroll
                    for (int i = 0; i < 8; ++i) sq += o[i] * o[i];
                    u32x4 w; w.x = cvt_pk_bf16(o[0], o[1]); w.y = cvt_pk_bf16(o[2], o[3]); w.z = cvt_pk_bf16(o[4], o[5]); w.w = cvt_pk_bf16(o[6], o[7]);
                    *(u32x4*)(dstp + bj * HALF) = w; }
                if (ss) { sq += __shfl_xor(sq, 16); sq += __shfl_xor(sq, 32); if (fq == 0) ss[(size_t)row * 16 + u.pn * 4 + wc] = sq; } } }
    }
};
typedef float f32x2e __attribute__((ext_vector_type(2)));
__device__ __forceinline__ f32x2e silu_mul_pk(f32x2e g, f32x2e up) {
    const f32x2e t = g * (-1.44269504088896f); f32x2e e; e.x = __builtin_amdgcn_exp2f(t.x); e.y = __builtin_amdgcn_exp2f(t.y);
    const f32x2e d = e + 1.0f; f32x2e r; r.x = __builtin_amdgcn_rcpf(d.x); r.y = __builtin_amdgcn_rcpf(d.y);
    return (g * r) * up;
}
template <bool SCALE> struct EpiSwiglu {
    static constexpr bool PERM = true, AFTER_DRAIN = false, SWAP = false;
    bf16_t* O; int ldc; const float* ss;
    __device__ __forceinline__ void operator()(const f32x4 (&acc)[2][2][4][2], const Unit& u, int wr, int wc, int fr, int fq) const {
        const int row0 = u.pm * BM + wr * 64 + fr, col0 = u.pn * 128 + wc * 16 + 4 * fq;
        float rsa[2][4]; if (SCALE) row_rs8(ss, row0, fq, rsa);
#pragma unroll
        for (int ai = 0; ai < 2; ++ai)
#pragma unroll
            for (int m = 0; m < 4; ++m) { bf16_t* rowp = O + (size_t)(row0 + ai * HALF + m * 16) * ldc + col0; const float rs = SCALE ? rsa[ai][m] : 1.0f;
#pragma unroll
                for (int bj = 0; bj < 2; ++bj) { f32x4 g = acc[ai][bj][m][0], up = acc[ai][bj][m][1]; if (SCALE) { g = g * rs; up = up * rs; }
                    const f32x2e o0 = silu_mul_pk((f32x2e){g[0], g[1]}, (f32x2e){up[0], up[1]}), o1 = silu_mul_pk((f32x2e){g[2], g[3]}, (f32x2e){up[2], up[3]});
                    u32x2 w; w.x = cvt_pk_bf16(o0.x, o0.y); w.y = cvt_pk_bf16(o1.x, o1.y);
                    *(u32x2*)(rowp + bj * 64) = w; } }
    }
};
template <class Epi, class Sched, bool ALIGN_EPI = false, bool SP2 = false>
__device__ __forceinline__ void gemm_phase(PG8_LAS unsigned char* lds, const Gemm g, const Sched& S, const Epi& E) {
    const int tid = opq_tid(), wid = __builtin_amdgcn_readfirstlane(tid >> 6), lane = tid & 63, wr = wid >> 2, wc = wid & 3, fr = lane & 15, fq = lane >> 4;
    const int K = g.K, nt = K / BK;
    unsigned voffA[2], voffB[2];
#pragma unroll
    for (int i = 0; i < 2; ++i) { int R, C; stage_rc(tid * 16 + i * 8192, R, C); const int Rb = Epi::PERM ? ((R & ~31) + perm32(R & 31)) : R;
        voffA[i] = (unsigned)(R * K + C) * 2u; voffB[i] = (unsigned)(Rb * K + C) * 2u; }
    const size_t kstep = (size_t)(BK * 2);
    const size_t hstep = (size_t)HALF * K * 2;
    const size_t tstep = 2 * hstep;
    const unsigned ldsw = (unsigned)wid * 1024u;
    const int aoff = lds_byte(wr * 64 + fr, fq * 8), boff = lds_byte(wc * 32 + fr, fq * 8);
#define PG8_SA(b, h) (((b) * 2 + (h)) * HTB)
#define PG8_SB(b, h) ((4 + (b) * 2 + (h)) * HTB)
#define PG8_STAGE(bufoff, gbase, voff) do { _Pragma("unroll") for (int _i = 0; _i < 2; ++_i) \
        __builtin_amdgcn_global_load_lds((const unsigned*)((const char*)(gbase) + (voff)[_i]), (PG8_LAS unsigned*)(lds + (bufoff) + ldsw + _i * 8192), 16, 0, 0); } while (0)
#define PG8_LDA(dst, b, h) do { _Pragma("unroll") for (int m = 0; m < 4; ++m) _Pragma("unroll") for (int k = 0; k < 2; ++k) dst[m][k] = *(const PG8_LAS bf16x8*)(lds + PG8_SA(b, h) + aoff + m * 2048 + k * 1024); } while (0)
#define PG8_LDB(dst, b, h) do { _Pragma("unroll") for (int n = 0; n < 2; ++n) _Pragma("unroll") for (int k = 0; k < 2; ++k) dst[n][k] = *(const PG8_LAS bf16x8*)(lds + PG8_SB(b, h) + boff + n * 2048 + k * 1024); } while (0)
#define PG8_MMA(ai, bj, At, Bt) do { __builtin_amdgcn_s_setprio(1); _Pragma("unroll") for (int m = 0; m < 4; ++m) _Pragma("unroll") for (int n = 0; n < 2; ++n) _Pragma("unroll") for (int k = 0; k < 2; ++k) \
        acc[ai][bj][m][n] = Epi::SWAP ? __builtin_amdgcn_mfma_f32_16x16x32_bf16(At[m][k], Bt[n][k], acc[ai][bj][m][n], 0, 0, 0) : __builtin_amdgcn_mfma_f32_16x16x32_bf16(Bt[n][k], At[m][k], acc[ai][bj][m][n], 0, 0, 0); __builtin_amdgcn_s_setprio(0); } while (0)
#define PG8_WAIT_V(n) asm volatile("s_waitcnt vmcnt(" #n ")" ::: "memory")
#define PG8_WAIT_L(n) asm volatile("s_waitcnt lgkmcnt(" #n ")" ::: "memory")
#define PG8_BAR __builtin_amdgcn_s_barrier()
#define PG8_SCHED __builtin_amdgcn_sched_barrier(0)
    Unit cur, nxt; int ui = 0;
    if (!S.next(0, cur)) return;
    f32x4 acc[2][2][4][2];
#pragma unroll
    for (int a = 0; a < 2; ++a)
#pragma unroll
        for (int b = 0; b < 2; ++b)
#pragma unroll
            for (int m = 0; m < 4; ++m)
#pragma unroll
                for (int n = 0; n < 2; ++n) acc[a][b][m][n] = (f32x4){0.f, 0.f, 0.f, 0.f};
    bf16x8 At[4][2], B0[2][2], B1[2][2];
    const char* cA = (const char*)g.A + (size_t)cur.pm * tstep; const char* cB = (const char*)g.Bt + S.boff(cur) + (size_t)cur.pn * tstep;
    S.a_ready(cur);
    if constexpr (SP2) {
        PG8_STAGE(PG8_SB(0, 0), cB, voffB); PG8_STAGE(PG8_SB(0, 1), cB + hstep, voffB); PG8_STAGE(PG8_SA(0, 0), cA, voffA); PG8_STAGE(PG8_SA(0, 1), cA + hstep, voffA);
        if (wr == 1) PG8_BAR;
        PG8_WAIT_V(2); PG8_BAR;
        PG8_STAGE(PG8_SB(1, 0), cB + kstep, voffB); PG8_STAGE(PG8_SA(1, 0), cA + kstep, voffA); PG8_STAGE(PG8_SB(1, 1), cB + hstep + kstep, voffB);
        PG8_WAIT_V(6); PG8_BAR;
    } else {
        PG8_STAGE(PG8_SB(0, 0), cB, voffB); PG8_STAGE(PG8_SA(0, 0), cA, voffA); PG8_STAGE(PG8_SB(0, 1), cB + hstep, voffB); PG8_STAGE(PG8_SA(0, 1), cA + hstep, voffA);
        if (wr == 1) PG8_BAR;
        PG8_WAIT_V(4); PG8_BAR;
        PG8_STAGE(PG8_SB(1, 0), cB + kstep, voffB); PG8_STAGE(PG8_SA(1, 0), cA + kstep, voffA); PG8_STAGE(PG8_SB(1, 1), cB + hstep + kstep, voffB);
        PG8_WAIT_V(6); PG8_BAR;
    }
    for (;;) {
        const bool has_next = S.next(ui + 1, nxt);
        const char* nA = has_next ? (const char*)g.A + (size_t)nxt.pm * tstep : cA; const char* nB = has_next ? (const char*)g.Bt + S.boff(nxt) + (size_t)nxt.pn * tstep : cB;
        for (int t = 0; t < nt; t += 2) {
            const bool last = (t == nt - 2);
            const char* a1 = cA + (size_t)(t + 1) * kstep;
            const char* a2 = last ? nA : cA + (size_t)(t + 2) * kstep; const char* b2 = last ? nB : cB + (size_t)(t + 2) * kstep;
            const char* a3 = a2 + kstep; const char* b3 = b2 + kstep;
            if (last && has_next) S.a_ready(nxt);
            if constexpr (SP2) {
            PG8_LDB(B0, 0, 0); PG8_LDB(B1, 0, 1); PG8_SCHED; PG8_LDA(At, 0, 0); PG8_STAGE(PG8_SA(1, 1), a1 + hstep, voffA);
            PG8_WAIT_V(8); PG8_WAIT_L(0); PG8_BAR; PG8_MMA(0, 0, At, B0); PG8_MMA(0, 1, At, B1); PG8_BAR; PG8_SCHED;
            PG8_LDA(At, 0, 1); PG8_STAGE(PG8_SB(0, 0), b2, voffB); PG8_STAGE(PG8_SB(0, 1), b2 + hstep, voffB); PG8_STAGE(PG8_SA(0, 0), a2, voffA);
            PG8_WAIT_V(8); PG8_WAIT_L(0); PG8_BAR; PG8_MMA(1, 0, At, B0); PG8_MMA(1, 1, At, B1); PG8_BAR; PG8_SCHED;
            PG8_LDB(B0, 1, 0); PG8_LDB(B1, 1, 1); PG8_SCHED; PG8_LDA(At, 1, 0); PG8_STAGE(PG8_SA(0, 1), a2 + hstep, voffA);
            PG8_WAIT_V(8); PG8_WAIT_L(0); PG8_BAR; PG8_MMA(0, 0, At, B0); PG8_MMA(0, 1, At, B1); PG8_BAR; PG8_SCHED;
            PG8_LDA(At, 1, 1); PG8_STAGE(PG8_SB(1, 0), b3, voffB); PG8_STAGE(PG8_SB(1, 1), b3 + hstep, voffB); PG8_STAGE(PG8_SA(1, 0), a3, voffA);
            PG8_WAIT_V(8); PG8_WAIT_L(0); PG8_BAR; PG8_MMA(1, 0, At, B0); PG8_MMA(1, 1, At, B1); PG8_BAR; PG8_SCHED;
            } else {
            PG8_LDB(B0, 0, 0); PG8_SCHED; PG8_LDA(At, 0, 0); PG8_STAGE(PG8_SA(1, 1), a1 + hstep, voffA);
            PG8_WAIT_L(8); PG8_BAR; PG8_WAIT_L(0); PG8_MMA(0, 0, At, B0); PG8_BAR; PG8_SCHED;
            PG8_LDB(B1, 0, 1); PG8_STAGE(PG8_SB(0, 0), b2, voffB);
            PG8_BAR; PG8_WAIT_L(0); PG8_MMA(0, 1, At, B1); PG8_BAR;
            PG8_LDA(At, 0, 1); PG8_STAGE(PG8_SA(0, 0), a2, voffA);
            PG8_BAR; PG8_WAIT_L(0); PG8_MMA(1, 0, At, B0); PG8_BAR; PG8_SCHED;
            PG8_STAGE(PG8_SB(0, 1), b2 + hstep, voffB);
            PG8_WAIT_V(6); PG8_BAR; PG8_MMA(1, 1, At, B1); PG8_BAR;
            PG8_LDB(B0, 1, 0); PG8_SCHED; PG8_LDA(At, 1, 0); PG8_STAGE(PG8_SA(0, 1), a2 + hstep, voffA);
            PG8_WAIT_L(8); PG8_BAR; PG8_WAIT_L(0); PG8_MMA(0, 0, At, B0); PG8_BAR; PG8_SCHED;
            PG8_LDB(B1, 1, 1); PG8_STAGE(PG8_SB(1, 0), b3, voffB);
            PG8_BAR; PG8_WAIT_L(0); PG8_MMA(0, 1, At, B1); PG8_BAR;
            PG8_LDA(At, 1, 1); PG8_STAGE(PG8_SA(1, 0), a3, voffA);
            PG8_BAR; PG8_WAIT_L(0); PG8_MMA(1, 0, At, B0); PG8_BAR; PG8_SCHED;
            PG8_STAGE(PG8_SB(1, 1), b3 + hstep, voffB);
            PG8_WAIT_V(6); PG8_BAR; PG8_MMA(1, 1, At, B1); PG8_BAR;
            }
        }
        if constexpr (ALIGN_EPI) { if (wr == 0) PG8_BAR; }
#ifndef EPI_REP
#define EPI_REP 1
#endif
        if constexpr (!Epi::AFTER_DRAIN) { _Pragma("unroll 1") for (int er_ = 0; er_ < EPI_REP; ++er_) E(acc, cur, wr, wc, fr, fq); S.done(cur); }
        if (!has_next) break;
#pragma unroll
        for (int a = 0; a < 2; ++a)
#pragma unroll
            for (int b = 0; b < 2; ++b)
#pragma unroll
                for (int m = 0; m < 4; ++m)
#pragma unroll
                    for (int n = 0; n < 2; ++n) acc[a][b][m][n] = (f32x4){0.f, 0.f, 0.f, 0.f};
        cur = nxt; cA = nA; cB = nB; ++ui;
        if constexpr (ALIGN_EPI) { if (wr == 1) PG8_BAR; }
    }
    PG8_WAIT_V(0);
    if constexpr (!ALIGN_EPI) { if (wr == 0) PG8_BAR; }
    PG8_BAR;
    if constexpr (Epi::AFTER_DRAIN) { E.fused(acc, cur, wr, wc, fr, fq, lds, wid, lane); S.done(cur); }
#undef PG8_SA
#undef PG8_SB
#undef PG8_STAGE
#undef PG8_LDA
#undef PG8_LDB
#undef PG8_MMA
#undef PG8_WAIT_V
#undef PG8_WAIT_L
#undef PG8_BAR
#undef PG8_SCHED
}
}
#ifndef PG8_SP2
#define PG8_SP2 true
#endif
#ifndef PG8_ALIGN
#define PG8_ALIGN true
#endif
constexpr int NB = 16, SEQ = 4096, D = 1024, M = NB * SEQ;
constexpr int NH = 8, NKV = 2, HDIM = 64, AW = 512, KVW = 128;
constexpr int HYW = 512, C3 = 1536, INC = 2304;
constexpr int XH = 4, XHD = 128, XW = 512, MEML = 256, MROWS = NB * MEML;
constexpr int FF = 2816, NE = 8, FFE = 3584;
constexpr float EPS = 1e-6f;
constexpr int NWAVES = 8, NTHR = 512;
constexpr int MOE_CH_TILES = 128, MOE_MAX_TILES = 520, MOE_MAX_ROWS = MOE_MAX_TILES * 256, MOE_ACT_TILES = 136;

constexpr size_t al256(size_t x) { return (x + 255) & ~(size_t)255; }
constexpr size_t WS_CTL = 0, CTL_ZERO_BYTES = 1u << 20;
constexpr size_t WS_SS = CTL_ZERO_BYTES, SS_STRIDE = (size_t)M * 16;
constexpr size_t WS_COS = WS_SS + 5 * SS_STRIDE * 4, WS_SIN = WS_COS + (size_t)SEQ * 32 * 4, WS_H2 = WS_SIN + (size_t)SEQ * 32 * 4;
constexpr size_t WS_TOKE = WS_H2 + (size_t)2 * SEQ * 64 * 4, WS_TOKW = WS_TOKE + (size_t)M * 2 * 4, WS_TOKP = WS_TOKW + (size_t)M * 2 * 4;
constexpr size_t WS_ROWTOK = WS_TOKP + (size_t)M * 2 * 4, WS_TILEE = WS_ROWTOK + al256((size_t)MOE_MAX_ROWS * 4), WS_WGCNT = WS_TILEE + 4096, WS_RSROW = WS_WGCNT + (size_t)1024 * 8 * 4, WS_META = WS_RSROW + (size_t)M * 4;
constexpr size_t WS_WINA = al256(WS_META + 4096);
constexpr size_t WS_WINB = WS_WINA + (size_t)2 * 768 * D * 2;
constexpr size_t WS_WOUT = WS_WINB + (size_t)2 * C3 * D * 2;
constexpr size_t WS_XQ = WS_WOUT + (size_t)2 * D * D * 2;
constexpr size_t WS_XK = WS_XQ + (size_t)2 * XW * D * 2;
constexpr size_t WS_XV = WS_XK + (size_t)2 * XW * D * 2;
constexpr size_t WS_XO = WS_XV + (size_t)2 * XW * D * 2;
constexpr size_t WS_FGU = WS_XO + (size_t)2 * D * XW * 2;
constexpr size_t WS_FDN = WS_FGU + (size_t)2 * FF * D * 2;
constexpr size_t WS_MGU = WS_FDN + (size_t)D * FF * 2;
constexpr size_t WS_MDN = WS_MGU + (size_t)NE * 2 * FFE * D * 2;
constexpr size_t WS_KFILT = WS_MDN + (size_t)NE * D * FFE * 2;
constexpr size_t WS_MB = WS_KFILT + (size_t)2 * 2 * HYW * 8192 * 4;
constexpr size_t WS_KMEM = WS_MB + (size_t)MROWS * D * 2;
constexpr size_t WS_VMEMT = WS_KMEM + (size_t)MROWS * 1024 * 2;
constexpr size_t WS_HB = WS_VMEMT + (size_t)1024 * MROWS * 2;
constexpr size_t WS_R = WS_HB + (size_t)M * D * 2;
constexpr size_t WS_QB = WS_R, WS_KB = WS_QB + (size_t)M * AW * 2, WS_VB = WS_KB + (size_t)M * KVW * 2, WS_UT = WS_VB + (size_t)M * KVW * 2;
constexpr size_t WS_MIXED = WS_UT;
constexpr size_t WS_AB = WS_UT + (size_t)M * C3 * 2, WS_YT = WS_AB + (size_t)M * AW * 2, WS_KSPEC = WS_YT + (size_t)M * HYW * 2, WS_MIXEND = WS_KSPEC + (size_t)2 * 2 * HYW * 16384 * 4;
constexpr size_t WS_XQB = WS_R, WS_XOB = WS_XQB + (size_t)M * XW * 2;
constexpr size_t WS_ACT = WS_R;
constexpr size_t WS_XG = WS_R;
constexpr size_t WS_MACT = WS_XG + (size_t)MOE_MAX_ROWS * D * 2;
constexpr size_t WS_MOEEND = WS_MACT + (size_t)MOE_ACT_TILES * 256 * FFE * 2;
constexpr size_t cmax(size_t a, size_t b) { return a > b ? a : b; }
constexpr size_t WS_END = cmax(cmax(WS_MIXEND, WS_ACT + (size_t)M * FF * 2), WS_MOEEND);
static_assert(WS_END <= (size_t)1073741824, "workspace map exceeds 1 GiB");
static_assert(WS_ACT + (size_t)M * FF * 2 <= WS_KSPEC && WS_XOB + (size_t)M * XW * 2 <= WS_KSPEC, "layer 0's later phases must not touch the filter spectra");
constexpr int CW_TMO = 0, CW_CODE = 1, CW_BAR = 4096;

constexpr int PHASE_LDS = 139264;
constexpr int LDSCTL_OFF = PHASE_LDS, MISC_OFF = LDSCTL_OFF + 64;
constexpr int LDS_BYTES = PHASE_LDS + 512;

#define GAS __attribute__((address_space(1)))
#define LAS __attribute__((address_space(3)))
typedef unsigned short bf16;
typedef unsigned v4u __attribute__((ext_vector_type(4)));
typedef unsigned v2u __attribute__((ext_vector_type(2)));
typedef float f32x4 __attribute__((ext_vector_type(4)));
typedef short bf16x8 __attribute__((ext_vector_type(8)));
typedef short s16x4 __attribute__((ext_vector_type(4)));
typedef GAS unsigned gu32;
#define RLX_AGENT __ATOMIC_RELAXED, __HIP_MEMORY_SCOPE_AGENT
#define LDS_WAIT() asm volatile("s_waitcnt lgkmcnt(0)" ::: "memory")
#define VM_WAIT() asm volatile("s_waitcnt vmcnt(0)" ::: "memory")
__device__ __forceinline__ unsigned f2bf(float f) { unsigned u = __builtin_bit_cast(unsigned, f); return (u + 0x7fffu + ((u >> 16) & 1u)) >> 16; }
__device__ __forceinline__ unsigned pk2(float lo, float hi) { return cvtpk_hw(lo, hi); }
__device__ __forceinline__ float bflo(unsigned w) { return __builtin_bit_cast(float, w << 16); }
__device__ __forceinline__ float bfhi(unsigned w) { return __builtin_bit_cast(float, w & 0xffff0000u); }
__device__ __forceinline__ float bf1(unsigned short h) { return __builtin_bit_cast(float, ((unsigned)h) << 16); }
#define XB_TMO      128
#define XB_XCNT(j)  (256  + 64 * (j))
#define XB_XSUB(j)  (1280 + 64 * (j))
#define XB_XGEN(j)  (2304 + 64 * (j))
#define XB_TOP      3328
#define XB_TOPGEN   3392
#define XCD_BAR_WORDS 3456
#define XB_SPIN_CAP (1u << 22)

__device__ __forceinline__ unsigned xb_ld(unsigned* p)              { return __hip_atomic_load(p, __ATOMIC_RELAXED, __HIP_MEMORY_SCOPE_AGENT); }
__device__ __forceinline__ unsigned xb_add(unsigned* p, unsigned v) { return __hip_atomic_fetch_add(p, v, __ATOMIC_RELAXED, __HIP_MEMORY_SCOPE_AGENT); }
__device__ __forceinline__ unsigned xb_xcc_id() { return (unsigned)__builtin_amdgcn_s_getreg((3 << 11) | 20) & 0xFu; }
#define XB_SPIN(cond, bar) do { unsigned _sp = 0; while (cond) { __builtin_amdgcn_s_sleep(1); \
    if ((++_sp & 255u) == 0u) { if (xb_ld(&(bar)[XB_TMO])) break; if (_sp > XB_SPIN_CAP) { atomicAdd(&(bar)[XB_TMO], 1u); break; } } } } while (0)

struct XcdBarrier {
    unsigned* bar; unsigned x;
    volatile LAS unsigned* st;
};

__device__ __forceinline__ XcdBarrier xcd_barrier_post(unsigned* bar, volatile LAS unsigned* st) {
    XcdBarrier b; b.bar = bar; b.x = xb_xcc_id(); b.st = st;
    if (threadIdx.x == 0) (void)xb_add(&bar[XB_XCNT(b.x)], 1u);
    return b;
}
__device__ __forceinline__ void xcd_barrier_complete(unsigned* bar, unsigned x, unsigned& nloc, unsigned& nx) {
    const unsigned G = gridDim.x * gridDim.y * gridDim.z;
    unsigned sum, cnt, mine, sp = 0u;
    for (;;) {
        sum = 0u; cnt = 0u; mine = 0u;
#pragma unroll
        for (unsigned j = 0; j < 16; ++j) { const unsigned c = xb_ld(&bar[XB_XCNT(j)]); sum += c; cnt += (c > 0u) ? 1u : 0u; mine = (j == x) ? c : mine; }
        if (sum == G) break;
        __builtin_amdgcn_s_sleep(1);
        if ((++sp & 255u) == 0u) { if (xb_ld(&bar[XB_TMO])) break; if (sp > XB_SPIN_CAP) { atomicAdd(&bar[XB_TMO], 1u); break; } }
    }
    nloc = mine > 0u ? mine : 1u; nx = cnt > 0u ? cnt : 1u;
}

__device__ __forceinline__ void xcd_barrier(const XcdBarrier& b) {
    asm volatile("s_waitcnt vmcnt(0)" ::: "memory");
    __syncthreads();
    if (threadIdx.x == 0) {
        unsigned* bar = b.bar;
        __builtin_amdgcn_s_waitcnt(0);
        unsigned nloc = b.st[0], nx = b.st[1];
        if (nloc == 0u) { xcd_barrier_complete(bar, b.x, nloc, nx); b.st[0] = nloc; b.st[1] = nx; }
        const unsigned old = xb_add(&bar[XB_XSUB(b.x)], 1u);
        const unsigned gen = old / nloc;
        if (old + 1u == (gen + 1u) * nloc) {
            __builtin_amdgcn_fence(__ATOMIC_RELEASE, "agent");
            asm volatile("s_waitcnt vmcnt(0)" ::: "memory");
            const unsigned og = xb_add(&bar[XB_TOP], 1u);
            const unsigned tg = og / nx;
            if (og + 1u == (tg + 1u) * nx) xb_add(&bar[XB_TOPGEN], 1u);
            else XB_SPIN(xb_ld(&bar[XB_TOPGEN]) == tg, bar);
            __builtin_amdgcn_fence(__ATOMIC_ACQUIRE, "agent");
            xb_add(&bar[XB_XGEN(b.x)], 1u);
            asm volatile("s_waitcnt vmcnt(0)" ::: "memory");
        } else {
            XB_SPIN(xb_ld(&bar[XB_XGEN(b.x)]) == gen, bar);
            __builtin_amdgcn_fence(__ATOMIC_ACQUIRE, "agent");
            asm volatile("s_waitcnt vmcnt(0)" ::: "memory");
        }
    }
    __syncthreads();
}
struct Args { const float* in[33]; float* out; unsigned char* ws; int ph_lo, ph_hi, use_bar, pad; };
enum InIdx { I_X = 0, I_MEM, I_MEMNORM, I_MIXNORM, I_WIN, I_SINK, I_CONVW, I_CONVB, I_FW1, I_FB1, I_FFR1, I_FW2, I_FB2, I_FFR2, I_FW3, I_SKIP, I_ANORM, I_YNORM, I_WOUT, I_XNORM,
             I_XWQ, I_XWK, I_XWV, I_XWO, I_FNORM, I_FGATE, I_FUP, I_FDOWN, I_ROUTER, I_MGATE, I_MUP, I_MDOWN, I_FINAL };

__device__ __forceinline__ float wave_sum(float v) {
#pragma unroll
    for (int o = 1; o < 64; o <<= 1) v += __shfl_xor(v, o);
    return v;
}
__device__ __forceinline__ void wg_sync() { __builtin_amdgcn_sched_barrier(0); asm volatile("s_waitcnt vmcnt(0) lgkmcnt(0)" ::: "memory"); __builtin_amdgcn_s_barrier(); asm volatile("" ::: "memory"); __builtin_amdgcn_sched_barrier(0); }

template <int MODE> __device__ __forceinline__ int rowmap(int n) {
    if (MODE == 1) return n < 640 ? ((n & ~63) + 8 * ((n & 31) >> 2) + (n & 3) + 4 * ((n >> 5) & 1)) : n;
    if (MODE == 2) return 8 * (n >> 2) + (n & 3);
    if (MODE == 3) return 8 * (n >> 2) + 4 + (n & 3);
    return n;
}
__device__ __forceinline__ int rowmap_rt(int mode, int n) { return mode == 1 ? rowmap<1>(n) : mode == 2 ? rowmap<2>(n) : mode == 3 ? rowmap<3>(n) : n; }
__device__ __forceinline__ void tr_item(const float* W, int ldw, int K, int col0, int ncols, bf16* WT, int mode, const float* gk, int item, LAS float* scr, int lane) {
    const int nblk = ncols / 32, kb = item / nblk, nb = item % nblk, k0 = 64 * kb, n0 = 32 * nb;
    f32x4 tv[8];
#pragma unroll
    for (int i = 0; i < 8; ++i) { const int kk = 8 * i + (lane >> 3); tv[i] = *(const f32x4*)(W + (size_t)(k0 + kk) * ldw + col0 + n0 + 4 * (lane & 7)); }
#pragma unroll
    for (int i = 0; i < 8; ++i) { const int kk = 8 * i + (lane >> 3); const float gv = gk ? gk[k0 + kk] : 1.0f; LAS float* d = scr + kk * 33 + 4 * (lane & 7);
        d[0] = gv * tv[i][0]; d[1] = gv * tv[i][1]; d[2] = gv * tv[i][2]; d[3] = gv * tv[i][3]; }
    LDS_WAIT(); asm volatile("" ::: "memory");
    const int c = lane & 7;
#pragma unroll
    for (int j = 0; j < 4; ++j) { const int n = (lane >> 3) + 8 * j; const LAS float* sp = scr + (8 * c) * 33 + n;
        v4u o; o.x = pk2(sp[0 * 33], sp[1 * 33]); o.y = pk2(sp[2 * 33], sp[3 * 33]); o.z = pk2(sp[4 * 33], sp[5 * 33]); o.w = pk2(sp[6 * 33], sp[7 * 33]);
        *(v4u*)(WT + (size_t)rowmap_rt(mode, n0 + n) * K + k0 + 8 * c) = o; }
    LDS_WAIT(); asm volatile("" ::: "memory");
}
__device__ __forceinline__ void rms_row(const float* xrow, const float* gain, int lane, f32x4 (&v)[4]) {
    const f32x4* xr = (const f32x4*)xrow + lane; float s = 0.f;
#pragma unroll
    for (int j = 0; j < 4; ++j) { v[j] = xr[64 * j]; s += (v[j].x * v[j].x + v[j].y * v[j].y) + (v[j].z * v[j].z + v[j].w * v[j].w); }
    const float rs = 1.0f / sqrtf(wave_sum(s) * (1.f / 1024.f) + EPS);
    const f32x4* gr = (const f32x4*)gain + lane;
#pragma unroll
    for (int j = 0; j < 4; ++j) v[j] = v[j] * rs * gr[64 * j];
}
__device__ __forceinline__ void store_row_bf16(bf16* orow, int lane, const f32x4 (&v)[4]) {
    unsigned long long* o8 = (unsigned long long*)orow + lane;
#pragma unroll
    for (int j = 0; j < 4; ++j) o8[64 * j] = (unsigned long long)pk2(v[j].x, v[j].y) | ((unsigned long long)pk2(v[j].z, v[j].w) << 32);
}
__device__ __forceinline__ void xb_rows(const float* x, bf16* o, float* ss, int nrows, int gw, int NGW, int lane) {
#pragma unroll 1
    for (int r0 = gw; r0 < nrows; r0 += 2 * NGW) {
        const int r1 = r0 + NGW; const bool on1 = r1 < nrows; const int r1c = on1 ? r1 : r0;
        const f32x4* xa = (const f32x4*)(x + (size_t)r0 * D) + lane; const f32x4* xc = (const f32x4*)(x + (size_t)r1c * D) + lane; f32x4 va[4], vc[4];
#pragma unroll
        for (int j = 0; j < 4; ++j) { va[j] = xa[64 * j]; vc[j] = xc[64 * j]; }
        float sa = 0.f, sc = 0.f;
#pragma unroll
        for (int j = 0; j < 4; ++j) { sa += (va[j].x * va[j].x + va[j].y * va[j].y) + (va[j].z * va[j].z + va[j].w * va[j].w); sc += (vc[j].x * vc[j].x + vc[j].y * vc[j].y) + (vc[j].z * vc[j].z + vc[j].w * vc[j].w); }
        sa = wave_sum(sa); sc = wave_sum(sc);
        store_row_bf16(o + (size_t)r0 * D, lane, va); if (lane < 16) ss[(size_t)r0 * 16 + lane] = lane == 0 ? sa : 0.f;
        if (on1) { store_row_bf16(o + (size_t)r1 * D, lane, vc); if (lane < 16) ss[(size_t)r1 * 16 + lane] = lane == 0 ? sc : 0.f; }
    }
}
__device__ __forceinline__ void norm_rows(const float* x, const float* gain, bf16* o, int nrows, int gw, int NGW, int lane) {
    for (int r = gw; r < nrows; r += NGW) { f32x4 v[4]; rms_row(x + (size_t)r * D, gain, lane, v); store_row_bf16(o + (size_t)r * D, lane, v); }
}

constexpr int BA_KS = 72, BA_VS = 408, BA_KROWS = 400;
constexpr int BA_K_BYTES = BA_KROWS * BA_KS * 2, BA_V_BYTES = 64 * BA_VS * 2;
static_assert(BA_K_BYTES % 16 == 0 && BA_K_BYTES + BA_V_BYTES <= PHASE_LDS, "band attention LDS");
__device__ __forceinline__ bf16x8 cat4(s16x4 a, s16x4 b) { return __builtin_shufflevector(a, b, 0, 1, 2, 3, 4, 5, 6, 7); }
__device__ __forceinline__ unsigned cvtpk(float lo, float hi) { unsigned r; asm volatile("v_cvt_pk_bf16_f32 %0, %1, %2" : "=v"(r) : "v"(lo), "v"(hi)); return r; }

__device__ __forceinline__ void band_attention_phase(LAS unsigned char* lds, const bf16* Q, const bf16* Kb, const bf16* Vb, bf16* Ao, const float* sink, int G) {
    const int tid = opq_tid(), lane = tid & 63, wave = __builtin_amdgcn_readfirstlane(tid >> 6), fr = lane & 15, fq = lane >> 4;
    LAS bf16* Ks = (LAS bf16*)lds; LAS bf16* VTs = (LAS bf16*)(lds + BA_K_BYTES);
    for (int unit = blockIdx.x; unit < NB * 32 * NKV; unit += G) {
        const int kh = unit & 1, ib = (unit >> 1) & 31, b = unit >> 6;
        const int kbase = 128 * (ib - 1);
        for (int c = tid; c < BA_KROWS * 8; c += NTHR) { const int row = c >> 3, c8 = c & 7, kpos = kbase + row;
            v4u val = (v4u){0u, 0u, 0u, 0u};
            if (row < 384 && kpos >= 0 && kpos < SEQ) val = *(const v4u*)(Kb + ((size_t)(b * SEQ + kpos)) * KVW + kh * 64 + c8 * 8);
            *(LAS v4u*)(Ks + row * BA_KS + c8 * 8) = val; }
        for (int c = tid; c < BA_KROWS * 8; c += NTHR) { const int c8 = c / BA_KROWS, key = c % BA_KROWS, kpos = kbase + key;
            v4u val = (v4u){0u, 0u, 0u, 0u};
            if (key < 384 && kpos >= 0 && kpos < SEQ) val = *(const v4u*)(Vb + ((size_t)(b * SEQ + kpos)) * KVW + kh * 64 + c8 * 8);
            LAS bf16* dst = VTs + (c8 * 8) * BA_VS + key;
            dst[0 * BA_VS] = (bf16)(val.x & 0xffffu); dst[1 * BA_VS] = (bf16)(val.x >> 16); dst[2 * BA_VS] = (bf16)(val.y & 0xffffu); dst[3 * BA_VS] = (bf16)(val.y >> 16);
            dst[4 * BA_VS] = (bf16)(val.z & 0xffffu); dst[5 * BA_VS] = (bf16)(val.z >> 16); dst[6 * BA_VS] = (bf16)(val.w & 0xffffu); dst[7 * BA_VS] = (bf16)(val.w >> 16); }
        wg_sync();
        const int g = wave >> 1, half = wave & 1, head = kh * 4 + g;
        const float snk = sink[head];
        bf16x8 qn[2];
        { const size_t t0 = (size_t)b * SEQ + 128 * ib + 64 * half;
#pragma unroll
          for (int ks = 0; ks < 2; ++ks) qn[ks] = *(const bf16x8*)(Q + (t0 + fr) * AW + head * 64 + 32 * ks + 8 * fq); }
#pragma unroll 1
        for (int qt = 0; qt < 4; ++qt) {
            const int p0 = 64 * half + 16 * qt;
            const size_t t0 = (size_t)b * SEQ + 128 * ib + p0;
            bf16x8 qf[2]; qf[0] = qn[0]; qf[1] = qn[1];
            if (qt < 3) {
#pragma unroll
                for (int ks = 0; ks < 2; ++ks) qn[ks] = *(const bf16x8*)(Q + (t0 + 16 + fr) * AW + head * 64 + 32 * ks + 8 * fq); }
            f32x4 s[18];
            const LAS bf16* kbase_p = Ks + (p0 + fr) * BA_KS + 8 * fq;
            bf16x8 kfa[3][2], kfb[3][2];
#pragma unroll
            for (int jj = 0; jj < 3; ++jj)
#pragma unroll
                for (int ks = 0; ks < 2; ++ks) kfa[jj][ks] = *(const LAS bf16x8*)(kbase_p + (16 * jj) * BA_KS + 32 * ks);
#pragma unroll
            for (int gq = 0; gq < 6; ++gq) {
                if (gq < 5) {
#pragma unroll
                    for (int jj = 0; jj < 3; ++jj)
#pragma unroll
                        for (int ks = 0; ks < 2; ++ks) { const bf16x8 t = *(const LAS bf16x8*)(kbase_p + (16 * (3 * (gq + 1) + jj)) * BA_KS + 32 * ks); if (gq & 1) kfa[jj][ks] = t; else kfb[jj][ks] = t; } }
                __builtin_amdgcn_sched_barrier(0);
#pragma unroll
                for (int jj = 0; jj < 3; ++jj) { const int j = 3 * gq + jj; s[j] = (f32x4){0.f, 0.f, 0.f, 0.f};
#pragma unroll
                    for (int ks = 0; ks < 2; ++ks) s[j] = __builtin_amdgcn_mfma_f32_16x16x32_bf16((gq & 1) ? kfb[jj][ks] : kfa[jj][ks], qf[ks], s[j], 0, 0, 0); }
                __builtin_amdgcn_sched_barrier(0);
            }
            float mx = -1e30f;
#pragma unroll
            for (int j = 0; j < 18; ++j)
#pragma unroll
                for (int r = 0; r < 4; ++r) { const int rel = 16 * j + 4 * fq + r - fr, idx = p0 + 16 * j + 4 * fq + r;
                    const bool ok = rel >= 0 && rel <= 256 && (ib > 0 || idx >= 128) && (ib < 31 || idx < 256);
                    const float v = ok ? s[j][r] * 0.125f : -1e30f; s[j][r] = v; mx = fmaxf(mx, v); }
            mx = fmaxf(mx, __shfl_xor(mx, 16)); mx = fmaxf(mx, __shfl_xor(mx, 32)); mx = fmaxf(mx, snk);
            float l = 0.f;
#pragma unroll
            for (int j = 0; j < 18; ++j)
#pragma unroll
                for (int r = 0; r < 4; ++r) { const float p = __expf(s[j][r] - mx); s[j][r] = p; l += p; }
            l += __shfl_xor(l, 16); l += __shfl_xor(l, 32); l += __expf(snk - mx);
            const float inv = 1.0f / l;
            f32x4 o[4];
#pragma unroll
            for (int dt = 0; dt < 4; ++dt) o[dt] = (f32x4){0.f, 0.f, 0.f, 0.f};
            const LAS bf16* vbase_p = VTs + fr * BA_VS + p0 + 4 * fq;
            s16x4 va[4][2], vb[4][2];
#pragma unroll
            for (int dt = 0; dt < 4; ++dt) { va[dt][0] = *(const LAS s16x4*)(vbase_p + (16 * dt) * BA_VS); va[dt][1] = *(const LAS s16x4*)(vbase_p + (16 * dt) * BA_VS + 16); }
#pragma unroll
            for (int kk = 0; kk < 9; ++kk) {
                if (kk < 8) {
#pragma unroll
                    for (int dt = 0; dt < 4; ++dt) { const s16x4 t0_ = *(const LAS s16x4*)(vbase_p + (16 * dt) * BA_VS + 32 * (kk + 1)), t1_ = *(const LAS s16x4*)(vbase_p + (16 * dt) * BA_VS + 32 * (kk + 1) + 16);
                        if (kk & 1) { va[dt][0] = t0_; va[dt][1] = t1_; } else { vb[dt][0] = t0_; vb[dt][1] = t1_; } } }
                v4u pw; pw.x = cvtpk(s[2 * kk][0], s[2 * kk][1]); pw.y = cvtpk(s[2 * kk][2], s[2 * kk][3]); pw.z = cvtpk(s[2 * kk + 1][0], s[2 * kk + 1][1]); pw.w = cvtpk(s[2 * kk + 1][2], s[2 * kk + 1][3]);
                const bf16x8 pf = __builtin_bit_cast(bf16x8, pw);
                __builtin_amdgcn_sched_barrier(0);
#pragma unroll
                for (int dt = 0; dt < 4; ++dt) { const bf16x8 vf = (kk & 1) ? cat4(vb[dt][0], vb[dt][1]) : cat4(va[dt][0], va[dt][1]);
                    o[dt] = __builtin_amdgcn_mfma_f32_16x16x32_bf16(vf, pf, o[dt], 0, 0, 0); }
                __builtin_amdgcn_sched_barrier(0);
            }
#pragma unroll
            for (int dt = 0; dt < 4; ++dt) { const f32x4 ov = o[dt] * inv; v2u w; w.x = cvtpk(ov[0], ov[1]); w.y = cvtpk(ov[2], ov[3]);
                *(v2u*)(Ao + (t0 + fr) * AW + head * 64 + 16 * dt + 4 * fq) = w; }
        }
        wg_sync();
    }
}

constexpr int XA_KS = 136, XA_VS = 264;
constexpr int XA_K_BYTES = MEML * XA_KS * 2, XA_V_BYTES = XHD * XA_VS * 2;
static_assert(XA_K_BYTES % 16 == 0 && XA_K_BYTES + XA_V_BYTES <= PHASE_LDS, "cross attention LDS");
__device__ __forceinline__ void cross_attention_phase(LAS unsigned char* lds, const bf16* Qx, const bf16* Kmem, const bf16* VmemT, bf16* Ox, int layer, int G) {
    const int tid = opq_tid(), lane = tid & 63, wave = __builtin_amdgcn_readfirstlane(tid >> 6), fr = lane & 15, fq = lane >> 4;
    LAS bf16* Ks = (LAS bf16*)lds; LAS bf16* VTs = (LAS bf16*)(lds + XA_K_BYTES);
    for (int unit = blockIdx.x; unit < 256; unit += G) {
        const int quarter = unit & 3, head = (unit >> 2) & 3, b = unit >> 4;
        for (int c = tid; c < MEML * 16; c += NTHR) { const int key = c >> 4, c8 = c & 15;
            *(LAS v4u*)(Ks + key * XA_KS + c8 * 8) = *(const v4u*)(Kmem + (size_t)(b * MEML + key) * 1024 + layer * 512 + head * 128 + c8 * 8); }
        for (int c = tid; c < XHD * 32; c += NTHR) { const int d = c >> 5, c8 = c & 31;
            *(LAS v4u*)(VTs + d * XA_VS + c8 * 8) = *(const v4u*)(VmemT + (size_t)(layer * 512 + head * 128 + d) * MROWS + b * MEML + c8 * 8); }
        wg_sync();
        bf16x8 qn[4];
        { const size_t t0 = (size_t)b * SEQ + (quarter * 4) * 256 + wave * 32;
#pragma unroll
          for (int ks = 0; ks < 4; ++ks) qn[ks] = *(const bf16x8*)(Qx + (t0 + fr) * XW + head * 128 + 32 * ks + 8 * fq); }
#pragma unroll 1
        for (int qi = 0; qi < 8; ++qi) {
            const size_t t0 = (size_t)b * SEQ + (quarter * 4 + (qi >> 1)) * 256 + wave * 32 + 16 * (qi & 1);
            bf16x8 qf[4];
#pragma unroll
            for (int ks = 0; ks < 4; ++ks) qf[ks] = qn[ks];
            if (qi < 7) { const size_t t1 = (size_t)b * SEQ + (quarter * 4 + ((qi + 1) >> 1)) * 256 + wave * 32 + 16 * ((qi + 1) & 1);
#pragma unroll
                for (int ks = 0; ks < 4; ++ks) qn[ks] = *(const bf16x8*)(Qx + (t1 + fr) * XW + head * 128 + 32 * ks + 8 * fq); }
            f32x4 s[16];
            const LAS bf16* kbase_p = Ks + fr * XA_KS + 8 * fq;
            bf16x8 kfa[2][4], kfb[2][4];
#pragma unroll
            for (int jj = 0; jj < 2; ++jj)
#pragma unroll
                for (int ks = 0; ks < 4; ++ks) kfa[jj][ks] = *(const LAS bf16x8*)(kbase_p + (16 * jj) * XA_KS + 32 * ks);
#pragma unroll
            for (int gq = 0; gq < 8; ++gq) {
                if (gq < 7) {
#pragma unroll
                    for (int jj = 0; jj < 2; ++jj)
#pragma unroll
                        for (int ks = 0; ks < 4; ++ks) { const bf16x8 t = *(const LAS bf16x8*)(kbase_p + (16 * (2 * (gq + 1) + jj)) * XA_KS + 32 * ks); if (gq & 1) kfa[jj][ks] = t; else kfb[jj][ks] = t; } }
                __builtin_amdgcn_sched_barrier(0);
#pragma unroll
                for (int jj = 0; jj < 2; ++jj) { const int j = 2 * gq + jj; s[j] = (f32x4){0.f, 0.f, 0.f, 0.f};
#pragma unroll
                    for (int ks = 0; ks < 4; ++ks) s[j] = __builtin_amdgcn_mfma_f32_16x16x32_bf16((gq & 1) ? kfb[jj][ks] : kfa[jj][ks], qf[ks], s[j], 0, 0, 0); }
                __builtin_amdgcn_sched_barrier(0);
            }
            float mx = -1e30f;
#pragma unroll
            for (int j = 0; j < 16; ++j)
#pragma unroll
                for (int r = 0; r < 4; ++r) { const float v = s[j][r] * 0.08838834764831845f; s[j][r] = v; mx = fmaxf(mx, v); }
            mx = fmaxf(mx, __shfl_xor(mx, 16)); mx = fmaxf(mx, __shfl_xor(mx, 32));
            float l = 0.f;
#pragma unroll
            for (int j = 0; j < 16; ++j)
#pragma unroll
                for (int r = 0; r < 4; ++r) { const float p = __expf(s[j][r] - mx); s[j][r] = p; l += p; }
            l += __shfl_xor(l, 16); l += __shfl_xor(l, 32);
            const float inv = 1.0f / l;
            f32x4 o[8];
#pragma unroll
            for (int dt = 0; dt < 8; ++dt) o[dt] = (f32x4){0.f, 0.f, 0.f, 0.f};
            const LAS bf16* vbase_p = VTs + fr * XA_VS + 4 * fq;
            s16x4 va[8][2], vb[8][2];
#pragma unroll
            for (int dt = 0; dt < 8; ++dt) { va[dt][0] = *(const LAS s16x4*)(vbase_p + (16 * dt) * XA_VS); va[dt][1] = *(const LAS s16x4*)(vbase_p + (16 * dt) * XA_VS + 16); }
#pragma unroll
            for (int kk = 0; kk < 8; ++kk) {
                if (kk < 7) {
#pragma unroll
                    for (int dt = 0; dt < 8; ++dt) { const s16x4 t0_ = *(const LAS s16x4*)(vbase_p + (16 * dt) * XA_VS + 32 * (kk + 1)), t1_ = *(const LAS s16x4*)(vbase_p + (16 * dt) * XA_VS + 32 * (kk + 1) + 16);
                        if (kk & 1) { va[dt][0] = t0_; va[dt][1] = t1_; } else { vb[dt][0] = t0_; vb[dt][1] = t1_; } } }
                v4u pw; pw.x = cvtpk(s[2 * kk][0], s[2 * kk][1]); pw.y = cvtpk(s[2 * kk][2], s[2 * kk][3]); pw.z = cvtpk(s[2 * kk + 1][0], s[2 * kk + 1][1]); pw.w = cvtpk(s[2 * kk + 1][2], s[2 * kk + 1][3]);
                const bf16x8 pf = __builtin_bit_cast(bf16x8, pw);
                __builtin_amdgcn_sched_barrier(0);
#pragma unroll
                for (int dt = 0; dt < 8; ++dt) { const bf16x8 vf = (kk & 1) ? cat4(vb[dt][0], vb[dt][1]) : cat4(va[dt][0], va[dt][1]);
                    o[dt] = __builtin_amdgcn_mfma_f32_16x16x32_bf16(vf, pf, o[dt], 0, 0, 0); }
                __builtin_amdgcn_sched_barrier(0);
            }
#pragma unroll
            for (int dt = 0; dt < 8; ++dt) { const f32x4 ov = o[dt] * inv; v2u w; w.x = cvtpk(ov[0], ov[1]); w.y = cvtpk(ov[2], ov[3]);
                *(v2u*)(Ox + (t0 + fr) * XW + head * 128 + 16 * dt + 4 * fq) = w; }
        }
        wg_sync();
    }
}
constexpr float HY_MIN_DECAY = -3.0701134573253944f;
constexpr float HY_MAX_DECAY = -15.350567286626972f;
__device__ __forceinline__ void h2_rows(const Args& a, float* H2, int gw, int NGW, int lane) {
    for (int idx = gw; idx < 2 * SEQ; idx += NGW) {
        const int l = idx >> 12, j = idx & 4095;
        const float* w1 = a.in[I_FW1] + l * 33 * 64; const float* b1 = a.in[I_FB1] + l * 64; const float* fr1 = a.in[I_FFR1] + l * 64;
        const float* w2 = a.in[I_FW2] + l * 64 * 64; const float* b2 = a.in[I_FB2] + l * 64; const float* fr2 = a.in[I_FFR2] + l * 64;
        const float w = 6.283185307179586f * (float)j / 4096.0f;
        const int mm = (lane - 1) & 15; const float f = 1e-4f + (float)mm * ((15.0f - 1e-4f) / 15.0f); const float ang = f * w;
        float zq = lane == 0 ? (float)j / 4095.0f : (lane <= 16 ? cosf(ang) : -sinf(ang));
        float acc = b1[lane];
#pragma unroll
        for (int q = 0; q < 33; ++q) acc += __shfl(zq, q) * w1[q * 64 + lane];
        const float h1 = sinf(fr1[lane] * acc);
        acc = b2[lane];
#pragma unroll
        for (int q = 0; q < 64; ++q) acc += __shfl(h1, q) * w2[q * 64 + lane];
        H2[(size_t)idx * 64 + lane] = sinf(fr2[lane] * acc);
    }
}
__device__ __forceinline__ void kfilt_phase(LAS unsigned char* lds, const float* H2, const float* w3all, float* KF, int G) {
    LAS float* ws = (LAS float*)lds;
    const int tid = opq_tid(), jj = tid & 63, cg = __builtin_amdgcn_readfirstlane(tid >> 6);
    for (int unit = blockIdx.x; unit < 2 * 64 * 32; unit += G) {
        const int cb = unit & 31, jb = (unit >> 5) & 63, l = unit >> 11;
        const float* w3 = w3all + (size_t)l * 64 * 2048;
        for (int e = tid; e < 4096; e += NTHR) ws[e] = w3[(size_t)(e >> 6) * 2048 + cb * 64 + (e & 63)];
        wg_sync();
        const int j = jb * 64 + jj;
        const f32x4* hr = (const f32x4*)(H2 + ((size_t)l * SEQ + j) * 64);
        float acc[8];
#pragma unroll
        for (int e = 0; e < 8; ++e) acc[e] = 0.f;
#pragma unroll
        for (int q = 0; q < 16; ++q) { const f32x4 hv = hr[q];
#pragma unroll
            for (int i = 0; i < 4; ++i) { const LAS f32x4* wp = (const LAS f32x4*)(ws + (4 * q + i) * 64 + cg * 8); const f32x4 wa = wp[0], wb = wp[1];
                acc[0] += hv[i] * wa[0]; acc[1] += hv[i] * wa[1]; acc[2] += hv[i] * wa[2]; acc[3] += hv[i] * wa[3];
                acc[4] += hv[i] * wb[0]; acc[5] += hv[i] * wb[1]; acc[6] += hv[i] * wb[2]; acc[7] += hv[i] * wb[3]; } }
        const float tj = (float)j / 4095.0f;
#pragma unroll
        for (int e = 0; e < 8; ++e) { const int col = cb * 64 + cg * 8 + e, dir = col >> 10, oc = col & 1023;
            const float delta = HY_MIN_DECAY + (float)oc * ((HY_MAX_DECAY - HY_MIN_DECAY) / 1023.0f);
            float val = acc[e] * expf(-tj * fabsf(delta));
            int n = dir == 0 ? j : 8192 - j;
            if (dir == 1 && j == 0) { n = 4096; val = 0.f; }
            KF[((size_t)(l * 1024 + oc)) * 8192 + n] = val; }
        wg_sync();
    }
}

constexpr int HY_RAWS = 4112;
constexpr int HY_RAW_OFF = FFT_WORK * 8;
static_assert(HY_RAW_OFF % 16 == 0 && HY_RAW_OFF + 6 * HY_RAWS * 2 <= PHASE_LDS && 4096 * 8 <= 4 * HY_RAWS * 2, "hyena LDS: work buffer | v rows (2) | x1 rows (2) | x2 rows (2); the gated signal (4096 complex f32) overlays the v and x1 rows");
typedef float f32x2v __attribute__((ext_vector_type(2)));
struct LdsCf { LAS f32x2v* p; __device__ __forceinline__ cf ld(int i) const { const f32x2v t = p[i]; return mk(t.x, t.y); } __device__ __forceinline__ void st(int i, cf v) const { p[i] = (f32x2v){v.x, v.y}; } };

__device__ __forceinline__ void hy_stage_rows(LAS bf16* raw, const bf16* UT, int b0, int ch, int tid) {
#pragma unroll
    for (int i = 0; i < 2; ++i) { const int q = tid + NTHR * i, row = q >> 9, cc = q & 511;
        *(LAS v4u*)(raw + row * HY_RAWS + 8 + cc * 8) = *(const v4u*)(UT + (((size_t)((b0 + row) * C3 + ch)) << 12) + cc * 8); }
    if (tid < 2) { raw[tid * HY_RAWS + 7] = 0; raw[tid * HY_RAWS + 8 + 4096] = 0; }
}
__device__ __forceinline__ float hy_conv(const LAS bf16* ldsh, int e, float w0, float w1, float w2, float bias) {
    return w0 * bf1(ldsh[e - 1]) + w1 * bf1(ldsh[e]) + w2 * bf1(ldsh[e + 1]) + bias;
}
__device__ __forceinline__ int opqi(int v) { asm volatile("" : "+v"(v)); return v; }
template <class T> __device__ __forceinline__ T* opqp(T* p) { asm volatile("" : "+v"(p)); return p; }
__device__ __forceinline__ cf opq(cf w) { asm volatile("" : "+v"(w.x), "+v"(w.y)); return w; }
__device__ __forceinline__ cf csel(bool c, cf a, cf b) { return mk(c ? a.x : b.x, c ? a.y : b.y); }
__device__ __forceinline__ float uni(float v) { return __builtin_bit_cast(float, __builtin_amdgcn_readfirstlane(__builtin_bit_cast(int, v))); }
__device__ __forceinline__ void wave_lds_fence() { __builtin_amdgcn_sched_barrier(0); asm volatile("s_waitcnt lgkmcnt(0)" ::: "memory"); __builtin_amdgcn_sched_barrier(0); }
__device__ __forceinline__ cf shfl_cf(cf v) { return mk(__shfl_xor(v.x, 32), __shfl_xor(v.y, 32)); }

__device__ __forceinline__ void kspec_phase(LAS unsigned char* lds, const float* KF, float* KSP, int G) {
    const int tid = opq_tid();
    LdsCf W; W.p = (LAS f32x2v*)lds;
    int h1, j1, h2, k1, j2, h3, blk; geo1(tid, h1, j1); geo2(tid, h2, k1, j2); geo3(tid, h3, blk);
    const int fb1 = opqi(fbase1(h1, j1)), fb2 = opqi(fbase2(h2, k1, j2)), fb3 = opqi(fbase3(h3, blk)), jo = opqi(j1);
    float sv, cv;
    sincospif(-(float)j1 / 4096.0f, &sv, &cv); const cf w8192j = mk(cv, sv);
    sincospif(-(float)j1 / 2048.0f, &sv, &cv); const cf w4096j = mk(cv, sv);
    sincospif(-(float)j2 / 128.0f, &sv, &cv);  const cf w256j = mk(cv, sv);
    const cf w32 = mk(0.98078528040323043f, -0.19509032201612825f);
#pragma unroll 1
    for (int unit = blockIdx.x; unit < 2 * 2 * HYW; unit += G) {
        const float* kf = KF + (size_t)unit * 8192;
        cf x[16]; cf wp = opq(w8192j);
#pragma unroll
        for (int m = 0; m < 16; ++m) { const float* kp = kf + opqi(jo + 1024 * (m >> 2)); const float ka = kp[256 * (m & 3)]; const float* kq = kp + opqi(4096); const float kb = kq[256 * (m & 3)];
            x[m] = csel(h1 == 0, mk(ka + kb, 0.f), cscale(wp, ka - kb)); wp = cmul(wp, w32); }
        fwd_pass1(W, fb1, opq(w4096j), x); wg_sync();
        fwd_pass2(W, fb2, opq(w256j)); wave_lds_fence();
        { cf kk[16]; fwd_pass3_keep(W, fb3, kk); f32x4* kd = opqp((f32x4*)(KSP + (size_t)unit * 16384 + tid * 32));
#pragma unroll
          for (int q = 0; q < 8; ++q) kd[q] = (f32x4){kk[2 * q].x, kk[2 * q].y, kk[2 * q + 1].x, kk[2 * q + 1].y}; }
        wg_sync();
    }
}
__device__ __forceinline__ void mid_pass3g(LdsCf lds, int b3, const f32x4* Kp) {
    f32x4 kv[8];
#pragma unroll
    for (int q = 0; q < 8; ++q) kv[q] = Kp[q];
    cf x[16];
#pragma unroll
    for (int m = 0; m < 16; ++m) x[m] = lds.ld(b3 + m);
    dft16<false>(x);
#pragma unroll
    for (int q = 0; q < 8; ++q) { x[2 * q] = cmul(x[2 * q], mk(kv[q][0], kv[q][1])); x[2 * q + 1] = cmul(x[2 * q + 1], mk(kv[q][2], kv[q][3])); }
    dft16<true>(x);
#pragma unroll
    for (int m = 0; m < 16; ++m) lds.st(b3 + m, x[m]);
}
__device__ __forceinline__ void hyena_phase(LAS unsigned char* lds, const Args& a, int layer, const bf16* UT, const float* KSP, bf16* YT, int G) {
    const int tid = opq_tid();
    LdsCf W; W.p = (LAS f32x2v*)lds;
    LAS bf16* raw = (LAS bf16*)(lds + HY_RAW_OFF);
    int h1, j1, h2, k1, j2, h3, blk; geo1(tid, h1, j1); geo2(tid, h2, k1, j2); geo3(tid, h3, blk);
    const int fb1 = opqi(fbase1(h1, j1)), fb2 = opqi(fbase2(h2, k1, j2)), fb3 = opqi(fbase3(h3, blk));
    const int jo = opqi(j1), jh = opqi(j1 + 2048 * h1);
    LdsCf ZB; ZB.p = (LAS f32x2v*)lds; const int zo = opqi(HY_RAW_OFF / 8 + j1), zh = opqi(HY_RAW_OFF / 8 + j1 + 2048 * h1);
    const LAS bf16* ldsh = (const LAS bf16*)lds; const int ro = opqi(HY_RAW_OFF / 2 + 8 + j1), rh = opqi(HY_RAW_OFF / 2 + 8 + j1 + 2048 * h1);
    float sv, cv;
    sincospif(-(float)j1 / 4096.0f, &sv, &cv); const cf w8192j = mk(cv, sv);
    sincospif(-(float)j1 / 2048.0f, &sv, &cv); const cf w4096j = mk(cv, sv);
    sincospif(-(float)j2 / 128.0f, &sv, &cv);  const cf w256j = mk(cv, sv);
    const cf w32 = mk(0.98078528040323043f, -0.19509032201612825f);
    const float* cw = a.in[I_CONVW] + layer * 3 * C3; const float* cbv = a.in[I_CONVB] + layer * C3; const float* skp = a.in[I_SKIP] + layer * 2 * HYW;
    for (int c = blockIdx.x; c < HYW; c += G) {
        const float x1w0 = uni(cw[c]), x1w1 = uni(cw[C3 + c]), x1w2 = uni(cw[2 * C3 + c]), x1b = uni(cbv[c]);
        const float x2w0 = uni(cw[512 + c]), x2w1 = uni(cw[C3 + 512 + c]), x2w2 = uni(cw[2 * C3 + 512 + c]), x2b = uni(cbv[512 + c]);
        const float vw0 = uni(cw[1024 + c]), vw1 = uni(cw[C3 + 1024 + c]), vw2 = uni(cw[2 * C3 + 1024 + c]), vb = uni(cbv[1024 + c]);
        const float skip0 = uni(skp[c]), skip1 = uni(skp[HYW + c]);
        const float* KS0 = KSP + ((size_t)((layer * 2 + 0) * HYW + c)) * 16384 + tid * 32;
        const float* KS1 = KSP + ((size_t)((layer * 2 + 1) * HYW + c)) * 16384 + tid * 32;
#pragma unroll 1
        for (int pr = 0; pr < 8; ++pr) {
            const int b0 = 2 * pr;
            hy_stage_rows(raw, UT, b0, 1024 + c, tid);
            hy_stage_rows(raw + 2 * HY_RAWS, UT, b0, c, tid);
            hy_stage_rows(raw + 4 * HY_RAWS, UT, b0, 512 + c, tid);
            wg_sync();
            cf x[16];
            { cf wp = opq(w8192j);
#pragma unroll
              for (int m = 0; m < 16; ++m) {
                  const cf z = mk(hy_conv(ldsh, ro + 256 * m, vw0, vw1, vw2, vb), hy_conv(ldsh, ro + 256 * m + HY_RAWS, vw0, vw1, vw2, vb));
                  x[m] = csel(h1 == 0, z, cmul(z, wp)); wp = cmul(wp, w32); } }
            fwd_pass1(W, fb1, opq(w4096j), x); wg_sync();
            fwd_pass2(W, fb2, opq(w256j)); wave_lds_fence();
            mid_pass3g(W, fb3, opqp((const f32x4*)KS0)); wave_lds_fence();
            inv_pass2(W, fb2, opq(w256j)); wg_sync();
            inv_pass1(W, fb1, opq(w4096j), x);
            cf zz[8];
            { cf wp = opq(w8192j);
#pragma unroll
              for (int m = 0; m < 16; ++m) { x[m] = csel(h1 == 1, cmulc(x[m], wp), x[m]); wp = cmul(wp, w32); }
#pragma unroll
              for (int i = 0; i < 8; ++i) { const cf xa_ = x[i], xb_ = x[8 + i]; const cf mine = csel(h1 == 1, xb_, xa_), send = csel(h1 == 1, xa_, xb_); const cf r = cscale(cadd(mine, shfl_cf(send)), 1.0f / 8192.0f);
                  const float va = hy_conv(ldsh, rh + 256 * i, vw0, vw1, vw2, vb), vbb = hy_conv(ldsh, rh + 256 * i + HY_RAWS, vw0, vw1, vw2, vb);
                  const float xa = hy_conv(ldsh, rh + 256 * i + 2 * HY_RAWS, x1w0, x1w1, x1w2, x1b), xb = hy_conv(ldsh, rh + 256 * i + 3 * HY_RAWS, x1w0, x1w1, x1w2, x1b);
                  zz[i] = mk(xa * (r.x + skip0 * va), xb * (r.y + skip0 * vbb)); } }
            wg_sync();
#pragma unroll
            for (int i = 0; i < 8; ++i) ZB.st(zh + 256 * i, zz[i]);
            wg_sync();
            { cf wp = opq(w8192j);
#pragma unroll
              for (int m = 0; m < 16; ++m) { const cf full = ZB.ld(zo + 256 * m); x[m] = csel(h1 == 0, full, cmul(full, wp)); wp = cmul(wp, w32); } }
            fwd_pass1(W, fb1, opq(w4096j), x); wg_sync();
            fwd_pass2(W, fb2, opq(w256j)); wave_lds_fence();
            mid_pass3g(W, fb3, opqp((const f32x4*)KS1)); wave_lds_fence();
            inv_pass2(W, fb2, opq(w256j)); wg_sync();
            inv_pass1(W, fb1, opq(w4096j), x);
            { cf wp = opq(w8192j);
#pragma unroll
              for (int m = 0; m < 16; ++m) { x[m] = csel(h1 == 1, cmulc(x[m], wp), x[m]); wp = cmul(wp, w32); }
#pragma unroll
              for (int i = 0; i < 8; ++i) { const cf xa_ = x[i], xb_ = x[8 + i]; const cf mine = csel(h1 == 1, xb_, xa_), send = csel(h1 == 1, xa_, xb_); const cf r = cscale(cadd(mine, shfl_cf(send)), 1.0f / 8192.0f);
                  const int p = jh + 256 * i; const cf zv = ZB.ld(zh + 256 * i);
                  const float xa = hy_conv(ldsh, rh + 256 * i + 4 * HY_RAWS, x2w0, x2w1, x2w2, x2b), xb = hy_conv(ldsh, rh + 256 * i + 5 * HY_RAWS, x2w0, x2w1, x2w2, x2b);
                  const float ya = xa * (r.x + skip1 * zv.x), yb = xb * (r.y + skip1 * zv.y);
                  YT[(((size_t)(b0 * HYW + c)) << 12) + p] = (bf16)f2bf(ya);
                  YT[(((size_t)((b0 + 1) * HYW + c)) << 12) + p] = (bf16)f2bf(yb); } }
            wg_sync();
        }
    }
}
constexpr int MN_STRIDE = 66;
static_assert(HYW * MN_STRIDE * 2 <= PHASE_LDS, "mix-norm LDS");
__device__ __forceinline__ void mixnorm_phase(LAS unsigned char* lds, const bf16* Ab, const bf16* YT, const float* ga, const float* gy, bf16* mixed, int G) {
    const int tid = opq_tid(), lane = tid & 63, wave = __builtin_amdgcn_readfirstlane(tid >> 6);
    LAS unsigned* tile32 = (LAS unsigned*)lds; const LAS bf16* tile16 = (const LAS bf16*)lds;
    f32x4 gav[2], gyv[2];
    gav[0] = *(const f32x4*)(ga + lane * 8); gav[1] = *(const f32x4*)(ga + lane * 8 + 4); gyv[0] = *(const f32x4*)(gy + lane * 8); gyv[1] = *(const f32x4*)(gy + lane * 8 + 4);
    v4u R[8];
    int unit = blockIdx.x;
    if (unit < M / 64) { const bf16* src = YT + (((size_t)((unit >> 6) * HYW + tid)) << 12) + (unit & 63) * 64;
#pragma unroll
        for (int q = 0; q < 8; ++q) R[q] = *(const v4u*)(src + 8 * q); }
#pragma unroll 1
    for (; unit < M / 64; unit += G) {
        const int b = unit >> 6, t0 = (unit & 63) * 64;
#pragma unroll
        for (int q = 0; q < 8; ++q) { LAS unsigned* d = tile32 + tid * (MN_STRIDE / 2) + 4 * q; d[0] = R[q].x; d[1] = R[q].y; d[2] = R[q].z; d[3] = R[q].w; }
        wg_sync();
        const int nu = unit + G;
        if (nu < M / 64) { const bf16* src = YT + (((size_t)((nu >> 6) * HYW + tid)) << 12) + (nu & 63) * 64;
#pragma unroll
            for (int q = 0; q < 8; ++q) R[q] = *(const v4u*)(src + 8 * q); }
        const size_t row0 = (size_t)b * SEQ + t0 + wave * 8;
        v4u av[8];
#pragma unroll
        for (int i = 0; i < 8; ++i) av[i] = *(const v4u*)(Ab + (row0 + i) * AW + lane * 8);
#pragma unroll
        for (int i = 0; i < 8; ++i) { const int tt = wave * 8 + i;
            float y[8]; float ss = 0.f;
#pragma unroll
            for (int e = 0; e < 8; ++e) { y[e] = bf1(tile16[(lane * 8 + e) * MN_STRIDE + tt]); ss += y[e] * y[e]; }
            const float rs = __builtin_amdgcn_rsqf(wave_sum(ss) * (1.f / 512.f) + EPS);
            v4u o; o.x = pk2(y[0] * rs * gyv[0][0], y[1] * rs * gyv[0][1]); o.y = pk2(y[2] * rs * gyv[0][2], y[3] * rs * gyv[0][3]);
            o.z = pk2(y[4] * rs * gyv[1][0], y[5] * rs * gyv[1][1]); o.w = pk2(y[6] * rs * gyv[1][2], y[7] * rs * gyv[1][3]);
            *(v4u*)(mixed + (row0 + i) * D + 512 + lane * 8) = o; }
#pragma unroll
        for (int i = 0; i < 8; ++i) {
            const float x[8] = {bflo(av[i].x), bfhi(av[i].x), bflo(av[i].y), bfhi(av[i].y), bflo(av[i].z), bfhi(av[i].z), bflo(av[i].w), bfhi(av[i].w)};
            float ss = 0.f;
#pragma unroll
            for (int e = 0; e < 8; ++e) ss += x[e] * x[e];
            const float rs = __builtin_amdgcn_rsqf(wave_sum(ss) * (1.f / 512.f) + EPS);
            v4u o; o.x = pk2(x[0] * rs * gav[0][0], x[1] * rs * gav[0][1]); o.y = pk2(x[2] * rs * gav[0][2], x[3] * rs * gav[0][3]);
            o.z = pk2(x[4] * rs * gav[1][0], x[5] * rs * gav[1][1]); o.w = pk2(x[6] * rs * gav[1][2], x[7] * rs * gav[1][3]);
            *(v4u*)(mixed + (row0 + i) * D + lane * 8) = o; }
        wg_sync();
    }
}

__device__ __forceinline__ void moe_norm_router_phase(LAS unsigned char* lds, const bf16* xb, const float* gain, const float* wr, float* rsrow, int* toke, float* tokw, int* wgcnt, int G) {
    const int tid = opq_tid(), lane = tid & 63, wave = __builtin_amdgcn_readfirstlane(tid >> 6);
    LAS int* cnt = (LAS int*)lds;
    if (tid < 8) cnt[tid] = 0;
    wg_sync();
    const int TPW = M / G;
    f32x4 wra[4][4], wrb[4][4];
#pragma unroll
    for (int j = 0; j < 4; ++j) { const f32x4 gv = *(const f32x4*)(gain + 4 * lane + 256 * j);
#pragma unroll
        for (int q = 0; q < 4; ++q) { const int k = 4 * lane + q + 256 * j; wra[j][q] = *(const f32x4*)(wr + k * 8) * gv[q]; wrb[j][q] = *(const f32x4*)(wr + k * 8 + 4) * gv[q]; } }
    v2u nx[4];
    { const v2u* xr = (const v2u*)(xb + (size_t)(blockIdx.x * TPW + wave) * D) + lane;
#pragma unroll
      for (int j = 0; j < 4; ++j) nx[j] = xr[64 * j]; }
#pragma unroll 1
    for (int i = wave; i < TPW; i += NWAVES) {
        const int t = blockIdx.x * TPW + i;
        v2u cu[4];
#pragma unroll
        for (int j = 0; j < 4; ++j) cu[j] = nx[j];
        if (i + NWAVES < TPW) { const v2u* xr = (const v2u*)(xb + (size_t)(t + NWAVES) * D) + lane;
#pragma unroll
            for (int j = 0; j < 4; ++j) nx[j] = xr[64 * j]; }
        f32x4 v[4]; float s = 0.f;
#pragma unroll
        for (int j = 0; j < 4; ++j) { const v2u a = cu[j]; v[j] = (f32x4){bflo(a.x), bfhi(a.x), bflo(a.y), bfhi(a.y)}; s += (v[j].x * v[j].x + v[j].y * v[j].y) + (v[j].z * v[j].z + v[j].w * v[j].w); }
        const float rs = 1.0f / sqrtf(wave_sum(s) * (1.f / 1024.f) + EPS);
        float lg[8];
#pragma unroll
        for (int e = 0; e < 8; ++e) lg[e] = 0.f;
#pragma unroll
        for (int j = 0; j < 4; ++j)
#pragma unroll
            for (int q = 0; q < 4; ++q) { const f32x4 wa = wra[j][q], wb = wrb[j][q]; const float hv = v[j][q];
                lg[0] += hv * wa[0]; lg[1] += hv * wa[1]; lg[2] += hv * wa[2]; lg[3] += hv * wa[3]; lg[4] += hv * wb[0]; lg[5] += hv * wb[1]; lg[6] += hv * wb[2]; lg[7] += hv * wb[3]; }
        { const bool b5 = lane & 32, b4 = lane & 16, b3 = lane & 8; float k4[4], k2[2], k1;
#pragma unroll
          for (int i = 0; i < 4; ++i) { const float send = b5 ? lg[i] : lg[4 + i], keep = b5 ? lg[4 + i] : lg[i]; k4[i] = keep + __shfl_xor(send, 32); }
#pragma unroll
          for (int i = 0; i < 2; ++i) { const float send = b4 ? k4[i] : k4[2 + i], keep = b4 ? k4[2 + i] : k4[i]; k2[i] = keep + __shfl_xor(send, 16); }
          { const float send = b3 ? k2[0] : k2[1], keep = b3 ? k2[1] : k2[0]; k1 = keep + __shfl_xor(send, 8); }
          k1 += __shfl_xor(k1, 4); k1 += __shfl_xor(k1, 2); k1 += __shfl_xor(k1, 1);
#pragma unroll
          for (int e = 0; e < 8; ++e) lg[e] = __builtin_bit_cast(float, __builtin_amdgcn_readlane(__builtin_bit_cast(int, k1), 8 * e)) * rs; }
        int i0 = 0; float v0 = lg[0];
#pragma unroll
        for (int e = 1; e < 8; ++e) if (lg[e] > v0) { v0 = lg[e]; i0 = e; }
        int i1 = -1; float v1 = -3.0e38f;
#pragma unroll
        for (int e = 0; e < 8; ++e) if (e != i0 && lg[e] > v1) { v1 = lg[e]; i1 = e; }
        const float e1 = __expf(v1 - v0), w0 = 1.0f / (1.0f + e1), w1 = e1 * w0;
        if (lane == 0) { toke[2 * t] = i0; toke[2 * t + 1] = i1; tokw[2 * t] = w0; tokw[2 * t + 1] = w1; rsrow[t] = rs; __hip_atomic_fetch_add(cnt + i0, 1, __ATOMIC_RELAXED, __HIP_MEMORY_SCOPE_WORKGROUP); __hip_atomic_fetch_add(cnt + i1, 1, __ATOMIC_RELAXED, __HIP_MEMORY_SCOPE_WORKGROUP); }
    }
    wg_sync();
    if (tid < 8) wgcnt[blockIdx.x * 8 + tid] = cnt[tid];
    wg_sync();
}
__device__ __forceinline__ void moe_slot_phase(LAS unsigned char* lds, const int* toke, const int* wgcnt, int* tokp, int* rowtok, int* tilee, int* meta, int G) {
    const int tid = opq_tid(), lane = tid & 63, wave = __builtin_amdgcn_readfirstlane(tid >> 6);
    LAS int* arr = (LAS int*)lds;
    LAS int* pre = arr + 1024 * 8;
    LAS int* wcnt = pre + 32;
    for (int i = tid; i < G * 8; i += NTHR) arr[i] = wgcnt[i];
    wg_sync();
    if (tid < 8) { int p = 0, tot = 0; for (int w = 0; w < G; ++w) { const int c = arr[w * 8 + tid]; if (w < (int)blockIdx.x) p += c; tot += c; } pre[tid] = p; pre[8 + tid] = tot; }
    wg_sync();
    if (tid == 0) { int ps = 0; for (int e = 0; e < 8; ++e) { pre[16 + e] = ps; ps += ((pre[8 + e] + 255) >> 8) << 8; } pre[24] = ps; }
    wg_sync();
    const int TPW = M / G;
    int e_mine = -1, t = 0, rank = 0;
    if (tid < 2 * TPW) { t = blockIdx.x * TPW + (tid >> 1); e_mine = toke[2 * t + (tid & 1)]; }
#pragma unroll
    for (int e = 0; e < 8; ++e) { const unsigned long long mk_ = __ballot(e_mine == e); if (e_mine == e) rank = __popcll(mk_ & ((1ull << lane) - 1ull)); if (lane == 0) wcnt[wave * 8 + e] = __popcll(mk_); }
    wg_sync();
    if (e_mine >= 0) { int base = pre[16 + e_mine] + pre[e_mine]; for (int w = 0; w < wave; ++w) base += wcnt[w * 8 + e_mine];
        const int slot = base + rank; rowtok[slot] = t; tokp[2 * t + (tid & 1)] = slot; }
    if ((int)blockIdx.x < 8) { const int e = blockIdx.x, s0 = pre[16 + e] + pre[8 + e], s1 = pre[16 + e] + (((pre[8 + e] + 255) >> 8) << 8);
        for (int s = s0 + tid; s < s1; s += NTHR) rowtok[s] = 0; }
    if (blockIdx.x == 0) { const int ntiles = pre[24] >> 8;
        for (int ti = tid; ti < ntiles; ti += NTHR) { int e = 0;
#pragma unroll
            for (int q = 1; q < 8; ++q) if (ti * 256 >= pre[16 + q]) e = q;
            tilee[ti] = e; }
        if (tid == 0) meta[0] = ntiles; }
    wg_sync();
}
__device__ __forceinline__ void moe_gather_phase(const bf16* xb, const float* rsrow, const float* gain, const int* rowtok, bf16* XG, int nrows, int gw, int NGW, int lane) {
    f32x4 g[4];
#pragma unroll
    for (int q = 0; q < 4; ++q) g[q] = *(const f32x4*)(gain + (q >> 1) * 512 + 8 * lane + 4 * (q & 1));
    for (int r = gw; r < nrows; r += NGW) { const int t = rowtok[r]; const float rs = rsrow[t]; const v4u* src = (const v4u*)(xb + (size_t)t * D); v4u* dst = (v4u*)(XG + (size_t)r * D);
#pragma unroll
        for (int h = 0; h < 2; ++h) { const v4u a = src[64 * h + lane]; v4u o;
            o.x = pk2(bflo(a.x) * rs * g[2 * h][0], bfhi(a.x) * rs * g[2 * h][1]); o.y = pk2(bflo(a.y) * rs * g[2 * h][2], bfhi(a.y) * rs * g[2 * h][3]);
            o.z = pk2(bflo(a.z) * rs * g[2 * h + 1][0], bfhi(a.z) * rs * g[2 * h + 1][1]); o.w = pk2(bflo(a.w) * rs * g[2 * h + 1][2], bfhi(a.w) * rs * g[2 * h + 1][3]);
            dst[64 * h + lane] = o; } }
}
__device__ __forceinline__ void moe_combine_final_phase(const bf16* xb, float* out, const bf16* YB, const int* tokp, const float* tokw, const float* gain, int gw, int NGW, int lane) {
    f32x4 g[4];
#pragma unroll
    for (int q = 0; q < 4; ++q) g[q] = *(const f32x4*)(gain + (q >> 1) * 512 + 8 * lane + 4 * (q & 1));
#pragma unroll 1
    for (int t0 = gw; t0 < M; t0 += 2 * NGW) {
        v4u xa[2][2], ya[2][2], yb[2][2]; float w0[2], w1[2]; bool on[2];
#pragma unroll
        for (int u = 0; u < 2; ++u) { const int t = t0 + u * NGW; on[u] = t < M; const int tt = on[u] ? t : t0;
            const int p0 = tokp[2 * tt], p1 = tokp[2 * tt + 1]; w0[u] = tokw[2 * tt]; w1[u] = tokw[2 * tt + 1];
            const v4u* xr = (const v4u*)(xb + (size_t)tt * D) + lane; const v4u* y0 = (const v4u*)(YB + (size_t)p0 * D) + lane; const v4u* y1 = (const v4u*)(YB + (size_t)p1 * D) + lane;
#pragma unroll
            for (int h = 0; h < 2; ++h) { xa[u][h] = xr[64 * h]; ya[u][h] = y0[64 * h]; yb[u][h] = y1[64 * h]; } }
#pragma unroll
        for (int u = 0; u < 2; ++u) { const int t = t0 + u * NGW; float v[2][8]; float s = 0.f;
#pragma unroll
            for (int h = 0; h < 2; ++h) { const unsigned xw[4] = {xa[u][h].x, xa[u][h].y, xa[u][h].z, xa[u][h].w}, aw[4] = {ya[u][h].x, ya[u][h].y, ya[u][h].z, ya[u][h].w}, bw[4] = {yb[u][h].x, yb[u][h].y, yb[u][h].z, yb[u][h].w};
#pragma unroll
                for (int q = 0; q < 4; ++q) { v[h][2 * q] = bflo(xw[q]) + w0[u] * bflo(aw[q]) + w1[u] * bflo(bw[q]); v[h][2 * q + 1] = bfhi(xw[q]) + w0[u] * bfhi(aw[q]) + w1[u] * bfhi(bw[q]);
                    s += v[h][2 * q] * v[h][2 * q] + v[h][2 * q + 1] * v[h][2 * q + 1]; } }
            const float rs = 1.0f / sqrtf(wave_sum(s) * (1.f / 1024.f) + EPS);
            if (on[u]) { f32x4* orow = (f32x4*)(out + (size_t)t * D);
#pragma unroll
                for (int h = 0; h < 2; ++h) { orow[128 * h + 2 * lane] = (f32x4){v[h][0], v[h][1], v[h][2], v[h][3]} * rs * g[2 * h]; orow[128 * h + 2 * lane + 1] = (f32x4){v[h][4], v[h][5], v[h][6], v[h][7]} * rs * g[2 * h + 1]; } } }
    }
}
struct MoeOrder : pg8::StaticOrder {
    const int* tilee; int tile0; size_t bstride;
    __device__ __forceinline__ size_t boff(const pg8::Unit& u) const { return (size_t)tilee[tile0 + u.pm] * bstride; }
};
#ifndef LB_WAVES
#define LB_WAVES 2
#endif
__global__ void __launch_bounds__(NTHR, LB_WAVES) fwd_kernel(Args args) {
    extern __shared__ __attribute__((aligned(16))) unsigned char lds_raw[];
    LAS unsigned char* lds = (LAS unsigned char*)lds_raw;
    const int tid0 = threadIdx.x;
    const int G = gridDim.x, NGW = G * NWAVES;
    unsigned char* ws = args.ws;
    gu32* ctl = (gu32*)(ws + WS_CTL);
    volatile LAS unsigned* MISC = (volatile LAS unsigned*)(lds + MISC_OFF);
    for (int u = tid0; u < (LDS_BYTES - LDSCTL_OFF) / 4; u += NTHR) ((LAS unsigned*)(lds + LDSCTL_OFF))[u] = 0u;
    __syncthreads();
    XcdBarrier bar; bar.bar = (unsigned*)(ctl + CW_BAR); bar.x = 0; bar.st = nullptr;
    if (args.use_bar) bar = xcd_barrier_post((unsigned*)(ctl + CW_BAR), MISC + 8);
    const int lo = args.ph_lo, hi = args.ph_hi;
    int ph = 0;
#ifndef PHMASK
#define PHMASK 0xffffffffu
#endif
#define EN(k) (((PHMASK) >> (k)) & 1u)
#define PH_ON() (ph >= lo && ph < hi)
#define LOCAL_IDS() const int tid = opq_tid(), lane = tid & 63, wave = __builtin_amdgcn_readfirstlane(tid >> 6), gw = blockIdx.x * NWAVES + wave; (void)lane; (void)gw
#ifndef DUPMASK
#define DUPMASK 0u
#endif
#define RES_DST(k) ((NREP(k) > 1 && rep_ + 1 < NREP(k)) ? (bf16*)args.out : HB)
#ifndef DUPN
#define DUPN 2
#endif
#define NREP(k) ((((DUPMASK) >> (k)) & 1u) ? DUPN : 1)
#define PH_END_K(k) do { if (args.use_bar && (ph + 1 < hi || rep_ + 1 < NREP(k))) xcd_barrier(bar); } while (0)

    float* cosT = (float*)(ws + WS_COS); float* sinT = (float*)(ws + WS_SIN); float* H2 = (float*)(ws + WS_H2);
    int* toke = (int*)(ws + WS_TOKE); float* tokw = (float*)(ws + WS_TOKW); int* tokp = (int*)(ws + WS_TOKP); int* rowtok = (int*)(ws + WS_ROWTOK);
    int* tilee = (int*)(ws + WS_TILEE); int* wgcnt = (int*)(ws + WS_WGCNT); int* meta = (int*)(ws + WS_META); float* rsrow = (float*)(ws + WS_RSROW);
    bf16* WINA = (bf16*)(ws + WS_WINA); bf16* WINB = (bf16*)(ws + WS_WINB); bf16* WOUT = (bf16*)(ws + WS_WOUT); bf16* XQ = (bf16*)(ws + WS_XQ); bf16* XK = (bf16*)(ws + WS_XK);
    bf16* XV = (bf16*)(ws + WS_XV); bf16* XO = (bf16*)(ws + WS_XO); bf16* FGU = (bf16*)(ws + WS_FGU); bf16* FDN = (bf16*)(ws + WS_FDN); bf16* MGU = (bf16*)(ws + WS_MGU); bf16* MDN = (bf16*)(ws + WS_MDN);
    float* KF = (float*)(ws + WS_KFILT); bf16* MB = (bf16*)(ws + WS_MB); bf16* KMEM = (bf16*)(ws + WS_KMEM); bf16* VMEMT = (bf16*)(ws + WS_VMEMT); bf16* HB = (bf16*)(ws + WS_HB);
    bf16* QB = (bf16*)(ws + WS_QB); bf16* KB = (bf16*)(ws + WS_KB); bf16* VB = (bf16*)(ws + WS_VB); bf16* UT = (bf16*)(ws + WS_UT); bf16* AB = (bf16*)(ws + WS_AB); bf16* YT = (bf16*)(ws + WS_YT);
    bf16* MIXED = (bf16*)(ws + WS_MIXED); float* SS = (float*)(ws + WS_SS);
    bf16* XQB = (bf16*)(ws + WS_XQB); bf16* XOB = (bf16*)(ws + WS_XOB); bf16* ACT = (bf16*)(ws + WS_ACT); bf16* XG = (bf16*)(ws + WS_XG); bf16* MACT = (bf16*)(ws + WS_MACT);
    const float* const* in = args.in;

    if (EN(0) && PH_ON()) for (int rep_ = 0; rep_ < NREP(0); ++rep_) { asm volatile("; PHASE_MARK 0"); LOCAL_IDS();
        LAS float* scr = (LAS float*)(lds + wave * 8704);
        constexpr int IT_L = 384 + 768 + 512 + 4 * 256, IT_D = 3 * 1408, IT_E = 3 * 1792, IT_ALL = 2 * IT_L + IT_D + NE * IT_E;
#pragma unroll 1
        for (int it = gw; it < IT_ALL; it += NGW) {
            const float* W; int ldw, K, col0 = 0, ncols, mode = 0; bf16* WT; const float* gk = nullptr; int r = it;
            if (r < 2 * IT_L) { const int l = r / IT_L; r -= l * IT_L;
                if (r < 384) { W = in[I_WIN] + (size_t)l * D * INC; ldw = INC; K = D; ncols = 768; WT = WINA + (size_t)l * 768 * D; mode = 1; gk = in[I_MIXNORM] + l * D; }
                else if ((r -= 384) < 768) { W = in[I_WIN] + (size_t)l * D * INC; ldw = INC; K = D; col0 = 768; ncols = C3; WT = WINB + (size_t)l * C3 * D; gk = in[I_MIXNORM] + l * D; }
                else if ((r -= 768) < 512) { W = in[I_WOUT] + (size_t)l * D * D; ldw = D; K = D; ncols = D; WT = WOUT + (size_t)l * D * D; }
                else if ((r -= 512) < 256) { W = in[I_XWQ] + (size_t)l * D * XW; ldw = XW; K = D; ncols = XW; WT = XQ + (size_t)l * XW * D; gk = in[I_XNORM] + l * D; }
                else if ((r -= 256) < 256) { W = in[I_XWK] + (size_t)l * D * XW; ldw = XW; K = D; ncols = XW; WT = XK + (size_t)l * XW * D; }
                else if ((r -= 256) < 256) { W = in[I_XWV] + (size_t)l * D * XW; ldw = XW; K = D; ncols = XW; WT = XV + (size_t)l * XW * D; }
                else { r -= 256; W = in[I_XWO] + (size_t)l * XW * D; ldw = D; K = XW; ncols = D; WT = XO + (size_t)l * D * XW; }
            } else if ((r -= 2 * IT_L) < IT_D) {
                if (r < 1408) { W = in[I_FGATE]; ldw = FF; K = D; ncols = FF; WT = FGU; mode = 2; gk = in[I_FNORM]; }
                else if ((r -= 1408) < 1408) { W = in[I_FUP]; ldw = FF; K = D; ncols = FF; WT = FGU; mode = 3; gk = in[I_FNORM]; }
                else { r -= 1408; W = in[I_FDOWN]; ldw = D; K = FF; ncols = D; WT = FDN; }
            } else { r -= IT_D; const int e = r / IT_E; r -= e * IT_E;
                if (r < 1792) { W = in[I_MGATE] + (size_t)e * D * FFE; ldw = FFE; K = D; ncols = FFE; WT = MGU + (size_t)e * 2 * FFE * D; mode = 2; }
                else if ((r -= 1792) < 1792) { W = in[I_MUP] + (size_t)e * D * FFE; ldw = FFE; K = D; ncols = FFE; WT = MGU + (size_t)e * 2 * FFE * D; mode = 3; }
                else { r -= 1792; W = in[I_MDOWN] + (size_t)e * FFE * D; ldw = D; K = FFE; ncols = D; WT = MDN + (size_t)e * D * FFE; }
            }
            tr_item(W, ldw, K, col0, ncols, WT, mode, gk, r, scr, lane);
        }
        for (int i = blockIdx.x * NTHR + tid; i < SEQ * 32; i += G * NTHR) { const int pos = i >> 5, f = i & 31;
            const float inv = (float)pow(10000.0, -(double)f / 32.0); const float ang = (float)pos * inv;
            cosT[i] = (float)cos((double)ang); sinT[i] = (float)sin((double)ang); }
        h2_rows(args, H2, gw, NGW, lane);
        norm_rows(in[I_MEM], in[I_MEMNORM], MB, MROWS, gw, NGW, lane);
        xb_rows(in[I_X], HB, SS, M, gw, NGW, lane);
        PH_END_K(0);
    }
    ++ph;
    if (EN(1) && PH_ON()) for (int rep_ = 0; rep_ < NREP(1); ++rep_) { asm volatile("; PHASE_MARK 1"); LOCAL_IDS();
        kfilt_phase(lds, H2, in[I_FW3], KF, G);
        PH_END_K(1);
    }
    ++ph;

#pragma unroll 1
    for (int l = 0; l < 2; ++l) {
        if (EN(2) && PH_ON()) for (int rep_ = 0; rep_ < NREP(2); ++rep_) { asm volatile("; PHASE_MARK 2"); LOCAL_IDS();
            if (l == 0) {
                kspec_phase(lds, KF, (float*)(ws + WS_KSPEC), G);
                { pg8::Gemm g{MB, XK, MROWS, 1024, D}; pg8::StaticOrder S; S.init(MROWS, 1024, G, (int)blockIdx.x); pg8::EpiBf16 E{KMEM, 1024, nullptr};
                  pg8::gemm_phase<pg8::EpiBf16, pg8::StaticOrder, PG8_ALIGN, PG8_SP2>(lds, g, S, E); }
                { pg8::Gemm g{MB, XV, MROWS, 1024, D}; pg8::StaticOrder S; S.init(MROWS, 1024, G, G >= 128 ? (int)((blockIdx.x + G - 64) % G) : (int)blockIdx.x); pg8::EpiT E{VMEMT, 1024, 12, nullptr};
                  pg8::gemm_phase<pg8::EpiT, pg8::StaticOrder, PG8_ALIGN, PG8_SP2>(lds, g, S, E); }
            }
            { pg8::Gemm g{HB, WINA + (size_t)l * 768 * D, M, 768, D}; pg8::StaticOrder S; S.init(M, 768, G, (int)blockIdx.x); pg8::EpiQKV E{QB, KB, VB, cosT, sinT, SS + (size_t)(3 * l) * SS_STRIDE};
              pg8::gemm_phase<pg8::EpiQKV, pg8::StaticOrder, PG8_ALIGN, PG8_SP2>(lds, g, S, E); }
            { pg8::Gemm g{HB, WINB + (size_t)l * C3 * D, M, C3, D}; pg8::StaticOrder S; S.init(M, C3, G, (int)blockIdx.x); pg8::EpiT E{UT, C3, 12, SS + (size_t)(3 * l) * SS_STRIDE};
              pg8::gemm_phase<pg8::EpiT, pg8::StaticOrder, PG8_ALIGN, PG8_SP2>(lds, g, S, E); }
            PH_END_K(2);
        }
        ++ph;
        if (EN(3) && PH_ON()) for (int rep_ = 0; rep_ < NREP(3); ++rep_) { asm volatile("; PHASE_MARK 3"); LOCAL_IDS();
#ifndef BA_REP
#define BA_REP 1
#endif
#ifndef HY_REP
#define HY_REP 1
#endif
#pragma unroll 1
            for (int r_ = 0; r_ < BA_REP; ++r_) band_attention_phase(lds, QB, KB, VB, AB, in[I_SINK] + l * NH, G);
#pragma unroll 1
            for (int r_ = 0; r_ < HY_REP; ++r_) hyena_phase(lds, args, l, UT, (const float*)(ws + WS_KSPEC), YT, G);
            PH_END_K(3);
        }
        ++ph;
        if (EN(4) && PH_ON()) for (int rep_ = 0; rep_ < NREP(4); ++rep_) { asm volatile("; PHASE_MARK 4"); LOCAL_IDS(); mixnorm_phase(lds, AB, YT, in[I_ANORM] + l * AW, in[I_YNORM] + l * HYW, MIXED, G); PH_END_K(4); }
        ++ph;
        if (EN(5) && PH_ON()) for (int rep_ = 0; rep_ < NREP(5); ++rep_) { asm volatile("; PHASE_MARK 5"); LOCAL_IDS();
            pg8::Gemm g{MIXED, WOUT + (size_t)l * D * D, M, D, D}; pg8::StaticOrder S; S.init(M, D, G, (int)blockIdx.x); pg8::EpiResB E{HB, D, SS + (size_t)(3 * l + 1) * SS_STRIDE, RES_DST(5)};
            pg8::gemm_phase<pg8::EpiResB, pg8::StaticOrder, PG8_ALIGN, PG8_SP2>(lds, g, S, E);
            PH_END_K(5);
        }
        ++ph;
        if (EN(7) && PH_ON()) for (int rep_ = 0; rep_ < NREP(7); ++rep_) { asm volatile("; PHASE_MARK 7"); LOCAL_IDS();
            pg8::Gemm g{HB, XQ + (size_t)l * XW * D, M, XW, D}; pg8::StaticOrder S; S.init(M, XW, G, (int)blockIdx.x); pg8::EpiBf16 E{XQB, XW, SS + (size_t)(3 * l + 1) * SS_STRIDE};
            pg8::gemm_phase<pg8::EpiBf16, pg8::StaticOrder, PG8_ALIGN, PG8_SP2>(lds, g, S, E);
            PH_END_K(7);
        }
        ++ph;
        if (EN(8) && PH_ON()) for (int rep_ = 0; rep_ < NREP(8); ++rep_) { asm volatile("; PHASE_MARK 8"); LOCAL_IDS(); cross_attention_phase(lds, XQB, KMEM, VMEMT, XOB, l, G); PH_END_K(8); }
        ++ph;
        if (EN(9) && PH_ON()) for (int rep_ = 0; rep_ < NREP(9); ++rep_) { asm volatile("; PHASE_MARK 9"); LOCAL_IDS();
            pg8::Gemm g{XOB, XO + (size_t)l * D * XW, M, D, XW}; pg8::StaticOrder S; S.init(M, D, G, (int)blockIdx.x); pg8::EpiResB E{HB, D, l == 0 ? SS + (size_t)2 * SS_STRIDE : nullptr, RES_DST(9)};
            pg8::gemm_phase<pg8::EpiResB, pg8::StaticOrder, PG8_ALIGN, PG8_SP2>(lds, g, S, E);
            PH_END_K(9);
        }
        ++ph;
        if (l == 0) {
            if (EN(11) && PH_ON()) for (int rep_ = 0; rep_ < NREP(11); ++rep_) { asm volatile("; PHASE_MARK 11"); LOCAL_IDS();
                pg8::Gemm g{HB, FGU, M, 2 * FF, D}; pg8::StaticOrder S; S.init(M, 2 * FF, G, (int)blockIdx.x); pg8::EpiSwiglu<true> E{ACT, FF, SS + (size_t)2 * SS_STRIDE};
                pg8::gemm_phase<pg8::EpiSwiglu<true>, pg8::StaticOrder, PG8_ALIGN, PG8_SP2>(lds, g, S, E);
                PH_END_K(11);
            }
            ++ph;
            if (EN(12) && PH_ON()) for (int rep_ = 0; rep_ < NREP(12); ++rep_) { asm volatile("; PHASE_MARK 12"); LOCAL_IDS();
                pg8::Gemm g{ACT, FDN, M, D, FF}; pg8::StaticOrder S; S.init(M, D, G, (int)blockIdx.x); pg8::EpiResB E{HB, D, SS + (size_t)3 * SS_STRIDE, RES_DST(12)};
                pg8::gemm_phase<pg8::EpiResB, pg8::StaticOrder, PG8_ALIGN, PG8_SP2>(lds, g, S, E);
                PH_END_K(12);
            }
            ++ph;
        } else {
            if (EN(14) && PH_ON()) for (int rep_ = 0; rep_ < NREP(14); ++rep_) { asm volatile("; PHASE_MARK 14"); LOCAL_IDS(); moe_norm_router_phase(lds, HB, in[I_FNORM] + D, in[I_ROUTER], rsrow, toke, tokw, wgcnt, G); PH_END_K(14); }
            ++ph;
            if (EN(15) && PH_ON()) for (int rep_ = 0; rep_ < NREP(15); ++rep_) { asm volatile("; PHASE_MARK 15"); LOCAL_IDS(); moe_slot_phase(lds, toke, wgcnt, tokp, rowtok, tilee, meta, G); PH_END_K(15); }
            ++ph;
            if (EN(16) && PH_ON()) for (int rep_ = 0; rep_ < NREP(16); ++rep_) { asm volatile("; PHASE_MARK 16"); LOCAL_IDS(); const int ntiles = meta[0]; moe_gather_phase(HB, rsrow, in[I_FNORM] + D, rowtok, XG, ntiles * 256, gw, NGW, lane); PH_END_K(16); }
            ++ph;
#pragma unroll 1
            for (int ci = 0; ci < 4; ++ci) {
                if (EN(17) && PH_ON()) for (int rep_ = 0; rep_ < NREP(17); ++rep_) { asm volatile("; PHASE_MARK 17"); LOCAL_IDS();
                    const int ntiles = meta[0], tile0 = ci * MOE_CH_TILES, nt = ci < 3 ? MOE_CH_TILES : ntiles - 3 * MOE_CH_TILES;
                    pg8::Gemm g{XG + (size_t)tile0 * 256 * D, MGU, nt * 256, 2 * FFE, D};
                    MoeOrder S; S.init(nt * 256, 2 * FFE, G, (int)blockIdx.x); S.tilee = tilee; S.tile0 = tile0; S.bstride = (size_t)2 * FFE * D * 2;
                    pg8::EpiSwiglu<false> E{MACT, FFE, nullptr};
                    pg8::gemm_phase<pg8::EpiSwiglu<false>, MoeOrder, PG8_ALIGN, PG8_SP2>(lds, g, S, E);
                    PH_END_K(17);
                }
                ++ph;
                if (EN(18) && PH_ON()) for (int rep_ = 0; rep_ < NREP(18); ++rep_) { asm volatile("; PHASE_MARK 18"); LOCAL_IDS();
                    const int ntiles = meta[0], tile0 = ci * MOE_CH_TILES, nt = ci < 3 ? MOE_CH_TILES : ntiles - 3 * MOE_CH_TILES;
                    pg8::Gemm g{MACT, MDN, nt * 256, D, FFE};
                    MoeOrder S; S.init(nt * 256, D, G, (int)blockIdx.x); S.tilee = tilee; S.tile0 = tile0; S.bstride = (size_t)D * FFE * 2;
                    pg8::EpiBf16 E{XG + (size_t)tile0 * 256 * D, D, nullptr};
                    pg8::gemm_phase<pg8::EpiBf16, MoeOrder, PG8_ALIGN, PG8_SP2>(lds, g, S, E);
                    PH_END_K(18);
                }
                ++ph;
            }
            if (EN(19) && PH_ON()) for (int rep_ = 0; rep_ < NREP(19); ++rep_) { asm volatile("; PHASE_MARK 19"); LOCAL_IDS(); moe_combine_final_phase(HB, args.out, XG, tokp, tokw, in[I_FINAL], gw, NGW, lane); PH_END_K(19); }
            ++ph;
        }
    }
#undef PH_ON
}
constexpr int N_PHASES = 2 + 7 + 2 + 7 + 3 + 8 + 1;

#ifndef MK_PER_PHASE
#define MK_PER_PHASE 0
#endif
extern "C" void kernel_launch(void* const* d_in, const int* in_sizes, int n_in, void* d_out, int out_size, void* d_ws, size_t ws_size, hipStream_t stream) {
    static int grid = 0;
    if (grid == 0) {
        if (n_in != 33 || in_sizes[0] != M * D || out_size != M * D || ws_size < WS_END) {
            fprintf(stderr, "kernel_launch: unexpected problem: n_in %d in0 %d out %d ws %zu (need %zu); nothing launched\n", n_in, n_in > 0 ? in_sizes[0] : -1, out_size, ws_size, (size_t)WS_END); grid = -1; return; }
        int dev = 0, cus = 0, per_cu = 0;
        if (hipGetDevice(&dev) != hipSuccess || hipDeviceGetAttribute(&cus, hipDeviceAttributeMultiprocessorCount, dev) != hipSuccess) { fprintf(stderr, "kernel_launch: device query failed\n"); grid = -1; return; }
        if (hipFuncSetAttribute((const void*)fwd_kernel, hipFuncAttributeMaxDynamicSharedMemorySize, LDS_BYTES) != hipSuccess) { fprintf(stderr, "kernel_launch: hipFuncSetAttribute failed\n"); grid = -1; return; }
        if (hipOccupancyMaxActiveBlocksPerMultiprocessor(&per_cu, (const void*)fwd_kernel, NTHR, LDS_BYTES) != hipSuccess || per_cu < 1) { fprintf(stderr, "kernel_launch: occupancy query reports %d\n", per_cu); }
        (void)hipGetLastError();
        grid = cus;
        if (grid > 256) grid = 256;
        while (grid > 1 && (M % grid != 0 || M / grid > 256)) --grid;
        if (grid != 256) fprintf(stderr, "kernel_launch: note: grid %d\n", grid);
    }
    if (grid < 0) return;
    if (hipMemsetAsync((char*)d_ws + WS_CTL, 0, CTL_ZERO_BYTES, stream) != hipSuccess) { fprintf(stderr, "kernel_launch: memset failed\n"); return; }
    Args a{};
    for (int i = 0; i < 33; ++i) a.in[i] = (const float*)d_in[i];
    a.out = (float*)d_out; a.ws = (unsigned char*)d_ws;
#if MK_PER_PHASE
    for (int p = 0; p < N_PHASES; ++p) { a.ph_lo = p; a.ph_hi = p + 1; a.use_bar = 0; a.pad = 0; hipLaunchKernelGGL(fwd_kernel, dim3(grid), dim3(NTHR), LDS_BYTES, stream, a); }
#else
    a.ph_lo = 0; a.ph_hi = N_PHASES; a.use_bar = 1; a.pad = 0;
    hipLaunchKernelGGL(fwd_kernel, dim3(grid), dim3(NTHR), LDS_BYTES, stream, a);
#endif
    const hipError_t le = hipPeekAtLastError();
    if (le != hipSuccess) fprintf(stderr, "kernel_launch: launch failed: %s\n", hipGetErrorName(le));
}
```

```cpp
#include <hip/hip_runtime.h>
#include <cstdio>
#include <cstdint>
#ifndef HD
#define HD __host__ __device__ __forceinline__
#endif
__device__ __forceinline__ int opq_tid() { int t = (int)threadIdx.x; asm volatile("" : "+v"(t)); return t; }
typedef float f32x2_cv __attribute__((ext_vector_type(2))); typedef __bf16 bf16x2_cv __attribute__((ext_vector_type(2)));
__device__ __forceinline__ unsigned cvtpk_hw(float lo, float hi) { f32x2_cv v = {lo, hi}; bf16x2_cv b = __builtin_convertvector(v, bf16x2_cv); return __builtin_bit_cast(unsigned, b); }

struct cf { float x, y; };
HD cf mk(float a, float b) { cf r; r.x = a; r.y = b; return r; }
HD cf cadd(cf a, cf b) { return mk(a.x + b.x, a.y + b.y); }
HD cf csub(cf a, cf b) { return mk(a.x - b.x, a.y - b.y); }
HD cf cmul(cf a, cf b) { return mk(a.x * b.x - a.y * b.y, a.x * b.y + a.y * b.x); }
HD cf cmulc(cf a, cf b) { return mk(a.x * b.x + a.y * b.y, a.y * b.x - a.x * b.y); }
template <bool INV> HD cf cmulw(cf a, cf w) { return INV ? cmulc(a, w) : cmul(a, w); }
HD cf cscale(cf a, float s) { return mk(a.x * s, a.y * s); }

template <bool INV> HD void dft4(cf& a0, cf& a1, cf& a2, cf& a3) {
    const cf t0 = cadd(a0, a2), t1 = csub(a0, a2), t2 = cadd(a1, a3), t3 = csub(a1, a3);
    a0 = cadd(t0, t2); a2 = csub(t0, t2);
    const cf mit3 = mk(t3.y, -t3.x);
    if (!INV) { a1 = cadd(t1, mit3); a3 = csub(t1, mit3); }
    else      { a1 = csub(t1, mit3); a3 = cadd(t1, mit3); }
}
template <bool INV> HD void dft16(cf (&x)[16]) {
#pragma unroll
    for (int n1 = 0; n1 < 4; ++n1) dft4<INV>(x[n1], x[n1 + 4], x[n1 + 8], x[n1 + 12]);
    const float c1 = 0.92387953251128674f, s1 = 0.38268343236508977f, r2 = 0.70710678118654752f;
    const cf W1 = mk(c1, -s1), W2 = mk(r2, -r2), W3 = mk(s1, -c1), W6 = mk(-r2, -r2), W9 = mk(-c1, s1);
    x[1 + 4 * 1] = cmulw<INV>(x[1 + 4 * 1], W1);
    x[1 + 4 * 2] = cmulw<INV>(x[1 + 4 * 2], W2);
    x[1 + 4 * 3] = cmulw<INV>(x[1 + 4 * 3], W3);
    x[2 + 4 * 1] = cmulw<INV>(x[2 + 4 * 1], W2);
    { const cf t = x[2 + 4 * 2]; x[2 + 4 * 2] = INV ? mk(-t.y, t.x) : mk(t.y, -t.x); }
    x[2 + 4 * 3] = cmulw<INV>(x[2 + 4 * 3], W6);
    x[3 + 4 * 1] = cmulw<INV>(x[3 + 4 * 1], W3);
    x[3 + 4 * 2] = cmulw<INV>(x[3 + 4 * 2], W6);
    x[3 + 4 * 3] = cmulw<INV>(x[3 + 4 * 3], W9);
#pragma unroll
    for (int k2 = 0; k2 < 4; ++k2) dft4<INV>(x[0 + 4 * k2], x[1 + 4 * k2], x[2 + 4 * k2], x[3 + 4 * k2]);
    cf t;
    t = x[1]; x[1] = x[4]; x[4] = t;   t = x[2]; x[2] = x[8]; x[8] = t;   t = x[3]; x[3] = x[12]; x[12] = t;
    t = x[6]; x[6] = x[9]; x[9] = t;   t = x[7]; x[7] = x[13]; x[13] = t; t = x[11]; x[11] = x[14]; x[14] = t;
}
template <bool INV> HD void twiddle16(cf (&x)[16], cf w1) {
    cf w = w1;
#pragma unroll
    for (int k = 1; k < 16; ++k) { x[k] = cmulw<INV>(x[k], w); if (k < 15) w = cmul(w, w1); }
}
constexpr int FFT_HALF = 4352;
constexpr int FFT_WORK = 2 * FFT_HALF;
HD int fphys(int h, int idx) { return h * FFT_HALF + idx + (idx >> 4); }

HD void geo1(int tid, int& h, int& j) { const int w = tid >> 6, l = tid & 63; h = l >> 5; j = 32 * w + (l & 31); }
HD void geo2(int tid, int& h, int& k1, int& j2) { h = tid >> 8; k1 = (tid >> 4) & 15; j2 = tid & 15; }
HD void geo3(int tid, int& h, int& blk) { h = tid >> 8; blk = tid & 255; }

HD int fbase1(int h, int j) { return h * FFT_HALF + j + (j >> 4); }
HD int fbase2(int h, int k1, int j2) { return h * FFT_HALF + 272 * k1 + j2; }
HD int fbase3(int h, int blk) { return h * FFT_HALF + 17 * blk; }
template <class L> HD void fwd_pass1(L lds, int b1, cf w4096j, cf (&x)[16]) {
    dft16<false>(x); twiddle16<false>(x, w4096j);
#pragma unroll
    for (int k = 0; k < 16; ++k) lds.st(b1 + 272 * k, x[k]);
}
template <class L> HD void fwd_pass2(L lds, int b2, cf w256j) {
    cf x[16];
#pragma unroll
    for (int m = 0; m < 16; ++m) x[m] = lds.ld(b2 + 17 * m);
    dft16<false>(x); twiddle16<false>(x, w256j);
#pragma unroll
    for (int k = 0; k < 16; ++k) lds.st(b2 + 17 * k, x[k]);
}
template <class L> HD void fwd_pass3_keep(L lds, int b3, cf (&x)[16]) {
#pragma unroll
    for (int m = 0; m < 16; ++m) x[m] = lds.ld(b3 + m);
    dft16<false>(x);
}
template <class L> HD void mid_pass3(L lds, int b3, const cf (&K)[16]) {
    cf x[16];
#pragma unroll
    for (int m = 0; m < 16; ++m) x[m] = lds.ld(b3 + m);
    dft16<false>(x);
#pragma unroll
    for (int k = 0; k < 16; ++k) x[k] = cmul(x[k], K[k]);
    dft16<true>(x);
#pragma unroll
    for (int m = 0; m < 16; ++m) lds.st(b3 + m, x[m]);
}
template <class L> HD void inv_pass2(L lds, int b2, cf w256j) {
    cf x[16];
#pragma unroll
    for (int k = 0; k < 16; ++k) x[k] = lds.ld(b2 + 17 * k);
    twiddle16<true>(x, w256j); dft16<true>(x);
#pragma unroll
    for (int m = 0; m < 16; ++m) lds.st(b2 + 17 * m, x[m]);
}
template <class L> HD void inv_pass1(L lds, int b1, cf w4096j, cf (&x)[16]) {
#pragma unroll
    for (int k = 0; k < 16; ++k) x[k] = lds.ld(b1 + 272 * k);
    twiddle16<true>(x, w4096j); dft16<true>(x);
}
#ifndef PG8_WGM
#define PG8_WGM 8
#endif
namespace pg8 {
#define PG8_LAS __attribute__((address_space(3)))
typedef unsigned short bf16_t;
typedef short bf16x8 __attribute__((ext_vector_type(8)));
typedef float f32x4 __attribute__((ext_vector_type(4)));
typedef unsigned u32x4 __attribute__((ext_vector_type(4)));
constexpr int BM = 256, BK = 64, HALF = 128, HTB = HALF * BK * 2  , STAGE_BYTES = 8 * HTB, NXCD = 8, WGM = PG8_WGM;

__host__ __device__ __forceinline__ int lds_byte(int r, int c) { const int st = (r >> 4) * 2 + (c >> 5), rr = r & 15, cc = c & 31, ob = rr * 64 + cc * 2; return st * 1024 + (ob ^ (((ob >> 9) & 1) << 5)); }
__host__ __device__ __forceinline__ void stage_rc(int b, int& R, int& C) { const int st = b / 1024, sb = b % 1024, swz = sb ^ (((sb >> 9) & 1) << 5); R = (st >> 1) * 16 + swz / 64; C = (st & 1) * 32 + (swz % 64) / 2; }
__host__ __device__ __forceinline__ int perm32(int rho) { const int n = rho >> 4, i = rho & 15; return 8 * (i >> 2) + 4 * n + (i & 3); }

typedef int v8i_t __attribute__((ext_vector_type(8))); typedef int v4i_t __attribute__((ext_vector_type(4)));
__device__ __forceinline__ v8i_t cat8(bf16x8 a, bf16x8 b) { const v4i_t x = __builtin_bit_cast(v4i_t, a), y = __builtin_bit_cast(v4i_t, b); return __builtin_shufflevector(x, y, 0, 1, 2, 3, 4, 5, 6, 7); }
struct Unit { int pm, pn; };
struct Gemm { const bf16_t* A; const bf16_t* Bt; int M, N, K; };

struct StaticOrder {
    int nM, nN, nwg, G, c;
    __host__ __device__ void init(int M, int N, int G_, int c_) { nM = M / BM; nN = N / BM; nwg = nM * nN; G = G_; c = c_; }
    __host__ __device__ bool next(int i, Unit& u) const {
        const long L = (long)i * G + c; if (L >= nwg) return false;
        int wgid = (int)L; { const int q = nwg / NXCD, r = nwg % NXCD, xcd = wgid % NXCD, off = wgid / NXCD; wgid = (xcd < r ? xcd * (q + 1) : r * (q + 1) + (xcd - r) * q) + off; }
        const int nig = WGM * nN, gid = wgid / nig, fm = gid * WGM, gsz = (nM - fm) < WGM ? (nM - fm) : WGM;
        u.pm = fm + ((wgid % nig) % gsz); u.pn = (wgid % nig) / gsz; return true;
    }
    __device__ __forceinline__ size_t boff(const Unit&) const { return 0; }
    __device__ __forceinline__ void a_ready(const Unit&) const {}
    __device__ __forceinline__ void done(const Unit&) const {}
};

__device__ __forceinline__ unsigned cvt_pk_bf16(float lo, float hi) { unsigned r; asm volatile("v_cvt_pk_bf16_f32 %0, %1, %2" : "=v"(r) : "v"(lo), "v"(hi)); return r; }
typedef float f32x2 __attribute__((ext_vector_type(2)));
typedef unsigned u32x2 __attribute__((ext_vector_type(2)));
__device__ __forceinline__ float row_rs(const float* ssp, int row, int fq) {
    if (!ssp) return 1.0f;
    const f32x4 q = *(const f32x4*)(ssp + (size_t)row * 16 + 4 * fq); float s = (q[0] + q[1]) + (q[2] + q[3]);
    s += __shfl_xor(s, 16); s += __shfl_xor(s, 32);
    return __builtin_amdgcn_rsqf(s * (1.0f / 1024.0f) + 1e-6f);
}
__device__ __forceinline__ void row_rs8(const float* ssp, int row0, int fq, float (&rs)[2][4]) {
    if (!ssp) {
#pragma unroll
        for (int ai = 0; ai < 2; ++ai)
#pragma unroll
            for (int m = 0; m < 4; ++m) rs[ai][m] = 1.0f;
        return; }
    f32x4 q[2][4];
#pragma unroll
    for (int ai = 0; ai < 2; ++ai)
#pragma unroll
        for (int m = 0; m < 4; ++m) q[ai][m] = *(const f32x4*)(ssp + (size_t)(row0 + ai * HALF + m * 16) * 16 + 4 * fq);
#pragma unroll
    for (int ai = 0; ai < 2; ++ai)
#pragma unroll
        for (int m = 0; m < 4; ++m) { float s = (q[ai][m][0] + q[ai][m][1]) + (q[ai][m][2] + q[ai][m][3]); s += __shfl_xor(s, 16); s += __shfl_xor(s, 32); rs[ai][m] = __builtin_amdgcn_rsqf(s * (1.0f / 1024.0f) + 1e-6f); }
}
__device__ __forceinline__ f32x4 row_rs4_swap(const float* ssp, int rowbase, int fr, int fq) {
    if (!ssp) return (f32x4){1.f, 1.f, 1.f, 1.f};
    const f32x4 q = *(const f32x4*)(ssp + (size_t)(rowbase + 4 * fq + (fr >> 2)) * 16 + 4 * (fr & 3)); float s = (q[0] + q[1]) + (q[2] + q[3]);
    s += __shfl_xor(s, 1); s += __shfl_xor(s, 2);
    const float rs = __builtin_amdgcn_rsqf(s * (1.0f / 1024.0f) + 1e-6f);
    f32x4 o;
#pragma unroll
    for (int r = 0; r < 4; ++r) o[r] = __shfl(rs, 16 * fq + 4 * r);
    return o;
}
template <bool F8 = false> struct EpiBf16T {
    static constexpr bool PERM = true, AFTER_DRAIN = false, SWAP = false, FP8 = F8;
    bf16_t* O; int ldc; const float* ss; float descale;
    __device__ __forceinline__ void operator()(const f32x4 (&acc)[2][2][4][2], const Unit& u, int wr, int wc, int fr, int fq) const {
        const int row0 = u.pm * BM + wr * 64 + fr, col0 = u.pn * BM + wc * 32 + 8 * fq;
        float rsa[2][4]; row_rs8(ss, row0, fq, rsa);
#pragma unroll
        for (int ai = 0; ai < 2; ++ai)
#pragma unroll
            for (int m = 0; m < 4; ++m) { bf16_t* rowp = O + (size_t)(row0 + ai * HALF + m * 16) * ldc + col0; const float rs = F8 ? rsa[ai][m] * descale : rsa[ai][m];
#pragma unroll
                for (int bj = 0; bj < 2; ++bj) { const f32x4 v0 = acc[ai][bj][m][0] * rs, v1 = acc[ai][bj][m][1] * rs;
                    u32x4 w; w.x = cvt_pk_bf16(v0[0], v0[1]); w.y = cvt_pk_bf16(v0[2], v0[3]); w.z = cvt_pk_bf16(v1[0], v1[1]); w.w = cvt_pk_bf16(v1[2], v1[3]);
                    *(u32x4*)(rowp + bj * HALF) = w; } }
    }
};
typedef EpiBf16T<false> EpiBf16;
struct EpiQKV {
    static constexpr bool PERM = true, AFTER_DRAIN = false, SWAP = false, FP8 = false;
    bf16_t* Q; bf16_t* Kb; bf16_t* Vb; const float* cosT; const float* sinT; const float* ss;
    __device__ __forceinline__ void operator()(const f32x4 (&acc)[2][2][4][2], const Unit& u, int wr, int wc, int fr, int fq) const {
        const int row0 = u.pm * BM + wr * 64 + fr;
        float rsa[2][4]; row_rs8(ss, row0, fq, rsa);
#pragma unroll
        for (int bj = 0; bj < 2; ++bj) {
            const int slot0 = u.pn * BM + bj * HALF + wc * 32 + 8 * fq;
            if (slot0 < 640) {
                const int head = slot0 >> 6, j4 = ((slot0 & 63) >> 3) * 4;
#pragma unroll
                for (int am = 0; am < 4; ++am) {
                    f32x4 c[2], sn[2];
                    const int tofs = ((row0 & 4095) + (am >> 1) * HALF + 2 * (am & 1) * 16) * 32 + j4;
                    const __attribute__((address_space(1))) float* cb = (const __attribute__((address_space(1))) float*)(cosT + tofs); const __attribute__((address_space(1))) float* sb = (const __attribute__((address_space(1))) float*)(sinT + tofs); asm volatile("" : "+v"(cb), "+v"(sb));
#pragma unroll
                    for (int h = 0; h < 2; ++h) { c[h] = *(const __attribute__((address_space(1))) f32x4*)(cb + h * 512); sn[h] = *(const __attribute__((address_space(1))) f32x4*)(sb + h * 512); }
#pragma unroll
                    for (int h = 0; h < 2; ++h) { const int ai = am >> 1, m = 2 * (am & 1) + h; const int row = row0 + ai * HALF + m * 16;
                        const float rs = rsa[ai][m]; const f32x4 lo = acc[ai][bj][m][0] * rs, hi = acc[ai][bj][m][1] * rs;
                        const f32x4 olo = lo * c[h] - hi * sn[h], ohi = hi * c[h] + lo * sn[h];
                        bf16_t* dst = head < 8 ? Q + (size_t)row * 512 + head * 64 + j4 : Kb + (size_t)row * 128 + (head - 8) * 64 + j4;
                        u32x2 w0, w1; w0.x = cvt_pk_bf16(olo[0], olo[1]); w0.y = cvt_pk_bf16(olo[2], olo[3]); w1.x = cvt_pk_bf16(ohi[0], ohi[1]); w1.y = cvt_pk_bf16(ohi[2], ohi[3]);
                        *(u32x2*)dst = w0; *(u32x2*)(dst + 32) = w1; } }
            } else {
#pragma unroll
                for (int ai = 0; ai < 2; ++ai)
#pragma unroll
                    for (int m = 0; m < 4; ++m) { const int row = row0 + ai * HALF + m * 16; const float rs = rsa[ai][m]; const f32x4 v0 = acc[ai][bj][m][0] * rs, v1 = acc[ai][bj][m][1] * rs;
                        u32x4 w; w.x = cvt_pk_bf16(v0[0], v0[1]); w.y = cvt_pk_bf16(v0[2], v0[3]); w.z = cvt_pk_bf16(v1[0], v1[1]); w.w = cvt_pk_bf16(v1[2], v1[3]);
                        *(u32x4*)(Vb + (size_t)row * 128 + (slot0 - 640)) = w; }
            }
        }
    }
};
struct EpiT {
    static constexpr bool PERM = false, AFTER_DRAIN = false, SWAP = true, FP8 = false;
    bf16_t* O; int nch; int ts_shift; const float* ss;
    __device__ __forceinline__ void operator()(const f32x4 (&acc)[2][2][4][2], const Unit& u, int wr, int wc, int fr, int fq) const {
        const int rowt = u.pm * BM, b = rowt >> ts_shift, tb = (rowt & ((1 << ts_shift) - 1)) + wr * 64 + 4 * fq;
#pragma unroll
        for (int ai = 0; ai < 2; ++ai) {
            f32x4 rsv[4];
#pragma unroll
            for (int m = 0; m < 4; ++m) rsv[m] = row_rs4_swap(ss, rowt + wr * 64 + ai * HALF + m * 16, fr, fq);
#pragma unroll
            for (int bj = 0; bj < 2; ++bj)
#pragma unroll
                for (int n = 0; n < 2; ++n) { const int ch = u.pn * BM + bj * HALF + wc * 32 + 16 * n + fr; bf16_t* chp = O + (((size_t)(b * nch + ch)) << ts_shift) + tb + ai * HALF;
#pragma unroll
                    for (int m = 0; m < 4; ++m) { const f32x4 v = acc[ai][bj][m][n] * rsv[m]; u32x2 w; w.x = cvt_pk_bf16(v[0], v[1]); w.y = cvt_pk_bf16(v[2], v[3]);
                        *(u32x2*)(chp + m * 16) = w; } } }
    }
};
struct EpiResB {
    static constexpr bool PERM = true, AFTER_DRAIN = false, SWAP = false, FP8 = false;
    bf16_t* xb; int ldc; float* ss; bf16_t* dst;
    __device__ __forceinline__ void operator()(const f32x4 (&acc)[2][2][4][2], const Unit& u, int wr, int wc, int fr, int fq) const {
        const int row0 = u.pm * BM + wr * 64 + fr, col0 = u.pn * BM + wc * 32 + 8 * fq;
#pragma unroll
        for (int ai = 0; ai < 2; ++ai) {
            u32x4 b[4][2];
#pragma unroll
            for (int m = 0; m < 4; ++m)
#pragma unroll
                for (int bj = 0; bj < 2; ++bj) b[m][bj] = *(const u32x4*)(xb + (size_t)(row0 + ai * HALF + m * 16) * ldc + col0 + bj * HALF);
#pragma unroll
            for (int m = 0; m < 4; ++m) { const int row = row0 + ai * HALF + m * 16; bf16_t* dstp = dst + (size_t)row * ldc + col0; float sq = 0.f;
#pragma unroll
                for (int bj = 0; bj < 2; ++bj) { const f32x4 a0 = acc[ai][bj][m][0], a1 = acc[ai][bj][m][1]; const u32x4 bb = b[m][bj]; float o[8];
                    o[0] = __builtin_bit_cast(float, bb.x << 16) + a0[0]; o[1] = __builtin_bit_cast(float, bb.x & 0xffff0000u) + a0[1];
                    o[2] = __builtin_bit_cast(float, bb.y << 16) + a0[2]; o[3] = __builtin_bit_cast(float, bb.y & 0xffff0000u) + a0[3];
                    o[4] = __builtin_bit_cast(float, bb.z << 16) + a1[0]; o[5] = __builtin_bit_cast(float, bb.z & 0xffff0000u) + a1[1];
                    o[6] = __builtin_bit_cast(float, bb.w << 16) + a1[2]; o[7] = __builtin_bit_cast(float, bb.w & 0xffff0000u) + a1[3];
#pragma unroll
                    for (int i = 0; i < 8; ++i) sq += o[i] * o[i];
                    u32x4 w; w.x = cvt_pk_bf16(o[0], o[1]); w.y = cvt_pk_bf16(o[2], o[3]); w.z = cvt_pk_bf16(o[4], o[5]); w.w = cvt_pk_bf16(o[6], o[7]);
                    *(u32x4*)(dstp + bj * HALF) = w; }
                if (ss) { sq += __shfl_xor(sq, 16); sq += __shfl_xor(sq, 32); if (fq == 0) ss[(size_t)row * 16 + u.pn * 4 + wc] = sq; } } }
    }
};
typedef float f32x2e __attribute__((ext_vector_type(2)));
__device__ __forceinline__ f32x2e silu_mul_pk(f32x2e g, f32x2e up) {
    const f32x2e t = g * (-1.44269504088896f); f32x2e e; e.x = __builtin_amdgcn_exp2f(t.x); e.y = __builtin_amdgcn_exp2f(t.y);
    const f32x2e d = e + 1.0f; f32x2e r; r.x = __builtin_amdgcn_rcpf(d.x); r.y = __builtin_amdgcn_rcpf(d.y);
    return (g * r) * up;
}
template <bool SCALE, bool F8 = false, bool F8OUT = false> struct EpiSwiglu {
    static constexpr bool PERM = true, AFTER_DRAIN = false, SWAP = false, FP8 = F8;
    bf16_t* O; int ldc; const float* ss;
    __device__ __forceinline__ void operator()(const f32x4 (&acc)[2][2][4][2], const Unit& u, int wr, int wc, int fr, int fq) const {
        const int row0 = u.pm * BM + wr * 64 + fr, col0 = u.pn * 128 + wc * 16 + 4 * fq;
        float rsa[2][4]; if (SCALE) row_rs8(ss, row0, fq, rsa);
#pragma unroll
        for (int ai = 0; ai < 2; ++ai)
#pragma unroll
            for (int m = 0; m < 4; ++m) { bf16_t* rowp = O + (size_t)(row0 + ai * HALF + m * 16) * ldc + col0; const float rs = SCALE ? rsa[ai][m] : 1.0f;
#pragma unroll
                for (int bj = 0; bj < 2; ++bj) { f32x4 g = acc[ai][bj][m][0], up = acc[ai][bj][m][1]; if (SCALE) { g = g * rs; up = up * rs; } if (F8) { g = g * 0.03125f; up = up * 0.03125f; }
                    const f32x2e o0 = silu_mul_pk((f32x2e){g[0], g[1]}, (f32x2e){up[0], up[1]}), o1 = silu_mul_pk((f32x2e){g[2], g[3]}, (f32x2e){up[2], up[3]});
                    if (F8OUT) { int w8 = 0; w8 = __builtin_amdgcn_cvt_pk_fp8_f32(o0.x * 4.0f, o0.y * 4.0f, w8, false); w8 = __builtin_amdgcn_cvt_pk_fp8_f32(o1.x * 4.0f, o1.y * 4.0f, w8, true);
                        *(unsigned*)((unsigned char*)O + (size_t)(row0 + ai * HALF + m * 16) * ldc + col0 + bj * 64) = (unsigned)w8; }
                    else { u32x2 w; w.x = cvt_pk_bf16(o0.x, o0.y); w.y = cvt_pk_bf16(o1.x, o1.y);
                    *(u32x2*)(rowp + bj * 64) = w; } } }
    }
};
template <class Epi, class Sched, bool ALIGN_EPI = false, bool SP2 = false>
__device__ __forceinline__ void gemm_phase(PG8_LAS unsigned char* lds, const Gemm g, const Sched& S, const Epi& E) {
    const int tid = opq_tid(), wid = __builtin_amdgcn_readfirstlane(tid >> 6), lane = tid & 63, wr = wid >> 2, wc = wid & 3, fr = lane & 15, fq = lane >> 4;
    const int K = g.K, nt = K / BK;
    unsigned voffA[2], voffB[2];
#pragma unroll
    for (int i = 0; i < 2; ++i) { int R, C; stage_rc(tid * 16 + i * 8192, R, C); const int Rb = Epi::PERM ? ((R & ~31) + perm32(R & 31)) : R;
        voffA[i] = (unsigned)(R * K + C) * 2u; voffB[i] = (unsigned)(Rb * K + C) * 2u; }
    const size_t kstep = (size_t)(BK * 2);
    const size_t hstep = (size_t)HALF * K * 2;
    const size_t tstep = 2 * hstep;
    const unsigned ldsw = (unsigned)wid * 1024u;
    const int aoff = lds_byte(wr * 64 + fr, fq * 8), boff = lds_byte(wc * 32 + fr, fq * 8);
#define PG8_SA(b, h) (((b) * 2 + (h)) * HTB)
#define PG8_SB(b, h) ((4 + (b) * 2 + (h)) * HTB)
#define PG8_STAGE(bufoff, gbase, voff) do { _Pragma("unroll") for (int _i = 0; _i < 2; ++_i) \
        __builtin_amdgcn_global_load_lds((const unsigned*)((const char*)(gbase) + (voff)[_i]), (PG8_LAS unsigned*)(lds + (bufoff) + ldsw + _i * 8192), 16, 0, 0); } while (0)
#define PG8_LDA(dst, b, h) do { if constexpr (Epi::FP8) { _Pragma("unroll") for (int m = 0; m < 4; ++m) dst##8[m] = cat8(*(const PG8_LAS bf16x8*)(lds + PG8_SA(b, h) + aoff + m * 2048), *(const PG8_LAS bf16x8*)(lds + PG8_SA(b, h) + aoff + m * 2048 + 1024)); } else { \
        _Pragma("unroll") for (int m = 0; m < 4; ++m) _Pragma("unroll") for (int k = 0; k < 2; ++k) dst[m][k] = *(const PG8_LAS bf16x8*)(lds + PG8_SA(b, h) + aoff + m * 2048 + k * 1024); } } while (0)
#define PG8_LDB(dst, b, h) do { if constexpr (Epi::FP8) { _Pragma("unroll") for (int n = 0; n < 2; ++n) dst##8[n] = cat8(*(const PG8_LAS bf16x8*)(lds + PG8_SB(b, h) + boff + n * 2048), *(const PG8_LAS bf16x8*)(lds + PG8_SB(b, h) + boff + n * 2048 + 1024)); } else { \
        _Pragma("unroll") for (int n = 0; n < 2; ++n) _Pragma("unroll") for (int k = 0; k < 2; ++k) dst[n][k] = *(const PG8_LAS bf16x8*)(lds + PG8_SB(b, h) + boff + n * 2048 + k * 1024); } } while (0)
#define PG8_MMA(ai, bj, At, Bt) do { __builtin_amdgcn_s_setprio(1); if constexpr (Epi::FP8) { _Pragma("unroll") for (int m = 0; m < 4; ++m) _Pragma("unroll") for (int n = 0; n < 2; ++n) \
        asm volatile("v_mfma_scale_f32_16x16x128_f8f6f4 %0, %1, %2, %0, %3, %3 op_sel_hi:[0,0,0]" : "+v"(acc[ai][bj][m][n]) : "v"(Bt##8[n]), "v"(At##8[m]), "v"(f8one)); } else { \
        _Pragma("unroll") for (int m = 0; m < 4; ++m) _Pragma("unroll") for (int n = 0; n < 2; ++n) _Pragma("unroll") for (int k = 0; k < 2; ++k) \
        acc[ai][bj][m][n] = Epi::SWAP ? __builtin_amdgcn_mfma_f32_16x16x32_bf16(At[m][k], Bt[n][k], acc[ai][bj][m][n], 0, 0, 0) : __builtin_amdgcn_mfma_f32_16x16x32_bf16(Bt[n][k], At[m][k], acc[ai][bj][m][n], 0, 0, 0); } __builtin_amdgcn_s_setprio(0); } while (0)
#define PG8_WAIT_V(n) asm volatile("s_waitcnt vmcnt(" #n ")" ::: "memory")
#define PG8_WAIT_L(n) asm volatile("s_waitcnt lgkmcnt(" #n ")" ::: "memory")
#define PG8_BAR __builtin_amdgcn_s_barrier()
#define PG8_SCHED __builtin_amdgcn_sched_barrier(0)
#ifdef DIAG
    unsigned long long dg_k = 0, dg_e = 0, dg_t1 = 0, dg_t2 = 0; const unsigned long long dg_t0 = wall_clock64();
#endif
    Unit cur, nxt; int ui = 0;
    if (!S.next(0, cur)) return;
    f32x4 acc[2][2][4][2];
#pragma unroll
    for (int a = 0; a < 2; ++a)
#pragma unroll
        for (int b = 0; b < 2; ++b)
#pragma unroll
            for (int m = 0; m < 4; ++m)
#pragma unroll
                for (int n = 0; n < 2; ++n) acc[a][b][m][n] = (f32x4){0.f, 0.f, 0.f, 0.f};
    bf16x8 At[4][2], B0[2][2], B1[2][2]; v8i_t At8[4], B08[2], B18[2];
    int f8one = 0x7F7F7F7F; asm volatile("" : "+v"(f8one));
    const char* cA = (const char*)g.A + (size_t)cur.pm * tstep; const char* cB = (const char*)g.Bt + S.boff(cur) + (size_t)cur.pn * tstep;
    S.a_ready(cur);
    if constexpr (SP2) {
        PG8_STAGE(PG8_SB(0, 0), cB, voffB); PG8_STAGE(PG8_SB(0, 1), cB + hstep, voffB); PG8_STAGE(PG8_SA(0, 0), cA, voffA); PG8_STAGE(PG8_SA(0, 1), cA + hstep, voffA);
        if (wr == 1) PG8_BAR;
        PG8_WAIT_V(2); PG8_BAR;
        PG8_STAGE(PG8_SB(1, 0), cB + kstep, voffB); PG8_STAGE(PG8_SA(1, 0), cA + kstep, voffA); PG8_STAGE(PG8_SB(1, 1), cB + hstep + kstep, voffB);
        PG8_WAIT_V(6); PG8_BAR;
    } else {
        PG8_STAGE(PG8_SB(0, 0), cB, voffB); PG8_STAGE(PG8_SA(0, 0), cA, voffA); PG8_STAGE(PG8_SB(0, 1), cB + hstep, voffB); PG8_STAGE(PG8_SA(0, 1), cA + hstep, voffA);
        if (wr == 1) PG8_BAR;
        PG8_WAIT_V(4); PG8_BAR;
        PG8_STAGE(PG8_SB(1, 0), cB + kstep, voffB); PG8_STAGE(PG8_SA(1, 0), cA + kstep, voffA); PG8_STAGE(PG8_SB(1, 1), cB + hstep + kstep, voffB);
        PG8_WAIT_V(6); PG8_BAR;
    }
    for (;;) {
        const bool has_next = S.next(ui + 1, nxt);
        const char* nA = has_next ? (const char*)g.A + (size_t)nxt.pm * tstep : cA; const char* nB = has_next ? (const char*)g.Bt + S.boff(nxt) + (size_t)nxt.pn * tstep : cB;
#ifdef DIAG
        dg_t1 = wall_clock64();
#endif
        for (int t = 0; t < nt; t += 2) {
            const bool last = (t == nt - 2);
            const char* a1 = cA + (size_t)(t + 1) * kstep;
            const char* a2 = last ? nA : cA + (size_t)(t + 2) * kstep; const char* b2 = last ? nB : cB + (size_t)(t + 2) * kstep;
            const char* a3 = a2 + kstep; const char* b3 = b2 + kstep;
            if (last && has_next) S.a_ready(nxt);
            if constexpr (SP2) {
            PG8_LDB(B0, 0, 0); PG8_LDB(B1, 0, 1); PG8_SCHED; PG8_LDA(At, 0, 0); PG8_STAGE(PG8_SA(1, 1), a1 + hstep, voffA);
            PG8_WAIT_V(8); PG8_WAIT_L(0); PG8_BAR; PG8_MMA(0, 0, At, B0); PG8_MMA(0, 1, At, B1); PG8_BAR; PG8_SCHED;
            PG8_LDA(At, 0, 1); PG8_STAGE(PG8_SB(0, 0), b2, voffB); PG8_STAGE(PG8_SB(0, 1), b2 + hstep, voffB); PG8_STAGE(PG8_SA(0, 0), a2, voffA);
            PG8_WAIT_V(8); PG8_WAIT_L(0); PG8_BAR; PG8_MMA(1, 0, At, B0); PG8_MMA(1, 1, At, B1); PG8_BAR; PG8_SCHED;
            PG8_LDB(B0, 1, 0); PG8_LDB(B1, 1, 1); PG8_SCHED; PG8_LDA(At, 1, 0); PG8_STAGE(PG8_SA(0, 1), a2 + hstep, voffA);
            PG8_WAIT_V(8); PG8_WAIT_L(0); PG8_BAR; PG8_MMA(0, 0, At, B0); PG8_MMA(0, 1, At, B1); PG8_BAR; PG8_SCHED;
            PG8_LDA(At, 1, 1); PG8_STAGE(PG8_SB(1, 0), b3, voffB); PG8_STAGE(PG8_SB(1, 1), b3 + hstep, voffB); PG8_STAGE(PG8_SA(1, 0), a3, voffA);
            PG8_WAIT_V(8); PG8_WAIT_L(0); PG8_BAR; PG8_MMA(1, 0, At, B0); PG8_MMA(1, 1, At, B1); PG8_BAR; PG8_SCHED;
            } else {
            PG8_LDB(B0, 0, 0); PG8_SCHED; PG8_LDA(At, 0, 0); PG8_STAGE(PG8_SA(1, 1), a1 + hstep, voffA);
            PG8_WAIT_L(8); PG8_BAR; PG8_WAIT_L(0); PG8_MMA(0, 0, At, B0); PG8_BAR; PG8_SCHED;
            PG8_LDB(B1, 0, 1); PG8_STAGE(PG8_SB(0, 0), b2, voffB);
            PG8_BAR; PG8_WAIT_L(0); PG8_MMA(0, 1, At, B1); PG8_BAR;
            PG8_LDA(At, 0, 1); PG8_STAGE(PG8_SA(0, 0), a2, voffA);
            PG8_BAR; PG8_WAIT_L(0); PG8_MMA(1, 0, At, B0); PG8_BAR; PG8_SCHED;
            PG8_STAGE(PG8_SB(0, 1), b2 + hstep, voffB);
            PG8_WAIT_V(6); PG8_BAR; PG8_MMA(1, 1, At, B1); PG8_BAR;
            PG8_LDB(B0, 1, 0); PG8_SCHED; PG8_LDA(At, 1, 0); PG8_STAGE(PG8_SA(0, 1), a2 + hstep, voffA);
            PG8_WAIT_L(8); PG8_BAR; PG8_WAIT_L(0); PG8_MMA(0, 0, At, B0); PG8_BAR; PG8_SCHED;
            PG8_LDB(B1, 1, 1); PG8_STAGE(PG8_SB(1, 0), b3, voffB);
            PG8_BAR; PG8_WAIT_L(0); PG8_MMA(0, 1, At, B1); PG8_BAR;
            PG8_LDA(At, 1, 1); PG8_STAGE(PG8_SA(1, 0), a3, voffA);
            PG8_BAR; PG8_WAIT_L(0); PG8_MMA(1, 0, At, B0); PG8_BAR; PG8_SCHED;
            PG8_STAGE(PG8_SB(1, 1), b3 + hstep, voffB);
            PG8_WAIT_V(6); PG8_BAR; PG8_MMA(1, 1, At, B1); PG8_BAR;
            }
        }
#ifdef DIAG
        dg_t2 = wall_clock64(); dg_k += dg_t2 - dg_t1;
#endif
        if constexpr (Epi::FP8) asm volatile("s_nop 15\n\ts_nop 15" ::: "memory");
        if constexpr (ALIGN_EPI) { if (wr == 0) PG8_BAR; }
#ifndef EPI_REP
#define EPI_REP 1
#endif
        if constexpr (!Epi::AFTER_DRAIN) { _Pragma("unroll 1") for (int er_ = 0; er_ < EPI_REP; ++er_) E(acc, cur, wr, wc, fr, fq); S.done(cur); }
#ifdef DIAG
        dg_e += wall_clock64() - dg_t2;
#endif
        if (!has_next) break;
#pragma unroll
        for (int a = 0; a < 2; ++a)
#pragma unroll
            for (int b = 0; b < 2; ++b)
#pragma unroll
                for (int m = 0; m < 4; ++m)
#pragma unroll
                    for (int n = 0; n < 2; ++n) acc[a][b][m][n] = (f32x4){0.f, 0.f, 0.f, 0.f};
        cur = nxt; cA = nA; cB = nB; ++ui;
        if constexpr (ALIGN_EPI) { if (wr == 1) PG8_BAR; }
    }
#ifdef DIAG
    if (blockIdx.x == 0 && tid == 0) { unsigned long long* dg = (unsigned long long*)(*(const PG8_LAS unsigned long long*)(lds + 139328)); atomicAdd(dg + 0, dg_k); atomicAdd(dg + 1, dg_e); atomicAdd(dg + 2, wall_clock64() - dg_t0); atomicAdd(dg + 3, (unsigned long long)(ui + 1)); }
#endif
    PG8_WAIT_V(0);
    if constexpr (!ALIGN_EPI) { if (wr == 0) PG8_BAR; }
    PG8_BAR;
    if constexpr (Epi::AFTER_DRAIN) { E.fused(acc, cur, wr, wc, fr, fq, lds, wid, lane); S.done(cur); }
#undef PG8_SA
#undef PG8_SB
#undef PG8_STAGE
#undef PG8_LDA
#undef PG8_LDB
#undef PG8_MMA
#undef PG8_WAIT_V
#undef PG8_WAIT_L
#undef PG8_BAR
#undef PG8_SCHED
}
}
#ifndef PG8_SP2
#define PG8_SP2 true
#endif
#ifndef PG8_ALIGN
#define PG8_ALIGN true
#endif
constexpr int NB = 16, SEQ = 4096, D = 1024, M = NB * SEQ;
constexpr int NH = 8, NKV = 2, HDIM = 64, AW = 512, KVW = 128;
constexpr int HYW = 512, C3 = 1536, INC = 2304;
constexpr int XH = 4, XHD = 128, XW = 512, MEML = 256, MROWS = NB * MEML;
constexpr int FF = 2816, NE = 8, FFE = 3584;
constexpr float EPS = 1e-6f;
constexpr int NWAVES = 8, NTHR = 512;
constexpr int MOE_CH_TILES = 256, MOE_NCHUNK = 2, MOE_MAX_TILES = 520, MOE_MAX_ROWS = MOE_MAX_TILES * 256, MOE_ACT_TILES = MOE_MAX_TILES - (MOE_NCHUNK - 1) * MOE_CH_TILES;

constexpr size_t al256(size_t x) { return (x + 255) & ~(size_t)255; }
constexpr size_t WS_CTL = 0, CTL_ZERO_BYTES = 1u << 20;
constexpr size_t WS_SS = CTL_ZERO_BYTES, SS_STRIDE = (size_t)M * 16;
constexpr size_t WS_COS = WS_SS + 5 * SS_STRIDE * 4, WS_SIN = WS_COS + (size_t)SEQ * 32 * 4, WS_H2 = WS_SIN + (size_t)SEQ * 32 * 4;
constexpr size_t WS_TOKE = WS_H2 + (size_t)2 * SEQ * 64 * 4, WS_TOKW = WS_TOKE + (size_t)M * 2 * 4, WS_TOKP = WS_TOKW + (size_t)M * 2 * 4;
constexpr size_t WS_ROWTOK = WS_TOKP + (size_t)M * 2 * 4, WS_TILEE = WS_ROWTOK + al256((size_t)MOE_MAX_ROWS * 4), WS_WGCNT = WS_TILEE + 4096, WS_RSROW = WS_WGCNT + (size_t)1024 * 8 * 4, WS_META = WS_RSROW + (size_t)M * 4;
constexpr size_t WS_WINA = al256(WS_META + 4096);
constexpr size_t WS_WINB = WS_WINA + (size_t)2 * 768 * D * 2;
constexpr size_t WS_WOUT = WS_WINB + (size_t)2 * C3 * D * 2;
constexpr size_t WS_XQ = WS_WOUT + (size_t)2 * D * D * 2;
constexpr size_t WS_XK = WS_XQ + (size_t)2 * XW * D * 2;
constexpr size_t WS_XV = WS_XK + (size_t)2 * XW * D * 2;
constexpr size_t WS_XO = WS_XV + (size_t)2 * XW * D * 2;
constexpr size_t WS_FGU = WS_XO + (size_t)2 * D * XW * 2;
constexpr size_t WS_FDN = WS_FGU + (size_t)2 * FF * D * 2;
constexpr size_t WS_MGU = WS_FDN + (size_t)D * FF * 2;
constexpr size_t WS_MDN = WS_MGU + (size_t)NE * 2 * FFE * D;
constexpr size_t WS_KFILT = WS_MDN + (size_t)NE * D * FFE;
constexpr size_t WS_MB = WS_KFILT + (size_t)2 * 2 * HYW * 8192 * 4;
constexpr size_t WS_KMEM = WS_MB + (size_t)MROWS * D * 2;
constexpr size_t WS_VMEMT = WS_KMEM + (size_t)MROWS * 1024 * 2;
constexpr size_t WS_HB = WS_VMEMT + (size_t)1024 * MROWS * 2;
constexpr size_t WS_R = WS_HB + (size_t)M * D * 2;
constexpr size_t WS_QB = WS_R, WS_KB = WS_QB + (size_t)M * AW * 2, WS_VB = WS_KB + (size_t)M * KVW * 2, WS_UT = WS_VB + (size_t)M * KVW * 2;
constexpr size_t WS_MIXED = WS_UT;
constexpr size_t WS_AB = WS_UT + (size_t)M * C3 * 2, WS_YT = WS_AB + (size_t)M * AW * 2, WS_KSPEC = WS_YT + (size_t)M * HYW * 2, WS_MIXEND = WS_KSPEC + (size_t)2 * 2 * HYW * 16384 * 4;
constexpr size_t WS_XQB = WS_R, WS_XOB = WS_XQB + (size_t)M * XW * 2;
constexpr size_t WS_ACT = WS_R;
constexpr size_t WS_XG = WS_R;
constexpr size_t WS_MACT = WS_XG + (size_t)MOE_MAX_ROWS * D;
constexpr size_t WS_YB = WS_MACT + (size_t)MOE_ACT_TILES * 256 * FFE;
constexpr size_t WS_MOEEND = WS_YB + (size_t)MOE_MAX_ROWS * D * 2;
constexpr size_t cmax(size_t a, size_t b) { return a > b ? a : b; }
constexpr size_t WS_END = cmax(cmax(WS_MIXEND, WS_ACT + (size_t)M * FF * 2), WS_MOEEND);
static_assert(WS_END <= (size_t)1073741824, "workspace map exceeds 1 GiB");
static_assert(WS_ACT + (size_t)M * FF * 2 <= WS_KSPEC && WS_XOB + (size_t)M * XW * 2 <= WS_KSPEC, "layer 0's later phases must not touch the filter spectra");
constexpr int CW_TMO = 0, CW_CODE = 1, CW_BAR = 4096;

constexpr int PHASE_LDS = 155648;
constexpr int LDSCTL_OFF = PHASE_LDS, MISC_OFF = LDSCTL_OFF + 64;
constexpr int LDS_BYTES = PHASE_LDS + 512;

#define GAS __attribute__((address_space(1)))
#define LAS __attribute__((address_space(3)))
typedef unsigned short bf16;
typedef unsigned v4u __attribute__((ext_vector_type(4)));
typedef unsigned v2u __attribute__((ext_vector_type(2)));
typedef float f32x4 __attribute__((ext_vector_type(4)));
typedef short bf16x8 __attribute__((ext_vector_type(8)));
typedef short s16x4 __attribute__((ext_vector_type(4)));
typedef GAS unsigned gu32;
#define RLX_AGENT __ATOMIC_RELAXED, __HIP_MEMORY_SCOPE_AGENT
#define LDS_WAIT() asm volatile("s_waitcnt lgkmcnt(0)" ::: "memory")
#define VM_WAIT() asm volatile("s_waitcnt vmcnt(0)" ::: "memory")
__device__ __forceinline__ unsigned f2bf(float f) { unsigned u = __builtin_bit_cast(unsigned, f); return (u + 0x7fffu + ((u >> 16) & 1u)) >> 16; }
__device__ __forceinline__ unsigned pk2(float lo, float hi) { return cvtpk_hw(lo, hi); }
__device__ __forceinline__ float bflo(unsigned w) { return __builtin_bit_cast(float, w << 16); }
__device__ __forceinline__ float bfhi(unsigned w) { return __builtin_bit_cast(float, w & 0xffff0000u); }
__device__ __forceinline__ float bf1(unsigned short h) { return __builtin_bit_cast(float, ((unsigned)h) << 16); }
#define XB_TMO      128
#define XB_XCNT(j)  (256  + 64 * (j))
#define XB_XSUB(j)  (1280 + 64 * (j))
#define XB_XGEN(j)  (2304 + 64 * (j))
#define XB_TOP      3328
#define XB_TOPGEN   3392
#define XCD_BAR_WORDS 3456
#define XB_SPIN_CAP (1u << 22)

__device__ __forceinline__ unsigned xb_ld(unsigned* p)              { return __hip_atomic_load(p, __ATOMIC_RELAXED, __HIP_MEMORY_SCOPE_AGENT); }
__device__ __forceinline__ unsigned xb_add(unsigned* p, unsigned v) { return __hip_atomic_fetch_add(p, v, __ATOMIC_RELAXED, __HIP_MEMORY_SCOPE_AGENT); }
__device__ __forceinline__ unsigned xb_xcc_id() { return (unsigned)__builtin_amdgcn_s_getreg((3 << 11) | 20) & 0xFu; }
#define XB_SPIN(cond, bar) do { unsigned _sp = 0; while (cond) { __builtin_amdgcn_s_sleep(1); \
    if ((++_sp & 255u) == 0u) { if (xb_ld(&(bar)[XB_TMO])) break; if (_sp > XB_SPIN_CAP) { atomicAdd(&(bar)[XB_TMO], 1u); break; } } } } while (0)

struct XcdBarrier {
    unsigned* bar; unsigned x;
    volatile LAS unsigned* st;
};

__device__ __forceinline__ XcdBarrier xcd_barrier_post(unsigned* bar, volatile LAS unsigned* st) {
    XcdBarrier b; b.bar = bar; b.x = xb_xcc_id(); b.st = st;
    if (threadIdx.x == 0) (void)xb_add(&bar[XB_XCNT(b.x)], 1u);
    return b;
}
__device__ __forceinline__ void xcd_barrier_complete(unsigned* bar, unsigned x, unsigned& nloc, unsigned& nx) {
    const unsigned G = gridDim.x * gridDim.y * gridDim.z;
    unsigned sum, cnt, mine, sp = 0u;
    for (;;) {
        sum = 0u; cnt = 0u; mine = 0u;
#pragma unroll
        for (unsigned j = 0; j < 16; ++j) { const unsigned c = xb_ld(&bar[XB_XCNT(j)]); sum += c; cnt += (c > 0u) ? 1u : 0u; mine = (j == x) ? c : mine; }
        if (sum == G) break;
        __builtin_amdgcn_s_sleep(1);
        if ((++sp & 255u) == 0u) { if (xb_ld(&bar[XB_TMO])) break; if (sp > XB_SPIN_CAP) { atomicAdd(&bar[XB_TMO], 1u); break; } }
    }
    nloc = mine > 0u ? mine : 1u; nx = cnt > 0u ? cnt : 1u;
}

__device__ __forceinline__ void xcd_barrier(const XcdBarrier& b) {
    asm volatile("s_waitcnt vmcnt(0)" ::: "memory");
    __syncthreads();
    if (threadIdx.x == 0) {
        unsigned* bar = b.bar;
        __builtin_amdgcn_s_waitcnt(0);
        unsigned nloc = b.st[0], nx = b.st[1];
        if (nloc == 0u) { xcd_barrier_complete(bar, b.x, nloc, nx); b.st[0] = nloc; b.st[1] = nx; }
        const unsigned old = xb_add(&bar[XB_XSUB(b.x)], 1u);
        const unsigned gen = old / nloc;
        if (old + 1u == (gen + 1u) * nloc) {
            __builtin_amdgcn_fence(__ATOMIC_RELEASE, "agent");
            asm volatile("s_waitcnt vmcnt(0)" ::: "memory");
            const unsigned og = xb_add(&bar[XB_TOP], 1u);
            const unsigned tg = og / nx;
            if (og + 1u == (tg + 1u) * nx) xb_add(&bar[XB_TOPGEN], 1u);
            else XB_SPIN(xb_ld(&bar[XB_TOPGEN]) == tg, bar);
            __builtin_amdgcn_fence(__ATOMIC_ACQUIRE, "agent");
            xb_add(&bar[XB_XGEN(b.x)], 1u);
            asm volatile("s_waitcnt vmcnt(0)" ::: "memory");
        } else {
            XB_SPIN(xb_ld(&bar[XB_XGEN(b.x)]) == gen, bar);
            __builtin_amdgcn_fence(__ATOMIC_ACQUIRE, "agent");
            asm volatile("s_waitcnt vmcnt(0)" ::: "memory");
        }
    }
    __syncthreads();
}
struct Args { const float* in[33]; float* out; unsigned char* ws; int ph_lo, ph_hi, use_bar, pad; };
enum InIdx { I_X = 0, I_MEM, I_MEMNORM, I_MIXNORM, I_WIN, I_SINK, I_CONVW, I_CONVB, I_FW1, I_FB1, I_FFR1, I_FW2, I_FB2, I_FFR2, I_FW3, I_SKIP, I_ANORM, I_YNORM, I_WOUT, I_XNORM,
             I_XWQ, I_XWK, I_XWV, I_XWO, I_FNORM, I_FGATE, I_FUP, I_FDOWN, I_ROUTER, I_MGATE, I_MUP, I_MDOWN, I_FINAL };

__device__ __forceinline__ float wave_sum(float v) {
#pragma unroll
    for (int o = 1; o < 64; o <<= 1) v += __shfl_xor(v, o);
    return v;
}
__device__ __forceinline__ void wg_sync() { __builtin_amdgcn_sched_barrier(0); asm volatile("s_waitcnt vmcnt(0) lgkmcnt(0)" ::: "memory"); __builtin_amdgcn_s_barrier(); asm volatile("" ::: "memory"); __builtin_amdgcn_sched_barrier(0); }

template <int MODE> __device__ __forceinline__ int rowmap(int n) {
    if (MODE == 1) return n < 640 ? ((n & ~63) + 8 * ((n & 31) >> 2) + (n & 3) + 4 * ((n >> 5) & 1)) : n;
    if (MODE == 2) return 8 * (n >> 2) + (n & 3);
    if (MODE == 3) return 8 * (n >> 2) + 4 + (n & 3);
    return n;
}
__device__ __forceinline__ int rowmap_rt(int mode, int n) { return mode == 1 ? rowmap<1>(n) : mode == 2 ? rowmap<2>(n) : mode == 3 ? rowmap<3>(n) : n; }
__device__ __forceinline__ void tr_item(const float* W, int ldw, int K, int col0, int ncols, bf16* WT, int mode, const float* gk, int item, LAS float* scr, int lane) {
    const int nblk = ncols / 32, kb = item / nblk, nb = item % nblk, k0 = 64 * kb, n0 = 32 * nb;
    f32x4 tv[8];
#pragma unroll
    for (int i = 0; i < 8; ++i) { const int kk = 8 * i + (lane >> 3); tv[i] = *(const f32x4*)(W + (size_t)(k0 + kk) * ldw + col0 + n0 + 4 * (lane & 7)); }
#pragma unroll
    for (int i = 0; i < 8; ++i) { const int kk = 8 * i + (lane >> 3); const float gv = gk ? gk[k0 + kk] : 1.0f; LAS float* d = scr + kk * 33 + 4 * (lane & 7);
        d[0] = gv * tv[i][0]; d[1] = gv * tv[i][1]; d[2] = gv * tv[i][2]; d[3] = gv * tv[i][3]; }
    LDS_WAIT(); asm volatile("" ::: "memory");
    const int c = lane & 7;
#pragma unroll
    for (int j = 0; j < 4; ++j) { const int n = (lane >> 3) + 8 * j; const LAS float* sp = scr + (8 * c) * 33 + n;
        v4u o; o.x = pk2(sp[0 * 33], sp[1 * 33]); o.y = pk2(sp[2 * 33], sp[3 * 33]); o.z = pk2(sp[4 * 33], sp[5 * 33]); o.w = pk2(sp[6 * 33], sp[7 * 33]);
        *(v4u*)(WT + (size_t)rowmap_rt(mode, n0 + n) * K + k0 + 8 * c) = o; }
    LDS_WAIT(); asm volatile("" ::: "memory");
}
__device__ __forceinline__ void tr_item8(const float* W, int ldw, int K, int ncols, unsigned char* WT8, int mode, float wscale, int item, LAS float* scr, int lane) {
    const int nblk = ncols / 32, kb = item / nblk, nb = item % nblk, k0 = 64 * kb, n0 = 32 * nb;
    f32x4 tv[8];
#pragma unroll
    for (int i = 0; i < 8; ++i) { const int kk = 8 * i + (lane >> 3); tv[i] = *(const f32x4*)(W + (size_t)(k0 + kk) * ldw + n0 + 4 * (lane & 7)); }
#pragma unroll
    for (int i = 0; i < 8; ++i) { const int kk = 8 * i + (lane >> 3); LAS float* d = scr + kk * 33 + 4 * (lane & 7);
        d[0] = wscale * tv[i][0]; d[1] = wscale * tv[i][1]; d[2] = wscale * tv[i][2]; d[3] = wscale * tv[i][3]; }
    LDS_WAIT(); asm volatile("" ::: "memory");
    const int n = lane >> 1, half = lane & 1; const LAS float* sp = scr + (32 * half) * 33 + n;
    v4u o[2];
#pragma unroll
    for (int q = 0; q < 8; ++q) { int w = 0;
        w = __builtin_amdgcn_cvt_pk_fp8_f32(sp[(4 * q + 0) * 33], sp[(4 * q + 1) * 33], w, false);
        w = __builtin_amdgcn_cvt_pk_fp8_f32(sp[(4 * q + 2) * 33], sp[(4 * q + 3) * 33], w, true);
        o[q >> 2][q & 3] = (unsigned)w; }
    v4u* dst = (v4u*)(WT8 + (size_t)rowmap_rt(mode, n0 + n) * K + k0 + 32 * half);
    dst[0] = o[0]; dst[1] = o[1];
    LDS_WAIT(); asm volatile("" ::: "memory");
}
__device__ __forceinline__ void rms_row(const float* xrow, const float* gain, int lane, f32x4 (&v)[4]) {
    const f32x4* xr = (const f32x4*)xrow + lane; float s = 0.f;
#pragma unroll
    for (int j = 0; j < 4; ++j) { v[j] = xr[64 * j]; s += (v[j].x * v[j].x + v[j].y * v[j].y) + (v[j].z * v[j].z + v[j].w * v[j].w); }
    const float rs = 1.0f / sqrtf(wave_sum(s) * (1.f / 1024.f) + EPS);
    const f32x4* gr = (const f32x4*)gain + lane;
#pragma unroll
    for (int j = 0; j < 4; ++j) v[j] = v[j] * rs * gr[64 * j];
}
__device__ __forceinline__ void store_row_bf16(bf16* orow, int lane, const f32x4 (&v)[4]) {
    unsigned long long* o8 = (unsigned long long*)orow + lane;
#pragma unroll
    for (int j = 0; j < 4; ++j) o8[64 * j] = (unsigned long long)pk2(v[j].x, v[j].y) | ((unsigned long long)pk2(v[j].z, v[j].w) << 32);
}
__device__ __forceinline__ void xb_rows(const float* x, bf16* o, float* ss, int nrows, int gw, int NGW, int lane) {
#pragma unroll 1
    for (int r0 = gw; r0 < nrows; r0 += 2 * NGW) {
        const int r1 = r0 + NGW; const bool on1 = r1 < nrows; const int r1c = on1 ? r1 : r0;
        const f32x4* xa = (const f32x4*)(x + (size_t)r0 * D) + lane; const f32x4* xc = (const f32x4*)(x + (size_t)r1c * D) + lane; f32x4 va[4], vc[4];
#pragma unroll
        for (int j = 0; j < 4; ++j) { va[j] = xa[64 * j]; vc[j] = xc[64 * j]; }
        float sa = 0.f, sc = 0.f;
#pragma unroll
        for (int j = 0; j < 4; ++j) { sa += (va[j].x * va[j].x + va[j].y * va[j].y) + (va[j].z * va[j].z + va[j].w * va[j].w); sc += (vc[j].x * vc[j].x + vc[j].y * vc[j].y) + (vc[j].z * vc[j].z + vc[j].w * vc[j].w); }
        sa = wave_sum(sa); sc = wave_sum(sc);
        store_row_bf16(o + (size_t)r0 * D, lane, va); if (lane < 16) ss[(size_t)r0 * 16 + lane] = lane == 0 ? sa : 0.f;
        if (on1) { store_row_bf16(o + (size_t)r1 * D, lane, vc); if (lane < 16) ss[(size_t)r1 * 16 + lane] = lane == 0 ? sc : 0.f; }
    }
}
__device__ __forceinline__ void norm_rows(const float* x, const float* gain, bf16* o, int nrows, int gw, int NGW, int lane) {
    for (int r = gw; r < nrows; r += NGW) { f32x4 v[4]; rms_row(x + (size_t)r * D, gain, lane, v); store_row_bf16(o + (size_t)r * D, lane, v); }
}

constexpr int BA_KS = 72, BA_VS = 408, BA_KROWS = 400;
constexpr int BA_K_BYTES = BA_KROWS * BA_KS * 2, BA_V_BYTES = 64 * BA_VS * 2;
static_assert(BA_K_BYTES % 16 == 0 && BA_K_BYTES + BA_V_BYTES <= PHASE_LDS, "band attention LDS");
__device__ __forceinline__ bf16x8 cat4(s16x4 a, s16x4 b) { return __builtin_shufflevector(a, b, 0, 1, 2, 3, 4, 5, 6, 7); }
__device__ __forceinline__ unsigned cvtpk(float lo, float hi) { unsigned r; asm volatile("v_cvt_pk_bf16_f32 %0, %1, %2" : "=v"(r) : "v"(lo), "v"(hi)); return r; }

__device__ __forceinline__ void band_attention_phase(LAS unsigned char* lds, const bf16* Q, const bf16* Kb, const bf16* Vb, bf16* Ao, const float* sink, int G) {
    const int tid = opq_tid(), lane = tid & 63, wave = __builtin_amdgcn_readfirstlane(tid >> 6), fr = lane & 15, fq = lane >> 4;
    LAS bf16* Ks = (LAS bf16*)lds; LAS bf16* VTs = (LAS bf16*)(lds + BA_K_BYTES);
    for (int unit = blockIdx.x; unit < NB * 32 * NKV; unit += G) {
        const int kh = unit & 1, ib = (unit >> 1) & 31, b = unit >> 6;
        const int kbase = 128 * (ib - 1);
        for (int c = tid; c < BA_KROWS * 8; c += NTHR) { const int row = c >> 3, c8 = c & 7, kpos = kbase + row;
            v4u val = (v4u){0u, 0u, 0u, 0u};
            if (row < 384 && kpos >= 0 && kpos < SEQ) val = *(const v4u*)(Kb + ((size_t)(b * SEQ + kpos)) * KVW + kh * 64 + c8 * 8);
            *(LAS v4u*)(Ks + row * BA_KS + c8 * 8) = val; }
        for (int c = tid; c < BA_KROWS * 8; c += NTHR) { const int c8 = c / BA_KROWS, key = c % BA_KROWS, kpos = kbase + key;
            v4u val = (v4u){0u, 0u, 0u, 0u};
            if (key < 384 && kpos >= 0 && kpos < SEQ) val = *(const v4u*)(Vb + ((size_t)(b * SEQ + kpos)) * KVW + kh * 64 + c8 * 8);
            LAS bf16* dst = VTs + (c8 * 8) * BA_VS + key;
            dst[0 * BA_VS] = (bf16)(val.x & 0xffffu); dst[1 * BA_VS] = (bf16)(val.x >> 16); dst[2 * BA_VS] = (bf16)(val.y & 0xffffu); dst[3 * BA_VS] = (bf16)(val.y >> 16);
            dst[4 * BA_VS] = (bf16)(val.z & 0xffffu); dst[5 * BA_VS] = (bf16)(val.z >> 16); dst[6 * BA_VS] = (bf16)(val.w & 0xffffu); dst[7 * BA_VS] = (bf16)(val.w >> 16); }
        wg_sync();
        const int g = wave >> 1, half = wave & 1, head = kh * 4 + g;
        const float snk = sink[head];
        bf16x8 qn[2];
        { const size_t t0 = (size_t)b * SEQ + 128 * ib + 64 * half;
#pragma unroll
          for (int ks = 0; ks < 2; ++ks) qn[ks] = *(const bf16x8*)(Q + (t0 + fr) * AW + head * 64 + 32 * ks + 8 * fq); }
#pragma unroll 1
        for (int qt = 0; qt < 4; ++qt) {
            const int p0 = 64 * half + 16 * qt;
            const size_t t0 = (size_t)b * SEQ + 128 * ib + p0;
            bf16x8 qf[2]; qf[0] = qn[0]; qf[1] = qn[1];
            if (qt < 3) {
#pragma unroll
                for (int ks = 0; ks < 2; ++ks) qn[ks] = *(const bf16x8*)(Q + (t0 + 16 + fr) * AW + head * 64 + 32 * ks + 8 * fq); }
            f32x4 s[18];
            const LAS bf16* kbase_p = Ks + (p0 + fr) * BA_KS + 8 * fq;
            bf16x8 kfa[3][2], kfb[3][2];
#pragma unroll
            for (int jj = 0; jj < 3; ++jj)
#pragma unroll
                for (int ks = 0; ks < 2; ++ks) kfa[jj][ks] = *(const LAS bf16x8*)(kbase_p + (16 * jj) * BA_KS + 32 * ks);
#pragma unroll
            for (int gq = 0; gq < 6; ++gq) {
                if (gq < 5) {
#pragma unroll
                    for (int jj = 0; jj < 3; ++jj)
#pragma unroll
                        for (int ks = 0; ks < 2; ++ks) { const bf16x8 t = *(const LAS bf16x8*)(kbase_p + (16 * (3 * (gq + 1) + jj)) * BA_KS + 32 * ks); if (gq & 1) kfa[jj][ks] = t; else kfb[jj][ks] = t; } }
                __builtin_amdgcn_sched_barrier(0);
#pragma unroll
                for (int jj = 0; jj < 3; ++jj) { const int j = 3 * gq + jj; s[j] = (f32x4){0.f, 0.f, 0.f, 0.f};
#pragma unroll
                    for (int ks = 0; ks < 2; ++ks) s[j] = __builtin_amdgcn_mfma_f32_16x16x32_bf16((gq & 1) ? kfb[jj][ks] : kfa[jj][ks], qf[ks], s[j], 0, 0, 0); }
                __builtin_amdgcn_sched_barrier(0);
            }
            float mx = -1e30f;
#pragma unroll
            for (int j = 0; j < 18; ++j)
#pragma unroll
                for (int r = 0; r < 4; ++r) { const int rel = 16 * j + 4 * fq + r - fr, idx = p0 + 16 * j + 4 * fq + r;
                    const bool ok = rel >= 0 && rel <= 256 && (ib > 0 || idx >= 128) && (ib < 31 || idx < 256);
                    const float v = ok ? s[j][r] * 0.125f : -1e30f; s[j][r] = v; mx = fmaxf(mx, v); }
            mx = fmaxf(mx, __shfl_xor(mx, 16)); mx = fmaxf(mx, __shfl_xor(mx, 32)); mx = fmaxf(mx, snk);
            float l = 0.f;
#pragma unroll
            for (int j = 0; j < 18; ++j)
#pragma unroll
                for (int r = 0; r < 4; ++r) { const float p = __expf(s[j][r] - mx); s[j][r] = p; l += p; }
            l += __shfl_xor(l, 16); l += __shfl_xor(l, 32); l += __expf(snk - mx);
            const float inv = 1.0f / l;
            f32x4 o[4];
#pragma unroll
            for (int dt = 0; dt < 4; ++dt) o[dt] = (f32x4){0.f, 0.f, 0.f, 0.f};
            const LAS bf16* vbase_p = VTs + fr * BA_VS + p0 + 4 * fq;
            s16x4 va[4][2], vb[4][2];
#pragma unroll
            for (int dt = 0; dt < 4; ++dt) { va[dt][0] = *(const LAS s16x4*)(vbase_p + (16 * dt) * BA_VS); va[dt][1] = *(const LAS s16x4*)(vbase_p + (16 * dt) * BA_VS + 16); }
#pragma unroll
            for (int kk = 0; kk < 9; ++kk) {
                if (kk < 8) {
#pragma unroll
                    for (int dt = 0; dt < 4; ++dt) { const s16x4 t0_ = *(const LAS s16x4*)(vbase_p + (16 * dt) * BA_VS + 32 * (kk + 1)), t1_ = *(const LAS s16x4*)(vbase_p + (16 * dt) * BA_VS + 32 * (kk + 1) + 16);
                        if (kk & 1) { va[dt][0] = t0_; va[dt][1] = t1_; } else { vb[dt][0] = t0_; vb[dt][1] = t1_; } } }
                v4u pw; pw.x = cvtpk(s[2 * kk][0], s[2 * kk][1]); pw.y = cvtpk(s[2 * kk][2], s[2 * kk][3]); pw.z = cvtpk(s[2 * kk + 1][0], s[2 * kk + 1][1]); pw.w = cvtpk(s[2 * kk + 1][2], s[2 * kk + 1][3]);
                const bf16x8 pf = __builtin_bit_cast(bf16x8, pw);
                __builtin_amdgcn_sched_barrier(0);
#pragma unroll
                for (int dt = 0; dt < 4; ++dt) { const bf16x8 vf = (kk & 1) ? cat4(vb[dt][0], vb[dt][1]) : cat4(va[dt][0], va[dt][1]);
                    o[dt] = __builtin_amdgcn_mfma_f32_16x16x32_bf16(vf, pf, o[dt], 0, 0, 0); }
                __builtin_amdgcn_sched_barrier(0);
            }
#pragma unroll
            for (int dt = 0; dt < 4; ++dt) { const f32x4 ov = o[dt] * inv; v2u w; w.x = cvtpk(ov[0], ov[1]); w.y = cvtpk(ov[2], ov[3]);
                *(v2u*)(Ao + (t0 + fr) * AW + head * 64 + 16 * dt + 4 * fq) = w; }
        }
        wg_sync();
    }
}

constexpr int XA_KS = 136, XA_VS = 264;
constexpr int XA_K_BYTES = MEML * XA_KS * 2, XA_V_BYTES = XHD * XA_VS * 2;
static_assert(XA_K_BYTES % 16 == 0 && XA_K_BYTES + XA_V_BYTES <= PHASE_LDS, "cross attention LDS");
__device__ __forceinline__ void cross_attention_phase(LAS unsigned char* lds, const bf16* Qx, const bf16* Kmem, const bf16* VmemT, bf16* Ox, int layer, int G) {
    const int tid = opq_tid(), lane = tid & 63, wave = __builtin_amdgcn_readfirstlane(tid >> 6), fr = lane & 15, fq = lane >> 4;
    LAS bf16* Ks = (LAS bf16*)lds; LAS bf16* VTs = (LAS bf16*)(lds + XA_K_BYTES);
    for (int unit = blockIdx.x; unit < 256; unit += G) {
        const int quarter = unit & 3, head = (unit >> 2) & 3, b = unit >> 4;
        for (int c = tid; c < MEML * 16; c += NTHR) { const int key = c >> 4, c8 = c & 15;
            *(LAS v4u*)(Ks + key * XA_KS + c8 * 8) = *(const v4u*)(Kmem + (size_t)(b * MEML + key) * 1024 + layer * 512 + head * 128 + c8 * 8); }
        for (int c = tid; c < XHD * 32; c += NTHR) { const int d = c >> 5, c8 = c & 31;
            *(LAS v4u*)(VTs + d * XA_VS + c8 * 8) = *(const v4u*)(VmemT + (size_t)(layer * 512 + head * 128 + d) * MROWS + b * MEML + c8 * 8); }
        wg_sync();
        bf16x8 qn[4];
        { const size_t t0 = (size_t)b * SEQ + (quarter * 4) * 256 + wave * 32;
#pragma unroll
          for (int ks = 0; ks < 4; ++ks) qn[ks] = *(const bf16x8*)(Qx + (t0 + fr) * XW + head * 128 + 32 * ks + 8 * fq); }
#pragma unroll 1
        for (int qi = 0; qi < 8; ++qi) {
            const size_t t0 = (size_t)b * SEQ + (quarter * 4 + (qi >> 1)) * 256 + wave * 32 + 16 * (qi & 1);
            bf16x8 qf[4];
#pragma unroll
            for (int ks = 0; ks < 4; ++ks) qf[ks] = qn[ks];
            if (qi < 7) { const size_t t1 = (size_t)b * SEQ + (quarter * 4 + ((qi + 1) >> 1)) * 256 + wave * 32 + 16 * ((qi + 1) & 1);
#pragma unroll
                for (int ks = 0; ks < 4; ++ks) qn[ks] = *(const bf16x8*)(Qx + (t1 + fr) * XW + head * 128 + 32 * ks + 8 * fq); }
            f32x4 s[16];
            const LAS bf16* kbase_p = Ks + fr * XA_KS + 8 * fq;
            bf16x8 kfa[2][4], kfb[2][4];
#pragma unroll
            for (int jj = 0; jj < 2; ++jj)
#pragma unroll
                for (int ks = 0; ks < 4; ++ks) kfa[jj][ks] = *(const LAS bf16x8*)(kbase_p + (16 * jj) * XA_KS + 32 * ks);
#pragma unroll
            for (int gq = 0; gq < 8; ++gq) {
                if (gq < 7) {
#pragma unroll
                    for (int jj = 0; jj < 2; ++jj)
#pragma unroll
                        for (int ks = 0; ks < 4; ++ks) { const bf16x8 t = *(const LAS bf16x8*)(kbase_p + (16 * (2 * (gq + 1) + jj)) * XA_KS + 32 * ks); if (gq & 1) kfa[jj][ks] = t; else kfb[jj][ks] = t; } }
                __builtin_amdgcn_sched_barrier(0);
#pragma unroll
                for (int jj = 0; jj < 2; ++jj) { const int j = 2 * gq + jj; s[j] = (f32x4){0.f, 0.f, 0.f, 0.f};
#pragma unroll
                    for (int ks = 0; ks < 4; ++ks) s[j] = __builtin_amdgcn_mfma_f32_16x16x32_bf16((gq & 1) ? kfb[jj][ks] : kfa[jj][ks], qf[ks], s[j], 0, 0, 0); }
                __builtin_amdgcn_sched_barrier(0);
            }
            float mx = -1e30f;
#pragma unroll
            for (int j = 0; j < 16; ++j)
#pragma unroll
                for (int r = 0; r < 4; ++r) { const float v = s[j][r] * 0.08838834764831845f; s[j][r] = v; mx = fmaxf(mx, v); }
            mx = fmaxf(mx, __shfl_xor(mx, 16)); mx = fmaxf(mx, __shfl_xor(mx, 32));
            float l = 0.f;
#pragma unroll
            for (int j = 0; j < 16; ++j)
#pragma unroll
                for (int r = 0; r < 4; ++r) { const float p = __expf(s[j][r] - mx); s[j][r] = p; l += p; }
            l += __shfl_xor(l, 16); l += __shfl_xor(l, 32);
            const float inv = 1.0f / l;
            f32x4 o[8];
#pragma unroll
            for (int dt = 0; dt < 8; ++dt) o[dt] = (f32x4){0.f, 0.f, 0.f, 0.f};
            const LAS bf16* vbase_p = VTs + fr * XA_VS + 4 * fq;
            s16x4 va[8][2], vb[8][2];
#pragma unroll
            for (int dt = 0; dt < 8; ++dt) { va[dt][0] = *(const LAS s16x4*)(vbase_p + (16 * dt) * XA_VS); va[dt][1] = *(const LAS s16x4*)(vbase_p + (16 * dt) * XA_VS + 16); }
#pragma unroll
            for (int kk = 0; kk < 8; ++kk) {
                if (kk < 7) {
#pragma unroll
                    for (int dt = 0; dt < 8; ++dt) { const s16x4 t0_ = *(const LAS s16x4*)(vbase_p + (16 * dt) * XA_VS + 32 * (kk + 1)), t1_ = *(const LAS s16x4*)(vbase_p + (16 * dt) * XA_VS + 32 * (kk + 1) + 16);
                        if (kk & 1) { va[dt][0] = t0_; va[dt][1] = t1_; } else { vb[dt][0] = t0_; vb[dt][1] = t1_; } } }
                v4u pw; pw.x = cvtpk(s[2 * kk][0], s[2 * kk][1]); pw.y = cvtpk(s[2 * kk][2], s[2 * kk][3]); pw.z = cvtpk(s[2 * kk + 1][0], s[2 * kk + 1][1]); pw.w = cvtpk(s[2 * kk + 1][2], s[2 * kk + 1][3]);
                const bf16x8 pf = __builtin_bit_cast(bf16x8, pw);
                __builtin_amdgcn_sched_barrier(0);
#pragma unroll
                for (int dt = 0; dt < 8; ++dt) { const bf16x8 vf = (kk & 1) ? cat4(vb[dt][0], vb[dt][1]) : cat4(va[dt][0], va[dt][1]);
                    o[dt] = __builtin_amdgcn_mfma_f32_16x16x32_bf16(vf, pf, o[dt], 0, 0, 0); }
                __builtin_amdgcn_sched_barrier(0);
            }
#pragma unroll
            for (int dt = 0; dt < 8; ++dt) { const f32x4 ov = o[dt] * inv; v2u w; w.x = cvtpk(ov[0], ov[1]); w.y = cvtpk(ov[2], ov[3]);
                *(v2u*)(Ox + (t0 + fr) * XW + head * 128 + 16 * dt + 4 * fq) = w; }
        }
        wg_sync();
    }
}
constexpr float HY_MIN_DECAY = -3.0701134573253944f;
constexpr float HY_MAX_DECAY = -15.350567286626972f;
__device__ __forceinline__ void h2_rows(const Args& a, float* H2, int gw, int NGW, int lane) {
    for (int idx = gw; idx < 2 * SEQ; idx += NGW) {
        const int l = idx >> 12, j = idx & 4095;
        const float* w1 = a.in[I_FW1] + l * 33 * 64; const float* b1 = a.in[I_FB1] + l * 64; const float* fr1 = a.in[I_FFR1] + l * 64;
        const float* w2 = a.in[I_FW2] + l * 64 * 64; const float* b2 = a.in[I_FB2] + l * 64; const float* fr2 = a.in[I_FFR2] + l * 64;
        const float w = 6.283185307179586f * (float)j / 4096.0f;
        const int mm = (lane - 1) & 15; const float f = 1e-4f + (float)mm * ((15.0f - 1e-4f) / 15.0f); const float ang = f * w;
        float zq = lane == 0 ? (float)j / 4095.0f : (lane <= 16 ? cosf(ang) : -sinf(ang));
        float acc = b1[lane];
#pragma unroll
        for (int q = 0; q < 33; ++q) acc += __shfl(zq, q) * w1[q * 64 + lane];
        const float h1 = sinf(fr1[lane] * acc);
        acc = b2[lane];
#pragma unroll
        for (int q = 0; q < 64; ++q) acc += __shfl(h1, q) * w2[q * 64 + lane];
        H2[(size_t)idx * 64 + lane] = sinf(fr2[lane] * acc);
    }
}
__device__ __forceinline__ void kfilt_phase(LAS unsigned char* lds, const float* H2, const float* w3all, float* KF, int G) {
    LAS float* ws = (LAS float*)lds;
    const int tid = opq_tid(), jj = tid & 63, cg = __builtin_amdgcn_readfirstlane(tid >> 6);
    for (int unit = blockIdx.x; unit < 2 * 64 * 32; unit += G) {
        const int cb = unit & 31, jb = (unit >> 5) & 63, l = unit >> 11;
        const float* w3 = w3all + (size_t)l * 64 * 2048;
        for (int e = tid; e < 4096; e += NTHR) ws[e] = w3[(size_t)(e >> 6) * 2048 + cb * 64 + (e & 63)];
        wg_sync();
        const int j = jb * 64 + jj;
        const f32x4* hr = (const f32x4*)(H2 + ((size_t)l * SEQ + j) * 64);
        float acc[8];
#pragma unroll
        for (int e = 0; e < 8; ++e) acc[e] = 0.f;
#pragma unroll
        for (int q = 0; q < 16; ++q) { const f32x4 hv = hr[q];
#pragma unroll
            for (int i = 0; i < 4; ++i) { const LAS f32x4* wp = (const LAS f32x4*)(ws + (4 * q + i) * 64 + cg * 8); const f32x4 wa = wp[0], wb = wp[1];
                acc[0] += hv[i] * wa[0]; acc[1] += hv[i] * wa[1]; acc[2] += hv[i] * wa[2]; acc[3] += hv[i] * wa[3];
                acc[4] += hv[i] * wb[0]; acc[5] += hv[i] * wb[1]; acc[6] += hv[i] * wb[2]; acc[7] += hv[i] * wb[3]; } }
        const float tj = (float)j / 4095.0f;
#pragma unroll
        for (int e = 0; e < 8; ++e) { const int col = cb * 64 + cg * 8 + e, dir = col >> 10, oc = col & 1023;
            const float delta = HY_MIN_DECAY + (float)oc * ((HY_MAX_DECAY - HY_MIN_DECAY) / 1023.0f);
            float val = acc[e] * expf(-tj * fabsf(delta));
            int n = dir == 0 ? j : 8192 - j;
            if (dir == 1 && j == 0) { n = 4096; val = 0.f; }
            KF[((size_t)(l * 1024 + oc)) * 8192 + n] = val; }
        wg_sync();
    }
}

constexpr int HY_RAWS = 4112;
constexpr int HY_ROWB = 2 * HY_RAWS * 2;
constexpr int HY_VB_OFF = FFT_WORK * 8;
constexpr int HY_X2_OFF = HY_VB_OFF + HY_ROWB;
constexpr int HY_X1_OFF = HY_X2_OFF + HY_ROWB;
constexpr int HY_EX_OFF = HY_X1_OFF + HY_ROWB;
constexpr int HY_YB_OFF = HY_EX_OFF + 16384;
static_assert(HY_VB_OFF % 16 == 0 && HY_ROWB % 16 == 0 && HY_YB_OFF + 2 * 4096 * 2 <= PHASE_LDS && HY_YB_OFF - HY_X1_OFF >= 4096 * 8 && HY_X1_OFF % 8 == 0, "hyena LDS map");
typedef float f32x2v __attribute__((ext_vector_type(2)));
struct LdsCf { LAS f32x2v* p; __device__ __forceinline__ cf ld(int i) const { const f32x2v t = p[i]; return mk(t.x, t.y); } __device__ __forceinline__ void st(int i, cf v) const { p[i] = (f32x2v){v.x, v.y}; } };

__device__ __forceinline__ void hy_dma_rows(LAS unsigned char* lds, int region_off, const bf16* UT, int b0, int ch, int wave, int lane) {
#pragma unroll
    for (int r = 0; r < 2; ++r)
        __builtin_amdgcn_global_load_lds((const unsigned*)(UT + (((size_t)((b0 + r) * C3 + ch)) << 12) + wave * 512 + lane * 8), (LAS unsigned*)(lds + region_off + r * HY_RAWS * 2 + 16 + wave * 1024), 16, 0, 0);
}
__device__ __forceinline__ void hy_pads(LAS unsigned char* lds, int region_off, int tid) {
    if (tid < 2) { LAS bf16* row = (LAS bf16*)(lds + region_off) + tid * HY_RAWS; row[7] = 0; row[8 + 4096] = 0; }
}
__device__ __forceinline__ float hy_conv(const LAS bf16* ldsh, int e, float w0, float w1, float w2, float bias) {
    return w0 * bf1(ldsh[e - 1]) + w1 * bf1(ldsh[e]) + w2 * bf1(ldsh[e + 1]) + bias;
}
__device__ __forceinline__ int opqi(int v) { asm volatile("" : "+v"(v)); return v; }
template <class T> __device__ __forceinline__ T* opqp(T* p) { asm volatile("" : "+v"(p)); return p; }
__device__ __forceinline__ cf opq(cf w) { asm volatile("" : "+v"(w.x), "+v"(w.y)); return w; }
__device__ __forceinline__ cf csel(bool c, cf a, cf b) { return mk(c ? a.x : b.x, c ? a.y : b.y); }
__device__ __forceinline__ float uni(float v) { return __builtin_bit_cast(float, __builtin_amdgcn_readfirstlane(__builtin_bit_cast(int, v))); }
__device__ __forceinline__ void wave_lds_fence() { __builtin_amdgcn_sched_barrier(0); asm volatile("s_waitcnt lgkmcnt(0)" ::: "memory"); __builtin_amdgcn_sched_barrier(0); }
__device__ __forceinline__ void wg_sync_lds() { __builtin_amdgcn_sched_barrier(0); asm volatile("s_waitcnt lgkmcnt(0)" ::: "memory"); __builtin_amdgcn_s_barrier(); asm volatile("" ::: "memory"); __builtin_amdgcn_sched_barrier(0); }
__device__ __forceinline__ cf shfl_cf(cf v) { return mk(__shfl_xor(v.x, 32), __shfl_xor(v.y, 32)); }

__device__ __forceinline__ void kspec_phase(LAS unsigned char* lds, const float* KF, float* KSP, int G) {
    const int tid = opq_tid();
    LdsCf W; W.p = (LAS f32x2v*)lds;
    int h1, j1, h2, k1, j2, h3, blk; geo1(tid, h1, j1); geo2(tid, h2, k1, j2); geo3(tid, h3, blk);
    const int fb1 = opqi(fbase1(h1, j1)), fb2 = opqi(fbase2(h2, k1, j2)), fb3 = opqi(fbase3(h3, blk)), jo = opqi(j1);
    float sv, cv;
    sincospif(-(float)j1 / 4096.0f, &sv, &cv); const cf w8192j = mk(cv, sv);
    sincospif(-(float)j1 / 2048.0f, &sv, &cv); const cf w4096j = mk(cv, sv);
    sincospif(-(float)j2 / 128.0f, &sv, &cv);  const cf w256j = mk(cv, sv);
    const cf w32 = mk(0.98078528040323043f, -0.19509032201612825f);
#pragma unroll 1
    for (int unit = blockIdx.x; unit < 2 * 2 * HYW; unit += G) {
        const float* kf = KF + (size_t)unit * 8192;
        cf x[16]; cf wp = opq(w8192j);
#pragma unroll
        for (int m = 0; m < 16; ++m) { const float* kp = kf + opqi(jo + 1024 * (m >> 2)); const float ka = kp[256 * (m & 3)]; const float* kq = kp + opqi(4096); const float kb = kq[256 * (m & 3)];
            x[m] = csel(h1 == 0, mk(ka + kb, 0.f), cscale(wp, ka - kb)); wp = cmul(wp, w32); }
        fwd_pass1(W, fb1, opq(w4096j), x); wg_sync();
        fwd_pass2(W, fb2, opq(w256j)); wave_lds_fence();
        { cf kk[16]; fwd_pass3_keep(W, fb3, kk); GAS f32x4* kd = opqp((GAS f32x4*)(KSP + (size_t)unit * 16384 + tid * 32));
#pragma unroll
          for (int q = 0; q < 8; ++q) kd[q] = (f32x4){kk[2 * q].x, kk[2 * q].y, kk[2 * q + 1].x, kk[2 * q + 1].y}; }
        wg_sync();
    }
}
__device__ __forceinline__ void mid_pass3g(LdsCf lds, int b3, const GAS f32x4* Kp) {
    f32x4 kv[8];
#pragma unroll
    for (int q = 0; q < 8; ++q) kv[q] = Kp[q];
    cf x[16];
#pragma unroll
    for (int m = 0; m < 16; ++m) x[m] = lds.ld(b3 + m);
    dft16<false>(x);
#pragma unroll
    for (int q = 0; q < 8; ++q) { x[2 * q] = cmul(x[2 * q], mk(kv[q][0], kv[q][1])); x[2 * q + 1] = cmul(x[2 * q + 1], mk(kv[q][2], kv[q][3])); }
    dft16<true>(x);
#pragma unroll
    for (int m = 0; m < 16; ++m) lds.st(b3 + m, x[m]);
}
#ifdef DIAG
#define HY_SYNC() do { const unsigned long long ts_ = wall_clock64(); wg_sync(); hy_wait_ += wall_clock64() - ts_; } while (0)
#else
#define HY_SYNC() wg_sync()
#endif
__device__ __forceinline__ void hyena_phase(LAS unsigned char* lds, const Args& a, int layer, const bf16* UT, const float* KSP, bf16* YT, int G) {
    const int tid = opq_tid();
#ifdef DIAG
    unsigned long long hy_wait_ = 0; const unsigned long long hy_t0_ = wall_clock64();
#endif
    LdsCf W; W.p = (LAS f32x2v*)lds;
    const int wave = __builtin_amdgcn_readfirstlane(tid >> 6), lane = tid & 63;
    int h1, j1, h2, k1, j2, h3, blk; geo1(tid, h1, j1); geo2(tid, h2, k1, j2); geo3(tid, h3, blk);
    const int fb1 = opqi(fbase1(h1, j1)), fb2 = opqi(fbase2(h2, k1, j2)), fb3 = opqi(fbase3(h3, blk));
    const int jo = opqi(j1), jh = opqi(j1 + 2048 * h1);
    LdsCf ZB; ZB.p = (LAS f32x2v*)lds; const int zo = opqi(HY_X1_OFF / 8 + j1), zh = opqi(HY_X1_OFF / 8 + j1 + 2048 * h1);
    LAS bf16* l16 = (LAS bf16*)lds; const int yh = opqi(HY_YB_OFF / 2 + j1 + 2048 * h1);
    const LAS bf16* ldsh = (const LAS bf16*)lds; const int ro = opqi(HY_VB_OFF / 2 + 8 + j1), rh = opqi(HY_VB_OFF / 2 + 8 + j1 + 2048 * h1);
    float sv, cv;
    sincospif(-(float)j1 / 4096.0f, &sv, &cv); const cf w8192j = mk(cv, sv);
    sincospif(-(float)j1 / 2048.0f, &sv, &cv); const cf w4096j = mk(cv, sv);
    sincospif(-(float)j2 / 128.0f, &sv, &cv);  const cf w256j = mk(cv, sv);
    const cf w32 = mk(0.98078528040323043f, -0.19509032201612825f);
    const float* cw = a.in[I_CONVW] + layer * 3 * C3; const float* cbv = a.in[I_CONVB] + layer * C3; const float* skp = a.in[I_SKIP] + layer * 2 * HYW;
    for (int c = blockIdx.x; c < HYW; c += G) {
        const float x1w0 = uni(cw[c]), x1w1 = uni(cw[C3 + c]), x1w2 = uni(cw[2 * C3 + c]), x1b = uni(cbv[c]);
        const float x2w0 = uni(cw[512 + c]), x2w1 = uni(cw[C3 + 512 + c]), x2w2 = uni(cw[2 * C3 + 512 + c]), x2b = uni(cbv[512 + c]);
        const float vw0 = uni(cw[1024 + c]), vw1 = uni(cw[C3 + 1024 + c]), vw2 = uni(cw[2 * C3 + 1024 + c]), vb = uni(cbv[1024 + c]);
        const float skip0 = uni(skp[c]), skip1 = uni(skp[HYW + c]);
        const float* KS0 = KSP + ((size_t)((layer * 2 + 0) * HYW + c)) * 16384 + opqi(tid * 32);
        const float* KS1 = KSP + ((size_t)((layer * 2 + 1) * HYW + c)) * 16384 + opqi(tid * 32);
        hy_dma_rows(lds, HY_VB_OFF, UT, 0, 1024 + c, wave, lane); hy_pads(lds, HY_VB_OFF, tid); hy_pads(lds, HY_X2_OFF, tid);
        HY_SYNC();
#pragma unroll 1
        for (int pr = 0; pr < 8; ++pr) {
            const int b0 = 2 * pr;
            hy_dma_rows(lds, HY_X1_OFF, UT, b0, c, wave, lane); hy_dma_rows(lds, HY_X2_OFF, UT, b0, 512 + c, wave, lane); hy_pads(lds, HY_X1_OFF, tid);
            cf x[16];
            { cf wp = opq(w8192j);
#pragma unroll
              for (int m = 0; m < 16; ++m) {
                  const cf z = mk(hy_conv(ldsh, ro + 256 * m, vw0, vw1, vw2, vb), hy_conv(ldsh, ro + 256 * m + HY_RAWS, vw0, vw1, vw2, vb));
                  x[m] = csel(h1 == 0, z, cmul(z, wp)); wp = cmul(wp, w32); } }
            fwd_pass1(W, fb1, opq(w4096j), x); wg_sync_lds();
            fwd_pass2(W, fb2, opq(w256j)); wave_lds_fence();
            mid_pass3g(W, fb3, opqp((const GAS f32x4*)KS0)); wave_lds_fence();
            inv_pass2(W, fb2, opq(w256j)); HY_SYNC();
            inv_pass1(W, fb1, opq(w4096j), x);
            cf zz[8];
            { cf wp = opq(w8192j);
#pragma unroll
              for (int m = 0; m < 16; ++m) { x[m] = csel(h1 == 1, cmulc(x[m], wp), x[m]); wp = cmul(wp, w32); }
#pragma unroll
              for (int i = 0; i < 8; ++i) { const cf xa_ = x[i], xb_ = x[8 + i]; const cf mine = csel(h1 == 1, xb_, xa_), send = csel(h1 == 1, xa_, xb_); const cf r = cscale(cadd(mine, shfl_cf(send)), 1.0f / 8192.0f);
                  const float va = hy_conv(ldsh, rh + 256 * i, vw0, vw1, vw2, vb), vbb = hy_conv(ldsh, rh + 256 * i + HY_RAWS, vw0, vw1, vw2, vb);
                  const float xa = hy_conv(ldsh, rh + 256 * i + (HY_X1_OFF - HY_VB_OFF) / 2, x1w0, x1w1, x1w2, x1b), xb = hy_conv(ldsh, rh + 256 * i + (HY_X1_OFF - HY_VB_OFF) / 2 + HY_RAWS, x1w0, x1w1, x1w2, x1b);
                  zz[i] = mk(xa * (r.x + skip0 * va), xb * (r.y + skip0 * vbb)); } }
            wg_sync_lds();
            if (pr < 7) hy_dma_rows(lds, HY_VB_OFF, UT, b0 + 2, 1024 + c, wave, lane);
#pragma unroll
            for (int i = 0; i < 8; ++i) ZB.st(zh + 256 * i, zz[i]);
            wg_sync_lds();
            { cf wp = opq(w8192j);
#pragma unroll
              for (int m = 0; m < 16; ++m) { const cf full = ZB.ld(zo + 256 * m); x[m] = csel(h1 == 0, full, cmul(full, wp)); wp = cmul(wp, w32); } }
            fwd_pass1(W, fb1, opq(w4096j), x); wg_sync_lds();
            fwd_pass2(W, fb2, opq(w256j)); wave_lds_fence();
            mid_pass3g(W, fb3, opqp((const GAS f32x4*)KS1)); wave_lds_fence();
            inv_pass2(W, fb2, opq(w256j)); wg_sync_lds();
            inv_pass1(W, fb1, opq(w4096j), x);
            { cf wp = opq(w8192j);
#pragma unroll
              for (int m = 0; m < 16; ++m) { x[m] = csel(h1 == 1, cmulc(x[m], wp), x[m]); wp = cmul(wp, w32); }
#pragma unroll
              for (int i = 0; i < 8; ++i) { const cf xa_ = x[i], xb_ = x[8 + i]; const cf mine = csel(h1 == 1, xb_, xa_), send = csel(h1 == 1, xa_, xb_); const cf r = cscale(cadd(mine, shfl_cf(send)), 1.0f / 8192.0f);
                  const int p = jh + 256 * i; const cf zv = ZB.ld(zh + 256 * i);
                  const float xa = hy_conv(ldsh, rh + 256 * i + (HY_X2_OFF - HY_VB_OFF) / 2, x2w0, x2w1, x2w2, x2b), xb = hy_conv(ldsh, rh + 256 * i + (HY_X2_OFF - HY_VB_OFF) / 2 + HY_RAWS, x2w0, x2w1, x2w2, x2b);
                  const float ya = xa * (r.x + skip1 * zv.x), yb = xb * (r.y + skip1 * zv.y);
                  l16[yh + 256 * i] = (bf16)f2bf(ya); l16[yh + 256 * i + 4096] = (bf16)f2bf(yb); (void)p; } }
            HY_SYNC();
#pragma unroll
            for (int i = 0; i < 2; ++i) { const int q = tid + NTHR * i, row = q >> 9, cc = q & 511;
                *(v4u*)(YT + (((size_t)((b0 + row) * HYW + c)) << 12) + cc * 8) = *(const LAS v4u*)(l16 + HY_YB_OFF / 2 + row * 4096 + cc * 8); }
        }
    }
#ifdef DIAG
    if (blockIdx.x == 0 && tid == 0) { unsigned long long* dg = (unsigned long long*)(*(const LAS unsigned long long*)(lds + 139328)); atomicAdd(dg + 16, hy_wait_); atomicAdd(dg + 17, wall_clock64() - hy_t0_); }
#endif
}
constexpr int MN_STRIDE = 66;
static_assert(HYW * MN_STRIDE * 2 <= PHASE_LDS, "mix-norm LDS");
__device__ __forceinline__ void mixnorm_phase(LAS unsigned char* lds, const bf16* Ab, const bf16* YT, const float* ga, const float* gy, bf16* mixed, int G) {
    const int tid = opq_tid(), lane = tid & 63, wave = __builtin_amdgcn_readfirstlane(tid >> 6);
    LAS unsigned* tile32 = (LAS unsigned*)lds; const LAS bf16* tile16 = (const LAS bf16*)lds;
    f32x4 gav[2], gyv[2];
    gav[0] = *(const f32x4*)(ga + lane * 8); gav[1] = *(const f32x4*)(ga + lane * 8 + 4); gyv[0] = *(const f32x4*)(gy + lane * 8); gyv[1] = *(const f32x4*)(gy + lane * 8 + 4);
    v4u R[8];
    int unit = blockIdx.x;
    if (unit < M / 64) { const bf16* src = YT + (((size_t)((unit >> 6) * HYW + tid)) << 12) + (unit & 63) * 64;
#pragma unroll
        for (int q = 0; q < 8; ++q) R[q] = *(const v4u*)(src + 8 * q); }
#pragma unroll 1
    for (; unit < M / 64; unit += G) {
        const int b = unit >> 6, t0 = (unit & 63) * 64;
#pragma unroll
        for (int q = 0; q < 8; ++q) { LAS unsigned* d = tile32 + tid * (MN_STRIDE / 2) + 4 * q; d[0] = R[q].x; d[1] = R[q].y; d[2] = R[q].z; d[3] = R[q].w; }
        wg_sync();
        const int nu = unit + G;
        if (nu < M / 64) { const bf16* src = YT + (((size_t)((nu >> 6) * HYW + tid)) << 12) + (nu & 63) * 64;
#pragma unroll
            for (int q = 0; q < 8; ++q) R[q] = *(const v4u*)(src + 8 * q); }
        const size_t row0 = (size_t)b * SEQ + t0 + wave * 8;
        v4u av[8];
#pragma unroll
        for (int i = 0; i < 8; ++i) av[i] = *(const v4u*)(Ab + (row0 + i) * AW + lane * 8);
#pragma unroll
        for (int i = 0; i < 8; ++i) { const int tt = wave * 8 + i;
            float y[8]; float ss = 0.f;
#pragma unroll
            for (int e = 0; e < 8; ++e) { y[e] = bf1(tile16[(lane * 8 + e) * MN_STRIDE + tt]); ss += y[e] * y[e]; }
            const float rs = __builtin_amdgcn_rsqf(wave_sum(ss) * (1.f / 512.f) + EPS);
            v4u o; o.x = pk2(y[0] * rs * gyv[0][0], y[1] * rs * gyv[0][1]); o.y = pk2(y[2] * rs * gyv[0][2], y[3] * rs * gyv[0][3]);
            o.z = pk2(y[4] * rs * gyv[1][0], y[5] * rs * gyv[1][1]); o.w = pk2(y[6] * rs * gyv[1][2], y[7] * rs * gyv[1][3]);
            *(v4u*)(mixed + (row0 + i) * D + 512 + lane * 8) = o; }
#pragma unroll
        for (int i = 0; i < 8; ++i) {
            const float x[8] = {bflo(av[i].x), bfhi(av[i].x), bflo(av[i].y), bfhi(av[i].y), bflo(av[i].z), bfhi(av[i].z), bflo(av[i].w), bfhi(av[i].w)};
            float ss = 0.f;
#pragma unroll
            for (int e = 0; e < 8; ++e) ss += x[e] * x[e];
            const float rs = __builtin_amdgcn_rsqf(wave_sum(ss) * (1.f / 512.f) + EPS);
            v4u o; o.x = pk2(x[0] * rs * gav[0][0], x[1] * rs * gav[0][1]); o.y = pk2(x[2] * rs * gav[0][2], x[3] * rs * gav[0][3]);
            o.z = pk2(x[4] * rs * gav[1][0], x[5] * rs * gav[1][1]); o.w = pk2(x[6] * rs * gav[1][2], x[7] * rs * gav[1][3]);
            *(v4u*)(mixed + (row0 + i) * D + lane * 8) = o; }
        wg_sync();
    }
}

__device__ __forceinline__ void moe_norm_router_phase(LAS unsigned char* lds, const bf16* xb, const float* gain, const float* wr, float* rsrow, int* toke, float* tokw, int* wgcnt, int G) {
    const int tid = opq_tid(), lane = tid & 63, wave = __builtin_amdgcn_readfirstlane(tid >> 6);
    LAS int* cnt = (LAS int*)lds;
    if (tid < 8) cnt[tid] = 0;
    wg_sync();
    const int TPW = M / G;
    f32x4 wra[4][4], wrb[4][4];
#pragma unroll
    for (int j = 0; j < 4; ++j) { const f32x4 gv = *(const f32x4*)(gain + 4 * lane + 256 * j);
#pragma unroll
        for (int q = 0; q < 4; ++q) { const int k = 4 * lane + q + 256 * j; wra[j][q] = *(const f32x4*)(wr + k * 8) * gv[q]; wrb[j][q] = *(const f32x4*)(wr + k * 8 + 4) * gv[q]; } }
    v2u nx[4];
    { const v2u* xr = (const v2u*)(xb + (size_t)(blockIdx.x * TPW + wave) * D) + lane;
#pragma unroll
      for (int j = 0; j < 4; ++j) nx[j] = xr[64 * j]; }
#pragma unroll 1
    for (int i = wave; i < TPW; i += NWAVES) {
        const int t = blockIdx.x * TPW + i;
        v2u cu[4];
#pragma unroll
        for (int j = 0; j < 4; ++j) cu[j] = nx[j];
        if (i + NWAVES < TPW) { const v2u* xr = (const v2u*)(xb + (size_t)(t + NWAVES) * D) + lane;
#pragma unroll
            for (int j = 0; j < 4; ++j) nx[j] = xr[64 * j]; }
        f32x4 v[4]; float s = 0.f;
#pragma unroll
        for (int j = 0; j < 4; ++j) { const v2u a = cu[j]; v[j] = (f32x4){bflo(a.x), bfhi(a.x), bflo(a.y), bfhi(a.y)}; s += (v[j].x * v[j].x + v[j].y * v[j].y) + (v[j].z * v[j].z + v[j].w * v[j].w); }
        const float rs = 1.0f / sqrtf(wave_sum(s) * (1.f / 1024.f) + EPS);
        float lg[8];
#pragma unroll
        for (int e = 0; e < 8; ++e) lg[e] = 0.f;
#pragma unroll
        for (int j = 0; j < 4; ++j)
#pragma unroll
            for (int q = 0; q < 4; ++q) { const f32x4 wa = wra[j][q], wb = wrb[j][q]; const float hv = v[j][q];
                lg[0] += hv * wa[0]; lg[1] += hv * wa[1]; lg[2] += hv * wa[2]; lg[3] += hv * wa[3]; lg[4] += hv * wb[0]; lg[5] += hv * wb[1]; lg[6] += hv * wb[2]; lg[7] += hv * wb[3]; }
        { const bool b5 = lane & 32, b4 = lane & 16, b3 = lane & 8; float k4[4], k2[2], k1;
#pragma unroll
          for (int i = 0; i < 4; ++i) { const float send = b5 ? lg[i] : lg[4 + i], keep = b5 ? lg[4 + i] : lg[i]; k4[i] = keep + __shfl_xor(send, 32); }
#pragma unroll
          for (int i = 0; i < 2; ++i) { const float send = b4 ? k4[i] : k4[2 + i], keep = b4 ? k4[2 + i] : k4[i]; k2[i] = keep + __shfl_xor(send, 16); }
          { const float send = b3 ? k2[0] : k2[1], keep = b3 ? k2[1] : k2[0]; k1 = keep + __shfl_xor(send, 8); }
          k1 += __shfl_xor(k1, 4); k1 += __shfl_xor(k1, 2); k1 += __shfl_xor(k1, 1);
#pragma unroll
          for (int e = 0; e < 8; ++e) lg[e] = __builtin_bit_cast(float, __builtin_amdgcn_readlane(__builtin_bit_cast(int, k1), 8 * e)) * rs; }
        int i0 = 0; float v0 = lg[0];
#pragma unroll
        for (int e = 1; e < 8; ++e) if (lg[e] > v0) { v0 = lg[e]; i0 = e; }
        int i1 = -1; float v1 = -3.0e38f;
#pragma unroll
        for (int e = 0; e < 8; ++e) if (e != i0 && lg[e] > v1) { v1 = lg[e]; i1 = e; }
        const float e1 = __expf(v1 - v0), w0 = 1.0f / (1.0f + e1), w1 = e1 * w0;
        if (lane == 0) { toke[2 * t] = i0; toke[2 * t + 1] = i1; tokw[2 * t] = w0; tokw[2 * t + 1] = w1; rsrow[t] = rs; __hip_atomic_fetch_add(cnt + i0, 1, __ATOMIC_RELAXED, __HIP_MEMORY_SCOPE_WORKGROUP); __hip_atomic_fetch_add(cnt + i1, 1, __ATOMIC_RELAXED, __HIP_MEMORY_SCOPE_WORKGROUP); }
    }
    wg_sync();
    if (tid < 8) wgcnt[blockIdx.x * 8 + tid] = cnt[tid];
    wg_sync();
}
__device__ __forceinline__ void moe_slot_phase(LAS unsigned char* lds, const int* toke, const int* wgcnt, int* tokp, int* tilee, int* meta, const bf16* xb, const float* rsrow, const float* gain, unsigned char* XG8, int G) {
    const int tid = opq_tid(), lane = tid & 63, wave = __builtin_amdgcn_readfirstlane(tid >> 6);
    LAS int* arr = (LAS int*)lds;
    LAS int* pre = arr + 1024 * 8;
    LAS int* wcnt = pre + 32;
    LAS int* slots = wcnt + 64;
    for (int i = tid; i < G * 8; i += NTHR) arr[i] = wgcnt[i];
    wg_sync();
    if (tid < 8) { int p = 0, tot = 0; for (int w = 0; w < G; ++w) { const int c = arr[w * 8 + tid]; if (w < (int)blockIdx.x) p += c; tot += c; } pre[tid] = p; pre[8 + tid] = tot; }
    wg_sync();
    if (tid == 0) { int ps = 0; for (int e = 0; e < 8; ++e) { pre[16 + e] = ps; ps += ((pre[8 + e] + 255) >> 8) << 8; } pre[24] = ps; }
    wg_sync();
    const int TPW = M / G;
    int e_mine = -1, t = 0, rank = 0;
    if (tid < 2 * TPW) { t = blockIdx.x * TPW + (tid >> 1); e_mine = toke[2 * t + (tid & 1)]; }
#pragma unroll
    for (int e = 0; e < 8; ++e) { const unsigned long long mk_ = __ballot(e_mine == e); if (e_mine == e) rank = __popcll(mk_ & ((1ull << lane) - 1ull)); if (lane == 0) wcnt[wave * 8 + e] = __popcll(mk_); }
    wg_sync();
    if (e_mine >= 0) { int base = pre[16 + e_mine] + pre[e_mine]; for (int w = 0; w < wave; ++w) base += wcnt[w * 8 + e_mine];
        const int slot = base + rank; slots[tid] = slot; tokp[2 * t + (tid & 1)] = slot; }
    else slots[tid] = -1;
    if ((int)blockIdx.x < 8) { const int e = blockIdx.x, s0 = pre[16 + e] + pre[8 + e], s1 = pre[16 + e] + (((pre[8 + e] + 255) >> 8) << 8);
        unsigned z0 = 0u; asm volatile("" : "+v"(z0));
        for (int i = tid; i < (s1 - s0) * 64; i += NTHR) ((v4u*)(XG8 + (size_t)s0 * D))[i] = (v4u){z0, z0, z0, z0}; }
    if (blockIdx.x == 0) { const int ntiles = pre[24] >> 8;
        for (int ti = tid; ti < ntiles; ti += NTHR) { int e = 0;
#pragma unroll
            for (int q = 1; q < 8; ++q) if (ti * 256 >= pre[16 + q]) e = q;
            tilee[ti] = e; }
        if (tid == 0) meta[0] = ntiles; }
    wg_sync();
    { f32x4 g[4];
#pragma unroll
      for (int q = 0; q < 4; ++q) g[q] = *(const f32x4*)(gain + 16 * lane + 4 * q);
#pragma unroll 1
      for (int a0 = wave * 64; a0 < wave * 64 + 64; a0 += 2) {
          v4u av[2][2]; float rs[2]; int sl[2];
#pragma unroll
          for (int u = 0; u < 2; ++u) { const int a = a0 + u; sl[u] = slots[a]; const int tt = blockIdx.x * TPW + (a >> 1); rs[u] = rsrow[tt]; const v4u* src = (const v4u*)(xb + (size_t)tt * D) + 2 * lane; av[u][0] = src[0]; av[u][1] = src[1]; }
#pragma unroll
          for (int u = 0; u < 2; ++u) if (sl[u] >= 0) { v4u o;
#pragma unroll
              for (int h = 0; h < 2; ++h) { const unsigned w4[4] = {av[u][h].x, av[u][h].y, av[u][h].z, av[u][h].w};
#pragma unroll
                  for (int q = 0; q < 2; ++q) { int w = 0;
                      w = __builtin_amdgcn_cvt_pk_fp8_f32(bflo(w4[2 * q]) * rs[u] * g[2 * h + q][0], bfhi(w4[2 * q]) * rs[u] * g[2 * h + q][1], w, false);
                      w = __builtin_amdgcn_cvt_pk_fp8_f32(bflo(w4[2 * q + 1]) * rs[u] * g[2 * h + q][2], bfhi(w4[2 * q + 1]) * rs[u] * g[2 * h + q][3], w, true);
                      o[2 * h + q] = (unsigned)w; } }
              ((v4u*)(XG8 + (size_t)sl[u] * D))[lane] = o; } } }
    wg_sync();
}
__device__ __forceinline__ void moe_gather_phase(const bf16* xb, const float* rsrow, const float* gain, const int* rowtok, bf16* XG, int nrows, int gw, int NGW, int lane) {
    f32x4 g[4];
#pragma unroll
    for (int q = 0; q < 4; ++q) g[q] = *(const f32x4*)(gain + (q >> 1) * 512 + 8 * lane + 4 * (q & 1));
    for (int r = gw; r < nrows; r += NGW) { const int t = rowtok[r]; const float rs = rsrow[t]; const v4u* src = (const v4u*)(xb + (size_t)t * D); v4u* dst = (v4u*)(XG + (size_t)r * D);
#pragma unroll
        for (int h = 0; h < 2; ++h) { const v4u a = src[64 * h + lane]; v4u o;
            o.x = pk2(bflo(a.x) * rs * g[2 * h][0], bfhi(a.x) * rs * g[2 * h][1]); o.y = pk2(bflo(a.y) * rs * g[2 * h][2], bfhi(a.y) * rs * g[2 * h][3]);
            o.z = pk2(bflo(a.z) * rs * g[2 * h + 1][0], bfhi(a.z) * rs * g[2 * h + 1][1]); o.w = pk2(bflo(a.w) * rs * g[2 * h + 1][2], bfhi(a.w) * rs * g[2 * h + 1][3]);
            dst[64 * h + lane] = o; } }
}
__device__ __forceinline__ void moe_combine_final_phase(const bf16* xb, float* out, const bf16* YB, const int* tokp, const float* tokw, const float* gain, int gw, int NGW, int lane) {
    f32x4 g[4];
#pragma unroll
    for (int q = 0; q < 4; ++q) g[q] = *(const f32x4*)(gain + (q >> 1) * 512 + 8 * lane + 4 * (q & 1));
#pragma unroll 1
    for (int t0 = gw; t0 < M; t0 += 2 * NGW) {
        v4u xa[2][2], ya[2][2], yb[2][2]; float w0[2], w1[2]; bool on[2];
#pragma unroll
        for (int u = 0; u < 2; ++u) { const int t = t0 + u * NGW; on[u] = t < M; const int tt = on[u] ? t : t0;
            const int p0 = tokp[2 * tt], p1 = tokp[2 * tt + 1]; w0[u] = tokw[2 * tt]; w1[u] = tokw[2 * tt + 1];
            const v4u* xr = (const v4u*)(xb + (size_t)tt * D) + lane; const v4u* y0 = (const v4u*)(YB + (size_t)p0 * D) + lane; const v4u* y1 = (const v4u*)(YB + (size_t)p1 * D) + lane;
#pragma unroll
            for (int h = 0; h < 2; ++h) { xa[u][h] = xr[64 * h]; ya[u][h] = y0[64 * h]; yb[u][h] = y1[64 * h]; } }
#pragma unroll
        for (int u = 0; u < 2; ++u) { const int t = t0 + u * NGW; float v[2][8]; float s = 0.f;
#pragma unroll
            for (int h = 0; h < 2; ++h) { const unsigned xw[4] = {xa[u][h].x, xa[u][h].y, xa[u][h].z, xa[u][h].w}, aw[4] = {ya[u][h].x, ya[u][h].y, ya[u][h].z, ya[u][h].w}, bw[4] = {yb[u][h].x, yb[u][h].y, yb[u][h].z, yb[u][h].w};
#pragma unroll
                for (int q = 0; q < 4; ++q) { v[h][2 * q] = bflo(xw[q]) + w0[u] * bflo(aw[q]) + w1[u] * bflo(bw[q]); v[h][2 * q + 1] = bfhi(xw[q]) + w0[u] * bfhi(aw[q]) + w1[u] * bfhi(bw[q]);
                    s += v[h][2 * q] * v[h][2 * q] + v[h][2 * q + 1] * v[h][2 * q + 1]; } }
            const float rs = 1.0f / sqrtf(wave_sum(s) * (1.f / 1024.f) + EPS);
            if (on[u]) { f32x4* orow = (f32x4*)(out + (size_t)t * D);
#pragma unroll
                for (int h = 0; h < 2; ++h) { orow[128 * h + 2 * lane] = (f32x4){v[h][0], v[h][1], v[h][2], v[h][3]} * rs * g[2 * h]; orow[128 * h + 2 * lane + 1] = (f32x4){v[h][4], v[h][5], v[h][6], v[h][7]} * rs * g[2 * h + 1]; } } }
    }
}
struct MoeOrder : pg8::StaticOrder {
    const int* tilee; int tile0; size_t bstride;
    __device__ __forceinline__ size_t boff(const pg8::Unit& u) const { return (size_t)tilee[tile0 + u.pm] * bstride; }
};
#ifndef LB_WAVES
#define LB_WAVES 2
#endif
constexpr int N_PHASES_C = 25;
__global__ void __launch_bounds__(NTHR, LB_WAVES) fwd_kernel(Args args) {
    extern __shared__ __attribute__((aligned(16))) unsigned char lds_raw[];
    LAS unsigned char* lds = (LAS unsigned char*)lds_raw;
    const int tid0 = threadIdx.x;
    const int G = gridDim.x, NGW = G * NWAVES;
    unsigned char* ws = args.ws;
    gu32* ctl = (gu32*)(ws + WS_CTL);
    volatile LAS unsigned* MISC = (volatile LAS unsigned*)(lds + MISC_OFF);
    for (int u = tid0; u < (LDS_BYTES - LDSCTL_OFF) / 4; u += NTHR) ((LAS unsigned*)(lds + LDSCTL_OFF))[u] = 0u;
#ifdef DIAG
#ifndef DIAG_WG
#define DIAG_WG 0
#endif
#ifndef DIAG_PH
#define DIAG_PH 0
#endif
#ifndef DIAG_DIV
#define DIAG_DIV 1
#endif
    static_assert(MISC_OFF == 139328, "diag pointer slot");
    if (tid0 == 0) ((LAS unsigned long long*)(lds + MISC_OFF))[0] = (unsigned long long)(ws + WS_CTL + 512 * 1024);
#endif
    __syncthreads();
    XcdBarrier bar; bar.bar = (unsigned*)(ctl + CW_BAR); bar.x = 0; bar.st = nullptr;
    if (args.use_bar) bar = xcd_barrier_post((unsigned*)(ctl + CW_BAR), MISC + 8);
    const int lo = args.ph_lo, hi = args.ph_hi;
    int ph = 0;
#ifndef PHMASK
#define PHMASK 0xffffffffu
#endif
#define EN(k) (((PHMASK) >> (k)) & 1u)
#define PH_ON() (ph >= lo && ph < hi)
#define LOCAL_IDS() const int tid = opq_tid(), lane = tid & 63, wave = __builtin_amdgcn_readfirstlane(tid >> 6), gw = blockIdx.x * NWAVES + wave; (void)lane; (void)gw
#ifndef DUPMASK
#define DUPMASK 0u
#endif
#define RES_DST(k) ((NREP(k) > 1 && rep_ + 1 < NREP(k)) ? (bf16*)args.out : HB)
#ifndef DUPN
#define DUPN 2
#endif
#define NREP(k) ((((DUPMASK) >> (k)) & 1u) ? DUPN : 1)
#ifdef DIAG
#define PH_END_K(k) do { if (args.use_bar && (ph + 1 < hi || rep_ + 1 < NREP(k))) { const unsigned long long tb_ = wall_clock64(); xcd_barrier(bar); if (threadIdx.x == 0) { unsigned long long* dg = (unsigned long long*)(ws + WS_CTL + 512 * 1024); const unsigned long long w_ = wall_clock64() - tb_; atomicAdd(dg + 5, w_); if (ph == DIAG_PH) atomicAdd(dg + 6, w_); } } } while (0)
#else
#define PH_END_K(k) do { if (args.use_bar && (ph + 1 < hi || rep_ + 1 < NREP(k))) xcd_barrier(bar); } while (0)
#endif

    float* cosT = (float*)(ws + WS_COS); float* sinT = (float*)(ws + WS_SIN); float* H2 = (float*)(ws + WS_H2);
    int* toke = (int*)(ws + WS_TOKE); float* tokw = (float*)(ws + WS_TOKW); int* tokp = (int*)(ws + WS_TOKP); int* rowtok = (int*)(ws + WS_ROWTOK);
    int* tilee = (int*)(ws + WS_TILEE); int* wgcnt = (int*)(ws + WS_WGCNT); int* meta = (int*)(ws + WS_META); float* rsrow = (float*)(ws + WS_RSROW);
    bf16* WINA = (bf16*)(ws + WS_WINA); bf16* WINB = (bf16*)(ws + WS_WINB); bf16* WOUT = (bf16*)(ws + WS_WOUT); bf16* XQ = (bf16*)(ws + WS_XQ); bf16* XK = (bf16*)(ws + WS_XK);
    bf16* XV = (bf16*)(ws + WS_XV); bf16* XO = (bf16*)(ws + WS_XO); bf16* FGU = (bf16*)(ws + WS_FGU); bf16* FDN = (bf16*)(ws + WS_FDN); bf16* MGU = (bf16*)(ws + WS_MGU); bf16* MDN = (bf16*)(ws + WS_MDN);
    float* KF = (float*)(ws + WS_KFILT); bf16* MB = (bf16*)(ws + WS_MB); bf16* KMEM = (bf16*)(ws + WS_KMEM); bf16* VMEMT = (bf16*)(ws + WS_VMEMT); bf16* HB = (bf16*)(ws + WS_HB);
    bf16* QB = (bf16*)(ws + WS_QB); bf16* KB = (bf16*)(ws + WS_KB); bf16* VB = (bf16*)(ws + WS_VB); bf16* UT = (bf16*)(ws + WS_UT); bf16* AB = (bf16*)(ws + WS_AB); bf16* YT = (bf16*)(ws + WS_YT);
    bf16* MIXED = (bf16*)(ws + WS_MIXED); float* SS = (float*)(ws + WS_SS);
    bf16* XQB = (bf16*)(ws + WS_XQB); bf16* XOB = (bf16*)(ws + WS_XOB); bf16* ACT = (bf16*)(ws + WS_ACT); unsigned char* XG8 = ws + WS_XG; bf16* YB = (bf16*)(ws + WS_YB); unsigned char* MGU8 = ws + WS_MGU; bf16* MACT = (bf16*)(ws + WS_MACT);
    const float* const* in = args.in;

    if (EN(0) && PH_ON()) for (int rep_ = 0; rep_ < NREP(0); ++rep_) { asm volatile("; PHASE_MARK 0"); LOCAL_IDS();
        LAS float* scr = (LAS float*)(lds + wave * 8704);
        constexpr int IT_L = 384 + 768 + 512 + 4 * 256, IT_D = 3 * 1408, IT_E = 3 * 1792, IT_ALL = 2 * IT_L + IT_D + NE * IT_E;
#pragma unroll 1
        for (int it = gw; it < IT_ALL; it += NGW) {
            const float* W; int ldw, K, col0 = 0, ncols, mode = 0; bf16* WT; const float* gk = nullptr; int r = it;
            if (r < 2 * IT_L) { const int l = r / IT_L; r -= l * IT_L;
                if (r < 384) { W = in[I_WIN] + (size_t)l * D * INC; ldw = INC; K = D; ncols = 768; WT = WINA + (size_t)l * 768 * D; mode = 1; gk = in[I_MIXNORM] + l * D; }
                else if ((r -= 384) < 768) { W = in[I_WIN] + (size_t)l * D * INC; ldw = INC; K = D; col0 = 768; ncols = C3; WT = WINB + (size_t)l * C3 * D; gk = in[I_MIXNORM] + l * D; }
                else if ((r -= 768) < 512) { W = in[I_WOUT] + (size_t)l * D * D; ldw = D; K = D; ncols = D; WT = WOUT + (size_t)l * D * D; }
                else if ((r -= 512) < 256) { W = in[I_XWQ] + (size_t)l * D * XW; ldw = XW; K = D; ncols = XW; WT = XQ + (size_t)l * XW * D; gk = in[I_XNORM] + l * D; }
                else if ((r -= 256) < 256) { W = in[I_XWK] + (size_t)l * D * XW; ldw = XW; K = D; ncols = XW; WT = XK + (size_t)l * XW * D; }
                else if ((r -= 256) < 256) { W = in[I_XWV] + (size_t)l * D * XW; ldw = XW; K = D; ncols = XW; WT = XV + (size_t)l * XW * D; }
                else { r -= 256; W = in[I_XWO] + (size_t)l * XW * D; ldw = D; K = XW; ncols = D; WT = XO + (size_t)l * D * XW; }
            } else if ((r -= 2 * IT_L) < IT_D) {
                if (r < 1408) { W = in[I_FGATE]; ldw = FF; K = D; ncols = FF; WT = FGU; mode = 2; gk = in[I_FNORM]; }
                else if ((r -= 1408) < 1408) { W = in[I_FUP]; ldw = FF; K = D; ncols = FF; WT = FGU; mode = 3; gk = in[I_FNORM]; }
                else { r -= 1408; W = in[I_FDOWN]; ldw = D; K = FF; ncols = D; WT = FDN; }
            } else { r -= IT_D; const int e = r / IT_E; r -= e * IT_E;
                if (r < 2 * 1792) { const bool up = r >= 1792; if (up) r -= 1792;
                    tr_item8(in[up ? I_MUP : I_MGATE] + (size_t)e * D * FFE, FFE, D, FFE, MGU8 + (size_t)e * 2 * FFE * D, up ? 3 : 2, 32.0f, r, scr, lane); continue; }
                else { r -= 2 * 1792; tr_item8(in[I_MDOWN] + (size_t)e * FFE * D, D, FFE, D, (unsigned char*)MDN + (size_t)e * D * FFE, 0, 32.0f, r, scr, lane); continue; }
            }
            tr_item(W, ldw, K, col0, ncols, WT, mode, gk, r, scr, lane);
        }
        for (int i = blockIdx.x * NTHR + tid; i < SEQ * 32; i += G * NTHR) { const int pos = i >> 5, f = i & 31;
            const float inv = (float)pow(10000.0, -(double)f / 32.0); const float ang = (float)pos * inv;
            cosT[i] = (float)cos((double)ang); sinT[i] = (float)sin((double)ang); }
        h2_rows(args, H2, gw, NGW, lane);
        norm_rows(in[I_MEM], in[I_MEMNORM], MB, MROWS, gw, NGW, lane);
        xb_rows(in[I_X], HB, SS, M, gw, NGW, lane);
        PH_END_K(0);
    }
    ++ph;
    if (EN(1) && PH_ON()) for (int rep_ = 0; rep_ < NREP(1); ++rep_) { asm volatile("; PHASE_MARK 1"); LOCAL_IDS();
        kfilt_phase(lds, H2, in[I_FW3], KF, G);
        PH_END_K(1);
    }
    ++ph;

#pragma unroll 1
    for (int l = 0; l < 2; ++l) {
        if (EN(2) && PH_ON()) for (int rep_ = 0; rep_ < NREP(2); ++rep_) { asm volatile("; PHASE_MARK 2"); LOCAL_IDS();
            if (l == 0) {
                kspec_phase(lds, KF, (float*)(ws + WS_KSPEC), G);
                { pg8::Gemm g{MB, XK, MROWS, 1024, D}; pg8::StaticOrder S; S.init(MROWS, 1024, G, (int)blockIdx.x); pg8::EpiBf16 E{KMEM, 1024, nullptr, 1.0f};
                  pg8::gemm_phase<pg8::EpiBf16, pg8::StaticOrder, PG8_ALIGN, PG8_SP2>(lds, g, S, E); }
                { pg8::Gemm g{MB, XV, MROWS, 1024, D}; pg8::StaticOrder S; S.init(MROWS, 1024, G, G >= 128 ? (int)((blockIdx.x + G - 64) % G) : (int)blockIdx.x); pg8::EpiT E{VMEMT, 1024, 12, nullptr};
                  pg8::gemm_phase<pg8::EpiT, pg8::StaticOrder, PG8_ALIGN, PG8_SP2>(lds, g, S, E); }
            }
            { pg8::Gemm g{HB, WINA + (size_t)l * 768 * D, M, 768, D}; pg8::StaticOrder S; S.init(M, 768, G, (int)blockIdx.x); pg8::EpiQKV E{QB, KB, VB, cosT, sinT, SS + (size_t)(3 * l) * SS_STRIDE};
              pg8::gemm_phase<pg8::EpiQKV, pg8::StaticOrder, PG8_ALIGN, PG8_SP2>(lds, g, S, E); }
            { pg8::Gemm g{HB, WINB + (size_t)l * C3 * D, M, C3, D}; pg8::StaticOrder S; S.init(M, C3, G, (int)blockIdx.x); pg8::EpiT E{UT, C3, 12, SS + (size_t)(3 * l) * SS_STRIDE};
              pg8::gemm_phase<pg8::EpiT, pg8::StaticOrder, PG8_ALIGN, PG8_SP2>(lds, g, S, E); }
            PH_END_K(2);
        }
        ++ph;
        if (EN(3) && PH_ON()) for (int rep_ = 0; rep_ < NREP(3); ++rep_) { asm volatile("; PHASE_MARK 3"); LOCAL_IDS();
#ifndef BA_REP
#define BA_REP 1
#endif
#ifndef HY_REP
#define HY_REP 1
#endif
#pragma unroll 1
            for (int r_ = 0; r_ < BA_REP; ++r_) band_attention_phase(lds, QB, KB, VB, AB, in[I_SINK] + l * NH, G);
#pragma unroll 1
            for (int r_ = 0; r_ < HY_REP; ++r_) hyena_phase(lds, args, l, UT, (const float*)(ws + WS_KSPEC), YT, G);
            PH_END_K(3);
        }
        ++ph;
        if (EN(4) && PH_ON()) for (int rep_ = 0; rep_ < NREP(4); ++rep_) { asm volatile("; PHASE_MARK 4"); LOCAL_IDS(); mixnorm_phase(lds, AB, YT, in[I_ANORM] + l * AW, in[I_YNORM] + l * HYW, MIXED, G); PH_END_K(4); }
        ++ph;
        if (EN(5) && PH_ON()) for (int rep_ = 0; rep_ < NREP(5); ++rep_) { asm volatile("; PHASE_MARK 5"); LOCAL_IDS();
            pg8::Gemm g{MIXED, WOUT + (size_t)l * D * D, M, D, D}; pg8::StaticOrder S; S.init(M, D, G, (int)blockIdx.x); pg8::EpiResB E{HB, D, SS + (size_t)(3 * l + 1) * SS_STRIDE, RES_DST(5)};
            pg8::gemm_phase<pg8::EpiResB, pg8::StaticOrder, PG8_ALIGN, PG8_SP2>(lds, g, S, E);
            PH_END_K(5);
        }
        ++ph;
        if (EN(7) && PH_ON()) for (int rep_ = 0; rep_ < NREP(7); ++rep_) { asm volatile("; PHASE_MARK 7"); LOCAL_IDS();
            pg8::Gemm g{HB, XQ + (size_t)l * XW * D, M, XW, D}; pg8::StaticOrder S; S.init(M, XW, G, (int)blockIdx.x); pg8::EpiBf16 E{XQB, XW, SS + (size_t)(3 * l + 1) * SS_STRIDE, 1.0f};
            pg8::gemm_phase<pg8::EpiBf16, pg8::StaticOrder, PG8_ALIGN, PG8_SP2>(lds, g, S, E);
            PH_END_K(7);
        }
        ++ph;
        if (EN(8) && PH_ON()) for (int rep_ = 0; rep_ < NREP(8); ++rep_) { asm volatile("; PHASE_MARK 8"); LOCAL_IDS(); cross_attention_phase(lds, XQB, KMEM, VMEMT, XOB, l, G); PH_END_K(8); }
        ++ph;
        if (EN(9) && PH_ON()) for (int rep_ = 0; rep_ < NREP(9); ++rep_) { asm volatile("; PHASE_MARK 9"); LOCAL_IDS();
            pg8::Gemm g{XOB, XO + (size_t)l * D * XW, M, D, XW}; pg8::StaticOrder S; S.init(M, D, G, (int)blockIdx.x); pg8::EpiResB E{HB, D, l == 0 ? SS + (size_t)2 * SS_STRIDE : nullptr, RES_DST(9)};
            pg8::gemm_phase<pg8::EpiResB, pg8::StaticOrder, PG8_ALIGN, PG8_SP2>(lds, g, S, E);
            PH_END_K(9);
        }
        ++ph;
        if (l == 0) {
            if (EN(11) && PH_ON()) for (int rep_ = 0; rep_ < NREP(11); ++rep_) { asm volatile("; PHASE_MARK 11"); LOCAL_IDS();
                pg8::Gemm g{HB, FGU, M, 2 * FF, D}; pg8::StaticOrder S; S.init(M, 2 * FF, G, (int)blockIdx.x); pg8::EpiSwiglu<true> E{ACT, FF, SS + (size_t)2 * SS_STRIDE};
                pg8::gemm_phase<pg8::EpiSwiglu<true>, pg8::StaticOrder, PG8_ALIGN, PG8_SP2>(lds, g, S, E);
                PH_END_K(11);
            }
            ++ph;
            if (EN(12) && PH_ON()) for (int rep_ = 0; rep_ < NREP(12); ++rep_) { asm volatile("; PHASE_MARK 12"); LOCAL_IDS();
                pg8::Gemm g{ACT, FDN, M, D, FF}; pg8::StaticOrder S; S.init(M, D, G, (int)blockIdx.x); pg8::EpiResB E{HB, D, SS + (size_t)3 * SS_STRIDE, RES_DST(12)};
                pg8::gemm_phase<pg8::EpiResB, pg8::StaticOrder, PG8_ALIGN, PG8_SP2>(lds, g, S, E);
                PH_END_K(12);
            }
            ++ph;
        } else {
            if (EN(14) && PH_ON()) for (int rep_ = 0; rep_ < NREP(14); ++rep_) { asm volatile("; PHASE_MARK 14"); LOCAL_IDS(); moe_norm_router_phase(lds, HB, in[I_FNORM] + D, in[I_ROUTER], rsrow, toke, tokw, wgcnt, G); PH_END_K(14); }
            ++ph;
            if (EN(15) && PH_ON()) for (int rep_ = 0; rep_ < NREP(15); ++rep_) { asm volatile("; PHASE_MARK 15"); LOCAL_IDS(); moe_slot_phase(lds, toke, wgcnt, tokp, tilee, meta, HB, rsrow, in[I_FNORM] + D, XG8, G); PH_END_K(15); }
            ++ph;
#pragma unroll 1
            for (int ci = 0; ci < MOE_NCHUNK; ++ci) {
                if (EN(17) && PH_ON()) for (int rep_ = 0; rep_ < NREP(17); ++rep_) { asm volatile("; PHASE_MARK 17"); LOCAL_IDS();
                    const int ntiles = meta[0], tile0 = ci * MOE_CH_TILES, nt = ci < MOE_NCHUNK - 1 ? MOE_CH_TILES : ntiles - (MOE_NCHUNK - 1) * MOE_CH_TILES;
                    int k8 = D / 2; asm volatile("" : "+s"(k8));
                    pg8::Gemm g{(const bf16*)(XG8 + (size_t)tile0 * 256 * D), (const bf16*)MGU8, nt * 256, 2 * FFE, k8};
                    MoeOrder S; S.init(nt * 256, 2 * FFE, G, (int)blockIdx.x); S.tilee = tilee; S.tile0 = tile0; S.bstride = (size_t)2 * FFE * D;
                    pg8::EpiSwiglu<false, true, true> E{MACT, FFE, nullptr};
                    pg8::gemm_phase<pg8::EpiSwiglu<false, true, true>, MoeOrder, PG8_ALIGN, PG8_SP2>(lds, g, S, E);
                    PH_END_K(17);
                }
                ++ph;
                if (EN(18) && PH_ON()) for (int rep_ = 0; rep_ < NREP(18); ++rep_) { asm volatile("; PHASE_MARK 18"); LOCAL_IDS();
                    const int ntiles = meta[0], tile0 = ci * MOE_CH_TILES, nt = ci < MOE_NCHUNK - 1 ? MOE_CH_TILES : ntiles - (MOE_NCHUNK - 1) * MOE_CH_TILES;
                    int k8 = FFE / 2; asm volatile("" : "+s"(k8));
                    pg8::Gemm g{MACT, MDN, nt * 256, D, k8};
                    MoeOrder S; S.init(nt * 256, D, G, (int)blockIdx.x); S.tilee = tilee; S.tile0 = tile0; S.bstride = (size_t)D * FFE;
                    pg8::EpiBf16T<true> E{YB + (size_t)tile0 * 256 * D, D, nullptr, 1.0f / 128.0f};
                    pg8::gemm_phase<pg8::EpiBf16T<true>, MoeOrder, PG8_ALIGN, PG8_SP2>(lds, g, S, E);
                    PH_END_K(18);
                }
                ++ph;
            }
            if (EN(19) && PH_ON()) for (int rep_ = 0; rep_ < NREP(19); ++rep_) { asm volatile("; PHASE_MARK 19"); LOCAL_IDS(); moe_combine_final_phase(HB, args.out, YB, tokp, tokw, in[I_FINAL], gw, NGW, lane); PH_END_K(19); }
            ++ph;
        }
    }
#ifdef DIAG
    if (blockIdx.x == DIAG_WG && tid0 == 0 && hi == N_PHASES_C) { const unsigned long long v = ((unsigned long long*)(ws + WS_CTL + 512 * 1024))[DIAG_SEL] * DIAG_MULT / DIAG_DIV; const unsigned long long t0 = wall_clock64(); while (wall_clock64() - t0 < v) __builtin_amdgcn_s_sleep(8); }
#endif
#undef PH_ON
}
constexpr int N_PHASES = 2 + 7 + 2 + 7 + 2 + 2 * MOE_NCHUNK + 1;

#ifndef MK_PER_PHASE
#define MK_PER_PHASE 0
#endif
extern "C" void kernel_launch(void* const* d_in, const int* in_sizes, int n_in, void* d_out, int out_size, void* d_ws, size_t ws_size, hipStream_t stream) {
    static int grid = 0;
    if (grid == 0) {
        if (n_in != 33 || in_sizes[0] != M * D || out_size != M * D || ws_size < WS_END) {
            fprintf(stderr, "kernel_launch: unexpected problem: n_in %d in0 %d out %d ws %zu (need %zu); nothing launched\n", n_in, n_in > 0 ? in_sizes[0] : -1, out_size, ws_size, (size_t)WS_END); grid = -1; return; }
        int dev = 0, cus = 0, per_cu = 0;
        if (hipGetDevice(&dev) != hipSuccess || hipDeviceGetAttribute(&cus, hipDeviceAttributeMultiprocessorCount, dev) != hipSuccess) { fprintf(stderr, "kernel_launch: device query failed\n"); grid = -1; return; }
        if (hipFuncSetAttribute((const void*)fwd_kernel, hipFuncAttributeMaxDynamicSharedMemorySize, LDS_BYTES) != hipSuccess) { fprintf(stderr, "kernel_launch: hipFuncSetAttribute failed\n"); grid = -1; return; }
        if (hipOccupancyMaxActiveBlocksPerMultiprocessor(&per_cu, (const void*)fwd_kernel, NTHR, LDS_BYTES) != hipSuccess || per_cu < 1) { fprintf(stderr, "kernel_launch: occupancy query reports %d\n", per_cu); }
        (void)hipGetLastError();
        grid = cus;
        if (grid > 256) grid = 256;
        while (grid > 1 && (M % grid != 0 || M / grid > 256)) --grid;
        if (grid != 256) fprintf(stderr, "kernel_launch: note: grid %d\n", grid);
    }
    if (grid < 0) return;
    if (hipMemsetAsync((char*)d_ws + WS_CTL, 0, CTL_ZERO_BYTES, stream) != hipSuccess) { fprintf(stderr, "kernel_launch: memset failed\n"); return; }
    Args a{};
    for (int i = 0; i < 33; ++i) a.in[i] = (const float*)d_in[i];
    a.out = (float*)d_out; a.ws = (unsigned char*)d_ws;
#if MK_PER_PHASE
    for (int p = 0; p < N_PHASES; ++p) { a.ph_lo = p; a.ph_hi = p + 1; a.use_bar = 0; a.pad = 0; hipLaunchKernelGGL(fwd_kernel, dim3(grid), dim3(NTHR), LDS_BYTES, stream, a); }
#else
    a.ph_lo = 0; a.ph_hi = N_PHASES; a.use_bar = 1; a.pad = 0;
    hipLaunchKernelGGL(fwd_kernel, dim3(grid), dim3(NTHR), LDS_BYTES, stream, a);
#endif
    const hipError_t le = hipPeekAtLastError();
    if (le != hipSuccess) fprintf(stderr, "kernel_launch: launch failed: %s\n", hipGetErrorName(le));
}
```

```cpp
#include <hip/hip_runtime.h>
#include <cstdio>
#include <cstdint>
#ifndef HD
#define HD __host__ __device__ __forceinline__
#endif
__device__ __forceinline__ int opq_tid() { int t = (int)threadIdx.x; asm volatile("" : "+v"(t)); return t; }
typedef float f32x2_cv __attribute__((ext_vector_type(2))); typedef __bf16 bf16x2_cv __attribute__((ext_vector_type(2)));
__device__ __forceinline__ unsigned cvtpk_hw(float lo, float hi) { f32x2_cv v = {lo, hi}; bf16x2_cv b = __builtin_convertvector(v, bf16x2_cv); return __builtin_bit_cast(unsigned, b); }

struct cf { float x, y; };
HD cf mk(float a, float b) { cf r; r.x = a; r.y = b; return r; }
HD cf cadd(cf a, cf b) { return mk(a.x + b.x, a.y + b.y); }
HD cf csub(cf a, cf b) { return mk(a.x - b.x, a.y - b.y); }
HD cf cmul(cf a, cf b) { return mk(a.x * b.x - a.y * b.y, a.x * b.y + a.y * b.x); }
HD cf cmulc(cf a, cf b) { return mk(a.x * b.x + a.y * b.y, a.y * b.x - a.x * b.y); }
template <bool INV> HD cf cmulw(cf a, cf w) { return INV ? cmulc(a, w) : cmul(a, w); }
HD cf cscale(cf a, float s) { return mk(a.x * s, a.y * s); }

template <bool INV> HD void dft4(cf& a0, cf& a1, cf& a2, cf& a3) {
    const cf t0 = cadd(a0, a2), t1 = csub(a0, a2), t2 = cadd(a1, a3), t3 = csub(a1, a3);
    a0 = cadd(t0, t2); a2 = csub(t0, t2);
    const cf mit3 = mk(t3.y, -t3.x);
    if (!INV) { a1 = cadd(t1, mit3); a3 = csub(t1, mit3); }
    else      { a1 = csub(t1, mit3); a3 = cadd(t1, mit3); }
}
template <bool INV> HD void dft16(cf (&x)[16]) {
#pragma unroll
    for (int n1 = 0; n1 < 4; ++n1) dft4<INV>(x[n1], x[n1 + 4], x[n1 + 8], x[n1 + 12]);
    const float c1 = 0.92387953251128674f, s1 = 0.38268343236508977f, r2 = 0.70710678118654752f;
    const cf W1 = mk(c1, -s1), W2 = mk(r2, -r2), W3 = mk(s1, -c1), W6 = mk(-r2, -r2), W9 = mk(-c1, s1);
    x[1 + 4 * 1] = cmulw<INV>(x[1 + 4 * 1], W1);
    x[1 + 4 * 2] = cmulw<INV>(x[1 + 4 * 2], W2);
    x[1 + 4 * 3] = cmulw<INV>(x[1 + 4 * 3], W3);
    x[2 + 4 * 1] = cmulw<INV>(x[2 + 4 * 1], W2);
    { const cf t = x[2 + 4 * 2]; x[2 + 4 * 2] = INV ? mk(-t.y, t.x) : mk(t.y, -t.x); }
    x[2 + 4 * 3] = cmulw<INV>(x[2 + 4 * 3], W6);
    x[3 + 4 * 1] = cmulw<INV>(x[3 + 4 * 1], W3);
    x[3 + 4 * 2] = cmulw<INV>(x[3 + 4 * 2], W6);
    x[3 + 4 * 3] = cmulw<INV>(x[3 + 4 * 3], W9);
#pragma unroll
    for (int k2 = 0; k2 < 4; ++k2) dft4<INV>(x[0 + 4 * k2], x[1 + 4 * k2], x[2 + 4 * k2], x[3 + 4 * k2]);
    cf t;
    t = x[1]; x[1] = x[4]; x[4] = t;   t = x[2]; x[2] = x[8]; x[8] = t;   t = x[3]; x[3] = x[12]; x[12] = t;
    t = x[6]; x[6] = x[9]; x[9] = t;   t = x[7]; x[7] = x[13]; x[13] = t; t = x[11]; x[11] = x[14]; x[14] = t;
}
template <bool INV> HD void twiddle16(cf (&x)[16], cf w1) {
    cf w = w1;
#pragma unroll
    for (int k = 1; k < 16; ++k) { x[k] = cmulw<INV>(x[k], w); if (k < 15) w = cmul(w, w1); }
}
constexpr int FFT_HALF = 4352;
constexpr int FFT_WORK = 2 * FFT_HALF;
HD int fphys(int h, int idx) { return h * FFT_HALF + idx + (idx >> 4); }

HD void geo1(int tid, int& h, int& j) { const int w = tid >> 6, l = tid & 63; h = l >> 5; j = 32 * w + (l & 31); }
HD void geo2(int tid, int& h, int& k1, int& j2) { h = tid >> 8; k1 = (tid >> 4) & 15; j2 = tid & 15; }
HD void geo3(int tid, int& h, int& blk) { h = tid >> 8; blk = tid & 255; }

HD int fbase1(int h, int j) { return h * FFT_HALF + j + (j >> 4); }
HD int fbase2(int h, int k1, int j2) { return h * FFT_HALF + 272 * k1 + j2; }
HD int fbase3(int h, int blk) { return h * FFT_HALF + 17 * blk; }
template <class L> HD void fwd_pass1(L lds, int b1, cf w4096j, cf (&x)[16]) {
    dft16<false>(x); twiddle16<false>(x, w4096j);
#pragma unroll
    for (int k = 0; k < 16; ++k) lds.st(b1 + 272 * k, x[k]);
}
template <class L> HD void fwd_pass2(L lds, int b2, cf w256j) {
    cf x[16];
#pragma unroll
    for (int m = 0; m < 16; ++m) x[m] = lds.ld(b2 + 17 * m);
    dft16<false>(x); twiddle16<false>(x, w256j);
#pragma unroll
    for (int k = 0; k < 16; ++k) lds.st(b2 + 17 * k, x[k]);
}
template <class L> HD void fwd_pass3_keep(L lds, int b3, cf (&x)[16]) {
#pragma unroll
    for (int m = 0; m < 16; ++m) x[m] = lds.ld(b3 + m);
    dft16<false>(x);
}
template <class L> HD void mid_pass3(L lds, int b3, const cf (&K)[16]) {
    cf x[16];
#pragma unroll
    for (int m = 0; m < 16; ++m) x[m] = lds.ld(b3 + m);
    dft16<false>(x);
#pragma unroll
    for (int k = 0; k < 16; ++k) x[k] = cmul(x[k], K[k]);
    dft16<true>(x);
#pragma unroll
    for (int m = 0; m < 16; ++m) lds.st(b3 + m, x[m]);
}
template <class L> HD void inv_pass2(L lds, int b2, cf w256j) {
    cf x[16];
#pragma unroll
    for (int k = 0; k < 16; ++k) x[k] = lds.ld(b2 + 17 * k);
    twiddle16<true>(x, w256j); dft16<true>(x);
#pragma unroll
    for (int m = 0; m < 16; ++m) lds.st(b2 + 17 * m, x[m]);
}
template <class L> HD void inv_pass1(L lds, int b1, cf w4096j, cf (&x)[16]) {
#pragma unroll
    for (int k = 0; k < 16; ++k) x[k] = lds.ld(b1 + 272 * k);
    twiddle16<true>(x, w4096j); dft16<true>(x);
}
#ifndef PG8_WGM
#define PG8_WGM 8
#endif
namespace pg8 {
#define PG8_LAS __attribute__((address_space(3)))
typedef unsigned short bf16_t;
typedef short bf16x8 __attribute__((ext_vector_type(8)));
typedef float f32x4 __attribute__((ext_vector_type(4)));
typedef unsigned u32x4 __attribute__((ext_vector_type(4)));
constexpr int BM = 256, BK = 64, HALF = 128, HTB = HALF * BK * 2  , STAGE_BYTES = 8 * HTB, NXCD = 8, WGM = PG8_WGM;

__host__ __device__ __forceinline__ int lds_byte(int r, int c) { const int st = (r >> 4) * 2 + (c >> 5), rr = r & 15, cc = c & 31, ob = rr * 64 + cc * 2; return st * 1024 + (ob ^ (((ob >> 9) & 1) << 5)); }
__host__ __device__ __forceinline__ void stage_rc(int b, int& R, int& C) { const int st = b / 1024, sb = b % 1024, swz = sb ^ (((sb >> 9) & 1) << 5); R = (st >> 1) * 16 + swz / 64; C = (st & 1) * 32 + (swz % 64) / 2; }
__host__ __device__ __forceinline__ int perm32(int rho) { const int n = rho >> 4, i = rho & 15; return 8 * (i >> 2) + 4 * n + (i & 3); }

typedef int v8i_t __attribute__((ext_vector_type(8))); typedef int v4i_t __attribute__((ext_vector_type(4)));
__device__ __forceinline__ v8i_t cat8(bf16x8 a, bf16x8 b) { const v4i_t x = __builtin_bit_cast(v4i_t, a), y = __builtin_bit_cast(v4i_t, b); return __builtin_shufflevector(x, y, 0, 1, 2, 3, 4, 5, 6, 7); }
struct Unit { int pm, pn; };
struct Gemm { const bf16_t* A; const bf16_t* Bt; int M, N, K; };

struct StaticOrder {
    int nM, nN, nwg, G, c;
    __host__ __device__ void init(int M, int N, int G_, int c_) { nM = M / BM; nN = N / BM; nwg = nM * nN; G = G_; c = c_; }
    __host__ __device__ bool next(int i, Unit& u) const {
        const long L = (long)i * G + c; if (L >= nwg) return false;
        int wgid = (int)L; { const int q = nwg / NXCD, r = nwg % NXCD, xcd = wgid % NXCD, off = wgid / NXCD; wgid = (xcd < r ? xcd * (q + 1) : r * (q + 1) + (xcd - r) * q) + off; }
        const int nig = WGM * nN, gid = wgid / nig, fm = gid * WGM, gsz = (nM - fm) < WGM ? (nM - fm) : WGM;
        u.pm = fm + ((wgid % nig) % gsz); u.pn = (wgid % nig) / gsz; return true;
    }
    __device__ __forceinline__ size_t boff(const Unit&) const { return 0; }
    __device__ __forceinline__ void a_ready(const Unit&) const {}
    __device__ __forceinline__ void done(const Unit&) const {}
};

__device__ __forceinline__ unsigned cvt_pk_bf16(float lo, float hi) { unsigned r; asm volatile("v_cvt_pk_bf16_f32 %0, %1, %2" : "=v"(r) : "v"(lo), "v"(hi)); return r; }
typedef float f32x2 __attribute__((ext_vector_type(2)));
typedef unsigned u32x2 __attribute__((ext_vector_type(2)));
__device__ __forceinline__ float row_rs(const float* ssp, int row, int fq) {
    if (!ssp) return 1.0f;
    const f32x4 q = *(const f32x4*)(ssp + (size_t)row * 16 + 4 * fq); float s = (q[0] + q[1]) + (q[2] + q[3]);
    s += __shfl_xor(s, 16); s += __shfl_xor(s, 32);
    return __builtin_amdgcn_rsqf(s * (1.0f / 1024.0f) + 1e-6f);
}
__device__ __forceinline__ void row_rs8(const float* ssp, int row0, int fq, float (&rs)[2][4]) {
    if (!ssp) {
#pragma unroll
        for (int ai = 0; ai < 2; ++ai)
#pragma unroll
            for (int m = 0; m < 4; ++m) rs[ai][m] = 1.0f;
        return; }
    f32x4 q[2][4];
#pragma unroll
    for (int ai = 0; ai < 2; ++ai)
#pragma unroll
        for (int m = 0; m < 4; ++m) q[ai][m] = *(const f32x4*)(ssp + (size_t)(row0 + ai * HALF + m * 16) * 16 + 4 * fq);
#pragma unroll
    for (int ai = 0; ai < 2; ++ai)
#pragma unroll
        for (int m = 0; m < 4; ++m) { float s = (q[ai][m][0] + q[ai][m][1]) + (q[ai][m][2] + q[ai][m][3]); s += __shfl_xor(s, 16); s += __shfl_xor(s, 32); rs[ai][m] = __builtin_amdgcn_rsqf(s * (1.0f / 1024.0f) + 1e-6f); }
}
__device__ __forceinline__ f32x4 row_rs4_swap(const float* ssp, int rowbase, int fr, int fq) {
    if (!ssp) return (f32x4){1.f, 1.f, 1.f, 1.f};
    const f32x4 q = *(const f32x4*)(ssp + (size_t)(rowbase + 4 * fq + (fr >> 2)) * 16 + 4 * (fr & 3)); float s = (q[0] + q[1]) + (q[2] + q[3]);
    s += __shfl_xor(s, 1); s += __shfl_xor(s, 2);
    const float rs = __builtin_amdgcn_rsqf(s * (1.0f / 1024.0f) + 1e-6f);
    f32x4 o;
#pragma unroll
    for (int r = 0; r < 4; ++r) o[r] = __shfl(rs, 16 * fq + 4 * r);
    return o;
}
template <bool F8 = false> struct EpiBf16T {
    static constexpr bool PERM = true, AFTER_DRAIN = false, SWAP = false, FP8 = F8;
    bf16_t* O; int ldc; const float* ss; float descale;
    __device__ __forceinline__ void operator()(const f32x4 (&acc)[2][2][4][2], const Unit& u, int wr, int wc, int fr, int fq) const {
        const int row0 = u.pm * BM + wr * 64 + fr, col0 = u.pn * BM + wc * 32 + 8 * fq;
        float rsa[2][4]; row_rs8(ss, row0, fq, rsa);
#pragma unroll
        for (int ai = 0; ai < 2; ++ai)
#pragma unroll
            for (int m = 0; m < 4; ++m) { bf16_t* rowp = O + (size_t)(row0 + ai * HALF + m * 16) * ldc + col0; const float rs = F8 ? rsa[ai][m] * descale : rsa[ai][m];
#pragma unroll
                for (int bj = 0; bj < 2; ++bj) { const f32x4 v0 = acc[ai][bj][m][0] * rs, v1 = acc[ai][bj][m][1] * rs;
                    u32x4 w; w.x = cvt_pk_bf16(v0[0], v0[1]); w.y = cvt_pk_bf16(v0[2], v0[3]); w.z = cvt_pk_bf16(v1[0], v1[1]); w.w = cvt_pk_bf16(v1[2], v1[3]);
                    *(u32x4*)(rowp + bj * HALF) = w; } }
    }
};
typedef EpiBf16T<false> EpiBf16;
struct EpiQKV {
    static constexpr bool PERM = true, AFTER_DRAIN = false, SWAP = false, FP8 = false;
    bf16_t* Q; bf16_t* Kb; bf16_t* Vb; const float* cosT; const float* sinT; const float* ss;
    __device__ __forceinline__ void operator()(const f32x4 (&acc)[2][2][4][2], const Unit& u, int wr, int wc, int fr, int fq) const {
        const int row0 = u.pm * BM + wr * 64 + fr;
        float rsa[2][4]; row_rs8(ss, row0, fq, rsa);
#pragma unroll
        for (int bj = 0; bj < 2; ++bj) {
            const int slot0 = u.pn * BM + bj * HALF + wc * 32 + 8 * fq;
            if (slot0 < 640) {
                const int head = slot0 >> 6, j4 = ((slot0 & 63) >> 3) * 4;
#pragma unroll
                for (int am = 0; am < 4; ++am) {
                    f32x4 c[2], sn[2];
                    const int tofs = ((row0 & 4095) + (am >> 1) * HALF + 2 * (am & 1) * 16) * 32 + j4;
                    const __attribute__((address_space(1))) float* cb = (const __attribute__((address_space(1))) float*)(cosT + tofs); const __attribute__((address_space(1))) float* sb = (const __attribute__((address_space(1))) float*)(sinT + tofs); asm volatile("" : "+v"(cb), "+v"(sb));
#pragma unroll
                    for (int h = 0; h < 2; ++h) { c[h] = *(const __attribute__((address_space(1))) f32x4*)(cb + h * 512); sn[h] = *(const __attribute__((address_space(1))) f32x4*)(sb + h * 512); }
#pragma unroll
                    for (int h = 0; h < 2; ++h) { const int ai = am >> 1, m = 2 * (am & 1) + h; const int row = row0 + ai * HALF + m * 16;
                        const float rs = rsa[ai][m]; const f32x4 lo = acc[ai][bj][m][0] * rs, hi = acc[ai][bj][m][1] * rs;
                        const f32x4 olo = lo * c[h] - hi * sn[h], ohi = hi * c[h] + lo * sn[h];
                        bf16_t* dst = head < 8 ? Q + (size_t)row * 512 + head * 64 + j4 : Kb + (size_t)row * 128 + (head - 8) * 64 + j4;
                        u32x2 w0, w1; w0.x = cvt_pk_bf16(olo[0], olo[1]); w0.y = cvt_pk_bf16(olo[2], olo[3]); w1.x = cvt_pk_bf16(ohi[0], ohi[1]); w1.y = cvt_pk_bf16(ohi[2], ohi[3]);
                        *(u32x2*)dst = w0; *(u32x2*)(dst + 32) = w1; } }
            } else {
#pragma unroll
                for (int ai = 0; ai < 2; ++ai)
#pragma unroll
                    for (int m = 0; m < 4; ++m) { const int row = row0 + ai * HALF + m * 16; const float rs = rsa[ai][m]; const f32x4 v0 = acc[ai][bj][m][0] * rs, v1 = acc[ai][bj][m][1] * rs;
                        u32x4 w; w.x = cvt_pk_bf16(v0[0], v0[1]); w.y = cvt_pk_bf16(v0[2], v0[3]); w.z = cvt_pk_bf16(v1[0], v1[1]); w.w = cvt_pk_bf16(v1[2], v1[3]);
                        *(u32x4*)(Vb + (size_t)row * 128 + (slot0 - 640)) = w; }
            }
        }
    }
};
struct EpiT {
    static constexpr bool PERM = false, AFTER_DRAIN = false, SWAP = true, FP8 = false;
    bf16_t* O; int nch; int ts_shift; const float* ss;
    __device__ __forceinline__ void operator()(const f32x4 (&acc)[2][2][4][2], const Unit& u, int wr, int wc, int fr, int fq) const {
        const int rowt = u.pm * BM, b = rowt >> ts_shift, tb = (rowt & ((1 << ts_shift) - 1)) + wr * 64 + 4 * fq;
#pragma unroll
        for (int ai = 0; ai < 2; ++ai) {
            f32x4 rsv[4];
#pragma unroll
            for (int m = 0; m < 4; ++m) rsv[m] = row_rs4_swap(ss, rowt + wr * 64 + ai * HALF + m * 16, fr, fq);
#pragma unroll
            for (int bj = 0; bj < 2; ++bj)
#pragma unroll
                for (int n = 0; n < 2; ++n) { const int ch = u.pn * BM + bj * HALF + wc * 32 + 16 * n + fr; bf16_t* chp = O + (((size_t)(b * nch + ch)) << ts_shift) + tb + ai * HALF;
#pragma unroll
                    for (int m = 0; m < 4; ++m) { const f32x4 v = acc[ai][bj][m][n] * rsv[m]; u32x2 w; w.x = cvt_pk_bf16(v[0], v[1]); w.y = cvt_pk_bf16(v[2], v[3]);
                        *(u32x2*)(chp + m * 16) = w; } } }
    }
};
struct EpiResB {
    static constexpr bool PERM = true, AFTER_DRAIN = false, SWAP = false, FP8 = false;
    bf16_t* xb; int ldc; float* ss; bf16_t* dst;
    __device__ __forceinline__ void operator()(const f32x4 (&acc)[2][2][4][2], const Unit& u, int wr, int wc, int fr, int fq) const {
        const int row0 = u.pm * BM + wr * 64 + fr, col0 = u.pn * BM + wc * 32 + 8 * fq;
#pragma unroll
        for (int ai = 0; ai < 2; ++ai) {
            u32x4 b[4][2];
#pragma unroll
            for (int m = 0; m < 4; ++m)
#pragma unroll
                for (int bj = 0; bj < 2; ++bj) b[m][bj] = *(const u32x4*)(xb + (size_t)(row0 + ai * HALF + m * 16) * ldc + col0 + bj * HALF);
#pragma unroll
            for (int m = 0; m < 4; ++m) { const int row = row0 + ai * HALF + m * 16; bf16_t* dstp = dst + (size_t)row * ldc + col0; float sq = 0.f;
#pragma unroll
                for (int bj = 0; bj < 2; ++bj) { const f32x4 a0 = acc[ai][bj][m][0], a1 = acc[ai][bj][m][1]; const u32x4 bb = b[m][bj]; float o[8];
                    o[0] = __builtin_bit_cast(float, bb.x << 16) + a0[0]; o[1] = __builtin_bit_cast(float, bb.x & 0xffff0000u) + a0[1];
                    o[2] = __builtin_bit_cast(float, bb.y << 16) + a0[2]; o[3] = __builtin_bit_cast(float, bb.y & 0xffff0000u) + a0[3];
                    o[4] = __builtin_bit_cast(float, bb.z << 16) + a1[0]; o[5] = __builtin_bit_cast(float, bb.z & 0xffff0000u) + a1[1];
                    o[6] = __builtin_bit_cast(float, bb.w << 16) + a1[2]; o[7] = __builtin_bit_cast(float, bb.w & 0xffff0000u) + a1[3];
#pragma unroll
                    for (int i = 0; i < 8; ++i) sq += o[i] * o[i];
                    u32x4 w; w.x = cvt_pk_bf16(o[0], o[1]); w.y = cvt_pk_bf16(o[2], o[3]); w.z = cvt_pk_bf16(o[4], o[5]); w.w = cvt_pk_bf16(o[6], o[7]);
                    *(u32x4*)(dstp + bj * HALF) = w; }
                if (ss) { sq += __shfl_xor(sq, 16); sq += __shfl_xor(sq, 32); if (fq == 0) ss[(size_t)row * 16 + u.pn * 4 + wc] = sq; } } }
    }
};
typedef float f32x2e __attribute__((ext_vector_type(2)));
__device__ __forceinline__ f32x2e silu_mul_pk(f32x2e g, f32x2e up) {
    const f32x2e t = g * (-1.44269504088896f); f32x2e e; e.x = __builtin_amdgcn_exp2f(t.x); e.y = __builtin_amdgcn_exp2f(t.y);
    const f32x2e d = e + 1.0f; f32x2e r; r.x = __builtin_amdgcn_rcpf(d.x); r.y = __builtin_amdgcn_rcpf(d.y);
    return (g * r) * up;
}
template <bool SCALE, bool F8 = false, bool F8OUT = false> struct EpiSwiglu {
    static constexpr bool PERM = true, AFTER_DRAIN = false, SWAP = false, FP8 = F8;
    bf16_t* O; int ldc; const float* ss;
    __device__ __forceinline__ void operator()(const f32x4 (&acc)[2][2][4][2], const Unit& u, int wr, int wc, int fr, int fq) const {
        const int row0 = u.pm * BM + wr * 64 + fr, col0 = u.pn * 128 + wc * 16 + 4 * fq;
        float rsa[2][4]; if (SCALE) row_rs8(ss, row0, fq, rsa);
#pragma unroll
        for (int ai = 0; ai < 2; ++ai)
#pragma unroll
            for (int m = 0; m < 4; ++m) { bf16_t* rowp = O + (size_t)(row0 + ai * HALF + m * 16) * ldc + col0; const float rs = SCALE ? rsa[ai][m] : 1.0f;
#pragma unroll
                for (int bj = 0; bj < 2; ++bj) { f32x4 g = acc[ai][bj][m][0], up = acc[ai][bj][m][1]; if (SCALE) { g = g * rs; up = up * rs; } if (F8) { g = g * 0.03125f; up = up * 0.03125f; }
                    const f32x2e o0 = silu_mul_pk((f32x2e){g[0], g[1]}, (f32x2e){up[0], up[1]}), o1 = silu_mul_pk((f32x2e){g[2], g[3]}, (f32x2e){up[2], up[3]});
                    if (F8OUT) { int w8 = 0; w8 = __builtin_amdgcn_cvt_pk_fp8_f32(o0.x * 4.0f, o0.y * 4.0f, w8, false); w8 = __builtin_amdgcn_cvt_pk_fp8_f32(o1.x * 4.0f, o1.y * 4.0f, w8, true);
                        *(unsigned*)((unsigned char*)O + (size_t)(row0 + ai * HALF + m * 16) * ldc + col0 + bj * 64) = (unsigned)w8; }
                    else { u32x2 w; w.x = cvt_pk_bf16(o0.x, o0.y); w.y = cvt_pk_bf16(o1.x, o1.y);
                    *(u32x2*)(rowp + bj * 64) = w; } } }
    }
};
template <class Epi, class Sched, bool ALIGN_EPI = false, bool SP2 = false>
__device__ __forceinline__ void gemm_phase(PG8_LAS unsigned char* lds, const Gemm g, const Sched& S, const Epi& E) {
    const int tid = opq_tid(), wid = __builtin_amdgcn_readfirstlane(tid >> 6), lane = tid & 63, wr = wid >> 2, wc = wid & 3, fr = lane & 15, fq = lane >> 4;
    const int K = g.K, nt = K / BK;
    unsigned voffA[2], voffB[2];
#pragma unroll
    for (int i = 0; i < 2; ++i) { int R, C; stage_rc(tid * 16 + i * 8192, R, C); const int Rb = Epi::PERM ? ((R & ~31) + perm32(R & 31)) : R;
        voffA[i] = (unsigned)(R * K + C) * 2u; voffB[i] = (unsigned)(Rb * K + C) * 2u; }
    const size_t kstep = (size_t)(BK * 2);
    const size_t hstep = (size_t)HALF * K * 2;
    const size_t tstep = 2 * hstep;
    const unsigned ldsw = (unsigned)wid * 1024u;
    const int aoff = lds_byte(wr * 64 + fr, fq * 8), boff = lds_byte(wc * 32 + fr, fq * 8);
#define PG8_SA(b, h) (((b) * 2 + (h)) * HTB)
#define PG8_SB(b, h) ((4 + (b) * 2 + (h)) * HTB)
#define PG8_STAGE(bufoff, gbase, voff) do { _Pragma("unroll") for (int _i = 0; _i < 2; ++_i) \
        __builtin_amdgcn_global_load_lds((const unsigned*)((const char*)(gbase) + (voff)[_i]), (PG8_LAS unsigned*)(lds + (bufoff) + ldsw + _i * 8192), 16, 0, 0); } while (0)
#define PG8_LDA(dst, b, h) do { if constexpr (Epi::FP8) { _Pragma("unroll") for (int m = 0; m < 4; ++m) dst##8[m] = cat8(*(const PG8_LAS bf16x8*)(lds + PG8_SA(b, h) + aoff + m * 2048), *(const PG8_LAS bf16x8*)(lds + PG8_SA(b, h) + aoff + m * 2048 + 1024)); } else { \
        _Pragma("unroll") for (int m = 0; m < 4; ++m) _Pragma("unroll") for (int k = 0; k < 2; ++k) dst[m][k] = *(const PG8_LAS bf16x8*)(lds + PG8_SA(b, h) + aoff + m * 2048 + k * 1024); } } while (0)
#define PG8_LDB(dst, b, h) do { if constexpr (Epi::FP8) { _Pragma("unroll") for (int n = 0; n < 2; ++n) dst##8[n] = cat8(*(const PG8_LAS bf16x8*)(lds + PG8_SB(b, h) + boff + n * 2048), *(const PG8_LAS bf16x8*)(lds + PG8_SB(b, h) + boff + n * 2048 + 1024)); } else { \
        _Pragma("unroll") for (int n = 0; n < 2; ++n) _Pragma("unroll") for (int k = 0; k < 2; ++k) dst[n][k] = *(const PG8_LAS bf16x8*)(lds + PG8_SB(b, h) + boff + n * 2048 + k * 1024); } } while (0)
#define PG8_MMA(ai, bj, At, Bt) do { __builtin_amdgcn_s_setprio(1); if constexpr (Epi::FP8) { _Pragma("unroll") for (int m = 0; m < 4; ++m) _Pragma("unroll") for (int n = 0; n < 2; ++n) \
        asm volatile("v_mfma_scale_f32_16x16x128_f8f6f4 %0, %1, %2, %0, %3, %3 op_sel_hi:[0,0,0]" : "+v"(acc[ai][bj][m][n]) : "v"(Bt##8[n]), "v"(At##8[m]), "v"(f8one)); } else { \
        _Pragma("unroll") for (int m = 0; m < 4; ++m) _Pragma("unroll") for (int n = 0; n < 2; ++n) _Pragma("unroll") for (int k = 0; k < 2; ++k) \
        acc[ai][bj][m][n] = Epi::SWAP ? __builtin_amdgcn_mfma_f32_16x16x32_bf16(At[m][k], Bt[n][k], acc[ai][bj][m][n], 0, 0, 0) : __builtin_amdgcn_mfma_f32_16x16x32_bf16(Bt[n][k], At[m][k], acc[ai][bj][m][n], 0, 0, 0); } __builtin_amdgcn_s_setprio(0); } while (0)
#define PG8_WAIT_V(n) asm volatile("s_waitcnt vmcnt(" #n ")" ::: "memory")
#define PG8_WAIT_L(n) asm volatile("s_waitcnt lgkmcnt(" #n ")" ::: "memory")
#define PG8_BAR __builtin_amdgcn_s_barrier()
#define PG8_SCHED __builtin_amdgcn_sched_barrier(0)
#ifdef DIAG
    unsigned long long dg_k = 0, dg_e = 0, dg_t1 = 0, dg_t2 = 0; const unsigned long long dg_t0 = wall_clock64();
#endif
    Unit cur, nxt; int ui = 0;
    if (!S.next(0, cur)) return;
    f32x4 acc[2][2][4][2];
#pragma unroll
    for (int a = 0; a < 2; ++a)
#pragma unroll
        for (int b = 0; b < 2; ++b)
#pragma unroll
            for (int m = 0; m < 4; ++m)
#pragma unroll
                for (int n = 0; n < 2; ++n) acc[a][b][m][n] = (f32x4){0.f, 0.f, 0.f, 0.f};
    bf16x8 At[4][2], B0[2][2], B1[2][2]; v8i_t At8[4], B08[2], B18[2];
    int f8one = 0x7F7F7F7F; asm volatile("" : "+v"(f8one));
    const char* cA = (const char*)g.A + (size_t)cur.pm * tstep; const char* cB = (const char*)g.Bt + S.boff(cur) + (size_t)cur.pn * tstep;
    S.a_ready(cur);
    if constexpr (SP2) {
        PG8_STAGE(PG8_SB(0, 0), cB, voffB); PG8_STAGE(PG8_SB(0, 1), cB + hstep, voffB); PG8_STAGE(PG8_SA(0, 0), cA, voffA); PG8_STAGE(PG8_SA(0, 1), cA + hstep, voffA);
        if (wr == 1) PG8_BAR;
        PG8_WAIT_V(2); PG8_BAR;
        PG8_STAGE(PG8_SB(1, 0), cB + kstep, voffB); PG8_STAGE(PG8_SA(1, 0), cA + kstep, voffA); PG8_STAGE(PG8_SB(1, 1), cB + hstep + kstep, voffB);
        PG8_WAIT_V(6); PG8_BAR;
    } else {
        PG8_STAGE(PG8_SB(0, 0), cB, voffB); PG8_STAGE(PG8_SA(0, 0), cA, voffA); PG8_STAGE(PG8_SB(0, 1), cB + hstep, voffB); PG8_STAGE(PG8_SA(0, 1), cA + hstep, voffA);
        if (wr == 1) PG8_BAR;
        PG8_WAIT_V(4); PG8_BAR;
        PG8_STAGE(PG8_SB(1, 0), cB + kstep, voffB); PG8_STAGE(PG8_SA(1, 0), cA + kstep, voffA); PG8_STAGE(PG8_SB(1, 1), cB + hstep + kstep, voffB);
        PG8_WAIT_V(6); PG8_BAR;
    }
    for (;;) {
        const bool has_next = S.next(ui + 1, nxt);
        const char* nA = has_next ? (const char*)g.A + (size_t)nxt.pm * tstep : cA; const char* nB = has_next ? (const char*)g.Bt + S.boff(nxt) + (size_t)nxt.pn * tstep : cB;
#ifdef DIAG
        dg_t1 = wall_clock64();
#endif
        for (int t = 0; t < nt; t += 2) {
            const bool last = (t == nt - 2);
            const char* a1 = cA + (size_t)(t + 1) * kstep;
            const char* a2 = last ? nA : cA + (size_t)(t + 2) * kstep; const char* b2 = last ? nB : cB + (size_t)(t + 2) * kstep;
            const char* a3 = a2 + kstep; const char* b3 = b2 + kstep;
            if (last && has_next) S.a_ready(nxt);
            if constexpr (SP2) {
            PG8_LDB(B0, 0, 0); PG8_LDB(B1, 0, 1); PG8_SCHED; PG8_LDA(At, 0, 0); PG8_STAGE(PG8_SA(1, 1), a1 + hstep, voffA);
            PG8_WAIT_V(8); PG8_WAIT_L(0); PG8_BAR; PG8_MMA(0, 0, At, B0); PG8_MMA(0, 1, At, B1); PG8_BAR; PG8_SCHED;
            PG8_LDA(At, 0, 1); PG8_STAGE(PG8_SB(0, 0), b2, voffB); PG8_STAGE(PG8_SB(0, 1), b2 + hstep, voffB); PG8_STAGE(PG8_SA(0, 0), a2, voffA);
            PG8_WAIT_V(8); PG8_WAIT_L(0); PG8_BAR; PG8_MMA(1, 0, At, B0); PG8_MMA(1, 1, At, B1); PG8_BAR; PG8_SCHED;
            PG8_LDB(B0, 1, 0); PG8_LDB(B1, 1, 1); PG8_SCHED; PG8_LDA(At, 1, 0); PG8_STAGE(PG8_SA(0, 1), a2 + hstep, voffA);
            PG8_WAIT_V(8); PG8_WAIT_L(0); PG8_BAR; PG8_MMA(0, 0, At, B0); PG8_MMA(0, 1, At, B1); PG8_BAR; PG8_SCHED;
            PG8_LDA(At, 1, 1); PG8_STAGE(PG8_SB(1, 0), b3, voffB); PG8_STAGE(PG8_SB(1, 1), b3 + hstep, voffB); PG8_STAGE(PG8_SA(1, 0), a3, voffA);
            PG8_WAIT_V(8); PG8_WAIT_L(0); PG8_BAR; PG8_MMA(1, 0, At, B0); PG8_MMA(1, 1, At, B1); PG8_BAR; PG8_SCHED;
            } else {
            PG8_LDB(B0, 0, 0); PG8_SCHED; PG8_LDA(At, 0, 0); PG8_STAGE(PG8_SA(1, 1), a1 + hstep, voffA);
            PG8_WAIT_L(8); PG8_BAR; PG8_WAIT_L(0); PG8_MMA(0, 0, At, B0); PG8_BAR; PG8_SCHED;
            PG8_LDB(B1, 0, 1); PG8_STAGE(PG8_SB(0, 0), b2, voffB);
            PG8_BAR; PG8_WAIT_L(0); PG8_MMA(0, 1, At, B1); PG8_BAR;
            PG8_LDA(At, 0, 1); PG8_STAGE(PG8_SA(0, 0), a2, voffA);
            PG8_BAR; PG8_WAIT_L(0); PG8_MMA(1, 0, At, B0); PG8_BAR; PG8_SCHED;
            PG8_STAGE(PG8_SB(0, 1), b2 + hstep, voffB);
            PG8_WAIT_V(6); PG8_BAR; PG8_MMA(1, 1, At, B1); PG8_BAR;
            PG8_LDB(B0, 1, 0); PG8_SCHED; PG8_LDA(At, 1, 0); PG8_STAGE(PG8_SA(0, 1), a2 + hstep, voffA);
            PG8_WAIT_L(8); PG8_BAR; PG8_WAIT_L(0); PG8_MMA(0, 0, At, B0); PG8_BAR; PG8_SCHED;
            PG8_LDB(B1, 1, 1); PG8_STAGE(PG8_SB(1, 0), b3, voffB);
            PG8_BAR; PG8_WAIT_L(0); PG8_MMA(0, 1, At, B1); PG8_BAR;
            PG8_LDA(At, 1, 1); PG8_STAGE(PG8_SA(1, 0), a3, voffA);
            PG8_BAR; PG8_WAIT_L(0); PG8_MMA(1, 0, At, B0); PG8_BAR; PG8_SCHED;
            PG8_STAGE(PG8_SB(1, 1), b3 + hstep, voffB);
            PG8_WAIT_V(6); PG8_BAR; PG8_MMA(1, 1, At, B1); PG8_BAR;
            }
        }
#ifdef DIAG
        dg_t2 = wall_clock64(); dg_k += dg_t2 - dg_t1;
#endif
        if constexpr (Epi::FP8) asm volatile("s_nop 15\n\ts_nop 15" ::: "memory");
        if constexpr (ALIGN_EPI) { if (wr == 0) PG8_BAR; }
#ifndef EPI_REP
#define EPI_REP 1
#endif
        if constexpr (!Epi::AFTER_DRAIN) { _Pragma("unroll 1") for (int er_ = 0; er_ < EPI_REP; ++er_) E(acc, cur, wr, wc, fr, fq); S.done(cur); }
#ifdef DIAG
        dg_e += wall_clock64() - dg_t2;
#endif
        if (!has_next) break;
#pragma unroll
        for (int a = 0; a < 2; ++a)
#pragma unroll
            for (int b = 0; b < 2; ++b)
#pragma unroll
                for (int m = 0; m < 4; ++m)
#pragma unroll
                    for (int n = 0; n < 2; ++n) acc[a][b][m][n] = (f32x4){0.f, 0.f, 0.f, 0.f};
        cur = nxt; cA = nA; cB = nB; ++ui;
        if constexpr (ALIGN_EPI) { if (wr == 1) PG8_BAR; }
    }
#ifdef DIAG
    if (blockIdx.x == 0 && tid == 0) { unsigned long long* dg = (unsigned long long*)(*(const PG8_LAS unsigned long long*)(lds + 139328)); atomicAdd(dg + 0, dg_k); atomicAdd(dg + 1, dg_e); atomicAdd(dg + 2, wall_clock64() - dg_t0); atomicAdd(dg + 3, (unsigned long long)(ui + 1)); }
#endif
    PG8_WAIT_V(0);
    if constexpr (!ALIGN_EPI) { if (wr == 0) PG8_BAR; }
    PG8_BAR;
    if constexpr (Epi::AFTER_DRAIN) { E.fused(acc, cur, wr, wc, fr, fq, lds, wid, lane); S.done(cur); }
#undef PG8_SA
#undef PG8_SB
#undef PG8_STAGE
#undef PG8_LDA
#undef PG8_LDB
#undef PG8_MMA
#undef PG8_WAIT_V
#undef PG8_WAIT_L
#undef PG8_BAR
#undef PG8_SCHED
}
}
#ifndef PG8_SP2
#define PG8_SP2 true
#endif
#ifndef PG8_ALIGN
#define PG8_ALIGN true
#endif
constexpr int NB = 16, SEQ = 4096, D = 1024, M = NB * SEQ;
constexpr int NH = 8, NKV = 2, HDIM = 64, AW = 512, KVW = 128;
constexpr int HYW = 512, C3 = 1536, INC = 2304;
constexpr int XH = 4, XHD = 128, XW = 512, MEML = 256, MROWS = NB * MEML;
constexpr int FF = 2816, NE = 8, FFE = 3584;
constexpr float EPS = 1e-6f;
constexpr int NWAVES = 8, NTHR = 512;
constexpr int MOE_CH_TILES = 128, MOE_NCHUNK = 4, MOE_MAX_TILES = 520, MOE_MAX_ROWS = MOE_MAX_TILES * 256, MOE_ACT_TILES = MOE_MAX_TILES - (MOE_NCHUNK - 1) * MOE_CH_TILES;

constexpr size_t al256(size_t x) { return (x + 255) & ~(size_t)255; }
constexpr size_t WS_CTL = 0, CTL_ZERO_BYTES = 1u << 20;
constexpr size_t WS_SS = CTL_ZERO_BYTES, SS_STRIDE = (size_t)M * 16;
constexpr size_t WS_COS = WS_SS + 5 * SS_STRIDE * 4, WS_SIN = WS_COS + (size_t)SEQ * 32 * 4, WS_H2 = WS_SIN + (size_t)SEQ * 32 * 4;
constexpr size_t WS_TOKE = WS_H2 + (size_t)2 * SEQ * 64 * 4, WS_TOKW = WS_TOKE + (size_t)M * 2 * 4, WS_TOKP = WS_TOKW + (size_t)M * 2 * 4;
constexpr size_t WS_ROWTOK = WS_TOKP + (size_t)M * 2 * 4, WS_TILEE = WS_ROWTOK + al256((size_t)MOE_MAX_ROWS * 4), WS_WGCNT = WS_TILEE + 4096, WS_RSROW = WS_WGCNT + (size_t)1024 * 8 * 4, WS_META = WS_RSROW + (size_t)M * 4;
constexpr size_t WS_WINA = al256(WS_META + 4096);
constexpr size_t WS_WINB = WS_WINA + (size_t)2 * 768 * D * 2;
constexpr size_t WS_WOUT = WS_WINB + (size_t)2 * C3 * D * 2;
constexpr size_t WS_XQ = WS_WOUT + (size_t)2 * D * D * 2;
constexpr size_t WS_XK = WS_XQ + (size_t)2 * XW * D * 2;
constexpr size_t WS_XV = WS_XK + (size_t)2 * XW * D * 2;
constexpr size_t WS_XO = WS_XV + (size_t)2 * XW * D * 2;
constexpr size_t WS_FGU = WS_XO + (size_t)2 * D * XW * 2;
constexpr size_t WS_FDN = WS_FGU + (size_t)2 * FF * D * 2;
constexpr size_t WS_MGU = WS_FDN + (size_t)D * FF * 2;
constexpr size_t WS_MDN = WS_MGU + (size_t)NE * 2 * FFE * D;
constexpr size_t WS_KFILT = WS_MDN + (size_t)NE * D * FFE;
constexpr size_t WS_MB = WS_KFILT + (size_t)2 * 2 * HYW * 8192 * 4;
constexpr size_t WS_KMEM = WS_MB + (size_t)MROWS * D * 2;
constexpr size_t WS_VMEMT = WS_KMEM + (size_t)MROWS * 1024 * 2;
constexpr size_t WS_HB = WS_VMEMT + (size_t)1024 * MROWS * 2;
constexpr size_t WS_R = WS_HB + (size_t)M * D * 2;
constexpr size_t WS_QB = WS_R, WS_KB = WS_QB + (size_t)M * AW * 2, WS_VB = WS_KB + (size_t)M * KVW * 2, WS_UT = WS_VB + (size_t)M * KVW * 2;
constexpr size_t WS_MIXED = WS_UT;
constexpr size_t WS_AB = WS_UT + (size_t)M * C3 * 2, WS_YT = WS_AB + (size_t)M * AW * 2, WS_KSPEC = WS_YT + (size_t)M * HYW * 2, WS_MIXEND = WS_KSPEC + (size_t)2 * 2 * HYW * 16384 * 4;
constexpr size_t WS_XQB = WS_R, WS_XOB = WS_XQB + (size_t)M * XW * 2;
constexpr size_t WS_ACT = WS_R;
constexpr size_t WS_XG = WS_R;
constexpr size_t WS_MACT = WS_XG + (size_t)MOE_MAX_ROWS * D;
constexpr size_t WS_YB = WS_MACT + (size_t)MOE_ACT_TILES * 256 * FFE;
constexpr size_t WS_MOEEND = WS_YB + (size_t)MOE_MAX_ROWS * D * 2;
constexpr size_t cmax(size_t a, size_t b) { return a > b ? a : b; }
constexpr size_t WS_END = cmax(cmax(WS_MIXEND, WS_ACT + (size_t)M * FF * 2), WS_MOEEND);
static_assert(WS_END <= (size_t)1073741824, "workspace map exceeds 1 GiB");
static_assert(WS_ACT + (size_t)M * FF * 2 <= WS_KSPEC && WS_XOB + (size_t)M * XW * 2 <= WS_KSPEC, "layer 0's later phases must not touch the filter spectra");
constexpr int CW_TMO = 0, CW_CODE = 1, CW_BAR = 4096;

constexpr int PHASE_LDS = 155648;
constexpr int LDSCTL_OFF = PHASE_LDS, MISC_OFF = LDSCTL_OFF + 64;
constexpr int LDS_BYTES = PHASE_LDS + 512;

#define GAS __attribute__((address_space(1)))
#define LAS __attribute__((address_space(3)))
typedef unsigned short bf16;
typedef unsigned v4u __attribute__((ext_vector_type(4)));
typedef unsigned v2u __attribute__((ext_vector_type(2)));
typedef float f32x4 __attribute__((ext_vector_type(4)));
typedef short bf16x8 __attribute__((ext_vector_type(8)));
typedef short s16x4 __attribute__((ext_vector_type(4)));
typedef GAS unsigned gu32;
#define RLX_AGENT __ATOMIC_RELAXED, __HIP_MEMORY_SCOPE_AGENT
#define LDS_WAIT() asm volatile("s_waitcnt lgkmcnt(0)" ::: "memory")
#define VM_WAIT() asm volatile("s_waitcnt vmcnt(0)" ::: "memory")
__device__ __forceinline__ unsigned f2bf(float f) { unsigned u = __builtin_bit_cast(unsigned, f); return (u + 0x7fffu + ((u >> 16) & 1u)) >> 16; }
__device__ __forceinline__ unsigned pk2(float lo, float hi) { return cvtpk_hw(lo, hi); }
__device__ __forceinline__ float bflo(unsigned w) { return __builtin_bit_cast(float, w << 16); }
__device__ __forceinline__ float bfhi(unsigned w) { return __builtin_bit_cast(float, w & 0xffff0000u); }
__device__ __forceinline__ float bf1(unsigned short h) { return __builtin_bit_cast(float, ((unsigned)h) << 16); }
#define XB_TMO      128
#define XB_XCNT(j)  (256  + 64 * (j))
#define XB_XSUB(j)  (1280 + 64 * (j))
#define XB_XGEN(j)  (2304 + 64 * (j))
#define XB_TOP      3328
#define XB_TOPGEN   3392
#define XCD_BAR_WORDS 3456
#define XB_SPIN_CAP (1u << 22)

__device__ __forceinline__ unsigned xb_ld(unsigned* p)              { return __hip_atomic_load(p, __ATOMIC_RELAXED, __HIP_MEMORY_SCOPE_AGENT); }
__device__ __forceinline__ unsigned xb_add(unsigned* p, unsigned v) { return __hip_atomic_fetch_add(p, v, __ATOMIC_RELAXED, __HIP_MEMORY_SCOPE_AGENT); }
__device__ __forceinline__ unsigned xb_xcc_id() { return (unsigned)__builtin_amdgcn_s_getreg((3 << 11) | 20) & 0xFu; }
#define XB_SPIN(cond, bar) do { unsigned _sp = 0; while (cond) { __builtin_amdgcn_s_sleep(1); \
    if ((++_sp & 255u) == 0u) { if (xb_ld(&(bar)[XB_TMO])) break; if (_sp > XB_SPIN_CAP) { atomicAdd(&(bar)[XB_TMO], 1u); break; } } } } while (0)

struct XcdBarrier {
    unsigned* bar; unsigned x;
    volatile LAS unsigned* st;
};

__device__ __forceinline__ XcdBarrier xcd_barrier_post(unsigned* bar, volatile LAS unsigned* st) {
    XcdBarrier b; b.bar = bar; b.x = xb_xcc_id(); b.st = st;
    if (threadIdx.x == 0) (void)xb_add(&bar[XB_XCNT(b.x)], 1u);
    return b;
}
__device__ __forceinline__ void xcd_barrier_complete(unsigned* bar, unsigned x, unsigned& nloc, unsigned& nx) {
    const unsigned G = gridDim.x * gridDim.y * gridDim.z;
    unsigned sum, cnt, mine, sp = 0u;
    for (;;) {
        sum = 0u; cnt = 0u; mine = 0u;
#pragma unroll
        for (unsigned j = 0; j < 16; ++j) { const unsigned c = xb_ld(&bar[XB_XCNT(j)]); sum += c; cnt += (c > 0u) ? 1u : 0u; mine = (j == x) ? c : mine; }
        if (sum == G) break;
        __builtin_amdgcn_s_sleep(1);
        if ((++sp & 255u) == 0u) { if (xb_ld(&bar[XB_TMO])) break; if (sp > XB_SPIN_CAP) { atomicAdd(&bar[XB_TMO], 1u); break; } }
    }
    nloc = mine > 0u ? mine : 1u; nx = cnt > 0u ? cnt : 1u;
}

__device__ __forceinline__ void xcd_barrier(const XcdBarrier& b) {
    asm volatile("s_waitcnt vmcnt(0)" ::: "memory");
    __syncthreads();
    if (threadIdx.x == 0) {
        unsigned* bar = b.bar;
        __builtin_amdgcn_s_waitcnt(0);
        unsigned nloc = b.st[0], nx = b.st[1];
        if (nloc == 0u) { xcd_barrier_complete(bar, b.x, nloc, nx); b.st[0] = nloc; b.st[1] = nx; }
        const unsigned old = xb_add(&bar[XB_XSUB(b.x)], 1u);
        const unsigned gen = old / nloc;
        if (old + 1u == (gen + 1u) * nloc) {
            __builtin_amdgcn_fence(__ATOMIC_RELEASE, "agent");
            asm volatile("s_waitcnt vmcnt(0)" ::: "memory");
            const unsigned og = xb_add(&bar[XB_TOP], 1u);
            const unsigned tg = og / nx;
            if (og + 1u == (tg + 1u) * nx) xb_add(&bar[XB_TOPGEN], 1u);
            else XB_SPIN(xb_ld(&bar[XB_TOPGEN]) == tg, bar);
            __builtin_amdgcn_fence(__ATOMIC_ACQUIRE, "agent");
            xb_add(&bar[XB_XGEN(b.x)], 1u);
            asm volatile("s_waitcnt vmcnt(0)" ::: "memory");
        } else {
            XB_SPIN(xb_ld(&bar[XB_XGEN(b.x)]) == gen, bar);
            __builtin_amdgcn_fence(__ATOMIC_ACQUIRE, "agent");
            asm volatile("s_waitcnt vmcnt(0)" ::: "memory");
        }
    }
    __syncthreads();
}
struct Args { const float* in[33]; float* out; unsigned char* ws; int ph_lo, ph_hi, use_bar, pad; };
enum InIdx { I_X = 0, I_MEM, I_MEMNORM, I_MIXNORM, I_WIN, I_SINK, I_CONVW, I_CONVB, I_FW1, I_FB1, I_FFR1, I_FW2, I_FB2, I_FFR2, I_FW3, I_SKIP, I_ANORM, I_YNORM, I_WOUT, I_XNORM,
             I_XWQ, I_XWK, I_XWV, I_XWO, I_FNORM, I_FGATE, I_FUP, I_FDOWN, I_ROUTER, I_MGATE, I_MUP, I_MDOWN, I_FINAL };

__device__ __forceinline__ float wave_sum(float v) {
#pragma unroll
    for (int o = 1; o < 64; o <<= 1) v += __shfl_xor(v, o);
    return v;
}
__device__ __forceinline__ void wg_sync() { __builtin_amdgcn_sched_barrier(0); asm volatile("s_waitcnt vmcnt(0) lgkmcnt(0)" ::: "memory"); __builtin_amdgcn_s_barrier(); asm volatile("" ::: "memory"); __builtin_amdgcn_sched_barrier(0); }

template <int MODE> __device__ __forceinline__ int rowmap(int n) {
    if (MODE == 1) return n < 640 ? ((n & ~63) + 8 * ((n & 31) >> 2) + (n & 3) + 4 * ((n >> 5) & 1)) : n;
    if (MODE == 2) return 8 * (n >> 2) + (n & 3);
    if (MODE == 3) return 8 * (n >> 2) + 4 + (n & 3);
    return n;
}
__device__ __forceinline__ int rowmap_rt(int mode, int n) { return mode == 1 ? rowmap<1>(n) : mode == 2 ? rowmap<2>(n) : mode == 3 ? rowmap<3>(n) : n; }
__device__ __forceinline__ void tr_item(const float* W, int ldw, int K, int col0, int ncols, bf16* WT, int mode, const float* gk, int item, LAS float* scr, int lane) {
    const int nblk = ncols / 32, kb = item / nblk, nb = item % nblk, k0 = 64 * kb, n0 = 32 * nb;
    f32x4 tv[8];
#pragma unroll
    for (int i = 0; i < 8; ++i) { const int kk = 8 * i + (lane >> 3); tv[i] = *(const f32x4*)(W + (size_t)(k0 + kk) * ldw + col0 + n0 + 4 * (lane & 7)); }
#pragma unroll
    for (int i = 0; i < 8; ++i) { const int kk = 8 * i + (lane >> 3); const float gv = gk ? gk[k0 + kk] : 1.0f; LAS float* d = scr + kk * 33 + 4 * (lane & 7);
        d[0] = gv * tv[i][0]; d[1] = gv * tv[i][1]; d[2] = gv * tv[i][2]; d[3] = gv * tv[i][3]; }
    LDS_WAIT(); asm volatile("" ::: "memory");
    const int c = lane & 7;
#pragma unroll
    for (int j = 0; j < 4; ++j) { const int n = (lane >> 3) + 8 * j; const LAS float* sp = scr + (8 * c) * 33 + n;
        v4u o; o.x = pk2(sp[0 * 33], sp[1 * 33]); o.y = pk2(sp[2 * 33], sp[3 * 33]); o.z = pk2(sp[4 * 33], sp[5 * 33]); o.w = pk2(sp[6 * 33], sp[7 * 33]);
        *(v4u*)(WT + (size_t)rowmap_rt(mode, n0 + n) * K + k0 + 8 * c) = o; }
    LDS_WAIT(); asm volatile("" ::: "memory");
}
__device__ __forceinline__ void tr_item8(const float* W, int ldw, int K, int ncols, unsigned char* WT8, int mode, float wscale, int item, LAS float* scr, int lane) {
    const int nblk = ncols / 32, kb = item / nblk, nb = item % nblk, k0 = 64 * kb, n0 = 32 * nb;
    f32x4 tv[8];
#pragma unroll
    for (int i = 0; i < 8; ++i) { const int kk = 8 * i + (lane >> 3); tv[i] = *(const f32x4*)(W + (size_t)(k0 + kk) * ldw + n0 + 4 * (lane & 7)); }
#pragma unroll
    for (int i = 0; i < 8; ++i) { const int kk = 8 * i + (lane >> 3); LAS float* d = scr + kk * 33 + 4 * (lane & 7);
        d[0] = wscale * tv[i][0]; d[1] = wscale * tv[i][1]; d[2] = wscale * tv[i][2]; d[3] = wscale * tv[i][3]; }
    LDS_WAIT(); asm volatile("" ::: "memory");
    const int n = lane >> 1, half = lane & 1; const LAS float* sp = scr + (32 * half) * 33 + n;
    v4u o[2];
#pragma unroll
    for (int q = 0; q < 8; ++q) { int w = 0;
        w = __builtin_amdgcn_cvt_pk_fp8_f32(sp[(4 * q + 0) * 33], sp[(4 * q + 1) * 33], w, false);
        w = __builtin_amdgcn_cvt_pk_fp8_f32(sp[(4 * q + 2) * 33], sp[(4 * q + 3) * 33], w, true);
        o[q >> 2][q & 3] = (unsigned)w; }
    v4u* dst = (v4u*)(WT8 + (size_t)rowmap_rt(mode, n0 + n) * K + k0 + 32 * half);
    dst[0] = o[0]; dst[1] = o[1];
    LDS_WAIT(); asm volatile("" ::: "memory");
}
__device__ __forceinline__ void rms_row(const float* xrow, const float* gain, int lane, f32x4 (&v)[4]) {
    const f32x4* xr = (const f32x4*)xrow + lane; float s = 0.f;
#pragma unroll
    for (int j = 0; j < 4; ++j) { v[j] = xr[64 * j]; s += (v[j].x * v[j].x + v[j].y * v[j].y) + (v[j].z * v[j].z + v[j].w * v[j].w); }
    const float rs = 1.0f / sqrtf(wave_sum(s) * (1.f / 1024.f) + EPS);
    const f32x4* gr = (const f32x4*)gain + lane;
#pragma unroll
    for (int j = 0; j < 4; ++j) v[j] = v[j] * rs * gr[64 * j];
}
__device__ __forceinline__ void store_row_bf16(bf16* orow, int lane, const f32x4 (&v)[4]) {
    unsigned long long* o8 = (unsigned long long*)orow + lane;
#pragma unroll
    for (int j = 0; j < 4; ++j) o8[64 * j] = (unsigned long long)pk2(v[j].x, v[j].y) | ((unsigned long long)pk2(v[j].z, v[j].w) << 32);
}
__device__ __forceinline__ void xb_rows(const float* x, bf16* o, float* ss, int nrows, int gw, int NGW, int lane) {
#pragma unroll 1
    for (int r0 = gw; r0 < nrows; r0 += 2 * NGW) {
        const int r1 = r0 + NGW; const bool on1 = r1 < nrows; const int r1c = on1 ? r1 : r0;
        const f32x4* xa = (const f32x4*)(x + (size_t)r0 * D) + lane; const f32x4* xc = (const f32x4*)(x + (size_t)r1c * D) + lane; f32x4 va[4], vc[4];
#pragma unroll
        for (int j = 0; j < 4; ++j) { va[j] = xa[64 * j]; vc[j] = xc[64 * j]; }
        float sa = 0.f, sc = 0.f;
#pragma unroll
        for (int j = 0; j < 4; ++j) { sa += (va[j].x * va[j].x + va[j].y * va[j].y) + (va[j].z * va[j].z + va[j].w * va[j].w); sc += (vc[j].x * vc[j].x + vc[j].y * vc[j].y) + (vc[j].z * vc[j].z + vc[j].w * vc[j].w); }
        sa = wave_sum(sa); sc = wave_sum(sc);
        store_row_bf16(o + (size_t)r0 * D, lane, va); if (lane < 16) ss[(size_t)r0 * 16 + lane] = lane == 0 ? sa : 0.f;
        if (on1) { store_row_bf16(o + (size_t)r1 * D, lane, vc); if (lane < 16) ss[(size_t)r1 * 16 + lane] = lane == 0 ? sc : 0.f; }
    }
}
__device__ __forceinline__ void norm_rows(const float* x, const float* gain, bf16* o, int nrows, int gw, int NGW, int lane) {
    for (int r = gw; r < nrows; r += NGW) { f32x4 v[4]; rms_row(x + (size_t)r * D, gain, lane, v); store_row_bf16(o + (size_t)r * D, lane, v); }
}

constexpr int BA_KS = 72, BA_VS = 408, BA_KROWS = 400;
constexpr int BA_K_BYTES = BA_KROWS * BA_KS * 2, BA_V_BYTES = 64 * BA_VS * 2;
static_assert(BA_K_BYTES % 16 == 0 && BA_K_BYTES + BA_V_BYTES <= PHASE_LDS, "band attention LDS");
__device__ __forceinline__ bf16x8 cat4(s16x4 a, s16x4 b) { return __builtin_shufflevector(a, b, 0, 1, 2, 3, 4, 5, 6, 7); }
__device__ __forceinline__ unsigned cvtpk(float lo, float hi) { unsigned r; asm volatile("v_cvt_pk_bf16_f32 %0, %1, %2" : "=v"(r) : "v"(lo), "v"(hi)); return r; }

__device__ __forceinline__ void band_attention_phase(LAS unsigned char* lds, const bf16* Q, const bf16* Kb, const bf16* Vb, bf16* Ao, const float* sink, int G) {
    const int tid = opq_tid(), lane = tid & 63, wave = __builtin_amdgcn_readfirstlane(tid >> 6), fr = lane & 15, fq = lane >> 4;
    LAS bf16* Ks = (LAS bf16*)lds; LAS bf16* VTs = (LAS bf16*)(lds + BA_K_BYTES);
    for (int unit = blockIdx.x; unit < NB * 32 * NKV; unit += G) {
        const int kh = unit & 1, ib = (unit >> 1) & 31, b = unit >> 6;
        const int kbase = 128 * (ib - 1);
        for (int c = tid; c < BA_KROWS * 8; c += NTHR) { const int row = c >> 3, c8 = c & 7, kpos = kbase + row;
            v4u val = (v4u){0u, 0u, 0u, 0u};
            if (row < 384 && kpos >= 0 && kpos < SEQ) val = *(const v4u*)(Kb + ((size_t)(b * SEQ + kpos)) * KVW + kh * 64 + c8 * 8);
            *(LAS v4u*)(Ks + row * BA_KS + c8 * 8) = val; }
        for (int c = tid; c < BA_KROWS * 8; c += NTHR) { const int c8 = c / BA_KROWS, key = c % BA_KROWS, kpos = kbase + key;
            v4u val = (v4u){0u, 0u, 0u, 0u};
            if (key < 384 && kpos >= 0 && kpos < SEQ) val = *(const v4u*)(Vb + ((size_t)(b * SEQ + kpos)) * KVW + kh * 64 + c8 * 8);
            LAS bf16* dst = VTs + (c8 * 8) * BA_VS + key;
            dst[0 * BA_VS] = (bf16)(val.x & 0xffffu); dst[1 * BA_VS] = (bf16)(val.x >> 16); dst[2 * BA_VS] = (bf16)(val.y & 0xffffu); dst[3 * BA_VS] = (bf16)(val.y >> 16);
            dst[4 * BA_VS] = (bf16)(val.z & 0xffffu); dst[5 * BA_VS] = (bf16)(val.z >> 16); dst[6 * BA_VS] = (bf16)(val.w & 0xffffu); dst[7 * BA_VS] = (bf16)(val.w >> 16); }
        wg_sync();
        const int g = wave >> 1, half = wave & 1, head = kh * 4 + g;
        const float snk = sink[head];
        bf16x8 qn[2];
        { const size_t t0 = (size_t)b * SEQ + 128 * ib + 64 * half;
#pragma unroll
          for (int ks = 0; ks < 2; ++ks) qn[ks] = *(const bf16x8*)(Q + (t0 + fr) * AW + head * 64 + 32 * ks + 8 * fq); }
#pragma unroll 1
        for (int qt = 0; qt < 4; ++qt) {
            const int p0 = 64 * half + 16 * qt;
            const size_t t0 = (size_t)b * SEQ + 128 * ib + p0;
            bf16x8 qf[2]; qf[0] = qn[0]; qf[1] = qn[1];
            if (qt < 3) {
#pragma unroll
                for (int ks = 0; ks < 2; ++ks) qn[ks] = *(const bf16x8*)(Q + (t0 + 16 + fr) * AW + head * 64 + 32 * ks + 8 * fq); }
            f32x4 s[18];
            const LAS bf16* kbase_p = Ks + (p0 + fr) * BA_KS + 8 * fq;
            bf16x8 kfa[3][2], kfb[3][2];
#pragma unroll
            for (int jj = 0; jj < 3; ++jj)
#pragma unroll
                for (int ks = 0; ks < 2; ++ks) kfa[jj][ks] = *(const LAS bf16x8*)(kbase_p + (16 * jj) * BA_KS + 32 * ks);
#pragma unroll
            for (int gq = 0; gq < 6; ++gq) {
                if (gq < 5) {
#pragma unroll
                    for (int jj = 0; jj < 3; ++jj)
#pragma unroll
                        for (int ks = 0; ks < 2; ++ks) { const bf16x8 t = *(const LAS bf16x8*)(kbase_p + (16 * (3 * (gq + 1) + jj)) * BA_KS + 32 * ks); if (gq & 1) kfa[jj][ks] = t; else kfb[jj][ks] = t; } }
                __builtin_amdgcn_sched_barrier(0);
#pragma unroll
                for (int jj = 0; jj < 3; ++jj) { const int j = 3 * gq + jj; s[j] = (f32x4){0.f, 0.f, 0.f, 0.f};
#pragma unroll
                    for (int ks = 0; ks < 2; ++ks) s[j] = __builtin_amdgcn_mfma_f32_16x16x32_bf16((gq & 1) ? kfb[jj][ks] : kfa[jj][ks], qf[ks], s[j], 0, 0, 0); }
                __builtin_amdgcn_sched_barrier(0);
            }
            float mx = -1e30f;
#pragma unroll
            for (int j = 0; j < 18; ++j)
#pragma unroll
                for (int r = 0; r < 4; ++r) { const int rel = 16 * j + 4 * fq + r - fr, idx = p0 + 16 * j + 4 * fq + r;
                    const bool ok = rel >= 0 && rel <= 256 && (ib > 0 || idx >= 128) && (ib < 31 || idx < 256);
                    const float v = ok ? s[j][r] * 0.125f : -1e30f; s[j][r] = v; mx = fmaxf(mx, v); }
            mx = fmaxf(mx, __shfl_xor(mx, 16)); mx = fmaxf(mx, __shfl_xor(mx, 32)); mx = fmaxf(mx, snk);
            float l = 0.f;
#pragma unroll
            for (int j = 0; j < 18; ++j)
#pragma unroll
                for (int r = 0; r < 4; ++r) { const float p = __expf(s[j][r] - mx); s[j][r] = p; l += p; }
            l += __shfl_xor(l, 16); l += __shfl_xor(l, 32); l += __expf(snk - mx);
            const float inv = 1.0f / l;
            f32x4 o[4];
#pragma unroll
            for (int dt = 0; dt < 4; ++dt) o[dt] = (f32x4){0.f, 0.f, 0.f, 0.f};
            const LAS bf16* vbase_p = VTs + fr * BA_VS + p0 + 4 * fq;
            s16x4 va[4][2], vb[4][2];
#pragma unroll
            for (int dt = 0; dt < 4; ++dt) { va[dt][0] = *(const LAS s16x4*)(vbase_p + (16 * dt) * BA_VS); va[dt][1] = *(const LAS s16x4*)(vbase_p + (16 * dt) * BA_VS + 16); }
#pragma unroll
            for (int kk = 0; kk < 9; ++kk) {
                if (kk < 8) {
#pragma unroll
                    for (int dt = 0; dt < 4; ++dt) { const s16x4 t0_ = *(const LAS s16x4*)(vbase_p + (16 * dt) * BA_VS + 32 * (kk + 1)), t1_ = *(const LAS s16x4*)(vbase_p + (16 * dt) * BA_VS + 32 * (kk + 1) + 16);
                        if (kk & 1) { va[dt][0] = t0_; va[dt][1] = t1_; } else { vb[dt][0] = t0_; vb[dt][1] = t1_; } } }
                v4u pw; pw.x = cvtpk(s[2 * kk][0], s[2 * kk][1]); pw.y = cvtpk(s[2 * kk][2], s[2 * kk][3]); pw.z = cvtpk(s[2 * kk + 1][0], s[2 * kk + 1][1]); pw.w = cvtpk(s[2 * kk + 1][2], s[2 * kk + 1][3]);
                const bf16x8 pf = __builtin_bit_cast(bf16x8, pw);
                __builtin_amdgcn_sched_barrier(0);
#pragma unroll
                for (int dt = 0; dt < 4; ++dt) { const bf16x8 vf = (kk & 1) ? cat4(vb[dt][0], vb[dt][1]) : cat4(va[dt][0], va[dt][1]);
                    o[dt] = __builtin_amdgcn_mfma_f32_16x16x32_bf16(vf, pf, o[dt], 0, 0, 0); }
                __builtin_amdgcn_sched_barrier(0);
            }
#pragma unroll
            for (int dt = 0; dt < 4; ++dt) { const f32x4 ov = o[dt] * inv; v2u w; w.x = cvtpk(ov[0], ov[1]); w.y = cvtpk(ov[2], ov[3]);
                *(v2u*)(Ao + (t0 + fr) * AW + head * 64 + 16 * dt + 4 * fq) = w; }
        }
        wg_sync();
    }
}

constexpr int XA_KS = 136, XA_VS = 264;
constexpr int XA_K_BYTES = MEML * XA_KS * 2, XA_V_BYTES = XHD * XA_VS * 2;
static_assert(XA_K_BYTES % 16 == 0 && XA_K_BYTES + XA_V_BYTES <= PHASE_LDS, "cross attention LDS");
__device__ __forceinline__ void cross_attention_phase(LAS unsigned char* lds, const bf16* Qx, const bf16* Kmem, const bf16* VmemT, bf16* Ox, int layer, int G) {
    const int tid = opq_tid(), lane = tid & 63, wave = __builtin_amdgcn_readfirstlane(tid >> 6), fr = lane & 15, fq = lane >> 4;
    LAS bf16* Ks = (LAS bf16*)lds; LAS bf16* VTs = (LAS bf16*)(lds + XA_K_BYTES);
    for (int unit = blockIdx.x; unit < 256; unit += G) {
        const int quarter = unit & 3, head = (unit >> 2) & 3, b = unit >> 4;
        for (int c = tid; c < MEML * 16; c += NTHR) { const int key = c >> 4, c8 = c & 15;
            *(LAS v4u*)(Ks + key * XA_KS + c8 * 8) = *(const v4u*)(Kmem + (size_t)(b * MEML + key) * 1024 + layer * 512 + head * 128 + c8 * 8); }
        for (int c = tid; c < XHD * 32; c += NTHR) { const int d = c >> 5, c8 = c & 31;
            *(LAS v4u*)(VTs + d * XA_VS + c8 * 8) = *(const v4u*)(VmemT + (size_t)(layer * 512 + head * 128 + d) * MROWS + b * MEML + c8 * 8); }
        wg_sync();
        bf16x8 qn[4];
        { const size_t t0 = (size_t)b * SEQ + (quarter * 4) * 256 + wave * 32;
#pragma unroll
          for (int ks = 0; ks < 4; ++ks) qn[ks] = *(const bf16x8*)(Qx + (t0 + fr) * XW + head * 128 + 32 * ks + 8 * fq); }
#pragma unroll 1
        for (int qi = 0; qi < 8; ++qi) {
            const size_t t0 = (size_t)b * SEQ + (quarter * 4 + (qi >> 1)) * 256 + wave * 32 + 16 * (qi & 1);
            bf16x8 qf[4];
#pragma unroll
            for (int ks = 0; ks < 4; ++ks) qf[ks] = qn[ks];
            if (qi < 7) { const size_t t1 = (size_t)b * SEQ + (quarter * 4 + ((qi + 1) >> 1)) * 256 + wave * 32 + 16 * ((qi + 1) & 1);
#pragma unroll
                for (int ks = 0; ks < 4; ++ks) qn[ks] = *(const bf16x8*)(Qx + (t1 + fr) * XW + head * 128 + 32 * ks + 8 * fq); }
            f32x4 s[16];
            const LAS bf16* kbase_p = Ks + fr * XA_KS + 8 * fq;
            bf16x8 kfa[2][4], kfb[2][4];
#pragma unroll
            for (int jj = 0; jj < 2; ++jj)
#pragma unroll
                for (int ks = 0; ks < 4; ++ks) kfa[jj][ks] = *(const LAS bf16x8*)(kbase_p + (16 * jj) * XA_KS + 32 * ks);
#pragma unroll
            for (int gq = 0; gq < 8; ++gq) {
                if (gq < 7) {
#pragma unroll
                    for (int jj = 0; jj < 2; ++jj)
#pragma unroll
                        for (int ks = 0; ks < 4; ++ks) { const bf16x8 t = *(const LAS bf16x8*)(kbase_p + (16 * (2 * (gq + 1) + jj)) * XA_KS + 32 * ks); if (gq & 1) kfa[jj][ks] = t; else kfb[jj][ks] = t; } }
                __builtin_amdgcn_sched_barrier(0);
#pragma unroll
                for (int jj = 0; jj < 2; ++jj) { const int j = 2 * gq + jj; s[j] = (f32x4){0.f, 0.f, 0.f, 0.f};
#pragma unroll
                    for (int ks = 0; ks < 4; ++ks) s[j] = __builtin_amdgcn_mfma_f32_16x16x32_bf16((gq & 1) ? kfb[jj][ks] : kfa[jj][ks], qf[ks], s[j], 0, 0, 0); }
                __builtin_amdgcn_sched_barrier(0);
            }
            float mx = -1e30f;
#pragma unroll
            for (int j = 0; j < 16; ++j)
#pragma unroll
                for (int r = 0; r < 4; ++r) { const float v = s[j][r] * 0.08838834764831845f; s[j][r] = v; mx = fmaxf(mx, v); }
            mx = fmaxf(mx, __shfl_xor(mx, 16)); mx = fmaxf(mx, __shfl_xor(mx, 32));
            float l = 0.f;
#pragma unroll
            for (int j = 0; j < 16; ++j)
#pragma unroll
                for (int r = 0; r < 4; ++r) { const float p = __expf(s[j][r] - mx); s[j][r] = p; l += p; }
            l += __shfl_xor(l, 16); l += __shfl_xor(l, 32);
            const float inv = 1.0f / l;
            f32x4 o[8];
#pragma unroll
            for (int dt = 0; dt < 8; ++dt) o[dt] = (f32x4){0.f, 0.f, 0.f, 0.f};
            const LAS bf16* vbase_p = VTs + fr * XA_VS + 4 * fq;
            s16x4 va[8][2], vb[8][2];
#pragma unroll
            for (int dt = 0; dt < 8; ++dt) { va[dt][0] = *(const LAS s16x4*)(vbase_p + (16 * dt) * XA_VS); va[dt][1] = *(const LAS s16x4*)(vbase_p + (16 * dt) * XA_VS + 16); }
#pragma unroll
            for (int kk = 0; kk < 8; ++kk) {
                if (kk < 7) {
#pragma unroll
                    for (int dt = 0; dt < 8; ++dt) { const s16x4 t0_ = *(const LAS s16x4*)(vbase_p + (16 * dt) * XA_VS + 32 * (kk + 1)), t1_ = *(const LAS s16x4*)(vbase_p + (16 * dt) * XA_VS + 32 * (kk + 1) + 16);
                        if (kk & 1) { va[dt][0] = t0_; va[dt][1] = t1_; } else { vb[dt][0] = t0_; vb[dt][1] = t1_; } } }
                v4u pw; pw.x = cvtpk(s[2 * kk][0], s[2 * kk][1]); pw.y = cvtpk(s[2 * kk][2], s[2 * kk][3]); pw.z = cvtpk(s[2 * kk + 1][0], s[2 * kk + 1][1]); pw.w = cvtpk(s[2 * kk + 1][2], s[2 * kk + 1][3]);
                const bf16x8 pf = __builtin_bit_cast(bf16x8, pw);
                __builtin_amdgcn_sched_barrier(0);
#pragma unroll
                for (int dt = 0; dt < 8; ++dt) { const bf16x8 vf = (kk & 1) ? cat4(vb[dt][0], vb[dt][1]) : cat4(va[dt][0], va[dt][1]);
                    o[dt] = __builtin_amdgcn_mfma_f32_16x16x32_bf16(vf, pf, o[dt], 0, 0, 0); }
                __builtin_amdgcn_sched_barrier(0);
            }
#pragma unroll
            for (int dt = 0; dt < 8; ++dt) { const f32x4 ov = o[dt] * inv; v2u w; w.x = cvtpk(ov[0], ov[1]); w.y = cvtpk(ov[2], ov[3]);
                *(v2u*)(Ox + (t0 + fr) * XW + head * 128 + 16 * dt + 4 * fq) = w; }
        }
        wg_sync();
    }
}
constexpr float HY_MIN_DECAY = -3.0701134573253944f;
constexpr float HY_MAX_DECAY = -15.350567286626972f;
__device__ __forceinline__ void h2_rows(const Args& a, float* H2, int gw, int NGW, int lane) {
    for (int idx = gw; idx < 2 * SEQ; idx += NGW) {
        const int l = idx >> 12, j = idx & 4095;
        const float* w1 = a.in[I_FW1] + l * 33 * 64; const float* b1 = a.in[I_FB1] + l * 64; const float* fr1 = a.in[I_FFR1] + l * 64;
        const float* w2 = a.in[I_FW2] + l * 64 * 64; const float* b2 = a.in[I_FB2] + l * 64; const float* fr2 = a.in[I_FFR2] + l * 64;
        const float w = 6.283185307179586f * (float)j / 4096.0f;
        const int mm = (lane - 1) & 15; const float f = 1e-4f + (float)mm * ((15.0f - 1e-4f) / 15.0f); const float ang = f * w;
        float zq = lane == 0 ? (float)j / 4095.0f : (lane <= 16 ? cosf(ang) : -sinf(ang));
        float acc = b1[lane];
#pragma unroll
        for (int q = 0; q < 33; ++q) acc += __shfl(zq, q) * w1[q * 64 + lane];
        const float h1 = sinf(fr1[lane] * acc);
        acc = b2[lane];
#pragma unroll
        for (int q = 0; q < 64; ++q) acc += __shfl(h1, q) * w2[q * 64 + lane];
        H2[(size_t)idx * 64 + lane] = sinf(fr2[lane] * acc);
    }
}
__device__ __forceinline__ void kfilt_phase(LAS unsigned char* lds, const float* H2, const float* w3all, float* KF, int G) {
    LAS float* ws = (LAS float*)lds;
    const int tid = opq_tid(), jj = tid & 63, cg = __builtin_amdgcn_readfirstlane(tid >> 6);
    for (int unit = blockIdx.x; unit < 2 * 64 * 32; unit += G) {
        const int cb = unit & 31, jb = (unit >> 5) & 63, l = unit >> 11;
        const float* w3 = w3all + (size_t)l * 64 * 2048;
        for (int e = tid; e < 4096; e += NTHR) ws[e] = w3[(size_t)(e >> 6) * 2048 + cb * 64 + (e & 63)];
        wg_sync();
        const int j = jb * 64 + jj;
        const f32x4* hr = (const f32x4*)(H2 + ((size_t)l * SEQ + j) * 64);
        float acc[8];
#pragma unroll
        for (int e = 0; e < 8; ++e) acc[e] = 0.f;
#pragma unroll
        for (int q = 0; q < 16; ++q) { const f32x4 hv = hr[q];
#pragma unroll
            for (int i = 0; i < 4; ++i) { const LAS f32x4* wp = (const LAS f32x4*)(ws + (4 * q + i) * 64 + cg * 8); const f32x4 wa = wp[0], wb = wp[1];
                acc[0] += hv[i] * wa[0]; acc[1] += hv[i] * wa[1]; acc[2] += hv[i] * wa[2]; acc[3] += hv[i] * wa[3];
                acc[4] += hv[i] * wb[0]; acc[5] += hv[i] * wb[1]; acc[6] += hv[i] * wb[2]; acc[7] += hv[i] * wb[3]; } }
        const float tj = (float)j / 4095.0f;
#pragma unroll
        for (int e = 0; e < 8; ++e) { const int col = cb * 64 + cg * 8 + e, dir = col >> 10, oc = col & 1023;
            const float delta = HY_MIN_DECAY + (float)oc * ((HY_MAX_DECAY - HY_MIN_DECAY) / 1023.0f);
            float val = acc[e] * expf(-tj * fabsf(delta));
            int n = dir == 0 ? j : 8192 - j;
            if (dir == 1 && j == 0) { n = 4096; val = 0.f; }
            KF[((size_t)(l * 1024 + oc)) * 8192 + n] = val; }
        wg_sync();
    }
}

constexpr int HY_RAWS = 4112;
constexpr int HY_ROWB = 2 * HY_RAWS * 2;
constexpr int HY_VB_OFF = FFT_WORK * 8;
constexpr int HY_X2_OFF = HY_VB_OFF + HY_ROWB;
constexpr int HY_X1_OFF = HY_X2_OFF + HY_ROWB;
constexpr int HY_EX_OFF = HY_X1_OFF + HY_ROWB;
constexpr int HY_YB_OFF = HY_EX_OFF + 16384;
static_assert(HY_VB_OFF % 16 == 0 && HY_ROWB % 16 == 0 && HY_YB_OFF + 2 * 4096 * 2 <= PHASE_LDS && HY_YB_OFF - HY_X1_OFF >= 4096 * 8 && HY_X1_OFF % 8 == 0, "hyena LDS map");
typedef float f32x2v __attribute__((ext_vector_type(2)));
struct LdsCf { LAS f32x2v* p; __device__ __forceinline__ cf ld(int i) const { const f32x2v t = p[i]; return mk(t.x, t.y); } __device__ __forceinline__ void st(int i, cf v) const { p[i] = (f32x2v){v.x, v.y}; } };

__device__ __forceinline__ void hy_dma_rows(LAS unsigned char* lds, int region_off, const bf16* UT, int b0, int ch, int wave, int lane) {
#pragma unroll
    for (int r = 0; r < 2; ++r)
        __builtin_amdgcn_global_load_lds((const unsigned*)(UT + (((size_t)((b0 + r) * C3 + ch)) << 12) + wave * 512 + lane * 8), (LAS unsigned*)(lds + region_off + r * HY_RAWS * 2 + 16 + wave * 1024), 16, 0, 0);
}
__device__ __forceinline__ void hy_pads(LAS unsigned char* lds, int region_off, int tid) {
    if (tid < 2) { LAS bf16* row = (LAS bf16*)(lds + region_off) + tid * HY_RAWS; row[7] = 0; row[8 + 4096] = 0; }
}
__device__ __forceinline__ float hy_conv(const LAS bf16* ldsh, int e, float w0, float w1, float w2, float bias) {
    return w0 * bf1(ldsh[e - 1]) + w1 * bf1(ldsh[e]) + w2 * bf1(ldsh[e + 1]) + bias;
}
__device__ __forceinline__ int opqi(int v) { asm volatile("" : "+v"(v)); return v; }
template <class T> __device__ __forceinline__ T* opqp(T* p) { asm volatile("" : "+v"(p)); return p; }
__device__ __forceinline__ cf opq(cf w) { asm volatile("" : "+v"(w.x), "+v"(w.y)); return w; }
__device__ __forceinline__ cf csel(bool c, cf a, cf b) { return mk(c ? a.x : b.x, c ? a.y : b.y); }
__device__ __forceinline__ float uni(float v) { return __builtin_bit_cast(float, __builtin_amdgcn_readfirstlane(__builtin_bit_cast(int, v))); }
__device__ __forceinline__ void wave_lds_fence() { __builtin_amdgcn_sched_barrier(0); asm volatile("s_waitcnt lgkmcnt(0)" ::: "memory"); __builtin_amdgcn_sched_barrier(0); }
__device__ __forceinline__ void wg_sync_lds() { __builtin_amdgcn_sched_barrier(0); asm volatile("s_waitcnt lgkmcnt(0)" ::: "memory"); __builtin_amdgcn_s_barrier(); asm volatile("" ::: "memory"); __builtin_amdgcn_sched_barrier(0); }
__device__ __forceinline__ cf shfl_cf(cf v) { return mk(__shfl_xor(v.x, 32), __shfl_xor(v.y, 32)); }

__device__ __forceinline__ void kspec_phase(LAS unsigned char* lds, const float* KF, float* KSP, int G) {
    const int tid = opq_tid();
    LdsCf W; W.p = (LAS f32x2v*)lds;
    int h1, j1, h2, k1, j2, h3, blk; geo1(tid, h1, j1); geo2(tid, h2, k1, j2); geo3(tid, h3, blk);
    const int fb1 = opqi(fbase1(h1, j1)), fb2 = opqi(fbase2(h2, k1, j2)), fb3 = opqi(fbase3(h3, blk)), jo = opqi(j1);
    float sv, cv;
    sincospif(-(float)j1 / 4096.0f, &sv, &cv); const cf w8192j = mk(cv, sv);
    sincospif(-(float)j1 / 2048.0f, &sv, &cv); const cf w4096j = mk(cv, sv);
    sincospif(-(float)j2 / 128.0f, &sv, &cv);  const cf w256j = mk(cv, sv);
    const cf w32 = mk(0.98078528040323043f, -0.19509032201612825f);
#pragma unroll 1
    for (int unit = blockIdx.x; unit < 2 * 2 * HYW; unit += G) {
        const float* kf = KF + (size_t)unit * 8192;
        cf x[16]; cf wp = opq(w8192j);
#pragma unroll
        for (int m = 0; m < 16; ++m) { const float* kp = kf + opqi(jo + 1024 * (m >> 2)); const float ka = kp[256 * (m & 3)]; const float* kq = kp + opqi(4096); const float kb = kq[256 * (m & 3)];
            x[m] = csel(h1 == 0, mk(ka + kb, 0.f), cscale(wp, ka - kb)); wp = cmul(wp, w32); }
        fwd_pass1(W, fb1, opq(w4096j), x); wg_sync();
        fwd_pass2(W, fb2, opq(w256j)); wave_lds_fence();
        { cf kk[16]; fwd_pass3_keep(W, fb3, kk); GAS f32x4* kd = opqp((GAS f32x4*)(KSP + (size_t)unit * 16384 + tid * 32));
#pragma unroll
          for (int q = 0; q < 8; ++q) kd[q] = (f32x4){kk[2 * q].x, kk[2 * q].y, kk[2 * q + 1].x, kk[2 * q + 1].y}; }
        wg_sync();
    }
}
__device__ __forceinline__ void mid_pass3g(LdsCf lds, int b3, const GAS f32x4* Kp) {
    f32x4 kv[8];
#pragma unroll
    for (int q = 0; q < 8; ++q) kv[q] = Kp[q];
    cf x[16];
#pragma unroll
    for (int m = 0; m < 16; ++m) x[m] = lds.ld(b3 + m);
    dft16<false>(x);
#pragma unroll
    for (int q = 0; q < 8; ++q) { x[2 * q] = cmul(x[2 * q], mk(kv[q][0], kv[q][1])); x[2 * q + 1] = cmul(x[2 * q + 1], mk(kv[q][2], kv[q][3])); }
    dft16<true>(x);
#pragma unroll
    for (int m = 0; m < 16; ++m) lds.st(b3 + m, x[m]);
}
#ifdef DIAG
#define HY_SYNC() do { const unsigned long long ts_ = wall_clock64(); wg_sync(); hy_wait_ += wall_clock64() - ts_; } while (0)
#else
#define HY_SYNC() wg_sync()
#endif
__device__ __forceinline__ void hyena_phase(LAS unsigned char* lds, const Args& a, int layer, const bf16* UT, const float* KSP, bf16* YT, int G) {
    const int tid = opq_tid();
#ifdef DIAG
    unsigned long long hy_wait_ = 0; const unsigned long long hy_t0_ = wall_clock64();
#endif
    LdsCf W; W.p = (LAS f32x2v*)lds;
    const int wave = __builtin_amdgcn_readfirstlane(tid >> 6), lane = tid & 63;
    int h1, j1, h2, k1, j2, h3, blk; geo1(tid, h1, j1); geo2(tid, h2, k1, j2); geo3(tid, h3, blk);
    const int fb1 = opqi(fbase1(h1, j1)), fb2 = opqi(fbase2(h2, k1, j2)), fb3 = opqi(fbase3(h3, blk));
    const int jo = opqi(j1), jh = opqi(j1 + 2048 * h1);
    LdsCf ZB; ZB.p = (LAS f32x2v*)lds; const int zo = opqi(HY_X1_OFF / 8 + j1), zh = opqi(HY_X1_OFF / 8 + j1 + 2048 * h1);
    LAS bf16* l16 = (LAS bf16*)lds; const int yh = opqi(HY_YB_OFF / 2 + j1 + 2048 * h1);
    const LAS bf16* ldsh = (const LAS bf16*)lds; const int ro = opqi(HY_VB_OFF / 2 + 8 + j1), rh = opqi(HY_VB_OFF / 2 + 8 + j1 + 2048 * h1);
    float sv, cv;
    sincospif(-(float)j1 / 4096.0f, &sv, &cv); const cf w8192j = mk(cv, sv);
    sincospif(-(float)j1 / 2048.0f, &sv, &cv); const cf w4096j = mk(cv, sv);
    sincospif(-(float)j2 / 128.0f, &sv, &cv);  const cf w256j = mk(cv, sv);
    const cf w32 = mk(0.98078528040323043f, -0.19509032201612825f);
    const float* cw = a.in[I_CONVW] + layer * 3 * C3; const float* cbv = a.in[I_CONVB] + layer * C3; const float* skp = a.in[I_SKIP] + layer * 2 * HYW;
    for (int c = blockIdx.x; c < HYW; c += G) {
        const float x1w0 = uni(cw[c]), x1w1 = uni(cw[C3 + c]), x1w2 = uni(cw[2 * C3 + c]), x1b = uni(cbv[c]);
        const float x2w0 = uni(cw[512 + c]), x2w1 = uni(cw[C3 + 512 + c]), x2w2 = uni(cw[2 * C3 + 512 + c]), x2b = uni(cbv[512 + c]);
        const float vw0 = uni(cw[1024 + c]), vw1 = uni(cw[C3 + 1024 + c]), vw2 = uni(cw[2 * C3 + 1024 + c]), vb = uni(cbv[1024 + c]);
        const float skip0 = uni(skp[c]), skip1 = uni(skp[HYW + c]);
        const float* KS0 = KSP + ((size_t)((layer * 2 + 0) * HYW + c)) * 16384 + opqi(tid * 32);
        const float* KS1 = KSP + ((size_t)((layer * 2 + 1) * HYW + c)) * 16384 + opqi(tid * 32);
        hy_dma_rows(lds, HY_VB_OFF, UT, 0, 1024 + c, wave, lane); hy_pads(lds, HY_VB_OFF, tid); hy_pads(lds, HY_X2_OFF, tid);
        HY_SYNC();
#pragma unroll 1
        for (int pr = 0; pr < 8; ++pr) {
            const int b0 = 2 * pr;
            hy_dma_rows(lds, HY_X1_OFF, UT, b0, c, wave, lane); hy_dma_rows(lds, HY_X2_OFF, UT, b0, 512 + c, wave, lane); hy_pads(lds, HY_X1_OFF, tid);
            cf x[16];
            { cf wp = opq(w8192j);
#pragma unroll
              for (int m = 0; m < 16; ++m) {
                  const cf z = mk(hy_conv(ldsh, ro + 256 * m, vw0, vw1, vw2, vb), hy_conv(ldsh, ro + 256 * m + HY_RAWS, vw0, vw1, vw2, vb));
                  x[m] = csel(h1 == 0, z, cmul(z, wp)); wp = cmul(wp, w32); } }
            fwd_pass1(W, fb1, opq(w4096j), x); wg_sync_lds();
            fwd_pass2(W, fb2, opq(w256j)); wave_lds_fence();
            mid_pass3g(W, fb3, opqp((const GAS f32x4*)KS0)); wave_lds_fence();
            inv_pass2(W, fb2, opq(w256j)); HY_SYNC();
            inv_pass1(W, fb1, opq(w4096j), x);
            cf zz[8];
            { cf wp = opq(w8192j);
#pragma unroll
              for (int m = 0; m < 16; ++m) { x[m] = csel(h1 == 1, cmulc(x[m], wp), x[m]); wp = cmul(wp, w32); }
#pragma unroll
              for (int i = 0; i < 8; ++i) { const cf xa_ = x[i], xb_ = x[8 + i]; const cf mine = csel(h1 == 1, xb_, xa_), send = csel(h1 == 1, xa_, xb_); const cf r = cscale(cadd(mine, shfl_cf(send)), 1.0f / 8192.0f);
                  const float va = hy_conv(ldsh, rh + 256 * i, vw0, vw1, vw2, vb), vbb = hy_conv(ldsh, rh + 256 * i + HY_RAWS, vw0, vw1, vw2, vb);
                  const float xa = hy_conv(ldsh, rh + 256 * i + (HY_X1_OFF - HY_VB_OFF) / 2, x1w0, x1w1, x1w2, x1b), xb = hy_conv(ldsh, rh + 256 * i + (HY_X1_OFF - HY_VB_OFF) / 2 + HY_RAWS, x1w0, x1w1, x1w2, x1b);
                  zz[i] = mk(xa * (r.x + skip0 * va), xb * (r.y + skip0 * vbb)); } }
            wg_sync_lds();
            if (pr < 7) hy_dma_rows(lds, HY_VB_OFF, UT, b0 + 2, 1024 + c, wave, lane);
#pragma unroll
            for (int i = 0; i < 8; ++i) ZB.st(zh + 256 * i, zz[i]);
            wg_sync_lds();
            { cf wp = opq(w8192j);
#pragma unroll
              for (int m = 0; m < 16; ++m) { const cf full = ZB.ld(zo + 256 * m); x[m] = csel(h1 == 0, full, cmul(full, wp)); wp = cmul(wp, w32); } }
            fwd_pass1(W, fb1, opq(w4096j), x); wg_sync_lds();
            fwd_pass2(W, fb2, opq(w256j)); wave_lds_fence();
            mid_pass3g(W, fb3, opqp((const GAS f32x4*)KS1)); wave_lds_fence();
            inv_pass2(W, fb2, opq(w256j)); wg_sync_lds();
            inv_pass1(W, fb1, opq(w4096j), x);
            { cf wp = opq(w8192j);
#pragma unroll
              for (int m = 0; m < 16; ++m) { x[m] = csel(h1 == 1, cmulc(x[m], wp), x[m]); wp = cmul(wp, w32); }
#pragma unroll
              for (int i = 0; i < 8; ++i) { const cf xa_ = x[i], xb_ = x[8 + i]; const cf mine = csel(h1 == 1, xb_, xa_), send = csel(h1 == 1, xa_, xb_); const cf r = cscale(cadd(mine, shfl_cf(send)), 1.0f / 8192.0f);
                  const int p = jh + 256 * i; const cf zv = ZB.ld(zh + 256 * i);
                  const float xa = hy_conv(ldsh, rh + 256 * i + (HY_X2_OFF - HY_VB_OFF) / 2, x2w0, x2w1, x2w2, x2b), xb = hy_conv(ldsh, rh + 256 * i + (HY_X2_OFF - HY_VB_OFF) / 2 + HY_RAWS, x2w0, x2w1, x2w2, x2b);
                  const float ya = xa * (r.x + skip1 * zv.x), yb = xb * (r.y + skip1 * zv.y);
                  l16[yh + 256 * i] = (bf16)f2bf(ya); l16[yh + 256 * i + 4096] = (bf16)f2bf(yb); (void)p; } }
            HY_SYNC();
#pragma unroll
            for (int i = 0; i < 2; ++i) { const int q = tid + NTHR * i, row = q >> 9, cc = q & 511;
                *(v4u*)(YT + (((size_t)((b0 + row) * HYW + c)) << 12) + cc * 8) = *(const LAS v4u*)(l16 + HY_YB_OFF / 2 + row * 4096 + cc * 8); }
        }
    }
#ifdef DIAG
    if (blockIdx.x == 0 && tid == 0) { unsigned long long* dg = (unsigned long long*)(*(const LAS unsigned long long*)(lds + 139328)); atomicAdd(dg + 16, hy_wait_); atomicAdd(dg + 17, wall_clock64() - hy_t0_); }
#endif
}
constexpr int MN_STRIDE = 66;
static_assert(HYW * MN_STRIDE * 2 <= PHASE_LDS, "mix-norm LDS");
__device__ __forceinline__ void mixnorm_phase(LAS unsigned char* lds, const bf16* Ab, const bf16* YT, const float* ga, const float* gy, bf16* mixed, int G) {
    const int tid = opq_tid(), lane = tid & 63, wave = __builtin_amdgcn_readfirstlane(tid >> 6);
    LAS unsigned* tile32 = (LAS unsigned*)lds; const LAS bf16* tile16 = (const LAS bf16*)lds;
    f32x4 gav[2], gyv[2];
    gav[0] = *(const f32x4*)(ga + lane * 8); gav[1] = *(const f32x4*)(ga + lane * 8 + 4); gyv[0] = *(const f32x4*)(gy + lane * 8); gyv[1] = *(const f32x4*)(gy + lane * 8 + 4);
    v4u R[8];
    int unit = blockIdx.x;
    if (unit < M / 64) { const bf16* src = YT + (((size_t)((unit >> 6) * HYW + tid)) << 12) + (unit & 63) * 64;
#pragma unroll
        for (int q = 0; q < 8; ++q) R[q] = *(const v4u*)(src + 8 * q); }
#pragma unroll 1
    for (; unit < M / 64; unit += G) {
        const int b = unit >> 6, t0 = (unit & 63) * 64;
#pragma unroll
        for (int q = 0; q < 8; ++q) { LAS unsigned* d = tile32 + tid * (MN_STRIDE / 2) + 4 * q; d[0] = R[q].x; d[1] = R[q].y; d[2] = R[q].z; d[3] = R[q].w; }
        wg_sync();
        const int nu = unit + G;
        if (nu < M / 64) { const bf16* src = YT + (((size_t)((nu >> 6) * HYW + tid)) << 12) + (nu & 63) * 64;
#pragma unroll
            for (int q = 0; q < 8; ++q) R[q] = *(const v4u*)(src + 8 * q); }
        const size_t row0 = (size_t)b * SEQ + t0 + wave * 8;
        v4u av[8];
#pragma unroll
        for (int i = 0; i < 8; ++i) av[i] = *(const v4u*)(Ab + (row0 + i) * AW + lane * 8);
#pragma unroll
        for (int i = 0; i < 8; ++i) { const int tt = wave * 8 + i;
            float y[8]; float ss = 0.f;
#pragma unroll
            for (int e = 0; e < 8; ++e) { y[e] = bf1(tile16[(lane * 8 + e) * MN_STRIDE + tt]); ss += y[e] * y[e]; }
            const float rs = __builtin_amdgcn_rsqf(wave_sum(ss) * (1.f / 512.f) + EPS);
            v4u o; o.x = pk2(y[0] * rs * gyv[0][0], y[1] * rs * gyv[0][1]); o.y = pk2(y[2] * rs * gyv[0][2], y[3] * rs * gyv[0][3]);
            o.z = pk2(y[4] * rs * gyv[1][0], y[5] * rs * gyv[1][1]); o.w = pk2(y[6] * rs * gyv[1][2], y[7] * rs * gyv[1][3]);
            *(v4u*)(mixed + (row0 + i) * D + 512 + lane * 8) = o; }
#pragma unroll
        for (int i = 0; i < 8; ++i) {
            const float x[8] = {bflo(av[i].x), bfhi(av[i].x), bflo(av[i].y), bfhi(av[i].y), bflo(av[i].z), bfhi(av[i].z), bflo(av[i].w), bfhi(av[i].w)};
            float ss = 0.f;
#pragma unroll
            for (int e = 0; e < 8; ++e) ss += x[e] * x[e];
            const float rs = __builtin_amdgcn_rsqf(wave_sum(ss) * (1.f / 512.f) + EPS);
            v4u o; o.x = pk2(x[0] * rs * gav[0][0], x[1] * rs * gav[0][1]); o.y = pk2(x[2] * rs * gav[0][2], x[3] * rs * gav[0][3]);
            o.z = pk2(x[4] * rs * gav[1][0], x[5] * rs * gav[1][1]); o.w = pk2(x[6] * rs * gav[1][2], x[7] * rs * gav[1][3]);
            *(v4u*)(mixed + (row0 + i) * D + lane * 8) = o; }
        wg_sync();
    }
}

__device__ __forceinline__ void moe_norm_router_phase(LAS unsigned char* lds, const bf16* xb, const float* gain, const float* wr, float* rsrow, int* toke, float* tokw, int* wgcnt, int G) {
    const int tid = opq_tid(), lane = tid & 63, wave = __builtin_amdgcn_readfirstlane(tid >> 6);
    LAS int* cnt = (LAS int*)lds;
    if (tid < 8) cnt[tid] = 0;
    wg_sync();
    const int TPW = M / G;
    f32x4 wra[4][4], wrb[4][4];
#pragma unroll
    for (int j = 0; j < 4; ++j) { const f32x4 gv = *(const f32x4*)(gain + 4 * lane + 256 * j);
#pragma unroll
        for (int q = 0; q < 4; ++q) { const int k = 4 * lane + q + 256 * j; wra[j][q] = *(const f32x4*)(wr + k * 8) * gv[q]; wrb[j][q] = *(const f32x4*)(wr + k * 8 + 4) * gv[q]; } }
    v2u nx[4];
    { const v2u* xr = (const v2u*)(xb + (size_t)(blockIdx.x * TPW + wave) * D) + lane;
#pragma unroll
      for (int j = 0; j < 4; ++j) nx[j] = xr[64 * j]; }
#pragma unroll 1
    for (int i = wave; i < TPW; i += NWAVES) {
        const int t = blockIdx.x * TPW + i;
        v2u cu[4];
#pragma unroll
        for (int j = 0; j < 4; ++j) cu[j] = nx[j];
        if (i + NWAVES < TPW) { const v2u* xr = (const v2u*)(xb + (size_t)(t + NWAVES) * D) + lane;
#pragma unroll
            for (int j = 0; j < 4; ++j) nx[j] = xr[64 * j]; }
        f32x4 v[4]; float s = 0.f;
#pragma unroll
        for (int j = 0; j < 4; ++j) { const v2u a = cu[j]; v[j] = (f32x4){bflo(a.x), bfhi(a.x), bflo(a.y), bfhi(a.y)}; s += (v[j].x * v[j].x + v[j].y * v[j].y) + (v[j].z * v[j].z + v[j].w * v[j].w); }
        const float rs = 1.0f / sqrtf(wave_sum(s) * (1.f / 1024.f) + EPS);
        float lg[8];
#pragma unroll
        for (int e = 0; e < 8; ++e) lg[e] = 0.f;
#pragma unroll
        for (int j = 0; j < 4; ++j)
#pragma unroll
            for (int q = 0; q < 4; ++q) { const f32x4 wa = wra[j][q], wb = wrb[j][q]; const float hv = v[j][q];
                lg[0] += hv * wa[0]; lg[1] += hv * wa[1]; lg[2] += hv * wa[2]; lg[3] += hv * wa[3]; lg[4] += hv * wb[0]; lg[5] += hv * wb[1]; lg[6] += hv * wb[2]; lg[7] += hv * wb[3]; }
        { const bool b5 = lane & 32, b4 = lane & 16, b3 = lane & 8; float k4[4], k2[2], k1;
#pragma unroll
          for (int i = 0; i < 4; ++i) { const float send = b5 ? lg[i] : lg[4 + i], keep = b5 ? lg[4 + i] : lg[i]; k4[i] = keep + __shfl_xor(send, 32); }
#pragma unroll
          for (int i = 0; i < 2; ++i) { const float send = b4 ? k4[i] : k4[2 + i], keep = b4 ? k4[2 + i] : k4[i]; k2[i] = keep + __shfl_xor(send, 16); }
          { const float send = b3 ? k2[0] : k2[1], keep = b3 ? k2[1] : k2[0]; k1 = keep + __shfl_xor(send, 8); }
          k1 += __shfl_xor(k1, 4); k1 += __shfl_xor(k1, 2); k1 += __shfl_xor(k1, 1);
#pragma unroll
          for (int e = 0; e < 8; ++e) lg[e] = __builtin_bit_cast(float, __builtin_amdgcn_readlane(__builtin_bit_cast(int, k1), 8 * e)) * rs; }
        int i0 = 0; float v0 = lg[0];
#pragma unroll
        for (int e = 1; e < 8; ++e) if (lg[e] > v0) { v0 = lg[e]; i0 = e; }
        int i1 = -1; float v1 = -3.0e38f;
#pragma unroll
        for (int e = 0; e < 8; ++e) if (e != i0 && lg[e] > v1) { v1 = lg[e]; i1 = e; }
        const float e1 = __expf(v1 - v0), w0 = 1.0f / (1.0f + e1), w1 = e1 * w0;
        if (lane == 0) { toke[2 * t] = i0; toke[2 * t + 1] = i1; tokw[2 * t] = w0; tokw[2 * t + 1] = w1; rsrow[t] = rs; __hip_atomic_fetch_add(cnt + i0, 1, __ATOMIC_RELAXED, __HIP_MEMORY_SCOPE_WORKGROUP); __hip_atomic_fetch_add(cnt + i1, 1, __ATOMIC_RELAXED, __HIP_MEMORY_SCOPE_WORKGROUP); }
    }
    wg_sync();
    if (tid < 8) wgcnt[blockIdx.x * 8 + tid] = cnt[tid];
    wg_sync();
}
__device__ __forceinline__ void moe_slot_phase(LAS unsigned char* lds, const int* toke, const int* wgcnt, int* tokp, int* tilee, int* meta, const bf16* xb, const float* rsrow, const float* gain, unsigned char* XG8, int G) {
    const int tid = opq_tid(), lane = tid & 63, wave = __builtin_amdgcn_readfirstlane(tid >> 6);
    LAS int* arr = (LAS int*)lds;
    LAS int* pre = arr + 1024 * 8;
    LAS int* wcnt = pre + 32;
    LAS int* slots = wcnt + 64;
    for (int i = tid; i < G * 8; i += NTHR) arr[i] = wgcnt[i];
    wg_sync();
    if (tid < 8) { int p = 0, tot = 0; for (int w = 0; w < G; ++w) { const int c = arr[w * 8 + tid]; if (w < (int)blockIdx.x) p += c; tot += c; } pre[tid] = p; pre[8 + tid] = tot; }
    wg_sync();
    if (tid == 0) { int ps = 0; for (int e = 0; e < 8; ++e) { pre[16 + e] = ps; ps += ((pre[8 + e] + 255) >> 8) << 8; } pre[24] = ps; }
    wg_sync();
    const int TPW = M / G;
    int e_mine = -1, t = 0, rank = 0;
    if (tid < 2 * TPW) { t = blockIdx.x * TPW + (tid >> 1); e_mine = toke[2 * t + (tid & 1)]; }
#pragma unroll
    for (int e = 0; e < 8; ++e) { const unsigned long long mk_ = __ballot(e_mine == e); if (e_mine == e) rank = __popcll(mk_ & ((1ull << lane) - 1ull)); if (lane == 0) wcnt[wave * 8 + e] = __popcll(mk_); }
    wg_sync();
    if (e_mine >= 0) { int base = pre[16 + e_mine] + pre[e_mine]; for (int w = 0; w < wave; ++w) base += wcnt[w * 8 + e_mine];
        const int slot = base + rank; slots[tid] = slot; tokp[2 * t + (tid & 1)] = slot; }
    else slots[tid] = -1;
    if ((int)blockIdx.x < 8) { const int e = blockIdx.x, s0 = pre[16 + e] + pre[8 + e], s1 = pre[16 + e] + (((pre[8 + e] + 255) >> 8) << 8);
        unsigned z0 = 0u; asm volatile("" : "+v"(z0));
        for (int i = tid; i < (s1 - s0) * 64; i += NTHR) ((v4u*)(XG8 + (size_t)s0 * D))[i] = (v4u){z0, z0, z0, z0}; }
    if (blockIdx.x == 0) { const int ntiles = pre[24] >> 8;
        for (int ti = tid; ti < ntiles; ti += NTHR) { int e = 0;
#pragma unroll
            for (int q = 1; q < 8; ++q) if (ti * 256 >= pre[16 + q]) e = q;
            tilee[ti] = e; }
        if (tid == 0) meta[0] = ntiles; }
    wg_sync();
    { f32x4 g[4];
#pragma unroll
      for (int q = 0; q < 4; ++q) g[q] = *(const f32x4*)(gain + 16 * lane + 4 * q);
#pragma unroll 1
      for (int a0 = wave * 64; a0 < wave * 64 + 64; a0 += 2) {
          v4u av[2][2]; float rs[2]; int sl[2];
#pragma unroll
          for (int u = 0; u < 2; ++u) { const int a = a0 + u; sl[u] = slots[a]; const int tt = blockIdx.x * TPW + (a >> 1); rs[u] = rsrow[tt]; const v4u* src = (const v4u*)(xb + (size_t)tt * D) + 2 * lane; av[u][0] = src[0]; av[u][1] = src[1]; }
#pragma unroll
          for (int u = 0; u < 2; ++u) if (sl[u] >= 0) { v4u o;
#pragma unroll
              for (int h = 0; h < 2; ++h) { const unsigned w4[4] = {av[u][h].x, av[u][h].y, av[u][h].z, av[u][h].w};
#pragma unroll
                  for (int q = 0; q < 2; ++q) { int w = 0;
                      w = __builtin_amdgcn_cvt_pk_fp8_f32(bflo(w4[2 * q]) * rs[u] * g[2 * h + q][0], bfhi(w4[2 * q]) * rs[u] * g[2 * h + q][1], w, false);
                      w = __builtin_amdgcn_cvt_pk_fp8_f32(bflo(w4[2 * q + 1]) * rs[u] * g[2 * h + q][2], bfhi(w4[2 * q + 1]) * rs[u] * g[2 * h + q][3], w, true);
                      o[2 * h + q] = (unsigned)w; } }
              ((v4u*)(XG8 + (size_t)sl[u] * D))[lane] = o; } } }
    wg_sync();
}
__device__ __forceinline__ void moe_gather_phase(const bf16* xb, const float* rsrow, const float* gain, const int* rowtok, bf16* XG, int nrows, int gw, int NGW, int lane) {
    f32x4 g[4];
#pragma unroll
    for (int q = 0; q < 4; ++q) g[q] = *(const f32x4*)(gain + (q >> 1) * 512 + 8 * lane + 4 * (q & 1));
    for (int r = gw; r < nrows; r += NGW) { const int t = rowtok[r]; const float rs = rsrow[t]; const v4u* src = (const v4u*)(xb + (size_t)t * D); v4u* dst = (v4u*)(XG + (size_t)r * D);
#pragma unroll
        for (int h = 0; h < 2; ++h) { const v4u a = src[64 * h + lane]; v4u o;
            o.x = pk2(bflo(a.x) * rs * g[2 * h][0], bfhi(a.x) * rs * g[2 * h][1]); o.y = pk2(bflo(a.y) * rs * g[2 * h][2], bfhi(a.y) * rs * g[2 * h][3]);
            o.z = pk2(bflo(a.z) * rs * g[2 * h + 1][0], bfhi(a.z) * rs * g[2 * h + 1][1]); o.w = pk2(bflo(a.w) * rs * g[2 * h + 1][2], bfhi(a.w) * rs * g[2 * h + 1][3]);
            dst[64 * h + lane] = o; } }
}
__device__ __forceinline__ void moe_combine_final_phase(const bf16* xb, float* out, const bf16* YB, const int* tokp, const float* tokw, const float* gain, int gw, int NGW, int lane) {
    f32x4 g[4];
#pragma unroll
    for (int q = 0; q < 4; ++q) g[q] = *(const f32x4*)(gain + (q >> 1) * 512 + 8 * lane + 4 * (q & 1));
#pragma unroll 1
    for (int t0 = gw; t0 < M; t0 += 2 * NGW) {
        v4u xa[2][2], ya[2][2], yb[2][2]; float w0[2], w1[2]; bool on[2];
#pragma unroll
        for (int u = 0; u < 2; ++u) { const int t = t0 + u * NGW; on[u] = t < M; const int tt = on[u] ? t : t0;
            const int p0 = tokp[2 * tt], p1 = tokp[2 * tt + 1]; w0[u] = tokw[2 * tt]; w1[u] = tokw[2 * tt + 1];
            const v4u* xr = (const v4u*)(xb + (size_t)tt * D) + lane; const v4u* y0 = (const v4u*)(YB + (size_t)p0 * D) + lane; const v4u* y1 = (const v4u*)(YB + (size_t)p1 * D) + lane;
#pragma unroll
            for (int h = 0; h < 2; ++h) { xa[u][h] = xr[64 * h]; ya[u][h] = y0[64 * h]; yb[u][h] = y1[64 * h]; } }
#pragma unroll
        for (int u = 0; u < 2; ++u) { const int t = t0 + u * NGW; float v[2][8]; float s = 0.f;
#pragma unroll
            for (int h = 0; h < 2; ++h) { const unsigned xw[4] = {xa[u][h].x, xa[u][h].y, xa[u][h].z, xa[u][h].w}, aw[4] = {ya[u][h].x, ya[u][h].y, ya[u][h].z, ya[u][h].w}, bw[4] = {yb[u][h].x, yb[u][h].y, yb[u][h].z, yb[u][h].w};
#pragma unroll
                for (int q = 0; q < 4; ++q) { v[h][2 * q] = bflo(xw[q]) + w0[u] * bflo(aw[q]) + w1[u] * bflo(bw[q]); v[h][2 * q + 1] = bfhi(xw[q]) + w0[u] * bfhi(aw[q]) + w1[u] * bfhi(bw[q]);
                    s += v[h][2 * q] * v[h][2 * q] + v[h][2 * q + 1] * v[h][2 * q + 1]; } }
            const float rs = 1.0f / sqrtf(wave_sum(s) * (1.f / 1024.f) + EPS);
            if (on[u]) { f32x4* orow = (f32x4*)(out + (size_t)t * D);
#pragma unroll
                for (int h = 0; h < 2; ++h) { orow[128 * h + 2 * lane] = (f32x4){v[h][0], v[h][1], v[h][2], v[h][3]} * rs * g[2 * h]; orow[128 * h + 2 * lane + 1] = (f32x4){v[h][4], v[h][5], v[h][6], v[h][7]} * rs * g[2 * h + 1]; } } }
    }
}
struct MoeOrder : pg8::StaticOrder {
    const int* tilee; int tile0; size_t bstride;
    __device__ __forceinline__ size_t boff(const pg8::Unit& u) const { return (size_t)tilee[tile0 + u.pm] * bstride; }
};
#ifndef LB_WAVES
#define LB_WAVES 2
#endif
constexpr int N_PHASES_C = 29;
__global__ void __launch_bounds__(NTHR, LB_WAVES) fwd_kernel(Args args) {
    extern __shared__ __attribute__((aligned(16))) unsigned char lds_raw[];
    LAS unsigned char* lds = (LAS unsigned char*)lds_raw;
    const int tid0 = threadIdx.x;
    const int G = gridDim.x, NGW = G * NWAVES;
    unsigned char* ws = args.ws;
    gu32* ctl = (gu32*)(ws + WS_CTL);
    volatile LAS unsigned* MISC = (volatile LAS unsigned*)(lds + MISC_OFF);
    for (int u = tid0; u < (LDS_BYTES - LDSCTL_OFF) / 4; u += NTHR) ((LAS unsigned*)(lds + LDSCTL_OFF))[u] = 0u;
#ifdef DIAG
#ifndef DIAG_WG
#define DIAG_WG 0
#endif
#ifndef DIAG_PH
#define DIAG_PH 0
#endif
#ifndef DIAG_DIV
#define DIAG_DIV 1
#endif
    static_assert(MISC_OFF == 139328, "diag pointer slot");
    if (tid0 == 0) ((LAS unsigned long long*)(lds + MISC_OFF))[0] = (unsigned long long)(ws + WS_CTL + 512 * 1024);
#endif
    __syncthreads();
    XcdBarrier bar; bar.bar = (unsigned*)(ctl + CW_BAR); bar.x = 0; bar.st = nullptr;
    if (args.use_bar) bar = xcd_barrier_post((unsigned*)(ctl + CW_BAR), MISC + 8);
    const int lo = args.ph_lo, hi = args.ph_hi;
    int ph = 0;
#ifndef PHMASK
#define PHMASK 0xffffffffu
#endif
#define EN(k) (((PHMASK) >> (k)) & 1u)
#define PH_ON() (ph >= lo && ph < hi)
#define LOCAL_IDS() const int tid = opq_tid(), lane = tid & 63, wave = __builtin_amdgcn_readfirstlane(tid >> 6), gw = blockIdx.x * NWAVES + wave; (void)lane; (void)gw
#ifndef DUPMASK
#define DUPMASK 0u
#endif
#define RES_DST(k) ((NREP(k) > 1 && rep_ + 1 < NREP(k)) ? (bf16*)args.out : HB)
#ifndef DUPN
#define DUPN 2
#endif
#define NREP(k) ((((DUPMASK) >> (k)) & 1u) ? DUPN : 1)
#ifdef DIAG
#define PH_END_K(k) do { if (args.use_bar && (ph + 1 < hi || rep_ + 1 < NREP(k))) { const unsigned long long tb_ = wall_clock64(); xcd_barrier(bar); if (threadIdx.x == 0) { unsigned long long* dg = (unsigned long long*)(ws + WS_CTL + 512 * 1024); const unsigned long long w_ = wall_clock64() - tb_; atomicAdd(dg + 5, w_); if (ph == DIAG_PH) atomicAdd(dg + 6, w_); } } } while (0)
#else
#define PH_END_K(k) do { if (args.use_bar && (ph + 1 < hi || rep_ + 1 < NREP(k))) xcd_barrier(bar); } while (0)
#endif

    float* cosT = (float*)(ws + WS_COS); float* sinT = (float*)(ws + WS_SIN); float* H2 = (float*)(ws + WS_H2);
    int* toke = (int*)(ws + WS_TOKE); float* tokw = (float*)(ws + WS_TOKW); int* tokp = (int*)(ws + WS_TOKP); int* rowtok = (int*)(ws + WS_ROWTOK);
    int* tilee = (int*)(ws + WS_TILEE); int* wgcnt = (int*)(ws + WS_WGCNT); int* meta = (int*)(ws + WS_META); float* rsrow = (float*)(ws + WS_RSROW);
    bf16* WINA = (bf16*)(ws + WS_WINA); bf16* WINB = (bf16*)(ws + WS_WINB); bf16* WOUT = (bf16*)(ws + WS_WOUT); bf16* XQ = (bf16*)(ws + WS_XQ); bf16* XK = (bf16*)(ws + WS_XK);
    bf16* XV = (bf16*)(ws + WS_XV); bf16* XO = (bf16*)(ws + WS_XO); bf16* FGU = (bf16*)(ws + WS_FGU); bf16* FDN = (bf16*)(ws + WS_FDN); bf16* MGU = (bf16*)(ws + WS_MGU); bf16* MDN = (bf16*)(ws + WS_MDN);
    float* KF = (float*)(ws + WS_KFILT); bf16* MB = (bf16*)(ws + WS_MB); bf16* KMEM = (bf16*)(ws + WS_KMEM); bf16* VMEMT = (bf16*)(ws + WS_VMEMT); bf16* HB = (bf16*)(ws + WS_HB);
    bf16* QB = (bf16*)(ws + WS_QB); bf16* KB = (bf16*)(ws + WS_KB); bf16* VB = (bf16*)(ws + WS_VB); bf16* UT = (bf16*)(ws + WS_UT); bf16* AB = (bf16*)(ws + WS_AB); bf16* YT = (bf16*)(ws + WS_YT);
    bf16* MIXED = (bf16*)(ws + WS_MIXED); float* SS = (float*)(ws + WS_SS);
    bf16* XQB = (bf16*)(ws + WS_XQB); bf16* XOB = (bf16*)(ws + WS_XOB); bf16* ACT = (bf16*)(ws + WS_ACT); unsigned char* XG8 = ws + WS_XG; bf16* YB = (bf16*)(ws + WS_YB); unsigned char* MGU8 = ws + WS_MGU; bf16* MACT = (bf16*)(ws + WS_MACT);
    const float* const* in = args.in;

    if (EN(0) && PH_ON()) for (int rep_ = 0; rep_ < NREP(0); ++rep_) { asm volatile("; PHASE_MARK 0"); LOCAL_IDS();
        LAS float* scr = (LAS float*)(lds + wave * 8704);
        constexpr int IT_L = 384 + 768 + 512 + 4 * 256, IT_D = 3 * 1408, IT_E = 3 * 1792, IT_ALL = 2 * IT_L + IT_D + NE * IT_E;
#pragma unroll 1
        for (int it = gw; it < IT_ALL; it += NGW) {
            const float* W; int ldw, K, col0 = 0, ncols, mode = 0; bf16* WT; const float* gk = nullptr; int r = it;
            if (r < 2 * IT_L) { const int l = r / IT_L; r -= l * IT_L;
                if (r < 384) { W = in[I_WIN] + (size_t)l * D * INC; ldw = INC; K = D; ncols = 768; WT = WINA + (size_t)l * 768 * D; mode = 1; gk = in[I_MIXNORM] + l * D; }
                else if ((r -= 384) < 768) { W = in[I_WIN] + (size_t)l * D * INC; ldw = INC; K = D; col0 = 768; ncols = C3; WT = WINB + (size_t)l * C3 * D; gk = in[I_MIXNORM] + l * D; }
                else if ((r -= 768) < 512) { W = in[I_WOUT] + (size_t)l * D * D; ldw = D; K = D; ncols = D; WT = WOUT + (size_t)l * D * D; }
                else if ((r -= 512) < 256) { W = in[I_XWQ] + (size_t)l * D * XW; ldw = XW; K = D; ncols = XW; WT = XQ + (size_t)l * XW * D; gk = in[I_XNORM] + l * D; }
                else if ((r -= 256) < 256) { W = in[I_XWK] + (size_t)l * D * XW; ldw = XW; K = D; ncols = XW; WT = XK + (size_t)l * XW * D; }
                else if ((r -= 256) < 256) { W = in[I_XWV] + (size_t)l * D * XW; ldw = XW; K = D; ncols = XW; WT = XV + (size_t)l * XW * D; }
                else { r -= 256; W = in[I_XWO] + (size_t)l * XW * D; ldw = D; K = XW; ncols = D; WT = XO + (size_t)l * D * XW; }
            } else if ((r -= 2 * IT_L) < IT_D) {
                if (r < 1408) { W = in[I_FGATE]; ldw = FF; K = D; ncols = FF; WT = FGU; mode = 2; gk = in[I_FNORM]; }
                else if ((r -= 1408) < 1408) { W = in[I_FUP]; ldw = FF; K = D; ncols = FF; WT = FGU; mode = 3; gk = in[I_FNORM]; }
                else { r -= 1408; W = in[I_FDOWN]; ldw = D; K = FF; ncols = D; WT = FDN; }
            } else { r -= IT_D; const int e = r / IT_E; r -= e * IT_E;
                if (r < 2 * 1792) { const bool up = r >= 1792; if (up) r -= 1792;
                    tr_item8(in[up ? I_MUP : I_MGATE] + (size_t)e * D * FFE, FFE, D, FFE, MGU8 + (size_t)e * 2 * FFE * D, up ? 3 : 2, 32.0f, r, scr, lane); continue; }
                else { r -= 2 * 1792; tr_item8(in[I_MDOWN] + (size_t)e * FFE * D, D, FFE, D, (unsigned char*)MDN + (size_t)e * D * FFE, 0, 32.0f, r, scr, lane); continue; }
            }
            tr_item(W, ldw, K, col0, ncols, WT, mode, gk, r, scr, lane);
        }
        for (int i = blockIdx.x * NTHR + tid; i < SEQ * 32; i += G * NTHR) { const int pos = i >> 5, f = i & 31;
            const float inv = (float)pow(10000.0, -(double)f / 32.0); const float ang = (float)pos * inv;
            cosT[i] = (float)cos((double)ang); sinT[i] = (float)sin((double)ang); }
        h2_rows(args, H2, gw, NGW, lane);
        norm_rows(in[I_MEM], in[I_MEMNORM], MB, MROWS, gw, NGW, lane);
        xb_rows(in[I_X], HB, SS, M, gw, NGW, lane);
        PH_END_K(0);
    }
    ++ph;
    if (EN(1) && PH_ON()) for (int rep_ = 0; rep_ < NREP(1); ++rep_) { asm volatile("; PHASE_MARK 1"); LOCAL_IDS();
        kfilt_phase(lds, H2, in[I_FW3], KF, G);
        PH_END_K(1);
    }
    ++ph;

#pragma unroll 1
    for (int l = 0; l < 2; ++l) {
        if (EN(2) && PH_ON()) for (int rep_ = 0; rep_ < NREP(2); ++rep_) { asm volatile("; PHASE_MARK 2"); LOCAL_IDS();
            if (l == 0) {
                kspec_phase(lds, KF, (float*)(ws + WS_KSPEC), G);
                { pg8::Gemm g{MB, XK, MROWS, 1024, D}; pg8::StaticOrder S; S.init(MROWS, 1024, G, (int)blockIdx.x); pg8::EpiBf16 E{KMEM, 1024, nullptr, 1.0f};
                  pg8::gemm_phase<pg8::EpiBf16, pg8::StaticOrder, PG8_ALIGN, PG8_SP2>(lds, g, S, E); }
                { pg8::Gemm g{MB, XV, MROWS, 1024, D}; pg8::StaticOrder S; S.init(MROWS, 1024, G, G >= 128 ? (int)((blockIdx.x + G - 64) % G) : (int)blockIdx.x); pg8::EpiT E{VMEMT, 1024, 12, nullptr};
                  pg8::gemm_phase<pg8::EpiT, pg8::StaticOrder, PG8_ALIGN, PG8_SP2>(lds, g, S, E); }
            }
            { pg8::Gemm g{HB, WINA + (size_t)l * 768 * D, M, 768, D}; pg8::StaticOrder S; S.init(M, 768, G, (int)blockIdx.x); pg8::EpiQKV E{QB, KB, VB, cosT, sinT, SS + (size_t)(3 * l) * SS_STRIDE};
              pg8::gemm_phase<pg8::EpiQKV, pg8::StaticOrder, PG8_ALIGN, PG8_SP2>(lds, g, S, E); }
            { pg8::Gemm g{HB, WINB + (size_t)l * C3 * D, M, C3, D}; pg8::StaticOrder S; S.init(M, C3, G, (int)blockIdx.x); pg8::EpiT E{UT, C3, 12, SS + (size_t)(3 * l) * SS_STRIDE};
              pg8::gemm_phase<pg8::EpiT, pg8::StaticOrder, PG8_ALIGN, PG8_SP2>(lds, g, S, E); }
            PH_END_K(2);
        }
        ++ph;
        if (EN(3) && PH_ON()) for (int rep_ = 0; rep_ < NREP(3); ++rep_) { asm volatile("; PHASE_MARK 3"); LOCAL_IDS();
#ifndef BA_REP
#define BA_REP 1
#endif
#ifndef HY_REP
#define HY_REP 1
#endif
#pragma unroll 1
            for (int r_ = 0; r_ < BA_REP; ++r_) band_attention_phase(lds, QB, KB, VB, AB, in[I_SINK] + l * NH, G);
#pragma unroll 1
            for (int r_ = 0; r_ < HY_REP; ++r_) hyena_phase(lds, args, l, UT, (const float*)(ws + WS_KSPEC), YT, G);
            PH_END_K(3);
        }
        ++ph;
        if (EN(4) && PH_ON()) for (int rep_ = 0; rep_ < NREP(4); ++rep_) { asm volatile("; PHASE_MARK 4"); LOCAL_IDS(); mixnorm_phase(lds, AB, YT, in[I_ANORM] + l * AW, in[I_YNORM] + l * HYW, MIXED, G); PH_END_K(4); }
        ++ph;
        if (EN(5) && PH_ON()) for (int rep_ = 0; rep_ < NREP(5); ++rep_) { asm volatile("; PHASE_MARK 5"); LOCAL_IDS();
            pg8::Gemm g{MIXED, WOUT + (size_t)l * D * D, M, D, D}; pg8::StaticOrder S; S.init(M, D, G, (int)blockIdx.x); pg8::EpiResB E{HB, D, SS + (size_t)(3 * l + 1) * SS_STRIDE, RES_DST(5)};
            pg8::gemm_phase<pg8::EpiResB, pg8::StaticOrder, PG8_ALIGN, PG8_SP2>(lds, g, S, E);
            PH_END_K(5);
        }
        ++ph;
        if (EN(7) && PH_ON()) for (int rep_ = 0; rep_ < NREP(7); ++rep_) { asm volatile("; PHASE_MARK 7"); LOCAL_IDS();
            pg8::Gemm g{HB, XQ + (size_t)l * XW * D, M, XW, D}; pg8::StaticOrder S; S.init(M, XW, G, (int)blockIdx.x); pg8::EpiBf16 E{XQB, XW, SS + (size_t)(3 * l + 1) * SS_STRIDE, 1.0f};
            pg8::gemm_phase<pg8::EpiBf16, pg8::StaticOrder, PG8_ALIGN, PG8_SP2>(lds, g, S, E);
            PH_END_K(7);
        }
        ++ph;
        if (EN(8) && PH_ON()) for (int rep_ = 0; rep_ < NREP(8); ++rep_) { asm volatile("; PHASE_MARK 8"); LOCAL_IDS(); cross_attention_phase(lds, XQB, KMEM, VMEMT, XOB, l, G); PH_END_K(8); }
        ++ph;
        if (EN(9) && PH_ON()) for (int rep_ = 0; rep_ < NREP(9); ++rep_) { asm volatile("; PHASE_MARK 9"); LOCAL_IDS();
            pg8::Gemm g{XOB, XO + (size_t)l * D * XW, M, D, XW}; pg8::StaticOrder S; S.init(M, D, G, (int)blockIdx.x); pg8::EpiResB E{HB, D, l == 0 ? SS + (size_t)2 * SS_STRIDE : nullptr, RES_DST(9)};
            pg8::gemm_phase<pg8::EpiResB, pg8::StaticOrder, PG8_ALIGN, PG8_SP2>(lds, g, S, E);
            PH_END_K(9);
        }
        ++ph;
        if (l == 0) {
            if (EN(11) && PH_ON()) for (int rep_ = 0; rep_ < NREP(11); ++rep_) { asm volatile("; PHASE_MARK 11"); LOCAL_IDS();
                pg8::Gemm g{HB, FGU, M, 2 * FF, D}; pg8::StaticOrder S; S.init(M, 2 * FF, G, (int)blockIdx.x); pg8::EpiSwiglu<true> E{ACT, FF, SS + (size_t)2 * SS_STRIDE};
                pg8::gemm_phase<pg8::EpiSwiglu<true>, pg8::StaticOrder, PG8_ALIGN, PG8_SP2>(lds, g, S, E);
                PH_END_K(11);
            }
            ++ph;
            if (EN(12) && PH_ON()) for (int rep_ = 0; rep_ < NREP(12); ++rep_) { asm volatile("; PHASE_MARK 12"); LOCAL_IDS();
                pg8::Gemm g{ACT, FDN, M, D, FF}; pg8::StaticOrder S; S.init(M, D, G, (int)blockIdx.x); pg8::EpiResB E{HB, D, SS + (size_t)3 * SS_STRIDE, RES_DST(12)};
                pg8::gemm_phase<pg8::EpiResB, pg8::StaticOrder, PG8_ALIGN, PG8_SP2>(lds, g, S, E);
                PH_END_K(12);
            }
            ++ph;
        } else {
            if (EN(14) && PH_ON()) for (int rep_ = 0; rep_ < NREP(14); ++rep_) { asm volatile("; PHASE_MARK 14"); LOCAL_IDS(); moe_norm_router_phase(lds, HB, in[I_FNORM] + D, in[I_ROUTER], rsrow, toke, tokw, wgcnt, G); PH_END_K(14); }
            ++ph;
            if (EN(15) && PH_ON()) for (int rep_ = 0; rep_ < NREP(15); ++rep_) { asm volatile("; PHASE_MARK 15"); LOCAL_IDS(); moe_slot_phase(lds, toke, wgcnt, tokp, tilee, meta, HB, rsrow, in[I_FNORM] + D, XG8, G); PH_END_K(15); }
            ++ph;
#pragma unroll 1
            for (int ci = 0; ci < MOE_NCHUNK; ++ci) {
                if (EN(17) && PH_ON()) for (int rep_ = 0; rep_ < NREP(17); ++rep_) { asm volatile("; PHASE_MARK 17"); LOCAL_IDS();
                    const int ntiles = meta[0], tile0 = ci * MOE_CH_TILES, nt = ci < MOE_NCHUNK - 1 ? MOE_CH_TILES : ntiles - (MOE_NCHUNK - 1) * MOE_CH_TILES;
                    int k8 = D / 2; asm volatile("" : "+s"(k8));
                    pg8::Gemm g{(const bf16*)(XG8 + (size_t)tile0 * 256 * D), (const bf16*)MGU8, nt * 256, 2 * FFE, k8};
                    MoeOrder S; S.init(nt * 256, 2 * FFE, G, (int)blockIdx.x); S.tilee = tilee; S.tile0 = tile0; S.bstride = (size_t)2 * FFE * D;
                    pg8::EpiSwiglu<false, true, true> E{MACT, FFE, nullptr};
                    pg8::gemm_phase<pg8::EpiSwiglu<false, true, true>, MoeOrder, PG8_ALIGN, PG8_SP2>(lds, g, S, E);
                    PH_END_K(17);
                }
                ++ph;
                if (EN(18) && PH_ON()) for (int rep_ = 0; rep_ < NREP(18); ++rep_) { asm volatile("; PHASE_MARK 18"); LOCAL_IDS();
                    const int ntiles = meta[0], tile0 = ci * MOE_CH_TILES, nt = ci < MOE_NCHUNK - 1 ? MOE_CH_TILES : ntiles - (MOE_NCHUNK - 1) * MOE_CH_TILES;
                    int k8 = FFE / 2; asm volatile("" : "+s"(k8));
                    pg8::Gemm g{MACT, MDN, nt * 256, D, k8};
                    MoeOrder S; S.init(nt * 256, D, G, (int)blockIdx.x); S.tilee = tilee; S.tile0 = tile0; S.bstride = (size_t)D * FFE;
                    pg8::EpiBf16T<true> E{YB + (size_t)tile0 * 256 * D, D, nullptr, 1.0f / 128.0f};
                    pg8::gemm_phase<pg8::EpiBf16T<true>, MoeOrder, PG8_ALIGN, PG8_SP2>(lds, g, S, E);
                    PH_END_K(18);
                }
                ++ph;
            }
            if (EN(19) && PH_ON()) for (int rep_ = 0; rep_ < NREP(19); ++rep_) { asm volatile("; PHASE_MARK 19"); LOCAL_IDS(); moe_combine_final_phase(HB, args.out, YB, tokp, tokw, in[I_FINAL], gw, NGW, lane); PH_END_K(19); }
            ++ph;
        }
    }
#ifdef DIAG
    if (blockIdx.x == DIAG_WG && tid0 == 0 && hi == N_PHASES_C) { const unsigned long long v = ((unsigned long long*)(ws + WS_CTL + 512 * 1024))[DIAG_SEL] * DIAG_MULT / DIAG_DIV; const unsigned long long t0 = wall_clock64(); while (wall_clock64() - t0 < v) __builtin_amdgcn_s_sleep(8); }
#endif
#undef PH_ON
}
constexpr int N_PHASES = 2 + 7 + 2 + 7 + 2 + 2 * MOE_NCHUNK + 1;

#ifndef MK_PER_PHASE
#define MK_PER_PHASE 0
#endif
extern "C" void kernel_launch(void* const* d_in, const int* in_sizes, int n_in, void* d_out, int out_size, void* d_ws, size_t ws_size, hipStream_t stream) {
    static int grid = 0;
    if (grid == 0) {
        if (n_in != 33 || in_sizes[0] != M * D || out_size != M * D || ws_size < WS_END) {
            fprintf(stderr, "kernel_launch: unexpected problem: n_in %d in0 %d out %d ws %zu (need %zu); nothing launched\n", n_in, n_in > 0 ? in_sizes[0] : -1, out_size, ws_size, (size_t)WS_END); grid = -1; return; }
        int dev = 0, cus = 0, per_cu = 0;
        if (hipGetDevice(&dev) != hipSuccess || hipDeviceGetAttribute(&cus, hipDeviceAttributeMultiprocessorCount, dev) != hipSuccess) { fprintf(stderr, "kernel_launch: device query failed\n"); grid = -1; return; }
        if (hipFuncSetAttribute((const void*)fwd_kernel, hipFuncAttributeMaxDynamicSharedMemorySize, LDS_BYTES) != hipSuccess) { fprintf(stderr, "kernel_launch: hipFuncSetAttribute failed\n"); grid = -1; return; }
        if (hipOccupancyMaxActiveBlocksPerMultiprocessor(&per_cu, (const void*)fwd_kernel, NTHR, LDS_BYTES) != hipSuccess || per_cu < 1) { fprintf(stderr, "kernel_launch: occupancy query reports %d\n", per_cu); }
        (void)hipGetLastError();
        grid = cus;
        if (grid > 256) grid = 256;
        while (grid > 1 && (M % grid != 0 || M / grid > 256)) --grid;
        if (grid != 256) fprintf(stderr, "kernel_launch: note: grid %d\n", grid);
    }
    if (grid < 0) return;
    if (hipMemsetAsync((char*)d_ws + WS_CTL, 0, CTL_ZERO_BYTES, stream) != hipSuccess) { fprintf(stderr, "kernel_launch: memset failed\n"); return; }
    Args a{};
    for (int i = 0; i < 33; ++i) a.in[i] = (const float*)d_in[i];
    a.out = (float*)d_out; a.ws = (unsigned char*)d_ws;
#if MK_PER_PHASE
    for (int p = 0; p < N_PHASES; ++p) { a.ph_lo = p; a.ph_hi = p + 1; a.use_bar = 0; a.pad = 0; hipLaunchKernelGGL(fwd_kernel, dim3(grid), dim3(NTHR), LDS_BYTES, stream, a); }
#else
    a.ph_lo = 0; a.ph_hi = N_PHASES; a.use_bar = 1; a.pad = 0;
    hipLaunchKernelGGL(fwd_kernel, dim3(grid), dim3(NTHR), LDS_BYTES, stream, a);
#endif
    const hipError_t le = hipPeekAtLastError();
    if (le != hipSuccess) fprintf(stderr, "kernel_launch: launch failed: %s\n", hipGetErrorName(le));
}
```

```cpp
#include <hip/hip_runtime.h>
#include <cstdio>
#include <cstdint>
#ifndef HD
#define HD __host__ __device__ __forceinline__
#endif
__device__ __forceinline__ int opq_tid() { int t = (int)threadIdx.x; asm volatile("" : "+v"(t)); return t; }
typedef float f32x2_cv __attribute__((ext_vector_type(2))); typedef __bf16 bf16x2_cv __attribute__((ext_vector_type(2)));
__device__ __forceinline__ unsigned cvtpk_hw(float lo, float hi) { f32x2_cv v = {lo, hi}; bf16x2_cv b = __builtin_convertvector(v, bf16x2_cv); return __builtin_bit_cast(unsigned, b); }

struct cf { float x, y; };
HD cf mk(float a, float b) { cf r; r.x = a; r.y = b; return r; }
HD cf cadd(cf a, cf b) { return mk(a.x + b.x, a.y + b.y); }
HD cf csub(cf a, cf b) { return mk(a.x - b.x, a.y - b.y); }
HD cf cmul(cf a, cf b) { return mk(a.x * b.x - a.y * b.y, a.x * b.y + a.y * b.x); }
HD cf cmulc(cf a, cf b) { return mk(a.x * b.x + a.y * b.y, a.y * b.x - a.x * b.y); }
template <bool INV> HD cf cmulw(cf a, cf w) { return INV ? cmulc(a, w) : cmul(a, w); }
HD cf cscale(cf a, float s) { return mk(a.x * s, a.y * s); }

template <bool INV> HD void dft4(cf& a0, cf& a1, cf& a2, cf& a3) {
    const cf t0 = cadd(a0, a2), t1 = csub(a0, a2), t2 = cadd(a1, a3), t3 = csub(a1, a3);
    a0 = cadd(t0, t2); a2 = csub(t0, t2);
    const cf mit3 = mk(t3.y, -t3.x);
    if (!INV) { a1 = cadd(t1, mit3); a3 = csub(t1, mit3); }
    else      { a1 = csub(t1, mit3); a3 = cadd(t1, mit3); }
}
template <bool INV> HD void dft16(cf (&x)[16]) {
#pragma unroll
    for (int n1 = 0; n1 < 4; ++n1) dft4<INV>(x[n1], x[n1 + 4], x[n1 + 8], x[n1 + 12]);
    const float c1 = 0.92387953251128674f, s1 = 0.38268343236508977f, r2 = 0.70710678118654752f;
    const cf W1 = mk(c1, -s1), W2 = mk(r2, -r2), W3 = mk(s1, -c1), W6 = mk(-r2, -r2), W9 = mk(-c1, s1);
    x[1 + 4 * 1] = cmulw<INV>(x[1 + 4 * 1], W1);
    x[1 + 4 * 2] = cmulw<INV>(x[1 + 4 * 2], W2);
    x[1 + 4 * 3] = cmulw<INV>(x[1 + 4 * 3], W3);
    x[2 + 4 * 1] = cmulw<INV>(x[2 + 4 * 1], W2);
    { const cf t = x[2 + 4 * 2]; x[2 + 4 * 2] = INV ? mk(-t.y, t.x) : mk(t.y, -t.x); }
    x[2 + 4 * 3] = cmulw<INV>(x[2 + 4 * 3], W6);
    x[3 + 4 * 1] = cmulw<INV>(x[3 + 4 * 1], W3);
    x[3 + 4 * 2] = cmulw<INV>(x[3 + 4 * 2], W6);
    x[3 + 4 * 3] = cmulw<INV>(x[3 + 4 * 3], W9);
#pragma unroll
    for (int k2 = 0; k2 < 4; ++k2) dft4<INV>(x[0 + 4 * k2], x[1 + 4 * k2], x[2 + 4 * k2], x[3 + 4 * k2]);
    cf t;
    t = x[1]; x[1] = x[4]; x[4] = t;   t = x[2]; x[2] = x[8]; x[8] = t;   t = x[3]; x[3] = x[12]; x[12] = t;
    t = x[6]; x[6] = x[9]; x[9] = t;   t = x[7]; x[7] = x[13]; x[13] = t; t = x[11]; x[11] = x[14]; x[14] = t;
}
template <bool INV> HD void twiddle16(cf (&x)[16], cf w1) {
    cf w = w1;
#pragma unroll
    for (int k = 1; k < 16; ++k) { x[k] = cmulw<INV>(x[k], w); if (k < 15) w = cmul(w, w1); }
}
constexpr int FFT_HALF = 4352;
constexpr int FFT_WORK = 2 * FFT_HALF;
HD int fphys(int h, int idx) { return h * FFT_HALF + idx + (idx >> 4); }

HD void geo1(int tid, int& h, int& j) { const int w = tid >> 6, l = tid & 63; h = l >> 5; j = 32 * w + (l & 31); }
HD void geo2(int tid, int& h, int& k1, int& j2) { h = tid >> 8; k1 = (tid >> 4) & 15; j2 = tid & 15; }
HD void geo3(int tid, int& h, int& blk) { h = tid >> 8; blk = tid & 255; }

HD int fbase1(int h, int j) { return h * FFT_HALF + j + (j >> 4); }
HD int fbase2(int h, int k1, int j2) { return h * FFT_HALF + 272 * k1 + j2; }
HD int fbase3(int h, int blk) { return h * FFT_HALF + 17 * blk; }
template <class L> HD void fwd_pass1(L lds, int b1, cf w4096j, cf (&x)[16]) {
    dft16<false>(x); twiddle16<false>(x, w4096j);
#pragma unroll
    for (int k = 0; k < 16; ++k) lds.st(b1 + 272 * k, x[k]);
}
template <class L> HD void fwd_pass2(L lds, int b2, cf w256j) {
    cf x[16];
#pragma unroll
    for (int m = 0; m < 16; ++m) x[m] = lds.ld(b2 + 17 * m);
    dft16<false>(x); twiddle16<false>(x, w256j);
#pragma unroll
    for (int k = 0; k < 16; ++k) lds.st(b2 + 17 * k, x[k]);
}
template <class L> HD void fwd_pass3_keep(L lds, int b3, cf (&x)[16]) {
#pragma unroll
    for (int m = 0; m < 16; ++m) x[m] = lds.ld(b3 + m);
    dft16<false>(x);
}
template <class L> HD void mid_pass3(L lds, int b3, const cf (&K)[16]) {
    cf x[16];
#pragma unroll
    for (int m = 0; m < 16; ++m) x[m] = lds.ld(b3 + m);
    dft16<false>(x);
#pragma unroll
    for (int k = 0; k < 16; ++k) x[k] = cmul(x[k], K[k]);
    dft16<true>(x);
#pragma unroll
    for (int m = 0; m < 16; ++m) lds.st(b3 + m, x[m]);
}
template <class L> HD void inv_pass2(L lds, int b2, cf w256j) {
    cf x[16];
#pragma unroll
    for (int k = 0; k < 16; ++k) x[k] = lds.ld(b2 + 17 * k);
    twiddle16<true>(x, w256j); dft16<true>(x);
#pragma unroll
    for (int m = 0; m < 16; ++m) lds.st(b2 + 17 * m, x[m]);
}
template <class L> HD void inv_pass1(L lds, int b1, cf w4096j, cf (&x)[16]) {
#pragma unroll
    for (int k = 0; k < 16; ++k) x[k] = lds.ld(b1 + 272 * k);
    twiddle16<true>(x, w4096j); dft16<true>(x);
}
#ifndef PG8_WGM
#define PG8_WGM 8
#endif
namespace pg8 {
#define PG8_LAS __attribute__((address_space(3)))
typedef unsigned short bf16_t;
typedef short bf16x8 __attribute__((ext_vector_type(8)));
typedef float f32x4 __attribute__((ext_vector_type(4)));
typedef unsigned u32x4 __attribute__((ext_vector_type(4)));
constexpr int BM = 256, BK = 64, HALF = 128, HTB = HALF * BK * 2  , STAGE_BYTES = 8 * HTB, NXCD = 8, WGM = PG8_WGM;

__host__ __device__ __forceinline__ int lds_byte(int r, int c) { const int st = (r >> 4) * 2 + (c >> 5), rr = r & 15, cc = c & 31, ob = rr * 64 + cc * 2; return st * 1024 + (ob ^ (((ob >> 9) & 1) << 5)); }
__host__ __device__ __forceinline__ void stage_rc(int b, int& R, int& C) { const int st = b / 1024, sb = b % 1024, swz = sb ^ (((sb >> 9) & 1) << 5); R = (st >> 1) * 16 + swz / 64; C = (st & 1) * 32 + (swz % 64) / 2; }
__host__ __device__ __forceinline__ int perm32(int rho) { const int n = rho >> 4, i = rho & 15; return 8 * (i >> 2) + 4 * n + (i & 3); }

typedef int v8i_t __attribute__((ext_vector_type(8))); typedef int v4i_t __attribute__((ext_vector_type(4)));
__device__ __forceinline__ v8i_t cat8(bf16x8 a, bf16x8 b) { const v4i_t x = __builtin_bit_cast(v4i_t, a), y = __builtin_bit_cast(v4i_t, b); return __builtin_shufflevector(x, y, 0, 1, 2, 3, 4, 5, 6, 7); }
struct Unit { int pm, pn; };
struct Gemm { const bf16_t* A; const bf16_t* Bt; int M, N, K; };

struct StaticOrder {
    int nM, nN, nwg, G, c;
    __host__ __device__ void init(int M, int N, int G_, int c_) { nM = M / BM; nN = N / BM; nwg = nM * nN; G = G_; c = c_; }
    __host__ __device__ bool next(int i, Unit& u) const {
        const long L = (long)i * G + c; if (L >= nwg) return false;
        int wgid = (int)L; { const int q = nwg / NXCD, r = nwg % NXCD, xcd = wgid % NXCD, off = wgid / NXCD; wgid = (xcd < r ? xcd * (q + 1) : r * (q + 1) + (xcd - r) * q) + off; }
        const int nig = WGM * nN, gid = wgid / nig, fm = gid * WGM, gsz = (nM - fm) < WGM ? (nM - fm) : WGM;
        u.pm = fm + ((wgid % nig) % gsz); u.pn = (wgid % nig) / gsz; return true;
    }
    __device__ __forceinline__ size_t boff(const Unit&) const { return 0; }
    __device__ __forceinline__ void a_ready(const Unit&) const {}
    __device__ __forceinline__ void done(const Unit&) const {}
};

__device__ __forceinline__ unsigned cvt_pk_bf16(float lo, float hi) { unsigned r; asm volatile("v_cvt_pk_bf16_f32 %0, %1, %2" : "=v"(r) : "v"(lo), "v"(hi)); return r; }
typedef float f32x2 __attribute__((ext_vector_type(2)));
typedef unsigned u32x2 __attribute__((ext_vector_type(2)));
__device__ __forceinline__ float row_rs(const float* ssp, int row, int fq) {
    if (!ssp) return 1.0f;
    const f32x4 q = *(const f32x4*)(ssp + (size_t)row * 16 + 4 * fq); float s = (q[0] + q[1]) + (q[2] + q[3]);
    s += __shfl_xor(s, 16); s += __shfl_xor(s, 32);
    return __builtin_amdgcn_rsqf(s * (1.0f / 1024.0f) + 1e-6f);
}
__device__ __forceinline__ void row_rs8(const float* ssp, int row0, int fq, float (&rs)[2][4]) {
    if (!ssp) {
#pragma unroll
        for (int ai = 0; ai < 2; ++ai)
#pragma unroll
            for (int m = 0; m < 4; ++m) rs[ai][m] = 1.0f;
        return; }
    f32x4 q[2][4];
#pragma unroll
    for (int ai = 0; ai < 2; ++ai)
#pragma unroll
        for (int m = 0; m < 4; ++m) q[ai][m] = *(const f32x4*)(ssp + (size_t)(row0 + ai * HALF + m * 16) * 16 + 4 * fq);
#pragma unroll
    for (int ai = 0; ai < 2; ++ai)
#pragma unroll
        for (int m = 0; m < 4; ++m) { float s = (q[ai][m][0] + q[ai][m][1]) + (q[ai][m][2] + q[ai][m][3]); s += __shfl_xor(s, 16); s += __shfl_xor(s, 32); rs[ai][m] = __builtin_amdgcn_rsqf(s * (1.0f / 1024.0f) + 1e-6f); }
}
__device__ __forceinline__ f32x4 row_rs4_swap(const float* ssp, int rowbase, int fr, int fq) {
    if (!ssp) return (f32x4){1.f, 1.f, 1.f, 1.f};
    const f32x4 q = *(const f32x4*)(ssp + (size_t)(rowbase + 4 * fq + (fr >> 2)) * 16 + 4 * (fr & 3)); float s = (q[0] + q[1]) + (q[2] + q[3]);
    s += __shfl_xor(s, 1); s += __shfl_xor(s, 2);
    const float rs = __builtin_amdgcn_rsqf(s * (1.0f / 1024.0f) + 1e-6f);
    f32x4 o;
#pragma unroll
    for (int r = 0; r < 4; ++r) o[r] = __shfl(rs, 16 * fq + 4 * r);
    return o;
}
template <bool F8 = false> struct EpiBf16T {
    static constexpr bool PERM = true, AFTER_DRAIN = false, SWAP = false, FP8 = F8;
    bf16_t* O; int ldc; const float* ss; float descale;
    __device__ __forceinline__ void operator()(const f32x4 (&acc)[2][2][4][2], const Unit& u, int wr, int wc, int fr, int fq) const {
        const int row0 = u.pm * BM + wr * 64 + fr, col0 = u.pn * BM + wc * 32 + 8 * fq;
        float rsa[2][4]; row_rs8(ss, row0, fq, rsa);
#pragma unroll
        for (int ai = 0; ai < 2; ++ai)
#pragma unroll
            for (int m = 0; m < 4; ++m) { bf16_t* rowp = O + (size_t)(row0 + ai * HALF + m * 16) * ldc + col0; const float rs = F8 ? rsa[ai][m] * descale : rsa[ai][m];
#pragma unroll
                for (int bj = 0; bj < 2; ++bj) { const f32x4 v0 = acc[ai][bj][m][0] * rs, v1 = acc[ai][bj][m][1] * rs;
                    u32x4 w; w.x = cvt_pk_bf16(v0[0], v0[1]); w.y = cvt_pk_bf16(v0[2], v0[3]); w.z = cvt_pk_bf16(v1[0], v1[1]); w.w = cvt_pk_bf16(v1[2], v1[3]);
                    *(u32x4*)(rowp + bj * HALF) = w; } }
    }
};
typedef EpiBf16T<false> EpiBf16;
struct EpiQKV {
    static constexpr bool PERM = true, AFTER_DRAIN = false, SWAP = false, FP8 = false;
    bf16_t* Q; bf16_t* Kb; bf16_t* Vb; const float* cosT; const float* sinT; const float* ss;
    __device__ __forceinline__ void operator()(const f32x4 (&acc)[2][2][4][2], const Unit& u, int wr, int wc, int fr, int fq) const {
        const int row0 = u.pm * BM + wr * 64 + fr;
        float rsa[2][4]; row_rs8(ss, row0, fq, rsa);
#pragma unroll
        for (int bj = 0; bj < 2; ++bj) {
            const int slot0 = u.pn * BM + bj * HALF + wc * 32 + 8 * fq;
            if (slot0 < 640) {
                const int head = slot0 >> 6, j4 = ((slot0 & 63) >> 3) * 4;
#pragma unroll
                for (int am = 0; am < 4; ++am) {
                    f32x4 c[2], sn[2];
                    const int tofs = ((row0 & 4095) + (am >> 1) * HALF + 2 * (am & 1) * 16) * 32 + j4;
                    const __attribute__((address_space(1))) float* cb = (const __attribute__((address_space(1))) float*)(cosT + tofs); const __attribute__((address_space(1))) float* sb = (const __attribute__((address_space(1))) float*)(sinT + tofs); asm volatile("" : "+v"(cb), "+v"(sb));
#pragma unroll
                    for (int h = 0; h < 2; ++h) { c[h] = *(const __attribute__((address_space(1))) f32x4*)(cb + h * 512); sn[h] = *(const __attribute__((address_space(1))) f32x4*)(sb + h * 512); }
#pragma unroll
                    for (int h = 0; h < 2; ++h) { const int ai = am >> 1, m = 2 * (am & 1) + h; const int row = row0 + ai * HALF + m * 16;
                        const float rs = rsa[ai][m]; const f32x4 lo = acc[ai][bj][m][0] * rs, hi = acc[ai][bj][m][1] * rs;
                        const f32x4 olo = lo * c[h] - hi * sn[h], ohi = hi * c[h] + lo * sn[h];
                        bf16_t* dst = head < 8 ? Q + (size_t)row * 512 + head * 64 + j4 : Kb + (size_t)row * 128 + (head - 8) * 64 + j4;
                        u32x2 w0, w1; w0.x = cvt_pk_bf16(olo[0], olo[1]); w0.y = cvt_pk_bf16(olo[2], olo[3]); w1.x = cvt_pk_bf16(ohi[0], ohi[1]); w1.y = cvt_pk_bf16(ohi[2], ohi[3]);
                        *(u32x2*)dst = w0; *(u32x2*)(dst + 32) = w1; } }
            } else {
#pragma unroll
                for (int ai = 0; ai < 2; ++ai)
#pragma unroll
                    for (int m = 0; m < 4; ++m) { const int row = row0 + ai * HALF + m * 16; const float rs = rsa[ai][m]; const f32x4 v0 = acc[ai][bj][m][0] * rs, v1 = acc[ai][bj][m][1] * rs;
                        u32x4 w; w.x = cvt_pk_bf16(v0[0], v0[1]); w.y = cvt_pk_bf16(v0[2], v0[3]); w.z = cvt_pk_bf16(v1[0], v1[1]); w.w = cvt_pk_bf16(v1[2], v1[3]);
                        *(u32x4*)(Vb + (size_t)row * 128 + (slot0 - 640)) = w; }
            }
        }
    }
};
struct EpiT {
    static constexpr bool PERM = false, AFTER_DRAIN = false, SWAP = true, FP8 = false;
    bf16_t* O; int nch; int ts_shift; const float* ss;
    __device__ __forceinline__ void operator()(const f32x4 (&acc)[2][2][4][2], const Unit& u, int wr, int wc, int fr, int fq) const {
        const int rowt = u.pm * BM, b = rowt >> ts_shift, tb = (rowt & ((1 << ts_shift) - 1)) + wr * 64 + 4 * fq;
#pragma unroll
        for (int ai = 0; ai < 2; ++ai) {
            f32x4 rsv[4];
#pragma unroll
            for (int m = 0; m < 4; ++m) rsv[m] = row_rs4_swap(ss, rowt + wr * 64 + ai * HALF + m * 16, fr, fq);
#pragma unroll
            for (int bj = 0; bj < 2; ++bj)
#pragma unroll
                for (int n = 0; n < 2; ++n) { const int ch = u.pn * BM + bj * HALF + wc * 32 + 16 * n + fr; bf16_t* chp = O + (((size_t)(b * nch + ch)) << ts_shift) + tb + ai * HALF;
#pragma unroll
                    for (int m = 0; m < 4; ++m) { const f32x4 v = acc[ai][bj][m][n] * rsv[m]; u32x2 w; w.x = cvt_pk_bf16(v[0], v[1]); w.y = cvt_pk_bf16(v[2], v[3]);
                        *(u32x2*)(chp + m * 16) = w; } } }
    }
};
struct EpiResB {
    static constexpr bool PERM = true, AFTER_DRAIN = false, SWAP = false, FP8 = false;
    bf16_t* xb; int ldc; float* ss; bf16_t* dst;
    __device__ __forceinline__ void operator()(const f32x4 (&acc)[2][2][4][2], const Unit& u, int wr, int wc, int fr, int fq) const {
        const int row0 = u.pm * BM + wr * 64 + fr, col0 = u.pn * BM + wc * 32 + 8 * fq;
#pragma unroll
        for (int ai = 0; ai < 2; ++ai) {
            u32x4 b[4][2];
#pragma unroll
            for (int m = 0; m < 4; ++m)
#pragma unroll
                for (int bj = 0; bj < 2; ++bj) b[m][bj] = *(const u32x4*)(xb + (size_t)(row0 + ai * HALF + m * 16) * ldc + col0 + bj * HALF);
#pragma unroll
            for (int m = 0; m < 4; ++m) { const int row = row0 + ai * HALF + m * 16; bf16_t* dstp = dst + (size_t)row * ldc + col0; float sq = 0.f;
#pragma unroll
                for (int bj = 0; bj < 2; ++bj) { const f32x4 a0 = acc[ai][bj][m][0], a1 = acc[ai][bj][m][1]; const u32x4 bb = b[m][bj]; float o[8];
                    o[0] = __builtin_bit_cast(float, bb.x << 16) + a0[0]; o[1] = __builtin_bit_cast(float, bb.x & 0xffff0000u) + a0[1];
                    o[2] = __builtin_bit_cast(float, bb.y << 16) + a0[2]; o[3] = __builtin_bit_cast(float, bb.y & 0xffff0000u) + a0[3];
                    o[4] = __builtin_bit_cast(float, bb.z << 16) + a1[0]; o[5] = __builtin_bit_cast(float, bb.z & 0xffff0000u) + a1[1];
                    o[6] = __builtin_bit_cast(float, bb.w << 16) + a1[2]; o[7] = __builtin_bit_cast(float, bb.w & 0xffff0000u) + a1[3];
#pragma unroll
                    for (int i = 0; i < 8; ++i) sq += o[i] * o[i];
                    u32x4 w; w.x = cvt_pk_bf16(o[0], o[1]); w.y = cvt_pk_bf16(o[2], o[3]); w.z = cvt_pk_bf16(o[4], o[5]); w.w = cvt_pk_bf16(o[6], o[7]);
                    *(u32x4*)(dstp + bj * HALF) = w; }
                if (ss) { sq += __shfl_xor(sq, 16); sq += __shfl_xor(sq, 32); if (fq == 0) ss[(size_t)row * 16 + u.pn * 4 + wc] = sq; } } }
    }
};
typedef float f32x2e __attribute__((ext_vector_type(2)));
__device__ __forceinline__ f32x2e silu_mul_pk(f32x2e g, f32x2e up) {
    const f32x2e t = g * (-1.44269504088896f); f32x2e e; e.x = __builtin_amdgcn_exp2f(t.x); e.y = __builtin_amdgcn_exp2f(t.y);
    const f32x2e d = e + 1.0f; f32x2e r; r.x = __builtin_amdgcn_rcpf(d.x); r.y = __builtin_amdgcn_rcpf(d.y);
    return (g * r) * up;
}
template <bool SCALE, bool F8 = false, bool F8OUT = false> struct EpiSwiglu {
    static constexpr bool PERM = true, AFTER_DRAIN = false, SWAP = false, FP8 = F8;
    bf16_t* O; int ldc; const float* ss;
    __device__ __forceinline__ void operator()(const f32x4 (&acc)[2][2][4][2], const Unit& u, int wr, int wc, int fr, int fq) const {
        const int row0 = u.pm * BM + wr * 64 + fr, col0 = u.pn * 128 + wc * 32 + 8 * fq;
        float rsa[2][4]; if (SCALE) row_rs8(ss, row0, fq, rsa);
#pragma unroll
        for (int ai = 0; ai < 2; ++ai)
#pragma unroll
            for (int m = 0; m < 4; ++m) { const int row = row0 + ai * HALF + m * 16; float sc = F8 ? 0.03125f : 1.0f; if (SCALE) sc *= rsa[ai][m];
                f32x2e o[4];
#pragma unroll
                for (int n = 0; n < 2; ++n) { f32x4 g = acc[ai][0][m][n], up = acc[ai][1][m][n]; if (SCALE || F8) { g = g * sc; up = up * sc; }
                    o[2 * n] = silu_mul_pk((f32x2e){g[0], g[1]}, (f32x2e){up[0], up[1]}); o[2 * n + 1] = silu_mul_pk((f32x2e){g[2], g[3]}, (f32x2e){up[2], up[3]}); }
                if (F8OUT) { int w0 = 0, w1 = 0; w0 = __builtin_amdgcn_cvt_pk_fp8_f32(o[0].x * 4.0f, o[0].y * 4.0f, w0, false); w0 = __builtin_amdgcn_cvt_pk_fp8_f32(o[1].x * 4.0f, o[1].y * 4.0f, w0, true);
                    w1 = __builtin_amdgcn_cvt_pk_fp8_f32(o[2].x * 4.0f, o[2].y * 4.0f, w1, false); w1 = __builtin_amdgcn_cvt_pk_fp8_f32(o[3].x * 4.0f, o[3].y * 4.0f, w1, true);
                    u32x2 w8; w8.x = (unsigned)w0; w8.y = (unsigned)w1; *(u32x2*)((unsigned char*)O + (size_t)row * ldc + col0) = w8; }
                else { u32x4 w; w.x = cvt_pk_bf16(o[0].x, o[0].y); w.y = cvt_pk_bf16(o[1].x, o[1].y); w.z = cvt_pk_bf16(o[2].x, o[2].y); w.w = cvt_pk_bf16(o[3].x, o[3].y);
                    *(u32x4*)(O + (size_t)row * ldc + col0) = w; } }
    }
};
template <class Epi, class Sched, bool ALIGN_EPI = false, bool SP2 = false>
__device__ __forceinline__ void gemm_phase(PG8_LAS unsigned char* lds, const Gemm g, const Sched& S, const Epi& E) {
    const int tid = opq_tid(), wid = __builtin_amdgcn_readfirstlane(tid >> 6), lane = tid & 63, wr = wid >> 2, wc = wid & 3, fr = lane & 15, fq = lane >> 4;
    const int K = g.K, nt = K / BK;
    unsigned voffA[2], voffB[2];
#pragma unroll
    for (int i = 0; i < 2; ++i) { int R, C; stage_rc(tid * 16 + i * 8192, R, C); const int Rb = Epi::PERM ? ((R & ~31) + perm32(R & 31)) : R;
        voffA[i] = (unsigned)(R * K + C) * 2u; voffB[i] = (unsigned)(Rb * K + C) * 2u; }
    const size_t kstep = (size_t)(BK * 2);
    const size_t hstep = (size_t)HALF * K * 2;
    const size_t tstep = 2 * hstep;
    const unsigned ldsw = (unsigned)wid * 1024u;
    const int aoff = lds_byte(wr * 64 + fr, fq * 8), boff = lds_byte(wc * 32 + fr, fq * 8);
#define PG8_SA(b, h) (((b) * 2 + (h)) * HTB)
#define PG8_SB(b, h) ((4 + (b) * 2 + (h)) * HTB)
#define PG8_STAGE(bufoff, gbase, voff) do { _Pragma("unroll") for (int _i = 0; _i < 2; ++_i) \
        __builtin_amdgcn_global_load_lds((const unsigned*)((const char*)(gbase) + (voff)[_i]), (PG8_LAS unsigned*)(lds + (bufoff) + ldsw + _i * 8192), 16, 0, 0); } while (0)
#define PG8_LDA(dst, b, h) do { if constexpr (Epi::FP8) { _Pragma("unroll") for (int m = 0; m < 4; ++m) dst##8[m] = cat8(*(const PG8_LAS bf16x8*)(lds + PG8_SA(b, h) + aoff + m * 2048), *(const PG8_LAS bf16x8*)(lds + PG8_SA(b, h) + aoff + m * 2048 + 1024)); } else { \
        _Pragma("unroll") for (int m = 0; m < 4; ++m) _Pragma("unroll") for (int k = 0; k < 2; ++k) dst[m][k] = *(const PG8_LAS bf16x8*)(lds + PG8_SA(b, h) + aoff + m * 2048 + k * 1024); } } while (0)
#define PG8_LDB(dst, b, h) do { if constexpr (Epi::FP8) { _Pragma("unroll") for (int n = 0; n < 2; ++n) dst##8[n] = cat8(*(const PG8_LAS bf16x8*)(lds + PG8_SB(b, h) + boff + n * 2048), *(const PG8_LAS bf16x8*)(lds + PG8_SB(b, h) + boff + n * 2048 + 1024)); } else { \
        _Pragma("unroll") for (int n = 0; n < 2; ++n) _Pragma("unroll") for (int k = 0; k < 2; ++k) dst[n][k] = *(const PG8_LAS bf16x8*)(lds + PG8_SB(b, h) + boff + n * 2048 + k * 1024); } } while (0)
#define PG8_MMA(ai, bj, At, Bt) do { __builtin_amdgcn_s_setprio(1); if constexpr (Epi::FP8) { _Pragma("unroll") for (int m = 0; m < 4; ++m) _Pragma("unroll") for (int n = 0; n < 2; ++n) \
        asm volatile("v_mfma_scale_f32_16x16x128_f8f6f4 %0, %1, %2, %0, %3, %3 op_sel_hi:[0,0,0]" : "+v"(acc[ai][bj][m][n]) : "v"(Bt##8[n]), "v"(At##8[m]), "v"(f8one)); } else { \
        _Pragma("unroll") for (int m = 0; m < 4; ++m) _Pragma("unroll") for (int n = 0; n < 2; ++n) _Pragma("unroll") for (int k = 0; k < 2; ++k) \
        acc[ai][bj][m][n] = Epi::SWAP ? __builtin_amdgcn_mfma_f32_16x16x32_bf16(At[m][k], Bt[n][k], acc[ai][bj][m][n], 0, 0, 0) : __builtin_amdgcn_mfma_f32_16x16x32_bf16(Bt[n][k], At[m][k], acc[ai][bj][m][n], 0, 0, 0); } __builtin_amdgcn_s_setprio(0); } while (0)
#define PG8_WAIT_V(n) asm volatile("s_waitcnt vmcnt(" #n ")" ::: "memory")
#define PG8_WAIT_L(n) asm volatile("s_waitcnt lgkmcnt(" #n ")" ::: "memory")
#define PG8_BAR __builtin_amdgcn_s_barrier()
#define PG8_SCHED __builtin_amdgcn_sched_barrier(0)
#ifdef DIAG
    unsigned long long dg_k = 0, dg_e = 0, dg_t1 = 0, dg_t2 = 0; const unsigned long long dg_t0 = wall_clock64();
#endif
    Unit cur, nxt; int ui = 0;
    if (!S.next(0, cur)) return;
    f32x4 acc[2][2][4][2];
#pragma unroll
    for (int a = 0; a < 2; ++a)
#pragma unroll
        for (int b = 0; b < 2; ++b)
#pragma unroll
            for (int m = 0; m < 4; ++m)
#pragma unroll
                for (int n = 0; n < 2; ++n) acc[a][b][m][n] = (f32x4){0.f, 0.f, 0.f, 0.f};
    bf16x8 At[4][2], B0[2][2], B1[2][2]; v8i_t At8[4], B08[2], B18[2];
    int f8one = 0x7F7F7F7F; asm volatile("" : "+v"(f8one));
    const char* cA = (const char*)g.A + (size_t)cur.pm * tstep; const char* cB = (const char*)g.Bt + S.boff(cur) + (size_t)cur.pn * tstep;
    S.a_ready(cur);
    if constexpr (SP2) {
        PG8_STAGE(PG8_SB(0, 0), cB, voffB); PG8_STAGE(PG8_SB(0, 1), cB + hstep, voffB); PG8_STAGE(PG8_SA(0, 0), cA, voffA); PG8_STAGE(PG8_SA(0, 1), cA + hstep, voffA);
        if (wr == 1) PG8_BAR;
        PG8_WAIT_V(2); PG8_BAR;
        PG8_STAGE(PG8_SB(1, 0), cB + kstep, voffB); PG8_STAGE(PG8_SA(1, 0), cA + kstep, voffA); PG8_STAGE(PG8_SB(1, 1), cB + hstep + kstep, voffB);
        PG8_WAIT_V(6); PG8_BAR;
    } else {
        PG8_STAGE(PG8_SB(0, 0), cB, voffB); PG8_STAGE(PG8_SA(0, 0), cA, voffA); PG8_STAGE(PG8_SB(0, 1), cB + hstep, voffB); PG8_STAGE(PG8_SA(0, 1), cA + hstep, voffA);
        if (wr == 1) PG8_BAR;
        PG8_WAIT_V(4); PG8_BAR;
        PG8_STAGE(PG8_SB(1, 0), cB + kstep, voffB); PG8_STAGE(PG8_SA(1, 0), cA + kstep, voffA); PG8_STAGE(PG8_SB(1, 1), cB + hstep + kstep, voffB);
        PG8_WAIT_V(6); PG8_BAR;
    }
    for (;;) {
        const bool has_next = S.next(ui + 1, nxt);
        const char* nA = has_next ? (const char*)g.A + (size_t)nxt.pm * tstep : cA; const char* nB = has_next ? (const char*)g.Bt + S.boff(nxt) + (size_t)nxt.pn * tstep : cB;
#ifdef DIAG
        dg_t1 = wall_clock64();
#endif
        for (int t = 0; t < nt; t += 2) {
            const bool last = (t == nt - 2);
            const char* a1 = cA + (size_t)(t + 1) * kstep;
            const char* a2 = last ? nA : cA + (size_t)(t + 2) * kstep; const char* b2 = last ? nB : cB + (size_t)(t + 2) * kstep;
            const char* a3 = a2 + kstep; const char* b3 = b2 + kstep;
            if (last && has_next) S.a_ready(nxt);
            if constexpr (SP2) {
            PG8_LDB(B0, 0, 0); PG8_LDB(B1, 0, 1); PG8_SCHED; PG8_LDA(At, 0, 0); PG8_STAGE(PG8_SA(1, 1), a1 + hstep, voffA);
            PG8_WAIT_V(8); PG8_WAIT_L(0); PG8_BAR; PG8_MMA(0, 0, At, B0); PG8_MMA(0, 1, At, B1); PG8_BAR; PG8_SCHED;
            PG8_LDA(At, 0, 1); PG8_STAGE(PG8_SB(0, 0), b2, voffB); PG8_STAGE(PG8_SB(0, 1), b2 + hstep, voffB); PG8_STAGE(PG8_SA(0, 0), a2, voffA);
            PG8_WAIT_V(8); PG8_WAIT_L(0); PG8_BAR; PG8_MMA(1, 0, At, B0); PG8_MMA(1, 1, At, B1); PG8_BAR; PG8_SCHED;
            PG8_LDB(B0, 1, 0); PG8_LDB(B1, 1, 1); PG8_SCHED; PG8_LDA(At, 1, 0); PG8_STAGE(PG8_SA(0, 1), a2 + hstep, voffA);
            PG8_WAIT_V(8); PG8_WAIT_L(0); PG8_BAR; PG8_MMA(0, 0, At, B0); PG8_MMA(0, 1, At, B1); PG8_BAR; PG8_SCHED;
            PG8_LDA(At, 1, 1); PG8_STAGE(PG8_SB(1, 0), b3, voffB); PG8_STAGE(PG8_SB(1, 1), b3 + hstep, voffB); PG8_STAGE(PG8_SA(1, 0), a3, voffA);
            PG8_WAIT_V(8); PG8_WAIT_L(0); PG8_BAR; PG8_MMA(1, 0, At, B0); PG8_MMA(1, 1, At, B1); PG8_BAR; PG8_SCHED;
            } else {
            PG8_LDB(B0, 0, 0); PG8_SCHED; PG8_LDA(At, 0, 0); PG8_STAGE(PG8_SA(1, 1), a1 + hstep, voffA);
            PG8_WAIT_L(8); PG8_BAR; PG8_WAIT_L(0); PG8_MMA(0, 0, At, B0); PG8_BAR; PG8_SCHED;
            PG8_LDB(B1, 0, 1); PG8_STAGE(PG8_SB(0, 0), b2, voffB);
            PG8_BAR; PG8_WAIT_L(0); PG8_MMA(0, 1, At, B1); PG8_BAR;
            PG8_LDA(At, 0, 1); PG8_STAGE(PG8_SA(0, 0), a2, voffA);
            PG8_BAR; PG8_WAIT_L(0); PG8_MMA(1, 0, At, B0); PG8_BAR; PG8_SCHED;
            PG8_STAGE(PG8_SB(0, 1), b2 + hstep, voffB);
            PG8_WAIT_V(6); PG8_BAR; PG8_MMA(1, 1, At, B1); PG8_BAR;
            PG8_LDB(B0, 1, 0); PG8_SCHED; PG8_LDA(At, 1, 0); PG8_STAGE(PG8_SA(0, 1), a2 + hstep, voffA);
            PG8_WAIT_L(8); PG8_BAR; PG8_WAIT_L(0); PG8_MMA(0, 0, At, B0); PG8_BAR; PG8_SCHED;
            PG8_LDB(B1, 1, 1); PG8_STAGE(PG8_SB(1, 0), b3, voffB);
            PG8_BAR; PG8_WAIT_L(0); PG8_MMA(0, 1, At, B1); PG8_BAR;
            PG8_LDA(At, 1, 1); PG8_STAGE(PG8_SA(1, 0), a3, voffA);
            PG8_BAR; PG8_WAIT_L(0); PG8_MMA(1, 0, At, B0); PG8_BAR; PG8_SCHED;
            PG8_STAGE(PG8_SB(1, 1), b3 + hstep, voffB);
            PG8_WAIT_V(6); PG8_BAR; PG8_MMA(1, 1, At, B1); PG8_BAR;
            }
        }
#ifdef DIAG
        dg_t2 = wall_clock64(); dg_k += dg_t2 - dg_t1;
#endif
        if constexpr (Epi::FP8) asm volatile("s_nop 15\n\ts_nop 15" ::: "memory");
        if constexpr (ALIGN_EPI) { if (wr == 0) PG8_BAR; }
#ifndef EPI_REP
#define EPI_REP 1
#endif
        if constexpr (!Epi::AFTER_DRAIN) { _Pragma("unroll 1") for (int er_ = 0; er_ < EPI_REP; ++er_) E(acc, cur, wr, wc, fr, fq); S.done(cur); }
#ifdef DIAG
        dg_e += wall_clock64() - dg_t2;
#endif
        if (!has_next) break;
#pragma unroll
        for (int a = 0; a < 2; ++a)
#pragma unroll
            for (int b = 0; b < 2; ++b)
#pragma unroll
                for (int m = 0; m < 4; ++m)
#pragma unroll
                    for (int n = 0; n < 2; ++n) acc[a][b][m][n] = (f32x4){0.f, 0.f, 0.f, 0.f};
        cur = nxt; cA = nA; cB = nB; ++ui;
        if constexpr (ALIGN_EPI) { if (wr == 1) PG8_BAR; }
    }
#ifdef DIAG
    if (blockIdx.x == 0 && tid == 0) { unsigned long long* dg = (unsigned long long*)(*(const PG8_LAS unsigned long long*)(lds + 139328)); atomicAdd(dg + 0, dg_k); atomicAdd(dg + 1, dg_e); atomicAdd(dg + 2, wall_clock64() - dg_t0); atomicAdd(dg + 3, (unsigned long long)(ui + 1)); }
#endif
    PG8_WAIT_V(0);
    if constexpr (!ALIGN_EPI) { if (wr == 0) PG8_BAR; }
    PG8_BAR;
    if constexpr (Epi::AFTER_DRAIN) { E.fused(acc, cur, wr, wc, fr, fq, lds, wid, lane); S.done(cur); }
#undef PG8_SA
#undef PG8_SB
#undef PG8_STAGE
#undef PG8_LDA
#undef PG8_LDB
#undef PG8_MMA
#undef PG8_WAIT_V
#undef PG8_WAIT_L
#undef PG8_BAR
#undef PG8_SCHED
}
}
#ifndef PG8_SP2
#define PG8_SP2 true
#endif
#ifndef PG8_ALIGN
#define PG8_ALIGN true
#endif
constexpr int NB = 16, SEQ = 4096, D = 1024, M = NB * SEQ;
constexpr int NH = 8, NKV = 2, HDIM = 64, AW = 512, KVW = 128;
constexpr int HYW = 512, C3 = 1536, INC = 2304;
constexpr int XH = 4, XHD = 128, XW = 512, MEML = 256, MROWS = NB * MEML;
constexpr int FF = 2816, NE = 8, FFE = 3584;
constexpr float EPS = 1e-6f;
constexpr int NWAVES = 8, NTHR = 512;
constexpr int MOE_CH_TILES = 128, MOE_NCHUNK = 4, MOE_MAX_TILES = 520, MOE_MAX_ROWS = MOE_MAX_TILES * 256, MOE_ACT_TILES = MOE_MAX_TILES - (MOE_NCHUNK - 1) * MOE_CH_TILES;

constexpr size_t al256(size_t x) { return (x + 255) & ~(size_t)255; }
constexpr size_t WS_CTL = 0, CTL_ZERO_BYTES = 1u << 20;
constexpr size_t WS_SS = CTL_ZERO_BYTES, SS_STRIDE = (size_t)M * 16;
constexpr size_t WS_COS = WS_SS + 5 * SS_STRIDE * 4, WS_SIN = WS_COS + (size_t)SEQ * 32 * 4, WS_H2 = WS_SIN + (size_t)SEQ * 32 * 4;
constexpr size_t WS_TOKE = WS_H2 + (size_t)2 * SEQ * 64 * 4, WS_TOKW = WS_TOKE + (size_t)M * 2 * 4, WS_TOKP = WS_TOKW + (size_t)M * 2 * 4;
constexpr size_t WS_ROWTOK = WS_TOKP + (size_t)M * 2 * 4, WS_TILEE = WS_ROWTOK + al256((size_t)MOE_MAX_ROWS * 4), WS_WGCNT = WS_TILEE + 4096, WS_RSROW = WS_WGCNT + (size_t)1024 * 8 * 4, WS_META = WS_RSROW + (size_t)M * 4;
constexpr size_t WS_WINA = al256(WS_META + 4096);
constexpr size_t WS_WINB = WS_WINA + (size_t)2 * 768 * D * 2;
constexpr size_t WS_WOUT = WS_WINB + (size_t)2 * C3 * D * 2;
constexpr size_t WS_XQ = WS_WOUT + (size_t)2 * D * D * 2;
constexpr size_t WS_XK = WS_XQ + (size_t)2 * XW * D * 2;
constexpr size_t WS_XV = WS_XK + (size_t)2 * XW * D * 2;
constexpr size_t WS_XO = WS_XV + (size_t)2 * XW * D * 2;
constexpr size_t WS_FGU = WS_XO + (size_t)2 * D * XW * 2;
constexpr size_t WS_FDN = WS_FGU + (size_t)2 * FF * D * 2;
constexpr size_t WS_MGU = WS_FDN + (size_t)D * FF * 2;
constexpr size_t WS_MDN = WS_MGU + (size_t)NE * 2 * FFE * D;
constexpr size_t WS_KFILT = WS_MDN + (size_t)NE * D * FFE;
constexpr size_t WS_MB = WS_KFILT + (size_t)2 * 2 * HYW * 8192 * 4;
constexpr size_t WS_KMEM = WS_MB + (size_t)MROWS * D * 2;
constexpr size_t WS_VMEMT = WS_KMEM + (size_t)MROWS * 1024 * 2;
constexpr size_t WS_HB = WS_VMEMT + (size_t)1024 * MROWS * 2;
constexpr size_t WS_R = WS_HB + (size_t)M * D * 2;
constexpr size_t WS_QB = WS_R, WS_KB = WS_QB + (size_t)M * AW * 2, WS_VB = WS_KB + (size_t)M * KVW * 2, WS_UT = WS_VB + (size_t)M * KVW * 2;
constexpr size_t WS_MIXED = WS_UT;
constexpr size_t WS_AB = WS_UT + (size_t)M * C3 * 2, WS_YT = WS_AB + (size_t)M * AW * 2, WS_KSPEC = WS_YT + (size_t)M * HYW * 2, WS_MIXEND = WS_KSPEC + (size_t)2 * 2 * HYW * 16384 * 4;
constexpr size_t WS_XQB = WS_R, WS_XOB = WS_XQB + (size_t)M * XW * 2;
constexpr size_t WS_ACT = WS_R;
constexpr size_t WS_XG = WS_R;
constexpr size_t WS_MACT = WS_XG + (size_t)MOE_MAX_ROWS * D;
constexpr size_t WS_YB = WS_MACT + (size_t)MOE_ACT_TILES * 256 * FFE;
constexpr size_t WS_MOEEND = WS_YB + (size_t)MOE_MAX_ROWS * D * 2;
constexpr size_t cmax(size_t a, size_t b) { return a > b ? a : b; }
constexpr size_t WS_END = cmax(cmax(WS_MIXEND, WS_ACT + (size_t)M * FF * 2), WS_MOEEND);
static_assert(WS_END <= (size_t)1073741824, "workspace map exceeds 1 GiB");
static_assert(WS_ACT + (size_t)M * FF * 2 <= WS_KSPEC && WS_XOB + (size_t)M * XW * 2 <= WS_KSPEC, "layer 0's later phases must not touch the filter spectra");
constexpr int CW_TMO = 0, CW_CODE = 1, CW_BAR = 4096;

constexpr int PHASE_LDS = 155648;
constexpr int LDSCTL_OFF = PHASE_LDS, MISC_OFF = LDSCTL_OFF + 64;
constexpr int LDS_BYTES = PHASE_LDS + 512;

#define GAS __attribute__((address_space(1)))
#define LAS __attribute__((address_space(3)))
typedef unsigned short bf16;
typedef unsigned v4u __attribute__((ext_vector_type(4)));
typedef unsigned v2u __attribute__((ext_vector_type(2)));
typedef float f32x4 __attribute__((ext_vector_type(4)));
typedef short bf16x8 __attribute__((ext_vector_type(8)));
typedef short s16x4 __attribute__((ext_vector_type(4)));
typedef GAS unsigned gu32;
#define RLX_AGENT __ATOMIC_RELAXED, __HIP_MEMORY_SCOPE_AGENT
#define LDS_WAIT() asm volatile("s_waitcnt lgkmcnt(0)" ::: "memory")
#define VM_WAIT() asm volatile("s_waitcnt vmcnt(0)" ::: "memory")
__device__ __forceinline__ unsigned f2bf(float f) { unsigned u = __builtin_bit_cast(unsigned, f); return (u + 0x7fffu + ((u >> 16) & 1u)) >> 16; }
__device__ __forceinline__ unsigned pk2(float lo, float hi) { return cvtpk_hw(lo, hi); }
__device__ __forceinline__ float bflo(unsigned w) { return __builtin_bit_cast(float, w << 16); }
__device__ __forceinline__ float bfhi(unsigned w) { return __builtin_bit_cast(float, w & 0xffff0000u); }
__device__ __forceinline__ float bf1(unsigned short h) { return __builtin_bit_cast(float, ((unsigned)h) << 16); }
#define XB_TMO      128
#define XB_XCNT(j)  (256  + 64 * (j))
#define XB_XSUB(j)  (1280 + 64 * (j))
#define XB_XGEN(j)  (2304 + 64 * (j))
#define XB_TOP      3328
#define XB_TOPGEN   3392
#define XCD_BAR_WORDS 3456
#define XB_SPIN_CAP (1u << 22)

__device__ __forceinline__ unsigned xb_ld(unsigned* p)              { return __hip_atomic_load(p, __ATOMIC_RELAXED, __HIP_MEMORY_SCOPE_AGENT); }
__device__ __forceinline__ unsigned xb_add(unsigned* p, unsigned v) { return __hip_atomic_fetch_add(p, v, __ATOMIC_RELAXED, __HIP_MEMORY_SCOPE_AGENT); }
__device__ __forceinline__ unsigned xb_xcc_id() { return (unsigned)__builtin_amdgcn_s_getreg((3 << 11) | 20) & 0xFu; }
#define XB_SPIN(cond, bar) do { unsigned _sp = 0; while (cond) { __builtin_amdgcn_s_sleep(1); \
    if ((++_sp & 255u) == 0u) { if (xb_ld(&(bar)[XB_TMO])) break; if (_sp > XB_SPIN_CAP) { atomicAdd(&(bar)[XB_TMO], 1u); break; } } } } while (0)

struct XcdBarrier {
    unsigned* bar; unsigned x;
    volatile LAS unsigned* st;
};

__device__ __forceinline__ XcdBarrier xcd_barrier_post(unsigned* bar, volatile LAS unsigned* st) {
    XcdBarrier b; b.bar = bar; b.x = xb_xcc_id(); b.st = st;
    if (threadIdx.x == 0) (void)xb_add(&bar[XB_XCNT(b.x)], 1u);
    return b;
}
__device__ __forceinline__ void xcd_barrier_complete(unsigned* bar, unsigned x, unsigned& nloc, unsigned& nx) {
    const unsigned G = gridDim.x * gridDim.y * gridDim.z;
    unsigned sum, cnt, mine, sp = 0u;
    for (;;) {
        sum = 0u; cnt = 0u; mine = 0u;
#pragma unroll
        for (unsigned j = 0; j < 16; ++j) { const unsigned c = xb_ld(&bar[XB_XCNT(j)]); sum += c; cnt += (c > 0u) ? 1u : 0u; mine = (j == x) ? c : mine; }
        if (sum == G) break;
        __builtin_amdgcn_s_sleep(1);
        if ((++sp & 255u) == 0u) { if (xb_ld(&bar[XB_TMO])) break; if (sp > XB_SPIN_CAP) { atomicAdd(&bar[XB_TMO], 1u); break; } }
    }
    nloc = mine > 0u ? mine : 1u; nx = cnt > 0u ? cnt : 1u;
}

__device__ __forceinline__ void xcd_barrier(const XcdBarrier& b) {
    asm volatile("s_waitcnt vmcnt(0)" ::: "memory");
    __syncthreads();
    if (threadIdx.x == 0) {
        unsigned* bar = b.bar;
        __builtin_amdgcn_s_waitcnt(0);
        unsigned nloc = b.st[0], nx = b.st[1];
        if (nloc == 0u) { xcd_barrier_complete(bar, b.x, nloc, nx); b.st[0] = nloc; b.st[1] = nx; }
        const unsigned old = xb_add(&bar[XB_XSUB(b.x)], 1u);
        const unsigned gen = old / nloc;
        if (old + 1u == (gen + 1u) * nloc) {
            __builtin_amdgcn_fence(__ATOMIC_RELEASE, "agent");
            asm volatile("s_waitcnt vmcnt(0)" ::: "memory");
            const unsigned og = xb_add(&bar[XB_TOP], 1u);
            const unsigned tg = og / nx;
            if (og + 1u == (tg + 1u) * nx) xb_add(&bar[XB_TOPGEN], 1u);
            else XB_SPIN(xb_ld(&bar[XB_TOPGEN]) == tg, bar);
            __builtin_amdgcn_fence(__ATOMIC_ACQUIRE, "agent");
            xb_add(&bar[XB_XGEN(b.x)], 1u);
            asm volatile("s_waitcnt vmcnt(0)" ::: "memory");
        } else {
            XB_SPIN(xb_ld(&bar[XB_XGEN(b.x)]) == gen, bar);
            __builtin_amdgcn_fence(__ATOMIC_ACQUIRE, "agent");
            asm volatile("s_waitcnt vmcnt(0)" ::: "memory");
        }
    }
    __syncthreads();
}
struct Args { const float* in[33]; float* out; unsigned char* ws; int ph_lo, ph_hi, use_bar, pad; };
enum InIdx { I_X = 0, I_MEM, I_MEMNORM, I_MIXNORM, I_WIN, I_SINK, I_CONVW, I_CONVB, I_FW1, I_FB1, I_FFR1, I_FW2, I_FB2, I_FFR2, I_FW3, I_SKIP, I_ANORM, I_YNORM, I_WOUT, I_XNORM,
             I_XWQ, I_XWK, I_XWV, I_XWO, I_FNORM, I_FGATE, I_FUP, I_FDOWN, I_ROUTER, I_MGATE, I_MUP, I_MDOWN, I_FINAL };

__device__ __forceinline__ float wave_sum(float v) {
#pragma unroll
    for (int o = 1; o < 64; o <<= 1) v += __shfl_xor(v, o);
    return v;
}
__device__ __forceinline__ void wg_sync() { __builtin_amdgcn_sched_barrier(0); asm volatile("s_waitcnt vmcnt(0) lgkmcnt(0)" ::: "memory"); __builtin_amdgcn_s_barrier(); asm volatile("" ::: "memory"); __builtin_amdgcn_sched_barrier(0); }

template <int MODE> __device__ __forceinline__ int rowmap(int n) {
    if (MODE == 1) return n < 640 ? ((n & ~63) + 8 * ((n & 31) >> 2) + (n & 3) + 4 * ((n >> 5) & 1)) : n;
    if (MODE == 2) return ((n >> 7) << 8) + (n & 127);
    if (MODE == 3) return ((n >> 7) << 8) + 128 + (n & 127);
    return n;
}
__device__ __forceinline__ int rowmap_rt(int mode, int n) { return mode == 1 ? rowmap<1>(n) : mode == 2 ? rowmap<2>(n) : mode == 3 ? rowmap<3>(n) : n; }
__device__ __forceinline__ void tr_item(const float* W, int ldw, int K, int col0, int ncols, bf16* WT, int mode, const float* gk, int item, LAS float* scr, int lane) {
    const int nblk = ncols / 32, kb = item / nblk, nb = item % nblk, k0 = 64 * kb, n0 = 32 * nb;
    f32x4 tv[8];
#pragma unroll
    for (int i = 0; i < 8; ++i) { const int kk = 8 * i + (lane >> 3); tv[i] = *(const f32x4*)(W + (size_t)(k0 + kk) * ldw + col0 + n0 + 4 * (lane & 7)); }
#pragma unroll
    for (int i = 0; i < 8; ++i) { const int kk = 8 * i + (lane >> 3); const float gv = gk ? gk[k0 + kk] : 1.0f; LAS float* d = scr + kk * 33 + 4 * (lane & 7);
        d[0] = gv * tv[i][0]; d[1] = gv * tv[i][1]; d[2] = gv * tv[i][2]; d[3] = gv * tv[i][3]; }
    LDS_WAIT(); asm volatile("" ::: "memory");
    const int c = lane & 7;
#pragma unroll
    for (int j = 0; j < 4; ++j) { const int n = (lane >> 3) + 8 * j; const LAS float* sp = scr + (8 * c) * 33 + n;
        v4u o; o.x = pk2(sp[0 * 33], sp[1 * 33]); o.y = pk2(sp[2 * 33], sp[3 * 33]); o.z = pk2(sp[4 * 33], sp[5 * 33]); o.w = pk2(sp[6 * 33], sp[7 * 33]);
        *(v4u*)(WT + (size_t)rowmap_rt(mode, n0 + n) * K + k0 + 8 * c) = o; }
    LDS_WAIT(); asm volatile("" ::: "memory");
}
__device__ __forceinline__ void tr_item8(const float* W, int ldw, int K, int ncols, unsigned char* WT8, int mode, float wscale, int item, LAS float* scr, int lane) {
    const int nblk = ncols / 32, kb = item / nblk, nb = item % nblk, k0 = 64 * kb, n0 = 32 * nb;
    f32x4 tv[8];
#pragma unroll
    for (int i = 0; i < 8; ++i) { const int kk = 8 * i + (lane >> 3); tv[i] = *(const f32x4*)(W + (size_t)(k0 + kk) * ldw + n0 + 4 * (lane & 7)); }
#pragma unroll
    for (int i = 0; i < 8; ++i) { const int kk = 8 * i + (lane >> 3); LAS float* d = scr + kk * 33 + 4 * (lane & 7);
        d[0] = wscale * tv[i][0]; d[1] = wscale * tv[i][1]; d[2] = wscale * tv[i][2]; d[3] = wscale * tv[i][3]; }
    LDS_WAIT(); asm volatile("" ::: "memory");
    const int n = lane >> 1, half = lane & 1; const LAS float* sp = scr + (32 * half) * 33 + n;
    v4u o[2];
#pragma unroll
    for (int q = 0; q < 8; ++q) { int w = 0;
        w = __builtin_amdgcn_cvt_pk_fp8_f32(sp[(4 * q + 0) * 33], sp[(4 * q + 1) * 33], w, false);
        w = __builtin_amdgcn_cvt_pk_fp8_f32(sp[(4 * q + 2) * 33], sp[(4 * q + 3) * 33], w, true);
        o[q >> 2][q & 3] = (unsigned)w; }
    v4u* dst = (v4u*)(WT8 + (size_t)rowmap_rt(mode, n0 + n) * K + k0 + 32 * half);
    dst[0] = o[0]; dst[1] = o[1];
    LDS_WAIT(); asm volatile("" ::: "memory");
}
__device__ __forceinline__ void rms_row(const float* xrow, const float* gain, int lane, f32x4 (&v)[4]) {
    const f32x4* xr = (const f32x4*)xrow + lane; float s = 0.f;
#pragma unroll
    for (int j = 0; j < 4; ++j) { v[j] = xr[64 * j]; s += (v[j].x * v[j].x + v[j].y * v[j].y) + (v[j].z * v[j].z + v[j].w * v[j].w); }
    const float rs = 1.0f / sqrtf(wave_sum(s) * (1.f / 1024.f) + EPS);
    const f32x4* gr = (const f32x4*)gain + lane;
#pragma unroll
    for (int j = 0; j < 4; ++j) v[j] = v[j] * rs * gr[64 * j];
}
__device__ __forceinline__ void store_row_bf16(bf16* orow, int lane, const f32x4 (&v)[4]) {
    unsigned long long* o8 = (unsigned long long*)orow + lane;
#pragma unroll
    for (int j = 0; j < 4; ++j) o8[64 * j] = (unsigned long long)pk2(v[j].x, v[j].y) | ((unsigned long long)pk2(v[j].z, v[j].w) << 32);
}
__device__ __forceinline__ void xb_rows(const float* x, bf16* o, float* ss, int nrows, int gw, int NGW, int lane) {
#pragma unroll 1
    for (int r0 = gw; r0 < nrows; r0 += 2 * NGW) {
        const int r1 = r0 + NGW; const bool on1 = r1 < nrows; const int r1c = on1 ? r1 : r0;
        const f32x4* xa = (const f32x4*)(x + (size_t)r0 * D) + lane; const f32x4* xc = (const f32x4*)(x + (size_t)r1c * D) + lane; f32x4 va[4], vc[4];
#pragma unroll
        for (int j = 0; j < 4; ++j) { va[j] = xa[64 * j]; vc[j] = xc[64 * j]; }
        float sa = 0.f, sc = 0.f;
#pragma unroll
        for (int j = 0; j < 4; ++j) { sa += (va[j].x * va[j].x + va[j].y * va[j].y) + (va[j].z * va[j].z + va[j].w * va[j].w); sc += (vc[j].x * vc[j].x + vc[j].y * vc[j].y) + (vc[j].z * vc[j].z + vc[j].w * vc[j].w); }
        sa = wave_sum(sa); sc = wave_sum(sc);
        store_row_bf16(o + (size_t)r0 * D, lane, va); if (lane < 16) ss[(size_t)r0 * 16 + lane] = lane == 0 ? sa : 0.f;
        if (on1) { store_row_bf16(o + (size_t)r1 * D, lane, vc); if (lane < 16) ss[(size_t)r1 * 16 + lane] = lane == 0 ? sc : 0.f; }
    }
}
__device__ __forceinline__ void norm_rows(const float* x, const float* gain, bf16* o, int nrows, int gw, int NGW, int lane) {
    for (int r = gw; r < nrows; r += NGW) { f32x4 v[4]; rms_row(x + (size_t)r * D, gain, lane, v); store_row_bf16(o + (size_t)r * D, lane, v); }
}

constexpr int BA_KS = 72, BA_VS = 408, BA_KROWS = 400;
constexpr int BA_K_BYTES = BA_KROWS * BA_KS * 2, BA_V_BYTES = 64 * BA_VS * 2;
static_assert(BA_K_BYTES % 16 == 0 && BA_K_BYTES + BA_V_BYTES <= PHASE_LDS, "band attention LDS");
__device__ __forceinline__ bf16x8 cat4(s16x4 a, s16x4 b) { return __builtin_shufflevector(a, b, 0, 1, 2, 3, 4, 5, 6, 7); }
__device__ __forceinline__ unsigned cvtpk(float lo, float hi) { unsigned r; asm volatile("v_cvt_pk_bf16_f32 %0, %1, %2" : "=v"(r) : "v"(lo), "v"(hi)); return r; }

__device__ __forceinline__ void band_attention_phase(LAS unsigned char* lds, const bf16* Q, const bf16* Kb, const bf16* Vb, bf16* Ao, const float* sink, int G) {
    const int tid = opq_tid(), lane = tid & 63, wave = __builtin_amdgcn_readfirstlane(tid >> 6), fr = lane & 15, fq = lane >> 4;
    LAS bf16* Ks = (LAS bf16*)lds; LAS bf16* VTs = (LAS bf16*)(lds + BA_K_BYTES);
    for (int unit = blockIdx.x; unit < NB * 32 * NKV; unit += G) {
        const int kh = unit & 1, ib = (unit >> 1) & 31, b = unit >> 6;
        const int kbase = 128 * (ib - 1);
        for (int c = tid; c < BA_KROWS * 8; c += NTHR) { const int row = c >> 3, c8 = c & 7, kpos = kbase + row;
            v4u val = (v4u){0u, 0u, 0u, 0u};
            if (row < 384 && kpos >= 0 && kpos < SEQ) val = *(const v4u*)(Kb + ((size_t)(b * SEQ + kpos)) * KVW + kh * 64 + c8 * 8);
            *(LAS v4u*)(Ks + row * BA_KS + c8 * 8) = val; }
        for (int c = tid; c < BA_KROWS * 8; c += NTHR) { const int c8 = c / BA_KROWS, key = c % BA_KROWS, kpos = kbase + key;
            v4u val = (v4u){0u, 0u, 0u, 0u};
            if (key < 384 && kpos >= 0 && kpos < SEQ) val = *(const v4u*)(Vb + ((size_t)(b * SEQ + kpos)) * KVW + kh * 64 + c8 * 8);
            LAS bf16* dst = VTs + (c8 * 8) * BA_VS + key;
            dst[0 * BA_VS] = (bf16)(val.x & 0xffffu); dst[1 * BA_VS] = (bf16)(val.x >> 16); dst[2 * BA_VS] = (bf16)(val.y & 0xffffu); dst[3 * BA_VS] = (bf16)(val.y >> 16);
            dst[4 * BA_VS] = (bf16)(val.z & 0xffffu); dst[5 * BA_VS] = (bf16)(val.z >> 16); dst[6 * BA_VS] = (bf16)(val.w & 0xffffu); dst[7 * BA_VS] = (bf16)(val.w >> 16); }
        wg_sync();
        const int g = wave >> 1, half = wave & 1, head = kh * 4 + g;
        const float snk = sink[head];
        bf16x8 qn[2];
        { const size_t t0 = (size_t)b * SEQ + 128 * ib + 64 * half;
#pragma unroll
          for (int ks = 0; ks < 2; ++ks) qn[ks] = *(const bf16x8*)(Q + (t0 + fr) * AW + head * 64 + 32 * ks + 8 * fq); }
#pragma unroll 1
        for (int qt = 0; qt < 4; ++qt) {
            const int p0 = 64 * half + 16 * qt;
            const size_t t0 = (size_t)b * SEQ + 128 * ib + p0;
            bf16x8 qf[2]; qf[0] = qn[0]; qf[1] = qn[1];
            if (qt < 3) {
#pragma unroll
                for (int ks = 0; ks < 2; ++ks) qn[ks] = *(const bf16x8*)(Q + (t0 + 16 + fr) * AW + head * 64 + 32 * ks + 8 * fq); }
            f32x4 s[18];
            const LAS bf16* kbase_p = Ks + (p0 + fr) * BA_KS + 8 * fq;
            bf16x8 kfa[3][2], kfb[3][2];
#pragma unroll
            for (int jj = 0; jj < 3; ++jj)
#pragma unroll
                for (int ks = 0; ks < 2; ++ks) kfa[jj][ks] = *(const LAS bf16x8*)(kbase_p + (16 * jj) * BA_KS + 32 * ks);
#pragma unroll
            for (int gq = 0; gq < 6; ++gq) {
                if (gq < 5) {
#pragma unroll
                    for (int jj = 0; jj < 3; ++jj)
#pragma unroll
                        for (int ks = 0; ks < 2; ++ks) { const bf16x8 t = *(const LAS bf16x8*)(kbase_p + (16 * (3 * (gq + 1) + jj)) * BA_KS + 32 * ks); if (gq & 1) kfa[jj][ks] = t; else kfb[jj][ks] = t; } }
                __builtin_amdgcn_sched_barrier(0);
#pragma unroll
                for (int jj = 0; jj < 3; ++jj) { const int j = 3 * gq + jj; s[j] = (f32x4){0.f, 0.f, 0.f, 0.f};
#pragma unroll
                    for (int ks = 0; ks < 2; ++ks) s[j] = __builtin_amdgcn_mfma_f32_16x16x32_bf16((gq & 1) ? kfb[jj][ks] : kfa[jj][ks], qf[ks], s[j], 0, 0, 0); }
                __builtin_amdgcn_sched_barrier(0);
            }
            float mx = -1e30f;
#pragma unroll
            for (int j = 0; j < 18; ++j)
#pragma unroll
                for (int r = 0; r < 4; ++r) { const int rel = 16 * j + 4 * fq + r - fr, idx = p0 + 16 * j + 4 * fq + r;
                    const bool ok = rel >= 0 && rel <= 256 && (ib > 0 || idx >= 128) && (ib < 31 || idx < 256);
                    const float v = ok ? s[j][r] * 0.125f : -1e30f; s[j][r] = v; mx = fmaxf(mx, v); }
            mx = fmaxf(mx, __shfl_xor(mx, 16)); mx = fmaxf(mx, __shfl_xor(mx, 32)); mx = fmaxf(mx, snk);
            float l = 0.f;
#pragma unroll
            for (int j = 0; j < 18; ++j)
#pragma unroll
                for (int r = 0; r < 4; ++r) { const float p = __expf(s[j][r] - mx); s[j][r] = p; l += p; }
            l += __shfl_xor(l, 16); l += __shfl_xor(l, 32); l += __expf(snk - mx);
            const float inv = 1.0f / l;
            f32x4 o[4];
#pragma unroll
            for (int dt = 0; dt < 4; ++dt) o[dt] = (f32x4){0.f, 0.f, 0.f, 0.f};
            const LAS bf16* vbase_p = VTs + fr * BA_VS + p0 + 4 * fq;
            s16x4 va[4][2], vb[4][2];
#pragma unroll
            for (int dt = 0; dt < 4; ++dt) { va[dt][0] = *(const LAS s16x4*)(vbase_p + (16 * dt) * BA_VS); va[dt][1] = *(const LAS s16x4*)(vbase_p + (16 * dt) * BA_VS + 16); }
#pragma unroll
            for (int kk = 0; kk < 9; ++kk) {
                if (kk < 8) {
#pragma unroll
                    for (int dt = 0; dt < 4; ++dt) { const s16x4 t0_ = *(const LAS s16x4*)(vbase_p + (16 * dt) * BA_VS + 32 * (kk + 1)), t1_ = *(const LAS s16x4*)(vbase_p + (16 * dt) * BA_VS + 32 * (kk + 1) + 16);
                        if (kk & 1) { va[dt][0] = t0_; va[dt][1] = t1_; } else { vb[dt][0] = t0_; vb[dt][1] = t1_; } } }
                v4u pw; pw.x = cvtpk(s[2 * kk][0], s[2 * kk][1]); pw.y = cvtpk(s[2 * kk][2], s[2 * kk][3]); pw.z = cvtpk(s[2 * kk + 1][0], s[2 * kk + 1][1]); pw.w = cvtpk(s[2 * kk + 1][2], s[2 * kk + 1][3]);
                const bf16x8 pf = __builtin_bit_cast(bf16x8, pw);
                __builtin_amdgcn_sched_barrier(0);
#pragma unroll
                for (int dt = 0; dt < 4; ++dt) { const bf16x8 vf = (kk & 1) ? cat4(vb[dt][0], vb[dt][1]) : cat4(va[dt][0], va[dt][1]);
                    o[dt] = __builtin_amdgcn_mfma_f32_16x16x32_bf16(vf, pf, o[dt], 0, 0, 0); }
                __builtin_amdgcn_sched_barrier(0);
            }
#pragma unroll
            for (int dt = 0; dt < 4; ++dt) { const f32x4 ov = o[dt] * inv; v2u w; w.x = cvtpk(ov[0], ov[1]); w.y = cvtpk(ov[2], ov[3]);
                *(v2u*)(Ao + (t0 + fr) * AW + head * 64 + 16 * dt + 4 * fq) = w; }
        }
        wg_sync();
    }
}

constexpr int XA_KS = 136, XA_VS = 264;
constexpr int XA_K_BYTES = MEML * XA_KS * 2, XA_V_BYTES = XHD * XA_VS * 2;
static_assert(XA_K_BYTES % 16 == 0 && XA_K_BYTES + XA_V_BYTES <= PHASE_LDS, "cross attention LDS");
__device__ __forceinline__ void cross_attention_phase(LAS unsigned char* lds, const bf16* Qx, const bf16* Kmem, const bf16* VmemT, bf16* Ox, int layer, int G) {
    const int tid = opq_tid(), lane = tid & 63, wave = __builtin_amdgcn_readfirstlane(tid >> 6), fr = lane & 15, fq = lane >> 4;
    LAS bf16* Ks = (LAS bf16*)lds; LAS bf16* VTs = (LAS bf16*)(lds + XA_K_BYTES);
    for (int unit = blockIdx.x; unit < 256; unit += G) {
        const int quarter = unit & 3, head = (unit >> 2) & 3, b = unit >> 4;
        for (int c = tid; c < MEML * 16; c += NTHR) { const int key = c >> 4, c8 = c & 15;
            *(LAS v4u*)(Ks + key * XA_KS + c8 * 8) = *(const v4u*)(Kmem + (size_t)(b * MEML + key) * 1024 + layer * 512 + head * 128 + c8 * 8); }
        for (int c = tid; c < XHD * 32; c += NTHR) { const int d = c >> 5, c8 = c & 31;
            *(LAS v4u*)(VTs + d * XA_VS + c8 * 8) = *(const v4u*)(VmemT + (size_t)(layer * 512 + head * 128 + d) * MROWS + b * MEML + c8 * 8); }
        wg_sync();
        bf16x8 qn[4];
        { const size_t t0 = (size_t)b * SEQ + (quarter * 4) * 256 + wave * 32;
#pragma unroll
          for (int ks = 0; ks < 4; ++ks) qn[ks] = *(const bf16x8*)(Qx + (t0 + fr) * XW + head * 128 + 32 * ks + 8 * fq); }
#pragma unroll 1
        for (int qi = 0; qi < 8; ++qi) {
            const size_t t0 = (size_t)b * SEQ + (quarter * 4 + (qi >> 1)) * 256 + wave * 32 + 16 * (qi & 1);
            bf16x8 qf[4];
#pragma unroll
            for (int ks = 0; ks < 4; ++ks) qf[ks] = qn[ks];
            if (qi < 7) { const size_t t1 = (size_t)b * SEQ + (quarter * 4 + ((qi + 1) >> 1)) * 256 + wave * 32 + 16 * ((qi + 1) & 1);
#pragma unroll
                for (int ks = 0; ks < 4; ++ks) qn[ks] = *(const bf16x8*)(Qx + (t1 + fr) * XW + head * 128 + 32 * ks + 8 * fq); }
            f32x4 s[16];
            const LAS bf16* kbase_p = Ks + fr * XA_KS + 8 * fq;
            bf16x8 kfa[2][4], kfb[2][4];
#pragma unroll
            for (int jj = 0; jj < 2; ++jj)
#pragma unroll
                for (int ks = 0; ks < 4; ++ks) kfa[jj][ks] = *(const LAS bf16x8*)(kbase_p + (16 * jj) * XA_KS + 32 * ks);
#pragma unroll
            for (int gq = 0; gq < 8; ++gq) {
                if (gq < 7) {
#pragma unroll
                    for (int jj = 0; jj < 2; ++jj)
#pragma unroll
                        for (int ks = 0; ks < 4; ++ks) { const bf16x8 t = *(const LAS bf16x8*)(kbase_p + (16 * (2 * (gq + 1) + jj)) * XA_KS + 32 * ks); if (gq & 1) kfa[jj][ks] = t; else kfb[jj][ks] = t; } }
                __builtin_amdgcn_sched_barrier(0);
#pragma unroll
                for (int jj = 0; jj < 2; ++jj) { const int j = 2 * gq + jj; s[j] = (f32x4){0.f, 0.f, 0.f, 0.f};
#pragma unroll
                    for (int ks = 0; ks < 4; ++ks) s[j] = __builtin_amdgcn_mfma_f32_16x16x32_bf16((gq & 1) ? kfb[jj][ks] : kfa[jj][ks], qf[ks], s[j], 0, 0, 0); }
                __builtin_amdgcn_sched_barrier(0);
            }
            float mx = -1e30f;
#pragma unroll
            for (int j = 0; j < 16; ++j)
#pragma unroll
                for (int r = 0; r < 4; ++r) { const float v = s[j][r] * 0.08838834764831845f; s[j][r] = v; mx = fmaxf(mx, v); }
            mx = fmaxf(mx, __shfl_xor(mx, 16)); mx = fmaxf(mx, __shfl_xor(mx, 32));
            float l = 0.f;
#pragma unroll
            for (int j = 0; j < 16; ++j)
#pragma unroll
                for (int r = 0; r < 4; ++r) { const float p = __expf(s[j][r] - mx); s[j][r] = p; l += p; }
            l += __shfl_xor(l, 16); l += __shfl_xor(l, 32);
            const float inv = 1.0f / l;
            f32x4 o[8];
#pragma unroll
            for (int dt = 0; dt < 8; ++dt) o[dt] = (f32x4){0.f, 0.f, 0.f, 0.f};
            const LAS bf16* vbase_p = VTs + fr * XA_VS + 4 * fq;
            s16x4 va[8][2], vb[8][2];
#pragma unroll
            for (int dt = 0; dt < 8; ++dt) { va[dt][0] = *(const LAS s16x4*)(vbase_p + (16 * dt) * XA_VS); va[dt][1] = *(const LAS s16x4*)(vbase_p + (16 * dt) * XA_VS + 16); }
#pragma unroll
            for (int kk = 0; kk < 8; ++kk) {
                if (kk < 7) {
#pragma unroll
                    for (int dt = 0; dt < 8; ++dt) { const s16x4 t0_ = *(const LAS s16x4*)(vbase_p + (16 * dt) * XA_VS + 32 * (kk + 1)), t1_ = *(const LAS s16x4*)(vbase_p + (16 * dt) * XA_VS + 32 * (kk + 1) + 16);
                        if (kk & 1) { va[dt][0] = t0_; va[dt][1] = t1_; } else { vb[dt][0] = t0_; vb[dt][1] = t1_; } } }
                v4u pw; pw.x = cvtpk(s[2 * kk][0], s[2 * kk][1]); pw.y = cvtpk(s[2 * kk][2], s[2 * kk][3]); pw.z = cvtpk(s[2 * kk + 1][0], s[2 * kk + 1][1]); pw.w = cvtpk(s[2 * kk + 1][2], s[2 * kk + 1][3]);
                const bf16x8 pf = __builtin_bit_cast(bf16x8, pw);
                __builtin_amdgcn_sched_barrier(0);
#pragma unroll
                for (int dt = 0; dt < 8; ++dt) { const bf16x8 vf = (kk & 1) ? cat4(vb[dt][0], vb[dt][1]) : cat4(va[dt][0], va[dt][1]);
                    o[dt] = __builtin_amdgcn_mfma_f32_16x16x32_bf16(vf, pf, o[dt], 0, 0, 0); }
                __builtin_amdgcn_sched_barrier(0);
            }
#pragma unroll
            for (int dt = 0; dt < 8; ++dt) { const f32x4 ov = o[dt] * inv; v2u w; w.x = cvtpk(ov[0], ov[1]); w.y = cvtpk(ov[2], ov[3]);
                *(v2u*)(Ox + (t0 + fr) * XW + head * 128 + 16 * dt + 4 * fq) = w; }
        }
        wg_sync();
    }
}
constexpr float HY_MIN_DECAY = -3.0701134573253944f;
constexpr float HY_MAX_DECAY = -15.350567286626972f;
__device__ __forceinline__ void h2_rows(const Args& a, float* H2, int gw, int NGW, int lane) {
    for (int idx = gw; idx < 2 * SEQ; idx += NGW) {
        const int l = idx >> 12, j = idx & 4095;
        const float* w1 = a.in[I_FW1] + l * 33 * 64; const float* b1 = a.in[I_FB1] + l * 64; const float* fr1 = a.in[I_FFR1] + l * 64;
        const float* w2 = a.in[I_FW2] + l * 64 * 64; const float* b2 = a.in[I_FB2] + l * 64; const float* fr2 = a.in[I_FFR2] + l * 64;
        const float w = 6.283185307179586f * (float)j / 4096.0f;
        const int mm = (lane - 1) & 15; const float f = 1e-4f + (float)mm * ((15.0f - 1e-4f) / 15.0f); const float ang = f * w;
        float zq = lane == 0 ? (float)j / 4095.0f : (lane <= 16 ? cosf(ang) : -sinf(ang));
        float acc = b1[lane];
#pragma unroll
        for (int q = 0; q < 33; ++q) acc += __shfl(zq, q) * w1[q * 64 + lane];
        const float h1 = sinf(fr1[lane] * acc);
        acc = b2[lane];
#pragma unroll
        for (int q = 0; q < 64; ++q) acc += __shfl(h1, q) * w2[q * 64 + lane];
        H2[(size_t)idx * 64 + lane] = sinf(fr2[lane] * acc);
    }
}
__device__ __forceinline__ void kfilt_phase(LAS unsigned char* lds, const float* H2, const float* w3all, float* KF, int G) {
    LAS float* ws = (LAS float*)lds;
    const int tid = opq_tid(), jj = tid & 63, cg = __builtin_amdgcn_readfirstlane(tid >> 6);
    for (int unit = blockIdx.x; unit < 2 * 64 * 32; unit += G) {
        const int cb = unit & 31, jb = (unit >> 5) & 63, l = unit >> 11;
        const float* w3 = w3all + (size_t)l * 64 * 2048;
        for (int e = tid; e < 4096; e += NTHR) ws[e] = w3[(size_t)(e >> 6) * 2048 + cb * 64 + (e & 63)];
        wg_sync();
        const int j = jb * 64 + jj;
        const f32x4* hr = (const f32x4*)(H2 + ((size_t)l * SEQ + j) * 64);
        float acc[8];
#pragma unroll
        for (int e = 0; e < 8; ++e) acc[e] = 0.f;
#pragma unroll
        for (int q = 0; q < 16; ++q) { const f32x4 hv = hr[q];
#pragma unroll
            for (int i = 0; i < 4; ++i) { const LAS f32x4* wp = (const LAS f32x4*)(ws + (4 * q + i) * 64 + cg * 8); const f32x4 wa = wp[0], wb = wp[1];
                acc[0] += hv[i] * wa[0]; acc[1] += hv[i] * wa[1]; acc[2] += hv[i] * wa[2]; acc[3] += hv[i] * wa[3];
                acc[4] += hv[i] * wb[0]; acc[5] += hv[i] * wb[1]; acc[6] += hv[i] * wb[2]; acc[7] += hv[i] * wb[3]; } }
        const float tj = (float)j / 4095.0f;
#pragma unroll
        for (int e = 0; e < 8; ++e) { const int col = cb * 64 + cg * 8 + e, dir = col >> 10, oc = col & 1023;
            const float delta = HY_MIN_DECAY + (float)oc * ((HY_MAX_DECAY - HY_MIN_DECAY) / 1023.0f);
            float val = acc[e] * expf(-tj * fabsf(delta));
            int n = dir == 0 ? j : 8192 - j;
            if (dir == 1 && j == 0) { n = 4096; val = 0.f; }
            KF[((size_t)(l * 1024 + oc)) * 8192 + n] = val; }
        wg_sync();
    }
}

constexpr int HY_RAWS = 4112;
constexpr int HY_ROWB = 2 * HY_RAWS * 2;
constexpr int HY_VB_OFF = FFT_WORK * 8;
constexpr int HY_X2_OFF = HY_VB_OFF + HY_ROWB;
constexpr int HY_X1_OFF = HY_X2_OFF + HY_ROWB;
constexpr int HY_EX_OFF = HY_X1_OFF + HY_ROWB;
constexpr int HY_YB_OFF = HY_EX_OFF + 16384;
static_assert(HY_VB_OFF % 16 == 0 && HY_ROWB % 16 == 0 && HY_YB_OFF + 2 * 4096 * 2 <= PHASE_LDS && HY_YB_OFF - HY_X1_OFF >= 4096 * 8 && HY_X1_OFF % 8 == 0, "hyena LDS map");
typedef float f32x2v __attribute__((ext_vector_type(2)));
struct LdsCf { LAS f32x2v* p; __device__ __forceinline__ cf ld(int i) const { const f32x2v t = p[i]; return mk(t.x, t.y); } __device__ __forceinline__ void st(int i, cf v) const { p[i] = (f32x2v){v.x, v.y}; } };

__device__ __forceinline__ void hy_dma_rows(LAS unsigned char* lds, int region_off, const bf16* UT, int b0, int ch, int wave, int lane) {
#pragma unroll
    for (int r = 0; r < 2; ++r)
        __builtin_amdgcn_global_load_lds((const unsigned*)(UT + (((size_t)((b0 + r) * C3 + ch)) << 12) + wave * 512 + lane * 8), (LAS unsigned*)(lds + region_off + r * HY_RAWS * 2 + 16 + wave * 1024), 16, 0, 0);
}
__device__ __forceinline__ void hy_pads(LAS unsigned char* lds, int region_off, int tid) {
    if (tid < 2) { LAS bf16* row = (LAS bf16*)(lds + region_off) + tid * HY_RAWS; row[7] = 0; row[8 + 4096] = 0; }
}
__device__ __forceinline__ float hy_conv(const LAS bf16* ldsh, int e, float w0, float w1, float w2, float bias) {
    return w0 * bf1(ldsh[e - 1]) + w1 * bf1(ldsh[e]) + w2 * bf1(ldsh[e + 1]) + bias;
}
__device__ __forceinline__ int opqi(int v) { asm volatile("" : "+v"(v)); return v; }
template <class T> __device__ __forceinline__ T* opqp(T* p) { asm volatile("" : "+v"(p)); return p; }
__device__ __forceinline__ cf opq(cf w) { asm volatile("" : "+v"(w.x), "+v"(w.y)); return w; }
__device__ __forceinline__ cf csel(bool c, cf a, cf b) { return mk(c ? a.x : b.x, c ? a.y : b.y); }
__device__ __forceinline__ float uni(float v) { return __builtin_bit_cast(float, __builtin_amdgcn_readfirstlane(__builtin_bit_cast(int, v))); }
__device__ __forceinline__ void wave_lds_fence() { __builtin_amdgcn_sched_barrier(0); asm volatile("s_waitcnt lgkmcnt(0)" ::: "memory"); __builtin_amdgcn_sched_barrier(0); }
__device__ __forceinline__ void wg_sync_lds() { __builtin_amdgcn_sched_barrier(0); asm volatile("s_waitcnt lgkmcnt(0)" ::: "memory"); __builtin_amdgcn_s_barrier(); asm volatile("" ::: "memory"); __builtin_amdgcn_sched_barrier(0); }
__device__ __forceinline__ cf shfl_cf(cf v) { return mk(__shfl_xor(v.x, 32), __shfl_xor(v.y, 32)); }

__device__ __forceinline__ void kspec_phase(LAS unsigned char* lds, const float* KF, float* KSP, int G) {
    const int tid = opq_tid();
    LdsCf W; W.p = (LAS f32x2v*)lds;
    int h1, j1, h2, k1, j2, h3, blk; geo1(tid, h1, j1); geo2(tid, h2, k1, j2); geo3(tid, h3, blk);
    const int fb1 = opqi(fbase1(h1, j1)), fb2 = opqi(fbase2(h2, k1, j2)), fb3 = opqi(fbase3(h3, blk)), jo = opqi(j1);
    float sv, cv;
    sincospif(-(float)j1 / 4096.0f, &sv, &cv); const cf w8192j = mk(cv, sv);
    sincospif(-(float)j1 / 2048.0f, &sv, &cv); const cf w4096j = mk(cv, sv);
    sincospif(-(float)j2 / 128.0f, &sv, &cv);  const cf w256j = mk(cv, sv);
    const cf w32 = mk(0.98078528040323043f, -0.19509032201612825f);
#pragma unroll 1
    for (int unit = blockIdx.x; unit < 2 * 2 * HYW; unit += G) {
        const float* kf = KF + (size_t)unit * 8192;
        cf x[16]; cf wp = opq(w8192j);
#pragma unroll
        for (int m = 0; m < 16; ++m) { const float* kp = kf + opqi(jo + 1024 * (m >> 2)); const float ka = kp[256 * (m & 3)]; const float* kq = kp + opqi(4096); const float kb = kq[256 * (m & 3)];
            x[m] = csel(h1 == 0, mk(ka + kb, 0.f), cscale(wp, ka - kb)); wp = cmul(wp, w32); }
        fwd_pass1(W, fb1, opq(w4096j), x); wg_sync();
        fwd_pass2(W, fb2, opq(w256j)); wave_lds_fence();
        { cf kk[16]; fwd_pass3_keep(W, fb3, kk); GAS f32x4* kd = opqp((GAS f32x4*)(KSP + (size_t)unit * 16384 + tid * 32));
#pragma unroll
          for (int q = 0; q < 8; ++q) kd[q] = (f32x4){kk[2 * q].x, kk[2 * q].y, kk[2 * q + 1].x, kk[2 * q + 1].y}; }
        wg_sync();
    }
}
__device__ __forceinline__ void mid_pass3g(LdsCf lds, int b3, const GAS f32x4* Kp) {
    f32x4 kv[8];
#pragma unroll
    for (int q = 0; q < 8; ++q) kv[q] = Kp[q];
    cf x[16];
#pragma unroll
    for (int m = 0; m < 16; ++m) x[m] = lds.ld(b3 + m);
    dft16<false>(x);
#pragma unroll
    for (int q = 0; q < 8; ++q) { x[2 * q] = cmul(x[2 * q], mk(kv[q][0], kv[q][1])); x[2 * q + 1] = cmul(x[2 * q + 1], mk(kv[q][2], kv[q][3])); }
    dft16<true>(x);
#pragma unroll
    for (int m = 0; m < 16; ++m) lds.st(b3 + m, x[m]);
}
#ifdef DIAG
#define HY_SYNC() do { const unsigned long long ts_ = wall_clock64(); wg_sync(); hy_wait_ += wall_clock64() - ts_; } while (0)
#else
#define HY_SYNC() wg_sync()
#endif
__device__ __forceinline__ void hyena_phase(LAS unsigned char* lds, const Args& a, int layer, const bf16* UT, const float* KSP, bf16* YT, int G) {
    const int tid = opq_tid();
#ifdef DIAG
    unsigned long long hy_wait_ = 0; const unsigned long long hy_t0_ = wall_clock64();
#endif
    LdsCf W; W.p = (LAS f32x2v*)lds;
    const int wave = __builtin_amdgcn_readfirstlane(tid >> 6), lane = tid & 63;
    int h1, j1, h2, k1, j2, h3, blk; geo1(tid, h1, j1); geo2(tid, h2, k1, j2); geo3(tid, h3, blk);
    const int fb1 = opqi(fbase1(h1, j1)), fb2 = opqi(fbase2(h2, k1, j2)), fb3 = opqi(fbase3(h3, blk));
    const int jo = opqi(j1), jh = opqi(j1 + 2048 * h1);
    LdsCf ZB; ZB.p = (LAS f32x2v*)lds; const int zo = opqi(HY_X1_OFF / 8 + j1), zh = opqi(HY_X1_OFF / 8 + j1 + 2048 * h1);
    LAS bf16* l16 = (LAS bf16*)lds; const int yh = opqi(HY_YB_OFF / 2 + j1 + 2048 * h1);
    const LAS bf16* ldsh = (const LAS bf16*)lds; const int ro = opqi(HY_VB_OFF / 2 + 8 + j1), rh = opqi(HY_VB_OFF / 2 + 8 + j1 + 2048 * h1);
    float sv, cv;
    sincospif(-(float)j1 / 4096.0f, &sv, &cv); const cf w8192j = mk(cv, sv);
    sincospif(-(float)j1 / 2048.0f, &sv, &cv); const cf w4096j = mk(cv, sv);
    sincospif(-(float)j2 / 128.0f, &sv, &cv);  const cf w256j = mk(cv, sv);
    const cf w32 = mk(0.98078528040323043f, -0.19509032201612825f);
    const float* cw = a.in[I_CONVW] + layer * 3 * C3; const float* cbv = a.in[I_CONVB] + layer * C3; const float* skp = a.in[I_SKIP] + layer * 2 * HYW;
    for (int c = blockIdx.x; c < HYW; c += G) {
        const float x1w0 = uni(cw[c]), x1w1 = uni(cw[C3 + c]), x1w2 = uni(cw[2 * C3 + c]), x1b = uni(cbv[c]);
        const float x2w0 = uni(cw[512 + c]), x2w1 = uni(cw[C3 + 512 + c]), x2w2 = uni(cw[2 * C3 + 512 + c]), x2b = uni(cbv[512 + c]);
        const float vw0 = uni(cw[1024 + c]), vw1 = uni(cw[C3 + 1024 + c]), vw2 = uni(cw[2 * C3 + 1024 + c]), vb = uni(cbv[1024 + c]);
        const float skip0 = uni(skp[c]), skip1 = uni(skp[HYW + c]);
        const float* KS0 = KSP + ((size_t)((layer * 2 + 0) * HYW + c)) * 16384 + opqi(tid * 32);
        const float* KS1 = KSP + ((size_t)((layer * 2 + 1) * HYW + c)) * 16384 + opqi(tid * 32);
        hy_dma_rows(lds, HY_VB_OFF, UT, 0, 1024 + c, wave, lane); hy_pads(lds, HY_VB_OFF, tid); hy_pads(lds, HY_X2_OFF, tid);
        HY_SYNC();
#pragma unroll 1
        for (int pr = 0; pr < 8; ++pr) {
            const int b0 = 2 * pr;
            hy_dma_rows(lds, HY_X1_OFF, UT, b0, c, wave, lane); hy_dma_rows(lds, HY_X2_OFF, UT, b0, 512 + c, wave, lane); hy_pads(lds, HY_X1_OFF, tid);
            cf x[16];
            { cf wp = opq(w8192j);
#pragma unroll
              for (int m = 0; m < 16; ++m) {
                  const cf z = mk(hy_conv(ldsh, ro + 256 * m, vw0, vw1, vw2, vb), hy_conv(ldsh, ro + 256 * m + HY_RAWS, vw0, vw1, vw2, vb));
                  x[m] = csel(h1 == 0, z, cmul(z, wp)); wp = cmul(wp, w32); } }
            fwd_pass1(W, fb1, opq(w4096j), x); wg_sync_lds();
            fwd_pass2(W, fb2, opq(w256j)); wave_lds_fence();
            mid_pass3g(W, fb3, opqp((const GAS f32x4*)KS0)); wave_lds_fence();
            inv_pass2(W, fb2, opq(w256j)); HY_SYNC();
            inv_pass1(W, fb1, opq(w4096j), x);
            cf zz[8];
            { cf wp = opq(w8192j);
#pragma unroll
              for (int m = 0; m < 16; ++m) { x[m] = csel(h1 == 1, cmulc(x[m], wp), x[m]); wp = cmul(wp, w32); }
#pragma unroll
              for (int i = 0; i < 8; ++i) { const cf xa_ = x[i], xb_ = x[8 + i]; const cf mine = csel(h1 == 1, xb_, xa_), send = csel(h1 == 1, xa_, xb_); const cf r = cscale(cadd(mine, shfl_cf(send)), 1.0f / 8192.0f);
                  const float va = hy_conv(ldsh, rh + 256 * i, vw0, vw1, vw2, vb), vbb = hy_conv(ldsh, rh + 256 * i + HY_RAWS, vw0, vw1, vw2, vb);
                  const float xa = hy_conv(ldsh, rh + 256 * i + (HY_X1_OFF - HY_VB_OFF) / 2, x1w0, x1w1, x1w2, x1b), xb = hy_conv(ldsh, rh + 256 * i + (HY_X1_OFF - HY_VB_OFF) / 2 + HY_RAWS, x1w0, x1w1, x1w2, x1b);
                  zz[i] = mk(xa * (r.x + skip0 * va), xb * (r.y + skip0 * vbb)); } }
            wg_sync_lds();
            if (pr < 7) hy_dma_rows(lds, HY_VB_OFF, UT, b0 + 2, 1024 + c, wave, lane);
#pragma unroll
            for (int i = 0; i < 8; ++i) ZB.st(zh + 256 * i, zz[i]);
            wg_sync_lds();
            { cf wp = opq(w8192j);
#pragma unroll
              for (int m = 0; m < 16; ++m) { const cf full = ZB.ld(zo + 256 * m); x[m] = csel(h1 == 0, full, cmul(full, wp)); wp = cmul(wp, w32); } }
            fwd_pass1(W, fb1, opq(w4096j), x); wg_sync_lds();
            fwd_pass2(W, fb2, opq(w256j)); wave_lds_fence();
            mid_pass3g(W, fb3, opqp((const GAS f32x4*)KS1)); wave_lds_fence();
            inv_pass2(W, fb2, opq(w256j)); wg_sync_lds();
            inv_pass1(W, fb1, opq(w4096j), x);
            { cf wp = opq(w8192j);
#pragma unroll
              for (int m = 0; m < 16; ++m) { x[m] = csel(h1 == 1, cmulc(x[m], wp), x[m]); wp = cmul(wp, w32); }
#pragma unroll
              for (int i = 0; i < 8; ++i) { const cf xa_ = x[i], xb_ = x[8 + i]; const cf mine = csel(h1 == 1, xb_, xa_), send = csel(h1 == 1, xa_, xb_); const cf r = cscale(cadd(mine, shfl_cf(send)), 1.0f / 8192.0f);
                  const int p = jh + 256 * i; const cf zv = ZB.ld(zh + 256 * i);
                  const float xa = hy_conv(ldsh, rh + 256 * i + (HY_X2_OFF - HY_VB_OFF) / 2, x2w0, x2w1, x2w2, x2b), xb = hy_conv(ldsh, rh + 256 * i + (HY_X2_OFF - HY_VB_OFF) / 2 + HY_RAWS, x2w0, x2w1, x2w2, x2b);
                  const float ya = xa * (r.x + skip1 * zv.x), yb = xb * (r.y + skip1 * zv.y);
                  l16[yh + 256 * i] = (bf16)f2bf(ya); l16[yh + 256 * i + 4096] = (bf16)f2bf(yb); (void)p; } }
            HY_SYNC();
#pragma unroll
            for (int i = 0; i < 2; ++i) { const int q = tid + NTHR * i, row = q >> 9, cc = q & 511;
                *(v4u*)(YT + (((size_t)((b0 + row) * HYW + c)) << 12) + cc * 8) = *(const LAS v4u*)(l16 + HY_YB_OFF / 2 + row * 4096 + cc * 8); }
        }
    }
#ifdef DIAG
    if (blockIdx.x == 0 && tid == 0) { unsigned long long* dg = (unsigned long long*)(*(const LAS unsigned long long*)(lds + 139328)); atomicAdd(dg + 16, hy_wait_); atomicAdd(dg + 17, wall_clock64() - hy_t0_); }
#endif
}
constexpr int MN_STRIDE = 66;
static_assert(HYW * MN_STRIDE * 2 <= PHASE_LDS, "mix-norm LDS");
__device__ __forceinline__ void mixnorm_phase(LAS unsigned char* lds, const bf16* Ab, const bf16* YT, const float* ga, const float* gy, bf16* mixed, int G) {
    const int tid = opq_tid(), lane = tid & 63, wave = __builtin_amdgcn_readfirstlane(tid >> 6);
    LAS unsigned* tile32 = (LAS unsigned*)lds; const LAS bf16* tile16 = (const LAS bf16*)lds;
    f32x4 gav[2], gyv[2];
    gav[0] = *(const f32x4*)(ga + lane * 8); gav[1] = *(const f32x4*)(ga + lane * 8 + 4); gyv[0] = *(const f32x4*)(gy + lane * 8); gyv[1] = *(const f32x4*)(gy + lane * 8 + 4);
    v4u R[8];
    int unit = blockIdx.x;
    if (unit < M / 64) { const bf16* src = YT + (((size_t)((unit >> 6) * HYW + tid)) << 12) + (unit & 63) * 64;
#pragma unroll
        for (int q = 0; q < 8; ++q) R[q] = *(const v4u*)(src + 8 * q); }
#pragma unroll 1
    for (; unit < M / 64; unit += G) {
        const int b = unit >> 6, t0 = (unit & 63) * 64;
#pragma unroll
        for (int q = 0; q < 8; ++q) { LAS unsigned* d = tile32 + tid * (MN_STRIDE / 2) + 4 * q; d[0] = R[q].x; d[1] = R[q].y; d[2] = R[q].z; d[3] = R[q].w; }
        wg_sync();
        const int nu = unit + G;
        if (nu < M / 64) { const bf16* src = YT + (((size_t)((nu >> 6) * HYW + tid)) << 12) + (nu & 63) * 64;
#pragma unroll
            for (int q = 0; q < 8; ++q) R[q] = *(const v4u*)(src + 8 * q); }
        const size_t row0 = (size_t)b * SEQ + t0 + wave * 8;
        v4u av[8];
#pragma unroll
        for (int i = 0; i < 8; ++i) av[i] = *(const v4u*)(Ab + (row0 + i) * AW + lane * 8);
#pragma unroll
        for (int i = 0; i < 8; ++i) { const int tt = wave * 8 + i;
            float y[8]; float ss = 0.f;
#pragma unroll
            for (int e = 0; e < 8; ++e) { y[e] = bf1(tile16[(lane * 8 + e) * MN_STRIDE + tt]); ss += y[e] * y[e]; }
            const float rs = __builtin_amdgcn_rsqf(wave_sum(ss) * (1.f / 512.f) + EPS);
            v4u o; o.x = pk2(y[0] * rs * gyv[0][0], y[1] * rs * gyv[0][1]); o.y = pk2(y[2] * rs * gyv[0][2], y[3] * rs * gyv[0][3]);
            o.z = pk2(y[4] * rs * gyv[1][0], y[5] * rs * gyv[1][1]); o.w = pk2(y[6] * rs * gyv[1][2], y[7] * rs * gyv[1][3]);
            *(v4u*)(mixed + (row0 + i) * D + 512 + lane * 8) = o; }
#pragma unroll
        for (int i = 0; i < 8; ++i) {
            const float x[8] = {bflo(av[i].x), bfhi(av[i].x), bflo(av[i].y), bfhi(av[i].y), bflo(av[i].z), bfhi(av[i].z), bflo(av[i].w), bfhi(av[i].w)};
            float ss = 0.f;
#pragma unroll
            for (int e = 0; e < 8; ++e) ss += x[e] * x[e];
            const float rs = __builtin_amdgcn_rsqf(wave_sum(ss) * (1.f / 512.f) + EPS);
            v4u o; o.x = pk2(x[0] * rs * gav[0][0], x[1] * rs * gav[0][1]); o.y = pk2(x[2] * rs * gav[0][2], x[3] * rs * gav[0][3]);
            o.z = pk2(x[4] * rs * gav[1][0], x[5] * rs * gav[1][1]); o.w = pk2(x[6] * rs * gav[1][2], x[7] * rs * gav[1][3]);
            *(v4u*)(mixed + (row0 + i) * D + lane * 8) = o; }
        wg_sync();
    }
}

__device__ __forceinline__ void moe_norm_router_phase(LAS unsigned char* lds, const bf16* xb, const float* gain, const float* wr, float* rsrow, int* toke, float* tokw, int* wgcnt, int G) {
    const int tid = opq_tid(), lane = tid & 63, wave = __builtin_amdgcn_readfirstlane(tid >> 6);
    LAS int* cnt = (LAS int*)lds;
    if (tid < 8) cnt[tid] = 0;
    wg_sync();
    const int TPW = M / G;
    f32x4 wra[4][4], wrb[4][4];
#pragma unroll
    for (int j = 0; j < 4; ++j) { const f32x4 gv = *(const f32x4*)(gain + 4 * lane + 256 * j);
#pragma unroll
        for (int q = 0; q < 4; ++q) { const int k = 4 * lane + q + 256 * j; wra[j][q] = *(const f32x4*)(wr + k * 8) * gv[q]; wrb[j][q] = *(const f32x4*)(wr + k * 8 + 4) * gv[q]; } }
    v2u nx[4];
    { const v2u* xr = (const v2u*)(xb + (size_t)(blockIdx.x * TPW + wave) * D) + lane;
#pragma unroll
      for (int j = 0; j < 4; ++j) nx[j] = xr[64 * j]; }
#pragma unroll 1
    for (int i = wave; i < TPW; i += NWAVES) {
        const int t = blockIdx.x * TPW + i;
        v2u cu[4];
#pragma unroll
        for (int j = 0; j < 4; ++j) cu[j] = nx[j];
        if (i + NWAVES < TPW) { const v2u* xr = (const v2u*)(xb + (size_t)(t + NWAVES) * D) + lane;
#pragma unroll
            for (int j = 0; j < 4; ++j) nx[j] = xr[64 * j]; }
        f32x4 v[4]; float s = 0.f;
#pragma unroll
        for (int j = 0; j < 4; ++j) { const v2u a = cu[j]; v[j] = (f32x4){bflo(a.x), bfhi(a.x), bflo(a.y), bfhi(a.y)}; s += (v[j].x * v[j].x + v[j].y * v[j].y) + (v[j].z * v[j].z + v[j].w * v[j].w); }
        const float rs = 1.0f / sqrtf(wave_sum(s) * (1.f / 1024.f) + EPS);
        float lg[8];
#pragma unroll
        for (int e = 0; e < 8; ++e) lg[e] = 0.f;
#pragma unroll
        for (int j = 0; j < 4; ++j)
#pragma unroll
            for (int q = 0; q < 4; ++q) { const f32x4 wa = wra[j][q], wb = wrb[j][q]; const float hv = v[j][q];
                lg[0] += hv * wa[0]; lg[1] += hv * wa[1]; lg[2] += hv * wa[2]; lg[3] += hv * wa[3]; lg[4] += hv * wb[0]; lg[5] += hv * wb[1]; lg[6] += hv * wb[2]; lg[7] += hv * wb[3]; }
        { const bool b5 = lane & 32, b4 = lane & 16, b3 = lane & 8; float k4[4], k2[2], k1;
#pragma unroll
          for (int i = 0; i < 4; ++i) { const float send = b5 ? lg[i] : lg[4 + i], keep = b5 ? lg[4 + i] : lg[i]; k4[i] = keep + __shfl_xor(send, 32); }
#pragma unroll
          for (int i = 0; i < 2; ++i) { const float send = b4 ? k4[i] : k4[2 + i], keep = b4 ? k4[2 + i] : k4[i]; k2[i] = keep + __shfl_xor(send, 16); }
          { const float send = b3 ? k2[0] : k2[1], keep = b3 ? k2[1] : k2[0]; k1 = keep + __shfl_xor(send, 8); }
          k1 += __shfl_xor(k1, 4); k1 += __shfl_xor(k1, 2); k1 += __shfl_xor(k1, 1);
#pragma unroll
          for (int e = 0; e < 8; ++e) lg[e] = __builtin_bit_cast(float, __builtin_amdgcn_readlane(__builtin_bit_cast(int, k1), 8 * e)) * rs; }
        int i0 = 0; float v0 = lg[0];
#pragma unroll
        for (int e = 1; e < 8; ++e) if (lg[e] > v0) { v0 = lg[e]; i0 = e; }
        int i1 = -1; float v1 = -3.0e38f;
#pragma unroll
        for (int e = 0; e < 8; ++e) if (e != i0 && lg[e] > v1) { v1 = lg[e]; i1 = e; }
        const float e1 = __expf(v1 - v0), w0 = 1.0f / (1.0f + e1), w1 = e1 * w0;
        if (lane == 0) { toke[2 * t] = i0; toke[2 * t + 1] = i1; tokw[2 * t] = w0; tokw[2 * t + 1] = w1; rsrow[t] = rs; __hip_atomic_fetch_add(cnt + i0, 1, __ATOMIC_RELAXED, __HIP_MEMORY_SCOPE_WORKGROUP); __hip_atomic_fetch_add(cnt + i1, 1, __ATOMIC_RELAXED, __HIP_MEMORY_SCOPE_WORKGROUP); }
    }
    wg_sync();
    if (tid < 8) wgcnt[blockIdx.x * 8 + tid] = cnt[tid];
    wg_sync();
}
__device__ __forceinline__ void moe_slot_phase(LAS unsigned char* lds, const int* toke, const int* wgcnt, int* tokp, int* tilee, int* meta, const bf16* xb, const float* rsrow, const float* gain, unsigned char* XG8, int G) {
    const int tid = opq_tid(), lane = tid & 63, wave = __builtin_amdgcn_readfirstlane(tid >> 6);
    LAS int* arr = (LAS int*)lds;
    LAS int* pre = arr + 1024 * 8;
    LAS int* wcnt = pre + 32;
    LAS int* slots = wcnt + 64;
    for (int i = tid; i < G * 8; i += NTHR) arr[i] = wgcnt[i];
    wg_sync();
    if (tid < 8) { int p = 0, tot = 0; for (int w = 0; w < G; ++w) { const int c = arr[w * 8 + tid]; if (w < (int)blockIdx.x) p += c; tot += c; } pre[tid] = p; pre[8 + tid] = tot; }
    wg_sync();
    if (tid == 0) { int ps = 0; for (int e = 0; e < 8; ++e) { pre[16 + e] = ps; ps += ((pre[8 + e] + 255) >> 8) << 8; } pre[24] = ps; }
    wg_sync();
    const int TPW = M / G;
    int e_mine = -1, t = 0, rank = 0;
    if (tid < 2 * TPW) { t = blockIdx.x * TPW + (tid >> 1); e_mine = toke[2 * t + (tid & 1)]; }
#pragma unroll
    for (int e = 0; e < 8; ++e) { const unsigned long long mk_ = __ballot(e_mine == e); if (e_mine == e) rank = __popcll(mk_ & ((1ull << lane) - 1ull)); if (lane == 0) wcnt[wave * 8 + e] = __popcll(mk_); }
    wg_sync();
    if (e_mine >= 0) { int base = pre[16 + e_mine] + pre[e_mine]; for (int w = 0; w < wave; ++w) base += wcnt[w * 8 + e_mine];
        const int slot = base + rank; slots[tid] = slot; tokp[2 * t + (tid & 1)] = slot; }
    else slots[tid] = -1;
    if ((int)blockIdx.x < 8) { const int e = blockIdx.x, s0 = pre[16 + e] + pre[8 + e], s1 = pre[16 + e] + (((pre[8 + e] + 255) >> 8) << 8);
        unsigned z0 = 0u; asm volatile("" : "+v"(z0));
        for (int i = tid; i < (s1 - s0) * 64; i += NTHR) ((v4u*)(XG8 + (size_t)s0 * D))[i] = (v4u){z0, z0, z0, z0}; }
    if (blockIdx.x == 0) { const int ntiles = pre[24] >> 8;
        for (int ti = tid; ti < ntiles; ti += NTHR) { int e = 0;
#pragma unroll
            for (int q = 1; q < 8; ++q) if (ti * 256 >= pre[16 + q]) e = q;
            tilee[ti] = e; }
        if (tid == 0) meta[0] = ntiles; }
    wg_sync();
    { f32x4 g[4];
#pragma unroll
      for (int q = 0; q < 4; ++q) g[q] = *(const f32x4*)(gain + 16 * lane + 4 * q);
#pragma unroll 1
      for (int a0 = wave * 64; a0 < wave * 64 + 64; a0 += 2) {
          v4u av[2][2]; float rs[2]; int sl[2];
#pragma unroll
          for (int u = 0; u < 2; ++u) { const int a = a0 + u; sl[u] = slots[a]; const int tt = blockIdx.x * TPW + (a >> 1); rs[u] = rsrow[tt]; const v4u* src = (const v4u*)(xb + (size_t)tt * D) + 2 * lane; av[u][0] = src[0]; av[u][1] = src[1]; }
#pragma unroll
          for (int u = 0; u < 2; ++u) if (sl[u] >= 0) { v4u o;
#pragma unroll
              for (int h = 0; h < 2; ++h) { const unsigned w4[4] = {av[u][h].x, av[u][h].y, av[u][h].z, av[u][h].w};
#pragma unroll
                  for (int q = 0; q < 2; ++q) { int w = 0;
                      w = __builtin_amdgcn_cvt_pk_fp8_f32(bflo(w4[2 * q]) * rs[u] * g[2 * h + q][0], bfhi(w4[2 * q]) * rs[u] * g[2 * h + q][1], w, false);
                      w = __builtin_amdgcn_cvt_pk_fp8_f32(bflo(w4[2 * q + 1]) * rs[u] * g[2 * h + q][2], bfhi(w4[2 * q + 1]) * rs[u] * g[2 * h + q][3], w, true);
                      o[2 * h + q] = (unsigned)w; } }
              ((v4u*)(XG8 + (size_t)sl[u] * D))[lane] = o; } } }
    wg_sync();
}
__device__ __forceinline__ void moe_gather_phase(const bf16* xb, const float* rsrow, const float* gain, const int* rowtok, bf16* XG, int nrows, int gw, int NGW, int lane) {
    f32x4 g[4];
#pragma unroll
    for (int q = 0; q < 4; ++q) g[q] = *(const f32x4*)(gain + (q >> 1) * 512 + 8 * lane + 4 * (q & 1));
    for (int r = gw; r < nrows; r += NGW) { const int t = rowtok[r]; const float rs = rsrow[t]; const v4u* src = (const v4u*)(xb + (size_t)t * D); v4u* dst = (v4u*)(XG + (size_t)r * D);
#pragma unroll
        for (int h = 0; h < 2; ++h) { const v4u a = src[64 * h + lane]; v4u o;
            o.x = pk2(bflo(a.x) * rs * g[2 * h][0], bfhi(a.x) * rs * g[2 * h][1]); o.y = pk2(bflo(a.y) * rs * g[2 * h][2], bfhi(a.y) * rs * g[2 * h][3]);
            o.z = pk2(bflo(a.z) * rs * g[2 * h + 1][0], bfhi(a.z) * rs * g[2 * h + 1][1]); o.w = pk2(bflo(a.w) * rs * g[2 * h + 1][2], bfhi(a.w) * rs * g[2 * h + 1][3]);
            dst[64 * h + lane] = o; } }
}
__device__ __forceinline__ void moe_combine_final_phase(const bf16* xb, float* out, const bf16* YB, const int* tokp, const float* tokw, const float* gain, int gw, int NGW, int lane) {
    f32x4 g[4];
#pragma unroll
    for (int q = 0; q < 4; ++q) g[q] = *(const f32x4*)(gain + (q >> 1) * 512 + 8 * lane + 4 * (q & 1));
#pragma unroll 1
    for (int t0 = gw; t0 < M; t0 += 2 * NGW) {
        v4u xa[2][2], ya[2][2], yb[2][2]; float w0[2], w1[2]; bool on[2];
#pragma unroll
        for (int u = 0; u < 2; ++u) { const int t = t0 + u * NGW; on[u] = t < M; const int tt = on[u] ? t : t0;
            const int p0 = tokp[2 * tt], p1 = tokp[2 * tt + 1]; w0[u] = tokw[2 * tt]; w1[u] = tokw[2 * tt + 1];
            const v4u* xr = (const v4u*)(xb + (size_t)tt * D) + lane; const v4u* y0 = (const v4u*)(YB + (size_t)p0 * D) + lane; const v4u* y1 = (const v4u*)(YB + (size_t)p1 * D) + lane;
#pragma unroll
            for (int h = 0; h < 2; ++h) { xa[u][h] = xr[64 * h]; ya[u][h] = y0[64 * h]; yb[u][h] = y1[64 * h]; } }
#pragma unroll
        for (int u = 0; u < 2; ++u) { const int t = t0 + u * NGW; float v[2][8]; float s = 0.f;
#pragma unroll
            for (int h = 0; h < 2; ++h) { const unsigned xw[4] = {xa[u][h].x, xa[u][h].y, xa[u][h].z, xa[u][h].w}, aw[4] = {ya[u][h].x, ya[u][h].y, ya[u][h].z, ya[u][h].w}, bw[4] = {yb[u][h].x, yb[u][h].y, yb[u][h].z, yb[u][h].w};
#pragma unroll
                for (int q = 0; q < 4; ++q) { v[h][2 * q] = bflo(xw[q]) + w0[u] * bflo(aw[q]) + w1[u] * bflo(bw[q]); v[h][2 * q + 1] = bfhi(xw[q]) + w0[u] * bfhi(aw[q]) + w1[u] * bfhi(bw[q]);
                    s += v[h][2 * q] * v[h][2 * q] + v[h][2 * q + 1] * v[h][2 * q + 1]; } }
            const float rs = 1.0f / sqrtf(wave_sum(s) * (1.f / 1024.f) + EPS);
            if (on[u]) { f32x4* orow = (f32x4*)(out + (size_t)t * D);
#pragma unroll
                for (int h = 0; h < 2; ++h) { orow[128 * h + 2 * lane] = (f32x4){v[h][0], v[h][1], v[h][2], v[h][3]} * rs * g[2 * h]; orow[128 * h + 2 * lane + 1] = (f32x4){v[h][4], v[h][5], v[h][6], v[h][7]} * rs * g[2 * h + 1]; } } }
    }
}
struct MoeOrder : pg8::StaticOrder {
    const int* tilee; int tile0; size_t bstride;
    __device__ __forceinline__ size_t boff(const pg8::Unit& u) const { return (size_t)tilee[tile0 + u.pm] * bstride; }
};
#ifndef LB_WAVES
#define LB_WAVES 2
#endif
constexpr int N_PHASES_C = 29;
__global__ void __launch_bounds__(NTHR, LB_WAVES) fwd_kernel(Args args) {
    extern __shared__ __attribute__((aligned(16))) unsigned char lds_raw[];
    LAS unsigned char* lds = (LAS unsigned char*)lds_raw;
    const int tid0 = threadIdx.x;
    const int G = gridDim.x, NGW = G * NWAVES;
    unsigned char* ws = args.ws;
    gu32* ctl = (gu32*)(ws + WS_CTL);
    volatile LAS unsigned* MISC = (volatile LAS unsigned*)(lds + MISC_OFF);
    for (int u = tid0; u < (LDS_BYTES - LDSCTL_OFF) / 4; u += NTHR) ((LAS unsigned*)(lds + LDSCTL_OFF))[u] = 0u;
#ifdef DIAG
#ifndef DIAG_WG
#define DIAG_WG 0
#endif
#ifndef DIAG_PH
#define DIAG_PH 0
#endif
#ifndef DIAG_DIV
#define DIAG_DIV 1
#endif
    static_assert(MISC_OFF == 139328, "diag pointer slot");
    if (tid0 == 0) ((LAS unsigned long long*)(lds + MISC_OFF))[0] = (unsigned long long)(ws + WS_CTL + 512 * 1024);
#endif
    __syncthreads();
    XcdBarrier bar; bar.bar = (unsigned*)(ctl + CW_BAR); bar.x = 0; bar.st = nullptr;
    if (args.use_bar) bar = xcd_barrier_post((unsigned*)(ctl + CW_BAR), MISC + 8);
    const int lo = args.ph_lo, hi = args.ph_hi;
    int ph = 0;
#ifndef PHMASK
#define PHMASK 0xffffffffu
#endif
#define EN(k) (((PHMASK) >> (k)) & 1u)
#define PH_ON() (ph >= lo && ph < hi)
#define LOCAL_IDS() const int tid = opq_tid(), lane = tid & 63, wave = __builtin_amdgcn_readfirstlane(tid >> 6), gw = blockIdx.x * NWAVES + wave; (void)lane; (void)gw
#ifndef DUPMASK
#define DUPMASK 0u
#endif
#define RES_DST(k) ((NREP(k) > 1 && rep_ + 1 < NREP(k)) ? (bf16*)args.out : HB)
#ifndef DUPN
#define DUPN 2
#endif
#define NREP(k) ((((DUPMASK) >> (k)) & 1u) ? DUPN : 1)
#ifdef DIAG
#define PH_END_K(k) do { if (args.use_bar && (ph + 1 < hi || rep_ + 1 < NREP(k))) { const unsigned long long tb_ = wall_clock64(); xcd_barrier(bar); if (threadIdx.x == 0) { unsigned long long* dg = (unsigned long long*)(ws + WS_CTL + 512 * 1024); const unsigned long long w_ = wall_clock64() - tb_; atomicAdd(dg + 5, w_); if (ph == DIAG_PH) atomicAdd(dg + 6, w_); } } } while (0)
#else
#define PH_END_K(k) do { if (args.use_bar && (ph + 1 < hi || rep_ + 1 < NREP(k))) xcd_barrier(bar); } while (0)
#endif

    float* cosT = (float*)(ws + WS_COS); float* sinT = (float*)(ws + WS_SIN); float* H2 = (float*)(ws + WS_H2);
    int* toke = (int*)(ws + WS_TOKE); float* tokw = (float*)(ws + WS_TOKW); int* tokp = (int*)(ws + WS_TOKP); int* rowtok = (int*)(ws + WS_ROWTOK);
    int* tilee = (int*)(ws + WS_TILEE); int* wgcnt = (int*)(ws + WS_WGCNT); int* meta = (int*)(ws + WS_META); float* rsrow = (float*)(ws + WS_RSROW);
    bf16* WINA = (bf16*)(ws + WS_WINA); bf16* WINB = (bf16*)(ws + WS_WINB); bf16* WOUT = (bf16*)(ws + WS_WOUT); bf16* XQ = (bf16*)(ws + WS_XQ); bf16* XK = (bf16*)(ws + WS_XK);
    bf16* XV = (bf16*)(ws + WS_XV); bf16* XO = (bf16*)(ws + WS_XO); bf16* FGU = (bf16*)(ws + WS_FGU); bf16* FDN = (bf16*)(ws + WS_FDN); bf16* MGU = (bf16*)(ws + WS_MGU); bf16* MDN = (bf16*)(ws + WS_MDN);
    float* KF = (float*)(ws + WS_KFILT); bf16* MB = (bf16*)(ws + WS_MB); bf16* KMEM = (bf16*)(ws + WS_KMEM); bf16* VMEMT = (bf16*)(ws + WS_VMEMT); bf16* HB = (bf16*)(ws + WS_HB);
    bf16* QB = (bf16*)(ws + WS_QB); bf16* KB = (bf16*)(ws + WS_KB); bf16* VB = (bf16*)(ws + WS_VB); bf16* UT = (bf16*)(ws + WS_UT); bf16* AB = (bf16*)(ws + WS_AB); bf16* YT = (bf16*)(ws + WS_YT);
    bf16* MIXED = (bf16*)(ws + WS_MIXED); float* SS = (float*)(ws + WS_SS);
    bf16* XQB = (bf16*)(ws + WS_XQB); bf16* XOB = (bf16*)(ws + WS_XOB); bf16* ACT = (bf16*)(ws + WS_ACT); unsigned char* XG8 = ws + WS_XG; bf16* YB = (bf16*)(ws + WS_YB); unsigned char* MGU8 = ws + WS_MGU; bf16* MACT = (bf16*)(ws + WS_MACT);
    const float* const* in = args.in;

    if (EN(0) && PH_ON()) for (int rep_ = 0; rep_ < NREP(0); ++rep_) { asm volatile("; PHASE_MARK 0"); LOCAL_IDS();
        LAS float* scr = (LAS float*)(lds + wave * 8704);
        constexpr int IT_L = 384 + 768 + 512 + 4 * 256, IT_D = 3 * 1408, IT_E = 3 * 1792, IT_ALL = 2 * IT_L + IT_D + NE * IT_E;
#pragma unroll 1
        for (int it = gw; it < IT_ALL; it += NGW) {
            const float* W; int ldw, K, col0 = 0, ncols, mode = 0; bf16* WT; const float* gk = nullptr; int r = it;
            if (r < 2 * IT_L) { const int l = r / IT_L; r -= l * IT_L;
                if (r < 384) { W = in[I_WIN] + (size_t)l * D * INC; ldw = INC; K = D; ncols = 768; WT = WINA + (size_t)l * 768 * D; mode = 1; gk = in[I_MIXNORM] + l * D; }
                else if ((r -= 384) < 768) { W = in[I_WIN] + (size_t)l * D * INC; ldw = INC; K = D; col0 = 768; ncols = C3; WT = WINB + (size_t)l * C3 * D; gk = in[I_MIXNORM] + l * D; }
                else if ((r -= 768) < 512) { W = in[I_WOUT] + (size_t)l * D * D; ldw = D; K = D; ncols = D; WT = WOUT + (size_t)l * D * D; }
                else if ((r -= 512) < 256) { W = in[I_XWQ] + (size_t)l * D * XW; ldw = XW; K = D; ncols = XW; WT = XQ + (size_t)l * XW * D; gk = in[I_XNORM] + l * D; }
                else if ((r -= 256) < 256) { W = in[I_XWK] + (size_t)l * D * XW; ldw = XW; K = D; ncols = XW; WT = XK + (size_t)l * XW * D; }
                else if ((r -= 256) < 256) { W = in[I_XWV] + (size_t)l * D * XW; ldw = XW; K = D; ncols = XW; WT = XV + (size_t)l * XW * D; }
                else { r -= 256; W = in[I_XWO] + (size_t)l * XW * D; ldw = D; K = XW; ncols = D; WT = XO + (size_t)l * D * XW; }
            } else if ((r -= 2 * IT_L) < IT_D) {
                if (r < 1408) { W = in[I_FGATE]; ldw = FF; K = D; ncols = FF; WT = FGU; mode = 2; gk = in[I_FNORM]; }
                else if ((r -= 1408) < 1408) { W = in[I_FUP]; ldw = FF; K = D; ncols = FF; WT = FGU; mode = 3; gk = in[I_FNORM]; }
                else { r -= 1408; W = in[I_FDOWN]; ldw = D; K = FF; ncols = D; WT = FDN; }
            } else { r -= IT_D; const int e = r / IT_E; r -= e * IT_E;
                if (r < 2 * 1792) { const bool up = r >= 1792; if (up) r -= 1792;
                    tr_item8(in[up ? I_MUP : I_MGATE] + (size_t)e * D * FFE, FFE, D, FFE, MGU8 + (size_t)e * 2 * FFE * D, up ? 3 : 2, 32.0f, r, scr, lane); continue; }
                else { r -= 2 * 1792; tr_item8(in[I_MDOWN] + (size_t)e * FFE * D, D, FFE, D, (unsigned char*)MDN + (size_t)e * D * FFE, 0, 32.0f, r, scr, lane); continue; }
            }
            tr_item(W, ldw, K, col0, ncols, WT, mode, gk, r, scr, lane);
        }
        for (int i = blockIdx.x * NTHR + tid; i < SEQ * 32; i += G * NTHR) { const int pos = i >> 5, f = i & 31;
            const float inv = (float)pow(10000.0, -(double)f / 32.0); const float ang = (float)pos * inv;
            cosT[i] = (float)cos((double)ang); sinT[i] = (float)sin((double)ang); }
        h2_rows(args, H2, gw, NGW, lane);
        norm_rows(in[I_MEM], in[I_MEMNORM], MB, MROWS, gw, NGW, lane);
        xb_rows(in[I_X], HB, SS, M, gw, NGW, lane);
        PH_END_K(0);
    }
    ++ph;
    if (EN(1) && PH_ON()) for (int rep_ = 0; rep_ < NREP(1); ++rep_) { asm volatile("; PHASE_MARK 1"); LOCAL_IDS();
        kfilt_phase(lds, H2, in[I_FW3], KF, G);
        PH_END_K(1);
    }
    ++ph;

#pragma unroll 1
    for (int l = 0; l < 2; ++l) {
        if (EN(2) && PH_ON()) for (int rep_ = 0; rep_ < NREP(2); ++rep_) { asm volatile("; PHASE_MARK 2"); LOCAL_IDS();
            if (l == 0) {
                kspec_phase(lds, KF, (float*)(ws + WS_KSPEC), G);
                { pg8::Gemm g{MB, XK, MROWS, 1024, D}; pg8::StaticOrder S; S.init(MROWS, 1024, G, (int)blockIdx.x); pg8::EpiBf16 E{KMEM, 1024, nullptr, 1.0f};
                  pg8::gemm_phase<pg8::EpiBf16, pg8::StaticOrder, PG8_ALIGN, PG8_SP2>(lds, g, S, E); }
                { pg8::Gemm g{MB, XV, MROWS, 1024, D}; pg8::StaticOrder S; S.init(MROWS, 1024, G, G >= 128 ? (int)((blockIdx.x + G - 64) % G) : (int)blockIdx.x); pg8::EpiT E{VMEMT, 1024, 12, nullptr};
                  pg8::gemm_phase<pg8::EpiT, pg8::StaticOrder, PG8_ALIGN, PG8_SP2>(lds, g, S, E); }
            }
            { pg8::Gemm g{HB, WINA + (size_t)l * 768 * D, M, 768, D}; pg8::StaticOrder S; S.init(M, 768, G, (int)blockIdx.x); pg8::EpiQKV E{QB, KB, VB, cosT, sinT, SS + (size_t)(3 * l) * SS_STRIDE};
              pg8::gemm_phase<pg8::EpiQKV, pg8::StaticOrder, PG8_ALIGN, PG8_SP2>(lds, g, S, E); }
            { pg8::Gemm g{HB, WINB + (size_t)l * C3 * D, M, C3, D}; pg8::StaticOrder S; S.init(M, C3, G, (int)blockIdx.x); pg8::EpiT E{UT, C3, 12, SS + (size_t)(3 * l) * SS_STRIDE};
              pg8::gemm_phase<pg8::EpiT, pg8::StaticOrder, PG8_ALIGN, PG8_SP2>(lds, g, S, E); }
            PH_END_K(2);
        }
        ++ph;
        if (EN(3) && PH_ON()) for (int rep_ = 0; rep_ < NREP(3); ++rep_) { asm volatile("; PHASE_MARK 3"); LOCAL_IDS();
#ifndef BA_REP
#define BA_REP 1
#endif
#ifndef HY_REP
#define HY_REP 1
#endif
#pragma unroll 1
            for (int r_ = 0; r_ < BA_REP; ++r_) band_attention_phase(lds, QB, KB, VB, AB, in[I_SINK] + l * NH, G);
#pragma unroll 1
            for (int r_ = 0; r_ < HY_REP; ++r_) hyena_phase(lds, args, l, UT, (const float*)(ws + WS_KSPEC), YT, G);
            PH_END_K(3);
        }
        ++ph;
        if (EN(4) && PH_ON()) for (int rep_ = 0; rep_ < NREP(4); ++rep_) { asm volatile("; PHASE_MARK 4"); LOCAL_IDS(); mixnorm_phase(lds, AB, YT, in[I_ANORM] + l * AW, in[I_YNORM] + l * HYW, MIXED, G); PH_END_K(4); }
        ++ph;
        if (EN(5) && PH_ON()) for (int rep_ = 0; rep_ < NREP(5); ++rep_) { asm volatile("; PHASE_MARK 5"); LOCAL_IDS();
            pg8::Gemm g{MIXED, WOUT + (size_t)l * D * D, M, D, D}; pg8::StaticOrder S; S.init(M, D, G, (int)blockIdx.x); pg8::EpiResB E{HB, D, SS + (size_t)(3 * l + 1) * SS_STRIDE, RES_DST(5)};
            pg8::gemm_phase<pg8::EpiResB, pg8::StaticOrder, PG8_ALIGN, PG8_SP2>(lds, g, S, E);
            PH_END_K(5);
        }
        ++ph;
        if (EN(7) && PH_ON()) for (int rep_ = 0; rep_ < NREP(7); ++rep_) { asm volatile("; PHASE_MARK 7"); LOCAL_IDS();
            pg8::Gemm g{HB, XQ + (size_t)l * XW * D, M, XW, D}; pg8::StaticOrder S; S.init(M, XW, G, (int)blockIdx.x); pg8::EpiBf16 E{XQB, XW, SS + (size_t)(3 * l + 1) * SS_STRIDE, 1.0f};
            pg8::gemm_phase<pg8::EpiBf16, pg8::StaticOrder, PG8_ALIGN, PG8_SP2>(lds, g, S, E);
            PH_END_K(7);
        }
        ++ph;
        if (EN(8) && PH_ON()) for (int rep_ = 0; rep_ < NREP(8); ++rep_) { asm volatile("; PHASE_MARK 8"); LOCAL_IDS(); cross_attention_phase(lds, XQB, KMEM, VMEMT, XOB, l, G); PH_END_K(8); }
        ++ph;
        if (EN(9) && PH_ON()) for (int rep_ = 0; rep_ < NREP(9); ++rep_) { asm volatile("; PHASE_MARK 9"); LOCAL_IDS();
            pg8::Gemm g{XOB, XO + (size_t)l * D * XW, M, D, XW}; pg8::StaticOrder S; S.init(M, D, G, (int)blockIdx.x); pg8::EpiResB E{HB, D, l == 0 ? SS + (size_t)2 * SS_STRIDE : nullptr, RES_DST(9)};
            pg8::gemm_phase<pg8::EpiResB, pg8::StaticOrder, PG8_ALIGN, PG8_SP2>(lds, g, S, E);
            PH_END_K(9);
        }
        ++ph;
        if (l == 0) {
            if (EN(11) && PH_ON()) for (int rep_ = 0; rep_ < NREP(11); ++rep_) { asm volatile("; PHASE_MARK 11"); LOCAL_IDS();
                pg8::Gemm g{HB, FGU, M, 2 * FF, D}; pg8::StaticOrder S; S.init(M, 2 * FF, G, (int)blockIdx.x); pg8::EpiSwiglu<true> E{ACT, FF, SS + (size_t)2 * SS_STRIDE};
                pg8::gemm_phase<pg8::EpiSwiglu<true>, pg8::StaticOrder, PG8_ALIGN, PG8_SP2>(lds, g, S, E);
                PH_END_K(11);
            }
            ++ph;
            if (EN(12) && PH_ON()) for (int rep_ = 0; rep_ < NREP(12); ++rep_) { asm volatile("; PHASE_MARK 12"); LOCAL_IDS();
                pg8::Gemm g{ACT, FDN, M, D, FF}; pg8::StaticOrder S; S.init(M, D, G, (int)blockIdx.x); pg8::EpiResB E{HB, D, SS + (size_t)3 * SS_STRIDE, RES_DST(12)};
                pg8::gemm_phase<pg8::EpiResB, pg8::StaticOrder, PG8_ALIGN, PG8_SP2>(lds, g, S, E);
                PH_END_K(12);
            }
            ++ph;
        } else {
            if (EN(14) && PH_ON()) for (int rep_ = 0; rep_ < NREP(14); ++rep_) { asm volatile("; PHASE_MARK 14"); LOCAL_IDS(); moe_norm_router_phase(lds, HB, in[I_FNORM] + D, in[I_ROUTER], rsrow, toke, tokw, wgcnt, G); PH_END_K(14); }
            ++ph;
            if (EN(15) && PH_ON()) for (int rep_ = 0; rep_ < NREP(15); ++rep_) { asm volatile("; PHASE_MARK 15"); LOCAL_IDS(); moe_slot_phase(lds, toke, wgcnt, tokp, tilee, meta, HB, rsrow, in[I_FNORM] + D, XG8, G); PH_END_K(15); }
            ++ph;
#pragma unroll 1
            for (int ci = 0; ci < MOE_NCHUNK; ++ci) {
                if (EN(17) && PH_ON()) for (int rep_ = 0; rep_ < NREP(17); ++rep_) { asm volatile("; PHASE_MARK 17"); LOCAL_IDS();
                    const int ntiles = meta[0], tile0 = ci * MOE_CH_TILES, nt = ci < MOE_NCHUNK - 1 ? MOE_CH_TILES : ntiles - (MOE_NCHUNK - 1) * MOE_CH_TILES;
                    int k8 = D / 2; asm volatile("" : "+s"(k8));
                    pg8::Gemm g{(const bf16*)(XG8 + (size_t)tile0 * 256 * D), (const bf16*)MGU8, nt * 256, 2 * FFE, k8};
                    MoeOrder S; S.init(nt * 256, 2 * FFE, G, (int)blockIdx.x); S.tilee = tilee; S.tile0 = tile0; S.bstride = (size_t)2 * FFE * D;
                    pg8::EpiSwiglu<false, true, true> E{MACT, FFE, nullptr};
                    pg8::gemm_phase<pg8::EpiSwiglu<false, true, true>, MoeOrder, PG8_ALIGN, PG8_SP2>(lds, g, S, E);
                    PH_END_K(17);
                }
                ++ph;
                if (EN(18) && PH_ON()) for (int rep_ = 0; rep_ < NREP(18); ++rep_) { asm volatile("; PHASE_MARK 18"); LOCAL_IDS();
                    const int ntiles = meta[0], tile0 = ci * MOE_CH_TILES, nt = ci < MOE_NCHUNK - 1 ? MOE_CH_TILES : ntiles - (MOE_NCHUNK - 1) * MOE_CH_TILES;
                    int k8 = FFE / 2; asm volatile("" : "+s"(k8));
                    pg8::Gemm g{MACT, MDN, nt * 256, D, k8};
                    MoeOrder S; S.init(nt * 256, D, G, (int)blockIdx.x); S.tilee = tilee; S.tile0 = tile0; S.bstride = (size_t)D * FFE;
                    pg8::EpiBf16T<true> E{YB + (size_t)tile0 * 256 * D, D, nullptr, 1.0f / 128.0f};
                    pg8::gemm_phase<pg8::EpiBf16T<true>, MoeOrder, PG8_ALIGN, PG8_SP2>(lds, g, S, E);
                    PH_END_K(18);
                }
                ++ph;
            }
            if (EN(19) && PH_ON()) for (int rep_ = 0; rep_ < NREP(19); ++rep_) { asm volatile("; PHASE_MARK 19"); LOCAL_IDS(); moe_combine_final_phase(HB, args.out, YB, tokp, tokw, in[I_FINAL], gw, NGW, lane); PH_END_K(19); }
            ++ph;
        }
    }
#ifdef DIAG
    if (blockIdx.x == DIAG_WG && tid0 == 0 && hi == N_PHASES_C) { const unsigned long long v = ((unsigned long long*)(ws + WS_CTL + 512 * 1024))[DIAG_SEL] * DIAG_MULT / DIAG_DIV; const unsigned long long t0 = wall_clock64(); while (wall_clock64() - t0 < v) __builtin_amdgcn_s_sleep(8); }
#endif
#undef PH_ON
}
constexpr int N_PHASES = 2 + 7 + 2 + 7 + 2 + 2 * MOE_NCHUNK + 1;

#ifndef MK_PER_PHASE
#define MK_PER_PHASE 0
#endif
extern "C" void kernel_launch(void* const* d_in, const int* in_sizes, int n_in, void* d_out, int out_size, void* d_ws, size_t ws_size, hipStream_t stream) {
    static int grid = 0;
    if (grid == 0) {
        if (n_in != 33 || in_sizes[0] != M * D || out_size != M * D || ws_size < WS_END) {
            fprintf(stderr, "kernel_launch: unexpected problem: n_in %d in0 %d out %d ws %zu (need %zu); nothing launched\n", n_in, n_in > 0 ? in_sizes[0] : -1, out_size, ws_size, (size_t)WS_END); grid = -1; return; }
        int dev = 0, cus = 0, per_cu = 0;
        if (hipGetDevice(&dev) != hipSuccess || hipDeviceGetAttribute(&cus, hipDeviceAttributeMultiprocessorCount, dev) != hipSuccess) { fprintf(stderr, "kernel_launch: device query failed\n"); grid = -1; return; }
        if (hipFuncSetAttribute((const void*)fwd_kernel, hipFuncAttributeMaxDynamicSharedMemorySize, LDS_BYTES) != hipSuccess) { fprintf(stderr, "kernel_launch: hipFuncSetAttribute failed\n"); grid = -1; return; }
        if (hipOccupancyMaxActiveBlocksPerMultiprocessor(&per_cu, (const void*)fwd_kernel, NTHR, LDS_BYTES) != hipSuccess || per_cu < 1) { fprintf(stderr, "kernel_launch: occupancy query reports %d\n", per_cu); }
        (void)hipGetLastError();
        grid = cus;
        if (grid > 256) grid = 256;
        while (grid > 1 && (M % grid != 0 || M / grid > 256)) --grid;
        if (grid != 256) fprintf(stderr, "kernel_launch: note: grid %d\n", grid);
    }
    if (grid < 0) return;
    if (hipMemsetAsync((char*)d_ws + WS_CTL, 0, CTL_ZERO_BYTES, stream) != hipSuccess) { fprintf(stderr, "kernel_launch: memset failed\n"); return; }
    Args a{};
    for (int i = 0; i < 33; ++i) a.in[i] = (const float*)d_in[i];
    a.out = (float*)d_out; a.ws = (unsigned char*)d_ws;
#if MK_PER_PHASE
    for (int p = 0; p < N_PHASES; ++p) { a.ph_lo = p; a.ph_hi = p + 1; a.use_bar = 0; a.pad = 0; hipLaunchKernelGGL(fwd_kernel, dim3(grid), dim3(NTHR), LDS_BYTES, stream, a); }
#else
    a.ph_lo = 0; a.ph_hi = N_PHASES; a.use_bar = 1; a.pad = 0;
    hipLaunchKernelGGL(fwd_kernel, dim3(grid), dim3(NTHR), LDS_BYTES, stream, a);
#endif
    const hipError_t le = hipPeekAtLastError();
    if (le != hipSuccess) fprintf(stderr, "kernel_launch: launch failed: %s\n", hipGetErrorName(le));
}
```

```cpp
#include <hip/hip_runtime.h>
#include <cstdio>
#include <cstdint>
#ifndef HD
#define HD __host__ __device__ __forceinline__
#endif
__device__ __forceinline__ int opq_tid() { int t = (int)threadIdx.x; asm volatile("" : "+v"(t)); return t; }
typedef float f32x2_cv __attribute__((ext_vector_type(2))); typedef __bf16 bf16x2_cv __attribute__((ext_vector_type(2)));
__device__ __forceinline__ unsigned cvtpk_hw(float lo, float hi) { f32x2_cv v = {lo, hi}; bf16x2_cv b = __builtin_convertvector(v, bf16x2_cv); return __builtin_bit_cast(unsigned, b); }
#ifdef CHAOS
#ifndef CHAOS_MASK
#define CHAOS_MASK 0xff
#endif
__device__ __forceinline__ void chaos_point(unsigned k) {
    const unsigned t = (unsigned)__builtin_amdgcn_s_memtime();
    unsigned r = (t >> 3) * 2654435761u + k * 40503u + (unsigned)__builtin_amdgcn_s_getreg(63492) * 97u;
    r ^= r >> 15;
    if ((r & 3u) == 0u) { if (r & 4u) __builtin_amdgcn_s_sleep(13); if (r & 8u) __builtin_amdgcn_s_sleep(37); if (r & 16u) __builtin_amdgcn_s_sleep(90); }
}
#define CHAOS_POINT(grp, k) do { if ((CHAOS_MASK) & (grp)) chaos_point(k); } while (0)
#else
#define CHAOS_POINT(grp, k) do {} while (0)
#endif

#if defined(__HIP__)
typedef float cf __attribute__((ext_vector_type(2)));
HD cf mk(float a, float b) { return (cf){a, b}; }
HD cf cadd(cf a, cf b) { return a + b; }
HD cf csub(cf a, cf b) { return a - b; }
#if defined(__HIP_DEVICE_COMPILE__) && !defined(FFT_NO_ASM)
HD cf cmul(cf a, cf b) { cf t, r;
    asm("v_pk_mul_f32 %0, %1, %2 op_sel:[1,1] op_sel_hi:[0,1]" : "=v"(t) : "v"(a), "v"(b));
    asm("v_pk_fma_f32 %0, %1, %2, %3 op_sel:[0,0,0] op_sel_hi:[1,0,1] neg_lo:[0,0,1]" : "=v"(r) : "v"(a), "v"(b), "v"(t)); return r; }
HD cf cmulc(cf a, cf b) { cf t, r;
    asm("v_pk_mul_f32 %0, %1, %2 op_sel:[1,1] op_sel_hi:[0,1]" : "=v"(t) : "v"(a), "v"(b));
    asm("v_pk_fma_f32 %0, %1, %2, %3 op_sel:[0,0,0] op_sel_hi:[1,0,1] neg_hi:[0,0,1]" : "=v"(r) : "v"(a), "v"(b), "v"(t)); return r; }
HD cf cmul_s(cf a, cf b) { cf t, r;
    asm("v_pk_mul_f32 %0, %1, %2 op_sel:[1,1] op_sel_hi:[0,1]" : "=v"(t) : "v"(a), "s"(b));
    asm("v_pk_fma_f32 %0, %1, %2, %3 op_sel:[0,0,0] op_sel_hi:[1,0,1] neg_lo:[0,0,1]" : "=v"(r) : "v"(a), "s"(b), "v"(t)); return r; }
HD cf cmulc_s(cf a, cf b) { cf t, r;
    asm("v_pk_mul_f32 %0, %1, %2 op_sel:[1,1] op_sel_hi:[0,1]" : "=v"(t) : "v"(a), "s"(b));
    asm("v_pk_fma_f32 %0, %1, %2, %3 op_sel:[0,0,0] op_sel_hi:[1,0,1] neg_hi:[0,0,1]" : "=v"(r) : "v"(a), "s"(b), "v"(t)); return r; }
HD cf add_mi(cf a, cf b) { cf r; asm("v_pk_add_f32 %0, %1, %2 op_sel:[0,1] op_sel_hi:[1,0] neg_hi:[0,1]" : "=v"(r) : "v"(a), "v"(b)); return r; }
HD cf add_pi(cf a, cf b) { cf r; asm("v_pk_add_f32 %0, %1, %2 op_sel:[0,1] op_sel_hi:[1,0] neg_lo:[0,1]" : "=v"(r) : "v"(a), "v"(b)); return r; }
#else
HD cf cmul(cf a, cf b) { return mk(a.x * b.x - a.y * b.y, a.x * b.y + a.y * b.x); }
HD cf cmulc(cf a, cf b) { return mk(a.x * b.x + a.y * b.y, a.y * b.x - a.x * b.y); }
HD cf cmul_s(cf a, cf b) { return cmul(a, b); }
HD cf cmulc_s(cf a, cf b) { return cmulc(a, b); }
HD cf add_mi(cf a, cf b) { return mk(a.x + b.y, a.y - b.x); }
HD cf add_pi(cf a, cf b) { return mk(a.x - b.y, a.y + b.x); }
#endif
HD cf cscale(cf a, float s) { return a * s; }
#else
struct cf { float x, y; };
HD cf mk(float a, float b) { cf r; r.x = a; r.y = b; return r; }
HD cf cadd(cf a, cf b) { return mk(a.x + b.x, a.y + b.y); }
HD cf csub(cf a, cf b) { return mk(a.x - b.x, a.y - b.y); }
HD cf cmul(cf a, cf b) { return mk(a.x * b.x - a.y * b.y, a.x * b.y + a.y * b.x); }
HD cf cmulc(cf a, cf b) { return mk(a.x * b.x + a.y * b.y, a.y * b.x - a.x * b.y); }
HD cf cmul_s(cf a, cf b) { return cmul(a, b); }
HD cf cmulc_s(cf a, cf b) { return cmulc(a, b); }
HD cf add_mi(cf a, cf b) { return mk(a.x + b.y, a.y - b.x); }
HD cf add_pi(cf a, cf b) { return mk(a.x - b.y, a.y + b.x); }
HD cf cscale(cf a, float s) { return mk(a.x * s, a.y * s); }
#endif
template <bool INV> HD cf cmulw(cf a, cf w) { return INV ? cmulc(a, w) : cmul(a, w); }
template <bool INV> HD cf cmulw_s(cf a, cf w) { return INV ? cmulc_s(a, w) : cmul_s(a, w); }

template <bool INV, bool ROT2 = false> HD void dft4(cf& a0, cf& a1, cf& a2, cf& a3) {
    const cf t0 = ROT2 ? (INV ? add_pi(a0, a2) : add_mi(a0, a2)) : cadd(a0, a2), t1 = ROT2 ? (INV ? add_mi(a0, a2) : add_pi(a0, a2)) : csub(a0, a2), t2 = cadd(a1, a3), t3 = csub(a1, a3);
    a0 = cadd(t0, t2); a2 = csub(t0, t2);
    if (!INV) { a1 = add_mi(t1, t3); a3 = add_pi(t1, t3); }
    else      { a1 = add_pi(t1, t3); a3 = add_mi(t1, t3); }
}
template <bool INV> HD void dft16(cf (&x)[16]) {
#pragma unroll
    for (int n1 = 0; n1 < 4; ++n1) dft4<INV>(x[n1], x[n1 + 4], x[n1 + 8], x[n1 + 12]);
    const float c1 = 0.92387953251128674f, s1 = 0.38268343236508977f, r2 = 0.70710678118654752f;
    const cf W1 = mk(c1, -s1), W2 = mk(r2, -r2), W3 = mk(s1, -c1), W6 = mk(-r2, -r2), W9 = mk(-c1, s1);
    x[1 + 4 * 1] = cmulw_s<INV>(x[1 + 4 * 1], W1);
    x[1 + 4 * 2] = cmulw_s<INV>(x[1 + 4 * 2], W2);
    x[1 + 4 * 3] = cmulw_s<INV>(x[1 + 4 * 3], W3);
    x[2 + 4 * 1] = cmulw_s<INV>(x[2 + 4 * 1], W2);
    x[2 + 4 * 3] = cmulw_s<INV>(x[2 + 4 * 3], W6);
    x[3 + 4 * 1] = cmulw_s<INV>(x[3 + 4 * 1], W3);
    x[3 + 4 * 2] = cmulw_s<INV>(x[3 + 4 * 2], W6);
    x[3 + 4 * 3] = cmulw_s<INV>(x[3 + 4 * 3], W9);
#pragma unroll
    for (int k2 = 0; k2 < 4; ++k2) { if (k2 == 2) dft4<INV, true>(x[0 + 4 * k2], x[1 + 4 * k2], x[2 + 4 * k2], x[3 + 4 * k2]); else dft4<INV>(x[0 + 4 * k2], x[1 + 4 * k2], x[2 + 4 * k2], x[3 + 4 * k2]); }
    cf t;
    t = x[1]; x[1] = x[4]; x[4] = t;   t = x[2]; x[2] = x[8]; x[8] = t;   t = x[3]; x[3] = x[12]; x[12] = t;
    t = x[6]; x[6] = x[9]; x[9] = t;   t = x[7]; x[7] = x[13]; x[13] = t; t = x[11]; x[11] = x[14]; x[14] = t;
}
template <bool INV> HD void twiddle16(cf (&x)[16], cf w1) {
    cf w = w1;
#pragma unroll
    for (int k = 1; k < 16; ++k) { x[k] = cmulw<INV>(x[k], w); if (k < 15) w = cmul(w, w1); }
}
constexpr int FFT_HALF = 4352;
constexpr int FFT_WORK = 2 * FFT_HALF;
HD int fphys(int h, int idx) { return h * FFT_HALF + idx + (idx >> 4); }

HD void geo1(int tid, int& h, int& j) { const int w = tid >> 6, l = tid & 63; h = l >> 5; j = 32 * w + (l & 31); }
HD void geo2(int tid, int& h, int& k1, int& j2) { h = tid >> 8; k1 = (tid >> 4) & 15; j2 = tid & 15; }
HD void geo3(int tid, int& h, int& blk) { h = tid >> 8; blk = tid & 255; }

HD int fbase1(int h, int j) { return h * FFT_HALF + j + (j >> 4); }
HD int fbase2(int h, int k1, int j2) { return h * FFT_HALF + 272 * k1 + j2; }
HD int fbase3(int h, int blk) { return h * FFT_HALF + 17 * blk; }
template <class L> HD void fwd_pass1(L lds, int b1, cf w4096j, cf (&x)[16]) {
    dft16<false>(x); twiddle16<false>(x, w4096j);
#pragma unroll
    for (int k = 0; k < 16; ++k) lds.st(b1 + 272 * k, x[k]);
}
template <class L> HD void fwd_pass2(L lds, int b2, cf w256j) {
    cf x[16];
#pragma unroll
    for (int m = 0; m < 16; ++m) x[m] = lds.ld(b2 + 17 * m);
    dft16<false>(x); twiddle16<false>(x, w256j);
#pragma unroll
    for (int k = 0; k < 16; ++k) lds.st(b2 + 17 * k, x[k]);
}
template <class L> HD void fwd_pass3_keep(L lds, int b3, cf (&x)[16]) {
#pragma unroll
    for (int m = 0; m < 16; ++m) x[m] = lds.ld(b3 + m);
    dft16<false>(x);
}
template <class L> HD void mid_pass3(L lds, int b3, const cf (&K)[16]) {
    cf x[16];
#pragma unroll
    for (int m = 0; m < 16; ++m) x[m] = lds.ld(b3 + m);
    dft16<false>(x);
#pragma unroll
    for (int k = 0; k < 16; ++k) x[k] = cmul(x[k], K[k]);
    dft16<true>(x);
#pragma unroll
    for (int m = 0; m < 16; ++m) lds.st(b3 + m, x[m]);
}
template <class L> HD void inv_pass2(L lds, int b2, cf w256j) {
    cf x[16];
#pragma unroll
    for (int k = 0; k < 16; ++k) x[k] = lds.ld(b2 + 17 * k);
    twiddle16<true>(x, w256j); dft16<true>(x);
#pragma unroll
    for (int m = 0; m < 16; ++m) lds.st(b2 + 17 * m, x[m]);
}
template <class L> HD void inv_pass1(L lds, int b1, cf w4096j, cf (&x)[16]) {
#pragma unroll
    for (int k = 0; k < 16; ++k) x[k] = lds.ld(b1 + 272 * k);
    twiddle16<true>(x, w4096j); dft16<true>(x);
}
#ifndef PG8_WGM
#define PG8_WGM 8
#endif
namespace pg8 {
#define PG8_LAS __attribute__((address_space(3)))
typedef unsigned short bf16_t;
typedef short bf16x8 __attribute__((ext_vector_type(8)));
typedef float f32x4 __attribute__((ext_vector_type(4)));
typedef unsigned u32x4 __attribute__((ext_vector_type(4)));
constexpr int BM = 256, BK = 64, HALF = 128, HTB = HALF * BK * 2  , STAGE_BYTES = 8 * HTB, NXCD = 8, WGM = PG8_WGM;

__host__ __device__ __forceinline__ int lds_byte(int r, int c) { const int st = (r >> 4) * 2 + (c >> 5), rr = r & 15, cc = c & 31, ob = rr * 64 + cc * 2; return st * 1024 + (ob ^ (((ob >> 9) & 1) << 5)); }
__host__ __device__ __forceinline__ void stage_rc(int b, int& R, int& C) { const int st = b / 1024, sb = b % 1024, swz = sb ^ (((sb >> 9) & 1) << 5); R = (st >> 1) * 16 + swz / 64; C = (st & 1) * 32 + (swz % 64) / 2; }
__host__ __device__ __forceinline__ int perm32(int rho) { const int n = rho >> 4, i = rho & 15; return 8 * (i >> 2) + 4 * n + (i & 3); }

typedef int v8i_t __attribute__((ext_vector_type(8))); typedef int v4i_t __attribute__((ext_vector_type(4)));
__device__ __forceinline__ v8i_t cat8(bf16x8 a, bf16x8 b) { const v4i_t x = __builtin_bit_cast(v4i_t, a), y = __builtin_bit_cast(v4i_t, b); return __builtin_shufflevector(x, y, 0, 1, 2, 3, 4, 5, 6, 7); }
struct Unit { int pm, pn; };
struct Gemm { const bf16_t* A; const bf16_t* Bt; int M, N, K; };

struct StaticOrder {
    int nM, nN, nwg, G, c;
    __host__ __device__ void init(int M, int N, int G_, int c_) { nM = M / BM; nN = N / BM; nwg = nM * nN; G = G_; c = c_; }
    __host__ __device__ bool next(int i, Unit& u) const {
        const long L = (long)i * G + c; if (L >= nwg) return false;
        int wgid = (int)L; { const int q = nwg / NXCD, r = nwg % NXCD, xcd = wgid % NXCD, off = wgid / NXCD; wgid = (xcd < r ? xcd * (q + 1) : r * (q + 1) + (xcd - r) * q) + off; }
        const int nig = WGM * nN, gid = wgid / nig, fm = gid * WGM, gsz = (nM - fm) < WGM ? (nM - fm) : WGM;
        u.pm = fm + ((wgid % nig) % gsz); u.pn = (wgid % nig) / gsz; return true;
    }
    __device__ __forceinline__ size_t boff(const Unit&) const { return 0; }
    __device__ __forceinline__ void a_ready(const Unit&) const {}
    __device__ __forceinline__ void done(const Unit&) const {}
};

__device__ __forceinline__ unsigned cvt_pk_bf16(float lo, float hi) { unsigned r; asm volatile("v_cvt_pk_bf16_f32 %0, %1, %2" : "=v"(r) : "v"(lo), "v"(hi)); return r; }
typedef float f32x2 __attribute__((ext_vector_type(2)));
typedef unsigned u32x2 __attribute__((ext_vector_type(2)));
__device__ __forceinline__ float row_rs(const float* ssp, int row, int fq) {
    if (!ssp) return 1.0f;
    const f32x4 q = *(const f32x4*)(ssp + (size_t)row * 16 + 4 * fq); float s = (q[0] + q[1]) + (q[2] + q[3]);
    s += __shfl_xor(s, 16); s += __shfl_xor(s, 32);
    return __builtin_amdgcn_rsqf(s * (1.0f / 1024.0f) + 1e-6f);
}
__device__ __forceinline__ void row_rs8(const float* ssp, int row0, int fq, float (&rs)[2][4]) {
    if (!ssp) {
#pragma unroll
        for (int ai = 0; ai < 2; ++ai)
#pragma unroll
            for (int m = 0; m < 4; ++m) rs[ai][m] = 1.0f;
        return; }
    f32x4 q[2][4];
#pragma unroll
    for (int ai = 0; ai < 2; ++ai)
#pragma unroll
        for (int m = 0; m < 4; ++m) q[ai][m] = *(const f32x4*)(ssp + (size_t)(row0 + ai * HALF + m * 16) * 16 + 4 * fq);
#pragma unroll
    for (int ai = 0; ai < 2; ++ai)
#pragma unroll
        for (int m = 0; m < 4; ++m) { float s = (q[ai][m][0] + q[ai][m][1]) + (q[ai][m][2] + q[ai][m][3]); s += __shfl_xor(s, 16); s += __shfl_xor(s, 32); rs[ai][m] = __builtin_amdgcn_rsqf(s * (1.0f / 1024.0f) + 1e-6f); }
}
__device__ __forceinline__ f32x4 row_rs4_swap(const float* ssp, int rowbase, int fr, int fq) {
    if (!ssp) return (f32x4){1.f, 1.f, 1.f, 1.f};
    const f32x4 q = *(const f32x4*)(ssp + (size_t)(rowbase + 4 * fq + (fr >> 2)) * 16 + 4 * (fr & 3)); float s = (q[0] + q[1]) + (q[2] + q[3]);
    s += __shfl_xor(s, 1); s += __shfl_xor(s, 2);
    const float rs = __builtin_amdgcn_rsqf(s * (1.0f / 1024.0f) + 1e-6f);
    f32x4 o;
#pragma unroll
    for (int r = 0; r < 4; ++r) o[r] = __shfl(rs, 16 * fq + 4 * r);
    return o;
}
template <bool F8 = false> struct EpiBf16T {
    static constexpr bool PERM = true, AFTER_DRAIN = false, SWAP = false, FP8 = F8;
    bf16_t* O; int ldc; const float* ss; float descale;
    __device__ __forceinline__ void operator()(const f32x4 (&acc)[2][2][4][2], const Unit& u, int wr, int wc, int fr, int fq) const {
        const int row0 = u.pm * BM + wr * 64 + fr, col0 = u.pn * BM + wc * 32 + 8 * fq;
        float rsa[2][4]; row_rs8(ss, row0, fq, rsa);
#pragma unroll
        for (int ai = 0; ai < 2; ++ai)
#pragma unroll
            for (int m = 0; m < 4; ++m) { bf16_t* rowp = O + (size_t)(row0 + ai * HALF + m * 16) * ldc + col0; const float rs = F8 ? rsa[ai][m] * descale : rsa[ai][m];
#pragma unroll
                for (int bj = 0; bj < 2; ++bj) { const f32x4 v0 = acc[ai][bj][m][0] * rs, v1 = acc[ai][bj][m][1] * rs;
                    u32x4 w; w.x = cvt_pk_bf16(v0[0], v0[1]); w.y = cvt_pk_bf16(v0[2], v0[3]); w.z = cvt_pk_bf16(v1[0], v1[1]); w.w = cvt_pk_bf16(v1[2], v1[3]);
                    *(u32x4*)(rowp + bj * HALF) = w; } }
    }
};
typedef EpiBf16T<false> EpiBf16;
struct EpiQKV {
    static constexpr bool PERM = true, AFTER_DRAIN = false, SWAP = false, FP8 = false;
    bf16_t* Q; bf16_t* Kb; bf16_t* Vb; const float* cosT; const float* sinT; const float* ss;
    __device__ __forceinline__ void operator()(const f32x4 (&acc)[2][2][4][2], const Unit& u, int wr, int wc, int fr, int fq) const {
        const int row0 = u.pm * BM + wr * 64 + fr;
        float rsa[2][4]; row_rs8(ss, row0, fq, rsa);
#pragma unroll
        for (int bj = 0; bj < 2; ++bj) {
            const int slot0 = u.pn * BM + bj * HALF + wc * 32 + 8 * fq;
            if (slot0 < 640) {
                const int head = slot0 >> 6, j4 = ((slot0 & 63) >> 3) * 4;
#pragma unroll
                for (int am = 0; am < 4; ++am) {
                    f32x4 c[2], sn[2];
                    const int tofs = ((row0 & 4095) + (am >> 1) * HALF + 2 * (am & 1) * 16) * 32 + j4;
                    const __attribute__((address_space(1))) float* cb = (const __attribute__((address_space(1))) float*)(cosT + tofs); const __attribute__((address_space(1))) float* sb = (const __attribute__((address_space(1))) float*)(sinT + tofs); asm volatile("" : "+v"(cb), "+v"(sb));
#pragma unroll
                    for (int h = 0; h < 2; ++h) { c[h] = *(const __attribute__((address_space(1))) f32x4*)(cb + h * 512); sn[h] = *(const __attribute__((address_space(1))) f32x4*)(sb + h * 512); }
#pragma unroll
                    for (int h = 0; h < 2; ++h) { const int ai = am >> 1, m = 2 * (am & 1) + h; const int row = row0 + ai * HALF + m * 16;
                        const float rs = rsa[ai][m]; const f32x4 lo = acc[ai][bj][m][0] * rs, hi = acc[ai][bj][m][1] * rs;
                        const f32x4 olo = lo * c[h] - hi * sn[h], ohi = hi * c[h] + lo * sn[h];
                        bf16_t* dst = head < 8 ? Q + (size_t)row * 512 + head * 64 + j4 : Kb + (size_t)row * 128 + (head - 8) * 64 + j4;
                        u32x2 w0, w1; w0.x = cvt_pk_bf16(olo[0], olo[1]); w0.y = cvt_pk_bf16(olo[2], olo[3]); w1.x = cvt_pk_bf16(ohi[0], ohi[1]); w1.y = cvt_pk_bf16(ohi[2], ohi[3]);
                        *(u32x2*)dst = w0; *(u32x2*)(dst + 32) = w1; } }
            } else {
#pragma unroll
                for (int ai = 0; ai < 2; ++ai)
#pragma unroll
                    for (int m = 0; m < 4; ++m) { const int row = row0 + ai * HALF + m * 16; const float rs = rsa[ai][m]; const f32x4 v0 = acc[ai][bj][m][0] * rs, v1 = acc[ai][bj][m][1] * rs;
                        u32x4 w; w.x = cvt_pk_bf16(v0[0], v0[1]); w.y = cvt_pk_bf16(v0[2], v0[3]); w.z = cvt_pk_bf16(v1[0], v1[1]); w.w = cvt_pk_bf16(v1[2], v1[3]);
                        *(u32x4*)(Vb + (size_t)row * 128 + (slot0 - 640)) = w; }
            }
        }
    }
};
struct EpiT {
    static constexpr bool PERM = false, AFTER_DRAIN = false, SWAP = true, FP8 = false;
    bf16_t* O; int nch; int ts_shift; const float* ss;
    __device__ __forceinline__ void operator()(const f32x4 (&acc)[2][2][4][2], const Unit& u, int wr, int wc, int fr, int fq) const {
        const int rowt = u.pm * BM, b = rowt >> ts_shift, tb = (rowt & ((1 << ts_shift) - 1)) + wr * 64 + 4 * fq;
#pragma unroll
        for (int ai = 0; ai < 2; ++ai) {
            f32x4 rsv[4];
#pragma unroll
            for (int m = 0; m < 4; ++m) rsv[m] = row_rs4_swap(ss, rowt + wr * 64 + ai * HALF + m * 16, fr, fq);
#pragma unroll
            for (int bj = 0; bj < 2; ++bj)
#pragma unroll
                for (int n = 0; n < 2; ++n) { const int ch = u.pn * BM + bj * HALF + wc * 32 + 16 * n + fr; bf16_t* chp = O + (((size_t)(b * nch + ch)) << ts_shift) + tb + ai * HALF;
#pragma unroll
                    for (int m = 0; m < 4; ++m) { const f32x4 v = acc[ai][bj][m][n] * rsv[m]; u32x2 w; w.x = cvt_pk_bf16(v[0], v[1]); w.y = cvt_pk_bf16(v[2], v[3]);
                        *(u32x2*)(chp + m * 16) = w; } } }
    }
};
struct EpiResB {
    static constexpr bool PERM = true, AFTER_DRAIN = false, SWAP = false, FP8 = false;
    bf16_t* xb; int ldc; float* ss; bf16_t* dst;
    __device__ __forceinline__ void operator()(const f32x4 (&acc)[2][2][4][2], const Unit& u, int wr, int wc, int fr, int fq) const {
        const int row0 = u.pm * BM + wr * 64 + fr, col0 = u.pn * BM + wc * 32 + 8 * fq;
#pragma unroll
        for (int ai = 0; ai < 2; ++ai) {
            u32x4 b[4][2];
#pragma unroll
            for (int m = 0; m < 4; ++m)
#pragma unroll
                for (int bj = 0; bj < 2; ++bj) b[m][bj] = *(const u32x4*)(xb + (size_t)(row0 + ai * HALF + m * 16) * ldc + col0 + bj * HALF);
#pragma unroll
            for (int m = 0; m < 4; ++m) { const int row = row0 + ai * HALF + m * 16; bf16_t* dstp = dst + (size_t)row * ldc + col0; float sq = 0.f;
#pragma unroll
                for (int bj = 0; bj < 2; ++bj) { const f32x4 a0 = acc[ai][bj][m][0], a1 = acc[ai][bj][m][1]; const u32x4 bb = b[m][bj]; float o[8];
                    o[0] = __builtin_bit_cast(float, bb.x << 16) + a0[0]; o[1] = __builtin_bit_cast(float, bb.x & 0xffff0000u) + a0[1];
                    o[2] = __builtin_bit_cast(float, bb.y << 16) + a0[2]; o[3] = __builtin_bit_cast(float, bb.y & 0xffff0000u) + a0[3];
                    o[4] = __builtin_bit_cast(float, bb.z << 16) + a1[0]; o[5] = __builtin_bit_cast(float, bb.z & 0xffff0000u) + a1[1];
                    o[6] = __builtin_bit_cast(float, bb.w << 16) + a1[2]; o[7] = __builtin_bit_cast(float, bb.w & 0xffff0000u) + a1[3];
#pragma unroll
                    for (int i = 0; i < 8; ++i) sq += o[i] * o[i];
                    u32x4 w; w.x = cvt_pk_bf16(o[0], o[1]); w.y = cvt_pk_bf16(o[2], o[3]); w.z = cvt_pk_bf16(o[4], o[5]); w.w = cvt_pk_bf16(o[6], o[7]);
                    *(u32x4*)(dstp + bj * HALF) = w; }
                if (ss) { sq += __shfl_xor(sq, 16); sq += __shfl_xor(sq, 32); if (fq == 0) ss[(size_t)row * 16 + u.pn * 4 + wc] = sq; } } }
    }
};
typedef float f32x2e __attribute__((ext_vector_type(2)));
__device__ __forceinline__ f32x2e silu_mul_pk(f32x2e g, f32x2e up) {
    const f32x2e t = g * (-1.44269504088896f); f32x2e e; e.x = __builtin_amdgcn_exp2f(t.x); e.y = __builtin_amdgcn_exp2f(t.y);
    const f32x2e d = e + 1.0f; f32x2e r; r.x = __builtin_amdgcn_rcpf(d.x); r.y = __builtin_amdgcn_rcpf(d.y);
    return (g * r) * up;
}
template <bool SCALE, bool F8 = false, bool F8OUT = false> struct EpiSwiglu {
    static constexpr bool PERM = true, AFTER_DRAIN = false, SWAP = false, FP8 = F8;
    bf16_t* O; int ldc; const float* ss;
    __device__ __forceinline__ void operator()(const f32x4 (&acc)[2][2][4][2], const Unit& u, int wr, int wc, int fr, int fq) const {
        const int row0 = u.pm * BM + wr * 64 + fr, col0 = u.pn * 128 + wc * 32 + 8 * fq;
        float rsa[2][4]; if (SCALE) row_rs8(ss, row0, fq, rsa);
#pragma unroll
        for (int ai = 0; ai < 2; ++ai)
#pragma unroll
            for (int m = 0; m < 4; ++m) { const int row = row0 + ai * HALF + m * 16; float sc = F8 ? 0.03125f : 1.0f; if (SCALE) sc *= rsa[ai][m];
                f32x2e o[4];
#pragma unroll
                for (int n = 0; n < 2; ++n) { f32x4 g = acc[ai][0][m][n], up = acc[ai][1][m][n]; if (SCALE || F8) { g = g * sc; up = up * sc; }
                    o[2 * n] = silu_mul_pk((f32x2e){g[0], g[1]}, (f32x2e){up[0], up[1]}); o[2 * n + 1] = silu_mul_pk((f32x2e){g[2], g[3]}, (f32x2e){up[2], up[3]}); }
                if (F8OUT) { int w0 = 0, w1 = 0; w0 = __builtin_amdgcn_cvt_pk_fp8_f32(o[0].x * 4.0f, o[0].y * 4.0f, w0, false); w0 = __builtin_amdgcn_cvt_pk_fp8_f32(o[1].x * 4.0f, o[1].y * 4.0f, w0, true);
                    w1 = __builtin_amdgcn_cvt_pk_fp8_f32(o[2].x * 4.0f, o[2].y * 4.0f, w1, false); w1 = __builtin_amdgcn_cvt_pk_fp8_f32(o[3].x * 4.0f, o[3].y * 4.0f, w1, true);
                    u32x2 w8; w8.x = (unsigned)w0; w8.y = (unsigned)w1; *(u32x2*)((unsigned char*)O + (size_t)row * ldc + col0) = w8; }
                else { u32x4 w; w.x = cvt_pk_bf16(o[0].x, o[0].y); w.y = cvt_pk_bf16(o[1].x, o[1].y); w.z = cvt_pk_bf16(o[2].x, o[2].y); w.w = cvt_pk_bf16(o[3].x, o[3].y);
                    *(u32x4*)(O + (size_t)row * ldc + col0) = w; } }
    }
};
template <class Epi, class Sched, bool ALIGN_EPI = false, bool SP2 = false>
__device__ __forceinline__ void gemm_phase(PG8_LAS unsigned char* lds, const Gemm g, const Sched& S, const Epi& E) {
    const int tid = opq_tid(), wid = __builtin_amdgcn_readfirstlane(tid >> 6), lane = tid & 63, wr = wid >> 2, wc = wid & 3, fr = lane & 15, fq = lane >> 4;
    const int K = g.K, nt = K / BK;
    unsigned voffA[2], voffB[2];
#pragma unroll
    for (int i = 0; i < 2; ++i) { int R, C; stage_rc(tid * 16 + i * 8192, R, C); const int Rb = Epi::PERM ? ((R & ~31) + perm32(R & 31)) : R;
        voffA[i] = (unsigned)(R * K + C) * 2u; voffB[i] = (unsigned)(Rb * K + C) * 2u; }
    const size_t kstep = (size_t)(BK * 2);
    const size_t hstep = (size_t)HALF * K * 2;
    const size_t tstep = 2 * hstep;
    const unsigned ldsw = (unsigned)wid * 1024u;
    const int aoff = lds_byte(wr * 64 + fr, fq * 8), boff = lds_byte(wc * 32 + fr, fq * 8);
#define PG8_SA(b, h) (((b) * 2 + (h)) * HTB)
#define PG8_SB(b, h) ((4 + (b) * 2 + (h)) * HTB)
#define PG8_STAGE(bufoff, gbase, voff) do { _Pragma("unroll") for (int _i = 0; _i < 2; ++_i) \
        __builtin_amdgcn_global_load_lds((const unsigned*)((const char*)(gbase) + (voff)[_i]), (PG8_LAS unsigned*)(lds + (bufoff) + ldsw + _i * 8192), 16, 0, 0); } while (0)
#define PG8_LDA(dst, b, h) do { if constexpr (Epi::FP8) { _Pragma("unroll") for (int m = 0; m < 4; ++m) dst##8[m] = cat8(*(const PG8_LAS bf16x8*)(lds + PG8_SA(b, h) + aoff + m * 2048), *(const PG8_LAS bf16x8*)(lds + PG8_SA(b, h) + aoff + m * 2048 + 1024)); } else { \
        _Pragma("unroll") for (int m = 0; m < 4; ++m) _Pragma("unroll") for (int k = 0; k < 2; ++k) dst[m][k] = *(const PG8_LAS bf16x8*)(lds + PG8_SA(b, h) + aoff + m * 2048 + k * 1024); } } while (0)
#define PG8_LDB(dst, b, h) do { if constexpr (Epi::FP8) { _Pragma("unroll") for (int n = 0; n < 2; ++n) dst##8[n] = cat8(*(const PG8_LAS bf16x8*)(lds + PG8_SB(b, h) + boff + n * 2048), *(const PG8_LAS bf16x8*)(lds + PG8_SB(b, h) + boff + n * 2048 + 1024)); } else { \
        _Pragma("unroll") for (int n = 0; n < 2; ++n) _Pragma("unroll") for (int k = 0; k < 2; ++k) dst[n][k] = *(const PG8_LAS bf16x8*)(lds + PG8_SB(b, h) + boff + n * 2048 + k * 1024); } } while (0)
#define PG8_MMA(ai, bj, At, Bt) do { __builtin_amdgcn_s_setprio(1); if constexpr (Epi::FP8) { _Pragma("unroll") for (int m = 0; m < 4; ++m) _Pragma("unroll") for (int n = 0; n < 2; ++n) \
        asm volatile("v_mfma_scale_f32_16x16x128_f8f6f4 %0, %1, %2, %0, %3, %3 op_sel_hi:[0,0,0]" : "+v"(acc[ai][bj][m][n]) : "v"(Bt##8[n]), "v"(At##8[m]), "v"(f8one)); } else { \
        _Pragma("unroll") for (int m = 0; m < 4; ++m) _Pragma("unroll") for (int n = 0; n < 2; ++n) _Pragma("unroll") for (int k = 0; k < 2; ++k) \
        acc[ai][bj][m][n] = Epi::SWAP ? __builtin_amdgcn_mfma_f32_16x16x32_bf16(At[m][k], Bt[n][k], acc[ai][bj][m][n], 0, 0, 0) : __builtin_amdgcn_mfma_f32_16x16x32_bf16(Bt[n][k], At[m][k], acc[ai][bj][m][n], 0, 0, 0); } __builtin_amdgcn_s_setprio(0); } while (0)
#define PG8_WAIT_V(n) asm volatile("s_waitcnt vmcnt(" #n ")" ::: "memory")
#define PG8_WAIT_L(n) asm volatile("s_waitcnt lgkmcnt(" #n ")" ::: "memory")
#define PG8_BAR __builtin_amdgcn_s_barrier()
#define PG8_SCHED __builtin_amdgcn_sched_barrier(0)
#ifdef DIAG
    unsigned long long dg_k = 0, dg_e = 0, dg_t1 = 0, dg_t2 = 0; const unsigned long long dg_t0 = wall_clock64();
#endif
    Unit cur, nxt; int ui = 0;
    if (!S.next(0, cur)) return;
    f32x4 acc[2][2][4][2];
#pragma unroll
    for (int a = 0; a < 2; ++a)
#pragma unroll
        for (int b = 0; b < 2; ++b)
#pragma unroll
            for (int m = 0; m < 4; ++m)
#pragma unroll
                for (int n = 0; n < 2; ++n) acc[a][b][m][n] = (f32x4){0.f, 0.f, 0.f, 0.f};
    bf16x8 At[4][2], B0[2][2], B1[2][2]; v8i_t At8[4], B08[2], B18[2];
    int f8one = 0x7F7F7F7F; asm volatile("" : "+v"(f8one));
    const char* cA = (const char*)g.A + (size_t)cur.pm * tstep; const char* cB = (const char*)g.Bt + S.boff(cur) + (size_t)cur.pn * tstep;
    S.a_ready(cur);
    if constexpr (SP2) {
        PG8_STAGE(PG8_SB(0, 0), cB, voffB); PG8_STAGE(PG8_SB(0, 1), cB + hstep, voffB); PG8_STAGE(PG8_SA(0, 0), cA, voffA); PG8_STAGE(PG8_SA(0, 1), cA + hstep, voffA);
        if (wr == 1) PG8_BAR;
        PG8_WAIT_V(2); PG8_BAR;
        PG8_STAGE(PG8_SB(1, 0), cB + kstep, voffB); PG8_STAGE(PG8_SA(1, 0), cA + kstep, voffA); PG8_STAGE(PG8_SB(1, 1), cB + hstep + kstep, voffB);
        PG8_WAIT_V(6); PG8_BAR;
    } else {
        PG8_STAGE(PG8_SB(0, 0), cB, voffB); PG8_STAGE(PG8_SA(0, 0), cA, voffA); PG8_STAGE(PG8_SB(0, 1), cB + hstep, voffB); PG8_STAGE(PG8_SA(0, 1), cA + hstep, voffA);
        if (wr == 1) PG8_BAR;
        PG8_WAIT_V(4); PG8_BAR;
        PG8_STAGE(PG8_SB(1, 0), cB + kstep, voffB); PG8_STAGE(PG8_SA(1, 0), cA + kstep, voffA); PG8_STAGE(PG8_SB(1, 1), cB + hstep + kstep, voffB);
        PG8_WAIT_V(6); PG8_BAR;
    }
    for (;;) {
        const bool has_next = S.next(ui + 1, nxt);
        const char* nA = has_next ? (const char*)g.A + (size_t)nxt.pm * tstep : cA; const char* nB = has_next ? (const char*)g.Bt + S.boff(nxt) + (size_t)nxt.pn * tstep : cB;
#ifdef DIAG
        dg_t1 = wall_clock64();
#endif
        CHAOS_POINT(4, 41);
        for (int t = 0; t < nt; t += 2) { CHAOS_POINT(8, 42);
            const bool last = (t == nt - 2);
            const char* a1 = cA + (size_t)(t + 1) * kstep;
            const char* a2 = last ? nA : cA + (size_t)(t + 2) * kstep; const char* b2 = last ? nB : cB + (size_t)(t + 2) * kstep;
            const char* a3 = a2 + kstep; const char* b3 = b2 + kstep;
            if (last && has_next) S.a_ready(nxt);
            if constexpr (SP2) {
            PG8_LDB(B0, 0, 0); PG8_LDB(B1, 0, 1); PG8_SCHED; PG8_LDA(At, 0, 0); PG8_STAGE(PG8_SA(1, 1), a1 + hstep, voffA);
            PG8_WAIT_V(8); PG8_WAIT_L(0); PG8_BAR; PG8_MMA(0, 0, At, B0); PG8_MMA(0, 1, At, B1); PG8_BAR; PG8_SCHED;
            PG8_LDA(At, 0, 1); PG8_STAGE(PG8_SB(0, 0), b2, voffB); PG8_STAGE(PG8_SB(0, 1), b2 + hstep, voffB); PG8_STAGE(PG8_SA(0, 0), a2, voffA);
            PG8_WAIT_V(8); PG8_WAIT_L(0); PG8_BAR; PG8_MMA(1, 0, At, B0); PG8_MMA(1, 1, At, B1); PG8_BAR; PG8_SCHED;
            PG8_LDB(B0, 1, 0); PG8_LDB(B1, 1, 1); PG8_SCHED; PG8_LDA(At, 1, 0); PG8_STAGE(PG8_SA(0, 1), a2 + hstep, voffA);
            PG8_WAIT_V(8); PG8_WAIT_L(0); PG8_BAR; PG8_MMA(0, 0, At, B0); PG8_MMA(0, 1, At, B1); PG8_BAR; PG8_SCHED;
            PG8_LDA(At, 1, 1); PG8_STAGE(PG8_SB(1, 0), b3, voffB); PG8_STAGE(PG8_SB(1, 1), b3 + hstep, voffB); PG8_STAGE(PG8_SA(1, 0), a3, voffA);
            PG8_WAIT_V(8); PG8_WAIT_L(0); PG8_BAR; PG8_MMA(1, 0, At, B0); PG8_MMA(1, 1, At, B1); PG8_BAR; PG8_SCHED;
            } else {
            PG8_LDB(B0, 0, 0); PG8_SCHED; PG8_LDA(At, 0, 0); PG8_STAGE(PG8_SA(1, 1), a1 + hstep, voffA);
            PG8_WAIT_L(8); PG8_BAR; PG8_WAIT_L(0); PG8_MMA(0, 0, At, B0); PG8_BAR; PG8_SCHED;
            PG8_LDB(B1, 0, 1); PG8_STAGE(PG8_SB(0, 0), b2, voffB);
            PG8_BAR; PG8_WAIT_L(0); PG8_MMA(0, 1, At, B1); PG8_BAR;
            PG8_LDA(At, 0, 1); PG8_STAGE(PG8_SA(0, 0), a2, voffA);
            PG8_BAR; PG8_WAIT_L(0); PG8_MMA(1, 0, At, B0); PG8_BAR; PG8_SCHED;
            PG8_STAGE(PG8_SB(0, 1), b2 + hstep, voffB);
            PG8_WAIT_V(6); PG8_BAR; PG8_MMA(1, 1, At, B1); PG8_BAR;
            PG8_LDB(B0, 1, 0); PG8_SCHED; PG8_LDA(At, 1, 0); PG8_STAGE(PG8_SA(0, 1), a2 + hstep, voffA);
            PG8_WAIT_L(8); PG8_BAR; PG8_WAIT_L(0); PG8_MMA(0, 0, At, B0); PG8_BAR; PG8_SCHED;
            PG8_LDB(B1, 1, 1); PG8_STAGE(PG8_SB(1, 0), b3, voffB);
            PG8_BAR; PG8_WAIT_L(0); PG8_MMA(0, 1, At, B1); PG8_BAR;
            PG8_LDA(At, 1, 1); PG8_STAGE(PG8_SA(1, 0), a3, voffA);
            PG8_BAR; PG8_WAIT_L(0); PG8_MMA(1, 0, At, B0); PG8_BAR; PG8_SCHED;
            PG8_STAGE(PG8_SB(1, 1), b3 + hstep, voffB);
            PG8_WAIT_V(6); PG8_BAR; PG8_MMA(1, 1, At, B1); PG8_BAR;
            }
        }
#ifdef DIAG
        dg_t2 = wall_clock64(); dg_k += dg_t2 - dg_t1;
#endif
        if constexpr (Epi::FP8) asm volatile("s_nop 15\n\ts_nop 15" ::: "memory");
        if constexpr (ALIGN_EPI) { if (wr == 0) PG8_BAR; }
#ifndef EPI_REP
#define EPI_REP 1
#endif
        CHAOS_POINT(4, 43);
        if constexpr (!Epi::AFTER_DRAIN) { _Pragma("unroll 1") for (int er_ = 0; er_ < EPI_REP; ++er_) E(acc, cur, wr, wc, fr, fq); S.done(cur); }
#ifdef DIAG
        dg_e += wall_clock64() - dg_t2;
#endif
        if (!has_next) break;
#pragma unroll
        for (int a = 0; a < 2; ++a)
#pragma unroll
            for (int b = 0; b < 2; ++b)
#pragma unroll
                for (int m = 0; m < 4; ++m)
#pragma unroll
                    for (int n = 0; n < 2; ++n) acc[a][b][m][n] = (f32x4){0.f, 0.f, 0.f, 0.f};
        cur = nxt; cA = nA; cB = nB; ++ui;
        if constexpr (ALIGN_EPI) { if (wr == 1) PG8_BAR; }
    }
#ifdef DIAG
    if (blockIdx.x == 0 && tid == 0) { unsigned long long* dg = (unsigned long long*)(*(const PG8_LAS unsigned long long*)(lds + 139328)); atomicAdd(dg + 0, dg_k); atomicAdd(dg + 1, dg_e); atomicAdd(dg + 2, wall_clock64() - dg_t0); atomicAdd(dg + 3, (unsigned long long)(ui + 1)); }
#endif
    PG8_WAIT_V(0);
    if constexpr (!ALIGN_EPI) { if (wr == 0) PG8_BAR; }
    PG8_BAR;
    if constexpr (Epi::AFTER_DRAIN) { E.fused(acc, cur, wr, wc, fr, fq, lds, wid, lane); S.done(cur); }
#undef PG8_SA
#undef PG8_SB
#undef PG8_STAGE
#undef PG8_LDA
#undef PG8_LDB
#undef PG8_MMA
#undef PG8_WAIT_V
#undef PG8_WAIT_L
#undef PG8_BAR
#undef PG8_SCHED
}
}
#ifndef PG8_SP2
#define PG8_SP2 true
#endif
#ifndef PG8_ALIGN
#define PG8_ALIGN true
#endif
constexpr int NB = 16, SEQ = 4096, D = 1024, M = NB * SEQ;
constexpr int NH = 8, NKV = 2, HDIM = 64, AW = 512, KVW = 128;
constexpr int HYW = 512, C3 = 1536, INC = 2304;
constexpr int XH = 4, XHD = 128, XW = 512, MEML = 256, MROWS = NB * MEML;
constexpr int FF = 2816, NE = 8, FFE = 3584;
constexpr float EPS = 1e-6f;
constexpr int NWAVES = 8, NTHR = 512;
constexpr int MOE_CH_TILES = 128, MOE_NCHUNK = 4, MOE_MAX_TILES = 520, MOE_MAX_ROWS = MOE_MAX_TILES * 256, MOE_ACT_TILES = MOE_MAX_TILES - (MOE_NCHUNK - 1) * MOE_CH_TILES;

constexpr size_t al256(size_t x) { return (x + 255) & ~(size_t)255; }
constexpr size_t WS_CTL = 0, CTL_ZERO_BYTES = 1u << 20;
constexpr size_t WS_SS = CTL_ZERO_BYTES, SS_STRIDE = (size_t)M * 16;
constexpr size_t WS_COS = WS_SS + 5 * SS_STRIDE * 4, WS_SIN = WS_COS + (size_t)SEQ * 32 * 4, WS_H2 = WS_SIN + (size_t)SEQ * 32 * 4;
constexpr size_t WS_TOKE = WS_H2 + (size_t)2 * SEQ * 64 * 4, WS_TOKW = WS_TOKE + (size_t)M * 2 * 4, WS_TOKP = WS_TOKW + (size_t)M * 2 * 4;
constexpr size_t WS_ROWTOK = WS_TOKP + (size_t)M * 2 * 4, WS_TILEE = WS_ROWTOK + al256((size_t)MOE_MAX_ROWS * 4), WS_WGCNT = WS_TILEE + 4096, WS_RSROW = WS_WGCNT + (size_t)1024 * 8 * 4, WS_META = WS_RSROW + (size_t)M * 4;
constexpr size_t WS_WINA = al256(WS_META + 4096);
constexpr size_t WS_WINB = WS_WINA + (size_t)2 * 768 * D * 2;
constexpr size_t WS_WOUT = WS_WINB + (size_t)2 * C3 * D * 2;
constexpr size_t WS_XQ = WS_WOUT + (size_t)2 * D * D * 2;
constexpr size_t WS_XK = WS_XQ + (size_t)2 * XW * D * 2;
constexpr size_t WS_XV = WS_XK + (size_t)2 * XW * D * 2;
constexpr size_t WS_XO = WS_XV + (size_t)2 * XW * D * 2;
constexpr size_t WS_FGU = WS_XO + (size_t)2 * D * XW * 2;
constexpr size_t WS_FDN = WS_FGU + (size_t)2 * FF * D * 2;
constexpr size_t WS_MGU = WS_FDN + (size_t)D * FF * 2;
constexpr size_t WS_MDN = WS_MGU + (size_t)NE * 2 * FFE * D;
constexpr size_t WS_KFILT = WS_MDN + (size_t)NE * D * FFE;
constexpr size_t WS_MB = WS_KFILT + (size_t)2 * 2 * HYW * 8192 * 4;
constexpr size_t WS_KMEM = WS_MB + (size_t)MROWS * D * 2;
constexpr size_t WS_VMEMT = WS_KMEM + (size_t)MROWS * 1024 * 2;
constexpr size_t WS_HB = WS_VMEMT + (size_t)1024 * MROWS * 2;
constexpr size_t WS_R = WS_HB + (size_t)M * D * 2;
constexpr size_t WS_QB = WS_R, WS_KB = WS_QB + (size_t)M * AW * 2, WS_VB = WS_KB + (size_t)M * KVW * 2, WS_UT = WS_VB + (size_t)M * KVW * 2;
constexpr size_t WS_MIXED = WS_UT;
constexpr size_t WS_AB = WS_UT + (size_t)M * C3 * 2, WS_YT = WS_AB + (size_t)M * AW * 2, WS_KSPEC = WS_YT + (size_t)M * HYW * 2, WS_MIXEND = WS_KSPEC + (size_t)2 * 2 * HYW * 16384 * 4;
constexpr size_t WS_XQB = WS_R, WS_XOB = WS_XQB + (size_t)M * XW * 2;
constexpr size_t WS_ACT = WS_R;
constexpr size_t WS_XG = WS_R;
constexpr size_t WS_MACT = WS_XG + (size_t)MOE_MAX_ROWS * D;
constexpr size_t WS_YB = WS_MACT + (size_t)MOE_ACT_TILES * 256 * FFE;
constexpr size_t WS_MOEEND = WS_YB + (size_t)MOE_MAX_ROWS * D * 2;
constexpr size_t cmax(size_t a, size_t b) { return a > b ? a : b; }
constexpr size_t WS_END = cmax(cmax(WS_MIXEND, WS_ACT + (size_t)M * FF * 2), WS_MOEEND);
static_assert(WS_END <= (size_t)1073741824, "workspace map exceeds 1 GiB");
static_assert(WS_ACT + (size_t)M * FF * 2 <= WS_KSPEC && WS_XOB + (size_t)M * XW * 2 <= WS_KSPEC, "layer 0's later phases must not touch the filter spectra");
constexpr int CW_TMO = 0, CW_CODE = 1, CW_BAR = 4096;

constexpr int PHASE_LDS = 155648;
constexpr int LDSCTL_OFF = PHASE_LDS, MISC_OFF = LDSCTL_OFF + 64;
constexpr int LDS_BYTES = PHASE_LDS + 512;

#define GAS __attribute__((address_space(1)))
#define LAS __attribute__((address_space(3)))
typedef unsigned short bf16;
typedef unsigned v4u __attribute__((ext_vector_type(4)));
typedef unsigned v2u __attribute__((ext_vector_type(2)));
typedef float f32x4 __attribute__((ext_vector_type(4)));
typedef short bf16x8 __attribute__((ext_vector_type(8)));
typedef short s16x4 __attribute__((ext_vector_type(4)));
typedef GAS unsigned gu32;
#define RLX_AGENT __ATOMIC_RELAXED, __HIP_MEMORY_SCOPE_AGENT
#define LDS_WAIT() asm volatile("s_waitcnt lgkmcnt(0)" ::: "memory")
#define VM_WAIT() asm volatile("s_waitcnt vmcnt(0)" ::: "memory")
__device__ __forceinline__ unsigned f2bf(float f) { unsigned u = __builtin_bit_cast(unsigned, f); return (u + 0x7fffu + ((u >> 16) & 1u)) >> 16; }
__device__ __forceinline__ unsigned pk2(float lo, float hi) { return cvtpk_hw(lo, hi); }
__device__ __forceinline__ float bflo(unsigned w) { return __builtin_bit_cast(float, w << 16); }
__device__ __forceinline__ float bfhi(unsigned w) { return __builtin_bit_cast(float, w & 0xffff0000u); }
__device__ __forceinline__ float bf1(unsigned short h) { return __builtin_bit_cast(float, ((unsigned)h) << 16); }
#define XB_TMO      128
#define XB_XCNT(j)  (256  + 64 * (j))
#define XB_XSUB(j)  (1280 + 64 * (j))
#define XB_XGEN(j)  (2304 + 64 * (j))
#define XB_TOP      3328
#define XB_TOPGEN   3392
#define XCD_BAR_WORDS 3456
#define XB_SPIN_CAP (1u << 22)

__device__ __forceinline__ unsigned xb_ld(unsigned* p)              { return __hip_atomic_load(p, __ATOMIC_RELAXED, __HIP_MEMORY_SCOPE_AGENT); }
__device__ __forceinline__ unsigned xb_add(unsigned* p, unsigned v) { return __hip_atomic_fetch_add(p, v, __ATOMIC_RELAXED, __HIP_MEMORY_SCOPE_AGENT); }
__device__ __forceinline__ unsigned xb_xcc_id() { return (unsigned)__builtin_amdgcn_s_getreg((3 << 11) | 20) & 0xFu; }
#define XB_SPIN(cond, bar) do { unsigned _sp = 0; while (cond) { __builtin_amdgcn_s_sleep(1); \
    if ((++_sp & 255u) == 0u) { if (xb_ld(&(bar)[XB_TMO])) break; if (_sp > XB_SPIN_CAP) { atomicAdd(&(bar)[XB_TMO], 1u); break; } } } } while (0)

struct XcdBarrier {
    unsigned* bar; unsigned x;
    volatile LAS unsigned* st;
};

__device__ __forceinline__ XcdBarrier xcd_barrier_post(unsigned* bar, volatile LAS unsigned* st) {
    XcdBarrier b; b.bar = bar; b.x = xb_xcc_id(); b.st = st;
    if (threadIdx.x == 0) (void)xb_add(&bar[XB_XCNT(b.x)], 1u);
    return b;
}
__device__ __forceinline__ void xcd_barrier_complete(unsigned* bar, unsigned x, unsigned& nloc, unsigned& nx) {
    const unsigned G = gridDim.x * gridDim.y * gridDim.z;
    unsigned sum, cnt, mine, sp = 0u;
    for (;;) {
        sum = 0u; cnt = 0u; mine = 0u;
#pragma unroll
        for (unsigned j = 0; j < 16; ++j) { const unsigned c = xb_ld(&bar[XB_XCNT(j)]); sum += c; cnt += (c > 0u) ? 1u : 0u; mine = (j == x) ? c : mine; }
        if (sum == G) break;
        __builtin_amdgcn_s_sleep(1);
        if ((++sp & 255u) == 0u) { if (xb_ld(&bar[XB_TMO])) break; if (sp > XB_SPIN_CAP) { atomicAdd(&bar[XB_TMO], 1u); break; } }
    }
    nloc = mine > 0u ? mine : 1u; nx = cnt > 0u ? cnt : 1u;
}

__device__ __forceinline__ void xcd_barrier(const XcdBarrier& b) {
    asm volatile("s_waitcnt vmcnt(0)" ::: "memory");
    __syncthreads();
    if (threadIdx.x == 0) {
        unsigned* bar = b.bar;
        __builtin_amdgcn_s_waitcnt(0);
        unsigned nloc = b.st[0], nx = b.st[1];
        if (nloc == 0u) { xcd_barrier_complete(bar, b.x, nloc, nx); b.st[0] = nloc; b.st[1] = nx; }
        const unsigned old = xb_add(&bar[XB_XSUB(b.x)], 1u);
        const unsigned gen = old / nloc;
        if (old + 1u == (gen + 1u) * nloc) {
            __builtin_amdgcn_fence(__ATOMIC_RELEASE, "agent");
            asm volatile("s_waitcnt vmcnt(0)" ::: "memory");
            const unsigned og = xb_add(&bar[XB_TOP], 1u);
            const unsigned tg = og / nx;
            if (og + 1u == (tg + 1u) * nx) xb_add(&bar[XB_TOPGEN], 1u);
            else XB_SPIN(xb_ld(&bar[XB_TOPGEN]) == tg, bar);
            __builtin_amdgcn_fence(__ATOMIC_ACQUIRE, "agent");
            xb_add(&bar[XB_XGEN(b.x)], 1u);
            asm volatile("s_waitcnt vmcnt(0)" ::: "memory");
        } else {
            XB_SPIN(xb_ld(&bar[XB_XGEN(b.x)]) == gen, bar);
            __builtin_amdgcn_fence(__ATOMIC_ACQUIRE, "agent");
            asm volatile("s_waitcnt vmcnt(0)" ::: "memory");
        }
    }
    __syncthreads();
}
struct Args { const float* in[33]; float* out; unsigned char* ws; int ph_lo, ph_hi, use_bar, pad; };
enum InIdx { I_X = 0, I_MEM, I_MEMNORM, I_MIXNORM, I_WIN, I_SINK, I_CONVW, I_CONVB, I_FW1, I_FB1, I_FFR1, I_FW2, I_FB2, I_FFR2, I_FW3, I_SKIP, I_ANORM, I_YNORM, I_WOUT, I_XNORM,
             I_XWQ, I_XWK, I_XWV, I_XWO, I_FNORM, I_FGATE, I_FUP, I_FDOWN, I_ROUTER, I_MGATE, I_MUP, I_MDOWN, I_FINAL };

__device__ __forceinline__ float wave_sum(float v) {
#pragma unroll
    for (int o = 1; o < 64; o <<= 1) v += __shfl_xor(v, o);
    return v;
}
__device__ __forceinline__ void wg_sync() { __builtin_amdgcn_sched_barrier(0); asm volatile("s_waitcnt vmcnt(0) lgkmcnt(0)" ::: "memory"); __builtin_amdgcn_s_barrier(); asm volatile("" ::: "memory"); __builtin_amdgcn_sched_barrier(0); }

template <int MODE> __device__ __forceinline__ int rowmap(int n) {
    if (MODE == 1) return n < 640 ? ((n & ~63) + 8 * ((n & 31) >> 2) + (n & 3) + 4 * ((n >> 5) & 1)) : n;
    if (MODE == 2) return ((n >> 7) << 8) + (n & 127);
    if (MODE == 3) return ((n >> 7) << 8) + 128 + (n & 127);
    return n;
}
__device__ __forceinline__ int rowmap_rt(int mode, int n) { return mode == 1 ? rowmap<1>(n) : mode == 2 ? rowmap<2>(n) : mode == 3 ? rowmap<3>(n) : n; }
__device__ __forceinline__ void tr_item(const float* W, int ldw, int K, int col0, int ncols, bf16* WT, int mode, const float* gk, int item, LAS float* scr, int lane) {
    const int nblk = ncols / 32, kb = item / nblk, nb = item % nblk, k0 = 64 * kb, n0 = 32 * nb;
    f32x4 tv[8];
#pragma unroll
    for (int i = 0; i < 8; ++i) { const int kk = 8 * i + (lane >> 3); tv[i] = *(const f32x4*)(W + (size_t)(k0 + kk) * ldw + col0 + n0 + 4 * (lane & 7)); }
#pragma unroll
    for (int i = 0; i < 8; ++i) { const int kk = 8 * i + (lane >> 3); const float gv = gk ? gk[k0 + kk] : 1.0f; LAS float* d = scr + kk * 33 + 4 * (lane & 7);
        d[0] = gv * tv[i][0]; d[1] = gv * tv[i][1]; d[2] = gv * tv[i][2]; d[3] = gv * tv[i][3]; }
    LDS_WAIT(); asm volatile("" ::: "memory");
    const int c = lane & 7;
#pragma unroll
    for (int j = 0; j < 4; ++j) { const int n = (lane >> 3) + 8 * j; const LAS float* sp = scr + (8 * c) * 33 + n;
        v4u o; o.x = pk2(sp[0 * 33], sp[1 * 33]); o.y = pk2(sp[2 * 33], sp[3 * 33]); o.z = pk2(sp[4 * 33], sp[5 * 33]); o.w = pk2(sp[6 * 33], sp[7 * 33]);
        *(v4u*)(WT + (size_t)rowmap_rt(mode, n0 + n) * K + k0 + 8 * c) = o; }
    LDS_WAIT(); asm volatile("" ::: "memory");
}
__device__ __forceinline__ void tr_item8(const float* W, int ldw, int K, int ncols, unsigned char* WT8, int mode, float wscale, int item, LAS float* scr, int lane) {
    const int nblk = ncols / 32, kb = item / nblk, nb = item % nblk, k0 = 64 * kb, n0 = 32 * nb;
    f32x4 tv[8];
#pragma unroll
    for (int i = 0; i < 8; ++i) { const int kk = 8 * i + (lane >> 3); tv[i] = *(const f32x4*)(W + (size_t)(k0 + kk) * ldw + n0 + 4 * (lane & 7)); }
#pragma unroll
    for (int i = 0; i < 8; ++i) { const int kk = 8 * i + (lane >> 3); LAS float* d = scr + kk * 33 + 4 * (lane & 7);
        d[0] = wscale * tv[i][0]; d[1] = wscale * tv[i][1]; d[2] = wscale * tv[i][2]; d[3] = wscale * tv[i][3]; }
    LDS_WAIT(); asm volatile("" ::: "memory");
    const int n = lane >> 1, half = lane & 1; const LAS float* sp = scr + (32 * half) * 33 + n;
    v4u o[2];
#pragma unroll
    for (int q = 0; q < 8; ++q) { int w = 0;
        w = __builtin_amdgcn_cvt_pk_fp8_f32(sp[(4 * q + 0) * 33], sp[(4 * q + 1) * 33], w, false);
        w = __builtin_amdgcn_cvt_pk_fp8_f32(sp[(4 * q + 2) * 33], sp[(4 * q + 3) * 33], w, true);
        o[q >> 2][q & 3] = (unsigned)w; }
    v4u* dst = (v4u*)(WT8 + (size_t)rowmap_rt(mode, n0 + n) * K + k0 + 32 * half);
    dst[0] = o[0]; dst[1] = o[1];
    LDS_WAIT(); asm volatile("" ::: "memory");
}
__device__ __forceinline__ void rms_row(const float* xrow, const float* gain, int lane, f32x4 (&v)[4]) {
    const f32x4* xr = (const f32x4*)xrow + lane; float s = 0.f;
#pragma unroll
    for (int j = 0; j < 4; ++j) { v[j] = xr[64 * j]; s += (v[j].x * v[j].x + v[j].y * v[j].y) + (v[j].z * v[j].z + v[j].w * v[j].w); }
    const float rs = 1.0f / sqrtf(wave_sum(s) * (1.f / 1024.f) + EPS);
    const f32x4* gr = (const f32x4*)gain + lane;
#pragma unroll
    for (int j = 0; j < 4; ++j) v[j] = v[j] * rs * gr[64 * j];
}
__device__ __forceinline__ void store_row_bf16(bf16* orow, int lane, const f32x4 (&v)[4]) {
    unsigned long long* o8 = (unsigned long long*)orow + lane;
#pragma unroll
    for (int j = 0; j < 4; ++j) o8[64 * j] = (unsigned long long)pk2(v[j].x, v[j].y) | ((unsigned long long)pk2(v[j].z, v[j].w) << 32);
}
__device__ __forceinline__ void xb_rows(const float* x, bf16* o, float* ss, int nrows, int gw, int NGW, int lane) {
#pragma unroll 1
    for (int r0 = gw; r0 < nrows; r0 += 2 * NGW) {
        const int r1 = r0 + NGW; const bool on1 = r1 < nrows; const int r1c = on1 ? r1 : r0;
        const f32x4* xa = (const f32x4*)(x + (size_t)r0 * D) + lane; const f32x4* xc = (const f32x4*)(x + (size_t)r1c * D) + lane; f32x4 va[4], vc[4];
#pragma unroll
        for (int j = 0; j < 4; ++j) { va[j] = xa[64 * j]; vc[j] = xc[64 * j]; }
        float sa = 0.f, sc = 0.f;
#pragma unroll
        for (int j = 0; j < 4; ++j) { sa += (va[j].x * va[j].x + va[j].y * va[j].y) + (va[j].z * va[j].z + va[j].w * va[j].w); sc += (vc[j].x * vc[j].x + vc[j].y * vc[j].y) + (vc[j].z * vc[j].z + vc[j].w * vc[j].w); }
        sa = wave_sum(sa); sc = wave_sum(sc);
        store_row_bf16(o + (size_t)r0 * D, lane, va); if (lane < 16) ss[(size_t)r0 * 16 + lane] = lane == 0 ? sa : 0.f;
        if (on1) { store_row_bf16(o + (size_t)r1 * D, lane, vc); if (lane < 16) ss[(size_t)r1 * 16 + lane] = lane == 0 ? sc : 0.f; }
    }
}
__device__ __forceinline__ void norm_rows(const float* x, const float* gain, bf16* o, int nrows, int gw, int NGW, int lane) {
    for (int r = gw; r < nrows; r += NGW) { f32x4 v[4]; rms_row(x + (size_t)r * D, gain, lane, v); store_row_bf16(o + (size_t)r * D, lane, v); }
}

constexpr int BA_KS = 72, BA_VS = 408, BA_KROWS = 400;
constexpr int BA_K_BYTES = BA_KROWS * BA_KS * 2, BA_V_BYTES = 64 * BA_VS * 2;
static_assert(BA_K_BYTES % 16 == 0 && BA_K_BYTES + BA_V_BYTES <= PHASE_LDS, "band attention LDS");
__device__ __forceinline__ bf16x8 cat4(s16x4 a, s16x4 b) { return __builtin_shufflevector(a, b, 0, 1, 2, 3, 4, 5, 6, 7); }
__device__ __forceinline__ unsigned cvtpk(float lo, float hi) { unsigned r; asm volatile("v_cvt_pk_bf16_f32 %0, %1, %2" : "=v"(r) : "v"(lo), "v"(hi)); return r; }

__device__ __forceinline__ void band_attention_phase(LAS unsigned char* lds, const bf16* Q, const bf16* Kb, const bf16* Vb, bf16* Ao, const float* sink, int G) {
    const int tid = opq_tid(), lane = tid & 63, wave = __builtin_amdgcn_readfirstlane(tid >> 6), fr = lane & 15, fq = lane >> 4;
    LAS bf16* Ks = (LAS bf16*)lds; LAS bf16* VTs = (LAS bf16*)(lds + BA_K_BYTES);
    for (int unit = blockIdx.x; unit < NB * 32 * NKV; unit += G) {
        const int kh = unit & 1, ib = (unit >> 1) & 31, b = unit >> 6;
        const int kbase = 128 * (ib - 1);
        for (int c = tid; c < BA_KROWS * 8; c += NTHR) { const int row = c >> 3, c8 = c & 7, kpos = kbase + row;
            v4u val = (v4u){0u, 0u, 0u, 0u};
            if (row < 384 && kpos >= 0 && kpos < SEQ) val = *(const v4u*)(Kb + ((size_t)(b * SEQ + kpos)) * KVW + kh * 64 + c8 * 8);
            *(LAS v4u*)(Ks + row * BA_KS + c8 * 8) = val; }
        for (int c = tid; c < BA_KROWS * 8; c += NTHR) { const int c8 = c / BA_KROWS, key = c % BA_KROWS, kpos = kbase + key;
            v4u val = (v4u){0u, 0u, 0u, 0u};
            if (key < 384 && kpos >= 0 && kpos < SEQ) val = *(const v4u*)(Vb + ((size_t)(b * SEQ + kpos)) * KVW + kh * 64 + c8 * 8);
            LAS bf16* dst = VTs + (c8 * 8) * BA_VS + key;
            dst[0 * BA_VS] = (bf16)(val.x & 0xffffu); dst[1 * BA_VS] = (bf16)(val.x >> 16); dst[2 * BA_VS] = (bf16)(val.y & 0xffffu); dst[3 * BA_VS] = (bf16)(val.y >> 16);
            dst[4 * BA_VS] = (bf16)(val.z & 0xffffu); dst[5 * BA_VS] = (bf16)(val.z >> 16); dst[6 * BA_VS] = (bf16)(val.w & 0xffffu); dst[7 * BA_VS] = (bf16)(val.w >> 16); }
        wg_sync(); CHAOS_POINT(2, 32);
        const int g = wave >> 1, half = wave & 1, head = kh * 4 + g;
        const float snk = sink[head];
        bf16x8 qn[2];
        { const size_t t0 = (size_t)b * SEQ + 128 * ib + 64 * half;
#pragma unroll
          for (int ks = 0; ks < 2; ++ks) qn[ks] = *(const bf16x8*)(Q + (t0 + fr) * AW + head * 64 + 32 * ks + 8 * fq); }
#pragma unroll 1
        for (int qt = 0; qt < 4; ++qt) { CHAOS_POINT(2, 31);
            const int p0 = 64 * half + 16 * qt;
            const size_t t0 = (size_t)b * SEQ + 128 * ib + p0;
            bf16x8 qf[2]; qf[0] = qn[0]; qf[1] = qn[1];
            if (qt < 3) {
#pragma unroll
                for (int ks = 0; ks < 2; ++ks) qn[ks] = *(const bf16x8*)(Q + (t0 + 16 + fr) * AW + head * 64 + 32 * ks + 8 * fq); }
            f32x4 s[18];
            const LAS bf16* kbase_p = Ks + (p0 + fr) * BA_KS + 8 * fq;
            bf16x8 kfa[3][2], kfb[3][2];
#pragma unroll
            for (int jj = 0; jj < 3; ++jj)
#pragma unroll
                for (int ks = 0; ks < 2; ++ks) kfa[jj][ks] = *(const LAS bf16x8*)(kbase_p + (16 * jj) * BA_KS + 32 * ks);
#pragma unroll
            for (int gq = 0; gq < 6; ++gq) {
                if (gq < 5) {
#pragma unroll
                    for (int jj = 0; jj < 3; ++jj)
#pragma unroll
                        for (int ks = 0; ks < 2; ++ks) { const bf16x8 t = *(const LAS bf16x8*)(kbase_p + (16 * (3 * (gq + 1) + jj)) * BA_KS + 32 * ks); if (gq & 1) kfa[jj][ks] = t; else kfb[jj][ks] = t; } }
                __builtin_amdgcn_sched_barrier(0);
#pragma unroll
                for (int jj = 0; jj < 3; ++jj) { const int j = 3 * gq + jj; s[j] = (f32x4){0.f, 0.f, 0.f, 0.f};
#pragma unroll
                    for (int ks = 0; ks < 2; ++ks) s[j] = __builtin_amdgcn_mfma_f32_16x16x32_bf16((gq & 1) ? kfb[jj][ks] : kfa[jj][ks], qf[ks], s[j], 0, 0, 0); }
                __builtin_amdgcn_sched_barrier(0);
            }
            float mx = -1e30f;
#pragma unroll
            for (int j = 0; j < 18; ++j)
#pragma unroll
                for (int r = 0; r < 4; ++r) { const int rel = 16 * j + 4 * fq + r - fr, idx = p0 + 16 * j + 4 * fq + r;
                    const bool ok = rel >= 0 && rel <= 256 && (ib > 0 || idx >= 128) && (ib < 31 || idx < 256);
                    const float v = ok ? s[j][r] * 0.125f : -1e30f; s[j][r] = v; mx = fmaxf(mx, v); }
            mx = fmaxf(mx, __shfl_xor(mx, 16)); mx = fmaxf(mx, __shfl_xor(mx, 32)); mx = fmaxf(mx, snk);
            float l = 0.f;
#pragma unroll
            for (int j = 0; j < 18; ++j)
#pragma unroll
                for (int r = 0; r < 4; ++r) { const float p = __expf(s[j][r] - mx); s[j][r] = p; l += p; }
            l += __shfl_xor(l, 16); l += __shfl_xor(l, 32); l += __expf(snk - mx);
            const float inv = 1.0f / l;
            f32x4 o[4];
#pragma unroll
            for (int dt = 0; dt < 4; ++dt) o[dt] = (f32x4){0.f, 0.f, 0.f, 0.f};
            const LAS bf16* vbase_p = VTs + fr * BA_VS + p0 + 4 * fq;
            s16x4 va[4][2], vb[4][2];
#pragma unroll
            for (int dt = 0; dt < 4; ++dt) { va[dt][0] = *(const LAS s16x4*)(vbase_p + (16 * dt) * BA_VS); va[dt][1] = *(const LAS s16x4*)(vbase_p + (16 * dt) * BA_VS + 16); }
#pragma unroll
            for (int kk = 0; kk < 9; ++kk) {
                if (kk < 8) {
#pragma unroll
                    for (int dt = 0; dt < 4; ++dt) { const s16x4 t0_ = *(const LAS s16x4*)(vbase_p + (16 * dt) * BA_VS + 32 * (kk + 1)), t1_ = *(const LAS s16x4*)(vbase_p + (16 * dt) * BA_VS + 32 * (kk + 1) + 16);
                        if (kk & 1) { va[dt][0] = t0_; va[dt][1] = t1_; } else { vb[dt][0] = t0_; vb[dt][1] = t1_; } } }
                v4u pw; pw.x = cvtpk(s[2 * kk][0], s[2 * kk][1]); pw.y = cvtpk(s[2 * kk][2], s[2 * kk][3]); pw.z = cvtpk(s[2 * kk + 1][0], s[2 * kk + 1][1]); pw.w = cvtpk(s[2 * kk + 1][2], s[2 * kk + 1][3]);
                const bf16x8 pf = __builtin_bit_cast(bf16x8, pw);
                __builtin_amdgcn_sched_barrier(0);
#pragma unroll
                for (int dt = 0; dt < 4; ++dt) { const bf16x8 vf = (kk & 1) ? cat4(vb[dt][0], vb[dt][1]) : cat4(va[dt][0], va[dt][1]);
                    o[dt] = __builtin_amdgcn_mfma_f32_16x16x32_bf16(vf, pf, o[dt], 0, 0, 0); }
                __builtin_amdgcn_sched_barrier(0);
            }
#pragma unroll
            for (int dt = 0; dt < 4; ++dt) { const f32x4 ov = o[dt] * inv; v2u w; w.x = cvtpk(ov[0], ov[1]); w.y = cvtpk(ov[2], ov[3]);
                *(v2u*)(Ao + (t0 + fr) * AW + head * 64 + 16 * dt + 4 * fq) = w; }
        }
        wg_sync(); CHAOS_POINT(2, 32);
    }
}

constexpr int XA_KS = 136, XA_VS = 264;
constexpr int XA_K_BYTES = MEML * XA_KS * 2, XA_V_BYTES = XHD * XA_VS * 2;
static_assert(XA_K_BYTES % 16 == 0 && XA_K_BYTES + XA_V_BYTES <= PHASE_LDS, "cross attention LDS");
__device__ __forceinline__ void cross_attention_phase(LAS unsigned char* lds, const bf16* Qx, const bf16* Kmem, const bf16* VmemT, bf16* Ox, int layer, int G) {
    const int tid = opq_tid(), lane = tid & 63, wave = __builtin_amdgcn_readfirstlane(tid >> 6), fr = lane & 15, fq = lane >> 4;
    LAS bf16* Ks = (LAS bf16*)lds; LAS bf16* VTs = (LAS bf16*)(lds + XA_K_BYTES);
    for (int unit = blockIdx.x; unit < 256; unit += G) {
        const int quarter = unit & 3, head = (unit >> 2) & 3, b = unit >> 4;
        for (int c = tid; c < MEML * 16; c += NTHR) { const int key = c >> 4, c8 = c & 15;
            *(LAS v4u*)(Ks + key * XA_KS + c8 * 8) = *(const v4u*)(Kmem + (size_t)(b * MEML + key) * 1024 + layer * 512 + head * 128 + c8 * 8); }
        for (int c = tid; c < XHD * 32; c += NTHR) { const int d = c >> 5, c8 = c & 31;
            *(LAS v4u*)(VTs + d * XA_VS + c8 * 8) = *(const v4u*)(VmemT + (size_t)(layer * 512 + head * 128 + d) * MROWS + b * MEML + c8 * 8); }
        wg_sync(); CHAOS_POINT(2, 32);
        bf16x8 qn[4];
        { const size_t t0 = (size_t)b * SEQ + (quarter * 4) * 256 + wave * 32;
#pragma unroll
          for (int ks = 0; ks < 4; ++ks) qn[ks] = *(const bf16x8*)(Qx + (t0 + fr) * XW + head * 128 + 32 * ks + 8 * fq); }
#pragma unroll 1
        for (int qi = 0; qi < 8; ++qi) {
            const size_t t0 = (size_t)b * SEQ + (quarter * 4 + (qi >> 1)) * 256 + wave * 32 + 16 * (qi & 1);
            bf16x8 qf[4];
#pragma unroll
            for (int ks = 0; ks < 4; ++ks) qf[ks] = qn[ks];
            if (qi < 7) { const size_t t1 = (size_t)b * SEQ + (quarter * 4 + ((qi + 1) >> 1)) * 256 + wave * 32 + 16 * ((qi + 1) & 1);
#pragma unroll
                for (int ks = 0; ks < 4; ++ks) qn[ks] = *(const bf16x8*)(Qx + (t1 + fr) * XW + head * 128 + 32 * ks + 8 * fq); }
            f32x4 s[16];
            const LAS bf16* kbase_p = Ks + fr * XA_KS + 8 * fq;
            bf16x8 kfa[2][4], kfb[2][4];
#pragma unroll
            for (int jj = 0; jj < 2; ++jj)
#pragma unroll
                for (int ks = 0; ks < 4; ++ks) kfa[jj][ks] = *(const LAS bf16x8*)(kbase_p + (16 * jj) * XA_KS + 32 * ks);
#pragma unroll
            for (int gq = 0; gq < 8; ++gq) {
                if (gq < 7) {
#pragma unroll
                    for (int jj = 0; jj < 2; ++jj)
#pragma unroll
                        for (int ks = 0; ks < 4; ++ks) { const bf16x8 t = *(const LAS bf16x8*)(kbase_p + (16 * (2 * (gq + 1) + jj)) * XA_KS + 32 * ks); if (gq & 1) kfa[jj][ks] = t; else kfb[jj][ks] = t; } }
                __builtin_amdgcn_sched_barrier(0);
#pragma unroll
                for (int jj = 0; jj < 2; ++jj) { const int j = 2 * gq + jj; s[j] = (f32x4){0.f, 0.f, 0.f, 0.f};
#pragma unroll
                    for (int ks = 0; ks < 4; ++ks) s[j] = __builtin_amdgcn_mfma_f32_16x16x32_bf16((gq & 1) ? kfb[jj][ks] : kfa[jj][ks], qf[ks], s[j], 0, 0, 0); }
                __builtin_amdgcn_sched_barrier(0);
            }
            float mx = -1e30f;
#pragma unroll
            for (int j = 0; j < 16; ++j)
#pragma unroll
                for (int r = 0; r < 4; ++r) { const float v = s[j][r] * 0.08838834764831845f; s[j][r] = v; mx = fmaxf(mx, v); }
            mx = fmaxf(mx, __shfl_xor(mx, 16)); mx = fmaxf(mx, __shfl_xor(mx, 32));
            float l = 0.f;
#pragma unroll
            for (int j = 0; j < 16; ++j)
#pragma unroll
                for (int r = 0; r < 4; ++r) { const float p = __expf(s[j][r] - mx); s[j][r] = p; l += p; }
            l += __shfl_xor(l, 16); l += __shfl_xor(l, 32);
            const float inv = 1.0f / l;
            f32x4 o[8];
#pragma unroll
            for (int dt = 0; dt < 8; ++dt) o[dt] = (f32x4){0.f, 0.f, 0.f, 0.f};
            const LAS bf16* vbase_p = VTs + fr * XA_VS + 4 * fq;
            s16x4 va[8][2], vb[8][2];
#pragma unroll
            for (int dt = 0; dt < 8; ++dt) { va[dt][0] = *(const LAS s16x4*)(vbase_p + (16 * dt) * XA_VS); va[dt][1] = *(const LAS s16x4*)(vbase_p + (16 * dt) * XA_VS + 16); }
#pragma unroll
            for (int kk = 0; kk < 8; ++kk) {
                if (kk < 7) {
#pragma unroll
                    for (int dt = 0; dt < 8; ++dt) { const s16x4 t0_ = *(const LAS s16x4*)(vbase_p + (16 * dt) * XA_VS + 32 * (kk + 1)), t1_ = *(const LAS s16x4*)(vbase_p + (16 * dt) * XA_VS + 32 * (kk + 1) + 16);
                        if (kk & 1) { va[dt][0] = t0_; va[dt][1] = t1_; } else { vb[dt][0] = t0_; vb[dt][1] = t1_; } } }
                v4u pw; pw.x = cvtpk(s[2 * kk][0], s[2 * kk][1]); pw.y = cvtpk(s[2 * kk][2], s[2 * kk][3]); pw.z = cvtpk(s[2 * kk + 1][0], s[2 * kk + 1][1]); pw.w = cvtpk(s[2 * kk + 1][2], s[2 * kk + 1][3]);
                const bf16x8 pf = __builtin_bit_cast(bf16x8, pw);
                __builtin_amdgcn_sched_barrier(0);
#pragma unroll
                for (int dt = 0; dt < 8; ++dt) { const bf16x8 vf = (kk & 1) ? cat4(vb[dt][0], vb[dt][1]) : cat4(va[dt][0], va[dt][1]);
                    o[dt] = __builtin_amdgcn_mfma_f32_16x16x32_bf16(vf, pf, o[dt], 0, 0, 0); }
                __builtin_amdgcn_sched_barrier(0);
            }
#pragma unroll
            for (int dt = 0; dt < 8; ++dt) { const f32x4 ov = o[dt] * inv; v2u w; w.x = cvtpk(ov[0], ov[1]); w.y = cvtpk(ov[2], ov[3]);
                *(v2u*)(Ox + (t0 + fr) * XW + head * 128 + 16 * dt + 4 * fq) = w; }
        }
        wg_sync(); CHAOS_POINT(2, 32);
    }
}
constexpr float HY_MIN_DECAY = -3.0701134573253944f;
constexpr float HY_MAX_DECAY = -15.350567286626972f;
__device__ __forceinline__ void h2_rows(const Args& a, float* H2, int gw, int NGW, int lane) {
    for (int idx = gw; idx < 2 * SEQ; idx += NGW) {
        const int l = idx >> 12, j = idx & 4095;
        const float* w1 = a.in[I_FW1] + l * 33 * 64; const float* b1 = a.in[I_FB1] + l * 64; const float* fr1 = a.in[I_FFR1] + l * 64;
        const float* w2 = a.in[I_FW2] + l * 64 * 64; const float* b2 = a.in[I_FB2] + l * 64; const float* fr2 = a.in[I_FFR2] + l * 64;
        const float w = 6.283185307179586f * (float)j / 4096.0f;
        const int mm = (lane - 1) & 15; const float f = 1e-4f + (float)mm * ((15.0f - 1e-4f) / 15.0f); const float ang = f * w;
        float zq = lane == 0 ? (float)j / 4095.0f : (lane <= 16 ? cosf(ang) : -sinf(ang));
        float acc = b1[lane];
#pragma unroll
        for (int q = 0; q < 33; ++q) acc += __shfl(zq, q) * w1[q * 64 + lane];
        const float h1 = sinf(fr1[lane] * acc);
        acc = b2[lane];
#pragma unroll
        for (int q = 0; q < 64; ++q) acc += __shfl(h1, q) * w2[q * 64 + lane];
        H2[(size_t)idx * 64 + lane] = sinf(fr2[lane] * acc);
    }
}
__device__ __forceinline__ void kfilt_phase(LAS unsigned char* lds, const float* H2, const float* w3all, float* KF, int G) {
    LAS float* ws = (LAS float*)lds;
    const int tid = opq_tid(), jj = tid & 63, cg = __builtin_amdgcn_readfirstlane(tid >> 6);
    for (int unit = blockIdx.x; unit < 2 * 64 * 32; unit += G) {
        const int cb = unit & 31, jb = (unit >> 5) & 63, l = unit >> 11;
        const float* w3 = w3all + (size_t)l * 64 * 2048;
        for (int e = tid; e < 4096; e += NTHR) ws[e] = w3[(size_t)(e >> 6) * 2048 + cb * 64 + (e & 63)];
        wg_sync();
        const int j = jb * 64 + jj;
        const f32x4* hr = (const f32x4*)(H2 + ((size_t)l * SEQ + j) * 64);
        float acc[8];
#pragma unroll
        for (int e = 0; e < 8; ++e) acc[e] = 0.f;
#pragma unroll
        for (int q = 0; q < 16; ++q) { const f32x4 hv = hr[q];
#pragma unroll
            for (int i = 0; i < 4; ++i) { const LAS f32x4* wp = (const LAS f32x4*)(ws + (4 * q + i) * 64 + cg * 8); const f32x4 wa = wp[0], wb = wp[1];
                acc[0] += hv[i] * wa[0]; acc[1] += hv[i] * wa[1]; acc[2] += hv[i] * wa[2]; acc[3] += hv[i] * wa[3];
                acc[4] += hv[i] * wb[0]; acc[5] += hv[i] * wb[1]; acc[6] += hv[i] * wb[2]; acc[7] += hv[i] * wb[3]; } }
        const float tj = (float)j / 4095.0f;
#pragma unroll
        for (int e = 0; e < 8; ++e) { const int col = cb * 64 + cg * 8 + e, dir = col >> 10, oc = col & 1023;
            const float delta = HY_MIN_DECAY + (float)oc * ((HY_MAX_DECAY - HY_MIN_DECAY) / 1023.0f);
            float val = acc[e] * expf(-tj * fabsf(delta));
            int n = dir == 0 ? j : 8192 - j;
            if (dir == 1 && j == 0) { n = 4096; val = 0.f; }
            KF[((size_t)(l * 1024 + oc)) * 8192 + n] = val; }
        wg_sync();
    }
}

constexpr int HY_RAWS = 4112;
constexpr int HY_ROWB = 2 * HY_RAWS * 2;
constexpr int HY_VB_OFF = FFT_WORK * 8;
constexpr int HY_X2_OFF = HY_VB_OFF + HY_ROWB;
constexpr int HY_X1_OFF = HY_X2_OFF + HY_ROWB;
constexpr int HY_EX_OFF = HY_X1_OFF + HY_ROWB;
constexpr int HY_YB_OFF = HY_EX_OFF + 16384;
static_assert(HY_VB_OFF % 16 == 0 && HY_ROWB % 16 == 0 && HY_YB_OFF + 2 * 4096 * 2 <= PHASE_LDS && HY_YB_OFF - HY_X1_OFF >= 4096 * 8 && HY_X1_OFF % 8 == 0, "hyena LDS map");
typedef float f32x2v __attribute__((ext_vector_type(2)));
struct LdsCf { LAS f32x2v* p; __device__ __forceinline__ cf ld(int i) const { const f32x2v t = p[i]; return mk(t.x, t.y); } __device__ __forceinline__ void st(int i, cf v) const { p[i] = (f32x2v){v.x, v.y}; } };

__device__ __forceinline__ void hy_dma_rows(LAS unsigned char* lds, int region_off, const bf16* UT, int b0, int ch, int wave, int lane) {
#pragma unroll
    for (int r = 0; r < 2; ++r)
        __builtin_amdgcn_global_load_lds((const unsigned*)(UT + (((size_t)((b0 + r) * C3 + ch)) << 12) + wave * 512 + lane * 8), (LAS unsigned*)(lds + region_off + r * HY_RAWS * 2 + 16 + wave * 1024), 16, 0, 0);
}
__device__ __forceinline__ void hy_pads(LAS unsigned char* lds, int region_off, int tid) {
    if (tid < 2) { LAS bf16* row = (LAS bf16*)(lds + region_off) + tid * HY_RAWS; row[7] = 0; row[8 + 4096] = 0; }
}
__device__ __forceinline__ float hy_conv(const LAS bf16* ldsh, int e, float w0, float w1, float w2, float bias) {
    return w0 * bf1(ldsh[e - 1]) + w1 * bf1(ldsh[e]) + w2 * bf1(ldsh[e + 1]) + bias;
}
__device__ __forceinline__ int opqi(int v) { asm volatile("" : "+v"(v)); return v; }
template <class T> __device__ __forceinline__ T* opqp(T* p) { asm volatile("" : "+v"(p)); return p; }
__device__ __forceinline__ cf opq(cf w) { asm volatile("" : "+v"(w)); return w; }
__device__ __forceinline__ cf csel(bool c, cf a, cf b) { return mk(c ? a.x : b.x, c ? a.y : b.y); }
__device__ __forceinline__ float uni(float v) { return __builtin_bit_cast(float, __builtin_amdgcn_readfirstlane(__builtin_bit_cast(int, v))); }
__device__ __forceinline__ void wave_lds_fence() { __builtin_amdgcn_sched_barrier(0); asm volatile("s_waitcnt lgkmcnt(0)" ::: "memory"); __builtin_amdgcn_sched_barrier(0); }
__device__ __forceinline__ void wg_sync_lds() { __builtin_amdgcn_sched_barrier(0); asm volatile("s_waitcnt lgkmcnt(0)" ::: "memory"); __builtin_amdgcn_s_barrier(); asm volatile("" ::: "memory"); __builtin_amdgcn_sched_barrier(0); }
__device__ __forceinline__ cf shfl_cf(cf v) { return mk(__shfl_xor(v.x, 32), __shfl_xor(v.y, 32)); }

__device__ __forceinline__ void kspec_phase(LAS unsigned char* lds, const float* KF, float* KSP, int G) {
    const int tid = opq_tid();
    LdsCf W; W.p = (LAS f32x2v*)lds;
    int h1, j1, h2, k1, j2, h3, blk; geo1(tid, h1, j1); geo2(tid, h2, k1, j2); geo3(tid, h3, blk);
    const int fb1 = opqi(fbase1(h1, j1)), fb2 = opqi(fbase2(h2, k1, j2)), fb3 = opqi(fbase3(h3, blk)), jo = opqi(j1);
    float sv, cv;
    sincospif(-(float)j1 / 4096.0f, &sv, &cv); const cf w8192j = mk(cv, sv);
    sincospif(-(float)j1 / 2048.0f, &sv, &cv); const cf w4096j = mk(cv, sv);
    sincospif(-(float)j2 / 128.0f, &sv, &cv);  const cf w256j = mk(cv, sv);
    const cf w32 = mk(0.98078528040323043f, -0.19509032201612825f);
#pragma unroll 1
    for (int unit = blockIdx.x; unit < 2 * 2 * HYW; unit += G) {
        const float* kf = KF + (size_t)unit * 8192;
        cf x[16]; cf wp = opq(w8192j);
#pragma unroll
        for (int m = 0; m < 16; ++m) { const float* kp = kf + opqi(jo + 1024 * (m >> 2)); const float ka = kp[256 * (m & 3)]; const float* kq = kp + opqi(4096); const float kb = kq[256 * (m & 3)];
            x[m] = csel(h1 == 0, mk(ka + kb, 0.f), cscale(wp, ka - kb)); wp = cmul(wp, w32); }
        CHAOS_POINT(32, 21); fwd_pass1(W, fb1, opq(w4096j), x); wg_sync(); CHAOS_POINT(32, 22);
        fwd_pass2(W, fb2, opq(w256j)); wave_lds_fence(); CHAOS_POINT(32, 23);
        { cf kk[16]; fwd_pass3_keep(W, fb3, kk); GAS f32x4* kd = opqp((GAS f32x4*)(KSP + (size_t)unit * 16384 + tid * 32));
#pragma unroll
          for (int q = 0; q < 8; ++q) kd[q] = (f32x4){kk[2 * q].x, kk[2 * q].y, kk[2 * q + 1].x, kk[2 * q + 1].y}; }
        wg_sync();
    }
}
__device__ __forceinline__ void mid_pass3g(LdsCf lds, int b3, const GAS f32x4* Kp) {
    f32x4 kv[8];
#pragma unroll
    for (int q = 0; q < 8; ++q) kv[q] = Kp[q];
    cf x[16];
#pragma unroll
    for (int m = 0; m < 16; ++m) x[m] = lds.ld(b3 + m);
    dft16<false>(x);
#pragma unroll
    for (int q = 0; q < 8; ++q) { x[2 * q] = cmul(x[2 * q], mk(kv[q][0], kv[q][1])); x[2 * q + 1] = cmul(x[2 * q + 1], mk(kv[q][2], kv[q][3])); }
    dft16<true>(x);
#pragma unroll
    for (int m = 0; m < 16; ++m) lds.st(b3 + m, x[m]);
}
#ifdef DIAG
#define HY_SYNC() do { const unsigned long long ts_ = wall_clock64(); wg_sync(); hy_wait_ += wall_clock64() - ts_; } while (0)
#else
#define HY_SYNC() wg_sync()
#endif
#ifdef PERTURB
#define HY_PERTURB0() do { __builtin_amdgcn_s_sleep(40); __builtin_amdgcn_s_sleep(100); } while (0)
#else
#define HY_PERTURB0() CHAOS_POINT(1, 11)
#endif
__device__ __forceinline__ void hyena_phase(LAS unsigned char* lds, const Args& a, int layer, const bf16* UT, const float* KSP, bf16* YT, int G) {
    const int tid = opq_tid();
#ifdef DIAG
    unsigned long long hy_wait_ = 0; const unsigned long long hy_t0_ = wall_clock64();
#endif
    LdsCf W; W.p = (LAS f32x2v*)lds;
    const int wave = __builtin_amdgcn_readfirstlane(tid >> 6), lane = tid & 63;
    int h1, j1, h2, k1, j2, h3, blk; geo1(tid, h1, j1); geo2(tid, h2, k1, j2); geo3(tid, h3, blk);
    const int fb1 = opqi(fbase1(h1, j1)), fb2 = opqi(fbase2(h2, k1, j2)), fb3 = opqi(fbase3(h3, blk));
    const int jo = opqi(j1), jh = opqi(j1 + 2048 * h1);
    LdsCf ZB; ZB.p = (LAS f32x2v*)lds; const int zo = opqi(HY_X1_OFF / 8 + j1), zh = opqi(HY_X1_OFF / 8 + j1 + 2048 * h1);
    LAS bf16* l16 = (LAS bf16*)lds; const int yh = opqi(HY_YB_OFF / 2 + j1 + 2048 * h1);
    const LAS bf16* ldsh = (const LAS bf16*)lds; const int ro = opqi(HY_VB_OFF / 2 + 8 + j1), rh = opqi(HY_VB_OFF / 2 + 8 + j1 + 2048 * h1);
    float sv, cv;
    sincospif(-(float)j1 / 4096.0f, &sv, &cv); const cf w8192j = mk(cv, sv);
    sincospif(-(float)j1 / 2048.0f, &sv, &cv); const cf w4096j = mk(cv, sv);
    sincospif(-(float)j2 / 128.0f, &sv, &cv);  const cf w256j = mk(cv, sv);
    const cf w32 = mk(0.98078528040323043f, -0.19509032201612825f);
    const float* cw = a.in[I_CONVW] + layer * 3 * C3; const float* cbv = a.in[I_CONVB] + layer * C3; const float* skp = a.in[I_SKIP] + layer * 2 * HYW;
    for (int c = blockIdx.x; c < HYW; c += G) {
        const float x1w0 = uni(cw[c]), x1w1 = uni(cw[C3 + c]), x1w2 = uni(cw[2 * C3 + c]), x1b = uni(cbv[c]);
        const float x2w0 = uni(cw[512 + c]), x2w1 = uni(cw[C3 + 512 + c]), x2w2 = uni(cw[2 * C3 + 512 + c]), x2b = uni(cbv[512 + c]);
        const float vw0 = uni(cw[1024 + c]), vw1 = uni(cw[C3 + 1024 + c]), vw2 = uni(cw[2 * C3 + 1024 + c]), vb = uni(cbv[1024 + c]);
        const float skip0 = uni(skp[c]), skip1 = uni(skp[HYW + c]);
        const float* KS0 = KSP + ((size_t)((layer * 2 + 0) * HYW + c)) * 16384 + opqi(tid * 32);
        const float* KS1 = KSP + ((size_t)((layer * 2 + 1) * HYW + c)) * 16384 + opqi(tid * 32);
        hy_dma_rows(lds, HY_VB_OFF, UT, 0, 1024 + c, wave, lane); hy_pads(lds, HY_VB_OFF, tid); hy_pads(lds, HY_X2_OFF, tid);
        HY_SYNC();
#pragma unroll 1
        for (int pr = 0; pr < 8; ++pr) {
            const int b0 = 2 * pr; CHAOS_POINT(1, 16);
            hy_dma_rows(lds, HY_X1_OFF, UT, b0, c, wave, lane); hy_dma_rows(lds, HY_X2_OFF, UT, b0, 512 + c, wave, lane); hy_pads(lds, HY_X1_OFF, tid);
            cf x[16];
            { cf wp = opq(w8192j);
#pragma unroll
              for (int m = 0; m < 16; ++m) {
                  const cf z = mk(hy_conv(ldsh, ro + 256 * m, vw0, vw1, vw2, vb), hy_conv(ldsh, ro + 256 * m + HY_RAWS, vw0, vw1, vw2, vb));
                  x[m] = csel(h1 == 0, z, cmul(z, wp)); wp = cmul(wp, w32); } }
            HY_PERTURB0();
            fwd_pass1(W, fb1, opq(w4096j), x); wg_sync_lds(); CHAOS_POINT(1, 12);
            fwd_pass2(W, fb2, opq(w256j)); wave_lds_fence(); CHAOS_POINT(1, 13);
            mid_pass3g(W, fb3, opqp((const GAS f32x4*)KS0)); wave_lds_fence(); CHAOS_POINT(1, 14);
            inv_pass2(W, fb2, opq(w256j)); HY_SYNC();
            CHAOS_POINT(1, 15); inv_pass1(W, fb1, opq(w4096j), x);
            cf zz[8];
            { cf wp = opq(w8192j);
#pragma unroll
              for (int m = 0; m < 16; ++m) { x[m] = csel(h1 == 1, cmulc(x[m], wp), x[m]); wp = cmul(wp, w32); }
#pragma unroll
              for (int i = 0; i < 8; ++i) { const cf xa_ = x[i], xb_ = x[8 + i]; const cf mine = csel(h1 == 1, xb_, xa_), send = csel(h1 == 1, xa_, xb_); const cf r = cscale(cadd(mine, shfl_cf(send)), 1.0f / 8192.0f);
                  const float va = hy_conv(ldsh, rh + 256 * i, vw0, vw1, vw2, vb), vbb = hy_conv(ldsh, rh + 256 * i + HY_RAWS, vw0, vw1, vw2, vb);
                  const float xa = hy_conv(ldsh, rh + 256 * i + (HY_X1_OFF - HY_VB_OFF) / 2, x1w0, x1w1, x1w2, x1b), xb = hy_conv(ldsh, rh + 256 * i + (HY_X1_OFF - HY_VB_OFF) / 2 + HY_RAWS, x1w0, x1w1, x1w2, x1b);
                  zz[i] = mk(xa * (r.x + skip0 * va), xb * (r.y + skip0 * vbb)); } }
            wg_sync_lds();
            CHAOS_POINT(1, 17); if (pr < 7) hy_dma_rows(lds, HY_VB_OFF, UT, b0 + 2, 1024 + c, wave, lane);
#pragma unroll
            for (int i = 0; i < 8; ++i) ZB.st(zh + 256 * i, zz[i]);
            wg_sync_lds();
            { cf wp = opq(w8192j);
#pragma unroll
              for (int m = 0; m < 16; ++m) { const cf full = ZB.ld(zo + 256 * m); x[m] = csel(h1 == 0, full, cmul(full, wp)); wp = cmul(wp, w32); } }
            HY_PERTURB0();
            fwd_pass1(W, fb1, opq(w4096j), x); wg_sync_lds(); CHAOS_POINT(1, 12);
            fwd_pass2(W, fb2, opq(w256j)); wave_lds_fence(); CHAOS_POINT(1, 13);
            mid_pass3g(W, fb3, opqp((const GAS f32x4*)KS1)); wave_lds_fence(); CHAOS_POINT(1, 14);
            inv_pass2(W, fb2, opq(w256j)); wg_sync_lds();
            CHAOS_POINT(1, 15); inv_pass1(W, fb1, opq(w4096j), x);
            { cf wp = opq(w8192j);
#pragma unroll
              for (int m = 0; m < 16; ++m) { x[m] = csel(h1 == 1, cmulc(x[m], wp), x[m]); wp = cmul(wp, w32); }
#pragma unroll
              for (int i = 0; i < 8; ++i) { const cf xa_ = x[i], xb_ = x[8 + i]; const cf mine = csel(h1 == 1, xb_, xa_), send = csel(h1 == 1, xa_, xb_); const cf r = cscale(cadd(mine, shfl_cf(send)), 1.0f / 8192.0f);
                  const int p = jh + 256 * i; const cf zv = ZB.ld(zh + 256 * i);
                  const float xa = hy_conv(ldsh, rh + 256 * i + (HY_X2_OFF - HY_VB_OFF) / 2, x2w0, x2w1, x2w2, x2b), xb = hy_conv(ldsh, rh + 256 * i + (HY_X2_OFF - HY_VB_OFF) / 2 + HY_RAWS, x2w0, x2w1, x2w2, x2b);
                  const float ya = xa * (r.x + skip1 * zv.x), yb = xb * (r.y + skip1 * zv.y);
                  l16[yh + 256 * i] = (bf16)f2bf(ya); l16[yh + 256 * i + 4096] = (bf16)f2bf(yb); (void)p; } }
            HY_SYNC();
#pragma unroll
            for (int i = 0; i < 2; ++i) { const int q = tid + NTHR * i, row = q >> 9, cc = q & 511;
                *(v4u*)(YT + (((size_t)((b0 + row) * HYW + c)) << 12) + cc * 8) = *(const LAS v4u*)(l16 + HY_YB_OFF / 2 + row * 4096 + cc * 8); }
        }
    }
#ifdef DIAG
    if (blockIdx.x == 0 && tid == 0) { unsigned long long* dg = (unsigned long long*)(*(const LAS unsigned long long*)(lds + 139328)); atomicAdd(dg + 16, hy_wait_); atomicAdd(dg + 17, wall_clock64() - hy_t0_); }
#endif
}
constexpr int MN_STRIDE = 66;
static_assert(HYW * MN_STRIDE * 2 <= PHASE_LDS, "mix-norm LDS");
__device__ __forceinline__ void mixnorm_phase(LAS unsigned char* lds, const bf16* Ab, const bf16* YT, const float* ga, const float* gy, bf16* mixed, int G) {
    const int tid = opq_tid(), lane = tid & 63, wave = __builtin_amdgcn_readfirstlane(tid >> 6);
    LAS unsigned* tile32 = (LAS unsigned*)lds; const LAS bf16* tile16 = (const LAS bf16*)lds;
    f32x4 gav[2], gyv[2];
    gav[0] = *(const f32x4*)(ga + lane * 8); gav[1] = *(const f32x4*)(ga + lane * 8 + 4); gyv[0] = *(const f32x4*)(gy + lane * 8); gyv[1] = *(const f32x4*)(gy + lane * 8 + 4);
    v4u R[8];
    int unit = blockIdx.x;
    if (unit < M / 64) { const bf16* src = YT + (((size_t)((unit >> 6) * HYW + tid)) << 12) + (unit & 63) * 64;
#pragma unroll
        for (int q = 0; q < 8; ++q) R[q] = *(const v4u*)(src + 8 * q); }
#pragma unroll 1
    for (; unit < M / 64; unit += G) {
        const int b = unit >> 6, t0 = (unit & 63) * 64;
#pragma unroll
        for (int q = 0; q < 8; ++q) { LAS unsigned* d = tile32 + tid * (MN_STRIDE / 2) + 4 * q; d[0] = R[q].x; d[1] = R[q].y; d[2] = R[q].z; d[3] = R[q].w; }
        wg_sync(); CHAOS_POINT(16, 51);
        const int nu = unit + G;
        if (nu < M / 64) { const bf16* src = YT + (((size_t)((nu >> 6) * HYW + tid)) << 12) + (nu & 63) * 64;
#pragma unroll
            for (int q = 0; q < 8; ++q) R[q] = *(const v4u*)(src + 8 * q); }
        const size_t row0 = (size_t)b * SEQ + t0 + wave * 8;
        v4u av[8];
#pragma unroll
        for (int i = 0; i < 8; ++i) av[i] = *(const v4u*)(Ab + (row0 + i) * AW + lane * 8);
#pragma unroll
        for (int i = 0; i < 8; ++i) { const int tt = wave * 8 + i;
            float y[8]; float ss = 0.f;
#pragma unroll
            for (int e = 0; e < 8; ++e) { y[e] = bf1(tile16[(lane * 8 + e) * MN_STRIDE + tt]); ss += y[e] * y[e]; }
            const float rs = __builtin_amdgcn_rsqf(wave_sum(ss) * (1.f / 512.f) + EPS);
            v4u o; o.x = pk2(y[0] * rs * gyv[0][0], y[1] * rs * gyv[0][1]); o.y = pk2(y[2] * rs * gyv[0][2], y[3] * rs * gyv[0][3]);
            o.z = pk2(y[4] * rs * gyv[1][0], y[5] * rs * gyv[1][1]); o.w = pk2(y[6] * rs * gyv[1][2], y[7] * rs * gyv[1][3]);
            *(v4u*)(mixed + (row0 + i) * D + 512 + lane * 8) = o; }
#pragma unroll
        for (int i = 0; i < 8; ++i) {
            const float x[8] = {bflo(av[i].x), bfhi(av[i].x), bflo(av[i].y), bfhi(av[i].y), bflo(av[i].z), bfhi(av[i].z), bflo(av[i].w), bfhi(av[i].w)};
            float ss = 0.f;
#pragma unroll
            for (int e = 0; e < 8; ++e) ss += x[e] * x[e];
            const float rs = __builtin_amdgcn_rsqf(wave_sum(ss) * (1.f / 512.f) + EPS);
            v4u o; o.x = pk2(x[0] * rs * gav[0][0], x[1] * rs * gav[0][1]); o.y = pk2(x[2] * rs * gav[0][2], x[3] * rs * gav[0][3]);
            o.z = pk2(x[4] * rs * gav[1][0], x[5] * rs * gav[1][1]); o.w = pk2(x[6] * rs * gav[1][2], x[7] * rs * gav[1][3]);
            *(v4u*)(mixed + (row0 + i) * D + lane * 8) = o; }
        wg_sync(); CHAOS_POINT(16, 51);
    }
}

__device__ __forceinline__ void moe_norm_router_phase(LAS unsigned char* lds, const bf16* xb, const float* gain, const float* wr, float* rsrow, int* toke, float* tokw, int* wgcnt, int G) {
    const int tid = opq_tid(), lane = tid & 63, wave = __builtin_amdgcn_readfirstlane(tid >> 6);
    LAS int* cnt = (LAS int*)lds;
    if (tid < 8) cnt[tid] = 0;
    wg_sync(); CHAOS_POINT(16, 51);
    const int TPW = M / G;
    f32x4 wra[4][4], wrb[4][4];
#pragma unroll
    for (int j = 0; j < 4; ++j) { const f32x4 gv = *(const f32x4*)(gain + 4 * lane + 256 * j);
#pragma unroll
        for (int q = 0; q < 4; ++q) { const int k = 4 * lane + q + 256 * j; wra[j][q] = *(const f32x4*)(wr + k * 8) * gv[q]; wrb[j][q] = *(const f32x4*)(wr + k * 8 + 4) * gv[q]; } }
    v2u nx[4];
    { const v2u* xr = (const v2u*)(xb + (size_t)(blockIdx.x * TPW + wave) * D) + lane;
#pragma unroll
      for (int j = 0; j < 4; ++j) nx[j] = xr[64 * j]; }
#pragma unroll 1
    for (int i = wave; i < TPW; i += NWAVES) {
        const int t = blockIdx.x * TPW + i;
        v2u cu[4];
#pragma unroll
        for (int j = 0; j < 4; ++j) cu[j] = nx[j];
        if (i + NWAVES < TPW) { const v2u* xr = (const v2u*)(xb + (size_t)(t + NWAVES) * D) + lane;
#pragma unroll
            for (int j = 0; j < 4; ++j) nx[j] = xr[64 * j]; }
        f32x4 v[4]; float s = 0.f;
#pragma unroll
        for (int j = 0; j < 4; ++j) { const v2u a = cu[j]; v[j] = (f32x4){bflo(a.x), bfhi(a.x), bflo(a.y), bfhi(a.y)}; s += (v[j].x * v[j].x + v[j].y * v[j].y) + (v[j].z * v[j].z + v[j].w * v[j].w); }
        const float rs = 1.0f / sqrtf(wave_sum(s) * (1.f / 1024.f) + EPS);
        float lg[8];
#pragma unroll
        for (int e = 0; e < 8; ++e) lg[e] = 0.f;
#pragma unroll
        for (int j = 0; j < 4; ++j)
#pragma unroll
            for (int q = 0; q < 4; ++q) { const f32x4 wa = wra[j][q], wb = wrb[j][q]; const float hv = v[j][q];
                lg[0] += hv * wa[0]; lg[1] += hv * wa[1]; lg[2] += hv * wa[2]; lg[3] += hv * wa[3]; lg[4] += hv * wb[0]; lg[5] += hv * wb[1]; lg[6] += hv * wb[2]; lg[7] += hv * wb[3]; }
        { const bool b5 = lane & 32, b4 = lane & 16, b3 = lane & 8; float k4[4], k2[2], k1;
#pragma unroll
          for (int i = 0; i < 4; ++i) { const float send = b5 ? lg[i] : lg[4 + i], keep = b5 ? lg[4 + i] : lg[i]; k4[i] = keep + __shfl_xor(send, 32); }
#pragma unroll
          for (int i = 0; i < 2; ++i) { const float send = b4 ? k4[i] : k4[2 + i], keep = b4 ? k4[2 + i] : k4[i]; k2[i] = keep + __shfl_xor(send, 16); }
          { const float send = b3 ? k2[0] : k2[1], keep = b3 ? k2[1] : k2[0]; k1 = keep + __shfl_xor(send, 8); }
          k1 += __shfl_xor(k1, 4); k1 += __shfl_xor(k1, 2); k1 += __shfl_xor(k1, 1);
#pragma unroll
          for (int e = 0; e < 8; ++e) lg[e] = __builtin_bit_cast(float, __builtin_amdgcn_readlane(__builtin_bit_cast(int, k1), 8 * e)) * rs; }
        int i0 = 0; float v0 = lg[0];
#pragma unroll
        for (int e = 1; e < 8; ++e) if (lg[e] > v0) { v0 = lg[e]; i0 = e; }
        int i1 = -1; float v1 = -3.0e38f;
#pragma unroll
        for (int e = 0; e < 8; ++e) if (e != i0 && lg[e] > v1) { v1 = lg[e]; i1 = e; }
        const float e1 = __expf(v1 - v0), w0 = 1.0f / (1.0f + e1), w1 = e1 * w0;
        if (lane == 0) { toke[2 * t] = i0; toke[2 * t + 1] = i1; tokw[2 * t] = w0; tokw[2 * t + 1] = w1; rsrow[t] = rs; __hip_atomic_fetch_add(cnt + i0, 1, __ATOMIC_RELAXED, __HIP_MEMORY_SCOPE_WORKGROUP); __hip_atomic_fetch_add(cnt + i1, 1, __ATOMIC_RELAXED, __HIP_MEMORY_SCOPE_WORKGROUP); }
    }
    wg_sync(); CHAOS_POINT(16, 51);
    if (tid < 8) wgcnt[blockIdx.x * 8 + tid] = cnt[tid];
    wg_sync(); CHAOS_POINT(16, 51);
}
__device__ __forceinline__ void moe_slot_phase(LAS unsigned char* lds, const int* toke, const int* wgcnt, int* tokp, int* tilee, int* meta, const bf16* xb, const float* rsrow, const float* gain, unsigned char* XG8, int G) {
    const int tid = opq_tid(), lane = tid & 63, wave = __builtin_amdgcn_readfirstlane(tid >> 6);
    LAS int* arr = (LAS int*)lds;
    LAS int* pre = arr + 1024 * 8;
    LAS int* wcnt = pre + 32;
    LAS int* slots = wcnt + 64;
    for (int i = tid; i < G * 8; i += NTHR) arr[i] = wgcnt[i];
    wg_sync(); CHAOS_POINT(16, 51);
    if (tid < 8) { int p = 0, tot = 0; for (int w = 0; w < G; ++w) { const int c = arr[w * 8 + tid]; if (w < (int)blockIdx.x) p += c; tot += c; } pre[tid] = p; pre[8 + tid] = tot; }
    wg_sync(); CHAOS_POINT(16, 51);
    if (tid == 0) { int ps = 0; for (int e = 0; e < 8; ++e) { pre[16 + e] = ps; ps += ((pre[8 + e] + 255) >> 8) << 8; } pre[24] = ps; }
    wg_sync(); CHAOS_POINT(16, 51);
    const int TPW = M / G;
    int e_mine = -1, t = 0, rank = 0;
    if (tid < 2 * TPW) { t = blockIdx.x * TPW + (tid >> 1); e_mine = toke[2 * t + (tid & 1)]; }
#pragma unroll
    for (int e = 0; e < 8; ++e) { const unsigned long long mk_ = __ballot(e_mine == e); if (e_mine == e) rank = __popcll(mk_ & ((1ull << lane) - 1ull)); if (lane == 0) wcnt[wave * 8 + e] = __popcll(mk_); }
    wg_sync(); CHAOS_POINT(16, 51);
    if (e_mine >= 0) { int base = pre[16 + e_mine] + pre[e_mine]; for (int w = 0; w < wave; ++w) base += wcnt[w * 8 + e_mine];
        const int slot = base + rank; slots[tid] = slot; tokp[2 * t + (tid & 1)] = slot; }
    else slots[tid] = -1;
    if ((int)blockIdx.x < 8) { const int e = blockIdx.x, s0 = pre[16 + e] + pre[8 + e], s1 = pre[16 + e] + (((pre[8 + e] + 255) >> 8) << 8);
        unsigned z0 = 0u; asm volatile("" : "+v"(z0));
        for (int i = tid; i < (s1 - s0) * 64; i += NTHR) ((v4u*)(XG8 + (size_t)s0 * D))[i] = (v4u){z0, z0, z0, z0}; }
    if (blockIdx.x == 0) { const int ntiles = pre[24] >> 8;
        for (int ti = tid; ti < ntiles; ti += NTHR) { int e = 0;
#pragma unroll
            for (int q = 1; q < 8; ++q) if (ti * 256 >= pre[16 + q]) e = q;
            tilee[ti] = e; }
        if (tid == 0) meta[0] = ntiles; }
    wg_sync(); CHAOS_POINT(16, 51);
    { f32x4 g[4];
#pragma unroll
      for (int q = 0; q < 4; ++q) g[q] = *(const f32x4*)(gain + 16 * lane + 4 * q);
#pragma unroll 1
      for (int a0 = wave * 64; a0 < wave * 64 + 64; a0 += 2) {
          v4u av[2][2]; float rs[2]; int sl[2];
#pragma unroll
          for (int u = 0; u < 2; ++u) { const int a = a0 + u; sl[u] = slots[a]; const int tt = blockIdx.x * TPW + (a >> 1); rs[u] = rsrow[tt]; const v4u* src = (const v4u*)(xb + (size_t)tt * D) + 2 * lane; av[u][0] = src[0]; av[u][1] = src[1]; }
#pragma unroll
          for (int u = 0; u < 2; ++u) if (sl[u] >= 0) { v4u o;
#pragma unroll
              for (int h = 0; h < 2; ++h) { const unsigned w4[4] = {av[u][h].x, av[u][h].y, av[u][h].z, av[u][h].w};
#pragma unroll
                  for (int q = 0; q < 2; ++q) { int w = 0;
                      w = __builtin_amdgcn_cvt_pk_fp8_f32(bflo(w4[2 * q]) * rs[u] * g[2 * h + q][0], bfhi(w4[2 * q]) * rs[u] * g[2 * h + q][1], w, false);
                      w = __builtin_amdgcn_cvt_pk_fp8_f32(bflo(w4[2 * q + 1]) * rs[u] * g[2 * h + q][2], bfhi(w4[2 * q + 1]) * rs[u] * g[2 * h + q][3], w, true);
                      o[2 * h + q] = (unsigned)w; } }
              ((v4u*)(XG8 + (size_t)sl[u] * D))[lane] = o; } } }
    wg_sync(); CHAOS_POINT(16, 51);
}
__device__ __forceinline__ void moe_gather_phase(const bf16* xb, const float* rsrow, const float* gain, const int* rowtok, bf16* XG, int nrows, int gw, int NGW, int lane) {
    f32x4 g[4];
#pragma unroll
    for (int q = 0; q < 4; ++q) g[q] = *(const f32x4*)(gain + (q >> 1) * 512 + 8 * lane + 4 * (q & 1));
    for (int r = gw; r < nrows; r += NGW) { const int t = rowtok[r]; const float rs = rsrow[t]; const v4u* src = (const v4u*)(xb + (size_t)t * D); v4u* dst = (v4u*)(XG + (size_t)r * D);
#pragma unroll
        for (int h = 0; h < 2; ++h) { const v4u a = src[64 * h + lane]; v4u o;
            o.x = pk2(bflo(a.x) * rs * g[2 * h][0], bfhi(a.x) * rs * g[2 * h][1]); o.y = pk2(bflo(a.y) * rs * g[2 * h][2], bfhi(a.y) * rs * g[2 * h][3]);
            o.z = pk2(bflo(a.z) * rs * g[2 * h + 1][0], bfhi(a.z) * rs * g[2 * h + 1][1]); o.w = pk2(bflo(a.w) * rs * g[2 * h + 1][2], bfhi(a.w) * rs * g[2 * h + 1][3]);
            dst[64 * h + lane] = o; } }
}
__device__ __forceinline__ void moe_combine_final_phase(const bf16* xb, float* out, const bf16* YB, const int* tokp, const float* tokw, const float* gain, int gw, int NGW, int lane) {
    f32x4 g[4];
#pragma unroll
    for (int q = 0; q < 4; ++q) g[q] = *(const f32x4*)(gain + (q >> 1) * 512 + 8 * lane + 4 * (q & 1));
#pragma unroll 1
    for (int t0 = gw; t0 < M; t0 += 2 * NGW) { CHAOS_POINT(16, 52);
        v4u xa[2][2], ya[2][2], yb[2][2]; float w0[2], w1[2]; bool on[2];
#pragma unroll
        for (int u = 0; u < 2; ++u) { const int t = t0 + u * NGW; on[u] = t < M; const int tt = on[u] ? t : t0;
            const int p0 = tokp[2 * tt], p1 = tokp[2 * tt + 1]; w0[u] = tokw[2 * tt]; w1[u] = tokw[2 * tt + 1];
            const v4u* xr = (const v4u*)(xb + (size_t)tt * D) + lane; const v4u* y0 = (const v4u*)(YB + (size_t)p0 * D) + lane; const v4u* y1 = (const v4u*)(YB + (size_t)p1 * D) + lane;
#pragma unroll
            for (int h = 0; h < 2; ++h) { xa[u][h] = xr[64 * h]; ya[u][h] = y0[64 * h]; yb[u][h] = y1[64 * h]; } }
#pragma unroll
        for (int u = 0; u < 2; ++u) { const int t = t0 + u * NGW; float v[2][8]; float s = 0.f;
#pragma unroll
            for (int h = 0; h < 2; ++h) { const unsigned xw[4] = {xa[u][h].x, xa[u][h].y, xa[u][h].z, xa[u][h].w}, aw[4] = {ya[u][h].x, ya[u][h].y, ya[u][h].z, ya[u][h].w}, bw[4] = {yb[u][h].x, yb[u][h].y, yb[u][h].z, yb[u][h].w};
#pragma unroll
                for (int q = 0; q < 4; ++q) { v[h][2 * q] = bflo(xw[q]) + w0[u] * bflo(aw[q]) + w1[u] * bflo(bw[q]); v[h][2 * q + 1] = bfhi(xw[q]) + w0[u] * bfhi(aw[q]) + w1[u] * bfhi(bw[q]);
                    s += v[h][2 * q] * v[h][2 * q] + v[h][2 * q + 1] * v[h][2 * q + 1]; } }
            const float rs = 1.0f / sqrtf(wave_sum(s) * (1.f / 1024.f) + EPS);
            if (on[u]) { f32x4* orow = (f32x4*)(out + (size_t)t * D);
#pragma unroll
                for (int h = 0; h < 2; ++h) { orow[128 * h + 2 * lane] = (f32x4){v[h][0], v[h][1], v[h][2], v[h][3]} * rs * g[2 * h]; orow[128 * h + 2 * lane + 1] = (f32x4){v[h][4], v[h][5], v[h][6], v[h][7]} * rs * g[2 * h + 1]; } } }
    }
}
struct MoeOrder : pg8::StaticOrder {
    const int* tilee; int tile0; size_t bstride;
    __device__ __forceinline__ size_t boff(const pg8::Unit& u) const { return (size_t)tilee[tile0 + u.pm] * bstride; }
};
#ifndef LB_WAVES
#define LB_WAVES 2
#endif
constexpr int N_PHASES_C = 29;
__global__ void __launch_bounds__(NTHR, LB_WAVES) fwd_kernel(Args args) {
    extern __shared__ __attribute__((aligned(16))) unsigned char lds_raw[];
    LAS unsigned char* lds = (LAS unsigned char*)lds_raw;
    const int tid0 = threadIdx.x;
    const int G = gridDim.x, NGW = G * NWAVES;
    unsigned char* ws = args.ws;
    gu32* ctl = (gu32*)(ws + WS_CTL);
    volatile LAS unsigned* MISC = (volatile LAS unsigned*)(lds + MISC_OFF);
    for (int u = tid0; u < (LDS_BYTES - LDSCTL_OFF) / 4; u += NTHR) ((LAS unsigned*)(lds + LDSCTL_OFF))[u] = 0u;
#ifdef DIAG
#ifndef DIAG_WG
#define DIAG_WG 0
#endif
#ifndef DIAG_PH
#define DIAG_PH 0
#endif
#ifndef DIAG_DIV
#define DIAG_DIV 1
#endif
    static_assert(MISC_OFF == 139328, "diag pointer slot");
    if (tid0 == 0) ((LAS unsigned long long*)(lds + MISC_OFF))[0] = (unsigned long long)(ws + WS_CTL + 512 * 1024);
#endif
    __syncthreads();
    XcdBarrier bar; bar.bar = (unsigned*)(ctl + CW_BAR); bar.x = 0; bar.st = nullptr;
    if (args.use_bar) bar = xcd_barrier_post((unsigned*)(ctl + CW_BAR), MISC + 8);
    const int lo = args.ph_lo, hi = args.ph_hi;
    int ph = 0;
#ifndef PHMASK
#define PHMASK 0xffffffffu
#endif
#define EN(k) (((PHMASK) >> (k)) & 1u)
#define PH_ON() (ph >= lo && ph < hi)
#define LOCAL_IDS() const int tid = opq_tid(), lane = tid & 63, wave = __builtin_amdgcn_readfirstlane(tid >> 6), gw = blockIdx.x * NWAVES + wave; (void)lane; (void)gw
#ifndef DUPMASK
#define DUPMASK 0u
#endif
#define RES_DST(k) ((NREP(k) > 1 && rep_ + 1 < NREP(k)) ? (bf16*)args.out : HB)
#ifndef DUPN
#define DUPN 2
#endif
#define NREP(k) ((((DUPMASK) >> (k)) & 1u) ? DUPN : 1)
#ifdef DIAG
#define PH_END_K(k) do { if (args.use_bar && (ph + 1 < hi || rep_ + 1 < NREP(k))) { const unsigned long long tb_ = wall_clock64(); xcd_barrier(bar); if (threadIdx.x == 0) { unsigned long long* dg = (unsigned long long*)(ws + WS_CTL + 512 * 1024); const unsigned long long w_ = wall_clock64() - tb_; atomicAdd(dg + 5, w_); if (ph == DIAG_PH) atomicAdd(dg + 6, w_); } } } while (0)
#else
#define PH_END_K(k) do { if (args.use_bar && (ph + 1 < hi || rep_ + 1 < NREP(k))) xcd_barrier(bar); } while (0)
#endif

    float* cosT = (float*)(ws + WS_COS); float* sinT = (float*)(ws + WS_SIN); float* H2 = (float*)(ws + WS_H2);
    int* toke = (int*)(ws + WS_TOKE); float* tokw = (float*)(ws + WS_TOKW); int* tokp = (int*)(ws + WS_TOKP); int* rowtok = (int*)(ws + WS_ROWTOK);
    int* tilee = (int*)(ws + WS_TILEE); int* wgcnt = (int*)(ws + WS_WGCNT); int* meta = (int*)(ws + WS_META); float* rsrow = (float*)(ws + WS_RSROW);
    bf16* WINA = (bf16*)(ws + WS_WINA); bf16* WINB = (bf16*)(ws + WS_WINB); bf16* WOUT = (bf16*)(ws + WS_WOUT); bf16* XQ = (bf16*)(ws + WS_XQ); bf16* XK = (bf16*)(ws + WS_XK);
    bf16* XV = (bf16*)(ws + WS_XV); bf16* XO = (bf16*)(ws + WS_XO); bf16* FGU = (bf16*)(ws + WS_FGU); bf16* FDN = (bf16*)(ws + WS_FDN); bf16* MGU = (bf16*)(ws + WS_MGU); bf16* MDN = (bf16*)(ws + WS_MDN);
    float* KF = (float*)(ws + WS_KFILT); bf16* MB = (bf16*)(ws + WS_MB); bf16* KMEM = (bf16*)(ws + WS_KMEM); bf16* VMEMT = (bf16*)(ws + WS_VMEMT); bf16* HB = (bf16*)(ws + WS_HB);
    bf16* QB = (bf16*)(ws + WS_QB); bf16* KB = (bf16*)(ws + WS_KB); bf16* VB = (bf16*)(ws + WS_VB); bf16* UT = (bf16*)(ws + WS_UT); bf16* AB = (bf16*)(ws + WS_AB); bf16* YT = (bf16*)(ws + WS_YT);
    bf16* MIXED = (bf16*)(ws + WS_MIXED); float* SS = (float*)(ws + WS_SS);
    bf16* XQB = (bf16*)(ws + WS_XQB); bf16* XOB = (bf16*)(ws + WS_XOB); bf16* ACT = (bf16*)(ws + WS_ACT); unsigned char* XG8 = ws + WS_XG; bf16* YB = (bf16*)(ws + WS_YB); unsigned char* MGU8 = ws + WS_MGU; bf16* MACT = (bf16*)(ws + WS_MACT);
    const float* const* in = args.in;

    if (EN(0) && PH_ON()) for (int rep_ = 0; rep_ < NREP(0); ++rep_) { asm volatile("; PHASE_MARK 0"); LOCAL_IDS();
        LAS float* scr = (LAS float*)(lds + wave * 8704);
        constexpr int IT_L = 384 + 768 + 512 + 4 * 256, IT_D = 3 * 1408, IT_E = 3 * 1792, IT_ALL = 2 * IT_L + IT_D + NE * IT_E;
#pragma unroll 1
        for (int it = gw; it < IT_ALL; it += NGW) {
            const float* W; int ldw, K, col0 = 0, ncols, mode = 0; bf16* WT; const float* gk = nullptr; int r = it;
            if (r < 2 * IT_L) { const int l = r / IT_L; r -= l * IT_L;
                if (r < 384) { W = in[I_WIN] + (size_t)l * D * INC; ldw = INC; K = D; ncols = 768; WT = WINA + (size_t)l * 768 * D; mode = 1; gk = in[I_MIXNORM] + l * D; }
                else if ((r -= 384) < 768) { W = in[I_WIN] + (size_t)l * D * INC; ldw = INC; K = D; col0 = 768; ncols = C3; WT = WINB + (size_t)l * C3 * D; gk = in[I_MIXNORM] + l * D; }
                else if ((r -= 768) < 512) { W = in[I_WOUT] + (size_t)l * D * D; ldw = D; K = D; ncols = D; WT = WOUT + (size_t)l * D * D; }
                else if ((r -= 512) < 256) { W = in[I_XWQ] + (size_t)l * D * XW; ldw = XW; K = D; ncols = XW; WT = XQ + (size_t)l * XW * D; gk = in[I_XNORM] + l * D; }
                else if ((r -= 256) < 256) { W = in[I_XWK] + (size_t)l * D * XW; ldw = XW; K = D; ncols = XW; WT = XK + (size_t)l * XW * D; }
                else if ((r -= 256) < 256) { W = in[I_XWV] + (size_t)l * D * XW; ldw = XW; K = D; ncols = XW; WT = XV + (size_t)l * XW * D; }
                else { r -= 256; W = in[I_XWO] + (size_t)l * XW * D; ldw = D; K = XW; ncols = D; WT = XO + (size_t)l * D * XW; }
            } else if ((r -= 2 * IT_L) < IT_D) {
                if (r < 1408) { W = in[I_FGATE]; ldw = FF; K = D; ncols = FF; WT = FGU; mode = 2; gk = in[I_FNORM]; }
                else if ((r -= 1408) < 1408) { W = in[I_FUP]; ldw = FF; K = D; ncols = FF; WT = FGU; mode = 3; gk = in[I_FNORM]; }
                else { r -= 1408; W = in[I_FDOWN]; ldw = D; K = FF; ncols = D; WT = FDN; }
            } else { r -= IT_D; const int e = r / IT_E; r -= e * IT_E;
                if (r < 2 * 1792) { const bool up = r >= 1792; if (up) r -= 1792;
                    tr_item8(in[up ? I_MUP : I_MGATE] + (size_t)e * D * FFE, FFE, D, FFE, MGU8 + (size_t)e * 2 * FFE * D, up ? 3 : 2, 32.0f, r, scr, lane); continue; }
                else { r -= 2 * 1792; tr_item8(in[I_MDOWN] + (size_t)e * FFE * D, D, FFE, D, (unsigned char*)MDN + (size_t)e * D * FFE, 0, 32.0f, r, scr, lane); continue; }
            }
            tr_item(W, ldw, K, col0, ncols, WT, mode, gk, r, scr, lane);
        }
        for (int i = blockIdx.x * NTHR + tid; i < SEQ * 32; i += G * NTHR) { const int pos = i >> 5, f = i & 31;
            const float inv = (float)pow(10000.0, -(double)f / 32.0); const float ang = (float)pos * inv;
            cosT[i] = (float)cos((double)ang); sinT[i] = (float)sin((double)ang); }
        h2_rows(args, H2, gw, NGW, lane);
        norm_rows(in[I_MEM], in[I_MEMNORM], MB, MROWS, gw, NGW, lane);
        xb_rows(in[I_X], HB, SS, M, gw, NGW, lane);
        PH_END_K(0);
    }
    ++ph;
    if (EN(1) && PH_ON()) for (int rep_ = 0; rep_ < NREP(1); ++rep_) { asm volatile("; PHASE_MARK 1"); LOCAL_IDS();
        kfilt_phase(lds, H2, in[I_FW3], KF, G);
        PH_END_K(1);
    }
    ++ph;

#pragma unroll 1
    for (int l = 0; l < 2; ++l) {
        if (EN(2) && PH_ON()) for (int rep_ = 0; rep_ < NREP(2); ++rep_) { asm volatile("; PHASE_MARK 2"); LOCAL_IDS();
            if (l == 0) {
                kspec_phase(lds, KF, (float*)(ws + WS_KSPEC), G);
                { pg8::Gemm g{MB, XK, MROWS, 1024, D}; pg8::StaticOrder S; S.init(MROWS, 1024, G, (int)blockIdx.x); pg8::EpiBf16 E{KMEM, 1024, nullptr, 1.0f};
                  pg8::gemm_phase<pg8::EpiBf16, pg8::StaticOrder, PG8_ALIGN, PG8_SP2>(lds, g, S, E); }
                { pg8::Gemm g{MB, XV, MROWS, 1024, D}; pg8::StaticOrder S; S.init(MROWS, 1024, G, G >= 128 ? (int)((blockIdx.x + G - 64) % G) : (int)blockIdx.x); pg8::EpiT E{VMEMT, 1024, 12, nullptr};
                  pg8::gemm_phase<pg8::EpiT, pg8::StaticOrder, PG8_ALIGN, PG8_SP2>(lds, g, S, E); }
            }
            { pg8::Gemm g{HB, WINA + (size_t)l * 768 * D, M, 768, D}; pg8::StaticOrder S; S.init(M, 768, G, (int)blockIdx.x); pg8::EpiQKV E{QB, KB, VB, cosT, sinT, SS + (size_t)(3 * l) * SS_STRIDE};
              pg8::gemm_phase<pg8::EpiQKV, pg8::StaticOrder, PG8_ALIGN, PG8_SP2>(lds, g, S, E); }
            { pg8::Gemm g{HB, WINB + (size_t)l * C3 * D, M, C3, D}; pg8::StaticOrder S; S.init(M, C3, G, (int)blockIdx.x); pg8::EpiT E{UT, C3, 12, SS + (size_t)(3 * l) * SS_STRIDE};
              pg8::gemm_phase<pg8::EpiT, pg8::StaticOrder, PG8_ALIGN, PG8_SP2>(lds, g, S, E); }
            PH_END_K(2);
        }
        ++ph;
        if (EN(3) && PH_ON()) for (int rep_ = 0; rep_ < NREP(3); ++rep_) { asm volatile("; PHASE_MARK 3"); LOCAL_IDS();
#ifndef BA_REP
#define BA_REP 1
#endif
#ifndef HY_REP
#define HY_REP 1
#endif
#pragma unroll 1
            for (int r_ = 0; r_ < BA_REP; ++r_) band_attention_phase(lds, QB, KB, VB, AB, in[I_SINK] + l * NH, G);
#pragma unroll 1
            for (int r_ = 0; r_ < HY_REP; ++r_) hyena_phase(lds, args, l, UT, (const float*)(ws + WS_KSPEC), YT, G);
            PH_END_K(3);
        }
        ++ph;
        if (EN(4) && PH_ON()) for (int rep_ = 0; rep_ < NREP(4); ++rep_) { asm volatile("; PHASE_MARK 4"); LOCAL_IDS(); mixnorm_phase(lds, AB, YT, in[I_ANORM] + l * AW, in[I_YNORM] + l * HYW, MIXED, G); PH_END_K(4); }
        ++ph;
        if (EN(5) && PH_ON()) for (int rep_ = 0; rep_ < NREP(5); ++rep_) { asm volatile("; PHASE_MARK 5"); LOCAL_IDS();
            pg8::Gemm g{MIXED, WOUT + (size_t)l * D * D, M, D, D}; pg8::StaticOrder S; S.init(M, D, G, (int)blockIdx.x); pg8::EpiResB E{HB, D, SS + (size_t)(3 * l + 1) * SS_STRIDE, RES_DST(5)};
            pg8::gemm_phase<pg8::EpiResB, pg8::StaticOrder, PG8_ALIGN, PG8_SP2>(lds, g, S, E);
            PH_END_K(5);
        }
        ++ph;
        if (EN(7) && PH_ON()) for (int rep_ = 0; rep_ < NREP(7); ++rep_) { asm volatile("; PHASE_MARK 7"); LOCAL_IDS();
            pg8::Gemm g{HB, XQ + (size_t)l * XW * D, M, XW, D}; pg8::StaticOrder S; S.init(M, XW, G, (int)blockIdx.x); pg8::EpiBf16 E{XQB, XW, SS + (size_t)(3 * l + 1) * SS_STRIDE, 1.0f};
            pg8::gemm_phase<pg8::EpiBf16, pg8::StaticOrder, PG8_ALIGN, PG8_SP2>(lds, g, S, E);
            PH_END_K(7);
        }
        ++ph;
        if (EN(8) && PH_ON()) for (int rep_ = 0; rep_ < NREP(8); ++rep_) { asm volatile("; PHASE_MARK 8"); LOCAL_IDS(); cross_attention_phase(lds, XQB, KMEM, VMEMT, XOB, l, G); PH_END_K(8); }
        ++ph;
        if (EN(9) && PH_ON()) for (int rep_ = 0; rep_ < NREP(9); ++rep_) { asm volatile("; PHASE_MARK 9"); LOCAL_IDS();
            pg8::Gemm g{XOB, XO + (size_t)l * D * XW, M, D, XW}; pg8::StaticOrder S; S.init(M, D, G, (int)blockIdx.x); pg8::EpiResB E{HB, D, l == 0 ? SS + (size_t)2 * SS_STRIDE : nullptr, RES_DST(9)};
            pg8::gemm_phase<pg8::EpiResB, pg8::StaticOrder, PG8_ALIGN, PG8_SP2>(lds, g, S, E);
            PH_END_K(9);
        }
        ++ph;
        if (l == 0) {
            if (EN(11) && PH_ON()) for (int rep_ = 0; rep_ < NREP(11); ++rep_) { asm volatile("; PHASE_MARK 11"); LOCAL_IDS();
                pg8::Gemm g{HB, FGU, M, 2 * FF, D}; pg8::StaticOrder S; S.init(M, 2 * FF, G, (int)blockIdx.x); pg8::EpiSwiglu<true> E{ACT, FF, SS + (size_t)2 * SS_STRIDE};
                pg8::gemm_phase<pg8::EpiSwiglu<true>, pg8::StaticOrder, PG8_ALIGN, PG8_SP2>(lds, g, S, E);
                PH_END_K(11);
            }
            ++ph;
            if (EN(12) && PH_ON()) for (int rep_ = 0; rep_ < NREP(12); ++rep_) { asm volatile("; PHASE_MARK 12"); LOCAL_IDS();
                pg8::Gemm g{ACT, FDN, M, D, FF}; pg8::StaticOrder S; S.init(M, D, G, (int)blockIdx.x); pg8::EpiResB E{HB, D, SS + (size_t)3 * SS_STRIDE, RES_DST(12)};
                pg8::gemm_phase<pg8::EpiResB, pg8::StaticOrder, PG8_ALIGN, PG8_SP2>(lds, g, S, E);
                PH_END_K(12);
            }
            ++ph;
        } else {
            if (EN(14) && PH_ON()) for (int rep_ = 0; rep_ < NREP(14); ++rep_) { asm volatile("; PHASE_MARK 14"); LOCAL_IDS(); moe_norm_router_phase(lds, HB, in[I_FNORM] + D, in[I_ROUTER], rsrow, toke, tokw, wgcnt, G); PH_END_K(14); }
            ++ph;
            if (EN(15) && PH_ON()) for (int rep_ = 0; rep_ < NREP(15); ++rep_) { asm volatile("; PHASE_MARK 15"); LOCAL_IDS(); moe_slot_phase(lds, toke, wgcnt, tokp, tilee, meta, HB, rsrow, in[I_FNORM] + D, XG8, G); PH_END_K(15); }
            ++ph;
#pragma unroll 1
            for (int ci = 0; ci < MOE_NCHUNK; ++ci) {
                if (EN(17) && PH_ON()) for (int rep_ = 0; rep_ < NREP(17); ++rep_) { asm volatile("; PHASE_MARK 17"); LOCAL_IDS();
                    const int ntiles = meta[0], tile0 = ci * MOE_CH_TILES, nt = ci < MOE_NCHUNK - 1 ? MOE_CH_TILES : ntiles - (MOE_NCHUNK - 1) * MOE_CH_TILES;
                    int k8 = D / 2; asm volatile("" : "+s"(k8));
                    pg8::Gemm g{(const bf16*)(XG8 + (size_t)tile0 * 256 * D), (const bf16*)MGU8, nt * 256, 2 * FFE, k8};
                    MoeOrder S; S.init(nt * 256, 2 * FFE, G, (int)blockIdx.x); S.tilee = tilee; S.tile0 = tile0; S.bstride = (size_t)2 * FFE * D;
                    pg8::EpiSwiglu<false, true, true> E{MACT, FFE, nullptr};
                    pg8::gemm_phase<pg8::EpiSwiglu<false, true, true>, MoeOrder, PG8_ALIGN, PG8_SP2>(lds, g, S, E);
                    PH_END_K(17);
                }
                ++ph;
                if (EN(18) && PH_ON()) for (int rep_ = 0; rep_ < NREP(18); ++rep_) { asm volatile("; PHASE_MARK 18"); LOCAL_IDS();
                    const int ntiles = meta[0], tile0 = ci * MOE_CH_TILES, nt = ci < MOE_NCHUNK - 1 ? MOE_CH_TILES : ntiles - (MOE_NCHUNK - 1) * MOE_CH_TILES;
                    int k8 = FFE / 2; asm volatile("" : "+s"(k8));
                    pg8::Gemm g{MACT, MDN, nt * 256, D, k8};
                    MoeOrder S; S.init(nt * 256, D, G, (int)blockIdx.x); S.tilee = tilee; S.tile0 = tile0; S.bstride = (size_t)D * FFE;
                    pg8::EpiBf16T<true> E{YB + (size_t)tile0 * 256 * D, D, nullptr, 1.0f / 128.0f};
                    pg8::gemm_phase<pg8::EpiBf16T<true>, MoeOrder, PG8_ALIGN, PG8_SP2>(lds, g, S, E);
                    PH_END_K(18);
                }
                ++ph;
            }
            if (EN(19) && PH_ON()) for (int rep_ = 0; rep_ < NREP(19); ++rep_) { asm volatile("; PHASE_MARK 19"); LOCAL_IDS(); moe_combine_final_phase(HB, args.out, YB, tokp, tokw, in[I_FINAL], gw, NGW, lane); PH_END_K(19); }
            ++ph;
        }
    }
#ifdef DIAG
    if (blockIdx.x == DIAG_WG && tid0 == 0 && hi == N_PHASES_C) { const unsigned long long v = ((unsigned long long*)(ws + WS_CTL + 512 * 1024))[DIAG_SEL] * DIAG_MULT / DIAG_DIV; const unsigned long long t0 = wall_clock64(); while (wall_clock64() - t0 < v) __builtin_amdgcn_s_sleep(8); }
#endif
#undef PH_ON
}
constexpr int N_PHASES = 2 + 7 + 2 + 7 + 2 + 2 * MOE_NCHUNK + 1;

#ifndef MK_PER_PHASE
#define MK_PER_PHASE 0
#endif
extern "C" void kernel_launch(void* const* d_in, const int* in_sizes, int n_in, void* d_out, int out_size, void* d_ws, size_t ws_size, hipStream_t stream) {
    static int grid = 0;
    if (grid == 0) {
        if (n_in != 33 || in_sizes[0] != M * D || out_size != M * D || ws_size < WS_END) {
            fprintf(stderr, "kernel_launch: unexpected problem: n_in %d in0 %d out %d ws %zu (need %zu); nothing launched\n", n_in, n_in > 0 ? in_sizes[0] : -1, out_size, ws_size, (size_t)WS_END); grid = -1; return; }
        int dev = 0, cus = 0, per_cu = 0;
        if (hipGetDevice(&dev) != hipSuccess || hipDeviceGetAttribute(&cus, hipDeviceAttributeMultiprocessorCount, dev) != hipSuccess) { fprintf(stderr, "kernel_launch: device query failed\n"); grid = -1; return; }
        if (hipFuncSetAttribute((const void*)fwd_kernel, hipFuncAttributeMaxDynamicSharedMemorySize, LDS_BYTES) != hipSuccess) { fprintf(stderr, "kernel_launch: hipFuncSetAttribute failed\n"); grid = -1; return; }
        if (hipOccupancyMaxActiveBlocksPerMultiprocessor(&per_cu, (const void*)fwd_kernel, NTHR, LDS_BYTES) != hipSuccess || per_cu < 1) { fprintf(stderr, "kernel_launch: occupancy query reports %d\n", per_cu); }
        (void)hipGetLastError();
        grid = cus;
        if (grid > 256) grid = 256;
        while (grid > 1 && (M % grid != 0 || M / grid > 256)) --grid;
        if (grid != 256) fprintf(stderr, "kernel_launch: note: grid %d\n", grid);
    }
    if (grid < 0) return;
    if (hipMemsetAsync((char*)d_ws + WS_CTL, 0, CTL_ZERO_BYTES, stream) != hipSuccess) { fprintf(stderr, "kernel_launch: memset failed\n"); return; }
    Args a{};
    for (int i = 0; i < 33; ++i) a.in[i] = (const float*)d_in[i];
    a.out = (float*)d_out; a.ws = (unsigned char*)d_ws;
#if MK_PER_PHASE
    for (int p = 0; p < N_PHASES; ++p) { a.ph_lo = p; a.ph_hi = p + 1; a.use_bar = 0; a.pad = 0; hipLaunchKernelGGL(fwd_kernel, dim3(grid), dim3(NTHR), LDS_BYTES, stream, a); }
#else
    a.ph_lo = 0; a.ph_hi = N_PHASES; a.use_bar = 1; a.pad = 0;
    hipLaunchKernelGGL(fwd_kernel, dim3(grid), dim3(NTHR), LDS_BYTES, stream, a);
#endif
    const hipError_t le = hipPeekAtLastError();
    if (le != hipSuccess) fprintf(stderr, "kernel_launch: launch failed: %s\n", hipGetErrorName(le));
}
```

```cpp
#include <hip/hip_runtime.h>
#include <cstdio>
#include <cstdint>
#ifndef HD
#define HD __host__ __device__ __forceinline__
#endif
__device__ __forceinline__ int opq_tid() { int t = (int)threadIdx.x; asm volatile("" : "+v"(t)); return t; }
typedef float f32x2_cv __attribute__((ext_vector_type(2))); typedef __bf16 bf16x2_cv __attribute__((ext_vector_type(2)));
__device__ __forceinline__ unsigned cvtpk_hw(float lo, float hi) { f32x2_cv v = {lo, hi}; bf16x2_cv b = __builtin_convertvector(v, bf16x2_cv); return __builtin_bit_cast(unsigned, b); }
#ifdef CHAOS
#ifndef CHAOS_MASK
#define CHAOS_MASK 0xff
#endif
__device__ __forceinline__ void chaos_point(unsigned k) {
    const unsigned t = (unsigned)__builtin_amdgcn_s_memtime();
    unsigned r = (t >> 3) * 2654435761u + k * 40503u + (unsigned)__builtin_amdgcn_s_getreg(63492) * 97u;
    r ^= r >> 15;
    if ((r & 3u) == 0u) { if (r & 4u) __builtin_amdgcn_s_sleep(13); if (r & 8u) __builtin_amdgcn_s_sleep(37); if (r & 16u) __builtin_amdgcn_s_sleep(90); }
}
#define CHAOS_POINT(grp, k) do { if ((CHAOS_MASK) & (grp)) chaos_point(k); } while (0)
#else
#define CHAOS_POINT(grp, k) do {} while (0)
#endif

#if defined(__HIP__)
typedef float cf __attribute__((ext_vector_type(2)));
HD cf mk(float a, float b) { return (cf){a, b}; }
HD cf cadd(cf a, cf b) { return a + b; }
HD cf csub(cf a, cf b) { return a - b; }
#if defined(__HIP_DEVICE_COMPILE__) && !defined(FFT_NO_ASM)
HD cf cmul(cf a, cf b) { cf t, r;
    asm("v_pk_mul_f32 %0, %1, %2 op_sel:[1,1] op_sel_hi:[0,1]" : "=v"(t) : "v"(a), "v"(b));
    asm("v_pk_fma_f32 %0, %1, %2, %3 op_sel:[0,0,0] op_sel_hi:[1,0,1] neg_lo:[0,0,1]" : "=v"(r) : "v"(a), "v"(b), "v"(t)); return r; }
HD cf cmulc(cf a, cf b) { cf t, r;
    asm("v_pk_mul_f32 %0, %1, %2 op_sel:[1,1] op_sel_hi:[0,1]" : "=v"(t) : "v"(a), "v"(b));
    asm("v_pk_fma_f32 %0, %1, %2, %3 op_sel:[0,0,0] op_sel_hi:[1,0,1] neg_hi:[0,0,1]" : "=v"(r) : "v"(a), "v"(b), "v"(t)); return r; }
HD cf cmul_s(cf a, cf b) { cf t, r;
    asm("v_pk_mul_f32 %0, %1, %2 op_sel:[1,1] op_sel_hi:[0,1]" : "=v"(t) : "v"(a), "s"(b));
    asm("v_pk_fma_f32 %0, %1, %2, %3 op_sel:[0,0,0] op_sel_hi:[1,0,1] neg_lo:[0,0,1]" : "=v"(r) : "v"(a), "s"(b), "v"(t)); return r; }
HD cf cmulc_s(cf a, cf b) { cf t, r;
    asm("v_pk_mul_f32 %0, %1, %2 op_sel:[1,1] op_sel_hi:[0,1]" : "=v"(t) : "v"(a), "s"(b));
    asm("v_pk_fma_f32 %0, %1, %2, %3 op_sel:[0,0,0] op_sel_hi:[1,0,1] neg_hi:[0,0,1]" : "=v"(r) : "v"(a), "s"(b), "v"(t)); return r; }
HD cf add_mi(cf a, cf b) { cf r; asm("v_pk_add_f32 %0, %1, %2 op_sel:[0,1] op_sel_hi:[1,0] neg_hi:[0,1]" : "=v"(r) : "v"(a), "v"(b)); return r; }
HD cf add_pi(cf a, cf b) { cf r; asm("v_pk_add_f32 %0, %1, %2 op_sel:[0,1] op_sel_hi:[1,0] neg_lo:[0,1]" : "=v"(r) : "v"(a), "v"(b)); return r; }
#else
HD cf cmul(cf a, cf b) { return mk(a.x * b.x - a.y * b.y, a.x * b.y + a.y * b.x); }
HD cf cmulc(cf a, cf b) { return mk(a.x * b.x + a.y * b.y, a.y * b.x - a.x * b.y); }
HD cf cmul_s(cf a, cf b) { return cmul(a, b); }
HD cf cmulc_s(cf a, cf b) { return cmulc(a, b); }
HD cf add_mi(cf a, cf b) { return mk(a.x + b.y, a.y - b.x); }
HD cf add_pi(cf a, cf b) { return mk(a.x - b.y, a.y + b.x); }
#endif
HD cf cscale(cf a, float s) { return a * s; }
#else
struct cf { float x, y; };
HD cf mk(float a, float b) { cf r; r.x = a; r.y = b; return r; }
HD cf cadd(cf a, cf b) { return mk(a.x + b.x, a.y + b.y); }
HD cf csub(cf a, cf b) { return mk(a.x - b.x, a.y - b.y); }
HD cf cmul(cf a, cf b) { return mk(a.x * b.x - a.y * b.y, a.x * b.y + a.y * b.x); }
HD cf cmulc(cf a, cf b) { return mk(a.x * b.x + a.y * b.y, a.y * b.x - a.x * b.y); }
HD cf cmul_s(cf a, cf b) { return cmul(a, b); }
HD cf cmulc_s(cf a, cf b) { return cmulc(a, b); }
HD cf add_mi(cf a, cf b) { return mk(a.x + b.y, a.y - b.x); }
HD cf add_pi(cf a, cf b) { return mk(a.x - b.y, a.y + b.x); }
HD cf cscale(cf a, float s) { return mk(a.x * s, a.y * s); }
#endif
template <bool INV> HD cf cmulw(cf a, cf w) { return INV ? cmulc(a, w) : cmul(a, w); }
template <bool INV> HD cf cmulw_s(cf a, cf w) { return INV ? cmulc_s(a, w) : cmul_s(a, w); }

template <bool INV, bool ROT2 = false> HD void dft4(cf& a0, cf& a1, cf& a2, cf& a3) {
    const cf t0 = ROT2 ? (INV ? add_pi(a0, a2) : add_mi(a0, a2)) : cadd(a0, a2), t1 = ROT2 ? (INV ? add_mi(a0, a2) : add_pi(a0, a2)) : csub(a0, a2), t2 = cadd(a1, a3), t3 = csub(a1, a3);
    a0 = cadd(t0, t2); a2 = csub(t0, t2);
    if (!INV) { a1 = add_mi(t1, t3); a3 = add_pi(t1, t3); }
    else      { a1 = add_pi(t1, t3); a3 = add_mi(t1, t3); }
}
template <bool INV> HD void dft16(cf (&x)[16]) {
#pragma unroll
    for (int n1 = 0; n1 < 4; ++n1) dft4<INV>(x[n1], x[n1 + 4], x[n1 + 8], x[n1 + 12]);
    const float c1 = 0.92387953251128674f, s1 = 0.38268343236508977f, r2 = 0.70710678118654752f;
    const cf W1 = mk(c1, -s1), W2 = mk(r2, -r2), W3 = mk(s1, -c1), W6 = mk(-r2, -r2), W9 = mk(-c1, s1);
    x[1 + 4 * 1] = cmulw_s<INV>(x[1 + 4 * 1], W1);
    x[1 + 4 * 2] = cmulw_s<INV>(x[1 + 4 * 2], W2);
    x[1 + 4 * 3] = cmulw_s<INV>(x[1 + 4 * 3], W3);
    x[2 + 4 * 1] = cmulw_s<INV>(x[2 + 4 * 1], W2);
    x[2 + 4 * 3] = cmulw_s<INV>(x[2 + 4 * 3], W6);
    x[3 + 4 * 1] = cmulw_s<INV>(x[3 + 4 * 1], W3);
    x[3 + 4 * 2] = cmulw_s<INV>(x[3 + 4 * 2], W6);
    x[3 + 4 * 3] = cmulw_s<INV>(x[3 + 4 * 3], W9);
#pragma unroll
    for (int k2 = 0; k2 < 4; ++k2) { if (k2 == 2) dft4<INV, true>(x[0 + 4 * k2], x[1 + 4 * k2], x[2 + 4 * k2], x[3 + 4 * k2]); else dft4<INV>(x[0 + 4 * k2], x[1 + 4 * k2], x[2 + 4 * k2], x[3 + 4 * k2]); }
    cf t;
    t = x[1]; x[1] = x[4]; x[4] = t;   t = x[2]; x[2] = x[8]; x[8] = t;   t = x[3]; x[3] = x[12]; x[12] = t;
    t = x[6]; x[6] = x[9]; x[9] = t;   t = x[7]; x[7] = x[13]; x[13] = t; t = x[11]; x[11] = x[14]; x[14] = t;
}
template <bool INV> HD void twiddle16(cf (&x)[16], cf w1) {
    cf w = w1;
#pragma unroll
    for (int k = 1; k < 16; ++k) { x[k] = cmulw<INV>(x[k], w); if (k < 15) w = cmul(w, w1); }
}
constexpr int FFT_HALF = 4352;
constexpr int FFT_WORK = 2 * FFT_HALF;
HD int fphys(int h, int idx) { return h * FFT_HALF + idx + (idx >> 4); }

HD void geo1(int tid, int& h, int& j) { const int w = tid >> 6, l = tid & 63; h = l >> 5; j = 32 * w + (l & 31); }
HD void geo2(int tid, int& h, int& k1, int& j2) { h = tid >> 8; k1 = (tid >> 4) & 15; j2 = tid & 15; }
HD void geo3(int tid, int& h, int& blk) { h = tid >> 8; blk = tid & 255; }

HD int fbase1(int h, int j) { return h * FFT_HALF + j + (j >> 4); }
HD int fbase2(int h, int k1, int j2) { return h * FFT_HALF + 272 * k1 + j2; }
HD int fbase3(int h, int blk) { return h * FFT_HALF + 17 * blk; }
template <class L> HD void fwd_pass1(L lds, int b1, cf w4096j, cf (&x)[16]) {
    dft16<false>(x); twiddle16<false>(x, w4096j);
#pragma unroll
    for (int k = 0; k < 16; ++k) lds.st(b1 + 272 * k, x[k]);
}
template <class L> HD void fwd_pass2(L lds, int b2, cf w256j) {
    cf x[16];
#pragma unroll
    for (int m = 0; m < 16; ++m) x[m] = lds.ld(b2 + 17 * m);
    dft16<false>(x); twiddle16<false>(x, w256j);
#pragma unroll
    for (int k = 0; k < 16; ++k) lds.st(b2 + 17 * k, x[k]);
}
template <class L> HD void fwd_pass3_keep(L lds, int b3, cf (&x)[16]) {
#pragma unroll
    for (int m = 0; m < 16; ++m) x[m] = lds.ld(b3 + m);
    dft16<false>(x);
}
template <class L> HD void mid_pass3(L lds, int b3, const cf (&K)[16]) {
    cf x[16];
#pragma unroll
    for (int m = 0; m < 16; ++m) x[m] = lds.ld(b3 + m);
    dft16<false>(x);
#pragma unroll
    for (int k = 0; k < 16; ++k) x[k] = cmul(x[k], K[k]);
    dft16<true>(x);
#pragma unroll
    for (int m = 0; m < 16; ++m) lds.st(b3 + m, x[m]);
}
template <class L> HD void inv_pass2(L lds, int b2, cf w256j) {
    cf x[16];
#pragma unroll
    for (int k = 0; k < 16; ++k) x[k] = lds.ld(b2 + 17 * k);
    twiddle16<true>(x, w256j); dft16<true>(x);
#pragma unroll
    for (int m = 0; m < 16; ++m) lds.st(b2 + 17 * m, x[m]);
}
template <class L> HD void inv_pass1(L lds, int b1, cf w4096j, cf (&x)[16]) {
#pragma unroll
    for (int k = 0; k < 16; ++k) x[k] = lds.ld(b1 + 272 * k);
    twiddle16<true>(x, w4096j); dft16<true>(x);
}
#ifndef PG8_WGM
#define PG8_WGM 8
#endif
namespace pg8 {
#define PG8_LAS __attribute__((address_space(3)))
typedef unsigned short bf16_t;
typedef short bf16x8 __attribute__((ext_vector_type(8)));
typedef float f32x4 __attribute__((ext_vector_type(4)));
typedef unsigned u32x4 __attribute__((ext_vector_type(4)));
constexpr int BM = 256, BK = 64, HALF = 128, HTB = HALF * BK * 2  , STAGE_BYTES = 8 * HTB, NXCD = 8, WGM = PG8_WGM;

__host__ __device__ __forceinline__ int lds_byte(int r, int c) { const int st = (r >> 4) * 2 + (c >> 5), rr = r & 15, cc = c & 31, ob = rr * 64 + cc * 2; return st * 1024 + (ob ^ (((ob >> 9) & 1) << 5)); }
__host__ __device__ __forceinline__ void stage_rc(int b, int& R, int& C) { const int st = b / 1024, sb = b % 1024, swz = sb ^ (((sb >> 9) & 1) << 5); R = (st >> 1) * 16 + swz / 64; C = (st & 1) * 32 + (swz % 64) / 2; }
__host__ __device__ __forceinline__ int perm32(int rho) { const int n = rho >> 4, i = rho & 15; return 8 * (i >> 2) + 4 * n + (i & 3); }

typedef int v8i_t __attribute__((ext_vector_type(8))); typedef int v4i_t __attribute__((ext_vector_type(4)));
__device__ __forceinline__ v8i_t cat8(bf16x8 a, bf16x8 b) { const v4i_t x = __builtin_bit_cast(v4i_t, a), y = __builtin_bit_cast(v4i_t, b); return __builtin_shufflevector(x, y, 0, 1, 2, 3, 4, 5, 6, 7); }
struct Unit { int pm, pn; };
struct Gemm { const bf16_t* A; const bf16_t* Bt; int M, N, K; };

struct StaticOrder {
    int nM, nN, nwg, G, c;
    __host__ __device__ void init(int M, int N, int G_, int c_) { nM = M / BM; nN = N / BM; nwg = nM * nN; G = G_; c = c_; }
    __host__ __device__ bool next(int i, Unit& u) const {
        const long L = (long)i * G + c; if (L >= nwg) return false;
        int wgid = (int)L; { const int q = nwg / NXCD, r = nwg % NXCD, xcd = wgid % NXCD, off = wgid / NXCD; wgid = (xcd < r ? xcd * (q + 1) : r * (q + 1) + (xcd - r) * q) + off; }
        const int nig = WGM * nN, gid = wgid / nig, fm = gid * WGM, gsz = (nM - fm) < WGM ? (nM - fm) : WGM;
        u.pm = fm + ((wgid % nig) % gsz); u.pn = (wgid % nig) / gsz; return true;
    }
    __device__ __forceinline__ size_t boff(const Unit&) const { return 0; }
    __device__ __forceinline__ void a_ready(const Unit&) const {}
    __device__ __forceinline__ void done(const Unit&) const {}
};

__device__ __forceinline__ unsigned cvt_pk_bf16(float lo, float hi) { unsigned r; asm volatile("v_cvt_pk_bf16_f32 %0, %1, %2" : "=v"(r) : "v"(lo), "v"(hi)); return r; }
typedef float f32x2 __attribute__((ext_vector_type(2)));
typedef unsigned u32x2 __attribute__((ext_vector_type(2)));
__device__ __forceinline__ float row_rs(const float* ssp, int row, int fq) {
    if (!ssp) return 1.0f;
    const f32x4 q = *(const f32x4*)(ssp + (size_t)row * 16 + 4 * fq); float s = (q[0] + q[1]) + (q[2] + q[3]);
    s += __shfl_xor(s, 16); s += __shfl_xor(s, 32);
    return __builtin_amdgcn_rsqf(s * (1.0f / 1024.0f) + 1e-6f);
}
__device__ __forceinline__ void row_rs8(const float* ssp, int row0, int fq, float (&rs)[2][4]) {
    if (!ssp) {
#pragma unroll
        for (int ai = 0; ai < 2; ++ai)
#pragma unroll
            for (int m = 0; m < 4; ++m) rs[ai][m] = 1.0f;
        return; }
    f32x4 q[2][4];
#pragma unroll
    for (int ai = 0; ai < 2; ++ai)
#pragma unroll
        for (int m = 0; m < 4; ++m) q[ai][m] = *(const f32x4*)(ssp + (size_t)(row0 + ai * HALF + m * 16) * 16 + 4 * fq);
#pragma unroll
    for (int ai = 0; ai < 2; ++ai)
#pragma unroll
        for (int m = 0; m < 4; ++m) { float s = (q[ai][m][0] + q[ai][m][1]) + (q[ai][m][2] + q[ai][m][3]); s += __shfl_xor(s, 16); s += __shfl_xor(s, 32); rs[ai][m] = __builtin_amdgcn_rsqf(s * (1.0f / 1024.0f) + 1e-6f); }
}
__device__ __forceinline__ f32x4 row_rs4_swap(const float* ssp, int rowbase, int fr, int fq) {
    if (!ssp) return (f32x4){1.f, 1.f, 1.f, 1.f};
    const f32x4 q = *(const f32x4*)(ssp + (size_t)(rowbase + 4 * fq + (fr >> 2)) * 16 + 4 * (fr & 3)); float s = (q[0] + q[1]) + (q[2] + q[3]);
    s += __shfl_xor(s, 1); s += __shfl_xor(s, 2);
    const float rs = __builtin_amdgcn_rsqf(s * (1.0f / 1024.0f) + 1e-6f);
    f32x4 o;
#pragma unroll
    for (int r = 0; r < 4; ++r) o[r] = __shfl(rs, 16 * fq + 4 * r);
    return o;
}
template <bool F8 = false> struct EpiBf16T {
    static constexpr bool PERM = true, AFTER_DRAIN = false, SWAP = false, FP8 = F8;
    bf16_t* O; int ldc; const float* ss; float descale;
    __device__ __forceinline__ void operator()(const f32x4 (&acc)[2][2][4][2], const Unit& u, int wr, int wc, int fr, int fq) const {
        const int row0 = u.pm * BM + wr * 64 + fr, col0 = u.pn * BM + wc * 32 + 8 * fq;
        float rsa[2][4]; row_rs8(ss, row0, fq, rsa);
#pragma unroll
        for (int ai = 0; ai < 2; ++ai)
#pragma unroll
            for (int m = 0; m < 4; ++m) { bf16_t* rowp = O + (size_t)(row0 + ai * HALF + m * 16) * ldc + col0; const float rs = F8 ? rsa[ai][m] * descale : rsa[ai][m];
#pragma unroll
                for (int bj = 0; bj < 2; ++bj) { const f32x4 v0 = acc[ai][bj][m][0] * rs, v1 = acc[ai][bj][m][1] * rs;
                    u32x4 w; w.x = cvt_pk_bf16(v0[0], v0[1]); w.y = cvt_pk_bf16(v0[2], v0[3]); w.z = cvt_pk_bf16(v1[0], v1[1]); w.w = cvt_pk_bf16(v1[2], v1[3]);
                    *(u32x4*)(rowp + bj * HALF) = w; } }
    }
};
typedef EpiBf16T<false> EpiBf16;
struct EpiQKV {
    static constexpr bool PERM = true, AFTER_DRAIN = false, SWAP = false, FP8 = false;
    bf16_t* Q; bf16_t* Kb; bf16_t* Vb; const float* cosT; const float* sinT; const float* ss;
    __device__ __forceinline__ void operator()(const f32x4 (&acc)[2][2][4][2], const Unit& u, int wr, int wc, int fr, int fq) const {
        const int row0 = u.pm * BM + wr * 64 + fr;
        float rsa[2][4]; row_rs8(ss, row0, fq, rsa);
#pragma unroll
        for (int bj = 0; bj < 2; ++bj) {
            const int slot0 = u.pn * BM + bj * HALF + wc * 32 + 8 * fq;
            if (slot0 < 640) {
                const int head = slot0 >> 6, j4 = ((slot0 & 63) >> 3) * 4;
#pragma unroll
                for (int am = 0; am < 4; ++am) {
                    f32x4 c[2], sn[2];
                    const int tofs = ((row0 & 4095) + (am >> 1) * HALF + 2 * (am & 1) * 16) * 32 + j4;
                    const __attribute__((address_space(1))) float* cb = (const __attribute__((address_space(1))) float*)(cosT + tofs); const __attribute__((address_space(1))) float* sb = (const __attribute__((address_space(1))) float*)(sinT + tofs); asm volatile("" : "+v"(cb), "+v"(sb));
#pragma unroll
                    for (int h = 0; h < 2; ++h) { c[h] = *(const __attribute__((address_space(1))) f32x4*)(cb + h * 512); sn[h] = *(const __attribute__((address_space(1))) f32x4*)(sb + h * 512); }
#pragma unroll
                    for (int h = 0; h < 2; ++h) { const int ai = am >> 1, m = 2 * (am & 1) + h; const int row = row0 + ai * HALF + m * 16;
                        const float rs = rsa[ai][m]; const f32x4 lo = acc[ai][bj][m][0] * rs, hi = acc[ai][bj][m][1] * rs;
                        const f32x4 olo = lo * c[h] - hi * sn[h], ohi = hi * c[h] + lo * sn[h];
                        bf16_t* dst = head < 8 ? Q + (size_t)row * 512 + head * 64 + j4 : Kb + (size_t)row * 128 + (head - 8) * 64 + j4;
                        u32x2 w0, w1; w0.x = cvt_pk_bf16(olo[0], olo[1]); w0.y = cvt_pk_bf16(olo[2], olo[3]); w1.x = cvt_pk_bf16(ohi[0], ohi[1]); w1.y = cvt_pk_bf16(ohi[2], ohi[3]);
                        *(u32x2*)dst = w0; *(u32x2*)(dst + 32) = w1; } }
            } else {
#pragma unroll
                for (int ai = 0; ai < 2; ++ai)
#pragma unroll
                    for (int m = 0; m < 4; ++m) { const int row = row0 + ai * HALF + m * 16; const float rs = rsa[ai][m]; const f32x4 v0 = acc[ai][bj][m][0] * rs, v1 = acc[ai][bj][m][1] * rs;
                        u32x4 w; w.x = cvt_pk_bf16(v0[0], v0[1]); w.y = cvt_pk_bf16(v0[2], v0[3]); w.z = cvt_pk_bf16(v1[0], v1[1]); w.w = cvt_pk_bf16(v1[2], v1[3]);
                        *(u32x4*)(Vb + (size_t)row * 128 + (slot0 - 640)) = w; }
            }
        }
    }
};
struct EpiT {
    static constexpr bool PERM = false, AFTER_DRAIN = false, SWAP = true, FP8 = false;
    bf16_t* O; int nch; int ts_shift; const float* ss;
    __device__ __forceinline__ void operator()(const f32x4 (&acc)[2][2][4][2], const Unit& u, int wr, int wc, int fr, int fq) const {
        const int rowt = u.pm * BM, b = rowt >> ts_shift, tb = (rowt & ((1 << ts_shift) - 1)) + wr * 64 + 4 * fq;
#pragma unroll
        for (int ai = 0; ai < 2; ++ai) {
            f32x4 rsv[4];
#pragma unroll
            for (int m = 0; m < 4; ++m) rsv[m] = row_rs4_swap(ss, rowt + wr * 64 + ai * HALF + m * 16, fr, fq);
#pragma unroll
            for (int bj = 0; bj < 2; ++bj)
#pragma unroll
                for (int n = 0; n < 2; ++n) { const int ch = u.pn * BM + bj * HALF + wc * 32 + 16 * n + fr; bf16_t* chp = O + (((size_t)(b * nch + ch)) << ts_shift) + tb + ai * HALF;
#pragma unroll
                    for (int m = 0; m < 4; ++m) { const f32x4 v = acc[ai][bj][m][n] * rsv[m]; u32x2 w; w.x = cvt_pk_bf16(v[0], v[1]); w.y = cvt_pk_bf16(v[2], v[3]);
                        *(u32x2*)(chp + m * 16) = w; } } }
    }
};
struct EpiResB {
    static constexpr bool PERM = true, AFTER_DRAIN = false, SWAP = false, FP8 = false;
    bf16_t* xb; int ldc; float* ss; bf16_t* dst;
    __device__ __forceinline__ void operator()(const f32x4 (&acc)[2][2][4][2], const Unit& u, int wr, int wc, int fr, int fq) const {
        const int row0 = u.pm * BM + wr * 64 + fr, col0 = u.pn * BM + wc * 32 + 8 * fq;
#pragma unroll
        for (int ai = 0; ai < 2; ++ai) {
            u32x4 b[4][2];
#pragma unroll
            for (int m = 0; m < 4; ++m)
#pragma unroll
                for (int bj = 0; bj < 2; ++bj) b[m][bj] = *(const u32x4*)(xb + (size_t)(row0 + ai * HALF + m * 16) * ldc + col0 + bj * HALF);
#pragma unroll
            for (int m = 0; m < 4; ++m) { const int row = row0 + ai * HALF + m * 16; bf16_t* dstp = dst + (size_t)row * ldc + col0; float sq = 0.f;
#pragma unroll
                for (int bj = 0; bj < 2; ++bj) { const f32x4 a0 = acc[ai][bj][m][0], a1 = acc[ai][bj][m][1]; const u32x4 bb = b[m][bj]; float o[8];
                    o[0] = __builtin_bit_cast(float, bb.x << 16) + a0[0]; o[1] = __builtin_bit_cast(float, bb.x & 0xffff0000u) + a0[1];
                    o[2] = __builtin_bit_cast(float, bb.y << 16) + a0[2]; o[3] = __builtin_bit_cast(float, bb.y & 0xffff0000u) + a0[3];
                    o[4] = __builtin_bit_cast(float, bb.z << 16) + a1[0]; o[5] = __builtin_bit_cast(float, bb.z & 0xffff0000u) + a1[1];
                    o[6] = __builtin_bit_cast(float, bb.w << 16) + a1[2]; o[7] = __builtin_bit_cast(float, bb.w & 0xffff0000u) + a1[3];
#pragma unroll
                    for (int i = 0; i < 8; ++i) sq += o[i] * o[i];
                    u32x4 w; w.x = cvt_pk_bf16(o[0], o[1]); w.y = cvt_pk_bf16(o[2], o[3]); w.z = cvt_pk_bf16(o[4], o[5]); w.w = cvt_pk_bf16(o[6], o[7]);
                    *(u32x4*)(dstp + bj * HALF) = w; }
                if (ss) { sq += __shfl_xor(sq, 16); sq += __shfl_xor(sq, 32); if (fq == 0) ss[(size_t)row * 16 + u.pn * 4 + wc] = sq; } } }
    }
};
typedef float f32x2e __attribute__((ext_vector_type(2)));
__device__ __forceinline__ f32x2e silu_mul_pk(f32x2e g, f32x2e up) {
    const f32x2e t = g * (-1.44269504088896f); f32x2e e; e.x = __builtin_amdgcn_exp2f(t.x); e.y = __builtin_amdgcn_exp2f(t.y);
    const f32x2e d = e + 1.0f; f32x2e r; r.x = __builtin_amdgcn_rcpf(d.x); r.y = __builtin_amdgcn_rcpf(d.y);
    return (g * r) * up;
}
template <bool SCALE, bool F8 = false, bool F8OUT = false> struct EpiSwiglu {
    static constexpr bool PERM = true, AFTER_DRAIN = false, SWAP = false, FP8 = F8;
    bf16_t* O; int ldc; const float* ss;
    __device__ __forceinline__ void operator()(const f32x4 (&acc)[2][2][4][2], const Unit& u, int wr, int wc, int fr, int fq) const {
        const int row0 = u.pm * BM + wr * 64 + fr, col0 = u.pn * 128 + wc * 32 + 8 * fq;
        float rsa[2][4]; if (SCALE) row_rs8(ss, row0, fq, rsa);
#pragma unroll
        for (int ai = 0; ai < 2; ++ai)
#pragma unroll
            for (int m = 0; m < 4; ++m) { const int row = row0 + ai * HALF + m * 16; float sc = F8 ? 0.03125f : 1.0f; if (SCALE) sc *= rsa[ai][m];
                f32x2e o[4];
#pragma unroll
                for (int n = 0; n < 2; ++n) { f32x4 g = acc[ai][0][m][n], up = acc[ai][1][m][n]; if (SCALE || F8) { g = g * sc; up = up * sc; }
                    o[2 * n] = silu_mul_pk((f32x2e){g[0], g[1]}, (f32x2e){up[0], up[1]}); o[2 * n + 1] = silu_mul_pk((f32x2e){g[2], g[3]}, (f32x2e){up[2], up[3]}); }
                if (F8OUT) { int w0 = 0, w1 = 0; w0 = __builtin_amdgcn_cvt_pk_fp8_f32(o[0].x * 4.0f, o[0].y * 4.0f, w0, false); w0 = __builtin_amdgcn_cvt_pk_fp8_f32(o[1].x * 4.0f, o[1].y * 4.0f, w0, true);
                    w1 = __builtin_amdgcn_cvt_pk_fp8_f32(o[2].x * 4.0f, o[2].y * 4.0f, w1, false); w1 = __builtin_amdgcn_cvt_pk_fp8_f32(o[3].x * 4.0f, o[3].y * 4.0f, w1, true);
                    u32x2 w8; w8.x = (unsigned)w0; w8.y = (unsigned)w1; *(u32x2*)((unsigned char*)O + (size_t)row * ldc + col0) = w8; }
                else { u32x4 w; w.x = cvt_pk_bf16(o[0].x, o[0].y); w.y = cvt_pk_bf16(o[1].x, o[1].y); w.z = cvt_pk_bf16(o[2].x, o[2].y); w.w = cvt_pk_bf16(o[3].x, o[3].y);
                    *(u32x4*)(O + (size_t)row * ldc + col0) = w; } }
    }
};
template <class Epi, class Sched, bool ALIGN_EPI = false, bool SP2 = false>
__device__ __forceinline__ void gemm_phase(PG8_LAS unsigned char* lds, const Gemm g, const Sched& S, const Epi& E) {
    const int tid = opq_tid(), wid = __builtin_amdgcn_readfirstlane(tid >> 6), lane = tid & 63, wr = wid >> 2, wc = wid & 3, fr = lane & 15, fq = lane >> 4;
    const int K = g.K, nt = K / BK;
    unsigned voffA[2], voffB[2];
#pragma unroll
    for (int i = 0; i < 2; ++i) { int R, C; stage_rc(tid * 16 + i * 8192, R, C); const int Rb = Epi::PERM ? ((R & ~31) + perm32(R & 31)) : R;
        voffA[i] = (unsigned)(R * K + C) * 2u; voffB[i] = (unsigned)(Rb * K + C) * 2u; }
    const size_t kstep = (size_t)(BK * 2);
    const size_t hstep = (size_t)HALF * K * 2;
    const size_t tstep = 2 * hstep;
    const unsigned ldsw = (unsigned)wid * 1024u;
    const int aoff = lds_byte(wr * 64 + fr, fq * 8), boff = lds_byte(wc * 32 + fr, fq * 8);
#define PG8_SA(b, h) (((b) * 2 + (h)) * HTB)
#define PG8_SB(b, h) ((4 + (b) * 2 + (h)) * HTB)
#define PG8_STAGE(bufoff, gbase, voff) do { _Pragma("unroll") for (int _i = 0; _i < 2; ++_i) \
        __builtin_amdgcn_global_load_lds((const unsigned*)((const char*)(gbase) + (voff)[_i]), (PG8_LAS unsigned*)(lds + (bufoff) + ldsw + _i * 8192), 16, 0, 0); } while (0)
#define PG8_LDA(dst, b, h) do { if constexpr (Epi::FP8) { _Pragma("unroll") for (int m = 0; m < 4; ++m) dst##8[m] = cat8(*(const PG8_LAS bf16x8*)(lds + PG8_SA(b, h) + aoff + m * 2048), *(const PG8_LAS bf16x8*)(lds + PG8_SA(b, h) + aoff + m * 2048 + 1024)); } else { \
        _Pragma("unroll") for (int m = 0; m < 4; ++m) _Pragma("unroll") for (int k = 0; k < 2; ++k) dst[m][k] = *(const PG8_LAS bf16x8*)(lds + PG8_SA(b, h) + aoff + m * 2048 + k * 1024); } } while (0)
#define PG8_LDB(dst, b, h) do { if constexpr (Epi::FP8) { _Pragma("unroll") for (int n = 0; n < 2; ++n) dst##8[n] = cat8(*(const PG8_LAS bf16x8*)(lds + PG8_SB(b, h) + boff + n * 2048), *(const PG8_LAS bf16x8*)(lds + PG8_SB(b, h) + boff + n * 2048 + 1024)); } else { \
        _Pragma("unroll") for (int n = 0; n < 2; ++n) _Pragma("unroll") for (int k = 0; k < 2; ++k) dst[n][k] = *(const PG8_LAS bf16x8*)(lds + PG8_SB(b, h) + boff + n * 2048 + k * 1024); } } while (0)
#define PG8_MMA(ai, bj, At, Bt) do { __builtin_amdgcn_s_setprio(1); if constexpr (Epi::FP8) { _Pragma("unroll") for (int m = 0; m < 4; ++m) _Pragma("unroll") for (int n = 0; n < 2; ++n) \
        asm volatile("v_mfma_scale_f32_16x16x128_f8f6f4 %0, %1, %2, %0, %3, %3 op_sel_hi:[0,0,0]" : "+v"(acc[ai][bj][m][n]) : "v"(Bt##8[n]), "v"(At##8[m]), "v"(f8one)); } else { \
        _Pragma("unroll") for (int m = 0; m < 4; ++m) _Pragma("unroll") for (int n = 0; n < 2; ++n) _Pragma("unroll") for (int k = 0; k < 2; ++k) \
        acc[ai][bj][m][n] = Epi::SWAP ? __builtin_amdgcn_mfma_f32_16x16x32_bf16(At[m][k], Bt[n][k], acc[ai][bj][m][n], 0, 0, 0) : __builtin_amdgcn_mfma_f32_16x16x32_bf16(Bt[n][k], At[m][k], acc[ai][bj][m][n], 0, 0, 0); } __builtin_amdgcn_s_setprio(0); } while (0)
#define PG8_WAIT_V(n) asm volatile("s_waitcnt vmcnt(" #n ")" ::: "memory")
#define PG8_WAIT_L(n) asm volatile("s_waitcnt lgkmcnt(" #n ")" ::: "memory")
#define PG8_BAR __builtin_amdgcn_s_barrier()
#define PG8_SCHED __builtin_amdgcn_sched_barrier(0)
#ifdef DIAG
    unsigned long long dg_k = 0, dg_e = 0, dg_t1 = 0, dg_t2 = 0; const unsigned long long dg_t0 = wall_clock64();
#endif
    Unit cur, nxt; int ui = 0;
    if (!S.next(0, cur)) return;
    f32x4 acc[2][2][4][2];
#pragma unroll
    for (int a = 0; a < 2; ++a)
#pragma unroll
        for (int b = 0; b < 2; ++b)
#pragma unroll
            for (int m = 0; m < 4; ++m)
#pragma unroll
                for (int n = 0; n < 2; ++n) acc[a][b][m][n] = (f32x4){0.f, 0.f, 0.f, 0.f};
    bf16x8 At[4][2], B0[2][2], B1[2][2]; v8i_t At8[4], B08[2], B18[2];
    int f8one = 0x7F7F7F7F; asm volatile("" : "+v"(f8one));
    const char* cA = (const char*)g.A + (size_t)cur.pm * tstep; const char* cB = (const char*)g.Bt + S.boff(cur) + (size_t)cur.pn * tstep;
    S.a_ready(cur);
    if constexpr (SP2) {
        PG8_STAGE(PG8_SB(0, 0), cB, voffB); PG8_STAGE(PG8_SB(0, 1), cB + hstep, voffB); PG8_STAGE(PG8_SA(0, 0), cA, voffA); PG8_STAGE(PG8_SA(0, 1), cA + hstep, voffA);
        if (wr == 1) PG8_BAR;
        PG8_WAIT_V(2); PG8_BAR;
        PG8_STAGE(PG8_SB(1, 0), cB + kstep, voffB); PG8_STAGE(PG8_SA(1, 0), cA + kstep, voffA); PG8_STAGE(PG8_SB(1, 1), cB + hstep + kstep, voffB);
        PG8_WAIT_V(6); PG8_BAR;
    } else {
        PG8_STAGE(PG8_SB(0, 0), cB, voffB); PG8_STAGE(PG8_SA(0, 0), cA, voffA); PG8_STAGE(PG8_SB(0, 1), cB + hstep, voffB); PG8_STAGE(PG8_SA(0, 1), cA + hstep, voffA);
        if (wr == 1) PG8_BAR;
        PG8_WAIT_V(4); PG8_BAR;
        PG8_STAGE(PG8_SB(1, 0), cB + kstep, voffB); PG8_STAGE(PG8_SA(1, 0), cA + kstep, voffA); PG8_STAGE(PG8_SB(1, 1), cB + hstep + kstep, voffB);
        PG8_WAIT_V(6); PG8_BAR;
    }
    for (;;) {
        const bool has_next = S.next(ui + 1, nxt);
        const char* nA = has_next ? (const char*)g.A + (size_t)nxt.pm * tstep : cA; const char* nB = has_next ? (const char*)g.Bt + S.boff(nxt) + (size_t)nxt.pn * tstep : cB;
#ifdef DIAG
        dg_t1 = wall_clock64();
#endif
        CHAOS_POINT(4, 41);
        for (int t = 0; t < nt; t += 2) { CHAOS_POINT(8, 42);
            const bool last = (t == nt - 2);
            const char* a1 = cA + (size_t)(t + 1) * kstep;
            const char* a2 = last ? nA : cA + (size_t)(t + 2) * kstep; const char* b2 = last ? nB : cB + (size_t)(t + 2) * kstep;
            const char* a3 = a2 + kstep; const char* b3 = b2 + kstep;
            if (last && has_next) S.a_ready(nxt);
            if constexpr (SP2) {
            PG8_LDB(B0, 0, 0); PG8_LDB(B1, 0, 1); PG8_SCHED; PG8_LDA(At, 0, 0); PG8_STAGE(PG8_SA(1, 1), a1 + hstep, voffA);
            PG8_WAIT_V(8); PG8_WAIT_L(0); PG8_BAR; PG8_MMA(0, 0, At, B0); PG8_MMA(0, 1, At, B1); PG8_BAR; PG8_SCHED;
            PG8_LDA(At, 0, 1); PG8_STAGE(PG8_SB(0, 0), b2, voffB); PG8_STAGE(PG8_SB(0, 1), b2 + hstep, voffB); PG8_STAGE(PG8_SA(0, 0), a2, voffA);
            PG8_WAIT_V(8); PG8_WAIT_L(0); PG8_BAR; PG8_MMA(1, 0, At, B0); PG8_MMA(1, 1, At, B1); PG8_BAR; PG8_SCHED;
            PG8_LDB(B0, 1, 0); PG8_LDB(B1, 1, 1); PG8_SCHED; PG8_LDA(At, 1, 0); PG8_STAGE(PG8_SA(0, 1), a2 + hstep, voffA);
            PG8_WAIT_V(8); PG8_WAIT_L(0); PG8_BAR; PG8_MMA(0, 0, At, B0); PG8_MMA(0, 1, At, B1); PG8_BAR; PG8_SCHED;
            PG8_LDA(At, 1, 1); PG8_STAGE(PG8_SB(1, 0), b3, voffB); PG8_STAGE(PG8_SB(1, 1), b3 + hstep, voffB); PG8_STAGE(PG8_SA(1, 0), a3, voffA);
            PG8_WAIT_V(8); PG8_WAIT_L(0); PG8_BAR; PG8_MMA(1, 0, At, B0); PG8_MMA(1, 1, At, B1); PG8_BAR; PG8_SCHED;
            } else {
            PG8_LDB(B0, 0, 0); PG8_SCHED; PG8_LDA(At, 0, 0); PG8_STAGE(PG8_SA(1, 1), a1 + hstep, voffA);
            PG8_WAIT_L(8); PG8_BAR; PG8_WAIT_L(0); PG8_MMA(0, 0, At, B0); PG8_BAR; PG8_SCHED;
            PG8_LDB(B1, 0, 1); PG8_STAGE(PG8_SB(0, 0), b2, voffB);
            PG8_BAR; PG8_WAIT_L(0); PG8_MMA(0, 1, At, B1); PG8_BAR;
            PG8_LDA(At, 0, 1); PG8_STAGE(PG8_SA(0, 0), a2, voffA);
            PG8_BAR; PG8_WAIT_L(0); PG8_MMA(1, 0, At, B0); PG8_BAR; PG8_SCHED;
            PG8_STAGE(PG8_SB(0, 1), b2 + hstep, voffB);
            PG8_WAIT_V(6); PG8_BAR; PG8_MMA(1, 1, At, B1); PG8_BAR;
            PG8_LDB(B0, 1, 0); PG8_SCHED; PG8_LDA(At, 1, 0); PG8_STAGE(PG8_SA(0, 1), a2 + hstep, voffA);
            PG8_WAIT_L(8); PG8_BAR; PG8_WAIT_L(0); PG8_MMA(0, 0, At, B0); PG8_BAR; PG8_SCHED;
            PG8_LDB(B1, 1, 1); PG8_STAGE(PG8_SB(1, 0), b3, voffB);
            PG8_BAR; PG8_WAIT_L(0); PG8_MMA(0, 1, At, B1); PG8_BAR;
            PG8_LDA(At, 1, 1); PG8_STAGE(PG8_SA(1, 0), a3, voffA);
            PG8_BAR; PG8_WAIT_L(0); PG8_MMA(1, 0, At, B0); PG8_BAR; PG8_SCHED;
            PG8_STAGE(PG8_SB(1, 1), b3 + hstep, voffB);
            PG8_WAIT_V(6); PG8_BAR; PG8_MMA(1, 1, At, B1); PG8_BAR;
            }
        }
#ifdef DIAG
        dg_t2 = wall_clock64(); dg_k += dg_t2 - dg_t1;
#endif
        if constexpr (Epi::FP8) asm volatile("s_nop 15\n\ts_nop 15" ::: "memory");
        if constexpr (ALIGN_EPI) { if (wr == 0) PG8_BAR; }
#ifndef EPI_REP
#define EPI_REP 1
#endif
        CHAOS_POINT(4, 43);
        if constexpr (!Epi::AFTER_DRAIN) { _Pragma("unroll 1") for (int er_ = 0; er_ < EPI_REP; ++er_) E(acc, cur, wr, wc, fr, fq); S.done(cur); }
#ifdef DIAG
        dg_e += wall_clock64() - dg_t2;
#endif
        if (!has_next) break;
#pragma unroll
        for (int a = 0; a < 2; ++a)
#pragma unroll
            for (int b = 0; b < 2; ++b)
#pragma unroll
                for (int m = 0; m < 4; ++m)
#pragma unroll
                    for (int n = 0; n < 2; ++n) acc[a][b][m][n] = (f32x4){0.f, 0.f, 0.f, 0.f};
        cur = nxt; cA = nA; cB = nB; ++ui;
        if constexpr (ALIGN_EPI) { if (wr == 1) PG8_BAR; }
    }
#ifdef DIAG
    if (blockIdx.x == 0 && tid == 0) { unsigned long long* dg = (unsigned long long*)(*(const PG8_LAS unsigned long long*)(lds + 139328)); atomicAdd(dg + 0, dg_k); atomicAdd(dg + 1, dg_e); atomicAdd(dg + 2, wall_clock64() - dg_t0); atomicAdd(dg + 3, (unsigned long long)(ui + 1)); }
#endif
    PG8_WAIT_V(0);
    if constexpr (!ALIGN_EPI) { if (wr == 0) PG8_BAR; }
    PG8_BAR;
    if constexpr (Epi::AFTER_DRAIN) { E.fused(acc, cur, wr, wc, fr, fq, lds, wid, lane); S.done(cur); }
#undef PG8_SA
#undef PG8_SB
#undef PG8_STAGE
#undef PG8_LDA
#undef PG8_LDB
#undef PG8_MMA
#undef PG8_WAIT_V
#undef PG8_WAIT_L
#undef PG8_BAR
#undef PG8_SCHED
}
}
#ifndef PG8_SP2
#define PG8_SP2 true
#endif
#ifndef PG8_ALIGN
#define PG8_ALIGN true
#endif
constexpr int NB = 16, SEQ = 4096, D = 1024, M = NB * SEQ;
constexpr int NH = 8, NKV = 2, HDIM = 64, AW = 512, KVW = 128;
constexpr int HYW = 512, C3 = 1536, INC = 2304;
constexpr int XH = 4, XHD = 128, XW = 512, MEML = 256, MROWS = NB * MEML;
constexpr int FF = 2816, NE = 8, FFE = 3584;
constexpr float EPS = 1e-6f;
constexpr int NWAVES = 8, NTHR = 512;
constexpr int MOE_CH_TILES = 128, MOE_NCHUNK = 4, MOE_MAX_TILES = 520, MOE_MAX_ROWS = MOE_MAX_TILES * 256, MOE_ACT_TILES = MOE_MAX_TILES - (MOE_NCHUNK - 1) * MOE_CH_TILES;

constexpr size_t al256(size_t x) { return (x + 255) & ~(size_t)255; }
constexpr size_t WS_CTL = 0, CTL_ZERO_BYTES = 1u << 20;
constexpr size_t WS_SS = CTL_ZERO_BYTES, SS_STRIDE = (size_t)M * 16;
constexpr size_t WS_COS = WS_SS + 5 * SS_STRIDE * 4, WS_SIN = WS_COS + (size_t)SEQ * 32 * 4, WS_H2 = WS_SIN + (size_t)SEQ * 32 * 4;
constexpr size_t WS_TOKE = WS_H2 + (size_t)2 * SEQ * 64 * 4, WS_TOKW = WS_TOKE + (size_t)M * 2 * 4, WS_TOKP = WS_TOKW + (size_t)M * 2 * 4;
constexpr size_t WS_ROWTOK = WS_TOKP + (size_t)M * 2 * 4, WS_TILEE = WS_ROWTOK + al256((size_t)MOE_MAX_ROWS * 4), WS_WGCNT = WS_TILEE + 4096, WS_RSROW = WS_WGCNT + (size_t)1024 * 8 * 4, WS_META = WS_RSROW + (size_t)M * 4;
constexpr size_t WS_WINA = al256(WS_META + 4096);
constexpr size_t WS_WINB = WS_WINA + (size_t)2 * 768 * D * 2;
constexpr size_t WS_WOUT = WS_WINB + (size_t)2 * C3 * D * 2;
constexpr size_t WS_XQ = WS_WOUT + (size_t)2 * D * D * 2;
constexpr size_t WS_XK = WS_XQ + (size_t)2 * XW * D * 2;
constexpr size_t WS_XV = WS_XK + (size_t)2 * XW * D * 2;
constexpr size_t WS_XO = WS_XV + (size_t)2 * XW * D * 2;
constexpr size_t WS_FGU = WS_XO + (size_t)2 * D * XW * 2;
constexpr size_t WS_FDN = WS_FGU + (size_t)2 * FF * D * 2;
constexpr size_t WS_MGU = WS_FDN + (size_t)D * FF * 2;
constexpr size_t WS_MDN = WS_MGU + (size_t)NE * 2 * FFE * D;
constexpr size_t WS_KFILT = WS_MDN + (size_t)NE * D * FFE;
constexpr size_t WS_MB = WS_KFILT + (size_t)2 * 2 * HYW * 8192 * 4;
constexpr size_t WS_KMEM = WS_MB + (size_t)MROWS * D * 2;
constexpr size_t WS_VMEMT = WS_KMEM + (size_t)MROWS * 1024 * 2;
constexpr size_t WS_HB = WS_VMEMT + (size_t)1024 * MROWS * 2;
constexpr size_t WS_R = WS_HB + (size_t)M * D * 2;
constexpr size_t WS_QB = WS_R, WS_KB = WS_QB + (size_t)M * AW * 2, WS_VB = WS_KB + (size_t)M * KVW * 2, WS_UT = WS_VB + (size_t)M * KVW * 2;
constexpr size_t WS_MIXED = WS_UT;
constexpr size_t WS_AB = WS_UT + (size_t)M * C3 * 2, WS_YT = WS_AB + (size_t)M * AW * 2, WS_KSPEC = WS_YT + (size_t)M * HYW * 2, WS_MIXEND = WS_KSPEC + (size_t)2 * 2 * HYW * 16384 * 4;
constexpr size_t WS_XQB = WS_R, WS_XOB = WS_XQB + (size_t)M * XW * 2;
constexpr size_t WS_ACT = WS_R;
constexpr size_t WS_XG = WS_R;
constexpr size_t WS_MACT = WS_XG + (size_t)MOE_MAX_ROWS * D;
constexpr size_t WS_YB = WS_MACT + (size_t)MOE_ACT_TILES * 256 * FFE;
constexpr size_t WS_MOEEND = WS_YB + (size_t)MOE_MAX_ROWS * D * 2;
constexpr size_t cmax(size_t a, size_t b) { return a > b ? a : b; }
constexpr size_t WS_END = cmax(cmax(WS_MIXEND, WS_ACT + (size_t)M * FF * 2), WS_MOEEND);
static_assert(WS_END <= (size_t)1073741824, "workspace map exceeds 1 GiB");
static_assert(WS_ACT + (size_t)M * FF * 2 <= WS_KSPEC && WS_XOB + (size_t)M * XW * 2 <= WS_KSPEC, "layer 0's later phases must not touch the filter spectra");
constexpr int CW_TMO = 0, CW_CODE = 1, CW_BAR = 4096;

constexpr int PHASE_LDS = 155648;
constexpr int LDSCTL_OFF = PHASE_LDS, MISC_OFF = LDSCTL_OFF + 64;
constexpr int LDS_BYTES = PHASE_LDS + 512;

#define GAS __attribute__((address_space(1)))
#define LAS __attribute__((address_space(3)))
typedef unsigned short bf16;
typedef unsigned v4u __attribute__((ext_vector_type(4)));
typedef unsigned v2u __attribute__((ext_vector_type(2)));
typedef float f32x4 __attribute__((ext_vector_type(4)));
typedef short bf16x8 __attribute__((ext_vector_type(8)));
typedef short s16x4 __attribute__((ext_vector_type(4)));
typedef GAS unsigned gu32;
#define RLX_AGENT __ATOMIC_RELAXED, __HIP_MEMORY_SCOPE_AGENT
#define LDS_WAIT() asm volatile("s_waitcnt lgkmcnt(0)" ::: "memory")
#define VM_WAIT() asm volatile("s_waitcnt vmcnt(0)" ::: "memory")
__device__ __forceinline__ unsigned f2bf(float f) { unsigned u = __builtin_bit_cast(unsigned, f); return (u + 0x7fffu + ((u >> 16) & 1u)) >> 16; }
__device__ __forceinline__ unsigned pk2(float lo, float hi) { return cvtpk_hw(lo, hi); }
__device__ __forceinline__ float bflo(unsigned w) { return __builtin_bit_cast(float, w << 16); }
__device__ __forceinline__ float bfhi(unsigned w) { return __builtin_bit_cast(float, w & 0xffff0000u); }
__device__ __forceinline__ float bf1(unsigned short h) { return __builtin_bit_cast(float, ((unsigned)h) << 16); }
#define XB_TMO      128
#define XB_XCNT(j)  (256  + 64 * (j))
#define XB_XSUB(j)  (1280 + 64 * (j))
#define XB_XGEN(j)  (2304 + 64 * (j))
#define XB_TOP      3328
#define XB_TOPGEN   3392
#define XCD_BAR_WORDS 3456
#define XB_SPIN_CAP (1u << 22)

__device__ __forceinline__ unsigned xb_ld(unsigned* p)              { return __hip_atomic_load(p, __ATOMIC_RELAXED, __HIP_MEMORY_SCOPE_AGENT); }
__device__ __forceinline__ unsigned xb_add(unsigned* p, unsigned v) { return __hip_atomic_fetch_add(p, v, __ATOMIC_RELAXED, __HIP_MEMORY_SCOPE_AGENT); }
__device__ __forceinline__ unsigned xb_xcc_id() { return (unsigned)__builtin_amdgcn_s_getreg((3 << 11) | 20) & 0xFu; }
#define XB_SPIN(cond, bar) do { unsigned _sp = 0; while (cond) { __builtin_amdgcn_s_sleep(1); \
    if ((++_sp & 255u) == 0u) { if (xb_ld(&(bar)[XB_TMO])) break; if (_sp > XB_SPIN_CAP) { atomicAdd(&(bar)[XB_TMO], 1u); break; } } } } while (0)

struct XcdBarrier {
    unsigned* bar; unsigned x;
    volatile LAS unsigned* st;
};

__device__ __forceinline__ XcdBarrier xcd_barrier_post(unsigned* bar, volatile LAS unsigned* st) {
    XcdBarrier b; b.bar = bar; b.x = xb_xcc_id(); b.st = st;
    if (threadIdx.x == 0) (void)xb_add(&bar[XB_XCNT(b.x)], 1u);
    return b;
}
__device__ __forceinline__ void xcd_barrier_complete(unsigned* bar, unsigned x, unsigned& nloc, unsigned& nx) {
    const unsigned G = gridDim.x * gridDim.y * gridDim.z;
    unsigned sum, cnt, mine, sp = 0u;
    for (;;) {
        sum = 0u; cnt = 0u; mine = 0u;
#pragma unroll
        for (unsigned j = 0; j < 16; ++j) { const unsigned c = xb_ld(&bar[XB_XCNT(j)]); sum += c; cnt += (c > 0u) ? 1u : 0u; mine = (j == x) ? c : mine; }
        if (sum == G) break;
        __builtin_amdgcn_s_sleep(1);
        if ((++sp & 255u) == 0u) { if (xb_ld(&bar[XB_TMO])) break; if (sp > XB_SPIN_CAP) { atomicAdd(&bar[XB_TMO], 1u); break; } }
    }
    nloc = mine > 0u ? mine : 1u; nx = cnt > 0u ? cnt : 1u;
}

__device__ __forceinline__ void xcd_barrier(const XcdBarrier& b) {
    asm volatile("s_waitcnt vmcnt(0)" ::: "memory");
    __syncthreads();
    if (threadIdx.x == 0) {
        unsigned* bar = b.bar;
        __builtin_amdgcn_s_waitcnt(0);
        unsigned nloc = b.st[0], nx = b.st[1];
        if (nloc == 0u) { xcd_barrier_complete(bar, b.x, nloc, nx); b.st[0] = nloc; b.st[1] = nx; }
        const unsigned old = xb_add(&bar[XB_XSUB(b.x)], 1u);
        const unsigned gen = old / nloc;
        if (old + 1u == (gen + 1u) * nloc) {
            __builtin_amdgcn_fence(__ATOMIC_RELEASE, "agent");
            asm volatile("s_waitcnt vmcnt(0)" ::: "memory");
            const unsigned og = xb_add(&bar[XB_TOP], 1u);
            const unsigned tg = og / nx;
            if (og + 1u == (tg + 1u) * nx) xb_add(&bar[XB_TOPGEN], 1u);
            else XB_SPIN(xb_ld(&bar[XB_TOPGEN]) == tg, bar);
            __builtin_amdgcn_fence(__ATOMIC_ACQUIRE, "agent");
            xb_add(&bar[XB_XGEN(b.x)], 1u);
            asm volatile("s_waitcnt vmcnt(0)" ::: "memory");
        } else {
            XB_SPIN(xb_ld(&bar[XB_XGEN(b.x)]) == gen, bar);
            __builtin_amdgcn_fence(__ATOMIC_ACQUIRE, "agent");
            asm volatile("s_waitcnt vmcnt(0)" ::: "memory");
        }
    }
    __syncthreads();
}
struct Args { const float* in[33]; float* out; unsigned char* ws; int ph_lo, ph_hi, use_bar, pad; };
enum InIdx { I_X = 0, I_MEM, I_MEMNORM, I_MIXNORM, I_WIN, I_SINK, I_CONVW, I_CONVB, I_FW1, I_FB1, I_FFR1, I_FW2, I_FB2, I_FFR2, I_FW3, I_SKIP, I_ANORM, I_YNORM, I_WOUT, I_XNORM,
             I_XWQ, I_XWK, I_XWV, I_XWO, I_FNORM, I_FGATE, I_FUP, I_FDOWN, I_ROUTER, I_MGATE, I_MUP, I_MDOWN, I_FINAL };

__device__ __forceinline__ float wave_sum(float v) {
#pragma unroll
    for (int o = 1; o < 64; o <<= 1) v += __shfl_xor(v, o);
    return v;
}
__device__ __forceinline__ void wg_sync() { __builtin_amdgcn_sched_barrier(0); asm volatile("s_waitcnt vmcnt(0) lgkmcnt(0)" ::: "memory"); __builtin_amdgcn_s_barrier(); asm volatile("" ::: "memory"); __builtin_amdgcn_sched_barrier(0); }

template <int MODE> __device__ __forceinline__ int rowmap(int n) {
    if (MODE == 1) return n < 640 ? ((n & ~63) + 8 * ((n & 31) >> 2) + (n & 3) + 4 * ((n >> 5) & 1)) : n;
    if (MODE == 2) return ((n >> 7) << 8) + (n & 127);
    if (MODE == 3) return ((n >> 7) << 8) + 128 + (n & 127);
    return n;
}
__device__ __forceinline__ int rowmap_rt(int mode, int n) { return mode == 1 ? rowmap<1>(n) : mode == 2 ? rowmap<2>(n) : mode == 3 ? rowmap<3>(n) : n; }
__device__ __forceinline__ void tr_item(const float* W, int ldw, int K, int col0, int ncols, bf16* WT, int mode, const float* gk, int item, LAS float* scr, int lane) {
    const int nblk = ncols / 32, kb = item / nblk, nb = item % nblk, k0 = 64 * kb, n0 = 32 * nb;
    f32x4 tv[8];
#pragma unroll
    for (int i = 0; i < 8; ++i) { const int kk = 8 * i + (lane >> 3); tv[i] = *(const f32x4*)(W + (size_t)(k0 + kk) * ldw + col0 + n0 + 4 * (lane & 7)); }
#pragma unroll
    for (int i = 0; i < 8; ++i) { const int kk = 8 * i + (lane >> 3); const float gv = gk ? gk[k0 + kk] : 1.0f; LAS float* d = scr + kk * 33 + 4 * (lane & 7);
        d[0] = gv * tv[i][0]; d[1] = gv * tv[i][1]; d[2] = gv * tv[i][2]; d[3] = gv * tv[i][3]; }
    LDS_WAIT(); asm volatile("" ::: "memory");
    const int c = lane & 7;
#pragma unroll
    for (int j = 0; j < 4; ++j) { const int n = (lane >> 3) + 8 * j; const LAS float* sp = scr + (8 * c) * 33 + n;
        v4u o; o.x = pk2(sp[0 * 33], sp[1 * 33]); o.y = pk2(sp[2 * 33], sp[3 * 33]); o.z = pk2(sp[4 * 33], sp[5 * 33]); o.w = pk2(sp[6 * 33], sp[7 * 33]);
        *(v4u*)(WT + (size_t)rowmap_rt(mode, n0 + n) * K + k0 + 8 * c) = o; }
    LDS_WAIT(); asm volatile("" ::: "memory");
}
__device__ __forceinline__ void tr_item8(const float* W, int ldw, int K, int ncols, unsigned char* WT8, int mode, float wscale, int item, LAS float* scr, int lane) {
    const int nblk = ncols / 32, kb = item / nblk, nb = item % nblk, k0 = 64 * kb, n0 = 32 * nb;
    f32x4 tv[8];
#pragma unroll
    for (int i = 0; i < 8; ++i) { const int kk = 8 * i + (lane >> 3); tv[i] = *(const f32x4*)(W + (size_t)(k0 + kk) * ldw + n0 + 4 * (lane & 7)); }
#pragma unroll
    for (int i = 0; i < 8; ++i) { const int kk = 8 * i + (lane >> 3); LAS float* d = scr + kk * 33 + 4 * (lane & 7);
        d[0] = wscale * tv[i][0]; d[1] = wscale * tv[i][1]; d[2] = wscale * tv[i][2]; d[3] = wscale * tv[i][3]; }
    LDS_WAIT(); asm volatile("" ::: "memory");
    const int n = lane >> 1, half = lane & 1; const LAS float* sp = scr + (32 * half) * 33 + n;
    v4u o[2];
#pragma unroll
    for (int q = 0; q < 8; ++q) { int w = 0;
        w = __builtin_amdgcn_cvt_pk_fp8_f32(sp[(4 * q + 0) * 33], sp[(4 * q + 1) * 33], w, false);
        w = __builtin_amdgcn_cvt_pk_fp8_f32(sp[(4 * q + 2) * 33], sp[(4 * q + 3) * 33], w, true);
        o[q >> 2][q & 3] = (unsigned)w; }
    v4u* dst = (v4u*)(WT8 + (size_t)rowmap_rt(mode, n0 + n) * K + k0 + 32 * half);
    dst[0] = o[0]; dst[1] = o[1];
    LDS_WAIT(); asm volatile("" ::: "memory");
}
__device__ __forceinline__ void rms_row(const float* xrow, const float* gain, int lane, f32x4 (&v)[4]) {
    const f32x4* xr = (const f32x4*)xrow + lane; float s = 0.f;
#pragma unroll
    for (int j = 0; j < 4; ++j) { v[j] = xr[64 * j]; s += (v[j].x * v[j].x + v[j].y * v[j].y) + (v[j].z * v[j].z + v[j].w * v[j].w); }
    const float rs = 1.0f / sqrtf(wave_sum(s) * (1.f / 1024.f) + EPS);
    const f32x4* gr = (const f32x4*)gain + lane;
#pragma unroll
    for (int j = 0; j < 4; ++j) v[j] = v[j] * rs * gr[64 * j];
}
__device__ __forceinline__ void store_row_bf16(bf16* orow, int lane, const f32x4 (&v)[4]) {
    unsigned long long* o8 = (unsigned long long*)orow + lane;
#pragma unroll
    for (int j = 0; j < 4; ++j) o8[64 * j] = (unsigned long long)pk2(v[j].x, v[j].y) | ((unsigned long long)pk2(v[j].z, v[j].w) << 32);
}
__device__ __forceinline__ void xb_rows(const float* x, bf16* o, float* ss, int nrows, int gw, int NGW, int lane) {
#pragma unroll 1
    for (int r0 = gw; r0 < nrows; r0 += 2 * NGW) {
        const int r1 = r0 + NGW; const bool on1 = r1 < nrows; const int r1c = on1 ? r1 : r0;
        const f32x4* xa = (const f32x4*)(x + (size_t)r0 * D) + lane; const f32x4* xc = (const f32x4*)(x + (size_t)r1c * D) + lane; f32x4 va[4], vc[4];
#pragma unroll
        for (int j = 0; j < 4; ++j) { va[j] = xa[64 * j]; vc[j] = xc[64 * j]; }
        float sa = 0.f, sc = 0.f;
#pragma unroll
        for (int j = 0; j < 4; ++j) { sa += (va[j].x * va[j].x + va[j].y * va[j].y) + (va[j].z * va[j].z + va[j].w * va[j].w); sc += (vc[j].x * vc[j].x + vc[j].y * vc[j].y) + (vc[j].z * vc[j].z + vc[j].w * vc[j].w); }
        sa = wave_sum(sa); sc = wave_sum(sc);
        store_row_bf16(o + (size_t)r0 * D, lane, va); if (lane < 16) ss[(size_t)r0 * 16 + lane] = lane == 0 ? sa : 0.f;
        if (on1) { store_row_bf16(o + (size_t)r1 * D, lane, vc); if (lane < 16) ss[(size_t)r1 * 16 + lane] = lane == 0 ? sc : 0.f; }
    }
}
__device__ __forceinline__ void norm_rows(const float* x, const float* gain, bf16* o, int nrows, int gw, int NGW, int lane) {
    for (int r = gw; r < nrows; r += NGW) { f32x4 v[4]; rms_row(x + (size_t)r * D, gain, lane, v); store_row_bf16(o + (size_t)r * D, lane, v); }
}

constexpr int BA_KS = 72, BA_VS = 408, BA_KROWS = 400;
constexpr int BA_K_BYTES = BA_KROWS * BA_KS * 2, BA_V_BYTES = 64 * BA_VS * 2;
static_assert(BA_K_BYTES % 16 == 0 && BA_K_BYTES + BA_V_BYTES <= PHASE_LDS, "band attention LDS");
__device__ __forceinline__ bf16x8 cat4(s16x4 a, s16x4 b) { return __builtin_shufflevector(a, b, 0, 1, 2, 3, 4, 5, 6, 7); }
__device__ __forceinline__ unsigned cvtpk(float lo, float hi) { unsigned r; asm volatile("v_cvt_pk_bf16_f32 %0, %1, %2" : "=v"(r) : "v"(lo), "v"(hi)); return r; }

__device__ __forceinline__ void band_attention_phase(LAS unsigned char* lds, const bf16* Q, const bf16* Kb, const bf16* Vb, bf16* Ao, const float* sink, int G) {
    const int tid = opq_tid(), lane = tid & 63, wave = __builtin_amdgcn_readfirstlane(tid >> 6), fr = lane & 15, fq = lane >> 4;
    LAS bf16* Ks = (LAS bf16*)lds; LAS bf16* VTs = (LAS bf16*)(lds + BA_K_BYTES);
    for (int unit = blockIdx.x; unit < NB * 32 * NKV; unit += G) {
        const int kh = unit & 1, ib = (unit >> 1) & 31, b = unit >> 6;
        const int kbase = 128 * (ib - 1);
        for (int c = tid; c < BA_KROWS * 8; c += NTHR) { const int row = c >> 3, c8 = c & 7, kpos = kbase + row;
            v4u val = (v4u){0u, 0u, 0u, 0u};
            if (row < 384 && kpos >= 0 && kpos < SEQ) val = *(const v4u*)(Kb + ((size_t)(b * SEQ + kpos)) * KVW + kh * 64 + c8 * 8);
            *(LAS v4u*)(Ks + row * BA_KS + c8 * 8) = val; }
        for (int c = tid; c < BA_KROWS * 8; c += NTHR) { const int c8 = c / BA_KROWS, key = c % BA_KROWS, kpos = kbase + key;
            v4u val = (v4u){0u, 0u, 0u, 0u};
            if (key < 384 && kpos >= 0 && kpos < SEQ) val = *(const v4u*)(Vb + ((size_t)(b * SEQ + kpos)) * KVW + kh * 64 + c8 * 8);
            LAS bf16* dst = VTs + (c8 * 8) * BA_VS + key;
            dst[0 * BA_VS] = (bf16)(val.x & 0xffffu); dst[1 * BA_VS] = (bf16)(val.x >> 16); dst[2 * BA_VS] = (bf16)(val.y & 0xffffu); dst[3 * BA_VS] = (bf16)(val.y >> 16);
            dst[4 * BA_VS] = (bf16)(val.z & 0xffffu); dst[5 * BA_VS] = (bf16)(val.z >> 16); dst[6 * BA_VS] = (bf16)(val.w & 0xffffu); dst[7 * BA_VS] = (bf16)(val.w >> 16); }
        wg_sync(); CHAOS_POINT(2, 32);
        const int g = wave >> 1, half = wave & 1, head = kh * 4 + g;
        const float snk = sink[head];
        bf16x8 qn[2];
        { const size_t t0 = (size_t)b * SEQ + 128 * ib + 64 * half;
#pragma unroll
          for (int ks = 0; ks < 2; ++ks) qn[ks] = *(const bf16x8*)(Q + (t0 + fr) * AW + head * 64 + 32 * ks + 8 * fq); }
#pragma unroll 1
        for (int qt = 0; qt < 4; ++qt) { CHAOS_POINT(2, 31);
            const int p0 = 64 * half + 16 * qt;
            const size_t t0 = (size_t)b * SEQ + 128 * ib + p0;
            bf16x8 qf[2]; qf[0] = qn[0]; qf[1] = qn[1];
            if (qt < 3) {
#pragma unroll
                for (int ks = 0; ks < 2; ++ks) qn[ks] = *(const bf16x8*)(Q + (t0 + 16 + fr) * AW + head * 64 + 32 * ks + 8 * fq); }
            f32x4 s[18];
            const LAS bf16* kbase_p = Ks + (p0 + fr) * BA_KS + 8 * fq;
            bf16x8 kfa[3][2], kfb[3][2];
#pragma unroll
            for (int jj = 0; jj < 3; ++jj)
#pragma unroll
                for (int ks = 0; ks < 2; ++ks) kfa[jj][ks] = *(const LAS bf16x8*)(kbase_p + (16 * jj) * BA_KS + 32 * ks);
#pragma unroll
            for (int gq = 0; gq < 6; ++gq) {
                if (gq < 5) {
#pragma unroll
                    for (int jj = 0; jj < 3; ++jj)
#pragma unroll
                        for (int ks = 0; ks < 2; ++ks) { const bf16x8 t = *(const LAS bf16x8*)(kbase_p + (16 * (3 * (gq + 1) + jj)) * BA_KS + 32 * ks); if (gq & 1) kfa[jj][ks] = t; else kfb[jj][ks] = t; } }
                __builtin_amdgcn_sched_barrier(0);
#pragma unroll
                for (int jj = 0; jj < 3; ++jj) { const int j = 3 * gq + jj; s[j] = (f32x4){0.f, 0.f, 0.f, 0.f};
#pragma unroll
                    for (int ks = 0; ks < 2; ++ks) s[j] = __builtin_amdgcn_mfma_f32_16x16x32_bf16((gq & 1) ? kfb[jj][ks] : kfa[jj][ks], qf[ks], s[j], 0, 0, 0); }
                __builtin_amdgcn_sched_barrier(0);
            }
            float mx = -1e30f;
#pragma unroll
            for (int j = 0; j < 18; ++j)
#pragma unroll
                for (int r = 0; r < 4; ++r) { const int rel = 16 * j + 4 * fq + r - fr, idx = p0 + 16 * j + 4 * fq + r;
                    const bool ok = rel >= 0 && rel <= 256 && (ib > 0 || idx >= 128) && (ib < 31 || idx < 256);
                    const float v = ok ? s[j][r] * 0.125f : -1e30f; s[j][r] = v; mx = fmaxf(mx, v); }
            mx = fmaxf(mx, __shfl_xor(mx, 16)); mx = fmaxf(mx, __shfl_xor(mx, 32)); mx = fmaxf(mx, snk);
            float l = 0.f;
#pragma unroll
            for (int j = 0; j < 18; ++j)
#pragma unroll
                for (int r = 0; r < 4; ++r) { const float p = __expf(s[j][r] - mx); s[j][r] = p; l += p; }
            l += __shfl_xor(l, 16); l += __shfl_xor(l, 32); l += __expf(snk - mx);
            const float inv = 1.0f / l;
            f32x4 o[4];
#pragma unroll
            for (int dt = 0; dt < 4; ++dt) o[dt] = (f32x4){0.f, 0.f, 0.f, 0.f};
            const LAS bf16* vbase_p = VTs + fr * BA_VS + p0 + 4 * fq;
            s16x4 va[4][2], vb[4][2];
#pragma unroll
            for (int dt = 0; dt < 4; ++dt) { va[dt][0] = *(const LAS s16x4*)(vbase_p + (16 * dt) * BA_VS); va[dt][1] = *(const LAS s16x4*)(vbase_p + (16 * dt) * BA_VS + 16); }
#pragma unroll
            for (int kk = 0; kk < 9; ++kk) {
                if (kk < 8) {
#pragma unroll
                    for (int dt = 0; dt < 4; ++dt) { const s16x4 t0_ = *(const LAS s16x4*)(vbase_p + (16 * dt) * BA_VS + 32 * (kk + 1)), t1_ = *(const LAS s16x4*)(vbase_p + (16 * dt) * BA_VS + 32 * (kk + 1) + 16);
                        if (kk & 1) { va[dt][0] = t0_; va[dt][1] = t1_; } else { vb[dt][0] = t0_; vb[dt][1] = t1_; } } }
                v4u pw; pw.x = cvtpk(s[2 * kk][0], s[2 * kk][1]); pw.y = cvtpk(s[2 * kk][2], s[2 * kk][3]); pw.z = cvtpk(s[2 * kk + 1][0], s[2 * kk + 1][1]); pw.w = cvtpk(s[2 * kk + 1][2], s[2 * kk + 1][3]);
                const bf16x8 pf = __builtin_bit_cast(bf16x8, pw);
                __builtin_amdgcn_sched_barrier(0);
#pragma unroll
                for (int dt = 0; dt < 4; ++dt) { const bf16x8 vf = (kk & 1) ? cat4(vb[dt][0], vb[dt][1]) : cat4(va[dt][0], va[dt][1]);
                    o[dt] = __builtin_amdgcn_mfma_f32_16x16x32_bf16(vf, pf, o[dt], 0, 0, 0); }
                __builtin_amdgcn_sched_barrier(0);
            }
#pragma unroll
            for (int dt = 0; dt < 4; ++dt) { const f32x4 ov = o[dt] * inv; v2u w; w.x = cvtpk(ov[0], ov[1]); w.y = cvtpk(ov[2], ov[3]);
                *(v2u*)(Ao + (t0 + fr) * AW + head * 64 + 16 * dt + 4 * fq) = w; }
        }
        wg_sync(); CHAOS_POINT(2, 32);
    }
}

constexpr int XA_KS = 136, XA_VS = 264;
constexpr int XA_K_BYTES = MEML * XA_KS * 2, XA_V_BYTES = XHD * XA_VS * 2;
static_assert(XA_K_BYTES % 16 == 0 && XA_K_BYTES + XA_V_BYTES <= PHASE_LDS, "cross attention LDS");
__device__ __forceinline__ void cross_attention_phase(LAS unsigned char* lds, const bf16* Qx, const bf16* Kmem, const bf16* VmemT, bf16* Ox, int layer, int G) {
    const int tid = opq_tid(), lane = tid & 63, wave = __builtin_amdgcn_readfirstlane(tid >> 6), fr = lane & 15, fq = lane >> 4;
    LAS bf16* Ks = (LAS bf16*)lds; LAS bf16* VTs = (LAS bf16*)(lds + XA_K_BYTES);
    for (int unit = blockIdx.x; unit < 256; unit += G) {
        const int quarter = unit & 3, head = (unit >> 2) & 3, b = unit >> 4;
        for (int c = tid; c < MEML * 16; c += NTHR) { const int key = c >> 4, c8 = c & 15;
            *(LAS v4u*)(Ks + key * XA_KS + c8 * 8) = *(const v4u*)(Kmem + (size_t)(b * MEML + key) * 1024 + layer * 512 + head * 128 + c8 * 8); }
        for (int c = tid; c < XHD * 32; c += NTHR) { const int d = c >> 5, c8 = c & 31;
            *(LAS v4u*)(VTs + d * XA_VS + c8 * 8) = *(const v4u*)(VmemT + (size_t)(layer * 512 + head * 128 + d) * MROWS + b * MEML + c8 * 8); }
        wg_sync(); CHAOS_POINT(2, 32);
        bf16x8 qn[4];
        { const size_t t0 = (size_t)b * SEQ + (quarter * 4) * 256 + wave * 32;
#pragma unroll
          for (int ks = 0; ks < 4; ++ks) qn[ks] = *(const bf16x8*)(Qx + (t0 + fr) * XW + head * 128 + 32 * ks + 8 * fq); }
#pragma unroll 1
        for (int qi = 0; qi < 8; ++qi) {
            const size_t t0 = (size_t)b * SEQ + (quarter * 4 + (qi >> 1)) * 256 + wave * 32 + 16 * (qi & 1);
            bf16x8 qf[4];
#pragma unroll
            for (int ks = 0; ks < 4; ++ks) qf[ks] = qn[ks];
            if (qi < 7) { const size_t t1 = (size_t)b * SEQ + (quarter * 4 + ((qi + 1) >> 1)) * 256 + wave * 32 + 16 * ((qi + 1) & 1);
#pragma unroll
                for (int ks = 0; ks < 4; ++ks) qn[ks] = *(const bf16x8*)(Qx + (t1 + fr) * XW + head * 128 + 32 * ks + 8 * fq); }
            f32x4 s[16];
            const LAS bf16* kbase_p = Ks + fr * XA_KS + 8 * fq;
            bf16x8 kfa[2][4], kfb[2][4];
#pragma unroll
            for (int jj = 0; jj < 2; ++jj)
#pragma unroll
                for (int ks = 0; ks < 4; ++ks) kfa[jj][ks] = *(const LAS bf16x8*)(kbase_p + (16 * jj) * XA_KS + 32 * ks);
#pragma unroll
            for (int gq = 0; gq < 8; ++gq) {
                if (gq < 7) {
#pragma unroll
                    for (int jj = 0; jj < 2; ++jj)
#pragma unroll
                        for (int ks = 0; ks < 4; ++ks) { const bf16x8 t = *(const LAS bf16x8*)(kbase_p + (16 * (2 * (gq + 1) + jj)) * XA_KS + 32 * ks); if (gq & 1) kfa[jj][ks] = t; else kfb[jj][ks] = t; } }
                __builtin_amdgcn_sched_barrier(0);
#pragma unroll
                for (int jj = 0; jj < 2; ++jj) { const int j = 2 * gq + jj; s[j] = (f32x4){0.f, 0.f, 0.f, 0.f};
#pragma unroll
                    for (int ks = 0; ks < 4; ++ks) s[j] = __builtin_amdgcn_mfma_f32_16x16x32_bf16((gq & 1) ? kfb[jj][ks] : kfa[jj][ks], qf[ks], s[j], 0, 0, 0); }
                __builtin_amdgcn_sched_barrier(0);
            }
            float mx = -1e30f;
#pragma unroll
            for (int j = 0; j < 16; ++j)
#pragma unroll
                for (int r = 0; r < 4; ++r) { const float v = s[j][r] * 0.08838834764831845f; s[j][r] = v; mx = fmaxf(mx, v); }
            mx = fmaxf(mx, __shfl_xor(mx, 16)); mx = fmaxf(mx, __shfl_xor(mx, 32));
            float l = 0.f;
#pragma unroll
            for (int j = 0; j < 16; ++j)
#pragma unroll
                for (int r = 0; r < 4; ++r) { const float p = __expf(s[j][r] - mx); s[j][r] = p; l += p; }
            l += __shfl_xor(l, 16); l += __shfl_xor(l, 32);
            const float inv = 1.0f / l;
            f32x4 o[8];
#pragma unroll
            for (int dt = 0; dt < 8; ++dt) o[dt] = (f32x4){0.f, 0.f, 0.f, 0.f};
            const LAS bf16* vbase_p = VTs + fr * XA_VS + 4 * fq;
            s16x4 va[8][2], vb[8][2];
#pragma unroll
            for (int dt = 0; dt < 8; ++dt) { va[dt][0] = *(const LAS s16x4*)(vbase_p + (16 * dt) * XA_VS); va[dt][1] = *(const LAS s16x4*)(vbase_p + (16 * dt) * XA_VS + 16); }
#pragma unroll
            for (int kk = 0; kk < 8; ++kk) {
                if (kk < 7) {
#pragma unroll
                    for (int dt = 0; dt < 8; ++dt) { const s16x4 t0_ = *(const LAS s16x4*)(vbase_p + (16 * dt) * XA_VS + 32 * (kk + 1)), t1_ = *(const LAS s16x4*)(vbase_p + (16 * dt) * XA_VS + 32 * (kk + 1) + 16);
                        if (kk & 1) { va[dt][0] = t0_; va[dt][1] = t1_; } else { vb[dt][0] = t0_; vb[dt][1] = t1_; } } }
                v4u pw; pw.x = cvtpk(s[2 * kk][0], s[2 * kk][1]); pw.y = cvtpk(s[2 * kk][2], s[2 * kk][3]); pw.z = cvtpk(s[2 * kk + 1][0], s[2 * kk + 1][1]); pw.w = cvtpk(s[2 * kk + 1][2], s[2 * kk + 1][3]);
                const bf16x8 pf = __builtin_bit_cast(bf16x8, pw);
                __builtin_amdgcn_sched_barrier(0);
#pragma unroll
                for (int dt = 0; dt < 8; ++dt) { const bf16x8 vf = (kk & 1) ? cat4(vb[dt][0], vb[dt][1]) : cat4(va[dt][0], va[dt][1]);
                    o[dt] = __builtin_amdgcn_mfma_f32_16x16x32_bf16(vf, pf, o[dt], 0, 0, 0); }
                __builtin_amdgcn_sched_barrier(0);
            }
#pragma unroll
            for (int dt = 0; dt < 8; ++dt) { const f32x4 ov = o[dt] * inv; v2u w; w.x = cvtpk(ov[0], ov[1]); w.y = cvtpk(ov[2], ov[3]);
                *(v2u*)(Ox + (t0 + fr) * XW + head * 128 + 16 * dt + 4 * fq) = w; }
        }
        wg_sync(); CHAOS_POINT(2, 32);
    }
}
constexpr float HY_MIN_DECAY = -3.0701134573253944f;
constexpr float HY_MAX_DECAY = -15.350567286626972f;
__device__ __forceinline__ void h2_rows(const Args& a, float* H2, int gw, int NGW, int lane) {
    for (int idx = gw; idx < 2 * SEQ; idx += NGW) {
        const int l = idx >> 12, j = idx & 4095;
        const float* w1 = a.in[I_FW1] + l * 33 * 64; const float* b1 = a.in[I_FB1] + l * 64; const float* fr1 = a.in[I_FFR1] + l * 64;
        const float* w2 = a.in[I_FW2] + l * 64 * 64; const float* b2 = a.in[I_FB2] + l * 64; const float* fr2 = a.in[I_FFR2] + l * 64;
        const float w = 6.283185307179586f * (float)j / 4096.0f;
        const int mm = (lane - 1) & 15; const float f = 1e-4f + (float)mm * ((15.0f - 1e-4f) / 15.0f); const float ang = f * w;
        float zq = lane == 0 ? (float)j / 4095.0f : (lane <= 16 ? cosf(ang) : -sinf(ang));
        float acc = b1[lane];
#pragma unroll
        for (int q = 0; q < 33; ++q) acc += __shfl(zq, q) * w1[q * 64 + lane];
        const float h1 = sinf(fr1[lane] * acc);
        acc = b2[lane];
#pragma unroll
        for (int q = 0; q < 64; ++q) acc += __shfl(h1, q) * w2[q * 64 + lane];
        H2[(size_t)idx * 64 + lane] = sinf(fr2[lane] * acc);
    }
}
__device__ __forceinline__ void kfilt_phase(LAS unsigned char* lds, const float* H2, const float* w3all, float* KF, int G) {
    LAS float* ws = (LAS float*)lds;
    const int tid = opq_tid(), jj = tid & 63, cg = __builtin_amdgcn_readfirstlane(tid >> 6);
    for (int unit = blockIdx.x; unit < 2 * 64 * 32; unit += G) {
        const int cb = unit & 31, jb = (unit >> 5) & 63, l = unit >> 11;
        const float* w3 = w3all + (size_t)l * 64 * 2048;
        for (int e = tid; e < 4096; e += NTHR) ws[e] = w3[(size_t)(e >> 6) * 2048 + cb * 64 + (e & 63)];
        wg_sync();
        const int j = jb * 64 + jj;
        const f32x4* hr = (const f32x4*)(H2 + ((size_t)l * SEQ + j) * 64);
        float acc[8];
#pragma unroll
        for (int e = 0; e < 8; ++e) acc[e] = 0.f;
#pragma unroll
        for (int q = 0; q < 16; ++q) { const f32x4 hv = hr[q];
#pragma unroll
            for (int i = 0; i < 4; ++i) { const LAS f32x4* wp = (const LAS f32x4*)(ws + (4 * q + i) * 64 + cg * 8); const f32x4 wa = wp[0], wb = wp[1];
                acc[0] += hv[i] * wa[0]; acc[1] += hv[i] * wa[1]; acc[2] += hv[i] * wa[2]; acc[3] += hv[i] * wa[3];
                acc[4] += hv[i] * wb[0]; acc[5] += hv[i] * wb[1]; acc[6] += hv[i] * wb[2]; acc[7] += hv[i] * wb[3]; } }
        const float tj = (float)j / 4095.0f;
#pragma unroll
        for (int e = 0; e < 8; ++e) { const int col = cb * 64 + cg * 8 + e, dir = col >> 10, oc = col & 1023;
            const float delta = HY_MIN_DECAY + (float)oc * ((HY_MAX_DECAY - HY_MIN_DECAY) / 1023.0f);
            float val = acc[e] * expf(-tj * fabsf(delta));
            int n = dir == 0 ? j : 8192 - j;
            if (dir == 1 && j == 0) { n = 4096; val = 0.f; }
            KF[((size_t)(l * 1024 + oc)) * 8192 + n] = val; }
        wg_sync();
    }
}

constexpr int HY_RAWS = 4112;
constexpr int HY_ROWB = 2 * HY_RAWS * 2;
constexpr int HY_VB_OFF = FFT_WORK * 8;
constexpr int HY_X2_OFF = HY_VB_OFF + HY_ROWB;
constexpr int HY_X1_OFF = HY_X2_OFF + HY_ROWB;
constexpr int HY_EX_OFF = HY_X1_OFF + HY_ROWB;
constexpr int HY_YB_OFF = HY_EX_OFF + 16384;
static_assert(HY_VB_OFF % 16 == 0 && HY_ROWB % 16 == 0 && HY_YB_OFF + 2 * 4096 * 2 <= PHASE_LDS && HY_YB_OFF - HY_X1_OFF >= 4096 * 8 && HY_X1_OFF % 8 == 0, "hyena LDS map");
typedef float f32x2v __attribute__((ext_vector_type(2)));
struct LdsCf { LAS f32x2v* p; __device__ __forceinline__ cf ld(int i) const { const f32x2v t = p[i]; return mk(t.x, t.y); } __device__ __forceinline__ void st(int i, cf v) const { p[i] = (f32x2v){v.x, v.y}; } };

__device__ __forceinline__ void hy_dma_rows(LAS unsigned char* lds, int region_off, const bf16* UT, int b0, int ch, int wave, int lane) {
#pragma unroll
    for (int r = 0; r < 2; ++r)
        __builtin_amdgcn_global_load_lds((const unsigned*)(UT + (((size_t)((b0 + r) * C3 + ch)) << 12) + wave * 512 + lane * 8), (LAS unsigned*)(lds + region_off + r * HY_RAWS * 2 + 16 + wave * 1024), 16, 0, 0);
}
__device__ __forceinline__ void hy_pads(LAS unsigned char* lds, int region_off, int tid) {
    if (tid < 2) { LAS bf16* row = (LAS bf16*)(lds + region_off) + tid * HY_RAWS; row[7] = 0; row[8 + 4096] = 0; }
}
__device__ __forceinline__ float hy_conv(const LAS bf16* ldsh, int e, float w0, float w1, float w2, float bias) {
    return w0 * bf1(ldsh[e - 1]) + w1 * bf1(ldsh[e]) + w2 * bf1(ldsh[e + 1]) + bias;
}
__device__ __forceinline__ int opqi(int v) { asm volatile("" : "+v"(v)); return v; }
template <class T> __device__ __forceinline__ T* opqp(T* p) { asm volatile("" : "+v"(p)); return p; }
__device__ __forceinline__ cf opq(cf w) { asm volatile("" : "+v"(w)); return w; }
__device__ __forceinline__ cf csel(bool c, cf a, cf b) { return mk(c ? a.x : b.x, c ? a.y : b.y); }
__device__ __forceinline__ float uni(float v) { return __builtin_bit_cast(float, __builtin_amdgcn_readfirstlane(__builtin_bit_cast(int, v))); }
__device__ __forceinline__ void wave_lds_fence() { __builtin_amdgcn_sched_barrier(0); asm volatile("s_waitcnt lgkmcnt(0)" ::: "memory"); __builtin_amdgcn_sched_barrier(0); }
__device__ __forceinline__ void wg_sync_lds() { __builtin_amdgcn_sched_barrier(0); asm volatile("s_waitcnt lgkmcnt(0)" ::: "memory"); __builtin_amdgcn_s_barrier(); asm volatile("" ::: "memory"); __builtin_amdgcn_sched_barrier(0); }
__device__ __forceinline__ cf shfl_cf(cf v) { return mk(__shfl_xor(v.x, 32), __shfl_xor(v.y, 32)); }

__device__ __forceinline__ void kspec_phase(LAS unsigned char* lds, const float* KF, float* KSP, int G) {
    const int tid = opq_tid();
    LdsCf W; W.p = (LAS f32x2v*)lds;
    int h1, j1, h2, k1, j2, h3, blk; geo1(tid, h1, j1); geo2(tid, h2, k1, j2); geo3(tid, h3, blk);
    const int fb1 = opqi(fbase1(h1, j1)), fb2 = opqi(fbase2(h2, k1, j2)), fb3 = opqi(fbase3(h3, blk)), jo = opqi(j1);
    float sv, cv;
    sincospif(-(float)j1 / 4096.0f, &sv, &cv); const cf w8192j = mk(cv, sv);
    sincospif(-(float)j1 / 2048.0f, &sv, &cv); const cf w4096j = mk(cv, sv);
    sincospif(-(float)j2 / 128.0f, &sv, &cv);  const cf w256j = mk(cv, sv);
    const cf w32 = mk(0.98078528040323043f, -0.19509032201612825f);
#pragma unroll 1
    for (int unit = blockIdx.x; unit < 2 * 2 * HYW; unit += G) {
        const float* kf = KF + (size_t)unit * 8192;
        cf x[16]; cf wp = opq(w8192j);
#pragma unroll
        for (int m = 0; m < 16; ++m) { const float* kp = kf + opqi(jo + 1024 * (m >> 2)); const float ka = kp[256 * (m & 3)]; const float* kq = kp + opqi(4096); const float kb = kq[256 * (m & 3)];
            x[m] = csel(h1 == 0, mk(ka + kb, 0.f), cscale(wp, ka - kb)); wp = cmul(wp, w32); }
        CHAOS_POINT(32, 21); fwd_pass1(W, fb1, opq(w4096j), x); wg_sync(); CHAOS_POINT(32, 22);
        fwd_pass2(W, fb2, opq(w256j)); wave_lds_fence(); CHAOS_POINT(32, 23);
        { cf kk[16]; fwd_pass3_keep(W, fb3, kk); GAS f32x4* kd = opqp((GAS f32x4*)(KSP + (size_t)unit * 16384 + tid * 32));
#pragma unroll
          for (int q = 0; q < 8; ++q) kd[q] = (f32x4){kk[2 * q].x, kk[2 * q].y, kk[2 * q + 1].x, kk[2 * q + 1].y}; }
        wg_sync();
    }
}
__device__ __forceinline__ void mid_pass3g(LdsCf lds, int b3, const GAS f32x4* Kp) {
    f32x4 kv[8];
#pragma unroll
    for (int q = 0; q < 8; ++q) kv[q] = Kp[q];
    cf x[16];
#pragma unroll
    for (int m = 0; m < 16; ++m) x[m] = lds.ld(b3 + m);
    dft16<false>(x);
#pragma unroll
    for (int q = 0; q < 8; ++q) { x[2 * q] = cmul(x[2 * q], mk(kv[q][0], kv[q][1])); x[2 * q + 1] = cmul(x[2 * q + 1], mk(kv[q][2], kv[q][3])); }
    dft16<true>(x);
#pragma unroll
    for (int m = 0; m < 16; ++m) lds.st(b3 + m, x[m]);
}
#ifdef DIAG
#define HY_SYNC() do { const unsigned long long ts_ = wall_clock64(); wg_sync(); hy_wait_ += wall_clock64() - ts_; } while (0)
#else
#define HY_SYNC() wg_sync()
#endif
#ifdef PERTURB
#define HY_PERTURB0() do { __builtin_amdgcn_s_sleep(40); __builtin_amdgcn_s_sleep(100); } while (0)
#else
#define HY_PERTURB0() CHAOS_POINT(1, 11)
#endif
__device__ __forceinline__ void hyena_phase(LAS unsigned char* lds, const Args& a, int layer, const bf16* UT, const float* KSP, bf16* YT, int G) {
    const int tid = opq_tid();
#ifdef DIAG
    unsigned long long hy_wait_ = 0; const unsigned long long hy_t0_ = wall_clock64();
#endif
    LdsCf W; W.p = (LAS f32x2v*)lds;
    const int wave = __builtin_amdgcn_readfirstlane(tid >> 6), lane = tid & 63;
    int h1, j1, h2, k1, j2, h3, blk; geo1(tid, h1, j1); geo2(tid, h2, k1, j2); geo3(tid, h3, blk);
    const int fb1 = opqi(fbase1(h1, j1)), fb2 = opqi(fbase2(h2, k1, j2)), fb3 = opqi(fbase3(h3, blk));
    const int jo = opqi(j1), jh = opqi(j1 + 2048 * h1);
    LdsCf ZB; ZB.p = (LAS f32x2v*)lds; const int zo = opqi(HY_X1_OFF / 8 + j1), zh = opqi(HY_X1_OFF / 8 + j1 + 2048 * h1);
    LAS bf16* l16 = (LAS bf16*)lds; const int yh = opqi(HY_YB_OFF / 2 + j1 + 2048 * h1);
    const LAS bf16* ldsh = (const LAS bf16*)lds; const int ro = opqi(HY_VB_OFF / 2 + 8 + j1), rh = opqi(HY_VB_OFF / 2 + 8 + j1 + 2048 * h1);
    float sv, cv;
    sincospif(-(float)j1 / 4096.0f, &sv, &cv); const cf w8192j = mk(cv, sv);
    sincospif(-(float)j1 / 2048.0f, &sv, &cv); const cf w4096j = mk(cv, sv);
    sincospif(-(float)j2 / 128.0f, &sv, &cv);  const cf w256j = mk(cv, sv);
    const cf w32 = mk(0.98078528040323043f, -0.19509032201612825f);
    const float* cw = a.in[I_CONVW] + layer * 3 * C3; const float* cbv = a.in[I_CONVB] + layer * C3; const float* skp = a.in[I_SKIP] + layer * 2 * HYW;
    for (int c = blockIdx.x; c < HYW; c += G) {
        const float x1w0 = uni(cw[c]), x1w1 = uni(cw[C3 + c]), x1w2 = uni(cw[2 * C3 + c]), x1b = uni(cbv[c]);
        const float x2w0 = uni(cw[512 + c]), x2w1 = uni(cw[C3 + 512 + c]), x2w2 = uni(cw[2 * C3 + 512 + c]), x2b = uni(cbv[512 + c]);
        const float vw0 = uni(cw[1024 + c]), vw1 = uni(cw[C3 + 1024 + c]), vw2 = uni(cw[2 * C3 + 1024 + c]), vb = uni(cbv[1024 + c]);
        const float skip0 = uni(skp[c]), skip1 = uni(skp[HYW + c]);
        const float* KS0 = KSP + ((size_t)((layer * 2 + 0) * HYW + c)) * 16384 + opqi(tid * 32);
        const float* KS1 = KSP + ((size_t)((layer * 2 + 1) * HYW + c)) * 16384 + opqi(tid * 32);
        hy_dma_rows(lds, HY_VB_OFF, UT, 0, 1024 + c, wave, lane); hy_pads(lds, HY_VB_OFF, tid); hy_pads(lds, HY_X2_OFF, tid);
        HY_SYNC();
#pragma unroll 1
        for (int pr = 0; pr < 8; ++pr) {
            const int b0 = 2 * pr; CHAOS_POINT(1, 16);
            hy_dma_rows(lds, HY_X1_OFF, UT, b0, c, wave, lane); hy_dma_rows(lds, HY_X2_OFF, UT, b0, 512 + c, wave, lane); hy_pads(lds, HY_X1_OFF, tid);
            cf x[16];
            { cf wp = opq(w8192j);
#pragma unroll
              for (int m = 0; m < 16; ++m) {
                  const cf z = mk(hy_conv(ldsh, ro + 256 * m, vw0, vw1, vw2, vb), hy_conv(ldsh, ro + 256 * m + HY_RAWS, vw0, vw1, vw2, vb));
                  x[m] = csel(h1 == 0, z, cmul(z, wp)); wp = cmul(wp, w32); } }
            HY_PERTURB0();
            fwd_pass1(W, fb1, opq(w4096j), x); wg_sync_lds(); CHAOS_POINT(1, 12);
            fwd_pass2(W, fb2, opq(w256j)); wave_lds_fence(); CHAOS_POINT(1, 13);
            mid_pass3g(W, fb3, opqp((const GAS f32x4*)KS0)); wave_lds_fence(); CHAOS_POINT(1, 14);
            inv_pass2(W, fb2, opq(w256j)); HY_SYNC();
            CHAOS_POINT(1, 15); inv_pass1(W, fb1, opq(w4096j), x);
            cf zz[8];
            { cf wp = opq(w8192j);
#pragma unroll
              for (int m = 0; m < 16; ++m) { x[m] = csel(h1 == 1, cmulc(x[m], wp), x[m]); wp = cmul(wp, w32); }
#pragma unroll
              for (int i = 0; i < 8; ++i) { const cf xa_ = x[i], xb_ = x[8 + i]; const cf mine = csel(h1 == 1, xb_, xa_), send = csel(h1 == 1, xa_, xb_); const cf r = cscale(cadd(mine, shfl_cf(send)), 1.0f / 8192.0f);
                  const float va = hy_conv(ldsh, rh + 256 * i, vw0, vw1, vw2, vb), vbb = hy_conv(ldsh, rh + 256 * i + HY_RAWS, vw0, vw1, vw2, vb);
                  const float xa = hy_conv(ldsh, rh + 256 * i + (HY_X1_OFF - HY_VB_OFF) / 2, x1w0, x1w1, x1w2, x1b), xb = hy_conv(ldsh, rh + 256 * i + (HY_X1_OFF - HY_VB_OFF) / 2 + HY_RAWS, x1w0, x1w1, x1w2, x1b);
                  zz[i] = mk(xa * (r.x + skip0 * va), xb * (r.y + skip0 * vbb)); } }
            { cf wp = opq(w8192j);
#pragma unroll
              for (int i = 0; i < 8; ++i) { const cf pz = shfl_cf(zz[i]); x[i] = csel(h1 == 0, zz[i], pz); x[8 + i] = csel(h1 == 0, pz, zz[i]); }
#pragma unroll
              for (int m = 0; m < 16; ++m) { x[m] = csel(h1 == 0, x[m], cmul(x[m], wp)); wp = cmul(wp, w32); } }
            HY_PERTURB0();
            fwd_pass1(W, fb1, opq(w4096j), x); wg_sync_lds(); CHAOS_POINT(1, 12);
            if (pr < 7) hy_dma_rows(lds, HY_VB_OFF, UT, b0 + 2, 1024 + c, wave, lane);
            fwd_pass2(W, fb2, opq(w256j)); wave_lds_fence(); CHAOS_POINT(1, 13);
            mid_pass3g(W, fb3, opqp((const GAS f32x4*)KS1)); wave_lds_fence(); CHAOS_POINT(1, 14);
            inv_pass2(W, fb2, opq(w256j)); wg_sync_lds();
            CHAOS_POINT(1, 15); inv_pass1(W, fb1, opq(w4096j), x);
            { cf wp = opq(w8192j);
#pragma unroll
              for (int m = 0; m < 16; ++m) { x[m] = csel(h1 == 1, cmulc(x[m], wp), x[m]); wp = cmul(wp, w32); }
#pragma unroll
              for (int i = 0; i < 8; ++i) { const cf xa_ = x[i], xb_ = x[8 + i]; const cf mine = csel(h1 == 1, xb_, xa_), send = csel(h1 == 1, xa_, xb_); const cf r = cscale(cadd(mine, shfl_cf(send)), 1.0f / 8192.0f);
                  const int p = jh + 256 * i; const cf zv = zz[i];
                  const float xa = hy_conv(ldsh, rh + 256 * i + (HY_X2_OFF - HY_VB_OFF) / 2, x2w0, x2w1, x2w2, x2b), xb = hy_conv(ldsh, rh + 256 * i + (HY_X2_OFF - HY_VB_OFF) / 2 + HY_RAWS, x2w0, x2w1, x2w2, x2b);
                  const float ya = xa * (r.x + skip1 * zv.x), yb = xb * (r.y + skip1 * zv.y);
                  l16[yh + 256 * i] = (bf16)f2bf(ya); l16[yh + 256 * i + 4096] = (bf16)f2bf(yb); (void)p; } }
            HY_SYNC();
#pragma unroll
            for (int i = 0; i < 2; ++i) { const int q = tid + NTHR * i, row = q >> 9, cc = q & 511;
                *(v4u*)(YT + (((size_t)((b0 + row) * HYW + c)) << 12) + cc * 8) = *(const LAS v4u*)(l16 + HY_YB_OFF / 2 + row * 4096 + cc * 8); }
        }
    }
#ifdef DIAG
    if (blockIdx.x == 0 && tid == 0) { unsigned long long* dg = (unsigned long long*)(*(const LAS unsigned long long*)(lds + 139328)); atomicAdd(dg + 16, hy_wait_); atomicAdd(dg + 17, wall_clock64() - hy_t0_); }
#endif
}
constexpr int MN_STRIDE = 66;
static_assert(HYW * MN_STRIDE * 2 <= PHASE_LDS, "mix-norm LDS");
__device__ __forceinline__ void mixnorm_phase(LAS unsigned char* lds, const bf16* Ab, const bf16* YT, const float* ga, const float* gy, bf16* mixed, int G) {
    const int tid = opq_tid(), lane = tid & 63, wave = __builtin_amdgcn_readfirstlane(tid >> 6);
    LAS unsigned* tile32 = (LAS unsigned*)lds; const LAS bf16* tile16 = (const LAS bf16*)lds;
    f32x4 gav[2], gyv[2];
    gav[0] = *(const f32x4*)(ga + lane * 8); gav[1] = *(const f32x4*)(ga + lane * 8 + 4); gyv[0] = *(const f32x4*)(gy + lane * 8); gyv[1] = *(const f32x4*)(gy + lane * 8 + 4);
    v4u R[8];
    int unit = blockIdx.x;
    if (unit < M / 64) { const bf16* src = YT + (((size_t)((unit >> 6) * HYW + tid)) << 12) + (unit & 63) * 64;
#pragma unroll
        for (int q = 0; q < 8; ++q) R[q] = *(const v4u*)(src + 8 * q); }
#pragma unroll 1
    for (; unit < M / 64; unit += G) {
        const int b = unit >> 6, t0 = (unit & 63) * 64;
#pragma unroll
        for (int q = 0; q < 8; ++q) { LAS unsigned* d = tile32 + tid * (MN_STRIDE / 2) + 4 * q; d[0] = R[q].x; d[1] = R[q].y; d[2] = R[q].z; d[3] = R[q].w; }
        wg_sync(); CHAOS_POINT(16, 51);
        const int nu = unit + G;
        if (nu < M / 64) { const bf16* src = YT + (((size_t)((nu >> 6) * HYW + tid)) << 12) + (nu & 63) * 64;
#pragma unroll
            for (int q = 0; q < 8; ++q) R[q] = *(const v4u*)(src + 8 * q); }
        const size_t row0 = (size_t)b * SEQ + t0 + wave * 8;
        v4u av[8];
#pragma unroll
        for (int i = 0; i < 8; ++i) av[i] = *(const v4u*)(Ab + (row0 + i) * AW + lane * 8);
#pragma unroll
        for (int i = 0; i < 8; ++i) { const int tt = wave * 8 + i;
            float y[8]; float ss = 0.f;
#pragma unroll
            for (int e = 0; e < 8; ++e) { y[e] = bf1(tile16[(lane * 8 + e) * MN_STRIDE + tt]); ss += y[e] * y[e]; }
            const float rs = __builtin_amdgcn_rsqf(wave_sum(ss) * (1.f / 512.f) + EPS);
            v4u o; o.x = pk2(y[0] * rs * gyv[0][0], y[1] * rs * gyv[0][1]); o.y = pk2(y[2] * rs * gyv[0][2], y[3] * rs * gyv[0][3]);
            o.z = pk2(y[4] * rs * gyv[1][0], y[5] * rs * gyv[1][1]); o.w = pk2(y[6] * rs * gyv[1][2], y[7] * rs * gyv[1][3]);
            *(v4u*)(mixed + (row0 + i) * D + 512 + lane * 8) = o; }
#pragma unroll
        for (int i = 0; i < 8; ++i) {
            const float x[8] = {bflo(av[i].x), bfhi(av[i].x), bflo(av[i].y), bfhi(av[i].y), bflo(av[i].z), bfhi(av[i].z), bflo(av[i].w), bfhi(av[i].w)};
            float ss = 0.f;
#pragma unroll
            for (int e = 0; e < 8; ++e) ss += x[e] * x[e];
            const float rs = __builtin_amdgcn_rsqf(wave_sum(ss) * (1.f / 512.f) + EPS);
            v4u o; o.x = pk2(x[0] * rs * gav[0][0], x[1] * rs * gav[0][1]); o.y = pk2(x[2] * rs * gav[0][2], x[3] * rs * gav[0][3]);
            o.z = pk2(x[4] * rs * gav[1][0], x[5] * rs * gav[1][1]); o.w = pk2(x[6] * rs * gav[1][2], x[7] * rs * gav[1][3]);
            *(v4u*)(mixed + (row0 + i) * D + lane * 8) = o; }
        wg_sync(); CHAOS_POINT(16, 51);
    }
}

__device__ __forceinline__ void moe_norm_router_phase(LAS unsigned char* lds, const bf16* xb, const float* gain, const float* wr, float* rsrow, int* toke, float* tokw, int* wgcnt, int G) {
    const int tid = opq_tid(), lane = tid & 63, wave = __builtin_amdgcn_readfirstlane(tid >> 6);
    LAS int* cnt = (LAS int*)lds;
    if (tid < 8) cnt[tid] = 0;
    wg_sync(); CHAOS_POINT(16, 51);
    const int TPW = M / G;
    f32x4 wra[4][4], wrb[4][4];
#pragma unroll
    for (int j = 0; j < 4; ++j) { const f32x4 gv = *(const f32x4*)(gain + 4 * lane + 256 * j);
#pragma unroll
        for (int q = 0; q < 4; ++q) { const int k = 4 * lane + q + 256 * j; wra[j][q] = *(const f32x4*)(wr + k * 8) * gv[q]; wrb[j][q] = *(const f32x4*)(wr + k * 8 + 4) * gv[q]; } }
    v2u nx[4];
    { const v2u* xr = (const v2u*)(xb + (size_t)(blockIdx.x * TPW + wave) * D) + lane;
#pragma unroll
      for (int j = 0; j < 4; ++j) nx[j] = xr[64 * j]; }
#pragma unroll 1
    for (int i = wave; i < TPW; i += NWAVES) {
        const int t = blockIdx.x * TPW + i;
        v2u cu[4];
#pragma unroll
        for (int j = 0; j < 4; ++j) cu[j] = nx[j];
        if (i + NWAVES < TPW) { const v2u* xr = (const v2u*)(xb + (size_t)(t + NWAVES) * D) + lane;
#pragma unroll
            for (int j = 0; j < 4; ++j) nx[j] = xr[64 * j]; }
        f32x4 v[4]; float s = 0.f;
#pragma unroll
        for (int j = 0; j < 4; ++j) { const v2u a = cu[j]; v[j] = (f32x4){bflo(a.x), bfhi(a.x), bflo(a.y), bfhi(a.y)}; s += (v[j].x * v[j].x + v[j].y * v[j].y) + (v[j].z * v[j].z + v[j].w * v[j].w); }
        const float rs = 1.0f / sqrtf(wave_sum(s) * (1.f / 1024.f) + EPS);
        float lg[8];
#pragma unroll
        for (int e = 0; e < 8; ++e) lg[e] = 0.f;
#pragma unroll
        for (int j = 0; j < 4; ++j)
#pragma unroll
            for (int q = 0; q < 4; ++q) { const f32x4 wa = wra[j][q], wb = wrb[j][q]; const float hv = v[j][q];
                lg[0] += hv * wa[0]; lg[1] += hv * wa[1]; lg[2] += hv * wa[2]; lg[3] += hv * wa[3]; lg[4] += hv * wb[0]; lg[5] += hv * wb[1]; lg[6] += hv * wb[2]; lg[7] += hv * wb[3]; }
        { const bool b5 = lane & 32, b4 = lane & 16, b3 = lane & 8; float k4[4], k2[2], k1;
#pragma unroll
          for (int i = 0; i < 4; ++i) { const float send = b5 ? lg[i] : lg[4 + i], keep = b5 ? lg[4 + i] : lg[i]; k4[i] = keep + __shfl_xor(send, 32); }
#pragma unroll
          for (int i = 0; i < 2; ++i) { const float send = b4 ? k4[i] : k4[2 + i], keep = b4 ? k4[2 + i] : k4[i]; k2[i] = keep + __shfl_xor(send, 16); }
          { const float send = b3 ? k2[0] : k2[1], keep = b3 ? k2[1] : k2[0]; k1 = keep + __shfl_xor(send, 8); }
          k1 += __shfl_xor(k1, 4); k1 += __shfl_xor(k1, 2); k1 += __shfl_xor(k1, 1);
#pragma unroll
          for (int e = 0; e < 8; ++e) lg[e] = __builtin_bit_cast(float, __builtin_amdgcn_readlane(__builtin_bit_cast(int, k1), 8 * e)) * rs; }
        int i0 = 0; float v0 = lg[0];
#pragma unroll
        for (int e = 1; e < 8; ++e) if (lg[e] > v0) { v0 = lg[e]; i0 = e; }
        int i1 = -1; float v1 = -3.0e38f;
#pragma unroll
        for (int e = 0; e < 8; ++e) if (e != i0 && lg[e] > v1) { v1 = lg[e]; i1 = e; }
        const float e1 = __expf(v1 - v0), w0 = 1.0f / (1.0f + e1), w1 = e1 * w0;
        if (lane == 0) { toke[2 * t] = i0; toke[2 * t + 1] = i1; tokw[2 * t] = w0; tokw[2 * t + 1] = w1; rsrow[t] = rs; __hip_atomic_fetch_add(cnt + i0, 1, __ATOMIC_RELAXED, __HIP_MEMORY_SCOPE_WORKGROUP); __hip_atomic_fetch_add(cnt + i1, 1, __ATOMIC_RELAXED, __HIP_MEMORY_SCOPE_WORKGROUP); }
    }
    wg_sync(); CHAOS_POINT(16, 51);
    if (tid < 8) wgcnt[blockIdx.x * 8 + tid] = cnt[tid];
    wg_sync(); CHAOS_POINT(16, 51);
}
__device__ __forceinline__ void moe_slot_phase(LAS unsigned char* lds, const int* toke, const int* wgcnt, int* tokp, int* tilee, int* meta, const bf16* xb, const float* rsrow, const float* gain, unsigned char* XG8, int G) {
    const int tid = opq_tid(), lane = tid & 63, wave = __builtin_amdgcn_readfirstlane(tid >> 6);
    LAS int* arr = (LAS int*)lds;
    LAS int* pre = arr + 1024 * 8;
    LAS int* wcnt = pre + 32;
    LAS int* slots = wcnt + 64;
    for (int i = tid; i < G * 8; i += NTHR) arr[i] = wgcnt[i];
    wg_sync(); CHAOS_POINT(16, 51);
    if (tid < 8) { int p = 0, tot = 0; for (int w = 0; w < G; ++w) { const int c = arr[w * 8 + tid]; if (w < (int)blockIdx.x) p += c; tot += c; } pre[tid] = p; pre[8 + tid] = tot; }
    wg_sync(); CHAOS_POINT(16, 51);
    if (tid == 0) { int ps = 0; for (int e = 0; e < 8; ++e) { pre[16 + e] = ps; ps += ((pre[8 + e] + 255) >> 8) << 8; } pre[24] = ps; }
    wg_sync(); CHAOS_POINT(16, 51);
    const int TPW = M / G;
    int e_mine = -1, t = 0, rank = 0;
    if (tid < 2 * TPW) { t = blockIdx.x * TPW + (tid >> 1); e_mine = toke[2 * t + (tid & 1)]; }
#pragma unroll
    for (int e = 0; e < 8; ++e) { const unsigned long long mk_ = __ballot(e_mine == e); if (e_mine == e) rank = __popcll(mk_ & ((1ull << lane) - 1ull)); if (lane == 0) wcnt[wave * 8 + e] = __popcll(mk_); }
    wg_sync(); CHAOS_POINT(16, 51);
    if (e_mine >= 0) { int base = pre[16 + e_mine] + pre[e_mine]; for (int w = 0; w < wave; ++w) base += wcnt[w * 8 + e_mine];
        const int slot = base + rank; slots[tid] = slot; tokp[2 * t + (tid & 1)] = slot; }
    else slots[tid] = -1;
    if ((int)blockIdx.x < 8) { const int e = blockIdx.x, s0 = pre[16 + e] + pre[8 + e], s1 = pre[16 + e] + (((pre[8 + e] + 255) >> 8) << 8);
        unsigned z0 = 0u; asm volatile("" : "+v"(z0));
        for (int i = tid; i < (s1 - s0) * 64; i += NTHR) ((v4u*)(XG8 + (size_t)s0 * D))[i] = (v4u){z0, z0, z0, z0}; }
    if (blockIdx.x == 0) { const int ntiles = pre[24] >> 8;
        for (int ti = tid; ti < ntiles; ti += NTHR) { int e = 0;
#pragma unroll
            for (int q = 1; q < 8; ++q) if (ti * 256 >= pre[16 + q]) e = q;
            tilee[ti] = e; }
        if (tid == 0) meta[0] = ntiles; }
    wg_sync(); CHAOS_POINT(16, 51);
    { f32x4 g[4];
#pragma unroll
      for (int q = 0; q < 4; ++q) g[q] = *(const f32x4*)(gain + 16 * lane + 4 * q);
#pragma unroll 1
      for (int a0 = wave * 64; a0 < wave * 64 + 64; a0 += 2) {
          v4u av[2][2]; float rs[2]; int sl[2];
#pragma unroll
          for (int u = 0; u < 2; ++u) { const int a = a0 + u; sl[u] = slots[a]; const int tt = blockIdx.x * TPW + (a >> 1); rs[u] = rsrow[tt]; const v4u* src = (const v4u*)(xb + (size_t)tt * D) + 2 * lane; av[u][0] = src[0]; av[u][1] = src[1]; }
#pragma unroll
          for (int u = 0; u < 2; ++u) if (sl[u] >= 0) { v4u o;
#pragma unroll
              for (int h = 0; h < 2; ++h) { const unsigned w4[4] = {av[u][h].x, av[u][h].y, av[u][h].z, av[u][h].w};
#pragma unroll
                  for (int q = 0; q < 2; ++q) { int w = 0;
                      w = __builtin_amdgcn_cvt_pk_fp8_f32(bflo(w4[2 * q]) * rs[u] * g[2 * h + q][0], bfhi(w4[2 * q]) * rs[u] * g[2 * h + q][1], w, false);
                      w = __builtin_amdgcn_cvt_pk_fp8_f32(bflo(w4[2 * q + 1]) * rs[u] * g[2 * h + q][2], bfhi(w4[2 * q + 1]) * rs[u] * g[2 * h + q][3], w, true);
                      o[2 * h + q] = (unsigned)w; } }
              ((v4u*)(XG8 + (size_t)sl[u] * D))[lane] = o; } } }
    wg_sync(); CHAOS_POINT(16, 51);
}
__device__ __forceinline__ void moe_gather_phase(const bf16* xb, const float* rsrow, const float* gain, const int* rowtok, bf16* XG, int nrows, int gw, int NGW, int lane) {
    f32x4 g[4];
#pragma unroll
    for (int q = 0; q < 4; ++q) g[q] = *(const f32x4*)(gain + (q >> 1) * 512 + 8 * lane + 4 * (q & 1));
    for (int r = gw; r < nrows; r += NGW) { const int t = rowtok[r]; const float rs = rsrow[t]; const v4u* src = (const v4u*)(xb + (size_t)t * D); v4u* dst = (v4u*)(XG + (size_t)r * D);
#pragma unroll
        for (int h = 0; h < 2; ++h) { const v4u a = src[64 * h + lane]; v4u o;
            o.x = pk2(bflo(a.x) * rs * g[2 * h][0], bfhi(a.x) * rs * g[2 * h][1]); o.y = pk2(bflo(a.y) * rs * g[2 * h][2], bfhi(a.y) * rs * g[2 * h][3]);
            o.z = pk2(bflo(a.z) * rs * g[2 * h + 1][0], bfhi(a.z) * rs * g[2 * h + 1][1]); o.w = pk2(bflo(a.w) * rs * g[2 * h + 1][2], bfhi(a.w) * rs * g[2 * h + 1][3]);
            dst[64 * h + lane] = o; } }
}
__device__ __forceinline__ void moe_combine_final_phase(const bf16* xb, float* out, const bf16* YB, const int* tokp, const float* tokw, const float* gain, int gw, int NGW, int lane) {
    f32x4 g[4];
#pragma unroll
    for (int q = 0; q < 4; ++q) g[q] = *(const f32x4*)(gain + (q >> 1) * 512 + 8 * lane + 4 * (q & 1));
#pragma unroll 1
    for (int t0 = gw; t0 < M; t0 += 2 * NGW) { CHAOS_POINT(16, 52);
        v4u xa[2][2], ya[2][2], yb[2][2]; float w0[2], w1[2]; bool on[2];
#pragma unroll
        for (int u = 0; u < 2; ++u) { const int t = t0 + u * NGW; on[u] = t < M; const int tt = on[u] ? t : t0;
            const int p0 = tokp[2 * tt], p1 = tokp[2 * tt + 1]; w0[u] = tokw[2 * tt]; w1[u] = tokw[2 * tt + 1];
            const v4u* xr = (const v4u*)(xb + (size_t)tt * D) + lane; const v4u* y0 = (const v4u*)(YB + (size_t)p0 * D) + lane; const v4u* y1 = (const v4u*)(YB + (size_t)p1 * D) + lane;
#pragma unroll
            for (int h = 0; h < 2; ++h) { xa[u][h] = xr[64 * h]; ya[u][h] = y0[64 * h]; yb[u][h] = y1[64 * h]; } }
#pragma unroll
        for (int u = 0; u < 2; ++u) { const int t = t0 + u * NGW; float v[2][8]; float s = 0.f;
#pragma unroll
            for (int h = 0; h < 2; ++h) { const unsigned xw[4] = {xa[u][h].x, xa[u][h].y, xa[u][h].z, xa[u][h].w}, aw[4] = {ya[u][h].x, ya[u][h].y, ya[u][h].z, ya[u][h].w}, bw[4] = {yb[u][h].x, yb[u][h].y, yb[u][h].z, yb[u][h].w};
#pragma unroll
                for (int q = 0; q < 4; ++q) { v[h][2 * q] = bflo(xw[q]) + w0[u] * bflo(aw[q]) + w1[u] * bflo(bw[q]); v[h][2 * q + 1] = bfhi(xw[q]) + w0[u] * bfhi(aw[q]) + w1[u] * bfhi(bw[q]);
                    s += v[h][2 * q] * v[h][2 * q] + v[h][2 * q + 1] * v[h][2 * q + 1]; } }
            const float rs = 1.0f / sqrtf(wave_sum(s) * (1.f / 1024.f) + EPS);
            if (on[u]) { f32x4* orow = (f32x4*)(out + (size_t)t * D);
#pragma unroll
                for (int h = 0; h < 2; ++h) { orow[128 * h + 2 * lane] = (f32x4){v[h][0], v[h][1], v[h][2], v[h][3]} * rs * g[2 * h]; orow[128 * h + 2 * lane + 1] = (f32x4){v[h][4], v[h][5], v[h][6], v[h][7]} * rs * g[2 * h + 1]; } } }
    }
}
struct MoeOrder : pg8::StaticOrder {
    const int* tilee; int tile0; size_t bstride;
    __device__ __forceinline__ size_t boff(const pg8::Unit& u) const { return (size_t)tilee[tile0 + u.pm] * bstride; }
};
#ifndef LB_WAVES
#define LB_WAVES 2
#endif
constexpr int N_PHASES_C = 29;
__global__ void __launch_bounds__(NTHR, LB_WAVES) fwd_kernel(Args args) {
    extern __shared__ __attribute__((aligned(16))) unsigned char lds_raw[];
    LAS unsigned char* lds = (LAS unsigned char*)lds_raw;
    const int tid0 = threadIdx.x;
    const int G = gridDim.x, NGW = G * NWAVES;
    unsigned char* ws = args.ws;
    gu32* ctl = (gu32*)(ws + WS_CTL);
    volatile LAS unsigned* MISC = (volatile LAS unsigned*)(lds + MISC_OFF);
    for (int u = tid0; u < (LDS_BYTES - LDSCTL_OFF) / 4; u += NTHR) ((LAS unsigned*)(lds + LDSCTL_OFF))[u] = 0u;
#ifdef DIAG
#ifndef DIAG_WG
#define DIAG_WG 0
#endif
#ifndef DIAG_PH
#define DIAG_PH 0
#endif
#ifndef DIAG_DIV
#define DIAG_DIV 1
#endif
    static_assert(MISC_OFF == 139328, "diag pointer slot");
    if (tid0 == 0) ((LAS unsigned long long*)(lds + MISC_OFF))[0] = (unsigned long long)(ws + WS_CTL + 512 * 1024);
#endif
    __syncthreads();
    XcdBarrier bar; bar.bar = (unsigned*)(ctl + CW_BAR); bar.x = 0; bar.st = nullptr;
    if (args.use_bar) bar = xcd_barrier_post((unsigned*)(ctl + CW_BAR), MISC + 8);
    const int lo = args.ph_lo, hi = args.ph_hi;
    int ph = 0;
#ifndef PHMASK
#define PHMASK 0xffffffffu
#endif
#define EN(k) (((PHMASK) >> (k)) & 1u)
#define PH_ON() (ph >= lo && ph < hi)
#define LOCAL_IDS() const int tid = opq_tid(), lane = tid & 63, wave = __builtin_amdgcn_readfirstlane(tid >> 6), gw = blockIdx.x * NWAVES + wave; (void)lane; (void)gw
#ifndef DUPMASK
#define DUPMASK 0u
#endif
#define RES_DST(k) ((NREP(k) > 1 && rep_ + 1 < NREP(k)) ? (bf16*)args.out : HB)
#ifndef DUPN
#define DUPN 2
#endif
#define NREP(k) ((((DUPMASK) >> (k)) & 1u) ? DUPN : 1)
#ifdef DIAG
#define PH_END_K(k) do { if (args.use_bar && (ph + 1 < hi || rep_ + 1 < NREP(k))) { const unsigned long long tb_ = wall_clock64(); xcd_barrier(bar); if (threadIdx.x == 0) { unsigned long long* dg = (unsigned long long*)(ws + WS_CTL + 512 * 1024); const unsigned long long w_ = wall_clock64() - tb_; atomicAdd(dg + 5, w_); if (ph == DIAG_PH) atomicAdd(dg + 6, w_); } } } while (0)
#else
#define PH_END_K(k) do { if (args.use_bar && (ph + 1 < hi || rep_ + 1 < NREP(k))) xcd_barrier(bar); } while (0)
#endif

    float* cosT = (float*)(ws + WS_COS); float* sinT = (float*)(ws + WS_SIN); float* H2 = (float*)(ws + WS_H2);
    int* toke = (int*)(ws + WS_TOKE); float* tokw = (float*)(ws + WS_TOKW); int* tokp = (int*)(ws + WS_TOKP); int* rowtok = (int*)(ws + WS_ROWTOK);
    int* tilee = (int*)(ws + WS_TILEE); int* wgcnt = (int*)(ws + WS_WGCNT); int* meta = (int*)(ws + WS_META); float* rsrow = (float*)(ws + WS_RSROW);
    bf16* WINA = (bf16*)(ws + WS_WINA); bf16* WINB = (bf16*)(ws + WS_WINB); bf16* WOUT = (bf16*)(ws + WS_WOUT); bf16* XQ = (bf16*)(ws + WS_XQ); bf16* XK = (bf16*)(ws + WS_XK);
    bf16* XV = (bf16*)(ws + WS_XV); bf16* XO = (bf16*)(ws + WS_XO); bf16* FGU = (bf16*)(ws + WS_FGU); bf16* FDN = (bf16*)(ws + WS_FDN); bf16* MGU = (bf16*)(ws + WS_MGU); bf16* MDN = (bf16*)(ws + WS_MDN);
    float* KF = (float*)(ws + WS_KFILT); bf16* MB = (bf16*)(ws + WS_MB); bf16* KMEM = (bf16*)(ws + WS_KMEM); bf16* VMEMT = (bf16*)(ws + WS_VMEMT); bf16* HB = (bf16*)(ws + WS_HB);
    bf16* QB = (bf16*)(ws + WS_QB); bf16* KB = (bf16*)(ws + WS_KB); bf16* VB = (bf16*)(ws + WS_VB); bf16* UT = (bf16*)(ws + WS_UT); bf16* AB = (bf16*)(ws + WS_AB); bf16* YT = (bf16*)(ws + WS_YT);
    bf16* MIXED = (bf16*)(ws + WS_MIXED); float* SS = (float*)(ws + WS_SS);
    bf16* XQB = (bf16*)(ws + WS_XQB); bf16* XOB = (bf16*)(ws + WS_XOB); bf16* ACT = (bf16*)(ws + WS_ACT); unsigned char* XG8 = ws + WS_XG; bf16* YB = (bf16*)(ws + WS_YB); unsigned char* MGU8 = ws + WS_MGU; bf16* MACT = (bf16*)(ws + WS_MACT);
    const float* const* in = args.in;

    if (EN(0) && PH_ON()) for (int rep_ = 0; rep_ < NREP(0); ++rep_) { asm volatile("; PHASE_MARK 0"); LOCAL_IDS();
        LAS float* scr = (LAS float*)(lds + wave * 8704);
        constexpr int IT_L = 384 + 768 + 512 + 4 * 256, IT_D = 3 * 1408, IT_E = 3 * 1792, IT_ALL = 2 * IT_L + IT_D + NE * IT_E;
#pragma unroll 1
        for (int it = gw; it < IT_ALL; it += NGW) {
            const float* W; int ldw, K, col0 = 0, ncols, mode = 0; bf16* WT; const float* gk = nullptr; int r = it;
            if (r < 2 * IT_L) { const int l = r / IT_L; r -= l * IT_L;
                if (r < 384) { W = in[I_WIN] + (size_t)l * D * INC; ldw = INC; K = D; ncols = 768; WT = WINA + (size_t)l * 768 * D; mode = 1; gk = in[I_MIXNORM] + l * D; }
                else if ((r -= 384) < 768) { W = in[I_WIN] + (size_t)l * D * INC; ldw = INC; K = D; col0 = 768; ncols = C3; WT = WINB + (size_t)l * C3 * D; gk = in[I_MIXNORM] + l * D; }
                else if ((r -= 768) < 512) { W = in[I_WOUT] + (size_t)l * D * D; ldw = D; K = D; ncols = D; WT = WOUT + (size_t)l * D * D; }
                else if ((r -= 512) < 256) { W = in[I_XWQ] + (size_t)l * D * XW; ldw = XW; K = D; ncols = XW; WT = XQ + (size_t)l * XW * D; gk = in[I_XNORM] + l * D; }
                else if ((r -= 256) < 256) { W = in[I_XWK] + (size_t)l * D * XW; ldw = XW; K = D; ncols = XW; WT = XK + (size_t)l * XW * D; }
                else if ((r -= 256) < 256) { W = in[I_XWV] + (size_t)l * D * XW; ldw = XW; K = D; ncols = XW; WT = XV + (size_t)l * XW * D; }
                else { r -= 256; W = in[I_XWO] + (size_t)l * XW * D; ldw = D; K = XW; ncols = D; WT = XO + (size_t)l * D * XW; }
            } else if ((r -= 2 * IT_L) < IT_D) {
                if (r < 1408) { W = in[I_FGATE]; ldw = FF; K = D; ncols = FF; WT = FGU; mode = 2; gk = in[I_FNORM]; }
                else if ((r -= 1408) < 1408) { W = in[I_FUP]; ldw = FF; K = D; ncols = FF; WT = FGU; mode = 3; gk = in[I_FNORM]; }
                else { r -= 1408; W = in[I_FDOWN]; ldw = D; K = FF; ncols = D; WT = FDN; }
            } else { r -= IT_D; const int e = r / IT_E; r -= e * IT_E;
                if (r < 2 * 1792) { const bool up = r >= 1792; if (up) r -= 1792;
                    tr_item8(in[up ? I_MUP : I_MGATE] + (size_t)e * D * FFE, FFE, D, FFE, MGU8 + (size_t)e * 2 * FFE * D, up ? 3 : 2, 32.0f, r, scr, lane); continue; }
                else { r -= 2 * 1792; tr_item8(in[I_MDOWN] + (size_t)e * FFE * D, D, FFE, D, (unsigned char*)MDN + (size_t)e * D * FFE, 0, 32.0f, r, scr, lane); continue; }
            }
            tr_item(W, ldw, K, col0, ncols, WT, mode, gk, r, scr, lane);
        }
        for (int i = blockIdx.x * NTHR + tid; i < SEQ * 32; i += G * NTHR) { const int pos = i >> 5, f = i & 31;
            const float inv = (float)pow(10000.0, -(double)f / 32.0); const float ang = (float)pos * inv;
            cosT[i] = (float)cos((double)ang); sinT[i] = (float)sin((double)ang); }
        h2_rows(args, H2, gw, NGW, lane);
        norm_rows(in[I_MEM], in[I_MEMNORM], MB, MROWS, gw, NGW, lane);
        xb_rows(in[I_X], HB, SS, M, gw, NGW, lane);
        PH_END_K(0);
    }
    ++ph;
    if (EN(1) && PH_ON()) for (int rep_ = 0; rep_ < NREP(1); ++rep_) { asm volatile("; PHASE_MARK 1"); LOCAL_IDS();
        kfilt_phase(lds, H2, in[I_FW3], KF, G);
        PH_END_K(1);
    }
    ++ph;

#pragma unroll 1
    for (int l = 0; l < 2; ++l) {
        if (EN(2) && PH_ON()) for (int rep_ = 0; rep_ < NREP(2); ++rep_) { asm volatile("; PHASE_MARK 2"); LOCAL_IDS();
            if (l == 0) {
                kspec_phase(lds, KF, (float*)(ws + WS_KSPEC), G);
                { pg8::Gemm g{MB, XK, MROWS, 1024, D}; pg8::StaticOrder S; S.init(MROWS, 1024, G, (int)blockIdx.x); pg8::EpiBf16 E{KMEM, 1024, nullptr, 1.0f};
                  pg8::gemm_phase<pg8::EpiBf16, pg8::StaticOrder, PG8_ALIGN, PG8_SP2>(lds, g, S, E); }
                { pg8::Gemm g{MB, XV, MROWS, 1024, D}; pg8::StaticOrder S; S.init(MROWS, 1024, G, G >= 128 ? (int)((blockIdx.x + G - 64) % G) : (int)blockIdx.x); pg8::EpiT E{VMEMT, 1024, 12, nullptr};
                  pg8::gemm_phase<pg8::EpiT, pg8::StaticOrder, PG8_ALIGN, PG8_SP2>(lds, g, S, E); }
            }
            { pg8::Gemm g{HB, WINA + (size_t)l * 768 * D, M, 768, D}; pg8::StaticOrder S; S.init(M, 768, G, (int)blockIdx.x); pg8::EpiQKV E{QB, KB, VB, cosT, sinT, SS + (size_t)(3 * l) * SS_STRIDE};
              pg8::gemm_phase<pg8::EpiQKV, pg8::StaticOrder, PG8_ALIGN, PG8_SP2>(lds, g, S, E); }
            { pg8::Gemm g{HB, WINB + (size_t)l * C3 * D, M, C3, D}; pg8::StaticOrder S; S.init(M, C3, G, (int)blockIdx.x); pg8::EpiT E{UT, C3, 12, SS + (size_t)(3 * l) * SS_STRIDE};
              pg8::gemm_phase<pg8::EpiT, pg8::StaticOrder, PG8_ALIGN, PG8_SP2>(lds, g, S, E); }
            PH_END_K(2);
        }
        ++ph;
        if (EN(3) && PH_ON()) for (int rep_ = 0; rep_ < NREP(3); ++rep_) { asm volatile("; PHASE_MARK 3"); LOCAL_IDS();
#ifndef BA_REP
#define BA_REP 1
#endif
#ifndef HY_REP
#define HY_REP 1
#endif
#pragma unroll 1
            for (int r_ = 0; r_ < BA_REP; ++r_) band_attention_phase(lds, QB, KB, VB, AB, in[I_SINK] + l * NH, G);
#pragma unroll 1
            for (int r_ = 0; r_ < HY_REP; ++r_) hyena_phase(lds, args, l, UT, (const float*)(ws + WS_KSPEC), YT, G);
            PH_END_K(3);
        }
        ++ph;
        if (EN(4) && PH_ON()) for (int rep_ = 0; rep_ < NREP(4); ++rep_) { asm volatile("; PHASE_MARK 4"); LOCAL_IDS(); mixnorm_phase(lds, AB, YT, in[I_ANORM] + l * AW, in[I_YNORM] + l * HYW, MIXED, G); PH_END_K(4); }
        ++ph;
        if (EN(5) && PH_ON()) for (int rep_ = 0; rep_ < NREP(5); ++rep_) { asm volatile("; PHASE_MARK 5"); LOCAL_IDS();
            pg8::Gemm g{MIXED, WOUT + (size_t)l * D * D, M, D, D}; pg8::StaticOrder S; S.init(M, D, G, (int)blockIdx.x); pg8::EpiResB E{HB, D, SS + (size_t)(3 * l + 1) * SS_STRIDE, RES_DST(5)};
            pg8::gemm_phase<pg8::EpiResB, pg8::StaticOrder, PG8_ALIGN, PG8_SP2>(lds, g, S, E);
            PH_END_K(5);
        }
        ++ph;
        if (EN(7) && PH_ON()) for (int rep_ = 0; rep_ < NREP(7); ++rep_) { asm volatile("; PHASE_MARK 7"); LOCAL_IDS();
            pg8::Gemm g{HB, XQ + (size_t)l * XW * D, M, XW, D}; pg8::StaticOrder S; S.init(M, XW, G, (int)blockIdx.x); pg8::EpiBf16 E{XQB, XW, SS + (size_t)(3 * l + 1) * SS_STRIDE, 1.0f};
            pg8::gemm_phase<pg8::EpiBf16, pg8::StaticOrder, PG8_ALIGN, PG8_SP2>(lds, g, S, E);
            PH_END_K(7);
        }
        ++ph;
        if (EN(8) && PH_ON()) for (int rep_ = 0; rep_ < NREP(8); ++rep_) { asm volatile("; PHASE_MARK 8"); LOCAL_IDS(); cross_attention_phase(lds, XQB, KMEM, VMEMT, XOB, l, G); PH_END_K(8); }
        ++ph;
        if (EN(9) && PH_ON()) for (int rep_ = 0; rep_ < NREP(9); ++rep_) { asm volatile("; PHASE_MARK 9"); LOCAL_IDS();
            pg8::Gemm g{XOB, XO + (size_t)l * D * XW, M, D, XW}; pg8::StaticOrder S; S.init(M, D, G, (int)blockIdx.x); pg8::EpiResB E{HB, D, l == 0 ? SS + (size_t)2 * SS_STRIDE : nullptr, RES_DST(9)};
            pg8::gemm_phase<pg8::EpiResB, pg8::StaticOrder, PG8_ALIGN, PG8_SP2>(lds, g, S, E);
            PH_END_K(9);
        }
        ++ph;
        if (l == 0) {
            if (EN(11) && PH_ON()) for (int rep_ = 0; rep_ < NREP(11); ++rep_) { asm volatile("; PHASE_MARK 11"); LOCAL_IDS();
                pg8::Gemm g{HB, FGU, M, 2 * FF, D}; pg8::StaticOrder S; S.init(M, 2 * FF, G, (int)blockIdx.x); pg8::EpiSwiglu<true> E{ACT, FF, SS + (size_t)2 * SS_STRIDE};
                pg8::gemm_phase<pg8::EpiSwiglu<true>, pg8::StaticOrder, PG8_ALIGN, PG8_SP2>(lds, g, S, E);
                PH_END_K(11);
            }
            ++ph;
            if (EN(12) && PH_ON()) for (int rep_ = 0; rep_ < NREP(12); ++rep_) { asm volatile("; PHASE_MARK 12"); LOCAL_IDS();
                pg8::Gemm g{ACT, FDN, M, D, FF}; pg8::StaticOrder S; S.init(M, D, G, (int)blockIdx.x); pg8::EpiResB E{HB, D, SS + (size_t)3 * SS_STRIDE, RES_DST(12)};
                pg8::gemm_phase<pg8::EpiResB, pg8::StaticOrder, PG8_ALIGN, PG8_SP2>(lds, g, S, E);
                PH_END_K(12);
            }
            ++ph;
        } else {
            if (EN(14) && PH_ON()) for (int rep_ = 0; rep_ < NREP(14); ++rep_) { asm volatile("; PHASE_MARK 14"); LOCAL_IDS(); moe_norm_router_phase(lds, HB, in[I_FNORM] + D, in[I_ROUTER], rsrow, toke, tokw, wgcnt, G); PH_END_K(14); }
            ++ph;
            if (EN(15) && PH_ON()) for (int rep_ = 0; rep_ < NREP(15); ++rep_) { asm volatile("; PHASE_MARK 15"); LOCAL_IDS(); moe_slot_phase(lds, toke, wgcnt, tokp, tilee, meta, HB, rsrow, in[I_FNORM] + D, XG8, G); PH_END_K(15); }
            ++ph;
#pragma unroll 1
            for (int ci = 0; ci < MOE_NCHUNK; ++ci) {
                if (EN(17) && PH_ON()) for (int rep_ = 0; rep_ < NREP(17); ++rep_) { asm volatile("; PHASE_MARK 17"); LOCAL_IDS();
                    const int ntiles = meta[0], tile0 = ci * MOE_CH_TILES, nt = ci < MOE_NCHUNK - 1 ? MOE_CH_TILES : ntiles - (MOE_NCHUNK - 1) * MOE_CH_TILES;
                    int k8 = D / 2; asm volatile("" : "+s"(k8));
                    pg8::Gemm g{(const bf16*)(XG8 + (size_t)tile0 * 256 * D), (const bf16*)MGU8, nt * 256, 2 * FFE, k8};
                    MoeOrder S; S.init(nt * 256, 2 * FFE, G, (int)blockIdx.x); S.tilee = tilee; S.tile0 = tile0; S.bstride = (size_t)2 * FFE * D;
                    pg8::EpiSwiglu<false, true, true> E{MACT, FFE, nullptr};
                    pg8::gemm_phase<pg8::EpiSwiglu<false, true, true>, MoeOrder, PG8_ALIGN, PG8_SP2>(lds, g, S, E);
                    PH_END_K(17);
                }
                ++ph;
                if (EN(18) && PH_ON()) for (int rep_ = 0; rep_ < NREP(18); ++rep_) { asm volatile("; PHASE_MARK 18"); LOCAL_IDS();
                    const int ntiles = meta[0], tile0 = ci * MOE_CH_TILES, nt = ci < MOE_NCHUNK - 1 ? MOE_CH_TILES : ntiles - (MOE_NCHUNK - 1) * MOE_CH_TILES;
                    int k8 = FFE / 2; asm volatile("" : "+s"(k8));
                    pg8::Gemm g{MACT, MDN, nt * 256, D, k8};
                    MoeOrder S; S.init(nt * 256, D, G, (int)blockIdx.x); S.tilee = tilee; S.tile0 = tile0; S.bstride = (size_t)D * FFE;
                    pg8::EpiBf16T<true> E{YB + (size_t)tile0 * 256 * D, D, nullptr, 1.0f / 128.0f};
                    pg8::gemm_phase<pg8::EpiBf16T<true>, MoeOrder, PG8_ALIGN, PG8_SP2>(lds, g, S, E);
                    PH_END_K(18);
                }
                ++ph;
            }
            if (EN(19) && PH_ON()) for (int rep_ = 0; rep_ < NREP(19); ++rep_) { asm volatile("; PHASE_MARK 19"); LOCAL_IDS(); moe_combine_final_phase(HB, args.out, YB, tokp, tokw, in[I_FINAL], gw, NGW, lane); PH_END_K(19); }
            ++ph;
        }
    }
#ifdef DIAG
    if (blockIdx.x == DIAG_WG && tid0 == 0 && hi == N_PHASES_C) { const unsigned long long v = ((unsigned long long*)(ws + WS_CTL + 512 * 1024))[DIAG_SEL] * DIAG_MULT / DIAG_DIV; const unsigned long long t0 = wall_clock64(); while (wall_clock64() - t0 < v) __builtin_amdgcn_s_sleep(8); }
#endif
#undef PH_ON
}
constexpr int N_PHASES = 2 + 7 + 2 + 7 + 2 + 2 * MOE_NCHUNK + 1;

#ifndef MK_PER_PHASE
#define MK_PER_PHASE 0
#endif
extern "C" void kernel_launch(void* const* d_in, const int* in_sizes, int n_in, void* d_out, int out_size, void* d_ws, size_t ws_size, hipStream_t stream) {
    static int grid = 0;
    if (grid == 0) {
        if (n_in != 33 || in_sizes[0] != M * D || out_size != M * D || ws_size < WS_END) {
            fprintf(stderr, "kernel_launch: unexpected problem: n_in %d in0 %d out %d ws %zu (need %zu); nothing launched\n", n_in, n_in > 0 ? in_sizes[0] : -1, out_size, ws_size, (size_t)WS_END); grid = -1; return; }
        int dev = 0, cus = 0, per_cu = 0;
        if (hipGetDevice(&dev) != hipSuccess || hipDeviceGetAttribute(&cus, hipDeviceAttributeMultiprocessorCount, dev) != hipSuccess) { fprintf(stderr, "kernel_launch: device query failed\n"); grid = -1; return; }
        if (hipFuncSetAttribute((const void*)fwd_kernel, hipFuncAttributeMaxDynamicSharedMemorySize, LDS_BYTES) != hipSuccess) { fprintf(stderr, "kernel_launch: hipFuncSetAttribute failed\n"); grid = -1; return; }
        if (hipOccupancyMaxActiveBlocksPerMultiprocessor(&per_cu, (const void*)fwd_kernel, NTHR, LDS_BYTES) != hipSuccess || per_cu < 1) { fprintf(stderr, "kernel_launch: occupancy query reports %d\n", per_cu); }
        (void)hipGetLastError();
        grid = cus;
        if (grid > 256) grid = 256;
        while (grid > 1 && (M % grid != 0 || M / grid > 256)) --grid;
        if (grid != 256) fprintf(stderr, "kernel_launch: note: grid %d\n", grid);
    }
    if (grid < 0) return;
    if (hipMemsetAsync((char*)d_ws + WS_CTL, 0, CTL_ZERO_BYTES, stream) != hipSuccess) { fprintf(stderr, "kernel_launch: memset failed\n"); return; }
    Args a{};
    for (int i = 0; i < 33; ++i) a.in[i] = (const float*)d_in[i];
    a.out = (float*)d_out; a.ws = (unsigned char*)d_ws;
#if MK_PER_PHASE
    for (int p = 0; p < N_PHASES; ++p) { a.ph_lo = p; a.ph_hi = p + 1; a.use_bar = 0; a.pad = 0; hipLaunchKernelGGL(fwd_kernel, dim3(grid), dim3(NTHR), LDS_BYTES, stream, a); }
#else
    a.ph_lo = 0; a.ph_hi = N_PHASES; a.use_bar = 1; a.pad = 0;
    hipLaunchKernelGGL(fwd_kernel, dim3(grid), dim3(NTHR), LDS_BYTES, stream, a);
#endif
    const hipError_t le = hipPeekAtLastError();
    if (le != hipSuccess) fprintf(stderr, "kernel_launch: launch failed: %s\n", hipGetErrorName(le));
}
```

```cpp
#include <hip/hip_runtime.h>
#include <cstdio>
#include <cstdint>
#ifndef HD
#define HD __host__ __device__ __forceinline__
#endif
__device__ __forceinline__ int opq_tid() { int t = (int)threadIdx.x; asm volatile("" : "+v"(t)); return t; }
typedef float f32x2_cv __attribute__((ext_vector_type(2))); typedef __bf16 bf16x2_cv __attribute__((ext_vector_type(2)));
__device__ __forceinline__ unsigned cvtpk_hw(float lo, float hi) { f32x2_cv v = {lo, hi}; bf16x2_cv b = __builtin_convertvector(v, bf16x2_cv); return __builtin_bit_cast(unsigned, b); }
#ifdef CHAOS
#ifndef CHAOS_MASK
#define CHAOS_MASK 0xff
#endif
__device__ __forceinline__ void chaos_point(unsigned k) {
    const unsigned t = (unsigned)__builtin_amdgcn_s_memtime();
    unsigned r = (t >> 3) * 2654435761u + k * 40503u + (unsigned)__builtin_amdgcn_s_getreg(63492) * 97u;
    r ^= r >> 15;
    if ((r & 3u) == 0u) { if (r & 4u) __builtin_amdgcn_s_sleep(13); if (r & 8u) __builtin_amdgcn_s_sleep(37); if (r & 16u) __builtin_amdgcn_s_sleep(90); }
}
#define CHAOS_POINT(grp, k) do { if ((CHAOS_MASK) & (grp)) chaos_point(k); } while (0)
#else
#define CHAOS_POINT(grp, k) do {} while (0)
#endif

#if defined(__HIP__)
typedef float cf __attribute__((ext_vector_type(2)));
HD cf mk(float a, float b) { return (cf){a, b}; }
HD cf cadd(cf a, cf b) { return a + b; }
HD cf csub(cf a, cf b) { return a - b; }
#if defined(__HIP_DEVICE_COMPILE__) && !defined(FFT_NO_ASM)
HD cf cmul(cf a, cf b) { cf t, r;
    asm("v_pk_mul_f32 %0, %1, %2 op_sel:[1,1] op_sel_hi:[0,1]" : "=v"(t) : "v"(a), "v"(b));
    asm("v_pk_fma_f32 %0, %1, %2, %3 op_sel:[0,0,0] op_sel_hi:[1,0,1] neg_lo:[0,0,1]" : "=v"(r) : "v"(a), "v"(b), "v"(t)); return r; }
HD cf cmulc(cf a, cf b) { cf t, r;
    asm("v_pk_mul_f32 %0, %1, %2 op_sel:[1,1] op_sel_hi:[0,1]" : "=v"(t) : "v"(a), "v"(b));
    asm("v_pk_fma_f32 %0, %1, %2, %3 op_sel:[0,0,0] op_sel_hi:[1,0,1] neg_hi:[0,0,1]" : "=v"(r) : "v"(a), "v"(b), "v"(t)); return r; }
HD cf cmul_s(cf a, cf b) { cf t, r;
    asm("v_pk_mul_f32 %0, %1, %2 op_sel:[1,1] op_sel_hi:[0,1]" : "=v"(t) : "v"(a), "s"(b));
    asm("v_pk_fma_f32 %0, %1, %2, %3 op_sel:[0,0,0] op_sel_hi:[1,0,1] neg_lo:[0,0,1]" : "=v"(r) : "v"(a), "s"(b), "v"(t)); return r; }
HD cf cmulc_s(cf a, cf b) { cf t, r;
    asm("v_pk_mul_f32 %0, %1, %2 op_sel:[1,1] op_sel_hi:[0,1]" : "=v"(t) : "v"(a), "s"(b));
    asm("v_pk_fma_f32 %0, %1, %2, %3 op_sel:[0,0,0] op_sel_hi:[1,0,1] neg_hi:[0,0,1]" : "=v"(r) : "v"(a), "s"(b), "v"(t)); return r; }
HD cf add_mi(cf a, cf b) { cf r; asm("v_pk_add_f32 %0, %1, %2 op_sel:[0,1] op_sel_hi:[1,0] neg_hi:[0,1]" : "=v"(r) : "v"(a), "v"(b)); return r; }
HD cf add_pi(cf a, cf b) { cf r; asm("v_pk_add_f32 %0, %1, %2 op_sel:[0,1] op_sel_hi:[1,0] neg_lo:[0,1]" : "=v"(r) : "v"(a), "v"(b)); return r; }
#else
HD cf cmul(cf a, cf b) { return mk(a.x * b.x - a.y * b.y, a.x * b.y + a.y * b.x); }
HD cf cmulc(cf a, cf b) { return mk(a.x * b.x + a.y * b.y, a.y * b.x - a.x * b.y); }
HD cf cmul_s(cf a, cf b) { return cmul(a, b); }
HD cf cmulc_s(cf a, cf b) { return cmulc(a, b); }
HD cf add_mi(cf a, cf b) { return mk(a.x + b.y, a.y - b.x); }
HD cf add_pi(cf a, cf b) { return mk(a.x - b.y, a.y + b.x); }
#endif
HD cf cscale(cf a, float s) { return a * s; }
#else
struct cf { float x, y; };
HD cf mk(float a, float b) { cf r; r.x = a; r.y = b; return r; }
HD cf cadd(cf a, cf b) { return mk(a.x + b.x, a.y + b.y); }
HD cf csub(cf a, cf b) { return mk(a.x - b.x, a.y - b.y); }
HD cf cmul(cf a, cf b) { return mk(a.x * b.x - a.y * b.y, a.x * b.y + a.y * b.x); }
HD cf cmulc(cf a, cf b) { return mk(a.x * b.x + a.y * b.y, a.y * b.x - a.x * b.y); }
HD cf cmul_s(cf a, cf b) { return cmul(a, b); }
HD cf cmulc_s(cf a, cf b) { return cmulc(a, b); }
HD cf add_mi(cf a, cf b) { return mk(a.x + b.y, a.y - b.x); }
HD cf add_pi(cf a, cf b) { return mk(a.x - b.y, a.y + b.x); }
HD cf cscale(cf a, float s) { return mk(a.x * s, a.y * s); }
#endif
template <bool INV> HD cf cmulw(cf a, cf w) { return INV ? cmulc(a, w) : cmul(a, w); }
template <bool INV> HD cf cmulw_s(cf a, cf w) { return INV ? cmulc_s(a, w) : cmul_s(a, w); }

template <bool INV, bool ROT2 = false> HD void dft4(cf& a0, cf& a1, cf& a2, cf& a3) {
    const cf t0 = ROT2 ? (INV ? add_pi(a0, a2) : add_mi(a0, a2)) : cadd(a0, a2), t1 = ROT2 ? (INV ? add_mi(a0, a2) : add_pi(a0, a2)) : csub(a0, a2), t2 = cadd(a1, a3), t3 = csub(a1, a3);
    a0 = cadd(t0, t2); a2 = csub(t0, t2);
    if (!INV) { a1 = add_mi(t1, t3); a3 = add_pi(t1, t3); }
    else      { a1 = add_pi(t1, t3); a3 = add_mi(t1, t3); }
}
template <bool INV> HD void dft16(cf (&x)[16]) {
#pragma unroll
    for (int n1 = 0; n1 < 4; ++n1) dft4<INV>(x[n1], x[n1 + 4], x[n1 + 8], x[n1 + 12]);
    const float c1 = 0.92387953251128674f, s1 = 0.38268343236508977f, r2 = 0.70710678118654752f;
    const cf W1 = mk(c1, -s1), W2 = mk(r2, -r2), W3 = mk(s1, -c1), W6 = mk(-r2, -r2), W9 = mk(-c1, s1);
    x[1 + 4 * 1] = cmulw_s<INV>(x[1 + 4 * 1], W1);
    x[1 + 4 * 2] = cmulw_s<INV>(x[1 + 4 * 2], W2);
    x[1 + 4 * 3] = cmulw_s<INV>(x[1 + 4 * 3], W3);
    x[2 + 4 * 1] = cmulw_s<INV>(x[2 + 4 * 1], W2);
    x[2 + 4 * 3] = cmulw_s<INV>(x[2 + 4 * 3], W6);
    x[3 + 4 * 1] = cmulw_s<INV>(x[3 + 4 * 1], W3);
    x[3 + 4 * 2] = cmulw_s<INV>(x[3 + 4 * 2], W6);
    x[3 + 4 * 3] = cmulw_s<INV>(x[3 + 4 * 3], W9);
#pragma unroll
    for (int k2 = 0; k2 < 4; ++k2) { if (k2 == 2) dft4<INV, true>(x[0 + 4 * k2], x[1 + 4 * k2], x[2 + 4 * k2], x[3 + 4 * k2]); else dft4<INV>(x[0 + 4 * k2], x[1 + 4 * k2], x[2 + 4 * k2], x[3 + 4 * k2]); }
    cf t;
    t = x[1]; x[1] = x[4]; x[4] = t;   t = x[2]; x[2] = x[8]; x[8] = t;   t = x[3]; x[3] = x[12]; x[12] = t;
    t = x[6]; x[6] = x[9]; x[9] = t;   t = x[7]; x[7] = x[13]; x[13] = t; t = x[11]; x[11] = x[14]; x[14] = t;
}
template <bool INV> HD void twiddle16(cf (&x)[16], cf w1) {
    cf w = w1;
#pragma unroll
    for (int k = 1; k < 16; ++k) { x[k] = cmulw<INV>(x[k], w); if (k < 15) w = cmul(w, w1); }
}
constexpr int FFT_HALF = 4352;
constexpr int FFT_WORK = 2 * FFT_HALF;
HD int fphys(int h, int idx) { return h * FFT_HALF + idx + (idx >> 4); }

HD void geo1(int tid, int& h, int& j) { const int w = tid >> 6, l = tid & 63; h = l >> 5; j = 32 * w + (l & 31); }
HD void geo2(int tid, int& h, int& k1, int& j2) { h = tid >> 8; k1 = (tid >> 4) & 15; j2 = tid & 15; }
HD void geo3(int tid, int& h, int& blk) { h = tid >> 8; blk = tid & 255; }

HD int fbase1(int h, int j) { return h * FFT_HALF + j + (j >> 4); }
HD int fbase2(int h, int k1, int j2) { return h * FFT_HALF + 272 * k1 + j2; }
HD int fbase3(int h, int blk) { return h * FFT_HALF + 17 * blk; }
template <class L> HD void fwd_pass1(L lds, int b1, cf w4096j, cf (&x)[16]) {
    dft16<false>(x); twiddle16<false>(x, w4096j);
#pragma unroll
    for (int k = 0; k < 16; ++k) lds.st(b1 + 272 * k, x[k]);
}
template <class L> HD void fwd_pass2(L lds, int b2, cf w256j) {
    cf x[16];
#pragma unroll
    for (int m = 0; m < 16; ++m) x[m] = lds.ld(b2 + 17 * m);
    dft16<false>(x); twiddle16<false>(x, w256j);
#pragma unroll
    for (int k = 0; k < 16; ++k) lds.st(b2 + 17 * k, x[k]);
}
template <class L> HD void fwd_pass3_keep(L lds, int b3, cf (&x)[16]) {
#pragma unroll
    for (int m = 0; m < 16; ++m) x[m] = lds.ld(b3 + m);
    dft16<false>(x);
}
template <class L> HD void mid_pass3(L lds, int b3, const cf (&K)[16]) {
    cf x[16];
#pragma unroll
    for (int m = 0; m < 16; ++m) x[m] = lds.ld(b3 + m);
    dft16<false>(x);
#pragma unroll
    for (int k = 0; k < 16; ++k) x[k] = cmul(x[k], K[k]);
    dft16<true>(x);
#pragma unroll
    for (int m = 0; m < 16; ++m) lds.st(b3 + m, x[m]);
}
template <class L> HD void inv_pass2(L lds, int b2, cf w256j) {
    cf x[16];
#pragma unroll
    for (int k = 0; k < 16; ++k) x[k] = lds.ld(b2 + 17 * k);
    twiddle16<true>(x, w256j); dft16<true>(x);
#pragma unroll
    for (int m = 0; m < 16; ++m) lds.st(b2 + 17 * m, x[m]);
}
template <class L> HD void inv_pass1(L lds, int b1, cf w4096j, cf (&x)[16]) {
#pragma unroll
    for (int k = 0; k < 16; ++k) x[k] = lds.ld(b1 + 272 * k);
    twiddle16<true>(x, w4096j); dft16<true>(x);
}
#ifndef PG8_WGM
#define PG8_WGM 8
#endif
namespace pg8 {
#define PG8_LAS __attribute__((address_space(3)))
typedef unsigned short bf16_t;
typedef short bf16x8 __attribute__((ext_vector_type(8)));
typedef float f32x4 __attribute__((ext_vector_type(4)));
typedef unsigned u32x4 __attribute__((ext_vector_type(4)));
constexpr int BM = 256, BK = 64, HALF = 128, HTB = HALF * BK * 2  , STAGE_BYTES = 8 * HTB, NXCD = 8, WGM = PG8_WGM;

__host__ __device__ __forceinline__ int lds_byte(int r, int c) { const int st = (r >> 4) * 2 + (c >> 5), rr = r & 15, cc = c & 31, ob = rr * 64 + cc * 2; return st * 1024 + (ob ^ (((ob >> 9) & 1) << 5)); }
__host__ __device__ __forceinline__ void stage_rc(int b, int& R, int& C) { const int st = b / 1024, sb = b % 1024, swz = sb ^ (((sb >> 9) & 1) << 5); R = (st >> 1) * 16 + swz / 64; C = (st & 1) * 32 + (swz % 64) / 2; }
__host__ __device__ __forceinline__ int perm32(int rho) { const int n = rho >> 4, i = rho & 15; return 8 * (i >> 2) + 4 * n + (i & 3); }

typedef int v8i_t __attribute__((ext_vector_type(8))); typedef int v4i_t __attribute__((ext_vector_type(4)));
__device__ __forceinline__ v8i_t cat8(bf16x8 a, bf16x8 b) { const v4i_t x = __builtin_bit_cast(v4i_t, a), y = __builtin_bit_cast(v4i_t, b); return __builtin_shufflevector(x, y, 0, 1, 2, 3, 4, 5, 6, 7); }
struct Unit { int pm, pn; };
struct Gemm { const bf16_t* A; const bf16_t* Bt; int M, N, K; };

struct StaticOrder {
    int nM, nN, nwg, G, c;
    __host__ __device__ void init(int M, int N, int G_, int c_) { nM = M / BM; nN = N / BM; nwg = nM * nN; G = G_; c = c_; }
    __host__ __device__ bool next(int i, Unit& u) const {
        const long L = (long)i * G + c; if (L >= nwg) return false;
        int wgid = (int)L; { const int q = nwg / NXCD, r = nwg % NXCD, xcd = wgid % NXCD, off = wgid / NXCD; wgid = (xcd < r ? xcd * (q + 1) : r * (q + 1) + (xcd - r) * q) + off; }
        const int nig = WGM * nN, gid = wgid / nig, fm = gid * WGM, gsz = (nM - fm) < WGM ? (nM - fm) : WGM;
        u.pm = fm + ((wgid % nig) % gsz); u.pn = (wgid % nig) / gsz; return true;
    }
    __device__ __forceinline__ size_t boff(const Unit&) const { return 0; }
    __device__ __forceinline__ void a_ready(const Unit&) const {}
    __device__ __forceinline__ void done(const Unit&) const {}
};

__device__ __forceinline__ unsigned cvt_pk_bf16(float lo, float hi) { unsigned r; asm volatile("v_cvt_pk_bf16_f32 %0, %1, %2" : "=v"(r) : "v"(lo), "v"(hi)); return r; }
typedef float f32x2 __attribute__((ext_vector_type(2)));
typedef unsigned u32x2 __attribute__((ext_vector_type(2)));
__device__ __forceinline__ float row_rs(const float* ssp, int row, int fq) {
    if (!ssp) return 1.0f;
    const f32x4 q = *(const f32x4*)(ssp + (size_t)row * 16 + 4 * fq); float s = (q[0] + q[1]) + (q[2] + q[3]);
    s += __shfl_xor(s, 16); s += __shfl_xor(s, 32);
    return __builtin_amdgcn_rsqf(s * (1.0f / 1024.0f) + 1e-6f);
}
__device__ __forceinline__ void row_rs8(const float* ssp, int row0, int fq, float (&rs)[2][4]) {
    if (!ssp) {
#pragma unroll
        for (int ai = 0; ai < 2; ++ai)
#pragma unroll
            for (int m = 0; m < 4; ++m) rs[ai][m] = 1.0f;
        return; }
    f32x4 q[2][4];
#pragma unroll
    for (int ai = 0; ai < 2; ++ai)
#pragma unroll
        for (int m = 0; m < 4; ++m) q[ai][m] = *(const f32x4*)(ssp + (size_t)(row0 + ai * HALF + m * 16) * 16 + 4 * fq);
#pragma unroll
    for (int ai = 0; ai < 2; ++ai)
#pragma unroll
        for (int m = 0; m < 4; ++m) { float s = (q[ai][m][0] + q[ai][m][1]) + (q[ai][m][2] + q[ai][m][3]); s += __shfl_xor(s, 16); s += __shfl_xor(s, 32); rs[ai][m] = __builtin_amdgcn_rsqf(s * (1.0f / 1024.0f) + 1e-6f); }
}
__device__ __forceinline__ f32x4 row_rs4_swap(const float* ssp, int rowbase, int fr, int fq) {
    if (!ssp) return (f32x4){1.f, 1.f, 1.f, 1.f};
    const f32x4 q = *(const f32x4*)(ssp + (size_t)(rowbase + 4 * fq + (fr >> 2)) * 16 + 4 * (fr & 3)); float s = (q[0] + q[1]) + (q[2] + q[3]);
    s += __shfl_xor(s, 1); s += __shfl_xor(s, 2);
    const float rs = __builtin_amdgcn_rsqf(s * (1.0f / 1024.0f) + 1e-6f);
    f32x4 o;
#pragma unroll
    for (int r = 0; r < 4; ++r) o[r] = __shfl(rs, 16 * fq + 4 * r);
    return o;
}
template <bool F8 = false> struct EpiBf16T {
    static constexpr bool PERM = true, AFTER_DRAIN = false, SWAP = false, FP8 = F8;
    bf16_t* O; int ldc; const float* ss; float descale;
    __device__ __forceinline__ void operator()(const f32x4 (&acc)[2][2][4][2], const Unit& u, int wr, int wc, int fr, int fq) const {
        const int row0 = u.pm * BM + wr * 64 + fr, col0 = u.pn * BM + wc * 32 + 8 * fq;
        float rsa[2][4]; row_rs8(ss, row0, fq, rsa);
#pragma unroll
        for (int ai = 0; ai < 2; ++ai)
#pragma unroll
            for (int m = 0; m < 4; ++m) { bf16_t* rowp = O + (size_t)(row0 + ai * HALF + m * 16) * ldc + col0; const float rs = F8 ? rsa[ai][m] * descale : rsa[ai][m];
#pragma unroll
                for (int bj = 0; bj < 2; ++bj) { const f32x4 v0 = acc[ai][bj][m][0] * rs, v1 = acc[ai][bj][m][1] * rs;
                    u32x4 w; w.x = cvt_pk_bf16(v0[0], v0[1]); w.y = cvt_pk_bf16(v0[2], v0[3]); w.z = cvt_pk_bf16(v1[0], v1[1]); w.w = cvt_pk_bf16(v1[2], v1[3]);
                    *(u32x4*)(rowp + bj * HALF) = w; } }
    }
};
typedef EpiBf16T<false> EpiBf16;
struct EpiQKV {
    static constexpr bool PERM = true, AFTER_DRAIN = false, SWAP = false, FP8 = false;
    bf16_t* Q; bf16_t* Kb; bf16_t* Vb; const float* cosT; const float* sinT; const float* ss;
    __device__ __forceinline__ void operator()(const f32x4 (&acc)[2][2][4][2], const Unit& u, int wr, int wc, int fr, int fq) const {
        const int row0 = u.pm * BM + wr * 64 + fr;
        float rsa[2][4]; row_rs8(ss, row0, fq, rsa);
#pragma unroll
        for (int bj = 0; bj < 2; ++bj) {
            const int slot0 = u.pn * BM + bj * HALF + wc * 32 + 8 * fq;
            if (slot0 < 640) {
                const int head = slot0 >> 6, j4 = ((slot0 & 63) >> 3) * 4;
#pragma unroll
                for (int am = 0; am < 4; ++am) {
                    f32x4 c[2], sn[2];
                    const int tofs = ((row0 & 4095) + (am >> 1) * HALF + 2 * (am & 1) * 16) * 32 + j4;
                    const __attribute__((address_space(1))) float* cb = (const __attribute__((address_space(1))) float*)(cosT + tofs); const __attribute__((address_space(1))) float* sb = (const __attribute__((address_space(1))) float*)(sinT + tofs); asm volatile("" : "+v"(cb), "+v"(sb));
#pragma unroll
                    for (int h = 0; h < 2; ++h) { c[h] = *(const __attribute__((address_space(1))) f32x4*)(cb + h * 512); sn[h] = *(const __attribute__((address_space(1))) f32x4*)(sb + h * 512); }
#pragma unroll
                    for (int h = 0; h < 2; ++h) { const int ai = am >> 1, m = 2 * (am & 1) + h; const int row = row0 + ai * HALF + m * 16;
                        const float rs = rsa[ai][m]; const f32x4 lo = acc[ai][bj][m][0] * rs, hi = acc[ai][bj][m][1] * rs;
                        const f32x4 olo = lo * c[h] - hi * sn[h], ohi = hi * c[h] + lo * sn[h];
                        bf16_t* dst = head < 8 ? Q + (size_t)row * 512 + head * 64 + j4 : Kb + (size_t)row * 128 + (head - 8) * 64 + j4;
                        u32x2 w0, w1; w0.x = cvt_pk_bf16(olo[0], olo[1]); w0.y = cvt_pk_bf16(olo[2], olo[3]); w1.x = cvt_pk_bf16(ohi[0], ohi[1]); w1.y = cvt_pk_bf16(ohi[2], ohi[3]);
                        *(u32x2*)dst = w0; *(u32x2*)(dst + 32) = w1; } }
            } else {
#pragma unroll
                for (int ai = 0; ai < 2; ++ai)
#pragma unroll
                    for (int m = 0; m < 4; ++m) { const int row = row0 + ai * HALF + m * 16; const float rs = rsa[ai][m]; const f32x4 v0 = acc[ai][bj][m][0] * rs, v1 = acc[ai][bj][m][1] * rs;
                        u32x4 w; w.x = cvt_pk_bf16(v0[0], v0[1]); w.y = cvt_pk_bf16(v0[2], v0[3]); w.z = cvt_pk_bf16(v1[0], v1[1]); w.w = cvt_pk_bf16(v1[2], v1[3]);
                        *(u32x4*)(Vb + (size_t)row * 128 + (slot0 - 640)) = w; }
            }
        }
    }
};
struct EpiT {
    static constexpr bool PERM = false, AFTER_DRAIN = false, SWAP = true, FP8 = false;
    bf16_t* O; int nch; int ts_shift; const float* ss;
    __device__ __forceinline__ void operator()(const f32x4 (&acc)[2][2][4][2], const Unit& u, int wr, int wc, int fr, int fq) const {
        const int rowt = u.pm * BM, b = rowt >> ts_shift, tb = (rowt & ((1 << ts_shift) - 1)) + wr * 64 + 4 * fq;
#pragma unroll
        for (int ai = 0; ai < 2; ++ai) {
            f32x4 rsv[4];
#pragma unroll
            for (int m = 0; m < 4; ++m) rsv[m] = row_rs4_swap(ss, rowt + wr * 64 + ai * HALF + m * 16, fr, fq);
#pragma unroll
            for (int bj = 0; bj < 2; ++bj)
#pragma unroll
                for (int n = 0; n < 2; ++n) { const int ch = u.pn * BM + bj * HALF + wc * 32 + 16 * n + fr; bf16_t* chp = O + (((size_t)(b * nch + ch)) << ts_shift) + tb + ai * HALF;
#pragma unroll
                    for (int m = 0; m < 4; ++m) { const f32x4 v = acc[ai][bj][m][n] * rsv[m]; u32x2 w; w.x = cvt_pk_bf16(v[0], v[1]); w.y = cvt_pk_bf16(v[2], v[3]);
                        *(u32x2*)(chp + m * 16) = w; } } }
    }
};
struct EpiResB {
    static constexpr bool PERM = true, AFTER_DRAIN = false, SWAP = false, FP8 = false;
    bf16_t* xb; int ldc; float* ss; bf16_t* dst;
    __device__ __forceinline__ void operator()(const f32x4 (&acc)[2][2][4][2], const Unit& u, int wr, int wc, int fr, int fq) const {
        const int row0 = u.pm * BM + wr * 64 + fr, col0 = u.pn * BM + wc * 32 + 8 * fq;
#pragma unroll
        for (int ai = 0; ai < 2; ++ai) {
            u32x4 b[4][2];
#pragma unroll
            for (int m = 0; m < 4; ++m)
#pragma unroll
                for (int bj = 0; bj < 2; ++bj) b[m][bj] = *(const u32x4*)(xb + (size_t)(row0 + ai * HALF + m * 16) * ldc + col0 + bj * HALF);
#pragma unroll
            for (int m = 0; m < 4; ++m) { const int row = row0 + ai * HALF + m * 16; bf16_t* dstp = dst + (size_t)row * ldc + col0; float sq = 0.f;
#pragma unroll
                for (int bj = 0; bj < 2; ++bj) { const f32x4 a0 = acc[ai][bj][m][0], a1 = acc[ai][bj][m][1]; const u32x4 bb = b[m][bj]; float o[8];
                    o[0] = __builtin_bit_cast(float, bb.x << 16) + a0[0]; o[1] = __builtin_bit_cast(float, bb.x & 0xffff0000u) + a0[1];
                    o[2] = __builtin_bit_cast(float, bb.y << 16) + a0[2]; o[3] = __builtin_bit_cast(float, bb.y & 0xffff0000u) + a0[3];
                    o[4] = __builtin_bit_cast(float, bb.z << 16) + a1[0]; o[5] = __builtin_bit_cast(float, bb.z & 0xffff0000u) + a1[1];
                    o[6] = __builtin_bit_cast(float, bb.w << 16) + a1[2]; o[7] = __builtin_bit_cast(float, bb.w & 0xffff0000u) + a1[3];
#pragma unroll
                    for (int i = 0; i < 8; ++i) sq += o[i] * o[i];
                    u32x4 w; w.x = cvt_pk_bf16(o[0], o[1]); w.y = cvt_pk_bf16(o[2], o[3]); w.z = cvt_pk_bf16(o[4], o[5]); w.w = cvt_pk_bf16(o[6], o[7]);
                    *(u32x4*)(dstp + bj * HALF) = w; }
                if (ss) { sq += __shfl_xor(sq, 16); sq += __shfl_xor(sq, 32); if (fq == 0) ss[(size_t)row * 16 + u.pn * 4 + wc] = sq; } } }
    }
};
typedef float f32x2e __attribute__((ext_vector_type(2)));
__device__ __forceinline__ f32x2e silu_mul_pk(f32x2e g, f32x2e up) {
    const f32x2e t = g * (-1.44269504088896f); f32x2e e; e.x = __builtin_amdgcn_exp2f(t.x); e.y = __builtin_amdgcn_exp2f(t.y);
    const f32x2e d = e + 1.0f; f32x2e r; r.x = __builtin_amdgcn_rcpf(d.x); r.y = __builtin_amdgcn_rcpf(d.y);
    return (g * r) * up;
}
template <bool SCALE, bool F8 = false, bool F8OUT = false> struct EpiSwiglu {
    static constexpr bool PERM = true, AFTER_DRAIN = false, SWAP = false, FP8 = F8;
    bf16_t* O; int ldc; const float* ss;
    __device__ __forceinline__ void operator()(const f32x4 (&acc)[2][2][4][2], const Unit& u, int wr, int wc, int fr, int fq) const {
        const int row0 = u.pm * BM + wr * 64 + fr, col0 = u.pn * 128 + wc * 32 + 8 * fq;
        float rsa[2][4]; if (SCALE) row_rs8(ss, row0, fq, rsa);
#pragma unroll
        for (int ai = 0; ai < 2; ++ai)
#pragma unroll
            for (int m = 0; m < 4; ++m) { const int row = row0 + ai * HALF + m * 16; float sc = F8 ? 0.03125f : 1.0f; if (SCALE) sc *= rsa[ai][m];
                f32x2e o[4];
#pragma unroll
                for (int n = 0; n < 2; ++n) { f32x4 g = acc[ai][0][m][n], up = acc[ai][1][m][n]; if (SCALE || F8) { g = g * sc; up = up * sc; }
                    o[2 * n] = silu_mul_pk((f32x2e){g[0], g[1]}, (f32x2e){up[0], up[1]}); o[2 * n + 1] = silu_mul_pk((f32x2e){g[2], g[3]}, (f32x2e){up[2], up[3]}); }
                if (F8OUT) { int w0 = 0, w1 = 0; w0 = __builtin_amdgcn_cvt_pk_fp8_f32(o[0].x * 4.0f, o[0].y * 4.0f, w0, false); w0 = __builtin_amdgcn_cvt_pk_fp8_f32(o[1].x * 4.0f, o[1].y * 4.0f, w0, true);
                    w1 = __builtin_amdgcn_cvt_pk_fp8_f32(o[2].x * 4.0f, o[2].y * 4.0f, w1, false); w1 = __builtin_amdgcn_cvt_pk_fp8_f32(o[3].x * 4.0f, o[3].y * 4.0f, w1, true);
                    u32x2 w8; w8.x = (unsigned)w0; w8.y = (unsigned)w1; *(u32x2*)((unsigned char*)O + (size_t)row * ldc + col0) = w8; }
                else { u32x4 w; w.x = cvt_pk_bf16(o[0].x, o[0].y); w.y = cvt_pk_bf16(o[1].x, o[1].y); w.z = cvt_pk_bf16(o[2].x, o[2].y); w.w = cvt_pk_bf16(o[3].x, o[3].y);
                    *(u32x4*)(O + (size_t)row * ldc + col0) = w; } }
    }
};
template <class Epi, class Sched, bool ALIGN_EPI = false, bool SP2 = false>
__device__ __forceinline__ void gemm_phase(PG8_LAS unsigned char* lds, const Gemm g, const Sched& S, const Epi& E) {
    const int tid = opq_tid(), wid = __builtin_amdgcn_readfirstlane(tid >> 6), lane = tid & 63, wr = wid >> 2, wc = wid & 3, fr = lane & 15, fq = lane >> 4;
    const int K = g.K, nt = K / BK;
    unsigned voffA[2], voffB[2];
#pragma unroll
    for (int i = 0; i < 2; ++i) { int R, C; stage_rc(tid * 16 + i * 8192, R, C); const int Rb = Epi::PERM ? ((R & ~31) + perm32(R & 31)) : R;
        voffA[i] = (unsigned)(R * K + C) * 2u; voffB[i] = (unsigned)(Rb * K + C) * 2u; }
    const size_t kstep = (size_t)(BK * 2);
    const size_t hstep = (size_t)HALF * K * 2;
    const size_t tstep = 2 * hstep;
    const unsigned ldsw = (unsigned)wid * 1024u;
    const int aoff = lds_byte(wr * 64 + fr, fq * 8), boff = lds_byte(wc * 32 + fr, fq * 8);
#define PG8_SA(b, h) (((b) * 2 + (h)) * HTB)
#define PG8_SB(b, h) ((4 + (b) * 2 + (h)) * HTB)
#define PG8_STAGE(bufoff, gbase, voff) do { _Pragma("unroll") for (int _i = 0; _i < 2; ++_i) \
        __builtin_amdgcn_global_load_lds((const unsigned*)((const char*)(gbase) + (voff)[_i]), (PG8_LAS unsigned*)(lds + (bufoff) + ldsw + _i * 8192), 16, 0, 0); } while (0)
#define PG8_LDA(dst, b, h) do { if constexpr (Epi::FP8) { _Pragma("unroll") for (int m = 0; m < 4; ++m) dst##8[m] = cat8(*(const PG8_LAS bf16x8*)(lds + PG8_SA(b, h) + aoff + m * 2048), *(const PG8_LAS bf16x8*)(lds + PG8_SA(b, h) + aoff + m * 2048 + 1024)); } else { \
        _Pragma("unroll") for (int m = 0; m < 4; ++m) _Pragma("unroll") for (int k = 0; k < 2; ++k) dst[m][k] = *(const PG8_LAS bf16x8*)(lds + PG8_SA(b, h) + aoff + m * 2048 + k * 1024); } } while (0)
#define PG8_LDB(dst, b, h) do { if constexpr (Epi::FP8) { _Pragma("unroll") for (int n = 0; n < 2; ++n) dst##8[n] = cat8(*(const PG8_LAS bf16x8*)(lds + PG8_SB(b, h) + boff + n * 2048), *(const PG8_LAS bf16x8*)(lds + PG8_SB(b, h) + boff + n * 2048 + 1024)); } else { \
        _Pragma("unroll") for (int n = 0; n < 2; ++n) _Pragma("unroll") for (int k = 0; k < 2; ++k) dst[n][k] = *(const PG8_LAS bf16x8*)(lds + PG8_SB(b, h) + boff + n * 2048 + k * 1024); } } while (0)
#define PG8_MMA(ai, bj, At, Bt) do { __builtin_amdgcn_s_setprio(1); if constexpr (Epi::FP8) { _Pragma("unroll") for (int m = 0; m < 4; ++m) _Pragma("unroll") for (int n = 0; n < 2; ++n) \
        asm volatile("v_mfma_scale_f32_16x16x128_f8f6f4 %0, %1, %2, %0, %3, %3 op_sel_hi:[0,0,0]" : "+v"(acc[ai][bj][m][n]) : "v"(Bt##8[n]), "v"(At##8[m]), "v"(f8one)); } else { \
        _Pragma("unroll") for (int m = 0; m < 4; ++m) _Pragma("unroll") for (int n = 0; n < 2; ++n) _Pragma("unroll") for (int k = 0; k < 2; ++k) \
        acc[ai][bj][m][n] = Epi::SWAP ? __builtin_amdgcn_mfma_f32_16x16x32_bf16(At[m][k], Bt[n][k], acc[ai][bj][m][n], 0, 0, 0) : __builtin_amdgcn_mfma_f32_16x16x32_bf16(Bt[n][k], At[m][k], acc[ai][bj][m][n], 0, 0, 0); } __builtin_amdgcn_s_setprio(0); } while (0)
#define PG8_WAIT_V(n) asm volatile("s_waitcnt vmcnt(" #n ")" ::: "memory")
#define PG8_WAIT_L(n) asm volatile("s_waitcnt lgkmcnt(" #n ")" ::: "memory")
#define PG8_BAR __builtin_amdgcn_s_barrier()
#define PG8_SCHED __builtin_amdgcn_sched_barrier(0)
#ifdef DIAG
    unsigned long long dg_k = 0, dg_e = 0, dg_t1 = 0, dg_t2 = 0; const unsigned long long dg_t0 = wall_clock64();
#endif
    Unit cur, nxt; int ui = 0;
    if (!S.next(0, cur)) return;
    f32x4 acc[2][2][4][2];
#pragma unroll
    for (int a = 0; a < 2; ++a)
#pragma unroll
        for (int b = 0; b < 2; ++b)
#pragma unroll
            for (int m = 0; m < 4; ++m)
#pragma unroll
                for (int n = 0; n < 2; ++n) acc[a][b][m][n] = (f32x4){0.f, 0.f, 0.f, 0.f};
    bf16x8 At[4][2], B0[2][2], B1[2][2]; v8i_t At8[4], B08[2], B18[2];
    int f8one = 0x7F7F7F7F; asm volatile("" : "+v"(f8one));
    const char* cA = (const char*)g.A + (size_t)cur.pm * tstep; const char* cB = (const char*)g.Bt + S.boff(cur) + (size_t)cur.pn * tstep;
    S.a_ready(cur);
    if constexpr (SP2) {
        PG8_STAGE(PG8_SB(0, 0), cB, voffB); PG8_STAGE(PG8_SB(0, 1), cB + hstep, voffB); PG8_STAGE(PG8_SA(0, 0), cA, voffA); PG8_STAGE(PG8_SA(0, 1), cA + hstep, voffA);
        if (wr == 1) PG8_BAR;
        PG8_WAIT_V(2); PG8_BAR;
        PG8_STAGE(PG8_SB(1, 0), cB + kstep, voffB); PG8_STAGE(PG8_SA(1, 0), cA + kstep, voffA); PG8_STAGE(PG8_SB(1, 1), cB + hstep + kstep, voffB);
        PG8_WAIT_V(6); PG8_BAR;
    } else {
        PG8_STAGE(PG8_SB(0, 0), cB, voffB); PG8_STAGE(PG8_SA(0, 0), cA, voffA); PG8_STAGE(PG8_SB(0, 1), cB + hstep, voffB); PG8_STAGE(PG8_SA(0, 1), cA + hstep, voffA);
        if (wr == 1) PG8_BAR;
        PG8_WAIT_V(4); PG8_BAR;
        PG8_STAGE(PG8_SB(1, 0), cB + kstep, voffB); PG8_STAGE(PG8_SA(1, 0), cA + kstep, voffA); PG8_STAGE(PG8_SB(1, 1), cB + hstep + kstep, voffB);
        PG8_WAIT_V(6); PG8_BAR;
    }
    for (;;) {
        const bool has_next = S.next(ui + 1, nxt);
        const char* nA = has_next ? (const char*)g.A + (size_t)nxt.pm * tstep : cA; const char* nB = has_next ? (const char*)g.Bt + S.boff(nxt) + (size_t)nxt.pn * tstep : cB;
#ifdef DIAG
        dg_t1 = wall_clock64();
#endif
        CHAOS_POINT(4, 41);
        for (int t = 0; t < nt; t += 2) { CHAOS_POINT(8, 42);
            const bool last = (t == nt - 2);
            const char* a1 = cA + (size_t)(t + 1) * kstep;
            const char* a2 = last ? nA : cA + (size_t)(t + 2) * kstep; const char* b2 = last ? nB : cB + (size_t)(t + 2) * kstep;
            const char* a3 = a2 + kstep; const char* b3 = b2 + kstep;
            if (last && has_next) S.a_ready(nxt);
            if constexpr (SP2) {
            PG8_LDB(B0, 0, 0); PG8_LDB(B1, 0, 1); PG8_SCHED; PG8_LDA(At, 0, 0); PG8_STAGE(PG8_SA(1, 1), a1 + hstep, voffA);
            PG8_WAIT_V(8); PG8_WAIT_L(0); PG8_BAR; PG8_MMA(0, 0, At, B0); PG8_MMA(0, 1, At, B1); PG8_BAR; PG8_SCHED;
            PG8_LDA(At, 0, 1); PG8_STAGE(PG8_SB(0, 0), b2, voffB); PG8_STAGE(PG8_SB(0, 1), b2 + hstep, voffB); PG8_STAGE(PG8_SA(0, 0), a2, voffA);
            PG8_WAIT_V(8); PG8_WAIT_L(0); PG8_BAR; PG8_MMA(1, 0, At, B0); PG8_MMA(1, 1, At, B1); PG8_BAR; PG8_SCHED;
            PG8_LDB(B0, 1, 0); PG8_LDB(B1, 1, 1); PG8_SCHED; PG8_LDA(At, 1, 0); PG8_STAGE(PG8_SA(0, 1), a2 + hstep, voffA);
            PG8_WAIT_V(8); PG8_WAIT_L(0); PG8_BAR; PG8_MMA(0, 0, At, B0); PG8_MMA(0, 1, At, B1); PG8_BAR; PG8_SCHED;
            PG8_LDA(At, 1, 1); PG8_STAGE(PG8_SB(1, 0), b3, voffB); PG8_STAGE(PG8_SB(1, 1), b3 + hstep, voffB); PG8_STAGE(PG8_SA(1, 0), a3, voffA);
            PG8_WAIT_V(8); PG8_WAIT_L(0); PG8_BAR; PG8_MMA(1, 0, At, B0); PG8_MMA(1, 1, At, B1); PG8_BAR; PG8_SCHED;
            } else {
            PG8_LDB(B0, 0, 0); PG8_SCHED; PG8_LDA(At, 0, 0); PG8_STAGE(PG8_SA(1, 1), a1 + hstep, voffA);
            PG8_WAIT_L(8); PG8_BAR; PG8_WAIT_L(0); PG8_MMA(0, 0, At, B0); PG8_BAR; PG8_SCHED;
            PG8_LDB(B1, 0, 1); PG8_STAGE(PG8_SB(0, 0), b2, voffB);
            PG8_BAR; PG8_WAIT_L(0); PG8_MMA(0, 1, At, B1); PG8_BAR;
            PG8_LDA(At, 0, 1); PG8_STAGE(PG8_SA(0, 0), a2, voffA);
            PG8_BAR; PG8_WAIT_L(0); PG8_MMA(1, 0, At, B0); PG8_BAR; PG8_SCHED;
            PG8_STAGE(PG8_SB(0, 1), b2 + hstep, voffB);
            PG8_WAIT_V(6); PG8_BAR; PG8_MMA(1, 1, At, B1); PG8_BAR;
            PG8_LDB(B0, 1, 0); PG8_SCHED; PG8_LDA(At, 1, 0); PG8_STAGE(PG8_SA(0, 1), a2 + hstep, voffA);
            PG8_WAIT_L(8); PG8_BAR; PG8_WAIT_L(0); PG8_MMA(0, 0, At, B0); PG8_BAR; PG8_SCHED;
            PG8_LDB(B1, 1, 1); PG8_STAGE(PG8_SB(1, 0), b3, voffB);
            PG8_BAR; PG8_WAIT_L(0); PG8_MMA(0, 1, At, B1); PG8_BAR;
            PG8_LDA(At, 1, 1); PG8_STAGE(PG8_SA(1, 0), a3, voffA);
            PG8_BAR; PG8_WAIT_L(0); PG8_MMA(1, 0, At, B0); PG8_BAR; PG8_SCHED;
            PG8_STAGE(PG8_SB(1, 1), b3 + hstep, voffB);
            PG8_WAIT_V(6); PG8_BAR; PG8_MMA(1, 1, At, B1); PG8_BAR;
            }
        }
#ifdef DIAG
        dg_t2 = wall_clock64(); dg_k += dg_t2 - dg_t1;
#endif
        if constexpr (Epi::FP8) asm volatile("s_nop 15\n\ts_nop 15" ::: "memory");
        if constexpr (ALIGN_EPI) { if (wr == 0) PG8_BAR; }
#ifndef EPI_REP
#define EPI_REP 1
#endif
        CHAOS_POINT(4, 43);
        if constexpr (!Epi::AFTER_DRAIN) { _Pragma("unroll 1") for (int er_ = 0; er_ < EPI_REP; ++er_) E(acc, cur, wr, wc, fr, fq); S.done(cur); }
#ifdef DIAG
        dg_e += wall_clock64() - dg_t2;
#endif
        if (!has_next) break;
#pragma unroll
        for (int a = 0; a < 2; ++a)
#pragma unroll
            for (int b = 0; b < 2; ++b)
#pragma unroll
                for (int m = 0; m < 4; ++m)
#pragma unroll
                    for (int n = 0; n < 2; ++n) acc[a][b][m][n] = (f32x4){0.f, 0.f, 0.f, 0.f};
        cur = nxt; cA = nA; cB = nB; ++ui;
        if constexpr (ALIGN_EPI) { if (wr == 1) PG8_BAR; }
    }
#ifdef DIAG
    if (blockIdx.x == 0 && tid == 0) { unsigned long long* dg = (unsigned long long*)(*(const PG8_LAS unsigned long long*)(lds + 155712)); atomicAdd(dg + 0, dg_k); atomicAdd(dg + 1, dg_e); atomicAdd(dg + 2, wall_clock64() - dg_t0); atomicAdd(dg + 3, (unsigned long long)(ui + 1)); }
#endif
    PG8_WAIT_V(0);
    if constexpr (!ALIGN_EPI) { if (wr == 0) PG8_BAR; }
    PG8_BAR;
    if constexpr (Epi::AFTER_DRAIN) { E.fused(acc, cur, wr, wc, fr, fq, lds, wid, lane); S.done(cur); }
#undef PG8_SA
#undef PG8_SB
#undef PG8_STAGE
#undef PG8_LDA
#undef PG8_LDB
#undef PG8_MMA
#undef PG8_WAIT_V
#undef PG8_WAIT_L
#undef PG8_BAR
#undef PG8_SCHED
}
}
#ifndef PG8_SP2
#define PG8_SP2 true
#endif
#ifndef PG8_ALIGN
#define PG8_ALIGN true
#endif
constexpr int NB = 16, SEQ = 4096, D = 1024, M = NB * SEQ;
constexpr int NH = 8, NKV = 2, HDIM = 64, AW = 512, KVW = 128;
constexpr int HYW = 512, C3 = 1536, INC = 2304;
constexpr int XH = 4, XHD = 128, XW = 512, MEML = 256, MROWS = NB * MEML;
constexpr int FF = 2816, NE = 8, FFE = 3584;
constexpr float EPS = 1e-6f;
constexpr int NWAVES = 8, NTHR = 512;
constexpr int MOE_CH_TILES = 128, MOE_NCHUNK = 4, MOE_MAX_TILES = 520, MOE_MAX_ROWS = MOE_MAX_TILES * 256, MOE_ACT_TILES = MOE_MAX_TILES - (MOE_NCHUNK - 1) * MOE_CH_TILES;

constexpr size_t al256(size_t x) { return (x + 255) & ~(size_t)255; }
constexpr size_t WS_CTL = 0, CTL_ZERO_BYTES = 1u << 20;
constexpr size_t WS_SS = CTL_ZERO_BYTES, SS_STRIDE = (size_t)M * 16;
constexpr size_t WS_COS = WS_SS + 5 * SS_STRIDE * 4, WS_SIN = WS_COS + (size_t)SEQ * 32 * 4, WS_H2 = WS_SIN + (size_t)SEQ * 32 * 4;
constexpr size_t WS_TOKE = WS_H2 + (size_t)2 * SEQ * 64 * 4, WS_TOKW = WS_TOKE + (size_t)M * 2 * 4, WS_TOKP = WS_TOKW + (size_t)M * 2 * 4;
constexpr size_t WS_ROWTOK = WS_TOKP + (size_t)M * 2 * 4, WS_TILEE = WS_ROWTOK + al256((size_t)MOE_MAX_ROWS * 4), WS_WGCNT = WS_TILEE + 4096, WS_RSROW = WS_WGCNT + (size_t)1024 * 8 * 4, WS_META = WS_RSROW + (size_t)M * 4;
constexpr size_t WS_WINA = al256(WS_META + 4096);
constexpr size_t WS_WINB = WS_WINA + (size_t)2 * 768 * D * 2;
constexpr size_t WS_WOUT = WS_WINB + (size_t)2 * C3 * D * 2;
constexpr size_t WS_XQ = WS_WOUT + (size_t)2 * D * D * 2;
constexpr size_t WS_XK = WS_XQ + (size_t)2 * XW * D * 2;
constexpr size_t WS_XV = WS_XK + (size_t)2 * XW * D * 2;
constexpr size_t WS_XO = WS_XV + (size_t)2 * XW * D * 2;
constexpr size_t WS_FGU = WS_XO + (size_t)2 * D * XW * 2;
constexpr size_t WS_FDN = WS_FGU + (size_t)2 * FF * D * 2;
constexpr size_t WS_MGU = WS_FDN + (size_t)D * FF * 2;
constexpr size_t WS_MDN = WS_MGU + (size_t)NE * 2 * FFE * D;
constexpr size_t WS_KFILT = WS_MDN + (size_t)NE * D * FFE;
constexpr size_t WS_MB = WS_KFILT + (size_t)2 * 2 * HYW * 8192 * 4;
constexpr size_t WS_KMEM = WS_MB + (size_t)MROWS * D * 2;
constexpr size_t WS_VMEMT = WS_KMEM + (size_t)MROWS * 1024 * 2;
constexpr size_t WS_HB = WS_VMEMT + (size_t)1024 * MROWS * 2;
constexpr size_t WS_R = WS_HB + (size_t)M * D * 2;
constexpr size_t WS_QB = WS_R, WS_KB = WS_QB + (size_t)M * AW * 2, WS_VB = WS_KB + (size_t)M * KVW * 2, WS_UT = WS_VB + (size_t)M * KVW * 2;
constexpr size_t WS_MIXED = WS_UT;
constexpr size_t WS_AB = WS_UT + (size_t)M * C3 * 2, WS_YT = WS_AB + (size_t)M * AW * 2, WS_KSPEC = WS_YT + (size_t)M * HYW * 2, WS_MIXEND = WS_KSPEC + (size_t)2 * 2 * HYW * 16384 * 4;
constexpr size_t WS_XQB = WS_R, WS_XOB = WS_XQB + (size_t)M * XW * 2;
constexpr size_t WS_ACT = WS_R;
constexpr size_t WS_XG = WS_R;
constexpr size_t WS_MACT = WS_XG + (size_t)MOE_MAX_ROWS * D;
constexpr size_t WS_YB = WS_MACT + (size_t)MOE_ACT_TILES * 256 * FFE;
constexpr size_t WS_MOEEND = WS_YB + (size_t)MOE_MAX_ROWS * D * 2;
constexpr size_t cmax(size_t a, size_t b) { return a > b ? a : b; }
constexpr size_t WS_END = cmax(cmax(WS_MIXEND, WS_ACT + (size_t)M * FF * 2), WS_MOEEND);
static_assert(WS_END <= (size_t)1073741824, "workspace map exceeds 1 GiB");
static_assert(WS_ACT + (size_t)M * FF * 2 <= WS_KSPEC && WS_XOB + (size_t)M * XW * 2 <= WS_KSPEC, "layer 0's later phases must not touch the filter spectra");
constexpr int CW_TMO = 0, CW_CODE = 1, CW_BAR = 4096;

constexpr int PHASE_LDS = 155648;
constexpr int LDSCTL_OFF = PHASE_LDS, MISC_OFF = LDSCTL_OFF + 64;
constexpr int LDS_BYTES = PHASE_LDS + 512;

#define GAS __attribute__((address_space(1)))
#define LAS __attribute__((address_space(3)))
typedef unsigned short bf16;
typedef unsigned v4u __attribute__((ext_vector_type(4)));
typedef unsigned v2u __attribute__((ext_vector_type(2)));
typedef float f32x4 __attribute__((ext_vector_type(4)));
typedef short bf16x8 __attribute__((ext_vector_type(8)));
typedef short s16x4 __attribute__((ext_vector_type(4)));
typedef GAS unsigned gu32;
#define RLX_AGENT __ATOMIC_RELAXED, __HIP_MEMORY_SCOPE_AGENT
#define LDS_WAIT() asm volatile("s_waitcnt lgkmcnt(0)" ::: "memory")
#define VM_WAIT() asm volatile("s_waitcnt vmcnt(0)" ::: "memory")
__device__ __forceinline__ unsigned f2bf(float f) { unsigned u = __builtin_bit_cast(unsigned, f); return (u + 0x7fffu + ((u >> 16) & 1u)) >> 16; }
__device__ __forceinline__ unsigned pk2(float lo, float hi) { return cvtpk_hw(lo, hi); }
__device__ __forceinline__ float bflo(unsigned w) { return __builtin_bit_cast(float, w << 16); }
__device__ __forceinline__ float bfhi(unsigned w) { return __builtin_bit_cast(float, w & 0xffff0000u); }
__device__ __forceinline__ float bf1(unsigned short h) { return __builtin_bit_cast(float, ((unsigned)h) << 16); }
#define XB_TMO      128
#define XB_XCNT(j)  (256  + 64 * (j))
#define XB_XSUB(j)  (1280 + 64 * (j))
#define XB_XGEN(j)  (2304 + 64 * (j))
#define XB_TOP      3328
#define XB_TOPGEN   3392
#define XCD_BAR_WORDS 3456
#define XB_SPIN_CAP (1u << 22)

__device__ __forceinline__ unsigned xb_ld(unsigned* p)              { return __hip_atomic_load(p, __ATOMIC_RELAXED, __HIP_MEMORY_SCOPE_AGENT); }
__device__ __forceinline__ unsigned xb_add(unsigned* p, unsigned v) { return __hip_atomic_fetch_add(p, v, __ATOMIC_RELAXED, __HIP_MEMORY_SCOPE_AGENT); }
__device__ __forceinline__ unsigned xb_xcc_id() { return (unsigned)__builtin_amdgcn_s_getreg((3 << 11) | 20) & 0xFu; }
#define XB_SPIN(cond, bar) do { unsigned _sp = 0; while (cond) { __builtin_amdgcn_s_sleep(1); \
    if ((++_sp & 255u) == 0u) { if (xb_ld(&(bar)[XB_TMO])) break; if (_sp > XB_SPIN_CAP) { atomicAdd(&(bar)[XB_TMO], 1u); break; } } } } while (0)

struct XcdBarrier {
    unsigned* bar; unsigned x;
    volatile LAS unsigned* st;
};

__device__ __forceinline__ XcdBarrier xcd_barrier_post(unsigned* bar, volatile LAS unsigned* st) {
    XcdBarrier b; b.bar = bar; b.x = xb_xcc_id(); b.st = st;
    if (threadIdx.x == 0) (void)xb_add(&bar[XB_XCNT(b.x)], 1u);
    return b;
}
__device__ __forceinline__ void xcd_barrier_complete(unsigned* bar, unsigned x, unsigned& nloc, unsigned& nx) {
    const unsigned G = gridDim.x * gridDim.y * gridDim.z;
    unsigned sum, cnt, mine, sp = 0u;
    for (;;) {
        sum = 0u; cnt = 0u; mine = 0u;
#pragma unroll
        for (unsigned j = 0; j < 16; ++j) { const unsigned c = xb_ld(&bar[XB_XCNT(j)]); sum += c; cnt += (c > 0u) ? 1u : 0u; mine = (j == x) ? c : mine; }
        if (sum == G) break;
        __builtin_amdgcn_s_sleep(1);
        if ((++sp & 255u) == 0u) { if (xb_ld(&bar[XB_TMO])) break; if (sp > XB_SPIN_CAP) { atomicAdd(&bar[XB_TMO], 1u); break; } }
    }
    nloc = mine > 0u ? mine : 1u; nx = cnt > 0u ? cnt : 1u;
}

__device__ __forceinline__ void xcd_barrier(const XcdBarrier& b) {
    asm volatile("s_waitcnt vmcnt(0)" ::: "memory");
    __syncthreads();
    if (threadIdx.x == 0) {
        unsigned* bar = b.bar;
        __builtin_amdgcn_s_waitcnt(0);
        unsigned nloc = b.st[0], nx = b.st[1];
        if (nloc == 0u) { xcd_barrier_complete(bar, b.x, nloc, nx); b.st[0] = nloc; b.st[1] = nx; }
        const unsigned old = xb_add(&bar[XB_XSUB(b.x)], 1u);
        const unsigned gen = old / nloc;
        if (old + 1u == (gen + 1u) * nloc) {
            __builtin_amdgcn_fence(__ATOMIC_RELEASE, "agent");
            asm volatile("s_waitcnt vmcnt(0)" ::: "memory");
            const unsigned og = xb_add(&bar[XB_TOP], 1u);
            const unsigned tg = og / nx;
            if (og + 1u == (tg + 1u) * nx) xb_add(&bar[XB_TOPGEN], 1u);
            else XB_SPIN(xb_ld(&bar[XB_TOPGEN]) == tg, bar);
            __builtin_amdgcn_fence(__ATOMIC_ACQUIRE, "agent");
            xb_add(&bar[XB_XGEN(b.x)], 1u);
            asm volatile("s_waitcnt vmcnt(0)" ::: "memory");
        } else {
            XB_SPIN(xb_ld(&bar[XB_XGEN(b.x)]) == gen, bar);
            __builtin_amdgcn_fence(__ATOMIC_ACQUIRE, "agent");
            asm volatile("s_waitcnt vmcnt(0)" ::: "memory");
        }
    }
    __syncthreads();
}
struct Args { const float* in[33]; float* out; unsigned char* ws; int ph_lo, ph_hi, use_bar, pad; };
enum InIdx { I_X = 0, I_MEM, I_MEMNORM, I_MIXNORM, I_WIN, I_SINK, I_CONVW, I_CONVB, I_FW1, I_FB1, I_FFR1, I_FW2, I_FB2, I_FFR2, I_FW3, I_SKIP, I_ANORM, I_YNORM, I_WOUT, I_XNORM,
             I_XWQ, I_XWK, I_XWV, I_XWO, I_FNORM, I_FGATE, I_FUP, I_FDOWN, I_ROUTER, I_MGATE, I_MUP, I_MDOWN, I_FINAL };

__device__ __forceinline__ float wave_sum(float v) {
#pragma unroll
    for (int o = 1; o < 64; o <<= 1) v += __shfl_xor(v, o);
    return v;
}
__device__ __forceinline__ void wg_sync() { __builtin_amdgcn_sched_barrier(0); asm volatile("s_waitcnt vmcnt(0) lgkmcnt(0)" ::: "memory"); __builtin_amdgcn_s_barrier(); asm volatile("" ::: "memory"); __builtin_amdgcn_sched_barrier(0); }

template <int MODE> __device__ __forceinline__ int rowmap(int n) {
    if (MODE == 1) return n < 640 ? ((n & ~63) + 8 * ((n & 31) >> 2) + (n & 3) + 4 * ((n >> 5) & 1)) : n;
    if (MODE == 2) return ((n >> 7) << 8) + (n & 127);
    if (MODE == 3) return ((n >> 7) << 8) + 128 + (n & 127);
    return n;
}
__device__ __forceinline__ int rowmap_rt(int mode, int n) { return mode == 1 ? rowmap<1>(n) : mode == 2 ? rowmap<2>(n) : mode == 3 ? rowmap<3>(n) : n; }
__device__ __forceinline__ void tr_item(const float* W, int ldw, int K, int col0, int ncols, bf16* WT, int mode, const float* gk, int item, LAS float* scr, int lane) {
    const int nblk = ncols / 32, kb = item / nblk, nb = item % nblk, k0 = 64 * kb, n0 = 32 * nb;
    f32x4 tv[8];
#pragma unroll
    for (int i = 0; i < 8; ++i) { const int kk = 8 * i + (lane >> 3); tv[i] = *(const f32x4*)(W + (size_t)(k0 + kk) * ldw + col0 + n0 + 4 * (lane & 7)); }
#pragma unroll
    for (int i = 0; i < 8; ++i) { const int kk = 8 * i + (lane >> 3); const float gv = gk ? gk[k0 + kk] : 1.0f; LAS float* d = scr + kk * 33 + 4 * (lane & 7);
        d[0] = gv * tv[i][0]; d[1] = gv * tv[i][1]; d[2] = gv * tv[i][2]; d[3] = gv * tv[i][3]; }
    LDS_WAIT(); asm volatile("" ::: "memory");
    const int c = lane & 7;
#pragma unroll
    for (int j = 0; j < 4; ++j) { const int n = (lane >> 3) + 8 * j; const LAS float* sp = scr + (8 * c) * 33 + n;
        v4u o; o.x = pk2(sp[0 * 33], sp[1 * 33]); o.y = pk2(sp[2 * 33], sp[3 * 33]); o.z = pk2(sp[4 * 33], sp[5 * 33]); o.w = pk2(sp[6 * 33], sp[7 * 33]);
        *(v4u*)(WT + (size_t)rowmap_rt(mode, n0 + n) * K + k0 + 8 * c) = o; }
    LDS_WAIT(); asm volatile("" ::: "memory");
}
__device__ __forceinline__ void tr_item8(const float* W, int ldw, int K, int ncols, unsigned char* WT8, int mode, float wscale, int item, LAS float* scr, int lane) {
    const int nblk = ncols / 32, kb = item / nblk, nb = item % nblk, k0 = 64 * kb, n0 = 32 * nb;
    f32x4 tv[8];
#pragma unroll
    for (int i = 0; i < 8; ++i) { const int kk = 8 * i + (lane >> 3); tv[i] = *(const f32x4*)(W + (size_t)(k0 + kk) * ldw + n0 + 4 * (lane & 7)); }
#pragma unroll
    for (int i = 0; i < 8; ++i) { const int kk = 8 * i + (lane >> 3); LAS float* d = scr + kk * 33 + 4 * (lane & 7);
        d[0] = wscale * tv[i][0]; d[1] = wscale * tv[i][1]; d[2] = wscale * tv[i][2]; d[3] = wscale * tv[i][3]; }
    LDS_WAIT(); asm volatile("" ::: "memory");
    const int n = lane >> 1, half = lane & 1; const LAS float* sp = scr + (32 * half) * 33 + n;
    v4u o[2];
#pragma unroll
    for (int q = 0; q < 8; ++q) { int w = 0;
        w = __builtin_amdgcn_cvt_pk_fp8_f32(sp[(4 * q + 0) * 33], sp[(4 * q + 1) * 33], w, false);
        w = __builtin_amdgcn_cvt_pk_fp8_f32(sp[(4 * q + 2) * 33], sp[(4 * q + 3) * 33], w, true);
        o[q >> 2][q & 3] = (unsigned)w; }
    v4u* dst = (v4u*)(WT8 + (size_t)rowmap_rt(mode, n0 + n) * K + k0 + 32 * half);
    dst[0] = o[0]; dst[1] = o[1];
    LDS_WAIT(); asm volatile("" ::: "memory");
}
__device__ __forceinline__ void rms_row(const float* xrow, const float* gain, int lane, f32x4 (&v)[4]) {
    const f32x4* xr = (const f32x4*)xrow + lane; float s = 0.f;
#pragma unroll
    for (int j = 0; j < 4; ++j) { v[j] = xr[64 * j]; s += (v[j].x * v[j].x + v[j].y * v[j].y) + (v[j].z * v[j].z + v[j].w * v[j].w); }
    const float rs = 1.0f / sqrtf(wave_sum(s) * (1.f / 1024.f) + EPS);
    const f32x4* gr = (const f32x4*)gain + lane;
#pragma unroll
    for (int j = 0; j < 4; ++j) v[j] = v[j] * rs * gr[64 * j];
}
__device__ __forceinline__ void store_row_bf16(bf16* orow, int lane, const f32x4 (&v)[4]) {
    unsigned long long* o8 = (unsigned long long*)orow + lane;
#pragma unroll
    for (int j = 0; j < 4; ++j) o8[64 * j] = (unsigned long long)pk2(v[j].x, v[j].y) | ((unsigned long long)pk2(v[j].z, v[j].w) << 32);
}
__device__ __forceinline__ void xb_rows(const float* x, bf16* o, float* ss, int nrows, int gw, int NGW, int lane) {
#pragma unroll 1
    for (int r0 = gw; r0 < nrows; r0 += 2 * NGW) {
        const int r1 = r0 + NGW; const bool on1 = r1 < nrows; const int r1c = on1 ? r1 : r0;
        const f32x4* xa = (const f32x4*)(x + (size_t)r0 * D) + lane; const f32x4* xc = (const f32x4*)(x + (size_t)r1c * D) + lane; f32x4 va[4], vc[4];
#pragma unroll
        for (int j = 0; j < 4; ++j) { va[j] = xa[64 * j]; vc[j] = xc[64 * j]; }
        float sa = 0.f, sc = 0.f;
#pragma unroll
        for (int j = 0; j < 4; ++j) { sa += (va[j].x * va[j].x + va[j].y * va[j].y) + (va[j].z * va[j].z + va[j].w * va[j].w); sc += (vc[j].x * vc[j].x + vc[j].y * vc[j].y) + (vc[j].z * vc[j].z + vc[j].w * vc[j].w); }
        sa = wave_sum(sa); sc = wave_sum(sc);
        store_row_bf16(o + (size_t)r0 * D, lane, va); if (lane < 16) ss[(size_t)r0 * 16 + lane] = lane == 0 ? sa : 0.f;
        if (on1) { store_row_bf16(o + (size_t)r1 * D, lane, vc); if (lane < 16) ss[(size_t)r1 * 16 + lane] = lane == 0 ? sc : 0.f; }
    }
}
__device__ __forceinline__ void norm_rows(const float* x, const float* gain, bf16* o, int nrows, int gw, int NGW, int lane) {
    for (int r = gw; r < nrows; r += NGW) { f32x4 v[4]; rms_row(x + (size_t)r * D, gain, lane, v); store_row_bf16(o + (size_t)r * D, lane, v); }
}

constexpr int BA_KS = 72, BA_VS = 408, BA_KROWS = 400;
constexpr int BA_K_BYTES = BA_KROWS * BA_KS * 2, BA_V_BYTES = 64 * BA_VS * 2;
static_assert(BA_K_BYTES % 16 == 0 && BA_K_BYTES + BA_V_BYTES <= PHASE_LDS, "band attention LDS");
__device__ __forceinline__ bf16x8 cat4(s16x4 a, s16x4 b) { return __builtin_shufflevector(a, b, 0, 1, 2, 3, 4, 5, 6, 7); }
__device__ __forceinline__ unsigned cvtpk(float lo, float hi) { unsigned r; asm volatile("v_cvt_pk_bf16_f32 %0, %1, %2" : "=v"(r) : "v"(lo), "v"(hi)); return r; }

__device__ __forceinline__ void band_attention_phase(LAS unsigned char* lds, const bf16* Q, const bf16* Kb, const bf16* Vb, bf16* Ao, const float* sink, int G) {
    const int tid = opq_tid(), lane = tid & 63, wave = __builtin_amdgcn_readfirstlane(tid >> 6), fr = lane & 15, fq = lane >> 4;
    LAS bf16* Ks = (LAS bf16*)lds; LAS bf16* VTs = (LAS bf16*)(lds + BA_K_BYTES);
    for (int unit = blockIdx.x; unit < NB * 32 * NKV; unit += G) {
        const int kh = unit & 1, ib = (unit >> 1) & 31, b = unit >> 6;
        const int kbase = 128 * (ib - 1);
        for (int c = tid; c < BA_KROWS * 8; c += NTHR) { const int row = c >> 3, c8 = c & 7, kpos = kbase + row;
            v4u val = (v4u){0u, 0u, 0u, 0u};
            if (row < 384 && kpos >= 0 && kpos < SEQ) val = *(const v4u*)(Kb + ((size_t)(b * SEQ + kpos)) * KVW + kh * 64 + c8 * 8);
            *(LAS v4u*)(Ks + row * BA_KS + c8 * 8) = val; }
        for (int c = tid; c < BA_KROWS * 8; c += NTHR) { const int c8 = c / BA_KROWS, key = c % BA_KROWS, kpos = kbase + key;
            v4u val = (v4u){0u, 0u, 0u, 0u};
            if (key < 384 && kpos >= 0 && kpos < SEQ) val = *(const v4u*)(Vb + ((size_t)(b * SEQ + kpos)) * KVW + kh * 64 + c8 * 8);
            LAS bf16* dst = VTs + (c8 * 8) * BA_VS + key;
            dst[0 * BA_VS] = (bf16)(val.x & 0xffffu); dst[1 * BA_VS] = (bf16)(val.x >> 16); dst[2 * BA_VS] = (bf16)(val.y & 0xffffu); dst[3 * BA_VS] = (bf16)(val.y >> 16);
            dst[4 * BA_VS] = (bf16)(val.z & 0xffffu); dst[5 * BA_VS] = (bf16)(val.z >> 16); dst[6 * BA_VS] = (bf16)(val.w & 0xffffu); dst[7 * BA_VS] = (bf16)(val.w >> 16); }
        wg_sync(); CHAOS_POINT(2, 32);
        const int g = wave >> 1, half = wave & 1, head = kh * 4 + g;
        const float snk = sink[head];
        bf16x8 qn[2];
        { const size_t t0 = (size_t)b * SEQ + 128 * ib + 64 * half;
#pragma unroll
          for (int ks = 0; ks < 2; ++ks) qn[ks] = *(const bf16x8*)(Q + (t0 + fr) * AW + head * 64 + 32 * ks + 8 * fq); }
#pragma unroll 1
        for (int qt = 0; qt < 4; ++qt) { CHAOS_POINT(2, 31);
            const int p0 = 64 * half + 16 * qt;
            const size_t t0 = (size_t)b * SEQ + 128 * ib + p0;
            bf16x8 qf[2]; qf[0] = qn[0]; qf[1] = qn[1];
            if (qt < 3) {
#pragma unroll
                for (int ks = 0; ks < 2; ++ks) qn[ks] = *(const bf16x8*)(Q + (t0 + 16 + fr) * AW + head * 64 + 32 * ks + 8 * fq); }
            f32x4 s[18];
            const LAS bf16* kbase_p = Ks + (p0 + fr) * BA_KS + 8 * fq;
            bf16x8 kfa[3][2], kfb[3][2];
#pragma unroll
            for (int jj = 0; jj < 3; ++jj)
#pragma unroll
                for (int ks = 0; ks < 2; ++ks) kfa[jj][ks] = *(const LAS bf16x8*)(kbase_p + (16 * jj) * BA_KS + 32 * ks);
#pragma unroll
            for (int gq = 0; gq < 6; ++gq) {
                if (gq < 5) {
#pragma unroll
                    for (int jj = 0; jj < 3; ++jj)
#pragma unroll
                        for (int ks = 0; ks < 2; ++ks) { const bf16x8 t = *(const LAS bf16x8*)(kbase_p + (16 * (3 * (gq + 1) + jj)) * BA_KS + 32 * ks); if (gq & 1) kfa[jj][ks] = t; else kfb[jj][ks] = t; } }
                __builtin_amdgcn_sched_barrier(0);
#pragma unroll
                for (int jj = 0; jj < 3; ++jj) { const int j = 3 * gq + jj; s[j] = (f32x4){0.f, 0.f, 0.f, 0.f};
#pragma unroll
                    for (int ks = 0; ks < 2; ++ks) s[j] = __builtin_amdgcn_mfma_f32_16x16x32_bf16((gq & 1) ? kfb[jj][ks] : kfa[jj][ks], qf[ks], s[j], 0, 0, 0); }
                __builtin_amdgcn_sched_barrier(0);
            }
            float mx = -1e30f;
#pragma unroll
            for (int j = 0; j < 18; ++j)
#pragma unroll
                for (int r = 0; r < 4; ++r) { const int rel = 16 * j + 4 * fq + r - fr, idx = p0 + 16 * j + 4 * fq + r;
                    const bool ok = rel >= 0 && rel <= 256 && (ib > 0 || idx >= 128) && (ib < 31 || idx < 256);
                    const float v = ok ? s[j][r] * 0.125f : -1e30f; s[j][r] = v; mx = fmaxf(mx, v); }
            mx = fmaxf(mx, __shfl_xor(mx, 16)); mx = fmaxf(mx, __shfl_xor(mx, 32)); mx = fmaxf(mx, snk);
            float l = 0.f;
#pragma unroll
            for (int j = 0; j < 18; ++j)
#pragma unroll
                for (int r = 0; r < 4; ++r) { const float p = __expf(s[j][r] - mx); s[j][r] = p; l += p; }
            l += __shfl_xor(l, 16); l += __shfl_xor(l, 32); l += __expf(snk - mx);
            const float inv = 1.0f / l;
            f32x4 o[4];
#pragma unroll
            for (int dt = 0; dt < 4; ++dt) o[dt] = (f32x4){0.f, 0.f, 0.f, 0.f};
            const LAS bf16* vbase_p = VTs + fr * BA_VS + p0 + 4 * fq;
            s16x4 va[4][2], vb[4][2];
#pragma unroll
            for (int dt = 0; dt < 4; ++dt) { va[dt][0] = *(const LAS s16x4*)(vbase_p + (16 * dt) * BA_VS); va[dt][1] = *(const LAS s16x4*)(vbase_p + (16 * dt) * BA_VS + 16); }
#pragma unroll
            for (int kk = 0; kk < 9; ++kk) {
                if (kk < 8) {
#pragma unroll
                    for (int dt = 0; dt < 4; ++dt) { const s16x4 t0_ = *(const LAS s16x4*)(vbase_p + (16 * dt) * BA_VS + 32 * (kk + 1)), t1_ = *(const LAS s16x4*)(vbase_p + (16 * dt) * BA_VS + 32 * (kk + 1) + 16);
                        if (kk & 1) { va[dt][0] = t0_; va[dt][1] = t1_; } else { vb[dt][0] = t0_; vb[dt][1] = t1_; } } }
                v4u pw; pw.x = cvtpk(s[2 * kk][0], s[2 * kk][1]); pw.y = cvtpk(s[2 * kk][2], s[2 * kk][3]); pw.z = cvtpk(s[2 * kk + 1][0], s[2 * kk + 1][1]); pw.w = cvtpk(s[2 * kk + 1][2], s[2 * kk + 1][3]);
                const bf16x8 pf = __builtin_bit_cast(bf16x8, pw);
                __builtin_amdgcn_sched_barrier(0);
#pragma unroll
                for (int dt = 0; dt < 4; ++dt) { const bf16x8 vf = (kk & 1) ? cat4(vb[dt][0], vb[dt][1]) : cat4(va[dt][0], va[dt][1]);
                    o[dt] = __builtin_amdgcn_mfma_f32_16x16x32_bf16(vf, pf, o[dt], 0, 0, 0); }
                __builtin_amdgcn_sched_barrier(0);
            }
#pragma unroll
            for (int dt = 0; dt < 4; ++dt) { const f32x4 ov = o[dt] * inv; v2u w; w.x = cvtpk(ov[0], ov[1]); w.y = cvtpk(ov[2], ov[3]);
                *(v2u*)(Ao + (t0 + fr) * AW + head * 64 + 16 * dt + 4 * fq) = w; }
        }
        wg_sync(); CHAOS_POINT(2, 32);
    }
}

constexpr int XA_KS = 136, XA_VS = 264;
constexpr int XA_K_BYTES = MEML * XA_KS * 2, XA_V_BYTES = XHD * XA_VS * 2;
static_assert(XA_K_BYTES % 16 == 0 && XA_K_BYTES + XA_V_BYTES <= PHASE_LDS, "cross attention LDS");
__device__ __forceinline__ void cross_attention_phase(LAS unsigned char* lds, const bf16* Qx, const bf16* Kmem, const bf16* VmemT, bf16* Ox, int layer, int G) {
    const int tid = opq_tid(), lane = tid & 63, wave = __builtin_amdgcn_readfirstlane(tid >> 6), fr = lane & 15, fq = lane >> 4;
    LAS bf16* Ks = (LAS bf16*)lds; LAS bf16* VTs = (LAS bf16*)(lds + XA_K_BYTES);
    for (int unit = blockIdx.x; unit < 256; unit += G) {
        const int quarter = unit & 3, head = (unit >> 2) & 3, b = unit >> 4;
        for (int c = tid; c < MEML * 16; c += NTHR) { const int key = c >> 4, c8 = c & 15;
            *(LAS v4u*)(Ks + key * XA_KS + c8 * 8) = *(const v4u*)(Kmem + (size_t)(b * MEML + key) * 1024 + layer * 512 + head * 128 + c8 * 8); }
        for (int c = tid; c < XHD * 32; c += NTHR) { const int d = c >> 5, c8 = c & 31;
            *(LAS v4u*)(VTs + d * XA_VS + c8 * 8) = *(const v4u*)(VmemT + (size_t)(layer * 512 + head * 128 + d) * MROWS + b * MEML + c8 * 8); }
        wg_sync(); CHAOS_POINT(2, 32);
        bf16x8 qn[4];
        { const size_t t0 = (size_t)b * SEQ + (quarter * 4) * 256 + wave * 32;
#pragma unroll
          for (int ks = 0; ks < 4; ++ks) qn[ks] = *(const bf16x8*)(Qx + (t0 + fr) * XW + head * 128 + 32 * ks + 8 * fq); }
#pragma unroll 1
        for (int qi = 0; qi < 8; ++qi) {
            const size_t t0 = (size_t)b * SEQ + (quarter * 4 + (qi >> 1)) * 256 + wave * 32 + 16 * (qi & 1);
            bf16x8 qf[4];
#pragma unroll
            for (int ks = 0; ks < 4; ++ks) qf[ks] = qn[ks];
            if (qi < 7) { const size_t t1 = (size_t)b * SEQ + (quarter * 4 + ((qi + 1) >> 1)) * 256 + wave * 32 + 16 * ((qi + 1) & 1);
#pragma unroll
                for (int ks = 0; ks < 4; ++ks) qn[ks] = *(const bf16x8*)(Qx + (t1 + fr) * XW + head * 128 + 32 * ks + 8 * fq); }
            f32x4 s[16];
            const LAS bf16* kbase_p = Ks + fr * XA_KS + 8 * fq;
            bf16x8 kfa[2][4], kfb[2][4];
#pragma unroll
            for (int jj = 0; jj < 2; ++jj)
#pragma unroll
                for (int ks = 0; ks < 4; ++ks) kfa[jj][ks] = *(const LAS bf16x8*)(kbase_p + (16 * jj) * XA_KS + 32 * ks);
#pragma unroll
            for (int gq = 0; gq < 8; ++gq) {
                if (gq < 7) {
#pragma unroll
                    for (int jj = 0; jj < 2; ++jj)
#pragma unroll
                        for (int ks = 0; ks < 4; ++ks) { const bf16x8 t = *(const LAS bf16x8*)(kbase_p + (16 * (2 * (gq + 1) + jj)) * XA_KS + 32 * ks); if (gq & 1) kfa[jj][ks] = t; else kfb[jj][ks] = t; } }
                __builtin_amdgcn_sched_barrier(0);
#pragma unroll
                for (int jj = 0; jj < 2; ++jj) { const int j = 2 * gq + jj; s[j] = (f32x4){0.f, 0.f, 0.f, 0.f};
#pragma unroll
                    for (int ks = 0; ks < 4; ++ks) s[j] = __builtin_amdgcn_mfma_f32_16x16x32_bf16((gq & 1) ? kfb[jj][ks] : kfa[jj][ks], qf[ks], s[j], 0, 0, 0); }
                __builtin_amdgcn_sched_barrier(0);
            }
            float mx = -1e30f;
#pragma unroll
            for (int j = 0; j < 16; ++j)
#pragma unroll
                for (int r = 0; r < 4; ++r) { const float v = s[j][r] * 0.08838834764831845f; s[j][r] = v; mx = fmaxf(mx, v); }
            mx = fmaxf(mx, __shfl_xor(mx, 16)); mx = fmaxf(mx, __shfl_xor(mx, 32));
            float l = 0.f;
#pragma unroll
            for (int j = 0; j < 16; ++j)
#pragma unroll
                for (int r = 0; r < 4; ++r) { const float p = __expf(s[j][r] - mx); s[j][r] = p; l += p; }
            l += __shfl_xor(l, 16); l += __shfl_xor(l, 32);
            const float inv = 1.0f / l;
            f32x4 o[8];
#pragma unroll
            for (int dt = 0; dt < 8; ++dt) o[dt] = (f32x4){0.f, 0.f, 0.f, 0.f};
            const LAS bf16* vbase_p = VTs + fr * XA_VS + 4 * fq;
            s16x4 va[8][2], vb[8][2];
#pragma unroll
            for (int dt = 0; dt < 8; ++dt) { va[dt][0] = *(const LAS s16x4*)(vbase_p + (16 * dt) * XA_VS); va[dt][1] = *(const LAS s16x4*)(vbase_p + (16 * dt) * XA_VS + 16); }
#pragma unroll
            for (int kk = 0; kk < 8; ++kk) {
                if (kk < 7) {
#pragma unroll
                    for (int dt = 0; dt < 8; ++dt) { const s16x4 t0_ = *(const LAS s16x4*)(vbase_p + (16 * dt) * XA_VS + 32 * (kk + 1)), t1_ = *(const LAS s16x4*)(vbase_p + (16 * dt) * XA_VS + 32 * (kk + 1) + 16);
                        if (kk & 1) { va[dt][0] = t0_; va[dt][1] = t1_; } else { vb[dt][0] = t0_; vb[dt][1] = t1_; } } }
                v4u pw; pw.x = cvtpk(s[2 * kk][0], s[2 * kk][1]); pw.y = cvtpk(s[2 * kk][2], s[2 * kk][3]); pw.z = cvtpk(s[2 * kk + 1][0], s[2 * kk + 1][1]); pw.w = cvtpk(s[2 * kk + 1][2], s[2 * kk + 1][3]);
                const bf16x8 pf = __builtin_bit_cast(bf16x8, pw);
                __builtin_amdgcn_sched_barrier(0);
#pragma unroll
                for (int dt = 0; dt < 8; ++dt) { const bf16x8 vf = (kk & 1) ? cat4(vb[dt][0], vb[dt][1]) : cat4(va[dt][0], va[dt][1]);
                    o[dt] = __builtin_amdgcn_mfma_f32_16x16x32_bf16(vf, pf, o[dt], 0, 0, 0); }
                __builtin_amdgcn_sched_barrier(0);
            }
#pragma unroll
            for (int dt = 0; dt < 8; ++dt) { const f32x4 ov = o[dt] * inv; v2u w; w.x = cvtpk(ov[0], ov[1]); w.y = cvtpk(ov[2], ov[3]);
                *(v2u*)(Ox + (t0 + fr) * XW + head * 128 + 16 * dt + 4 * fq) = w; }
        }
        wg_sync(); CHAOS_POINT(2, 32);
    }
}
constexpr float HY_MIN_DECAY = -3.0701134573253944f;
constexpr float HY_MAX_DECAY = -15.350567286626972f;
__device__ __forceinline__ void h2_rows(const Args& a, float* H2, int gw, int NGW, int lane) {
    for (int idx = gw; idx < 2 * SEQ; idx += NGW) {
        const int l = idx >> 12, j = idx & 4095;
        const float* w1 = a.in[I_FW1] + l * 33 * 64; const float* b1 = a.in[I_FB1] + l * 64; const float* fr1 = a.in[I_FFR1] + l * 64;
        const float* w2 = a.in[I_FW2] + l * 64 * 64; const float* b2 = a.in[I_FB2] + l * 64; const float* fr2 = a.in[I_FFR2] + l * 64;
        const float w = 6.283185307179586f * (float)j / 4096.0f;
        const int mm = (lane - 1) & 15; const float f = 1e-4f + (float)mm * ((15.0f - 1e-4f) / 15.0f); const float ang = f * w;
        float zq = lane == 0 ? (float)j / 4095.0f : (lane <= 16 ? cosf(ang) : -sinf(ang));
        float acc = b1[lane];
#pragma unroll
        for (int q = 0; q < 33; ++q) acc += __shfl(zq, q) * w1[q * 64 + lane];
        const float h1 = sinf(fr1[lane] * acc);
        acc = b2[lane];
#pragma unroll
        for (int q = 0; q < 64; ++q) acc += __shfl(h1, q) * w2[q * 64 + lane];
        H2[(size_t)idx * 64 + lane] = sinf(fr2[lane] * acc);
    }
}
__device__ __forceinline__ void kfilt_phase(LAS unsigned char* lds, const float* H2, const float* w3all, float* KF, int G) {
    LAS float* ws = (LAS float*)lds;
    const int tid = opq_tid(), jj = tid & 63, cg = __builtin_amdgcn_readfirstlane(tid >> 6);
    for (int unit = blockIdx.x; unit < 2 * 64 * 32; unit += G) {
        const int cb = unit & 31, jb = (unit >> 5) & 63, l = unit >> 11;
        const float* w3 = w3all + (size_t)l * 64 * 2048;
        for (int e = tid; e < 4096; e += NTHR) ws[e] = w3[(size_t)(e >> 6) * 2048 + cb * 64 + (e & 63)];
        wg_sync();
        const int j = jb * 64 + jj;
        const f32x4* hr = (const f32x4*)(H2 + ((size_t)l * SEQ + j) * 64);
        float acc[8];
#pragma unroll
        for (int e = 0; e < 8; ++e) acc[e] = 0.f;
#pragma unroll
        for (int q = 0; q < 16; ++q) { const f32x4 hv = hr[q];
#pragma unroll
            for (int i = 0; i < 4; ++i) { const LAS f32x4* wp = (const LAS f32x4*)(ws + (4 * q + i) * 64 + cg * 8); const f32x4 wa = wp[0], wb = wp[1];
                acc[0] += hv[i] * wa[0]; acc[1] += hv[i] * wa[1]; acc[2] += hv[i] * wa[2]; acc[3] += hv[i] * wa[3];
                acc[4] += hv[i] * wb[0]; acc[5] += hv[i] * wb[1]; acc[6] += hv[i] * wb[2]; acc[7] += hv[i] * wb[3]; } }
        const float tj = (float)j / 4095.0f;
#pragma unroll
        for (int e = 0; e < 8; ++e) { const int col = cb * 64 + cg * 8 + e, dir = col >> 10, oc = col & 1023;
            const float delta = HY_MIN_DECAY + (float)oc * ((HY_MAX_DECAY - HY_MIN_DECAY) / 1023.0f);
            float val = acc[e] * expf(-tj * fabsf(delta));
            int n = dir == 0 ? j : 8192 - j;
            if (dir == 1 && j == 0) { n = 4096; val = 0.f; }
            KF[((size_t)(l * 1024 + oc)) * 8192 + n] = val; }
        wg_sync();
    }
}

constexpr int HY_RAWS = 4112;
constexpr int HY_ROWB = 2 * HY_RAWS * 2;
constexpr int HY_VB_OFF = FFT_WORK * 8;
constexpr int HY_X2_OFF = HY_VB_OFF + HY_ROWB;
constexpr int HY_X1_OFF = HY_X2_OFF + HY_ROWB;
constexpr int HY_EX_OFF = HY_X1_OFF + HY_ROWB;
constexpr int HY_YB_OFF = HY_EX_OFF + 16384;
static_assert(HY_VB_OFF % 16 == 0 && HY_ROWB % 16 == 0 && HY_YB_OFF + 2 * 4096 * 2 <= PHASE_LDS && HY_YB_OFF - HY_X1_OFF >= 4096 * 8 && HY_X1_OFF % 8 == 0, "hyena LDS map");
typedef float f32x2v __attribute__((ext_vector_type(2)));
struct LdsCf { LAS f32x2v* p; __device__ __forceinline__ cf ld(int i) const { const f32x2v t = p[i]; return mk(t.x, t.y); } __device__ __forceinline__ void st(int i, cf v) const { p[i] = (f32x2v){v.x, v.y}; } };

__device__ __forceinline__ void hy_dma_rows(LAS unsigned char* lds, int region_off, const bf16* UT, int b0, int ch, int wave, int lane) {
#pragma unroll
    for (int r = 0; r < 2; ++r)
        __builtin_amdgcn_global_load_lds((const unsigned*)(UT + (((size_t)((b0 + r) * C3 + ch)) << 12) + wave * 512 + lane * 8), (LAS unsigned*)(lds + region_off + r * HY_RAWS * 2 + 16 + wave * 1024), 16, 0, 0);
}
__device__ __forceinline__ void hy_pads(LAS unsigned char* lds, int region_off, int tid) {
    if (tid < 2) { LAS bf16* row = (LAS bf16*)(lds + region_off) + tid * HY_RAWS; row[7] = 0; row[8 + 4096] = 0; }
}
struct HySel { unsigned s0, s1, s2; };
__device__ __forceinline__ float hy_conv(const LAS unsigned* lds32, int d, const HySel& hs, float w0, float w1, float w2, float bias) {
    const unsigned lo = *(const volatile LAS unsigned*)(lds32 + d), hi = *(const volatile LAS unsigned*)(lds32 + d + 1);
    const float f0 = __builtin_bit_cast(float, __builtin_amdgcn_perm(hi, lo, hs.s0)), f1 = __builtin_bit_cast(float, __builtin_amdgcn_perm(hi, lo, hs.s1)), f2 = __builtin_bit_cast(float, __builtin_amdgcn_perm(hi, lo, hs.s2));
    return w0 * f0 + w1 * f1 + w2 * f2 + bias;
}
__device__ __forceinline__ int opqi(int v) { asm volatile("" : "+v"(v)); return v; }
template <class T> __device__ __forceinline__ T* opqp(T* p) { asm volatile("" : "+v"(p)); return p; }
__device__ __forceinline__ cf opq(cf w) { asm volatile("" : "+v"(w)); return w; }
__device__ __forceinline__ cf csel(bool c, cf a, cf b) { return mk(c ? a.x : b.x, c ? a.y : b.y); }
__device__ __forceinline__ float uni(float v) { return __builtin_bit_cast(float, __builtin_amdgcn_readfirstlane(__builtin_bit_cast(int, v))); }
__device__ __forceinline__ void wave_lds_fence() { __builtin_amdgcn_sched_barrier(0); asm volatile("s_waitcnt lgkmcnt(0)" ::: "memory"); __builtin_amdgcn_sched_barrier(0); }
__device__ __forceinline__ void wg_sync_lds() { __builtin_amdgcn_sched_barrier(0); asm volatile("s_waitcnt lgkmcnt(0)" ::: "memory"); __builtin_amdgcn_s_barrier(); asm volatile("" ::: "memory"); __builtin_amdgcn_sched_barrier(0); }
__device__ __forceinline__ cf shfl_cf(cf v) { return mk(__shfl_xor(v.x, 32), __shfl_xor(v.y, 32)); }

__device__ __forceinline__ void kspec_phase(LAS unsigned char* lds, const float* KF, float* KSP, int G) {
    const int tid = opq_tid();
    LdsCf W; W.p = (LAS f32x2v*)lds;
    int h1, j1, h2, k1, j2, h3, blk; geo1(tid, h1, j1); geo2(tid, h2, k1, j2); geo3(tid, h3, blk);
    const int fb1 = opqi(fbase1(h1, j1)), fb2 = opqi(fbase2(h2, k1, j2)), fb3 = opqi(fbase3(h3, blk)), jo = opqi(j1);
    float sv, cv;
    sincospif(-(float)j1 / 4096.0f, &sv, &cv); const cf w8192j = mk(cv, sv);
    sincospif(-(float)j1 / 2048.0f, &sv, &cv); const cf w4096j = mk(cv, sv);
    sincospif(-(float)j2 / 128.0f, &sv, &cv);  const cf w256j = mk(cv, sv);
    const cf w32 = mk(0.98078528040323043f, -0.19509032201612825f);
#pragma unroll 1
    for (int unit = blockIdx.x; unit < 2 * 2 * HYW; unit += G) {
        const float* kf = KF + (size_t)unit * 8192;
        cf x[16]; cf wp = opq(w8192j);
#pragma unroll
        for (int m = 0; m < 16; ++m) { const float* kp = kf + opqi(jo + 1024 * (m >> 2)); const float ka = kp[256 * (m & 3)]; const float* kq = kp + opqi(4096); const float kb = kq[256 * (m & 3)];
            x[m] = csel(h1 == 0, mk(ka + kb, 0.f), cscale(wp, ka - kb)); wp = cmul(wp, w32); }
        CHAOS_POINT(32, 21); fwd_pass1(W, fb1, opq(w4096j), x); wg_sync(); CHAOS_POINT(32, 22);
        fwd_pass2(W, fb2, opq(w256j)); wave_lds_fence(); CHAOS_POINT(32, 23);
        { cf kk[16]; fwd_pass3_keep(W, fb3, kk); GAS f32x4* kd = opqp((GAS f32x4*)(KSP + (size_t)unit * 16384 + tid * 32));
#pragma unroll
          for (int q = 0; q < 8; ++q) kd[q] = (f32x4){kk[2 * q].x, kk[2 * q].y, kk[2 * q + 1].x, kk[2 * q + 1].y}; }
        wg_sync();
    }
}
__device__ __forceinline__ void mid_pass3g(LdsCf lds, int b3, const GAS f32x4* Kp) {
    f32x4 kv[8];
#pragma unroll
    for (int q = 0; q < 8; ++q) kv[q] = Kp[q];
    cf x[16];
#pragma unroll
    for (int m = 0; m < 16; ++m) x[m] = lds.ld(b3 + m);
    dft16<false>(x);
#pragma unroll
    for (int q = 0; q < 8; ++q) { x[2 * q] = cmul(x[2 * q], mk(kv[q][0], kv[q][1])); x[2 * q + 1] = cmul(x[2 * q + 1], mk(kv[q][2], kv[q][3])); }
    dft16<true>(x);
#pragma unroll
    for (int m = 0; m < 16; ++m) lds.st(b3 + m, x[m]);
}
#ifdef DIAG
#define HY_SYNC() do { const unsigned long long ts_ = wall_clock64(); wg_sync(); hy_wait_ += wall_clock64() - ts_; } while (0)
#else
#define HY_SYNC() wg_sync()
#endif
#ifdef PERTURB
#define HY_PERTURB0() do { __builtin_amdgcn_s_sleep(40); __builtin_amdgcn_s_sleep(100); } while (0)
#else
#define HY_PERTURB0() CHAOS_POINT(1, 11)
#endif
__device__ __forceinline__ void hyena_phase(LAS unsigned char* lds, const Args& a, int layer, const bf16* UT, const float* KSP, bf16* YT, int G) {
    const int tid = opq_tid();
#ifdef DIAG
    unsigned long long hy_wait_ = 0; const unsigned long long hy_t0_ = wall_clock64(); unsigned long long dg_a0 = 0, dg_a1 = 0, dg_a2 = 0, dg_a3 = 0, dg_a4 = 0, dg_a5 = 0, dg_a6 = 0, dg_a7 = 0, dg_last = hy_t0_;
#define HYT(k) do { const unsigned long long n_ = wall_clock64(); dg_a##k += n_ - dg_last; dg_last = n_; } while (0)
#else
#define HYT(k) do {} while (0)
#endif
    LdsCf W; W.p = (LAS f32x2v*)lds;
    const int wave = __builtin_amdgcn_readfirstlane(tid >> 6), lane = tid & 63;
    int h1, j1, h2, k1, j2, h3, blk; geo1(tid, h1, j1); geo2(tid, h2, k1, j2); geo3(tid, h3, blk);
    const int fb1 = opqi(fbase1(h1, j1)), fb2 = opqi(fbase2(h2, k1, j2)), fb3 = opqi(fbase3(h3, blk));
    const int jo = opqi(j1), jh = opqi(j1 + 2048 * h1);
    LdsCf ZB; ZB.p = (LAS f32x2v*)lds; const int zo = opqi(HY_X1_OFF / 8 + j1), zh = opqi(HY_X1_OFF / 8 + j1 + 2048 * h1);
    LAS bf16* l16 = (LAS bf16*)lds; const int yh = opqi(HY_YB_OFF / 2 + j1 + 2048 * h1);
    const LAS unsigned* lds32 = (const LAS unsigned*)lds; const int par = 1 - (j1 & 1);
    const int rod = opqi((HY_VB_OFF / 2 + 8 + j1 - 1 - par) >> 1), rhd = opqi((HY_VB_OFF / 2 + 8 + j1 + 2048 * h1 - 1 - par) >> 1);
    HySel hs; hs.s0 = opqi(par ? 0x03020c0c : 0x01000c0c); hs.s1 = opqi(par ? 0x05040c0c : 0x03020c0c); hs.s2 = opqi(par ? 0x07060c0c : 0x05040c0c);
    float sv, cv;
    sincospif(-(float)j1 / 4096.0f, &sv, &cv); const cf w8192j = mk(cv, sv);
    sincospif(-(float)j1 / 2048.0f, &sv, &cv); const cf w4096j = mk(cv, sv);
    sincospif(-(float)j2 / 128.0f, &sv, &cv);  const cf w256j = mk(cv, sv);
    const cf w32 = mk(0.98078528040323043f, -0.19509032201612825f);
    const float* cw = a.in[I_CONVW] + layer * 3 * C3; const float* cbv = a.in[I_CONVB] + layer * C3; const float* skp = a.in[I_SKIP] + layer * 2 * HYW;
    for (int c = blockIdx.x; c < HYW; c += G) {
        const float x1w0 = uni(cw[c]), x1w1 = uni(cw[C3 + c]), x1w2 = uni(cw[2 * C3 + c]), x1b = uni(cbv[c]);
        const float x2w0 = uni(cw[512 + c]), x2w1 = uni(cw[C3 + 512 + c]), x2w2 = uni(cw[2 * C3 + 512 + c]), x2b = uni(cbv[512 + c]);
        const float vw0 = uni(cw[1024 + c]), vw1 = uni(cw[C3 + 1024 + c]), vw2 = uni(cw[2 * C3 + 1024 + c]), vb = uni(cbv[1024 + c]);
        const float skip0 = uni(skp[c]), skip1 = uni(skp[HYW + c]);
        const float* KS0 = KSP + ((size_t)((layer * 2 + 0) * HYW + c)) * 16384 + opqi(tid * 32);
        const float* KS1 = KSP + ((size_t)((layer * 2 + 1) * HYW + c)) * 16384 + opqi(tid * 32);
        hy_dma_rows(lds, HY_VB_OFF, UT, 0, 1024 + c, wave, lane); hy_pads(lds, HY_VB_OFF, tid); hy_pads(lds, HY_X2_OFF, tid);
        HY_SYNC();
#pragma unroll 1
        for (int pr = 0; pr < 8; ++pr) {
            const int b0 = 2 * pr; CHAOS_POINT(1, 16);
            hy_dma_rows(lds, HY_X1_OFF, UT, b0, c, wave, lane); hy_dma_rows(lds, HY_X2_OFF, UT, b0, 512 + c, wave, lane); hy_pads(lds, HY_X1_OFF, tid); HYT(6);
            cf x[16];
            { cf wp = opq(w8192j);
#pragma unroll
              for (int m = 0; m < 16; ++m) {
                  const cf z = mk(hy_conv(lds32, rod + 128 * m, hs, vw0, vw1, vw2, vb), hy_conv(lds32, rod + 128 * m + HY_RAWS / 2, hs, vw0, vw1, vw2, vb));
                  x[m] = csel(h1 == 0, z, cmul(z, wp)); wp = cmul(wp, w32); } }
            HYT(7);
            HY_PERTURB0();
            fwd_pass1(W, fb1, opq(w4096j), x); HYT(0); wg_sync_lds(); HYT(4); CHAOS_POINT(1, 12);
            fwd_pass2(W, fb2, opq(w256j)); wave_lds_fence(); CHAOS_POINT(1, 13);
            mid_pass3g(W, fb3, opqp((const GAS f32x4*)KS0)); wave_lds_fence(); CHAOS_POINT(1, 14);
            inv_pass2(W, fb2, opq(w256j)); HYT(1); HY_SYNC(); HYT(5);
            CHAOS_POINT(1, 15); inv_pass1(W, fb1, opq(w4096j), x);
            cf zz[8];
            { cf wp = opq(w8192j);
#pragma unroll
              for (int m = 0; m < 16; ++m) { x[m] = csel(h1 == 1, cmulc(x[m], wp), x[m]); wp = cmul(wp, w32); }
#pragma unroll
              for (int i = 0; i < 8; ++i) { const cf xa_ = x[i], xb_ = x[8 + i]; const cf mine = csel(h1 == 1, xb_, xa_), send = csel(h1 == 1, xa_, xb_); const cf r = cscale(cadd(mine, shfl_cf(send)), 1.0f / 8192.0f);
                  const float va = hy_conv(lds32, rhd + 128 * i, hs, vw0, vw1, vw2, vb), vbb = hy_conv(lds32, rhd + 128 * i + HY_RAWS / 2, hs, vw0, vw1, vw2, vb);
                  const float xa = hy_conv(lds32, rhd + 128 * i + (HY_X1_OFF - HY_VB_OFF) / 4, hs, x1w0, x1w1, x1w2, x1b), xb = hy_conv(lds32, rhd + 128 * i + (HY_X1_OFF - HY_VB_OFF) / 4 + HY_RAWS / 2, hs, x1w0, x1w1, x1w2, x1b);
                  zz[i] = mk(xa * (r.x + skip0 * va), xb * (r.y + skip0 * vbb)); } }
            { cf wp = opq(w8192j);
#pragma unroll
              for (int i = 0; i < 8; ++i) { const cf pz = shfl_cf(zz[i]); x[i] = csel(h1 == 0, zz[i], pz); x[8 + i] = csel(h1 == 0, pz, zz[i]); }
#pragma unroll
              for (int m = 0; m < 16; ++m) { x[m] = csel(h1 == 0, x[m], cmul(x[m], wp)); wp = cmul(wp, w32); } }
            HY_PERTURB0();
            fwd_pass1(W, fb1, opq(w4096j), x); HYT(2); wg_sync_lds(); HYT(4); CHAOS_POINT(1, 12);
            if (pr < 7) hy_dma_rows(lds, HY_VB_OFF, UT, b0 + 2, 1024 + c, wave, lane);
            fwd_pass2(W, fb2, opq(w256j)); wave_lds_fence(); CHAOS_POINT(1, 13);
            mid_pass3g(W, fb3, opqp((const GAS f32x4*)KS1)); wave_lds_fence(); CHAOS_POINT(1, 14);
            inv_pass2(W, fb2, opq(w256j)); HYT(1); wg_sync_lds(); HYT(4);
            CHAOS_POINT(1, 15); inv_pass1(W, fb1, opq(w4096j), x);
            { cf wp = opq(w8192j);
#pragma unroll
              for (int m = 0; m < 16; ++m) { x[m] = csel(h1 == 1, cmulc(x[m], wp), x[m]); wp = cmul(wp, w32); }
#pragma unroll
              for (int i = 0; i < 8; ++i) { const cf xa_ = x[i], xb_ = x[8 + i]; const cf mine = csel(h1 == 1, xb_, xa_), send = csel(h1 == 1, xa_, xb_); const cf r = cscale(cadd(mine, shfl_cf(send)), 1.0f / 8192.0f);
                  const int p = jh + 256 * i; const cf zv = zz[i];
                  const float xa = hy_conv(lds32, rhd + 128 * i + (HY_X2_OFF - HY_VB_OFF) / 4, hs, x2w0, x2w1, x2w2, x2b), xb = hy_conv(lds32, rhd + 128 * i + (HY_X2_OFF - HY_VB_OFF) / 4 + HY_RAWS / 2, hs, x2w0, x2w1, x2w2, x2b);
                  const float ya = xa * (r.x + skip1 * zv.x), yb = xb * (r.y + skip1 * zv.y);
                  l16[yh + 256 * i] = (bf16)f2bf(ya); l16[yh + 256 * i + 4096] = (bf16)f2bf(yb); (void)p; } }
            HYT(3); HY_SYNC(); HYT(5);
#pragma unroll
            for (int i = 0; i < 2; ++i) { const int q = tid + NTHR * i, row = q >> 9, cc = q & 511;
                *(v4u*)(YT + (((size_t)((b0 + row) * HYW + c)) << 12) + cc * 8) = *(const LAS v4u*)(l16 + HY_YB_OFF / 2 + row * 4096 + cc * 8); }
        }
    }
#ifdef DIAG
    if (blockIdx.x == 0 && tid == 0) { unsigned long long* dg = (unsigned long long*)(*(const LAS unsigned long long*)(lds + 155712)); atomicAdd(dg + 16, hy_wait_); atomicAdd(dg + 17, wall_clock64() - hy_t0_); atomicAdd(dg + 20, dg_a0); atomicAdd(dg + 21, dg_a1); atomicAdd(dg + 22, dg_a2); atomicAdd(dg + 23, dg_a3); atomicAdd(dg + 24, dg_a4); atomicAdd(dg + 25, dg_a5); atomicAdd(dg + 26, dg_a6); atomicAdd(dg + 27, dg_a7); }
#endif
}
constexpr int MN_STRIDE = 66;
static_assert(HYW * MN_STRIDE * 2 <= PHASE_LDS, "mix-norm LDS");
__device__ __forceinline__ void mixnorm_phase(LAS unsigned char* lds, const bf16* Ab, const bf16* YT, const float* ga, const float* gy, bf16* mixed, int G) {
    const int tid = opq_tid(), lane = tid & 63, wave = __builtin_amdgcn_readfirstlane(tid >> 6);
    LAS unsigned* tile32 = (LAS unsigned*)lds; const LAS bf16* tile16 = (const LAS bf16*)lds;
    f32x4 gav[2], gyv[2];
    gav[0] = *(const f32x4*)(ga + lane * 8); gav[1] = *(const f32x4*)(ga + lane * 8 + 4); gyv[0] = *(const f32x4*)(gy + lane * 8); gyv[1] = *(const f32x4*)(gy + lane * 8 + 4);
    v4u R[8];
    int unit = blockIdx.x;
    if (unit < M / 64) { const bf16* src = YT + (((size_t)((unit >> 6) * HYW + tid)) << 12) + (unit & 63) * 64;
#pragma unroll
        for (int q = 0; q < 8; ++q) R[q] = *(const v4u*)(src + 8 * q); }
#pragma unroll 1
    for (; unit < M / 64; unit += G) {
        const int b = unit >> 6, t0 = (unit & 63) * 64;
#pragma unroll
        for (int q = 0; q < 8; ++q) { LAS unsigned* d = tile32 + tid * (MN_STRIDE / 2) + 4 * q; d[0] = R[q].x; d[1] = R[q].y; d[2] = R[q].z; d[3] = R[q].w; }
        wg_sync(); CHAOS_POINT(16, 51);
        const int nu = unit + G;
        if (nu < M / 64) { const bf16* src = YT + (((size_t)((nu >> 6) * HYW + tid)) << 12) + (nu & 63) * 64;
#pragma unroll
            for (int q = 0; q < 8; ++q) R[q] = *(const v4u*)(src + 8 * q); }
        const size_t row0 = (size_t)b * SEQ + t0 + wave * 8;
        v4u av[8];
#pragma unroll
        for (int i = 0; i < 8; ++i) av[i] = *(const v4u*)(Ab + (row0 + i) * AW + lane * 8);
#pragma unroll
        for (int i = 0; i < 8; ++i) { const int tt = wave * 8 + i;
            float y[8]; float ss = 0.f;
#pragma unroll
            for (int e = 0; e < 8; ++e) { y[e] = bf1(tile16[(lane * 8 + e) * MN_STRIDE + tt]); ss += y[e] * y[e]; }
            const float rs = __builtin_amdgcn_rsqf(wave_sum(ss) * (1.f / 512.f) + EPS);
            v4u o; o.x = pk2(y[0] * rs * gyv[0][0], y[1] * rs * gyv[0][1]); o.y = pk2(y[2] * rs * gyv[0][2], y[3] * rs * gyv[0][3]);
            o.z = pk2(y[4] * rs * gyv[1][0], y[5] * rs * gyv[1][1]); o.w = pk2(y[6] * rs * gyv[1][2], y[7] * rs * gyv[1][3]);
            *(v4u*)(mixed + (row0 + i) * D + 512 + lane * 8) = o; }
#pragma unroll
        for (int i = 0; i < 8; ++i) {
            const float x[8] = {bflo(av[i].x), bfhi(av[i].x), bflo(av[i].y), bfhi(av[i].y), bflo(av[i].z), bfhi(av[i].z), bflo(av[i].w), bfhi(av[i].w)};
            float ss = 0.f;
#pragma unroll
            for (int e = 0; e < 8; ++e) ss += x[e] * x[e];
            const float rs = __builtin_amdgcn_rsqf(wave_sum(ss) * (1.f / 512.f) + EPS);
            v4u o; o.x = pk2(x[0] * rs * gav[0][0], x[1] * rs * gav[0][1]); o.y = pk2(x[2] * rs * gav[0][2], x[3] * rs * gav[0][3]);
            o.z = pk2(x[4] * rs * gav[1][0], x[5] * rs * gav[1][1]); o.w = pk2(x[6] * rs * gav[1][2], x[7] * rs * gav[1][3]);
            *(v4u*)(mixed + (row0 + i) * D + lane * 8) = o; }
        wg_sync(); CHAOS_POINT(16, 51);
    }
}

__device__ __forceinline__ void moe_norm_router_phase(LAS unsigned char* lds, const bf16* xb, const float* gain, const float* wr, float* rsrow, int* toke, float* tokw, int* wgcnt, int G) {
    const int tid = opq_tid(), lane = tid & 63, wave = __builtin_amdgcn_readfirstlane(tid >> 6);
    LAS int* cnt = (LAS int*)lds;
    if (tid < 8) cnt[tid] = 0;
    wg_sync(); CHAOS_POINT(16, 51);
    const int TPW = M / G;
    f32x4 wra[4][4], wrb[4][4];
#pragma unroll
    for (int j = 0; j < 4; ++j) { const f32x4 gv = *(const f32x4*)(gain + 4 * lane + 256 * j);
#pragma unroll
        for (int q = 0; q < 4; ++q) { const int k = 4 * lane + q + 256 * j; wra[j][q] = *(const f32x4*)(wr + k * 8) * gv[q]; wrb[j][q] = *(const f32x4*)(wr + k * 8 + 4) * gv[q]; } }
    v2u nx[4];
    { const v2u* xr = (const v2u*)(xb + (size_t)(blockIdx.x * TPW + wave) * D) + lane;
#pragma unroll
      for (int j = 0; j < 4; ++j) nx[j] = xr[64 * j]; }
#pragma unroll 1
    for (int i = wave; i < TPW; i += NWAVES) {
        const int t = blockIdx.x * TPW + i;
        v2u cu[4];
#pragma unroll
        for (int j = 0; j < 4; ++j) cu[j] = nx[j];
        if (i + NWAVES < TPW) { const v2u* xr = (const v2u*)(xb + (size_t)(t + NWAVES) * D) + lane;
#pragma unroll
            for (int j = 0; j < 4; ++j) nx[j] = xr[64 * j]; }
        f32x4 v[4]; float s = 0.f;
#pragma unroll
        for (int j = 0; j < 4; ++j) { const v2u a = cu[j]; v[j] = (f32x4){bflo(a.x), bfhi(a.x), bflo(a.y), bfhi(a.y)}; s += (v[j].x * v[j].x + v[j].y * v[j].y) + (v[j].z * v[j].z + v[j].w * v[j].w); }
        const float rs = 1.0f / sqrtf(wave_sum(s) * (1.f / 1024.f) + EPS);
        float lg[8];
#pragma unroll
        for (int e = 0; e < 8; ++e) lg[e] = 0.f;
#pragma unroll
        for (int j = 0; j < 4; ++j)
#pragma unroll
            for (int q = 0; q < 4; ++q) { const f32x4 wa = wra[j][q], wb = wrb[j][q]; const float hv = v[j][q];
                lg[0] += hv * wa[0]; lg[1] += hv * wa[1]; lg[2] += hv * wa[2]; lg[3] += hv * wa[3]; lg[4] += hv * wb[0]; lg[5] += hv * wb[1]; lg[6] += hv * wb[2]; lg[7] += hv * wb[3]; }
        { const bool b5 = lane & 32, b4 = lane & 16, b3 = lane & 8; float k4[4], k2[2], k1;
#pragma unroll
          for (int i = 0; i < 4; ++i) { const float send = b5 ? lg[i] : lg[4 + i], keep = b5 ? lg[4 + i] : lg[i]; k4[i] = keep + __shfl_xor(send, 32); }
#pragma unroll
          for (int i = 0; i < 2; ++i) { const float send = b4 ? k4[i] : k4[2 + i], keep = b4 ? k4[2 + i] : k4[i]; k2[i] = keep + __shfl_xor(send, 16); }
          { const float send = b3 ? k2[0] : k2[1], keep = b3 ? k2[1] : k2[0]; k1 = keep + __shfl_xor(send, 8); }
          k1 += __shfl_xor(k1, 4); k1 += __shfl_xor(k1, 2); k1 += __shfl_xor(k1, 1);
#pragma unroll
          for (int e = 0; e < 8; ++e) lg[e] = __builtin_bit_cast(float, __builtin_amdgcn_readlane(__builtin_bit_cast(int, k1), 8 * e)) * rs; }
        int i0 = 0; float v0 = lg[0];
#pragma unroll
        for (int e = 1; e < 8; ++e) if (lg[e] > v0) { v0 = lg[e]; i0 = e; }
        int i1 = -1; float v1 = -3.0e38f;
#pragma unroll
        for (int e = 0; e < 8; ++e) if (e != i0 && lg[e] > v1) { v1 = lg[e]; i1 = e; }
        const float e1 = __expf(v1 - v0), w0 = 1.0f / (1.0f + e1), w1 = e1 * w0;
        if (lane == 0) { toke[2 * t] = i0; toke[2 * t + 1] = i1; tokw[2 * t] = w0; tokw[2 * t + 1] = w1; rsrow[t] = rs; __hip_atomic_fetch_add(cnt + i0, 1, __ATOMIC_RELAXED, __HIP_MEMORY_SCOPE_WORKGROUP); __hip_atomic_fetch_add(cnt + i1, 1, __ATOMIC_RELAXED, __HIP_MEMORY_SCOPE_WORKGROUP); }
    }
    wg_sync(); CHAOS_POINT(16, 51);
    if (tid < 8) wgcnt[blockIdx.x * 8 + tid] = cnt[tid];
    wg_sync(); CHAOS_POINT(16, 51);
}
__device__ __forceinline__ void moe_slot_phase(LAS unsigned char* lds, const int* toke, const int* wgcnt, int* tokp, int* tilee, int* meta, const bf16* xb, const float* rsrow, const float* gain, unsigned char* XG8, int G) {
    const int tid = opq_tid(), lane = tid & 63, wave = __builtin_amdgcn_readfirstlane(tid >> 6);
    LAS int* arr = (LAS int*)lds;
    LAS int* pre = arr + 1024 * 8;
    LAS int* wcnt = pre + 32;
    LAS int* slots = wcnt + 64;
    for (int i = tid; i < G * 8; i += NTHR) arr[i] = wgcnt[i];
    wg_sync(); CHAOS_POINT(16, 51);
    if (tid < 8) { int p = 0, tot = 0; for (int w = 0; w < G; ++w) { const int c = arr[w * 8 + tid]; if (w < (int)blockIdx.x) p += c; tot += c; } pre[tid] = p; pre[8 + tid] = tot; }
    wg_sync(); CHAOS_POINT(16, 51);
    if (tid == 0) { int ps = 0; for (int e = 0; e < 8; ++e) { pre[16 + e] = ps; ps += ((pre[8 + e] + 255) >> 8) << 8; } pre[24] = ps; }
    wg_sync(); CHAOS_POINT(16, 51);
    const int TPW = M / G;
    int e_mine = -1, t = 0, rank = 0;
    if (tid < 2 * TPW) { t = blockIdx.x * TPW + (tid >> 1); e_mine = toke[2 * t + (tid & 1)]; }
#pragma unroll
    for (int e = 0; e < 8; ++e) { const unsigned long long mk_ = __ballot(e_mine == e); if (e_mine == e) rank = __popcll(mk_ & ((1ull << lane) - 1ull)); if (lane == 0) wcnt[wave * 8 + e] = __popcll(mk_); }
    wg_sync(); CHAOS_POINT(16, 51);
    if (e_mine >= 0) { int base = pre[16 + e_mine] + pre[e_mine]; for (int w = 0; w < wave; ++w) base += wcnt[w * 8 + e_mine];
        const int slot = base + rank; slots[tid] = slot; tokp[2 * t + (tid & 1)] = slot; }
    else slots[tid] = -1;
    if ((int)blockIdx.x < 8) { const int e = blockIdx.x, s0 = pre[16 + e] + pre[8 + e], s1 = pre[16 + e] + (((pre[8 + e] + 255) >> 8) << 8);
        unsigned z0 = 0u; asm volatile("" : "+v"(z0));
        for (int i = tid; i < (s1 - s0) * 64; i += NTHR) ((v4u*)(XG8 + (size_t)s0 * D))[i] = (v4u){z0, z0, z0, z0}; }
    if (blockIdx.x == 0) { const int ntiles = pre[24] >> 8;
        for (int ti = tid; ti < ntiles; ti += NTHR) { int e = 0;
#pragma unroll
            for (int q = 1; q < 8; ++q) if (ti * 256 >= pre[16 + q]) e = q;
            tilee[ti] = e; }
        if (tid == 0) meta[0] = ntiles; }
    wg_sync(); CHAOS_POINT(16, 51);
    { f32x4 g[4];
#pragma unroll
      for (int q = 0; q < 4; ++q) g[q] = *(const f32x4*)(gain + 16 * lane + 4 * q);
#pragma unroll 1
      for (int a0 = wave * 64; a0 < wave * 64 + 64; a0 += 2) {
          v4u av[2][2]; float rs[2]; int sl[2];
#pragma unroll
          for (int u = 0; u < 2; ++u) { const int a = a0 + u; sl[u] = slots[a]; const int tt = blockIdx.x * TPW + (a >> 1); rs[u] = rsrow[tt]; const v4u* src = (const v4u*)(xb + (size_t)tt * D) + 2 * lane; av[u][0] = src[0]; av[u][1] = src[1]; }
#pragma unroll
          for (int u = 0; u < 2; ++u) if (sl[u] >= 0) { v4u o;
#pragma unroll
              for (int h = 0; h < 2; ++h) { const unsigned w4[4] = {av[u][h].x, av[u][h].y, av[u][h].z, av[u][h].w};
#pragma unroll
                  for (int q = 0; q < 2; ++q) { int w = 0;
                      w = __builtin_amdgcn_cvt_pk_fp8_f32(bflo(w4[2 * q]) * rs[u] * g[2 * h + q][0], bfhi(w4[2 * q]) * rs[u] * g[2 * h + q][1], w, false);
                      w = __builtin_amdgcn_cvt_pk_fp8_f32(bflo(w4[2 * q + 1]) * rs[u] * g[2 * h + q][2], bfhi(w4[2 * q + 1]) * rs[u] * g[2 * h + q][3], w, true);
                      o[2 * h + q] = (unsigned)w; } }
              ((v4u*)(XG8 + (size_t)sl[u] * D))[lane] = o; } } }
    wg_sync(); CHAOS_POINT(16, 51);
}
__device__ __forceinline__ void moe_gather_phase(const bf16* xb, const float* rsrow, const float* gain, const int* rowtok, bf16* XG, int nrows, int gw, int NGW, int lane) {
    f32x4 g[4];
#pragma unroll
    for (int q = 0; q < 4; ++q) g[q] = *(const f32x4*)(gain + (q >> 1) * 512 + 8 * lane + 4 * (q & 1));
    for (int r = gw; r < nrows; r += NGW) { const int t = rowtok[r]; const float rs = rsrow[t]; const v4u* src = (const v4u*)(xb + (size_t)t * D); v4u* dst = (v4u*)(XG + (size_t)r * D);
#pragma unroll
        for (int h = 0; h < 2; ++h) { const v4u a = src[64 * h + lane]; v4u o;
            o.x = pk2(bflo(a.x) * rs * g[2 * h][0], bfhi(a.x) * rs * g[2 * h][1]); o.y = pk2(bflo(a.y) * rs * g[2 * h][2], bfhi(a.y) * rs * g[2 * h][3]);
            o.z = pk2(bflo(a.z) * rs * g[2 * h + 1][0], bfhi(a.z) * rs * g[2 * h + 1][1]); o.w = pk2(bflo(a.w) * rs * g[2 * h + 1][2], bfhi(a.w) * rs * g[2 * h + 1][3]);
            dst[64 * h + lane] = o; } }
}
__device__ __forceinline__ void moe_combine_final_phase(const bf16* xb, float* out, const bf16* YB, const int* tokp, const float* tokw, const float* gain, int gw, int NGW, int lane) {
    f32x4 g[4];
#pragma unroll
    for (int q = 0; q < 4; ++q) g[q] = *(const f32x4*)(gain + (q >> 1) * 512 + 8 * lane + 4 * (q & 1));
#pragma unroll 1
    for (int t0 = gw; t0 < M; t0 += 2 * NGW) { CHAOS_POINT(16, 52);
        v4u xa[2][2], ya[2][2], yb[2][2]; float w0[2], w1[2]; bool on[2];
#pragma unroll
        for (int u = 0; u < 2; ++u) { const int t = t0 + u * NGW; on[u] = t < M; const int tt = on[u] ? t : t0;
            const int p0 = tokp[2 * tt], p1 = tokp[2 * tt + 1]; w0[u] = tokw[2 * tt]; w1[u] = tokw[2 * tt + 1];
            const v4u* xr = (const v4u*)(xb + (size_t)tt * D) + lane; const v4u* y0 = (const v4u*)(YB + (size_t)p0 * D) + lane; const v4u* y1 = (const v4u*)(YB + (size_t)p1 * D) + lane;
#pragma unroll
            for (int h = 0; h < 2; ++h) { xa[u][h] = xr[64 * h]; ya[u][h] = y0[64 * h]; yb[u][h] = y1[64 * h]; } }
#pragma unroll
        for (int u = 0; u < 2; ++u) { const int t = t0 + u * NGW; float v[2][8]; float s = 0.f;
#pragma unroll
            for (int h = 0; h < 2; ++h) { const unsigned xw[4] = {xa[u][h].x, xa[u][h].y, xa[u][h].z, xa[u][h].w}, aw[4] = {ya[u][h].x, ya[u][h].y, ya[u][h].z, ya[u][h].w}, bw[4] = {yb[u][h].x, yb[u][h].y, yb[u][h].z, yb[u][h].w};
#pragma unroll
                for (int q = 0; q < 4; ++q) { v[h][2 * q] = bflo(xw[q]) + w0[u] * bflo(aw[q]) + w1[u] * bflo(bw[q]); v[h][2 * q + 1] = bfhi(xw[q]) + w0[u] * bfhi(aw[q]) + w1[u] * bfhi(bw[q]);
                    s += v[h][2 * q] * v[h][2 * q] + v[h][2 * q + 1] * v[h][2 * q + 1]; } }
            const float rs = 1.0f / sqrtf(wave_sum(s) * (1.f / 1024.f) + EPS);
            if (on[u]) { f32x4* orow = (f32x4*)(out + (size_t)t * D);
#pragma unroll
                for (int h = 0; h < 2; ++h) { orow[128 * h + 2 * lane] = (f32x4){v[h][0], v[h][1], v[h][2], v[h][3]} * rs * g[2 * h]; orow[128 * h + 2 * lane + 1] = (f32x4){v[h][4], v[h][5], v[h][6], v[h][7]} * rs * g[2 * h + 1]; } } }
    }
}
struct MoeOrder : pg8::StaticOrder {
    const int* tilee; int tile0; size_t bstride;
    __device__ __forceinline__ size_t boff(const pg8::Unit& u) const { return (size_t)tilee[tile0 + u.pm] * bstride; }
};
#ifndef LB_WAVES
#define LB_WAVES 2
#endif
constexpr int N_PHASES_C = 29;
__global__ void __launch_bounds__(NTHR, LB_WAVES) fwd_kernel(Args args) {
    extern __shared__ __attribute__((aligned(16))) unsigned char lds_raw[];
    LAS unsigned char* lds = (LAS unsigned char*)lds_raw;
    const int tid0 = threadIdx.x;
    const int G = gridDim.x, NGW = G * NWAVES;
    unsigned char* ws = args.ws;
    gu32* ctl = (gu32*)(ws + WS_CTL);
    volatile LAS unsigned* MISC = (volatile LAS unsigned*)(lds + MISC_OFF);
    for (int u = tid0; u < (LDS_BYTES - LDSCTL_OFF) / 4; u += NTHR) ((LAS unsigned*)(lds + LDSCTL_OFF))[u] = 0u;
#ifdef DIAG
#ifndef DIAG_WG
#define DIAG_WG 0
#endif
#ifndef DIAG_PH
#define DIAG_PH 0
#endif
#ifndef DIAG_DIV
#define DIAG_DIV 1
#endif
    static_assert(MISC_OFF == 155712, "diag pointer slot");
    if (tid0 == 0) ((LAS unsigned long long*)(lds + MISC_OFF))[0] = (unsigned long long)(ws + WS_CTL + 512 * 1024);
#endif
    __syncthreads();
    XcdBarrier bar; bar.bar = (unsigned*)(ctl + CW_BAR); bar.x = 0; bar.st = nullptr;
    if (args.use_bar) bar = xcd_barrier_post((unsigned*)(ctl + CW_BAR), MISC + 8);
    const int lo = args.ph_lo, hi = args.ph_hi;
    int ph = 0;
#ifndef PHMASK
#define PHMASK 0xffffffffu
#endif
#define EN(k) (((PHMASK) >> (k)) & 1u)
#define PH_ON() (ph >= lo && ph < hi)
#define LOCAL_IDS() const int tid = opq_tid(), lane = tid & 63, wave = __builtin_amdgcn_readfirstlane(tid >> 6), gw = blockIdx.x * NWAVES + wave; (void)lane; (void)gw
#ifndef DUPMASK
#define DUPMASK 0u
#endif
#define RES_DST(k) ((NREP(k) > 1 && rep_ + 1 < NREP(k)) ? (bf16*)args.out : HB)
#ifndef DUPN
#define DUPN 2
#endif
#define NREP(k) ((((DUPMASK) >> (k)) & 1u) ? DUPN : 1)
#ifdef DIAG
#define PH_END_K(k) do { if (args.use_bar && (ph + 1 < hi || rep_ + 1 < NREP(k))) { const unsigned long long tb_ = wall_clock64(); xcd_barrier(bar); if (threadIdx.x == 0) { unsigned long long* dg = (unsigned long long*)(ws + WS_CTL + 512 * 1024); const unsigned long long w_ = wall_clock64() - tb_; atomicAdd(dg + 5, w_); if (ph == DIAG_PH) atomicAdd(dg + 6, w_); } } } while (0)
#else
#define PH_END_K(k) do { if (args.use_bar && (ph + 1 < hi || rep_ + 1 < NREP(k))) xcd_barrier(bar); } while (0)
#endif

    float* cosT = (float*)(ws + WS_COS); float* sinT = (float*)(ws + WS_SIN); float* H2 = (float*)(ws + WS_H2);
    int* toke = (int*)(ws + WS_TOKE); float* tokw = (float*)(ws + WS_TOKW); int* tokp = (int*)(ws + WS_TOKP); int* rowtok = (int*)(ws + WS_ROWTOK);
    int* tilee = (int*)(ws + WS_TILEE); int* wgcnt = (int*)(ws + WS_WGCNT); int* meta = (int*)(ws + WS_META); float* rsrow = (float*)(ws + WS_RSROW);
    bf16* WINA = (bf16*)(ws + WS_WINA); bf16* WINB = (bf16*)(ws + WS_WINB); bf16* WOUT = (bf16*)(ws + WS_WOUT); bf16* XQ = (bf16*)(ws + WS_XQ); bf16* XK = (bf16*)(ws + WS_XK);
    bf16* XV = (bf16*)(ws + WS_XV); bf16* XO = (bf16*)(ws + WS_XO); bf16* FGU = (bf16*)(ws + WS_FGU); bf16* FDN = (bf16*)(ws + WS_FDN); bf16* MGU = (bf16*)(ws + WS_MGU); bf16* MDN = (bf16*)(ws + WS_MDN);
    float* KF = (float*)(ws + WS_KFILT); bf16* MB = (bf16*)(ws + WS_MB); bf16* KMEM = (bf16*)(ws + WS_KMEM); bf16* VMEMT = (bf16*)(ws + WS_VMEMT); bf16* HB = (bf16*)(ws + WS_HB);
    bf16* QB = (bf16*)(ws + WS_QB); bf16* KB = (bf16*)(ws + WS_KB); bf16* VB = (bf16*)(ws + WS_VB); bf16* UT = (bf16*)(ws + WS_UT); bf16* AB = (bf16*)(ws + WS_AB); bf16* YT = (bf16*)(ws + WS_YT);
    bf16* MIXED = (bf16*)(ws + WS_MIXED); float* SS = (float*)(ws + WS_SS);
    bf16* XQB = (bf16*)(ws + WS_XQB); bf16* XOB = (bf16*)(ws + WS_XOB); bf16* ACT = (bf16*)(ws + WS_ACT); unsigned char* XG8 = ws + WS_XG; bf16* YB = (bf16*)(ws + WS_YB); unsigned char* MGU8 = ws + WS_MGU; bf16* MACT = (bf16*)(ws + WS_MACT);
    const float* const* in = args.in;

    if (EN(0) && PH_ON()) for (int rep_ = 0; rep_ < NREP(0); ++rep_) { asm volatile("; PHASE_MARK 0"); LOCAL_IDS();
        LAS float* scr = (LAS float*)(lds + wave * 8704);
        constexpr int IT_L = 384 + 768 + 512 + 4 * 256, IT_D = 3 * 1408, IT_E = 3 * 1792, IT_ALL = 2 * IT_L + IT_D + NE * IT_E;
#pragma unroll 1
        for (int it = gw; it < IT_ALL; it += NGW) {
            const float* W; int ldw, K, col0 = 0, ncols, mode = 0; bf16* WT; const float* gk = nullptr; int r = it;
            if (r < 2 * IT_L) { const int l = r / IT_L; r -= l * IT_L;
                if (r < 384) { W = in[I_WIN] + (size_t)l * D * INC; ldw = INC; K = D; ncols = 768; WT = WINA + (size_t)l * 768 * D; mode = 1; gk = in[I_MIXNORM] + l * D; }
                else if ((r -= 384) < 768) { W = in[I_WIN] + (size_t)l * D * INC; ldw = INC; K = D; col0 = 768; ncols = C3; WT = WINB + (size_t)l * C3 * D; gk = in[I_MIXNORM] + l * D; }
                else if ((r -= 768) < 512) { W = in[I_WOUT] + (size_t)l * D * D; ldw = D; K = D; ncols = D; WT = WOUT + (size_t)l * D * D; }
                else if ((r -= 512) < 256) { W = in[I_XWQ] + (size_t)l * D * XW; ldw = XW; K = D; ncols = XW; WT = XQ + (size_t)l * XW * D; gk = in[I_XNORM] + l * D; }
                else if ((r -= 256) < 256) { W = in[I_XWK] + (size_t)l * D * XW; ldw = XW; K = D; ncols = XW; WT = XK + (size_t)l * XW * D; }
                else if ((r -= 256) < 256) { W = in[I_XWV] + (size_t)l * D * XW; ldw = XW; K = D; ncols = XW; WT = XV + (size_t)l * XW * D; }
                else { r -= 256; W = in[I_XWO] + (size_t)l * XW * D; ldw = D; K = XW; ncols = D; WT = XO + (size_t)l * D * XW; }
            } else if ((r -= 2 * IT_L) < IT_D) {
                if (r < 1408) { W = in[I_FGATE]; ldw = FF; K = D; ncols = FF; WT = FGU; mode = 2; gk = in[I_FNORM]; }
                else if ((r -= 1408) < 1408) { W = in[I_FUP]; ldw = FF; K = D; ncols = FF; WT = FGU; mode = 3; gk = in[I_FNORM]; }
                else { r -= 1408; W = in[I_FDOWN]; ldw = D; K = FF; ncols = D; WT = FDN; }
            } else { r -= IT_D; const int e = r / IT_E; r -= e * IT_E;
                if (r < 2 * 1792) { const bool up = r >= 1792; if (up) r -= 1792;
                    tr_item8(in[up ? I_MUP : I_MGATE] + (size_t)e * D * FFE, FFE, D, FFE, MGU8 + (size_t)e * 2 * FFE * D, up ? 3 : 2, 32.0f, r, scr, lane); continue; }
                else { r -= 2 * 1792; tr_item8(in[I_MDOWN] + (size_t)e * FFE * D, D, FFE, D, (unsigned char*)MDN + (size_t)e * D * FFE, 0, 32.0f, r, scr, lane); continue; }
            }
            tr_item(W, ldw, K, col0, ncols, WT, mode, gk, r, scr, lane);
        }
        for (int i = blockIdx.x * NTHR + tid; i < SEQ * 32; i += G * NTHR) { const int pos = i >> 5, f = i & 31;
            const float inv = (float)pow(10000.0, -(double)f / 32.0); const float ang = (float)pos * inv;
            cosT[i] = (float)cos((double)ang); sinT[i] = (float)sin((double)ang); }
        h2_rows(args, H2, gw, NGW, lane);
        norm_rows(in[I_MEM], in[I_MEMNORM], MB, MROWS, gw, NGW, lane);
        xb_rows(in[I_X], HB, SS, M, gw, NGW, lane);
        PH_END_K(0);
    }
    ++ph;
    if (EN(1) && PH_ON()) for (int rep_ = 0; rep_ < NREP(1); ++rep_) { asm volatile("; PHASE_MARK 1"); LOCAL_IDS();
        kfilt_phase(lds, H2, in[I_FW3], KF, G);
        PH_END_K(1);
    }
    ++ph;

#pragma unroll 1
    for (int l = 0; l < 2; ++l) {
        if (EN(2) && PH_ON()) for (int rep_ = 0; rep_ < NREP(2); ++rep_) { asm volatile("; PHASE_MARK 2"); LOCAL_IDS();
            if (l == 0) {
                kspec_phase(lds, KF, (float*)(ws + WS_KSPEC), G);
                { pg8::Gemm g{MB, XK, MROWS, 1024, D}; pg8::StaticOrder S; S.init(MROWS, 1024, G, (int)blockIdx.x); pg8::EpiBf16 E{KMEM, 1024, nullptr, 1.0f};
                  pg8::gemm_phase<pg8::EpiBf16, pg8::StaticOrder, PG8_ALIGN, PG8_SP2>(lds, g, S, E); }
                { pg8::Gemm g{MB, XV, MROWS, 1024, D}; pg8::StaticOrder S; S.init(MROWS, 1024, G, G >= 128 ? (int)((blockIdx.x + G - 64) % G) : (int)blockIdx.x); pg8::EpiT E{VMEMT, 1024, 12, nullptr};
                  pg8::gemm_phase<pg8::EpiT, pg8::StaticOrder, PG8_ALIGN, PG8_SP2>(lds, g, S, E); }
            }
            { pg8::Gemm g{HB, WINA + (size_t)l * 768 * D, M, 768, D}; pg8::StaticOrder S; S.init(M, 768, G, (int)blockIdx.x); pg8::EpiQKV E{QB, KB, VB, cosT, sinT, SS + (size_t)(3 * l) * SS_STRIDE};
              pg8::gemm_phase<pg8::EpiQKV, pg8::StaticOrder, PG8_ALIGN, PG8_SP2>(lds, g, S, E); }
            { pg8::Gemm g{HB, WINB + (size_t)l * C3 * D, M, C3, D}; pg8::StaticOrder S; S.init(M, C3, G, (int)blockIdx.x); pg8::EpiT E{UT, C3, 12, SS + (size_t)(3 * l) * SS_STRIDE};
              pg8::gemm_phase<pg8::EpiT, pg8::StaticOrder, PG8_ALIGN, PG8_SP2>(lds, g, S, E); }
            PH_END_K(2);
        }
        ++ph;
        if (EN(3) && PH_ON()) for (int rep_ = 0; rep_ < NREP(3); ++rep_) { asm volatile("; PHASE_MARK 3"); LOCAL_IDS();
#ifndef BA_REP
#define BA_REP 1
#endif
#ifndef HY_REP
#define HY_REP 1
#endif
#pragma unroll 1
            for (int r_ = 0; r_ < BA_REP; ++r_) band_attention_phase(lds, QB, KB, VB, AB, in[I_SINK] + l * NH, G);
#pragma unroll 1
            for (int r_ = 0; r_ < HY_REP; ++r_) hyena_phase(lds, args, l, UT, (const float*)(ws + WS_KSPEC), YT, G);
            PH_END_K(3);
        }
        ++ph;
        if (EN(4) && PH_ON()) for (int rep_ = 0; rep_ < NREP(4); ++rep_) { asm volatile("; PHASE_MARK 4"); LOCAL_IDS(); mixnorm_phase(lds, AB, YT, in[I_ANORM] + l * AW, in[I_YNORM] + l * HYW, MIXED, G); PH_END_K(4); }
        ++ph;
        if (EN(5) && PH_ON()) for (int rep_ = 0; rep_ < NREP(5); ++rep_) { asm volatile("; PHASE_MARK 5"); LOCAL_IDS();
            pg8::Gemm g{MIXED, WOUT + (size_t)l * D * D, M, D, D}; pg8::StaticOrder S; S.init(M, D, G, (int)blockIdx.x); pg8::EpiResB E{HB, D, SS + (size_t)(3 * l + 1) * SS_STRIDE, RES_DST(5)};
            pg8::gemm_phase<pg8::EpiResB, pg8::StaticOrder, PG8_ALIGN, PG8_SP2>(lds, g, S, E);
            PH_END_K(5);
        }
        ++ph;
        if (EN(7) && PH_ON()) for (int rep_ = 0; rep_ < NREP(7); ++rep_) { asm volatile("; PHASE_MARK 7"); LOCAL_IDS();
            pg8::Gemm g{HB, XQ + (size_t)l * XW * D, M, XW, D}; pg8::StaticOrder S; S.init(M, XW, G, (int)blockIdx.x); pg8::EpiBf16 E{XQB, XW, SS + (size_t)(3 * l + 1) * SS_STRIDE, 1.0f};
            pg8::gemm_phase<pg8::EpiBf16, pg8::StaticOrder, PG8_ALIGN, PG8_SP2>(lds, g, S, E);
            PH_END_K(7);
        }
        ++ph;
        if (EN(8) && PH_ON()) for (int rep_ = 0; rep_ < NREP(8); ++rep_) { asm volatile("; PHASE_MARK 8"); LOCAL_IDS(); cross_attention_phase(lds, XQB, KMEM, VMEMT, XOB, l, G); PH_END_K(8); }
        ++ph;
        if (EN(9) && PH_ON()) for (int rep_ = 0; rep_ < NREP(9); ++rep_) { asm volatile("; PHASE_MARK 9"); LOCAL_IDS();
            pg8::Gemm g{XOB, XO + (size_t)l * D * XW, M, D, XW}; pg8::StaticOrder S; S.init(M, D, G, (int)blockIdx.x); pg8::EpiResB E{HB, D, l == 0 ? SS + (size_t)2 * SS_STRIDE : nullptr, RES_DST(9)};
            pg8::gemm_phase<pg8::EpiResB, pg8::StaticOrder, PG8_ALIGN, PG8_SP2>(lds, g, S, E);
            PH_END_K(9);
        }
        ++ph;
        if (l == 0) {
            if (EN(11) && PH_ON()) for (int rep_ = 0; rep_ < NREP(11); ++rep_) { asm volatile("; PHASE_MARK 11"); LOCAL_IDS();
                pg8::Gemm g{HB, FGU, M, 2 * FF, D}; pg8::StaticOrder S; S.init(M, 2 * FF, G, (int)blockIdx.x); pg8::EpiSwiglu<true> E{ACT, FF, SS + (size_t)2 * SS_STRIDE};
                pg8::gemm_phase<pg8::EpiSwiglu<true>, pg8::StaticOrder, PG8_ALIGN, PG8_SP2>(lds, g, S, E);
                PH_END_K(11);
            }
            ++ph;
            if (EN(12) && PH_ON()) for (int rep_ = 0; rep_ < NREP(12); ++rep_) { asm volatile("; PHASE_MARK 12"); LOCAL_IDS();
                pg8::Gemm g{ACT, FDN, M, D, FF}; pg8::StaticOrder S; S.init(M, D, G, (int)blockIdx.x); pg8::EpiResB E{HB, D, SS + (size_t)3 * SS_STRIDE, RES_DST(12)};
                pg8::gemm_phase<pg8::EpiResB, pg8::StaticOrder, PG8_ALIGN, PG8_SP2>(lds, g, S, E);
                PH_END_K(12);
            }
            ++ph;
        } else {
            if (EN(14) && PH_ON()) for (int rep_ = 0; rep_ < NREP(14); ++rep_) { asm volatile("; PHASE_MARK 14"); LOCAL_IDS(); moe_norm_router_phase(lds, HB, in[I_FNORM] + D, in[I_ROUTER], rsrow, toke, tokw, wgcnt, G); PH_END_K(14); }
            ++ph;
            if (EN(15) && PH_ON()) for (int rep_ = 0; rep_ < NREP(15); ++rep_) { asm volatile("; PHASE_MARK 15"); LOCAL_IDS(); moe_slot_phase(lds, toke, wgcnt, tokp, tilee, meta, HB, rsrow, in[I_FNORM] + D, XG8, G); PH_END_K(15); }
            ++ph;
#pragma unroll 1
            for (int ci = 0; ci < MOE_NCHUNK; ++ci) {
                if (EN(17) && PH_ON()) for (int rep_ = 0; rep_ < NREP(17); ++rep_) { asm volatile("; PHASE_MARK 17"); LOCAL_IDS();
                    const int ntiles = meta[0], tile0 = ci * MOE_CH_TILES, nt = ci < MOE_NCHUNK - 1 ? MOE_CH_TILES : ntiles - (MOE_NCHUNK - 1) * MOE_CH_TILES;
                    int k8 = D / 2; asm volatile("" : "+s"(k8));
                    pg8::Gemm g{(const bf16*)(XG8 + (size_t)tile0 * 256 * D), (const bf16*)MGU8, nt * 256, 2 * FFE, k8};
                    MoeOrder S; S.init(nt * 256, 2 * FFE, G, (int)blockIdx.x); S.tilee = tilee; S.tile0 = tile0; S.bstride = (size_t)2 * FFE * D;
                    pg8::EpiSwiglu<false, true, true> E{MACT, FFE, nullptr};
                    pg8::gemm_phase<pg8::EpiSwiglu<false, true, true>, MoeOrder, PG8_ALIGN, PG8_SP2>(lds, g, S, E);
                    PH_END_K(17);
                }
                ++ph;
                if (EN(18) && PH_ON()) for (int rep_ = 0; rep_ < NREP(18); ++rep_) { asm volatile("; PHASE_MARK 18"); LOCAL_IDS();
                    const int ntiles = meta[0], tile0 = ci * MOE_CH_TILES, nt = ci < MOE_NCHUNK - 1 ? MOE_CH_TILES : ntiles - (MOE_NCHUNK - 1) * MOE_CH_TILES;
                    int k8 = FFE / 2; asm volatile("" : "+s"(k8));
                    pg8::Gemm g{MACT, MDN, nt * 256, D, k8};
                    MoeOrder S; S.init(nt * 256, D, G, (int)blockIdx.x); S.tilee = tilee; S.tile0 = tile0; S.bstride = (size_t)D * FFE;
                    pg8::EpiBf16T<true> E{YB + (size_t)tile0 * 256 * D, D, nullptr, 1.0f / 128.0f};
                    pg8::gemm_phase<pg8::EpiBf16T<true>, MoeOrder, PG8_ALIGN, PG8_SP2>(lds, g, S, E);
                    PH_END_K(18);
                }
                ++ph;
            }
            if (EN(19) && PH_ON()) for (int rep_ = 0; rep_ < NREP(19); ++rep_) { asm volatile("; PHASE_MARK 19"); LOCAL_IDS(); moe_combine_final_phase(HB, args.out, YB, tokp, tokw, in[I_FINAL], gw, NGW, lane); PH_END_K(19); }
            ++ph;
        }
    }
#ifdef DIAG
    if (blockIdx.x == DIAG_WG && tid0 == 0 && hi == N_PHASES_C) { const unsigned long long v = ((unsigned long long*)(ws + WS_CTL + 512 * 1024))[DIAG_SEL] * DIAG_MULT / DIAG_DIV; const unsigned long long t0 = wall_clock64(); while (wall_clock64() - t0 < v) __builtin_amdgcn_s_sleep(8); }
#endif
#undef PH_ON
}
constexpr int N_PHASES = 2 + 7 + 2 + 7 + 2 + 2 * MOE_NCHUNK + 1;

#ifndef MK_PER_PHASE
#define MK_PER_PHASE 0
#endif
extern "C" void kernel_launch(void* const* d_in, const int* in_sizes, int n_in, void* d_out, int out_size, void* d_ws, size_t ws_size, hipStream_t stream) {
    static int grid = 0;
    if (grid == 0) {
        if (n_in != 33 || in_sizes[0] != M * D || out_size != M * D || ws_size < WS_END) {
            fprintf(stderr, "kernel_launch: unexpected problem: n_in %d in0 %d out %d ws %zu (need %zu); nothing launched\n", n_in, n_in > 0 ? in_sizes[0] : -1, out_size, ws_size, (size_t)WS_END); grid = -1; return; }
        int dev = 0, cus = 0, per_cu = 0;
        if (hipGetDevice(&dev) != hipSuccess || hipDeviceGetAttribute(&cus, hipDeviceAttributeMultiprocessorCount, dev) != hipSuccess) { fprintf(stderr, "kernel_launch: device query failed\n"); grid = -1; return; }
        if (hipFuncSetAttribute((const void*)fwd_kernel, hipFuncAttributeMaxDynamicSharedMemorySize, LDS_BYTES) != hipSuccess) { fprintf(stderr, "kernel_launch: hipFuncSetAttribute failed\n"); grid = -1; return; }
        if (hipOccupancyMaxActiveBlocksPerMultiprocessor(&per_cu, (const void*)fwd_kernel, NTHR, LDS_BYTES) != hipSuccess || per_cu < 1) { fprintf(stderr, "kernel_launch: occupancy query reports %d\n", per_cu); }
        (void)hipGetLastError();
        grid = cus;
        if (grid > 256) grid = 256;
        while (grid > 1 && (M % grid != 0 || M / grid > 256)) --grid;
        if (grid != 256) fprintf(stderr, "kernel_launch: note: grid %d\n", grid);
    }
    if (grid < 0) return;
    if (hipMemsetAsync((char*)d_ws + WS_CTL, 0, CTL_ZERO_BYTES, stream) != hipSuccess) { fprintf(stderr, "kernel_launch: memset failed\n"); return; }
    Args a{};
    for (int i = 0; i < 33; ++i) a.in[i] = (const float*)d_in[i];
    a.out = (float*)d_out; a.ws = (unsigned char*)d_ws;
#if MK_PER_PHASE
    for (int p = 0; p < N_PHASES; ++p) { a.ph_lo = p; a.ph_hi = p + 1; a.use_bar = 0; a.pad = 0; hipLaunchKernelGGL(fwd_kernel, dim3(grid), dim3(NTHR), LDS_BYTES, stream, a); }
#else
    a.ph_lo = 0; a.ph_hi = N_PHASES; a.use_bar = 1; a.pad = 0;
    hipLaunchKernelGGL(fwd_kernel, dim3(grid), dim3(NTHR), LDS_BYTES, stream, a);
#endif
    const hipError_t le = hipPeekAtLastError();
    if (le != hipSuccess) fprintf(stderr, "kernel_launch: launch failed: %s\n", hipGetErrorName(le));
}
```

```cpp
#include <hip/hip_runtime.h>
#include <cstdio>
#include <cstdint>
#ifndef HD
#define HD __host__ __device__ __forceinline__
#endif
__device__ __forceinline__ int opq_tid() { int t = (int)threadIdx.x; asm volatile("" : "+v"(t)); return t; }
typedef float f32x2_cv __attribute__((ext_vector_type(2))); typedef __bf16 bf16x2_cv __attribute__((ext_vector_type(2)));
__device__ __forceinline__ unsigned cvtpk_hw(float lo, float hi) { f32x2_cv v = {lo, hi}; bf16x2_cv b = __builtin_convertvector(v, bf16x2_cv); return __builtin_bit_cast(unsigned, b); }
#ifdef CHAOS
#ifndef CHAOS_MASK
#define CHAOS_MASK 0xff
#endif
__device__ __forceinline__ void chaos_point(unsigned k) {
    const unsigned t = (unsigned)__builtin_amdgcn_s_memtime();
    unsigned r = (t >> 3) * 2654435761u + k * 40503u + (unsigned)__builtin_amdgcn_s_getreg(63492) * 97u;
    r ^= r >> 15;
    if ((r & 3u) == 0u) { if (r & 4u) __builtin_amdgcn_s_sleep(13); if (r & 8u) __builtin_amdgcn_s_sleep(37); if (r & 16u) __builtin_amdgcn_s_sleep(90); }
}
#define CHAOS_POINT(grp, k) do { if ((CHAOS_MASK) & (grp)) chaos_point(k); } while (0)
#else
#define CHAOS_POINT(grp, k) do {} while (0)
#endif

#if defined(__HIP__)
typedef float cf __attribute__((ext_vector_type(2)));
HD cf mk(float a, float b) { return (cf){a, b}; }
HD cf cadd(cf a, cf b) { return a + b; }
HD cf csub(cf a, cf b) { return a - b; }
#if defined(__HIP_DEVICE_COMPILE__) && !defined(FFT_NO_ASM)
HD cf cmul(cf a, cf b) { cf t, r;
    asm("v_pk_mul_f32 %0, %1, %2 op_sel:[1,1] op_sel_hi:[0,1]" : "=v"(t) : "v"(a), "v"(b));
    asm("v_pk_fma_f32 %0, %1, %2, %3 op_sel:[0,0,0] op_sel_hi:[1,0,1] neg_lo:[0,0,1]" : "=v"(r) : "v"(a), "v"(b), "v"(t)); return r; }
HD cf cmulc(cf a, cf b) { cf t, r;
    asm("v_pk_mul_f32 %0, %1, %2 op_sel:[1,1] op_sel_hi:[0,1]" : "=v"(t) : "v"(a), "v"(b));
    asm("v_pk_fma_f32 %0, %1, %2, %3 op_sel:[0,0,0] op_sel_hi:[1,0,1] neg_hi:[0,0,1]" : "=v"(r) : "v"(a), "v"(b), "v"(t)); return r; }
HD cf cmul_s(cf a, cf b) { cf t, r;
    asm("v_pk_mul_f32 %0, %1, %2 op_sel:[1,1] op_sel_hi:[0,1]" : "=v"(t) : "v"(a), "s"(b));
    asm("v_pk_fma_f32 %0, %1, %2, %3 op_sel:[0,0,0] op_sel_hi:[1,0,1] neg_lo:[0,0,1]" : "=v"(r) : "v"(a), "s"(b), "v"(t)); return r; }
HD cf cmulc_s(cf a, cf b) { cf t, r;
    asm("v_pk_mul_f32 %0, %1, %2 op_sel:[1,1] op_sel_hi:[0,1]" : "=v"(t) : "v"(a), "s"(b));
    asm("v_pk_fma_f32 %0, %1, %2, %3 op_sel:[0,0,0] op_sel_hi:[1,0,1] neg_hi:[0,0,1]" : "=v"(r) : "v"(a), "s"(b), "v"(t)); return r; }
HD cf add_mi(cf a, cf b) { cf r; asm("v_pk_add_f32 %0, %1, %2 op_sel:[0,1] op_sel_hi:[1,0] neg_hi:[0,1]" : "=v"(r) : "v"(a), "v"(b)); return r; }
HD cf add_pi(cf a, cf b) { cf r; asm("v_pk_add_f32 %0, %1, %2 op_sel:[0,1] op_sel_hi:[1,0] neg_lo:[0,1]" : "=v"(r) : "v"(a), "v"(b)); return r; }
#else
HD cf cmul(cf a, cf b) { return mk(a.x * b.x - a.y * b.y, a.x * b.y + a.y * b.x); }
HD cf cmulc(cf a, cf b) { return mk(a.x * b.x + a.y * b.y, a.y * b.x - a.x * b.y); }
HD cf cmul_s(cf a, cf b) { return cmul(a, b); }
HD cf cmulc_s(cf a, cf b) { return cmulc(a, b); }
HD cf add_mi(cf a, cf b) { return mk(a.x + b.y, a.y - b.x); }
HD cf add_pi(cf a, cf b) { return mk(a.x - b.y, a.y + b.x); }
#endif
HD cf cscale(cf a, float s) { return a * s; }
#else
struct cf { float x, y; };
HD cf mk(float a, float b) { cf r; r.x = a; r.y = b; return r; }
HD cf cadd(cf a, cf b) { return mk(a.x + b.x, a.y + b.y); }
HD cf csub(cf a, cf b) { return mk(a.x - b.x, a.y - b.y); }
HD cf cmul(cf a, cf b) { return mk(a.x * b.x - a.y * b.y, a.x * b.y + a.y * b.x); }
HD cf cmulc(cf a, cf b) { return mk(a.x * b.x + a.y * b.y, a.y * b.x - a.x * b.y); }
HD cf cmul_s(cf a, cf b) { return cmul(a, b); }
HD cf cmulc_s(cf a, cf b) { return cmulc(a, b); }
HD cf add_mi(cf a, cf b) { return mk(a.x + b.y, a.y - b.x); }
HD cf add_pi(cf a, cf b) { return mk(a.x - b.y, a.y + b.x); }
HD cf cscale(cf a, float s) { return mk(a.x * s, a.y * s); }
#endif
template <bool INV> HD cf cmulw(cf a, cf w) { return INV ? cmulc(a, w) : cmul(a, w); }
template <bool INV> HD cf cmulw_s(cf a, cf w) { return INV ? cmulc_s(a, w) : cmul_s(a, w); }

template <bool INV, bool ROT2 = false> HD void dft4(cf& a0, cf& a1, cf& a2, cf& a3) {
    const cf t0 = ROT2 ? (INV ? add_pi(a0, a2) : add_mi(a0, a2)) : cadd(a0, a2), t1 = ROT2 ? (INV ? add_mi(a0, a2) : add_pi(a0, a2)) : csub(a0, a2), t2 = cadd(a1, a3), t3 = csub(a1, a3);
    a0 = cadd(t0, t2); a2 = csub(t0, t2);
    if (!INV) { a1 = add_mi(t1, t3); a3 = add_pi(t1, t3); }
    else      { a1 = add_pi(t1, t3); a3 = add_mi(t1, t3); }
}
template <bool INV> HD void dft16(cf (&x)[16]) {
#pragma unroll
    for (int n1 = 0; n1 < 4; ++n1) dft4<INV>(x[n1], x[n1 + 4], x[n1 + 8], x[n1 + 12]);
    const float c1 = 0.92387953251128674f, s1 = 0.38268343236508977f, r2 = 0.70710678118654752f;
    const cf W1 = mk(c1, -s1), W2 = mk(r2, -r2), W3 = mk(s1, -c1), W6 = mk(-r2, -r2), W9 = mk(-c1, s1);
    x[1 + 4 * 1] = cmulw_s<INV>(x[1 + 4 * 1], W1);
    x[1 + 4 * 2] = cmulw_s<INV>(x[1 + 4 * 2], W2);
    x[1 + 4 * 3] = cmulw_s<INV>(x[1 + 4 * 3], W3);
    x[2 + 4 * 1] = cmulw_s<INV>(x[2 + 4 * 1], W2);
    x[2 + 4 * 3] = cmulw_s<INV>(x[2 + 4 * 3], W6);
    x[3 + 4 * 1] = cmulw_s<INV>(x[3 + 4 * 1], W3);
    x[3 + 4 * 2] = cmulw_s<INV>(x[3 + 4 * 2], W6);
    x[3 + 4 * 3] = cmulw_s<INV>(x[3 + 4 * 3], W9);
#pragma unroll
    for (int k2 = 0; k2 < 4; ++k2) { if (k2 == 2) dft4<INV, true>(x[0 + 4 * k2], x[1 + 4 * k2], x[2 + 4 * k2], x[3 + 4 * k2]); else dft4<INV>(x[0 + 4 * k2], x[1 + 4 * k2], x[2 + 4 * k2], x[3 + 4 * k2]); }
    cf t;
    t = x[1]; x[1] = x[4]; x[4] = t;   t = x[2]; x[2] = x[8]; x[8] = t;   t = x[3]; x[3] = x[12]; x[12] = t;
    t = x[6]; x[6] = x[9]; x[9] = t;   t = x[7]; x[7] = x[13]; x[13] = t; t = x[11]; x[11] = x[14]; x[14] = t;
}
template <bool INV> HD void twiddle16(cf (&x)[16], cf w1) {
    cf w = w1;
#pragma unroll
    for (int k = 1; k < 16; ++k) { x[k] = cmulw<INV>(x[k], w); if (k < 15) w = cmul(w, w1); }
}
constexpr int FFT_HALF = 4352;
constexpr int FFT_WORK = 2 * FFT_HALF;
HD int fphys(int h, int idx) { return h * FFT_HALF + idx + (idx >> 4); }

HD void geo1(int tid, int& h, int& j) { const int w = tid >> 6, l = tid & 63; h = l >> 5; j = 32 * w + (l & 31); }
HD void geo2(int tid, int& h, int& k1, int& j2) { h = tid >> 8; k1 = (tid >> 4) & 15; j2 = tid & 15; }
HD void geo3(int tid, int& h, int& blk) { h = tid >> 8; blk = tid & 255; }

HD int fbase1(int h, int j) { return h * FFT_HALF + j + (j >> 4); }
HD int fbase2(int h, int k1, int j2) { return h * FFT_HALF + 272 * k1 + j2; }
HD int fbase3(int h, int blk) { return h * FFT_HALF + 17 * blk; }
template <class L> HD void fwd_pass1(L lds, int b1, cf w4096j, cf (&x)[16]) {
    dft16<false>(x); twiddle16<false>(x, w4096j);
#pragma unroll
    for (int k = 0; k < 16; ++k) lds.st(b1 + 272 * k, x[k]);
}
template <class L> HD void fwd_pass2(L lds, int b2, cf w256j) {
    cf x[16];
#pragma unroll
    for (int m = 0; m < 16; ++m) x[m] = lds.ld(b2 + 17 * m);
    dft16<false>(x); twiddle16<false>(x, w256j);
#pragma unroll
    for (int k = 0; k < 16; ++k) lds.st(b2 + 17 * k, x[k]);
}
template <class L> HD void fwd_pass3_keep(L lds, int b3, cf (&x)[16]) {
#pragma unroll
    for (int m = 0; m < 16; ++m) x[m] = lds.ld(b3 + m);
    dft16<false>(x);
}
template <class L> HD void mid_pass3(L lds, int b3, const cf (&K)[16]) {
    cf x[16];
#pragma unroll
    for (int m = 0; m < 16; ++m) x[m] = lds.ld(b3 + m);
    dft16<false>(x);
#pragma unroll
    for (int k = 0; k < 16; ++k) x[k] = cmul(x[k], K[k]);
    dft16<true>(x);
#pragma unroll
    for (int m = 0; m < 16; ++m) lds.st(b3 + m, x[m]);
}
template <class L> HD void inv_pass2(L lds, int b2, cf w256j) {
    cf x[16];
#pragma unroll
    for (int k = 0; k < 16; ++k) x[k] = lds.ld(b2 + 17 * k);
    twiddle16<true>(x, w256j); dft16<true>(x);
#pragma unroll
    for (int m = 0; m < 16; ++m) lds.st(b2 + 17 * m, x[m]);
}
template <class L> HD void inv_pass1(L lds, int b1, cf w4096j, cf (&x)[16]) {
#pragma unroll
    for (int k = 0; k < 16; ++k) x[k] = lds.ld(b1 + 272 * k);
    twiddle16<true>(x, w4096j); dft16<true>(x);
}
#ifndef PG8_WGM
#define PG8_WGM 8
#endif
namespace pg8 {
#define PG8_LAS __attribute__((address_space(3)))
typedef unsigned short bf16_t;
typedef short bf16x8 __attribute__((ext_vector_type(8)));
typedef float f32x4 __attribute__((ext_vector_type(4)));
typedef unsigned u32x4 __attribute__((ext_vector_type(4)));
constexpr int BM = 256, BK = 64, HALF = 128, HTB = HALF * BK * 2  , STAGE_BYTES = 8 * HTB, NXCD = 8, WGM = PG8_WGM;

__host__ __device__ __forceinline__ int lds_byte(int r, int c) { const int st = (r >> 4) * 2 + (c >> 5), rr = r & 15, cc = c & 31, ob = rr * 64 + cc * 2; return st * 1024 + (ob ^ (((ob >> 9) & 1) << 5)); }
__host__ __device__ __forceinline__ void stage_rc(int b, int& R, int& C) { const int st = b / 1024, sb = b % 1024, swz = sb ^ (((sb >> 9) & 1) << 5); R = (st >> 1) * 16 + swz / 64; C = (st & 1) * 32 + (swz % 64) / 2; }
__host__ __device__ __forceinline__ int perm32(int rho) { const int n = rho >> 4, i = rho & 15; return 8 * (i >> 2) + 4 * n + (i & 3); }

typedef int v8i_t __attribute__((ext_vector_type(8))); typedef int v4i_t __attribute__((ext_vector_type(4)));
__device__ __forceinline__ v8i_t cat8(bf16x8 a, bf16x8 b) { const v4i_t x = __builtin_bit_cast(v4i_t, a), y = __builtin_bit_cast(v4i_t, b); return __builtin_shufflevector(x, y, 0, 1, 2, 3, 4, 5, 6, 7); }
struct Unit { int pm, pn; };
struct Gemm { const bf16_t* A; const bf16_t* Bt; int M, N, K; };

struct StaticOrder {
    int nM, nN, nwg, G, c;
    __host__ __device__ void init(int M, int N, int G_, int c_) { nM = M / BM; nN = N / BM; nwg = nM * nN; G = G_; c = c_; }
    __host__ __device__ bool next(int i, Unit& u) const {
        const long L = (long)i * G + c; if (L >= nwg) return false;
        int wgid = (int)L; { const int q = nwg / NXCD, r = nwg % NXCD, xcd = wgid % NXCD, off = wgid / NXCD; wgid = (xcd < r ? xcd * (q + 1) : r * (q + 1) + (xcd - r) * q) + off; }
        const int nig = WGM * nN, gid = wgid / nig, fm = gid * WGM, gsz = (nM - fm) < WGM ? (nM - fm) : WGM;
        u.pm = fm + ((wgid % nig) % gsz); u.pn = (wgid % nig) / gsz; return true;
    }
    __device__ __forceinline__ size_t boff(const Unit&) const { return 0; }
    __device__ __forceinline__ void a_ready(const Unit&) const {}
    __device__ __forceinline__ void done(const Unit&) const {}
};

__device__ __forceinline__ unsigned cvt_pk_bf16(float lo, float hi) { unsigned r; asm volatile("v_cvt_pk_bf16_f32 %0, %1, %2" : "=v"(r) : "v"(lo), "v"(hi)); return r; }
typedef float f32x2 __attribute__((ext_vector_type(2)));
typedef unsigned u32x2 __attribute__((ext_vector_type(2)));
__device__ __forceinline__ float row_rs(const float* ssp, int row, int fq) {
    if (!ssp) return 1.0f;
    const f32x4 q = *(const f32x4*)(ssp + (size_t)row * 16 + 4 * fq); float s = (q[0] + q[1]) + (q[2] + q[3]);
    s += __shfl_xor(s, 16); s += __shfl_xor(s, 32);
    return __builtin_amdgcn_rsqf(s * (1.0f / 1024.0f) + 1e-6f);
}
__device__ __forceinline__ void row_rs8(const float* ssp, int row0, int fq, float (&rs)[2][4]) {
    if (!ssp) {
#pragma unroll
        for (int ai = 0; ai < 2; ++ai)
#pragma unroll
            for (int m = 0; m < 4; ++m) rs[ai][m] = 1.0f;
        return; }
    f32x4 q[2][4];
#pragma unroll
    for (int ai = 0; ai < 2; ++ai)
#pragma unroll
        for (int m = 0; m < 4; ++m) q[ai][m] = *(const f32x4*)(ssp + (size_t)(row0 + ai * HALF + m * 16) * 16 + 4 * fq);
#pragma unroll
    for (int ai = 0; ai < 2; ++ai)
#pragma unroll
        for (int m = 0; m < 4; ++m) { float s = (q[ai][m][0] + q[ai][m][1]) + (q[ai][m][2] + q[ai][m][3]); s += __shfl_xor(s, 16); s += __shfl_xor(s, 32); rs[ai][m] = __builtin_amdgcn_rsqf(s * (1.0f / 1024.0f) + 1e-6f); }
}
__device__ __forceinline__ f32x4 row_rs4_swap(const float* ssp, int rowbase, int fr, int fq) {
    if (!ssp) return (f32x4){1.f, 1.f, 1.f, 1.f};
    const f32x4 q = *(const f32x4*)(ssp + (size_t)(rowbase + 4 * fq + (fr >> 2)) * 16 + 4 * (fr & 3)); float s = (q[0] + q[1]) + (q[2] + q[3]);
    s += __shfl_xor(s, 1); s += __shfl_xor(s, 2);
    const float rs = __builtin_amdgcn_rsqf(s * (1.0f / 1024.0f) + 1e-6f);
    f32x4 o;
#pragma unroll
    for (int r = 0; r < 4; ++r) o[r] = __shfl(rs, 16 * fq + 4 * r);
    return o;
}
template <bool F8 = false> struct EpiBf16T {
    static constexpr bool PERM = true, AFTER_DRAIN = false, SWAP = false, FP8 = F8;
    bf16_t* O; int ldc; const float* ss; float descale;
    __device__ __forceinline__ void operator()(const f32x4 (&acc)[2][2][4][2], const Unit& u, int wr, int wc, int fr, int fq) const {
        const int row0 = u.pm * BM + wr * 64 + fr, col0 = u.pn * BM + wc * 32 + 8 * fq;
        float rsa[2][4]; row_rs8(ss, row0, fq, rsa);
#pragma unroll
        for (int ai = 0; ai < 2; ++ai)
#pragma unroll
            for (int m = 0; m < 4; ++m) { bf16_t* rowp = O + (size_t)(row0 + ai * HALF + m * 16) * ldc + col0; const float rs = F8 ? rsa[ai][m] * descale : rsa[ai][m];
#pragma unroll
                for (int bj = 0; bj < 2; ++bj) { const f32x4 v0 = acc[ai][bj][m][0] * rs, v1 = acc[ai][bj][m][1] * rs;
                    u32x4 w; w.x = cvt_pk_bf16(v0[0], v0[1]); w.y = cvt_pk_bf16(v0[2], v0[3]); w.z = cvt_pk_bf16(v1[0], v1[1]); w.w = cvt_pk_bf16(v1[2], v1[3]);
                    *(u32x4*)(rowp + bj * HALF) = w; } }
    }
};
typedef EpiBf16T<false> EpiBf16;
struct EpiQKV {
    static constexpr bool PERM = true, AFTER_DRAIN = false, SWAP = false, FP8 = false;
    bf16_t* Q; bf16_t* Kb; bf16_t* Vb; const float* cosT; const float* sinT; const float* ss;
    __device__ __forceinline__ void operator()(const f32x4 (&acc)[2][2][4][2], const Unit& u, int wr, int wc, int fr, int fq) const {
        const int row0 = u.pm * BM + wr * 64 + fr;
        float rsa[2][4]; row_rs8(ss, row0, fq, rsa);
#pragma unroll
        for (int bj = 0; bj < 2; ++bj) {
            const int slot0 = u.pn * BM + bj * HALF + wc * 32 + 8 * fq;
            if (slot0 < 640) {
                const int head = slot0 >> 6, j4 = ((slot0 & 63) >> 3) * 4;
#pragma unroll
                for (int am = 0; am < 4; ++am) {
                    f32x4 c[2], sn[2];
                    const int tofs = ((row0 & 4095) + (am >> 1) * HALF + 2 * (am & 1) * 16) * 32 + j4;
                    const __attribute__((address_space(1))) float* cb = (const __attribute__((address_space(1))) float*)(cosT + tofs); const __attribute__((address_space(1))) float* sb = (const __attribute__((address_space(1))) float*)(sinT + tofs); asm volatile("" : "+v"(cb), "+v"(sb));
#pragma unroll
                    for (int h = 0; h < 2; ++h) { c[h] = *(const __attribute__((address_space(1))) f32x4*)(cb + h * 512); sn[h] = *(const __attribute__((address_space(1))) f32x4*)(sb + h * 512); }
#pragma unroll
                    for (int h = 0; h < 2; ++h) { const int ai = am >> 1, m = 2 * (am & 1) + h; const int row = row0 + ai * HALF + m * 16;
                        const float rs = rsa[ai][m]; const f32x4 lo = acc[ai][bj][m][0] * rs, hi = acc[ai][bj][m][1] * rs;
                        const f32x4 olo = lo * c[h] - hi * sn[h], ohi = hi * c[h] + lo * sn[h];
                        bf16_t* dst = head < 8 ? Q + (size_t)row * 512 + head * 64 + j4 : Kb + (size_t)row * 128 + (head - 8) * 64 + j4;
                        u32x2 w0, w1; w0.x = cvt_pk_bf16(olo[0], olo[1]); w0.y = cvt_pk_bf16(olo[2], olo[3]); w1.x = cvt_pk_bf16(ohi[0], ohi[1]); w1.y = cvt_pk_bf16(ohi[2], ohi[3]);
                        *(u32x2*)dst = w0; *(u32x2*)(dst + 32) = w1; } }
            } else {
#pragma unroll
                for (int ai = 0; ai < 2; ++ai)
#pragma unroll
                    for (int m = 0; m < 4; ++m) { const int row = row0 + ai * HALF + m * 16; const float rs = rsa[ai][m]; const f32x4 v0 = acc[ai][bj][m][0] * rs, v1 = acc[ai][bj][m][1] * rs;
                        u32x4 w; w.x = cvt_pk_bf16(v0[0], v0[1]); w.y = cvt_pk_bf16(v0[2], v0[3]); w.z = cvt_pk_bf16(v1[0], v1[1]); w.w = cvt_pk_bf16(v1[2], v1[3]);
                        *(u32x4*)(Vb + (size_t)row * 128 + (slot0 - 640)) = w; }
            }
        }
    }
};
struct EpiT {
    static constexpr bool PERM = false, AFTER_DRAIN = false, SWAP = true, FP8 = false;
    bf16_t* O; int nch; int ts_shift; const float* ss;
    __device__ __forceinline__ void operator()(const f32x4 (&acc)[2][2][4][2], const Unit& u, int wr, int wc, int fr, int fq) const {
        const int rowt = u.pm * BM, b = rowt >> ts_shift, tb = (rowt & ((1 << ts_shift) - 1)) + wr * 64 + 4 * fq;
#pragma unroll
        for (int ai = 0; ai < 2; ++ai) {
            f32x4 rsv[4];
#pragma unroll
            for (int m = 0; m < 4; ++m) rsv[m] = row_rs4_swap(ss, rowt + wr * 64 + ai * HALF + m * 16, fr, fq);
#pragma unroll
            for (int bj = 0; bj < 2; ++bj)
#pragma unroll
                for (int n = 0; n < 2; ++n) { const int ch = u.pn * BM + bj * HALF + wc * 32 + 16 * n + fr; bf16_t* chp = O + (((size_t)(b * nch + ch)) << ts_shift) + tb + ai * HALF;
#pragma unroll
                    for (int m = 0; m < 4; ++m) { const f32x4 v = acc[ai][bj][m][n] * rsv[m]; u32x2 w; w.x = cvt_pk_bf16(v[0], v[1]); w.y = cvt_pk_bf16(v[2], v[3]);
                        *(u32x2*)(chp + m * 16) = w; } } }
    }
};
struct EpiResB {
    static constexpr bool PERM = true, AFTER_DRAIN = false, SWAP = false, FP8 = false;
    bf16_t* xb; int ldc; float* ss; bf16_t* dst;
    __device__ __forceinline__ void operator()(const f32x4 (&acc)[2][2][4][2], const Unit& u, int wr, int wc, int fr, int fq) const {
        const int row0 = u.pm * BM + wr * 64 + fr, col0 = u.pn * BM + wc * 32 + 8 * fq;
#pragma unroll
        for (int ai = 0; ai < 2; ++ai) {
            u32x4 b[4][2];
#pragma unroll
            for (int m = 0; m < 4; ++m)
#pragma unroll
                for (int bj = 0; bj < 2; ++bj) b[m][bj] = *(const u32x4*)(xb + (size_t)(row0 + ai * HALF + m * 16) * ldc + col0 + bj * HALF);
#pragma unroll
            for (int m = 0; m < 4; ++m) { const int row = row0 + ai * HALF + m * 16; bf16_t* dstp = dst + (size_t)row * ldc + col0; float sq = 0.f;
#pragma unroll
                for (int bj = 0; bj < 2; ++bj) { const f32x4 a0 = acc[ai][bj][m][0], a1 = acc[ai][bj][m][1]; const u32x4 bb = b[m][bj]; float o[8];
                    o[0] = __builtin_bit_cast(float, bb.x << 16) + a0[0]; o[1] = __builtin_bit_cast(float, bb.x & 0xffff0000u) + a0[1];
                    o[2] = __builtin_bit_cast(float, bb.y << 16) + a0[2]; o[3] = __builtin_bit_cast(float, bb.y & 0xffff0000u) + a0[3];
                    o[4] = __builtin_bit_cast(float, bb.z << 16) + a1[0]; o[5] = __builtin_bit_cast(float, bb.z & 0xffff0000u) + a1[1];
                    o[6] = __builtin_bit_cast(float, bb.w << 16) + a1[2]; o[7] = __builtin_bit_cast(float, bb.w & 0xffff0000u) + a1[3];
#pragma unroll
                    for (int i = 0; i < 8; ++i) sq += o[i] * o[i];
                    u32x4 w; w.x = cvt_pk_bf16(o[0], o[1]); w.y = cvt_pk_bf16(o[2], o[3]); w.z = cvt_pk_bf16(o[4], o[5]); w.w = cvt_pk_bf16(o[6], o[7]);
                    *(u32x4*)(dstp + bj * HALF) = w; }
                if (ss) { sq += __shfl_xor(sq, 16); sq += __shfl_xor(sq, 32); if (fq == 0) ss[(size_t)row * 16 + u.pn * 4 + wc] = sq; } } }
    }
};
typedef float f32x2e __attribute__((ext_vector_type(2)));
__device__ __forceinline__ f32x2e silu_mul_pk(f32x2e g, f32x2e up) {
    const f32x2e t = g * (-1.44269504088896f); f32x2e e; e.x = __builtin_amdgcn_exp2f(t.x); e.y = __builtin_amdgcn_exp2f(t.y);
    const f32x2e d = e + 1.0f; f32x2e r; r.x = __builtin_amdgcn_rcpf(d.x); r.y = __builtin_amdgcn_rcpf(d.y);
    return (g * r) * up;
}
template <bool SCALE, bool F8 = false, bool F8OUT = false> struct EpiSwiglu {
    static constexpr bool PERM = true, AFTER_DRAIN = false, SWAP = false, FP8 = F8;
    bf16_t* O; int ldc; const float* ss;
    __device__ __forceinline__ void operator()(const f32x4 (&acc)[2][2][4][2], const Unit& u, int wr, int wc, int fr, int fq) const {
        const int row0 = u.pm * BM + wr * 64 + fr, col0 = u.pn * 128 + wc * 32 + 8 * fq;
        float rsa[2][4]; if (SCALE) row_rs8(ss, row0, fq, rsa);
#pragma unroll
        for (int ai = 0; ai < 2; ++ai)
#pragma unroll
            for (int m = 0; m < 4; ++m) { const int row = row0 + ai * HALF + m * 16; float sc = F8 ? 0.03125f : 1.0f; if (SCALE) sc *= rsa[ai][m];
                f32x2e o[4];
#pragma unroll
                for (int n = 0; n < 2; ++n) { f32x4 g = acc[ai][0][m][n], up = acc[ai][1][m][n]; if (SCALE || F8) { g = g * sc; up = up * sc; }
                    o[2 * n] = silu_mul_pk((f32x2e){g[0], g[1]}, (f32x2e){up[0], up[1]}); o[2 * n + 1] = silu_mul_pk((f32x2e){g[2], g[3]}, (f32x2e){up[2], up[3]}); }
                if (F8OUT) { int w0 = 0, w1 = 0; w0 = __builtin_amdgcn_cvt_pk_fp8_f32(o[0].x * 4.0f, o[0].y * 4.0f, w0, false); w0 = __builtin_amdgcn_cvt_pk_fp8_f32(o[1].x * 4.0f, o[1].y * 4.0f, w0, true);
                    w1 = __builtin_amdgcn_cvt_pk_fp8_f32(o[2].x * 4.0f, o[2].y * 4.0f, w1, false); w1 = __builtin_amdgcn_cvt_pk_fp8_f32(o[3].x * 4.0f, o[3].y * 4.0f, w1, true);
                    u32x2 w8; w8.x = (unsigned)w0; w8.y = (unsigned)w1; *(u32x2*)((unsigned char*)O + (size_t)row * ldc + col0) = w8; }
                else { u32x4 w; w.x = cvt_pk_bf16(o[0].x, o[0].y); w.y = cvt_pk_bf16(o[1].x, o[1].y); w.z = cvt_pk_bf16(o[2].x, o[2].y); w.w = cvt_pk_bf16(o[3].x, o[3].y);
                    *(u32x4*)(O + (size_t)row * ldc + col0) = w; } }
    }
};
template <class Epi, class Sched, bool ALIGN_EPI = false, bool SP2 = false>
__device__ __forceinline__ void gemm_phase(PG8_LAS unsigned char* lds, const Gemm g, const Sched& S, const Epi& E) {
    const int tid = opq_tid(), wid = __builtin_amdgcn_readfirstlane(tid >> 6), lane = tid & 63, wr = wid >> 2, wc = wid & 3, fr = lane & 15, fq = lane >> 4;
    const int K = g.K, nt = K / BK;
    unsigned voffA[2], voffB[2];
#pragma unroll
    for (int i = 0; i < 2; ++i) { int R, C; stage_rc(tid * 16 + i * 8192, R, C); const int Rb = Epi::PERM ? ((R & ~31) + perm32(R & 31)) : R;
        voffA[i] = (unsigned)(R * K + C) * 2u; voffB[i] = (unsigned)(Rb * K + C) * 2u; }
    const size_t kstep = (size_t)(BK * 2);
    const size_t hstep = (size_t)HALF * K * 2;
    const size_t tstep = 2 * hstep;
    const unsigned ldsw = (unsigned)wid * 1024u;
    const int aoff = lds_byte(wr * 64 + fr, fq * 8), boff = lds_byte(wc * 32 + fr, fq * 8);
#define PG8_SA(b, h) (((b) * 2 + (h)) * HTB)
#define PG8_SB(b, h) ((4 + (b) * 2 + (h)) * HTB)
#define PG8_STAGE(bufoff, gbase, voff) do { _Pragma("unroll") for (int _i = 0; _i < 2; ++_i) \
        __builtin_amdgcn_global_load_lds((const unsigned*)((const char*)(gbase) + (voff)[_i]), (PG8_LAS unsigned*)(lds + (bufoff) + ldsw + _i * 8192), 16, 0, 0); } while (0)
#define PG8_LDA(dst, b, h) do { if constexpr (Epi::FP8) { _Pragma("unroll") for (int m = 0; m < 4; ++m) dst##8[m] = cat8(*(const PG8_LAS bf16x8*)(lds + PG8_SA(b, h) + aoff + m * 2048), *(const PG8_LAS bf16x8*)(lds + PG8_SA(b, h) + aoff + m * 2048 + 1024)); } else { \
        _Pragma("unroll") for (int m = 0; m < 4; ++m) _Pragma("unroll") for (int k = 0; k < 2; ++k) dst[m][k] = *(const PG8_LAS bf16x8*)(lds + PG8_SA(b, h) + aoff + m * 2048 + k * 1024); } } while (0)
#define PG8_LDB(dst, b, h) do { if constexpr (Epi::FP8) { _Pragma("unroll") for (int n = 0; n < 2; ++n) dst##8[n] = cat8(*(const PG8_LAS bf16x8*)(lds + PG8_SB(b, h) + boff + n * 2048), *(const PG8_LAS bf16x8*)(lds + PG8_SB(b, h) + boff + n * 2048 + 1024)); } else { \
        _Pragma("unroll") for (int n = 0; n < 2; ++n) _Pragma("unroll") for (int k = 0; k < 2; ++k) dst[n][k] = *(const PG8_LAS bf16x8*)(lds + PG8_SB(b, h) + boff + n * 2048 + k * 1024); } } while (0)
#define PG8_MMA(ai, bj, At, Bt) do { __builtin_amdgcn_s_setprio(1); if constexpr (Epi::FP8) { _Pragma("unroll") for (int m = 0; m < 4; ++m) _Pragma("unroll") for (int n = 0; n < 2; ++n) \
        asm volatile("v_mfma_scale_f32_16x16x128_f8f6f4 %0, %1, %2, %0, %3, %3 op_sel_hi:[0,0,0]" : "+v"(acc[ai][bj][m][n]) : "v"(Bt##8[n]), "v"(At##8[m]), "v"(f8one)); } else { \
        _Pragma("unroll") for (int m = 0; m < 4; ++m) _Pragma("unroll") for (int n = 0; n < 2; ++n) _Pragma("unroll") for (int k = 0; k < 2; ++k) \
        acc[ai][bj][m][n] = Epi::SWAP ? __builtin_amdgcn_mfma_f32_16x16x32_bf16(At[m][k], Bt[n][k], acc[ai][bj][m][n], 0, 0, 0) : __builtin_amdgcn_mfma_f32_16x16x32_bf16(Bt[n][k], At[m][k], acc[ai][bj][m][n], 0, 0, 0); } __builtin_amdgcn_s_setprio(0); } while (0)
#define PG8_WAIT_V(n) asm volatile("s_waitcnt vmcnt(" #n ")" ::: "memory")
#define PG8_WAIT_L(n) asm volatile("s_waitcnt lgkmcnt(" #n ")" ::: "memory")
#define PG8_BAR __builtin_amdgcn_s_barrier()
#define PG8_SCHED __builtin_amdgcn_sched_barrier(0)
#ifdef DIAG
    unsigned long long dg_k = 0, dg_e = 0, dg_t1 = 0, dg_t2 = 0; const unsigned long long dg_t0 = wall_clock64();
#endif
    Unit cur, nxt; int ui = 0;
    if (!S.next(0, cur)) return;
    f32x4 acc[2][2][4][2];
#pragma unroll
    for (int a = 0; a < 2; ++a)
#pragma unroll
        for (int b = 0; b < 2; ++b)
#pragma unroll
            for (int m = 0; m < 4; ++m)
#pragma unroll
                for (int n = 0; n < 2; ++n) acc[a][b][m][n] = (f32x4){0.f, 0.f, 0.f, 0.f};
    bf16x8 At[4][2], B0[2][2], B1[2][2]; v8i_t At8[4], B08[2], B18[2];
    int f8one = 0x7F7F7F7F; asm volatile("" : "+v"(f8one));
    const char* cA = (const char*)g.A + (size_t)cur.pm * tstep; const char* cB = (const char*)g.Bt + S.boff(cur) + (size_t)cur.pn * tstep;
    S.a_ready(cur);
    if constexpr (SP2) {
        PG8_STAGE(PG8_SB(0, 0), cB, voffB); PG8_STAGE(PG8_SB(0, 1), cB + hstep, voffB); PG8_STAGE(PG8_SA(0, 0), cA, voffA); PG8_STAGE(PG8_SA(0, 1), cA + hstep, voffA);
        if (wr == 1) PG8_BAR;
        PG8_WAIT_V(2); PG8_BAR;
        PG8_STAGE(PG8_SB(1, 0), cB + kstep, voffB); PG8_STAGE(PG8_SA(1, 0), cA + kstep, voffA); PG8_STAGE(PG8_SB(1, 1), cB + hstep + kstep, voffB);
        PG8_WAIT_V(6); PG8_BAR;
    } else {
        PG8_STAGE(PG8_SB(0, 0), cB, voffB); PG8_STAGE(PG8_SA(0, 0), cA, voffA); PG8_STAGE(PG8_SB(0, 1), cB + hstep, voffB); PG8_STAGE(PG8_SA(0, 1), cA + hstep, voffA);
        if (wr == 1) PG8_BAR;
        PG8_WAIT_V(4); PG8_BAR;
        PG8_STAGE(PG8_SB(1, 0), cB + kstep, voffB); PG8_STAGE(PG8_SA(1, 0), cA + kstep, voffA); PG8_STAGE(PG8_SB(1, 1), cB + hstep + kstep, voffB);
        PG8_WAIT_V(6); PG8_BAR;
    }
    for (;;) {
        const bool has_next = S.next(ui + 1, nxt);
        const char* nA = has_next ? (const char*)g.A + (size_t)nxt.pm * tstep : cA; const char* nB = has_next ? (const char*)g.Bt + S.boff(nxt) + (size_t)nxt.pn * tstep : cB;
#ifdef DIAG
        dg_t1 = wall_clock64();
#endif
        CHAOS_POINT(4, 41);
        for (int t = 0; t < nt; t += 2) { CHAOS_POINT(8, 42);
            const bool last = (t == nt - 2);
            const char* a1 = cA + (size_t)(t + 1) * kstep;
            const char* a2 = last ? nA : cA + (size_t)(t + 2) * kstep; const char* b2 = last ? nB : cB + (size_t)(t + 2) * kstep;
            const char* a3 = a2 + kstep; const char* b3 = b2 + kstep;
            if (last && has_next) S.a_ready(nxt);
            if constexpr (SP2) {
            PG8_LDB(B0, 0, 0); PG8_LDB(B1, 0, 1); PG8_SCHED; PG8_LDA(At, 0, 0); PG8_STAGE(PG8_SA(1, 1), a1 + hstep, voffA);
            PG8_WAIT_V(8); PG8_WAIT_L(0); PG8_BAR; PG8_MMA(0, 0, At, B0); PG8_MMA(0, 1, At, B1); PG8_BAR; PG8_SCHED;
            PG8_LDA(At, 0, 1); PG8_STAGE(PG8_SB(0, 0), b2, voffB); PG8_STAGE(PG8_SB(0, 1), b2 + hstep, voffB); PG8_STAGE(PG8_SA(0, 0), a2, voffA);
            PG8_WAIT_V(8); PG8_WAIT_L(0); PG8_BAR; PG8_MMA(1, 0, At, B0); PG8_MMA(1, 1, At, B1); PG8_BAR; PG8_SCHED;
            PG8_LDB(B0, 1, 0); PG8_LDB(B1, 1, 1); PG8_SCHED; PG8_LDA(At, 1, 0); PG8_STAGE(PG8_SA(0, 1), a2 + hstep, voffA);
            PG8_WAIT_V(8); PG8_WAIT_L(0); PG8_BAR; PG8_MMA(0, 0, At, B0); PG8_MMA(0, 1, At, B1); PG8_BAR; PG8_SCHED;
            PG8_LDA(At, 1, 1); PG8_STAGE(PG8_SB(1, 0), b3, voffB); PG8_STAGE(PG8_SB(1, 1), b3 + hstep, voffB); PG8_STAGE(PG8_SA(1, 0), a3, voffA);
            PG8_WAIT_V(8); PG8_WAIT_L(0); PG8_BAR; PG8_MMA(1, 0, At, B0); PG8_MMA(1, 1, At, B1); PG8_BAR; PG8_SCHED;
            } else {
            PG8_LDB(B0, 0, 0); PG8_SCHED; PG8_LDA(At, 0, 0); PG8_STAGE(PG8_SA(1, 1), a1 + hstep, voffA);
            PG8_WAIT_L(8); PG8_BAR; PG8_WAIT_L(0); PG8_MMA(0, 0, At, B0); PG8_BAR; PG8_SCHED;
            PG8_LDB(B1, 0, 1); PG8_STAGE(PG8_SB(0, 0), b2, voffB);
            PG8_BAR; PG8_WAIT_L(0); PG8_MMA(0, 1, At, B1); PG8_BAR;
            PG8_LDA(At, 0, 1); PG8_STAGE(PG8_SA(0, 0), a2, voffA);
            PG8_BAR; PG8_WAIT_L(0); PG8_MMA(1, 0, At, B0); PG8_BAR; PG8_SCHED;
            PG8_STAGE(PG8_SB(0, 1), b2 + hstep, voffB);
            PG8_WAIT_V(6); PG8_BAR; PG8_MMA(1, 1, At, B1); PG8_BAR;
            PG8_LDB(B0, 1, 0); PG8_SCHED; PG8_LDA(At, 1, 0); PG8_STAGE(PG8_SA(0, 1), a2 + hstep, voffA);
            PG8_WAIT_L(8); PG8_BAR; PG8_WAIT_L(0); PG8_MMA(0, 0, At, B0); PG8_BAR; PG8_SCHED;
            PG8_LDB(B1, 1, 1); PG8_STAGE(PG8_SB(1, 0), b3, voffB);
            PG8_BAR; PG8_WAIT_L(0); PG8_MMA(0, 1, At, B1); PG8_BAR;
            PG8_LDA(At, 1, 1); PG8_STAGE(PG8_SA(1, 0), a3, voffA);
            PG8_BAR; PG8_WAIT_L(0); PG8_MMA(1, 0, At, B0); PG8_BAR; PG8_SCHED;
            PG8_STAGE(PG8_SB(1, 1), b3 + hstep, voffB);
            PG8_WAIT_V(6); PG8_BAR; PG8_MMA(1, 1, At, B1); PG8_BAR;
            }
        }
#ifdef DIAG
        dg_t2 = wall_clock64(); dg_k += dg_t2 - dg_t1;
#endif
        if constexpr (Epi::FP8) asm volatile("s_nop 15\n\ts_nop 15" ::: "memory");
        if constexpr (ALIGN_EPI) { if (wr == 0) PG8_BAR; }
#ifndef EPI_REP
#define EPI_REP 1
#endif
        CHAOS_POINT(4, 43);
        if constexpr (!Epi::AFTER_DRAIN) { _Pragma("unroll 1") for (int er_ = 0; er_ < EPI_REP; ++er_) E(acc, cur, wr, wc, fr, fq); S.done(cur); }
#ifdef DIAG
        dg_e += wall_clock64() - dg_t2;
#endif
        if (!has_next) break;
#pragma unroll
        for (int a = 0; a < 2; ++a)
#pragma unroll
            for (int b = 0; b < 2; ++b)
#pragma unroll
                for (int m = 0; m < 4; ++m)
#pragma unroll
                    for (int n = 0; n < 2; ++n) acc[a][b][m][n] = (f32x4){0.f, 0.f, 0.f, 0.f};
        cur = nxt; cA = nA; cB = nB; ++ui;
        if constexpr (ALIGN_EPI) { if (wr == 1) PG8_BAR; }
    }
#ifdef DIAG
    if (blockIdx.x == 0 && tid == 0) { unsigned long long* dg = (unsigned long long*)(*(const PG8_LAS unsigned long long*)(lds + 155712)); atomicAdd(dg + 0, dg_k); atomicAdd(dg + 1, dg_e); atomicAdd(dg + 2, wall_clock64() - dg_t0); atomicAdd(dg + 3, (unsigned long long)(ui + 1)); }
#endif
    PG8_WAIT_V(0);
    if constexpr (!ALIGN_EPI) { if (wr == 0) PG8_BAR; }
    PG8_BAR;
    if constexpr (Epi::AFTER_DRAIN) { E.fused(acc, cur, wr, wc, fr, fq, lds, wid, lane); S.done(cur); }
#undef PG8_SA
#undef PG8_SB
#undef PG8_STAGE
#undef PG8_LDA
#undef PG8_LDB
#undef PG8_MMA
#undef PG8_WAIT_V
#undef PG8_WAIT_L
#undef PG8_BAR
#undef PG8_SCHED
}
}
#ifndef PG8_SP2
#define PG8_SP2 true
#endif
#ifndef PG8_ALIGN
#define PG8_ALIGN true
#endif
constexpr int NB = 16, SEQ = 4096, D = 1024, M = NB * SEQ;
constexpr int NH = 8, NKV = 2, HDIM = 64, AW = 512, KVW = 128;
constexpr int HYW = 512, C3 = 1536, INC = 2304;
constexpr int XH = 4, XHD = 128, XW = 512, MEML = 256, MROWS = NB * MEML;
constexpr int FF = 2816, NE = 8, FFE = 3584;
constexpr float EPS = 1e-6f;
constexpr int NWAVES = 8, NTHR = 512;
constexpr int MOE_CH_TILES = 128, MOE_NCHUNK = 4, MOE_MAX_TILES = 520, MOE_MAX_ROWS = MOE_MAX_TILES * 256, MOE_ACT_TILES = MOE_MAX_TILES - (MOE_NCHUNK - 1) * MOE_CH_TILES;

constexpr size_t al256(size_t x) { return (x + 255) & ~(size_t)255; }
constexpr size_t WS_CTL = 0, CTL_ZERO_BYTES = 1u << 20;
constexpr size_t WS_SS = CTL_ZERO_BYTES, SS_STRIDE = (size_t)M * 16;
constexpr size_t WS_COS = WS_SS + 5 * SS_STRIDE * 4, WS_SIN = WS_COS + (size_t)SEQ * 32 * 4, WS_H2 = WS_SIN + (size_t)SEQ * 32 * 4;
constexpr size_t WS_TOKE = WS_H2 + (size_t)2 * SEQ * 64 * 4, WS_TOKW = WS_TOKE + (size_t)M * 2 * 4, WS_TOKP = WS_TOKW + (size_t)M * 2 * 4;
constexpr size_t WS_ROWTOK = WS_TOKP + (size_t)M * 2 * 4, WS_TILEE = WS_ROWTOK + al256((size_t)MOE_MAX_ROWS * 4), WS_WGCNT = WS_TILEE + 4096, WS_RSROW = WS_WGCNT + (size_t)1024 * 8 * 4, WS_META = WS_RSROW + (size_t)M * 4;
constexpr size_t WS_WINA = al256(WS_META + 4096);
constexpr size_t WS_WINB = WS_WINA + (size_t)2 * 768 * D * 2;
constexpr size_t WS_WOUT = WS_WINB + (size_t)2 * C3 * D * 2;
constexpr size_t WS_XQ = WS_WOUT + (size_t)2 * D * D * 2;
constexpr size_t WS_XK = WS_XQ + (size_t)2 * XW * D * 2;
constexpr size_t WS_XV = WS_XK + (size_t)2 * XW * D * 2;
constexpr size_t WS_XO = WS_XV + (size_t)2 * XW * D * 2;
constexpr size_t WS_FGU = WS_XO + (size_t)2 * D * XW * 2;
constexpr size_t WS_FDN = WS_FGU + (size_t)2 * FF * D * 2;
constexpr size_t WS_MGU = WS_FDN + (size_t)D * FF * 2;
constexpr size_t WS_MDN = WS_MGU + (size_t)NE * 2 * FFE * D;
constexpr size_t WS_KFILT = WS_MDN + (size_t)NE * D * FFE;
constexpr size_t WS_MB = WS_KFILT + (size_t)2 * 2 * HYW * 8192 * 4;
constexpr size_t WS_KMEM = WS_MB + (size_t)MROWS * D * 2;
constexpr size_t WS_VMEMT = WS_KMEM + (size_t)MROWS * 1024 * 2;
constexpr size_t WS_HB = WS_VMEMT + (size_t)1024 * MROWS * 2;
constexpr size_t WS_R = WS_HB + (size_t)M * D * 2;
constexpr size_t WS_QB = WS_R, WS_KB = WS_QB + (size_t)M * AW * 2, WS_VB = WS_KB + (size_t)M * KVW * 2, WS_UT = WS_VB + (size_t)M * KVW * 2;
constexpr size_t WS_MIXED = WS_UT;
constexpr size_t WS_AB = WS_UT + (size_t)M * C3 * 2, WS_YT = WS_AB + (size_t)M * AW * 2, WS_KSPEC = WS_YT + (size_t)M * HYW * 2, WS_MIXEND = WS_KSPEC + (size_t)2 * 2 * HYW * 16384 * 4;
constexpr size_t WS_XQB = WS_R, WS_XOB = WS_XQB + (size_t)M * XW * 2;
constexpr size_t WS_ACT = WS_R;
constexpr size_t WS_XG = WS_R;
constexpr size_t WS_MACT = WS_XG + (size_t)MOE_MAX_ROWS * D;
constexpr size_t WS_YB = WS_MACT + (size_t)MOE_ACT_TILES * 256 * FFE;
constexpr size_t WS_MOEEND = WS_YB + (size_t)MOE_MAX_ROWS * D * 2;
constexpr size_t cmax(size_t a, size_t b) { return a > b ? a : b; }
constexpr size_t WS_END = cmax(cmax(WS_MIXEND, WS_ACT + (size_t)M * FF * 2), WS_MOEEND);
static_assert(WS_END <= (size_t)1073741824, "workspace map exceeds 1 GiB");
static_assert(WS_ACT + (size_t)M * FF * 2 <= WS_KSPEC && WS_XOB + (size_t)M * XW * 2 <= WS_KSPEC, "layer 0's later phases must not touch the filter spectra");
constexpr int CW_TMO = 0, CW_CODE = 1, CW_BAR = 4096;

constexpr int PHASE_LDS = 155648;
constexpr int LDSCTL_OFF = PHASE_LDS, MISC_OFF = LDSCTL_OFF + 64;
constexpr int LDS_BYTES = PHASE_LDS + 512;

#define GAS __attribute__((address_space(1)))
#define LAS __attribute__((address_space(3)))
typedef unsigned short bf16;
typedef unsigned v4u __attribute__((ext_vector_type(4)));
typedef unsigned v2u __attribute__((ext_vector_type(2)));
typedef float f32x4 __attribute__((ext_vector_type(4)));
typedef short bf16x8 __attribute__((ext_vector_type(8)));
typedef short s16x4 __attribute__((ext_vector_type(4)));
typedef GAS unsigned gu32;
#define RLX_AGENT __ATOMIC_RELAXED, __HIP_MEMORY_SCOPE_AGENT
#define LDS_WAIT() asm volatile("s_waitcnt lgkmcnt(0)" ::: "memory")
#define VM_WAIT() asm volatile("s_waitcnt vmcnt(0)" ::: "memory")
__device__ __forceinline__ unsigned f2bf(float f) { unsigned u = __builtin_bit_cast(unsigned, f); return (u + 0x7fffu + ((u >> 16) & 1u)) >> 16; }
__device__ __forceinline__ unsigned pk2(float lo, float hi) { return cvtpk_hw(lo, hi); }
__device__ __forceinline__ float bflo(unsigned w) { return __builtin_bit_cast(float, w << 16); }
__device__ __forceinline__ float bfhi(unsigned w) { return __builtin_bit_cast(float, w & 0xffff0000u); }
__device__ __forceinline__ float bf1(unsigned short h) { return __builtin_bit_cast(float, ((unsigned)h) << 16); }
#define XB_TMO      128
#define XB_XCNT(j)  (256  + 64 * (j))
#define XB_XSUB(j)  (1280 + 64 * (j))
#define XB_XGEN(j)  (2304 + 64 * (j))
#define XB_TOP      3328
#define XB_TOPGEN   3392
#define XCD_BAR_WORDS 3456
#define XB_SPIN_CAP (1u << 22)

__device__ __forceinline__ unsigned xb_ld(unsigned* p)              { return __hip_atomic_load(p, __ATOMIC_RELAXED, __HIP_MEMORY_SCOPE_AGENT); }
__device__ __forceinline__ unsigned xb_add(unsigned* p, unsigned v) { return __hip_atomic_fetch_add(p, v, __ATOMIC_RELAXED, __HIP_MEMORY_SCOPE_AGENT); }
__device__ __forceinline__ unsigned xb_xcc_id() { return (unsigned)__builtin_amdgcn_s_getreg((3 << 11) | 20) & 0xFu; }
#define XB_SPIN(cond, bar) do { unsigned _sp = 0; while (cond) { __builtin_amdgcn_s_sleep(1); \
    if ((++_sp & 255u) == 0u) { if (xb_ld(&(bar)[XB_TMO])) break; if (_sp > XB_SPIN_CAP) { atomicAdd(&(bar)[XB_TMO], 1u); break; } } } } while (0)

struct XcdBarrier {
    unsigned* bar; unsigned x;
    volatile LAS unsigned* st;
};

__device__ __forceinline__ XcdBarrier xcd_barrier_post(unsigned* bar, volatile LAS unsigned* st) {
    XcdBarrier b; b.bar = bar; b.x = xb_xcc_id(); b.st = st;
    if (threadIdx.x == 0) (void)xb_add(&bar[XB_XCNT(b.x)], 1u);
    return b;
}
__device__ __forceinline__ void xcd_barrier_complete(unsigned* bar, unsigned x, unsigned& nloc, unsigned& nx) {
    const unsigned G = gridDim.x * gridDim.y * gridDim.z;
    unsigned sum, cnt, mine, sp = 0u;
    for (;;) {
        sum = 0u; cnt = 0u; mine = 0u;
#pragma unroll
        for (unsigned j = 0; j < 16; ++j) { const unsigned c = xb_ld(&bar[XB_XCNT(j)]); sum += c; cnt += (c > 0u) ? 1u : 0u; mine = (j == x) ? c : mine; }
        if (sum == G) break;
        __builtin_amdgcn_s_sleep(1);
        if ((++sp & 255u) == 0u) { if (xb_ld(&bar[XB_TMO])) break; if (sp > XB_SPIN_CAP) { atomicAdd(&bar[XB_TMO], 1u); break; } }
    }
    nloc = mine > 0u ? mine : 1u; nx = cnt > 0u ? cnt : 1u;
}

__device__ __forceinline__ void xcd_barrier(const XcdBarrier& b) {
    asm volatile("s_waitcnt vmcnt(0)" ::: "memory");
    __syncthreads();
    if (threadIdx.x == 0) {
        unsigned* bar = b.bar;
        __builtin_amdgcn_s_waitcnt(0);
        unsigned nloc = b.st[0], nx = b.st[1];
        if (nloc == 0u) { xcd_barrier_complete(bar, b.x, nloc, nx); b.st[0] = nloc; b.st[1] = nx; }
        const unsigned old = xb_add(&bar[XB_XSUB(b.x)], 1u);
        const unsigned gen = old / nloc;
        if (old + 1u == (gen + 1u) * nloc) {
            __builtin_amdgcn_fence(__ATOMIC_RELEASE, "agent");
            asm volatile("s_waitcnt vmcnt(0)" ::: "memory");
            const unsigned og = xb_add(&bar[XB_TOP], 1u);
            const unsigned tg = og / nx;
            if (og + 1u == (tg + 1u) * nx) xb_add(&bar[XB_TOPGEN], 1u);
            else XB_SPIN(xb_ld(&bar[XB_TOPGEN]) == tg, bar);
            __builtin_amdgcn_fence(__ATOMIC_ACQUIRE, "agent");
            xb_add(&bar[XB_XGEN(b.x)], 1u);
            asm volatile("s_waitcnt vmcnt(0)" ::: "memory");
        } else {
            XB_SPIN(xb_ld(&bar[XB_XGEN(b.x)]) == gen, bar);
            __builtin_amdgcn_fence(__ATOMIC_ACQUIRE, "agent");
            asm volatile("s_waitcnt vmcnt(0)" ::: "memory");
        }
    }
    __syncthreads();
}
struct Args { const float* in[33]; float* out; unsigned char* ws; int ph_lo, ph_hi, use_bar, pad; };
enum InIdx { I_X = 0, I_MEM, I_MEMNORM, I_MIXNORM, I_WIN, I_SINK, I_CONVW, I_CONVB, I_FW1, I_FB1, I_FFR1, I_FW2, I_FB2, I_FFR2, I_FW3, I_SKIP, I_ANORM, I_YNORM, I_WOUT, I_XNORM,
             I_XWQ, I_XWK, I_XWV, I_XWO, I_FNORM, I_FGATE, I_FUP, I_FDOWN, I_ROUTER, I_MGATE, I_MUP, I_MDOWN, I_FINAL };

__device__ __forceinline__ float wave_sum(float v) {
#pragma unroll
    for (int o = 1; o < 64; o <<= 1) v += __shfl_xor(v, o);
    return v;
}
__device__ __forceinline__ void wg_sync() { __builtin_amdgcn_sched_barrier(0); asm volatile("s_waitcnt vmcnt(0) lgkmcnt(0)" ::: "memory"); __builtin_amdgcn_s_barrier(); asm volatile("" ::: "memory"); __builtin_amdgcn_sched_barrier(0); }

template <int MODE> __device__ __forceinline__ int rowmap(int n) {
    if (MODE == 1) return n < 640 ? ((n & ~63) + 8 * ((n & 31) >> 2) + (n & 3) + 4 * ((n >> 5) & 1)) : n;
    if (MODE == 2) return ((n >> 7) << 8) + (n & 127);
    if (MODE == 3) return ((n >> 7) << 8) + 128 + (n & 127);
    return n;
}
__device__ __forceinline__ int rowmap_rt(int mode, int n) { return mode == 1 ? rowmap<1>(n) : mode == 2 ? rowmap<2>(n) : mode == 3 ? rowmap<3>(n) : n; }
__device__ __forceinline__ void tr_item(const float* W, int ldw, int K, int col0, int ncols, bf16* WT, int mode, const float* gk, int item, LAS float* scr, int lane) {
    const int nblk = ncols / 32, kb = item / nblk, nb = item % nblk, k0 = 64 * kb, n0 = 32 * nb;
    f32x4 tv[8];
#pragma unroll
    for (int i = 0; i < 8; ++i) { const int kk = 8 * i + (lane >> 3); tv[i] = *(const f32x4*)(W + (size_t)(k0 + kk) * ldw + col0 + n0 + 4 * (lane & 7)); }
#pragma unroll
    for (int i = 0; i < 8; ++i) { const int kk = 8 * i + (lane >> 3); const float gv = gk ? gk[k0 + kk] : 1.0f; LAS float* d = scr + kk * 33 + 4 * (lane & 7);
        d[0] = gv * tv[i][0]; d[1] = gv * tv[i][1]; d[2] = gv * tv[i][2]; d[3] = gv * tv[i][3]; }
    LDS_WAIT(); asm volatile("" ::: "memory");
    const int c = lane & 7;
#pragma unroll
    for (int j = 0; j < 4; ++j) { const int n = (lane >> 3) + 8 * j; const LAS float* sp = scr + (8 * c) * 33 + n;
        v4u o; o.x = pk2(sp[0 * 33], sp[1 * 33]); o.y = pk2(sp[2 * 33], sp[3 * 33]); o.z = pk2(sp[4 * 33], sp[5 * 33]); o.w = pk2(sp[6 * 33], sp[7 * 33]);
        *(v4u*)(WT + (size_t)rowmap_rt(mode, n0 + n) * K + k0 + 8 * c) = o; }
    LDS_WAIT(); asm volatile("" ::: "memory");
}
__device__ __forceinline__ void tr_item8(const float* W, int ldw, int K, int ncols, unsigned char* WT8, int mode, float wscale, int item, LAS float* scr, int lane) {
    const int nblk = ncols / 32, kb = item / nblk, nb = item % nblk, k0 = 64 * kb, n0 = 32 * nb;
    f32x4 tv[8];
#pragma unroll
    for (int i = 0; i < 8; ++i) { const int kk = 8 * i + (lane >> 3); tv[i] = *(const f32x4*)(W + (size_t)(k0 + kk) * ldw + n0 + 4 * (lane & 7)); }
#pragma unroll
    for (int i = 0; i < 8; ++i) { const int kk = 8 * i + (lane >> 3); LAS float* d = scr + kk * 33 + 4 * (lane & 7);
        d[0] = wscale * tv[i][0]; d[1] = wscale * tv[i][1]; d[2] = wscale * tv[i][2]; d[3] = wscale * tv[i][3]; }
    LDS_WAIT(); asm volatile("" ::: "memory");
    const int n = lane >> 1, half = lane & 1; const LAS float* sp = scr + (32 * half) * 33 + n;
    v4u o[2];
#pragma unroll
    for (int q = 0; q < 8; ++q) { int w = 0;
        w = __builtin_amdgcn_cvt_pk_fp8_f32(sp[(4 * q + 0) * 33], sp[(4 * q + 1) * 33], w, false);
        w = __builtin_amdgcn_cvt_pk_fp8_f32(sp[(4 * q + 2) * 33], sp[(4 * q + 3) * 33], w, true);
        o[q >> 2][q & 3] = (unsigned)w; }
    v4u* dst = (v4u*)(WT8 + (size_t)rowmap_rt(mode, n0 + n) * K + k0 + 32 * half);
    dst[0] = o[0]; dst[1] = o[1];
    LDS_WAIT(); asm volatile("" ::: "memory");
}
__device__ __forceinline__ void rms_row(const float* xrow, const float* gain, int lane, f32x4 (&v)[4]) {
    const f32x4* xr = (const f32x4*)xrow + lane; float s = 0.f;
#pragma unroll
    for (int j = 0; j < 4; ++j) { v[j] = xr[64 * j]; s += (v[j].x * v[j].x + v[j].y * v[j].y) + (v[j].z * v[j].z + v[j].w * v[j].w); }
    const float rs = 1.0f / sqrtf(wave_sum(s) * (1.f / 1024.f) + EPS);
    const f32x4* gr = (const f32x4*)gain + lane;
#pragma unroll
    for (int j = 0; j < 4; ++j) v[j] = v[j] * rs * gr[64 * j];
}
__device__ __forceinline__ void store_row_bf16(bf16* orow, int lane, const f32x4 (&v)[4]) {
    unsigned long long* o8 = (unsigned long long*)orow + lane;
#pragma unroll
    for (int j = 0; j < 4; ++j) o8[64 * j] = (unsigned long long)pk2(v[j].x, v[j].y) | ((unsigned long long)pk2(v[j].z, v[j].w) << 32);
}
__device__ __forceinline__ void xb_rows(const float* x, bf16* o, float* ss, int nrows, int gw, int NGW, int lane) {
#pragma unroll 1
    for (int r0 = gw; r0 < nrows; r0 += 2 * NGW) {
        const int r1 = r0 + NGW; const bool on1 = r1 < nrows; const int r1c = on1 ? r1 : r0;
        const f32x4* xa = (const f32x4*)(x + (size_t)r0 * D) + lane; const f32x4* xc = (const f32x4*)(x + (size_t)r1c * D) + lane; f32x4 va[4], vc[4];
#pragma unroll
        for (int j = 0; j < 4; ++j) { va[j] = xa[64 * j]; vc[j] = xc[64 * j]; }
        float sa = 0.f, sc = 0.f;
#pragma unroll
        for (int j = 0; j < 4; ++j) { sa += (va[j].x * va[j].x + va[j].y * va[j].y) + (va[j].z * va[j].z + va[j].w * va[j].w); sc += (vc[j].x * vc[j].x + vc[j].y * vc[j].y) + (vc[j].z * vc[j].z + vc[j].w * vc[j].w); }
        sa = wave_sum(sa); sc = wave_sum(sc);
        store_row_bf16(o + (size_t)r0 * D, lane, va); if (lane < 16) ss[(size_t)r0 * 16 + lane] = lane == 0 ? sa : 0.f;
        if (on1) { store_row_bf16(o + (size_t)r1 * D, lane, vc); if (lane < 16) ss[(size_t)r1 * 16 + lane] = lane == 0 ? sc : 0.f; }
    }
}
__device__ __forceinline__ void norm_rows(const float* x, const float* gain, bf16* o, int nrows, int gw, int NGW, int lane) {
    for (int r = gw; r < nrows; r += NGW) { f32x4 v[4]; rms_row(x + (size_t)r * D, gain, lane, v); store_row_bf16(o + (size_t)r * D, lane, v); }
}

constexpr int BA_KS = 72, BA_VS = 408, BA_KROWS = 400;
constexpr int BA_K_BYTES = BA_KROWS * BA_KS * 2, BA_V_BYTES = 64 * BA_VS * 2;
static_assert(BA_K_BYTES % 16 == 0 && BA_K_BYTES + BA_V_BYTES <= PHASE_LDS, "band attention LDS");
__device__ __forceinline__ bf16x8 cat4(s16x4 a, s16x4 b) { return __builtin_shufflevector(a, b, 0, 1, 2, 3, 4, 5, 6, 7); }
__device__ __forceinline__ unsigned cvtpk(float lo, float hi) { unsigned r; asm volatile("v_cvt_pk_bf16_f32 %0, %1, %2" : "=v"(r) : "v"(lo), "v"(hi)); return r; }

__device__ __forceinline__ void band_attention_phase(LAS unsigned char* lds, const bf16* Q, const bf16* Kb, const bf16* Vb, bf16* Ao, const float* sink, int G) {
    const int tid = opq_tid(), lane = tid & 63, wave = __builtin_amdgcn_readfirstlane(tid >> 6), fr = lane & 15, fq = lane >> 4;
    LAS bf16* Ks = (LAS bf16*)lds; LAS bf16* VTs = (LAS bf16*)(lds + BA_K_BYTES);
#ifdef DIAG
    unsigned long long ba_s = 0, ba_c = 0, ba_l = wall_clock64();
#define BAT(v) do { const unsigned long long n_ = wall_clock64(); v += n_ - ba_l; ba_l = n_; } while (0)
#else
#define BAT(v) do {} while (0)
#endif
    for (int unit = blockIdx.x; unit < NB * 32 * NKV; unit += G) {
        const int kh = unit & 1, ib = (unit >> 1) & 31, b = unit >> 6;
        const int kbase = 128 * (ib - 1);
        for (int c = tid; c < BA_KROWS * 8; c += NTHR) { const int row = c >> 3, c8 = c & 7, kpos = kbase + row;
            v4u val = (v4u){0u, 0u, 0u, 0u};
            if (row < 384 && kpos >= 0 && kpos < SEQ) val = *(const v4u*)(Kb + ((size_t)(b * SEQ + kpos)) * KVW + kh * 64 + c8 * 8);
            *(LAS v4u*)(Ks + row * BA_KS + c8 * 8) = val; }
        for (int c = tid; c < BA_KROWS * 8; c += NTHR) { const int c8 = c / BA_KROWS, key = c % BA_KROWS, kpos = kbase + key;
            v4u val = (v4u){0u, 0u, 0u, 0u};
            if (key < 384 && kpos >= 0 && kpos < SEQ) val = *(const v4u*)(Vb + ((size_t)(b * SEQ + kpos)) * KVW + kh * 64 + c8 * 8);
            LAS bf16* dst = VTs + (c8 * 8) * BA_VS + key;
            dst[0 * BA_VS] = (bf16)(val.x & 0xffffu); dst[1 * BA_VS] = (bf16)(val.x >> 16); dst[2 * BA_VS] = (bf16)(val.y & 0xffffu); dst[3 * BA_VS] = (bf16)(val.y >> 16);
            dst[4 * BA_VS] = (bf16)(val.z & 0xffffu); dst[5 * BA_VS] = (bf16)(val.z >> 16); dst[6 * BA_VS] = (bf16)(val.w & 0xffffu); dst[7 * BA_VS] = (bf16)(val.w >> 16); }
        wg_sync(); BAT(ba_s); CHAOS_POINT(2, 32);
        const int g = wave >> 1, half = wave & 1, head = kh * 4 + g;
        const float snk = sink[head];
        bf16x8 qn[2];
        { const size_t t0 = (size_t)b * SEQ + 128 * ib + 64 * half;
#pragma unroll
          for (int ks = 0; ks < 2; ++ks) qn[ks] = *(const bf16x8*)(Q + (t0 + fr) * AW + head * 64 + 32 * ks + 8 * fq); }
#pragma unroll 1
        for (int qt = 0; qt < 4; ++qt) { CHAOS_POINT(2, 31);
            const int p0 = 64 * half + 16 * qt;
            const size_t t0 = (size_t)b * SEQ + 128 * ib + p0;
            bf16x8 qf[2]; qf[0] = qn[0]; qf[1] = qn[1];
            if (qt < 3) {
#pragma unroll
                for (int ks = 0; ks < 2; ++ks) qn[ks] = *(const bf16x8*)(Q + (t0 + 16 + fr) * AW + head * 64 + 32 * ks + 8 * fq); }
            f32x4 s[18];
            const LAS bf16* kbase_p = Ks + (p0 + fr) * BA_KS + 8 * fq;
            bf16x8 kfa[3][2], kfb[3][2];
#pragma unroll
            for (int jj = 0; jj < 3; ++jj)
#pragma unroll
                for (int ks = 0; ks < 2; ++ks) kfa[jj][ks] = *(const LAS bf16x8*)(kbase_p + (16 * jj) * BA_KS + 32 * ks);
#pragma unroll
            for (int gq = 0; gq < 6; ++gq) {
                if (gq < 5) {
#pragma unroll
                    for (int jj = 0; jj < 3; ++jj)
#pragma unroll
                        for (int ks = 0; ks < 2; ++ks) { const bf16x8 t = *(const LAS bf16x8*)(kbase_p + (16 * (3 * (gq + 1) + jj)) * BA_KS + 32 * ks); if (gq & 1) kfa[jj][ks] = t; else kfb[jj][ks] = t; } }
                __builtin_amdgcn_sched_barrier(0);
#pragma unroll
                for (int jj = 0; jj < 3; ++jj) { const int j = 3 * gq + jj; s[j] = (f32x4){0.f, 0.f, 0.f, 0.f};
#pragma unroll
                    for (int ks = 0; ks < 2; ++ks) s[j] = __builtin_amdgcn_mfma_f32_16x16x32_bf16((gq & 1) ? kfb[jj][ks] : kfa[jj][ks], qf[ks], s[j], 0, 0, 0); }
                __builtin_amdgcn_sched_barrier(0);
            }
            float mx = -1e30f;
#pragma unroll
            for (int j = 0; j < 18; ++j)
#pragma unroll
                for (int r = 0; r < 4; ++r) { const int rel = 16 * j + 4 * fq + r - fr, idx = p0 + 16 * j + 4 * fq + r;
                    const bool ok = rel >= 0 && rel <= 256 && (ib > 0 || idx >= 128) && (ib < 31 || idx < 256);
                    const float v = ok ? s[j][r] * 0.125f : -1e30f; s[j][r] = v; mx = fmaxf(mx, v); }
            mx = fmaxf(mx, __shfl_xor(mx, 16)); mx = fmaxf(mx, __shfl_xor(mx, 32)); mx = fmaxf(mx, snk);
            float l = 0.f;
#pragma unroll
            for (int j = 0; j < 18; ++j)
#pragma unroll
                for (int r = 0; r < 4; ++r) { const float p = __expf(s[j][r] - mx); s[j][r] = p; l += p; }
            l += __shfl_xor(l, 16); l += __shfl_xor(l, 32); l += __expf(snk - mx);
            const float inv = 1.0f / l;
            f32x4 o[4];
#pragma unroll
            for (int dt = 0; dt < 4; ++dt) o[dt] = (f32x4){0.f, 0.f, 0.f, 0.f};
            const LAS bf16* vbase_p = VTs + fr * BA_VS + p0 + 4 * fq;
            s16x4 va[4][2], vb[4][2];
#pragma unroll
            for (int dt = 0; dt < 4; ++dt) { va[dt][0] = *(const LAS s16x4*)(vbase_p + (16 * dt) * BA_VS); va[dt][1] = *(const LAS s16x4*)(vbase_p + (16 * dt) * BA_VS + 16); }
#pragma unroll
            for (int kk = 0; kk < 9; ++kk) {
                if (kk < 8) {
#pragma unroll
                    for (int dt = 0; dt < 4; ++dt) { const s16x4 t0_ = *(const LAS s16x4*)(vbase_p + (16 * dt) * BA_VS + 32 * (kk + 1)), t1_ = *(const LAS s16x4*)(vbase_p + (16 * dt) * BA_VS + 32 * (kk + 1) + 16);
                        if (kk & 1) { va[dt][0] = t0_; va[dt][1] = t1_; } else { vb[dt][0] = t0_; vb[dt][1] = t1_; } } }
                v4u pw; pw.x = cvtpk(s[2 * kk][0], s[2 * kk][1]); pw.y = cvtpk(s[2 * kk][2], s[2 * kk][3]); pw.z = cvtpk(s[2 * kk + 1][0], s[2 * kk + 1][1]); pw.w = cvtpk(s[2 * kk + 1][2], s[2 * kk + 1][3]);
                const bf16x8 pf = __builtin_bit_cast(bf16x8, pw);
                __builtin_amdgcn_sched_barrier(0);
#pragma unroll
                for (int dt = 0; dt < 4; ++dt) { const bf16x8 vf = (kk & 1) ? cat4(vb[dt][0], vb[dt][1]) : cat4(va[dt][0], va[dt][1]);
                    o[dt] = __builtin_amdgcn_mfma_f32_16x16x32_bf16(vf, pf, o[dt], 0, 0, 0); }
                __builtin_amdgcn_sched_barrier(0);
            }
#pragma unroll
            for (int dt = 0; dt < 4; ++dt) { const f32x4 ov = o[dt] * inv; v2u w; w.x = cvtpk(ov[0], ov[1]); w.y = cvtpk(ov[2], ov[3]);
                *(v2u*)(Ao + (t0 + fr) * AW + head * 64 + 16 * dt + 4 * fq) = w; }
        }
        wg_sync(); BAT(ba_c); CHAOS_POINT(2, 32);
    }
#ifdef DIAG
    if (blockIdx.x == 0 && tid == 0) { unsigned long long* dg = (unsigned long long*)(*(const LAS unsigned long long*)(lds + 155712)); atomicAdd(dg + 28, ba_s); atomicAdd(dg + 29, ba_c); }
#endif
}

constexpr int XA_KS = 136, XA_VS = 264;
constexpr int XA_K_BYTES = MEML * XA_KS * 2, XA_V_BYTES = XHD * XA_VS * 2;
static_assert(XA_K_BYTES % 16 == 0 && XA_K_BYTES + XA_V_BYTES <= PHASE_LDS, "cross attention LDS");
__device__ __forceinline__ void cross_attention_phase(LAS unsigned char* lds, const bf16* Qx, const bf16* Kmem, const bf16* VmemT, bf16* Ox, int layer, int G) {
    const int tid = opq_tid(), lane = tid & 63, wave = __builtin_amdgcn_readfirstlane(tid >> 6), fr = lane & 15, fq = lane >> 4;
    LAS bf16* Ks = (LAS bf16*)lds; LAS bf16* VTs = (LAS bf16*)(lds + XA_K_BYTES);
    for (int unit = blockIdx.x; unit < 256; unit += G) {
        const int quarter = unit & 3, head = (unit >> 2) & 3, b = unit >> 4;
        for (int c = tid; c < MEML * 16; c += NTHR) { const int key = c >> 4, c8 = c & 15;
            *(LAS v4u*)(Ks + key * XA_KS + c8 * 8) = *(const v4u*)(Kmem + (size_t)(b * MEML + key) * 1024 + layer * 512 + head * 128 + c8 * 8); }
        for (int c = tid; c < XHD * 32; c += NTHR) { const int d = c >> 5, c8 = c & 31;
            *(LAS v4u*)(VTs + d * XA_VS + c8 * 8) = *(const v4u*)(VmemT + (size_t)(layer * 512 + head * 128 + d) * MROWS + b * MEML + c8 * 8); }
        wg_sync(); CHAOS_POINT(2, 32);
        bf16x8 qn[4];
        { const size_t t0 = (size_t)b * SEQ + (quarter * 4) * 256 + wave * 32;
#pragma unroll
          for (int ks = 0; ks < 4; ++ks) qn[ks] = *(const bf16x8*)(Qx + (t0 + fr) * XW + head * 128 + 32 * ks + 8 * fq); }
#pragma unroll 1
        for (int qi = 0; qi < 8; ++qi) {
            const size_t t0 = (size_t)b * SEQ + (quarter * 4 + (qi >> 1)) * 256 + wave * 32 + 16 * (qi & 1);
            bf16x8 qf[4];
#pragma unroll
            for (int ks = 0; ks < 4; ++ks) qf[ks] = qn[ks];
            if (qi < 7) { const size_t t1 = (size_t)b * SEQ + (quarter * 4 + ((qi + 1) >> 1)) * 256 + wave * 32 + 16 * ((qi + 1) & 1);
#pragma unroll
                for (int ks = 0; ks < 4; ++ks) qn[ks] = *(const bf16x8*)(Qx + (t1 + fr) * XW + head * 128 + 32 * ks + 8 * fq); }
            f32x4 s[16];
            const LAS bf16* kbase_p = Ks + fr * XA_KS + 8 * fq;
            bf16x8 kfa[2][4], kfb[2][4];
#pragma unroll
            for (int jj = 0; jj < 2; ++jj)
#pragma unroll
                for (int ks = 0; ks < 4; ++ks) kfa[jj][ks] = *(const LAS bf16x8*)(kbase_p + (16 * jj) * XA_KS + 32 * ks);
#pragma unroll
            for (int gq = 0; gq < 8; ++gq) {
                if (gq < 7) {
#pragma unroll
                    for (int jj = 0; jj < 2; ++jj)
#pragma unroll
                        for (int ks = 0; ks < 4; ++ks) { const bf16x8 t = *(const LAS bf16x8*)(kbase_p + (16 * (2 * (gq + 1) + jj)) * XA_KS + 32 * ks); if (gq & 1) kfa[jj][ks] = t; else kfb[jj][ks] = t; } }
                __builtin_amdgcn_sched_barrier(0);
#pragma unroll
                for (int jj = 0; jj < 2; ++jj) { const int j = 2 * gq + jj; s[j] = (f32x4){0.f, 0.f, 0.f, 0.f};
#pragma unroll
                    for (int ks = 0; ks < 4; ++ks) s[j] = __builtin_amdgcn_mfma_f32_16x16x32_bf16((gq & 1) ? kfb[jj][ks] : kfa[jj][ks], qf[ks], s[j], 0, 0, 0); }
                __builtin_amdgcn_sched_barrier(0);
            }
            float mx = -1e30f;
#pragma unroll
            for (int j = 0; j < 16; ++j)
#pragma unroll
                for (int r = 0; r < 4; ++r) { const float v = s[j][r] * 0.08838834764831845f; s[j][r] = v; mx = fmaxf(mx, v); }
            mx = fmaxf(mx, __shfl_xor(mx, 16)); mx = fmaxf(mx, __shfl_xor(mx, 32));
            float l = 0.f;
#pragma unroll
            for (int j = 0; j < 16; ++j)
#pragma unroll
                for (int r = 0; r < 4; ++r) { const float p = __expf(s[j][r] - mx); s[j][r] = p; l += p; }
            l += __shfl_xor(l, 16); l += __shfl_xor(l, 32);
            const float inv = 1.0f / l;
            f32x4 o[8];
#pragma unroll
            for (int dt = 0; dt < 8; ++dt) o[dt] = (f32x4){0.f, 0.f, 0.f, 0.f};
            const LAS bf16* vbase_p = VTs + fr * XA_VS + 4 * fq;
            s16x4 va[8][2], vb[8][2];
#pragma unroll
            for (int dt = 0; dt < 8; ++dt) { va[dt][0] = *(const LAS s16x4*)(vbase_p + (16 * dt) * XA_VS); va[dt][1] = *(const LAS s16x4*)(vbase_p + (16 * dt) * XA_VS + 16); }
#pragma unroll
            for (int kk = 0; kk < 8; ++kk) {
                if (kk < 7) {
#pragma unroll
                    for (int dt = 0; dt < 8; ++dt) { const s16x4 t0_ = *(const LAS s16x4*)(vbase_p + (16 * dt) * XA_VS + 32 * (kk + 1)), t1_ = *(const LAS s16x4*)(vbase_p + (16 * dt) * XA_VS + 32 * (kk + 1) + 16);
                        if (kk & 1) { va[dt][0] = t0_; va[dt][1] = t1_; } else { vb[dt][0] = t0_; vb[dt][1] = t1_; } } }
                v4u pw; pw.x = cvtpk(s[2 * kk][0], s[2 * kk][1]); pw.y = cvtpk(s[2 * kk][2], s[2 * kk][3]); pw.z = cvtpk(s[2 * kk + 1][0], s[2 * kk + 1][1]); pw.w = cvtpk(s[2 * kk + 1][2], s[2 * kk + 1][3]);
                const bf16x8 pf = __builtin_bit_cast(bf16x8, pw);
                __builtin_amdgcn_sched_barrier(0);
#pragma unroll
                for (int dt = 0; dt < 8; ++dt) { const bf16x8 vf = (kk & 1) ? cat4(vb[dt][0], vb[dt][1]) : cat4(va[dt][0], va[dt][1]);
                    o[dt] = __builtin_amdgcn_mfma_f32_16x16x32_bf16(vf, pf, o[dt], 0, 0, 0); }
                __builtin_amdgcn_sched_barrier(0);
            }
#pragma unroll
            for (int dt = 0; dt < 8; ++dt) { const f32x4 ov = o[dt] * inv; v2u w; w.x = cvtpk(ov[0], ov[1]); w.y = cvtpk(ov[2], ov[3]);
                *(v2u*)(Ox + (t0 + fr) * XW + head * 128 + 16 * dt + 4 * fq) = w; }
        }
        wg_sync(); CHAOS_POINT(2, 32);
    }
}
constexpr float HY_MIN_DECAY = -3.0701134573253944f;
constexpr float HY_MAX_DECAY = -15.350567286626972f;
__device__ __forceinline__ void h2_rows(const Args& a, float* H2, int gw, int NGW, int lane) {
    for (int idx = gw; idx < 2 * SEQ; idx += NGW) {
        const int l = idx >> 12, j = idx & 4095;
        const float* w1 = a.in[I_FW1] + l * 33 * 64; const float* b1 = a.in[I_FB1] + l * 64; const float* fr1 = a.in[I_FFR1] + l * 64;
        const float* w2 = a.in[I_FW2] + l * 64 * 64; const float* b2 = a.in[I_FB2] + l * 64; const float* fr2 = a.in[I_FFR2] + l * 64;
        const float w = 6.283185307179586f * (float)j / 4096.0f;
        const int mm = (lane - 1) & 15; const float f = 1e-4f + (float)mm * ((15.0f - 1e-4f) / 15.0f); const float ang = f * w;
        float zq = lane == 0 ? (float)j / 4095.0f : (lane <= 16 ? cosf(ang) : -sinf(ang));
        float acc = b1[lane];
#pragma unroll
        for (int q = 0; q < 33; ++q) acc += __shfl(zq, q) * w1[q * 64 + lane];
        const float h1 = sinf(fr1[lane] * acc);
        acc = b2[lane];
#pragma unroll
        for (int q = 0; q < 64; ++q) acc += __shfl(h1, q) * w2[q * 64 + lane];
        H2[(size_t)idx * 64 + lane] = sinf(fr2[lane] * acc);
    }
}
__device__ __forceinline__ void kfilt_phase(LAS unsigned char* lds, const float* H2, const float* w3all, float* KF, int G) {
    LAS float* ws = (LAS float*)lds;
    const int tid = opq_tid(), jj = tid & 63, cg = __builtin_amdgcn_readfirstlane(tid >> 6);
    for (int unit = blockIdx.x; unit < 2 * 64 * 32; unit += G) {
        const int cb = unit & 31, jb = (unit >> 5) & 63, l = unit >> 11;
        const float* w3 = w3all + (size_t)l * 64 * 2048;
        for (int e = tid; e < 4096; e += NTHR) ws[e] = w3[(size_t)(e >> 6) * 2048 + cb * 64 + (e & 63)];
        wg_sync();
        const int j = jb * 64 + jj;
        const f32x4* hr = (const f32x4*)(H2 + ((size_t)l * SEQ + j) * 64);
        float acc[8];
#pragma unroll
        for (int e = 0; e < 8; ++e) acc[e] = 0.f;
#pragma unroll
        for (int q = 0; q < 16; ++q) { const f32x4 hv = hr[q];
#pragma unroll
            for (int i = 0; i < 4; ++i) { const LAS f32x4* wp = (const LAS f32x4*)(ws + (4 * q + i) * 64 + cg * 8); const f32x4 wa = wp[0], wb = wp[1];
                acc[0] += hv[i] * wa[0]; acc[1] += hv[i] * wa[1]; acc[2] += hv[i] * wa[2]; acc[3] += hv[i] * wa[3];
                acc[4] += hv[i] * wb[0]; acc[5] += hv[i] * wb[1]; acc[6] += hv[i] * wb[2]; acc[7] += hv[i] * wb[3]; } }
        const float tj = (float)j / 4095.0f;
#pragma unroll
        for (int e = 0; e < 8; ++e) { const int col = cb * 64 + cg * 8 + e, dir = col >> 10, oc = col & 1023;
            const float delta = HY_MIN_DECAY + (float)oc * ((HY_MAX_DECAY - HY_MIN_DECAY) / 1023.0f);
            float val = acc[e] * expf(-tj * fabsf(delta));
            int n = dir == 0 ? j : 8192 - j;
            if (dir == 1 && j == 0) { n = 4096; val = 0.f; }
            KF[((size_t)(l * 1024 + oc)) * 8192 + n] = val; }
        wg_sync();
    }
}

constexpr int HY_RAWS = 4112;
constexpr int HY_ROWB = 2 * HY_RAWS * 2;
constexpr int HY_VB_OFF = FFT_WORK * 8;
constexpr int HY_X2_OFF = HY_VB_OFF + HY_ROWB;
constexpr int HY_X1_OFF = HY_X2_OFF + HY_ROWB;
constexpr int HY_EX_OFF = HY_X1_OFF + HY_ROWB;
constexpr int HY_YB_OFF = HY_EX_OFF + 16384;
static_assert(HY_VB_OFF % 16 == 0 && HY_ROWB % 16 == 0 && HY_YB_OFF + 2 * 4096 * 2 <= PHASE_LDS && HY_YB_OFF - HY_X1_OFF >= 4096 * 8 && HY_X1_OFF % 8 == 0, "hyena LDS map");
typedef float f32x2v __attribute__((ext_vector_type(2)));
struct LdsCf { LAS f32x2v* p; __device__ __forceinline__ cf ld(int i) const { const f32x2v t = p[i]; return mk(t.x, t.y); } __device__ __forceinline__ void st(int i, cf v) const { p[i] = (f32x2v){v.x, v.y}; } };

__device__ __forceinline__ void hy_dma_rows(LAS unsigned char* lds, int region_off, const bf16* UT, int b0, int ch, int wave, int lane) {
#pragma unroll
    for (int r = 0; r < 2; ++r)
        __builtin_amdgcn_global_load_lds((const unsigned*)(UT + (((size_t)((b0 + r) * C3 + ch)) << 12) + wave * 512 + lane * 8), (LAS unsigned*)(lds + region_off + r * HY_RAWS * 2 + 16 + wave * 1024), 16, 0, 0);
}
__device__ __forceinline__ void hy_pads(LAS unsigned char* lds, int region_off, int tid) {
    if (tid < 2) { LAS bf16* row = (LAS bf16*)(lds + region_off) + tid * HY_RAWS; row[7] = 0; row[8 + 4096] = 0; }
}
struct HySel { unsigned s0, s1, s2; };
__device__ __forceinline__ float hy_conv(const LAS unsigned* lds32, int d, const HySel& hs, float w0, float w1, float w2, float bias) {
    const unsigned lo = *(const volatile LAS unsigned*)(lds32 + d), hi = *(const volatile LAS unsigned*)(lds32 + d + 1);
    const float f0 = __builtin_bit_cast(float, __builtin_amdgcn_perm(hi, lo, hs.s0)), f1 = __builtin_bit_cast(float, __builtin_amdgcn_perm(hi, lo, hs.s1)), f2 = __builtin_bit_cast(float, __builtin_amdgcn_perm(hi, lo, hs.s2));
    return w0 * f0 + w1 * f1 + w2 * f2 + bias;
}
__device__ __forceinline__ int opqi(int v) { asm volatile("" : "+v"(v)); return v; }
template <class T> __device__ __forceinline__ T* opqp(T* p) { asm volatile("" : "+v"(p)); return p; }
__device__ __forceinline__ cf opq(cf w) { asm volatile("" : "+v"(w)); return w; }
__device__ __forceinline__ cf csel(bool c, cf a, cf b) { return mk(c ? a.x : b.x, c ? a.y : b.y); }
__device__ __forceinline__ float uni(float v) { return __builtin_bit_cast(float, __builtin_amdgcn_readfirstlane(__builtin_bit_cast(int, v))); }
__device__ __forceinline__ void wave_lds_fence() { __builtin_amdgcn_sched_barrier(0); asm volatile("s_waitcnt lgkmcnt(0)" ::: "memory"); __builtin_amdgcn_sched_barrier(0); }
__device__ __forceinline__ void wg_sync_lds() { __builtin_amdgcn_sched_barrier(0); asm volatile("s_waitcnt lgkmcnt(0)" ::: "memory"); __builtin_amdgcn_s_barrier(); asm volatile("" ::: "memory"); __builtin_amdgcn_sched_barrier(0); }
__device__ __forceinline__ cf shfl_cf(cf v) { return mk(__shfl_xor(v.x, 32), __shfl_xor(v.y, 32)); }

__device__ __forceinline__ void kspec_phase(LAS unsigned char* lds, const float* KF, float* KSP, int G) {
    const int tid = opq_tid();
    LdsCf W; W.p = (LAS f32x2v*)lds;
    int h1, j1, h2, k1, j2, h3, blk; geo1(tid, h1, j1); geo2(tid, h2, k1, j2); geo3(tid, h3, blk);
    const int fb1 = opqi(fbase1(h1, j1)), fb2 = opqi(fbase2(h2, k1, j2)), fb3 = opqi(fbase3(h3, blk)), jo = opqi(j1);
    float sv, cv;
    sincospif(-(float)j1 / 4096.0f, &sv, &cv); const cf w8192j = mk(cv, sv);
    sincospif(-(float)j1 / 2048.0f, &sv, &cv); const cf w4096j = mk(cv, sv);
    sincospif(-(float)j2 / 128.0f, &sv, &cv);  const cf w256j = mk(cv, sv);
    const cf w32 = mk(0.98078528040323043f, -0.19509032201612825f);
#pragma unroll 1
    for (int unit = blockIdx.x; unit < 2 * 2 * HYW; unit += G) {
        const float* kf = KF + (size_t)unit * 8192;
        cf x[16]; cf wp = opq(w8192j);
#pragma unroll
        for (int m = 0; m < 16; ++m) { const float* kp = kf + opqi(jo + 1024 * (m >> 2)); const float ka = kp[256 * (m & 3)]; const float* kq = kp + opqi(4096); const float kb = kq[256 * (m & 3)];
            x[m] = csel(h1 == 0, mk(ka + kb, 0.f), cscale(wp, ka - kb)); wp = cmul(wp, w32); }
        CHAOS_POINT(32, 21); fwd_pass1(W, fb1, opq(w4096j), x); wg_sync(); CHAOS_POINT(32, 22);
        fwd_pass2(W, fb2, opq(w256j)); wave_lds_fence(); CHAOS_POINT(32, 23);
        { cf kk[16]; fwd_pass3_keep(W, fb3, kk); GAS f32x4* kd = opqp((GAS f32x4*)(KSP + (size_t)unit * 16384 + tid * 32));
#pragma unroll
          for (int q = 0; q < 8; ++q) kd[q] = (f32x4){kk[2 * q].x, kk[2 * q].y, kk[2 * q + 1].x, kk[2 * q + 1].y}; }
        wg_sync();
    }
}
__device__ __forceinline__ void load_spec(f32x4 (&kv)[8], const GAS f32x4* Kp) {
#pragma unroll
    for (int q = 0; q < 8; ++q) kv[q] = Kp[q];
}
__device__ __forceinline__ void mid_pass3g(LdsCf lds, int b3, const f32x4 (&kv)[8]) {
    cf x[16];
#pragma unroll
    for (int m = 0; m < 16; ++m) x[m] = lds.ld(b3 + m);
    dft16<false>(x);
#pragma unroll
    for (int q = 0; q < 8; ++q) { x[2 * q] = cmul(x[2 * q], mk(kv[q][0], kv[q][1])); x[2 * q + 1] = cmul(x[2 * q + 1], mk(kv[q][2], kv[q][3])); }
    dft16<true>(x);
#pragma unroll
    for (int m = 0; m < 16; ++m) lds.st(b3 + m, x[m]);
}
#ifdef DIAG
#define HY_SYNC() do { const unsigned long long ts_ = wall_clock64(); wg_sync(); hy_wait_ += wall_clock64() - ts_; } while (0)
#else
#define HY_SYNC() wg_sync()
#endif
#ifdef PERTURB
#define HY_PERTURB0() do { __builtin_amdgcn_s_sleep(40); __builtin_amdgcn_s_sleep(100); } while (0)
#else
#define HY_PERTURB0() CHAOS_POINT(1, 11)
#endif
__device__ __forceinline__ void hyena_phase(LAS unsigned char* lds, const Args& a, int layer, const bf16* UT, const float* KSP, bf16* YT, int G) {
    const int tid = opq_tid();
#ifdef DIAG
    unsigned long long hy_wait_ = 0; const unsigned long long hy_t0_ = wall_clock64(); unsigned long long dg_a0 = 0, dg_a1 = 0, dg_a2 = 0, dg_a3 = 0, dg_a4 = 0, dg_a5 = 0, dg_a6 = 0, dg_a7 = 0, dg_last = hy_t0_;
#define HYT(k) do { const unsigned long long n_ = wall_clock64(); dg_a##k += n_ - dg_last; dg_last = n_; } while (0)
#else
#define HYT(k) do {} while (0)
#endif
    LdsCf W; W.p = (LAS f32x2v*)lds;
    const int wave = __builtin_amdgcn_readfirstlane(tid >> 6), lane = tid & 63;
    int h1, j1, h2, k1, j2, h3, blk; geo1(tid, h1, j1); geo2(tid, h2, k1, j2); geo3(tid, h3, blk);
    const int fb1 = opqi(fbase1(h1, j1)), fb2 = opqi(fbase2(h2, k1, j2)), fb3 = opqi(fbase3(h3, blk));
    const int jo = opqi(j1), jh = opqi(j1 + 2048 * h1);
    LdsCf ZB; ZB.p = (LAS f32x2v*)lds; const int zo = opqi(HY_X1_OFF / 8 + j1), zh = opqi(HY_X1_OFF / 8 + j1 + 2048 * h1);
    LAS bf16* l16 = (LAS bf16*)lds; const int yh = opqi(HY_YB_OFF / 2 + j1 + 2048 * h1);
    const LAS unsigned* lds32 = (const LAS unsigned*)lds; const int par = 1 - (j1 & 1);
    const int rod = opqi((HY_VB_OFF / 2 + 8 + j1 - 1 - par) >> 1), rhd = opqi((HY_VB_OFF / 2 + 8 + j1 + 2048 * h1 - 1 - par) >> 1);
    HySel hs; hs.s0 = opqi(par ? 0x03020c0c : 0x01000c0c); hs.s1 = opqi(par ? 0x05040c0c : 0x03020c0c); hs.s2 = opqi(par ? 0x07060c0c : 0x05040c0c);
    float sv, cv;
    sincospif(-(float)j1 / 4096.0f, &sv, &cv); const cf w8192j = mk(cv, sv);
    sincospif(-(float)j1 / 2048.0f, &sv, &cv); const cf w4096j = mk(cv, sv);
    sincospif(-(float)j2 / 128.0f, &sv, &cv);  const cf w256j = mk(cv, sv);
    const cf w32 = mk(0.98078528040323043f, -0.19509032201612825f);
    const float* cw = a.in[I_CONVW] + layer * 3 * C3; const float* cbv = a.in[I_CONVB] + layer * C3; const float* skp = a.in[I_SKIP] + layer * 2 * HYW;
    for (int c = blockIdx.x; c < HYW; c += G) {
        const float x1w0 = uni(cw[c]), x1w1 = uni(cw[C3 + c]), x1w2 = uni(cw[2 * C3 + c]), x1b = uni(cbv[c]);
        const float x2w0 = uni(cw[512 + c]), x2w1 = uni(cw[C3 + 512 + c]), x2w2 = uni(cw[2 * C3 + 512 + c]), x2b = uni(cbv[512 + c]);
        const float vw0 = uni(cw[1024 + c]), vw1 = uni(cw[C3 + 1024 + c]), vw2 = uni(cw[2 * C3 + 1024 + c]), vb = uni(cbv[1024 + c]);
        const float skip0 = uni(skp[c]), skip1 = uni(skp[HYW + c]);
        const float* KS0 = KSP + ((size_t)((layer * 2 + 0) * HYW + c)) * 16384 + opqi(tid * 32);
        const float* KS1 = KSP + ((size_t)((layer * 2 + 1) * HYW + c)) * 16384 + opqi(tid * 32);
        hy_dma_rows(lds, HY_VB_OFF, UT, 0, 1024 + c, wave, lane); hy_pads(lds, HY_VB_OFF, tid); hy_pads(lds, HY_X2_OFF, tid);
        HY_SYNC();
#pragma unroll 1
        for (int pr = 0; pr < 8; ++pr) {
            const int b0 = 2 * pr; CHAOS_POINT(1, 16);
            hy_dma_rows(lds, HY_X1_OFF, UT, b0, c, wave, lane); hy_dma_rows(lds, HY_X2_OFF, UT, b0, 512 + c, wave, lane); hy_pads(lds, HY_X1_OFF, tid); HYT(6);
            cf x[16];
            { cf wp = opq(w8192j);
#pragma unroll
              for (int m = 0; m < 16; ++m) {
                  const cf z = mk(hy_conv(lds32, rod + 128 * m, hs, vw0, vw1, vw2, vb), hy_conv(lds32, rod + 128 * m + HY_RAWS / 2, hs, vw0, vw1, vw2, vb));
                  x[m] = csel(h1 == 0, z, cmul(z, wp)); wp = cmul(wp, w32); } }
            HYT(7);
            HY_PERTURB0();
            fwd_pass1(W, fb1, opq(w4096j), x); HYT(0); wg_sync_lds(); HYT(4); CHAOS_POINT(1, 12);
            { f32x4 kv[8]; load_spec(kv, opqp((const GAS f32x4*)KS0));
              fwd_pass2(W, fb2, opq(w256j)); wave_lds_fence(); CHAOS_POINT(1, 13);
              mid_pass3g(W, fb3, kv); } wave_lds_fence(); CHAOS_POINT(1, 14);
            inv_pass2(W, fb2, opq(w256j)); HYT(1); HY_SYNC(); HYT(5);
            CHAOS_POINT(1, 15); inv_pass1(W, fb1, opq(w4096j), x);
            cf zz[8];
            { cf wp = opq(w8192j);
#pragma unroll
              for (int m = 0; m < 16; ++m) { x[m] = csel(h1 == 1, cmulc(x[m], wp), x[m]); wp = cmul(wp, w32); }
#pragma unroll
              for (int i = 0; i < 8; ++i) { const cf xa_ = x[i], xb_ = x[8 + i]; const cf mine = csel(h1 == 1, xb_, xa_), send = csel(h1 == 1, xa_, xb_); const cf r = cscale(cadd(mine, shfl_cf(send)), 1.0f / 8192.0f);
                  const float va = hy_conv(lds32, rhd + 128 * i, hs, vw0, vw1, vw2, vb), vbb = hy_conv(lds32, rhd + 128 * i + HY_RAWS / 2, hs, vw0, vw1, vw2, vb);
                  const float xa = hy_conv(lds32, rhd + 128 * i + (HY_X1_OFF - HY_VB_OFF) / 4, hs, x1w0, x1w1, x1w2, x1b), xb = hy_conv(lds32, rhd + 128 * i + (HY_X1_OFF - HY_VB_OFF) / 4 + HY_RAWS / 2, hs, x1w0, x1w1, x1w2, x1b);
                  zz[i] = mk(xa * (r.x + skip0 * va), xb * (r.y + skip0 * vbb)); } }
            { cf wp = opq(w8192j);
#pragma unroll
              for (int i = 0; i < 8; ++i) { const cf pz = shfl_cf(zz[i]); x[i] = csel(h1 == 0, zz[i], pz); x[8 + i] = csel(h1 == 0, pz, zz[i]); }
#pragma unroll
              for (int m = 0; m < 16; ++m) { x[m] = csel(h1 == 0, x[m], cmul(x[m], wp)); wp = cmul(wp, w32); } }
            HY_PERTURB0();
            fwd_pass1(W, fb1, opq(w4096j), x); HYT(2); wg_sync_lds(); HYT(4); CHAOS_POINT(1, 12);
            { f32x4 kv[8]; load_spec(kv, opqp((const GAS f32x4*)KS1));
              fwd_pass2(W, fb2, opq(w256j)); wave_lds_fence(); CHAOS_POINT(1, 13);
              mid_pass3g(W, fb3, kv); } wave_lds_fence(); CHAOS_POINT(1, 14);
            if (pr < 7) hy_dma_rows(lds, HY_VB_OFF, UT, b0 + 2, 1024 + c, wave, lane);
            inv_pass2(W, fb2, opq(w256j)); HYT(1); wg_sync_lds(); HYT(4);
            CHAOS_POINT(1, 15); inv_pass1(W, fb1, opq(w4096j), x);
            { cf wp = opq(w8192j);
#pragma unroll
              for (int m = 0; m < 16; ++m) { x[m] = csel(h1 == 1, cmulc(x[m], wp), x[m]); wp = cmul(wp, w32); }
#pragma unroll
              for (int i = 0; i < 8; ++i) { const cf xa_ = x[i], xb_ = x[8 + i]; const cf mine = csel(h1 == 1, xb_, xa_), send = csel(h1 == 1, xa_, xb_); const cf r = cscale(cadd(mine, shfl_cf(send)), 1.0f / 8192.0f);
                  const int p = jh + 256 * i; const cf zv = zz[i];
                  const float xa = hy_conv(lds32, rhd + 128 * i + (HY_X2_OFF - HY_VB_OFF) / 4, hs, x2w0, x2w1, x2w2, x2b), xb = hy_conv(lds32, rhd + 128 * i + (HY_X2_OFF - HY_VB_OFF) / 4 + HY_RAWS / 2, hs, x2w0, x2w1, x2w2, x2b);
                  const float ya = xa * (r.x + skip1 * zv.x), yb = xb * (r.y + skip1 * zv.y);
                  l16[yh + 256 * i] = (bf16)f2bf(ya); l16[yh + 256 * i + 4096] = (bf16)f2bf(yb); (void)p; } }
            HYT(3); HY_SYNC(); HYT(5);
#pragma unroll
            for (int i = 0; i < 2; ++i) { const int q = tid + NTHR * i, row = q >> 9, cc = q & 511;
                *(v4u*)(YT + (((size_t)((b0 + row) * HYW + c)) << 12) + cc * 8) = *(const LAS v4u*)(l16 + HY_YB_OFF / 2 + row * 4096 + cc * 8); }
        }
    }
#ifdef DIAG
    if (blockIdx.x == 0 && tid == 0) { unsigned long long* dg = (unsigned long long*)(*(const LAS unsigned long long*)(lds + 155712)); atomicAdd(dg + 16, hy_wait_); atomicAdd(dg + 17, wall_clock64() - hy_t0_); atomicAdd(dg + 20, dg_a0); atomicAdd(dg + 21, dg_a1); atomicAdd(dg + 22, dg_a2); atomicAdd(dg + 23, dg_a3); atomicAdd(dg + 24, dg_a4); atomicAdd(dg + 25, dg_a5); atomicAdd(dg + 26, dg_a6); atomicAdd(dg + 27, dg_a7); }
#endif
}
constexpr int MN_STRIDE = 66;
static_assert(HYW * MN_STRIDE * 2 <= PHASE_LDS, "mix-norm LDS");
__device__ __forceinline__ void mixnorm_phase(LAS unsigned char* lds, const bf16* Ab, const bf16* YT, const float* ga, const float* gy, bf16* mixed, int G) {
    const int tid = opq_tid(), lane = tid & 63, wave = __builtin_amdgcn_readfirstlane(tid >> 6);
    LAS unsigned* tile32 = (LAS unsigned*)lds; const LAS bf16* tile16 = (const LAS bf16*)lds;
    f32x4 gav[2], gyv[2];
    gav[0] = *(const f32x4*)(ga + lane * 8); gav[1] = *(const f32x4*)(ga + lane * 8 + 4); gyv[0] = *(const f32x4*)(gy + lane * 8); gyv[1] = *(const f32x4*)(gy + lane * 8 + 4);
    v4u R[8];
    int unit = blockIdx.x;
    if (unit < M / 64) { const bf16* src = YT + (((size_t)((unit >> 6) * HYW + tid)) << 12) + (unit & 63) * 64;
#pragma unroll
        for (int q = 0; q < 8; ++q) R[q] = *(const v4u*)(src + 8 * q); }
#pragma unroll 1
    for (; unit < M / 64; unit += G) {
        const int b = unit >> 6, t0 = (unit & 63) * 64;
#pragma unroll
        for (int q = 0; q < 8; ++q) { LAS unsigned* d = tile32 + tid * (MN_STRIDE / 2) + 4 * q; d[0] = R[q].x; d[1] = R[q].y; d[2] = R[q].z; d[3] = R[q].w; }
        wg_sync(); CHAOS_POINT(16, 51);
        const int nu = unit + G;
        if (nu < M / 64) { const bf16* src = YT + (((size_t)((nu >> 6) * HYW + tid)) << 12) + (nu & 63) * 64;
#pragma unroll
            for (int q = 0; q < 8; ++q) R[q] = *(const v4u*)(src + 8 * q); }
        const size_t row0 = (size_t)b * SEQ + t0 + wave * 8;
        v4u av[8];
#pragma unroll
        for (int i = 0; i < 8; ++i) av[i] = *(const v4u*)(Ab + (row0 + i) * AW + lane * 8);
#pragma unroll
        for (int i = 0; i < 8; ++i) { const int tt = wave * 8 + i;
            float y[8]; float ss = 0.f;
#pragma unroll
            for (int e = 0; e < 8; ++e) { y[e] = bf1(tile16[(lane * 8 + e) * MN_STRIDE + tt]); ss += y[e] * y[e]; }
            const float rs = __builtin_amdgcn_rsqf(wave_sum(ss) * (1.f / 512.f) + EPS);
            v4u o; o.x = pk2(y[0] * rs * gyv[0][0], y[1] * rs * gyv[0][1]); o.y = pk2(y[2] * rs * gyv[0][2], y[3] * rs * gyv[0][3]);
            o.z = pk2(y[4] * rs * gyv[1][0], y[5] * rs * gyv[1][1]); o.w = pk2(y[6] * rs * gyv[1][2], y[7] * rs * gyv[1][3]);
            *(v4u*)(mixed + (row0 + i) * D + 512 + lane * 8) = o; }
#pragma unroll
        for (int i = 0; i < 8; ++i) {
            const float x[8] = {bflo(av[i].x), bfhi(av[i].x), bflo(av[i].y), bfhi(av[i].y), bflo(av[i].z), bfhi(av[i].z), bflo(av[i].w), bfhi(av[i].w)};
            float ss = 0.f;
#pragma unroll
            for (int e = 0; e < 8; ++e) ss += x[e] * x[e];
            const float rs = __builtin_amdgcn_rsqf(wave_sum(ss) * (1.f / 512.f) + EPS);
            v4u o; o.x = pk2(x[0] * rs * gav[0][0], x[1] * rs * gav[0][1]); o.y = pk2(x[2] * rs * gav[0][2], x[3] * rs * gav[0][3]);
            o.z = pk2(x[4] * rs * gav[1][0], x[5] * rs * gav[1][1]); o.w = pk2(x[6] * rs * gav[1][2], x[7] * rs * gav[1][3]);
            *(v4u*)(mixed + (row0 + i) * D + lane * 8) = o; }
        wg_sync(); CHAOS_POINT(16, 51);
    }
}

__device__ __forceinline__ void moe_norm_router_phase(LAS unsigned char* lds, const bf16* xb, const float* gain, const float* wr, float* rsrow, int* toke, float* tokw, int* wgcnt, int G) {
    const int tid = opq_tid(), lane = tid & 63, wave = __builtin_amdgcn_readfirstlane(tid >> 6);
    LAS int* cnt = (LAS int*)lds;
    if (tid < 8) cnt[tid] = 0;
    wg_sync(); CHAOS_POINT(16, 51);
    const int TPW = M / G;
    f32x4 wra[4][4], wrb[4][4];
#pragma unroll
    for (int j = 0; j < 4; ++j) { const f32x4 gv = *(const f32x4*)(gain + 4 * lane + 256 * j);
#pragma unroll
        for (int q = 0; q < 4; ++q) { const int k = 4 * lane + q + 256 * j; wra[j][q] = *(const f32x4*)(wr + k * 8) * gv[q]; wrb[j][q] = *(const f32x4*)(wr + k * 8 + 4) * gv[q]; } }
    v2u nx[4];
    { const v2u* xr = (const v2u*)(xb + (size_t)(blockIdx.x * TPW + wave) * D) + lane;
#pragma unroll
      for (int j = 0; j < 4; ++j) nx[j] = xr[64 * j]; }
#pragma unroll 1
    for (int i = wave; i < TPW; i += NWAVES) {
        const int t = blockIdx.x * TPW + i;
        v2u cu[4];
#pragma unroll
        for (int j = 0; j < 4; ++j) cu[j] = nx[j];
        if (i + NWAVES < TPW) { const v2u* xr = (const v2u*)(xb + (size_t)(t + NWAVES) * D) + lane;
#pragma unroll
            for (int j = 0; j < 4; ++j) nx[j] = xr[64 * j]; }
        f32x4 v[4]; float s = 0.f;
#pragma unroll
        for (int j = 0; j < 4; ++j) { const v2u a = cu[j]; v[j] = (f32x4){bflo(a.x), bfhi(a.x), bflo(a.y), bfhi(a.y)}; s += (v[j].x * v[j].x + v[j].y * v[j].y) + (v[j].z * v[j].z + v[j].w * v[j].w); }
        const float rs = 1.0f / sqrtf(wave_sum(s) * (1.f / 1024.f) + EPS);
        float lg[8];
#pragma unroll
        for (int e = 0; e < 8; ++e) lg[e] = 0.f;
#pragma unroll
        for (int j = 0; j < 4; ++j)
#pragma unroll
            for (int q = 0; q < 4; ++q) { const f32x4 wa = wra[j][q], wb = wrb[j][q]; const float hv = v[j][q];
                lg[0] += hv * wa[0]; lg[1] += hv * wa[1]; lg[2] += hv * wa[2]; lg[3] += hv * wa[3]; lg[4] += hv * wb[0]; lg[5] += hv * wb[1]; lg[6] += hv * wb[2]; lg[7] += hv * wb[3]; }
        { const bool b5 = lane & 32, b4 = lane & 16, b3 = lane & 8; float k4[4], k2[2], k1;
#pragma unroll
          for (int i = 0; i < 4; ++i) { const float send = b5 ? lg[i] : lg[4 + i], keep = b5 ? lg[4 + i] : lg[i]; k4[i] = keep + __shfl_xor(send, 32); }
#pragma unroll
          for (int i = 0; i < 2; ++i) { const float send = b4 ? k4[i] : k4[2 + i], keep = b4 ? k4[2 + i] : k4[i]; k2[i] = keep + __shfl_xor(send, 16); }
          { const float send = b3 ? k2[0] : k2[1], keep = b3 ? k2[1] : k2[0]; k1 = keep + __shfl_xor(send, 8); }
          k1 += __shfl_xor(k1, 4); k1 += __shfl_xor(k1, 2); k1 += __shfl_xor(k1, 1);
#pragma unroll
          for (int e = 0; e < 8; ++e) lg[e] = __builtin_bit_cast(float, __builtin_amdgcn_readlane(__builtin_bit_cast(int, k1), 8 * e)) * rs; }
        int i0 = 0; float v0 = lg[0];
#pragma unroll
        for (int e = 1; e < 8; ++e) if (lg[e] > v0) { v0 = lg[e]; i0 = e; }
        int i1 = -1; float v1 = -3.0e38f;
#pragma unroll
        for (int e = 0; e < 8; ++e) if (e != i0 && lg[e] > v1) { v1 = lg[e]; i1 = e; }
        const float e1 = __expf(v1 - v0), w0 = 1.0f / (1.0f + e1), w1 = e1 * w0;
        if (lane == 0) { toke[2 * t] = i0; toke[2 * t + 1] = i1; tokw[2 * t] = w0; tokw[2 * t + 1] = w1; rsrow[t] = rs; __hip_atomic_fetch_add(cnt + i0, 1, __ATOMIC_RELAXED, __HIP_MEMORY_SCOPE_WORKGROUP); __hip_atomic_fetch_add(cnt + i1, 1, __ATOMIC_RELAXED, __HIP_MEMORY_SCOPE_WORKGROUP); }
    }
    wg_sync(); CHAOS_POINT(16, 51);
    if (tid < 8) wgcnt[blockIdx.x * 8 + tid] = cnt[tid];
    wg_sync(); CHAOS_POINT(16, 51);
}
__device__ __forceinline__ void moe_slot_phase(LAS unsigned char* lds, const int* toke, const int* wgcnt, int* tokp, int* tilee, int* meta, const bf16* xb, const float* rsrow, const float* gain, unsigned char* XG8, int G) {
    const int tid = opq_tid(), lane = tid & 63, wave = __builtin_amdgcn_readfirstlane(tid >> 6);
    LAS int* arr = (LAS int*)lds;
    LAS int* pre = arr + 1024 * 8;
    LAS int* wcnt = pre + 32;
    LAS int* slots = wcnt + 64;
    for (int i = tid; i < G * 8; i += NTHR) arr[i] = wgcnt[i];
    wg_sync(); CHAOS_POINT(16, 51);
    if (tid < 8) { int p = 0, tot = 0; for (int w = 0; w < G; ++w) { const int c = arr[w * 8 + tid]; if (w < (int)blockIdx.x) p += c; tot += c; } pre[tid] = p; pre[8 + tid] = tot; }
    wg_sync(); CHAOS_POINT(16, 51);
    if (tid == 0) { int ps = 0; for (int e = 0; e < 8; ++e) { pre[16 + e] = ps; ps += ((pre[8 + e] + 255) >> 8) << 8; } pre[24] = ps; }
    wg_sync(); CHAOS_POINT(16, 51);
    const int TPW = M / G;
    int e_mine = -1, t = 0, rank = 0;
    if (tid < 2 * TPW) { t = blockIdx.x * TPW + (tid >> 1); e_mine = toke[2 * t + (tid & 1)]; }
#pragma unroll
    for (int e = 0; e < 8; ++e) { const unsigned long long mk_ = __ballot(e_mine == e); if (e_mine == e) rank = __popcll(mk_ & ((1ull << lane) - 1ull)); if (lane == 0) wcnt[wave * 8 + e] = __popcll(mk_); }
    wg_sync(); CHAOS_POINT(16, 51);
    if (e_mine >= 0) { int base = pre[16 + e_mine] + pre[e_mine]; for (int w = 0; w < wave; ++w) base += wcnt[w * 8 + e_mine];
        const int slot = base + rank; slots[tid] = slot; tokp[2 * t + (tid & 1)] = slot; }
    else slots[tid] = -1;
    if ((int)blockIdx.x < 8) { const int e = blockIdx.x, s0 = pre[16 + e] + pre[8 + e], s1 = pre[16 + e] + (((pre[8 + e] + 255) >> 8) << 8);
        unsigned z0 = 0u; asm volatile("" : "+v"(z0));
        for (int i = tid; i < (s1 - s0) * 64; i += NTHR) ((v4u*)(XG8 + (size_t)s0 * D))[i] = (v4u){z0, z0, z0, z0}; }
    if (blockIdx.x == 0) { const int ntiles = pre[24] >> 8;
        for (int ti = tid; ti < ntiles; ti += NTHR) { int e = 0;
#pragma unroll
            for (int q = 1; q < 8; ++q) if (ti * 256 >= pre[16 + q]) e = q;
            tilee[ti] = e; }
        if (tid == 0) meta[0] = ntiles; }
    wg_sync(); CHAOS_POINT(16, 51);
    { f32x4 g[4];
#pragma unroll
      for (int q = 0; q < 4; ++q) g[q] = *(const f32x4*)(gain + 16 * lane + 4 * q);
#pragma unroll 1
      for (int a0 = wave * 64; a0 < wave * 64 + 64; a0 += 2) {
          v4u av[2][2]; float rs[2]; int sl[2];
#pragma unroll
          for (int u = 0; u < 2; ++u) { const int a = a0 + u; sl[u] = slots[a]; const int tt = blockIdx.x * TPW + (a >> 1); rs[u] = rsrow[tt]; const v4u* src = (const v4u*)(xb + (size_t)tt * D) + 2 * lane; av[u][0] = src[0]; av[u][1] = src[1]; }
#pragma unroll
          for (int u = 0; u < 2; ++u) if (sl[u] >= 0) { v4u o;
#pragma unroll
              for (int h = 0; h < 2; ++h) { const unsigned w4[4] = {av[u][h].x, av[u][h].y, av[u][h].z, av[u][h].w};
#pragma unroll
                  for (int q = 0; q < 2; ++q) { int w = 0;
                      w = __builtin_amdgcn_cvt_pk_fp8_f32(bflo(w4[2 * q]) * rs[u] * g[2 * h + q][0], bfhi(w4[2 * q]) * rs[u] * g[2 * h + q][1], w, false);
                      w = __builtin_amdgcn_cvt_pk_fp8_f32(bflo(w4[2 * q + 1]) * rs[u] * g[2 * h + q][2], bfhi(w4[2 * q + 1]) * rs[u] * g[2 * h + q][3], w, true);
                      o[2 * h + q] = (unsigned)w; } }
              ((v4u*)(XG8 + (size_t)sl[u] * D))[lane] = o; } } }
    wg_sync(); CHAOS_POINT(16, 51);
}
__device__ __forceinline__ void moe_gather_phase(const bf16* xb, const float* rsrow, const float* gain, const int* rowtok, bf16* XG, int nrows, int gw, int NGW, int lane) {
    f32x4 g[4];
#pragma unroll
    for (int q = 0; q < 4; ++q) g[q] = *(const f32x4*)(gain + (q >> 1) * 512 + 8 * lane + 4 * (q & 1));
    for (int r = gw; r < nrows; r += NGW) { const int t = rowtok[r]; const float rs = rsrow[t]; const v4u* src = (const v4u*)(xb + (size_t)t * D); v4u* dst = (v4u*)(XG + (size_t)r * D);
#pragma unroll
        for (int h = 0; h < 2; ++h) { const v4u a = src[64 * h + lane]; v4u o;
            o.x = pk2(bflo(a.x) * rs * g[2 * h][0], bfhi(a.x) * rs * g[2 * h][1]); o.y = pk2(bflo(a.y) * rs * g[2 * h][2], bfhi(a.y) * rs * g[2 * h][3]);
            o.z = pk2(bflo(a.z) * rs * g[2 * h + 1][0], bfhi(a.z) * rs * g[2 * h + 1][1]); o.w = pk2(bflo(a.w) * rs * g[2 * h + 1][2], bfhi(a.w) * rs * g[2 * h + 1][3]);
            dst[64 * h + lane] = o; } }
}
__device__ __forceinline__ void moe_combine_final_phase(const bf16* xb, float* out, const bf16* YB, const int* tokp, const float* tokw, const float* gain, int gw, int NGW, int lane) {
    f32x4 g[4];
#pragma unroll
    for (int q = 0; q < 4; ++q) g[q] = *(const f32x4*)(gain + (q >> 1) * 512 + 8 * lane + 4 * (q & 1));
#pragma unroll 1
    for (int t0 = gw; t0 < M; t0 += 2 * NGW) { CHAOS_POINT(16, 52);
        v4u xa[2][2], ya[2][2], yb[2][2]; float w0[2], w1[2]; bool on[2];
#pragma unroll
        for (int u = 0; u < 2; ++u) { const int t = t0 + u * NGW; on[u] = t < M; const int tt = on[u] ? t : t0;
            const int p0 = tokp[2 * tt], p1 = tokp[2 * tt + 1]; w0[u] = tokw[2 * tt]; w1[u] = tokw[2 * tt + 1];
            const v4u* xr = (const v4u*)(xb + (size_t)tt * D) + lane; const v4u* y0 = (const v4u*)(YB + (size_t)p0 * D) + lane; const v4u* y1 = (const v4u*)(YB + (size_t)p1 * D) + lane;
#pragma unroll
            for (int h = 0; h < 2; ++h) { xa[u][h] = xr[64 * h]; ya[u][h] = y0[64 * h]; yb[u][h] = y1[64 * h]; } }
#pragma unroll
        for (int u = 0; u < 2; ++u) { const int t = t0 + u * NGW; float v[2][8]; float s = 0.f;
#pragma unroll
            for (int h = 0; h < 2; ++h) { const unsigned xw[4] = {xa[u][h].x, xa[u][h].y, xa[u][h].z, xa[u][h].w}, aw[4] = {ya[u][h].x, ya[u][h].y, ya[u][h].z, ya[u][h].w}, bw[4] = {yb[u][h].x, yb[u][h].y, yb[u][h].z, yb[u][h].w};
#pragma unroll
                for (int q = 0; q < 4; ++q) { v[h][2 * q] = bflo(xw[q]) + w0[u] * bflo(aw[q]) + w1[u] * bflo(bw[q]); v[h][2 * q + 1] = bfhi(xw[q]) + w0[u] * bfhi(aw[q]) + w1[u] * bfhi(bw[q]);
                    s += v[h][2 * q] * v[h][2 * q] + v[h][2 * q + 1] * v[h][2 * q + 1]; } }
            const float rs = 1.0f / sqrtf(wave_sum(s) * (1.f / 1024.f) + EPS);
            if (on[u]) { f32x4* orow = (f32x4*)(out + (size_t)t * D);
#pragma unroll
                for (int h = 0; h < 2; ++h) { orow[128 * h + 2 * lane] = (f32x4){v[h][0], v[h][1], v[h][2], v[h][3]} * rs * g[2 * h]; orow[128 * h + 2 * lane + 1] = (f32x4){v[h][4], v[h][5], v[h][6], v[h][7]} * rs * g[2 * h + 1]; } } }
    }
}
struct MoeOrder : pg8::StaticOrder {
    const int* tilee; int tile0; size_t bstride;
    __device__ __forceinline__ size_t boff(const pg8::Unit& u) const { return (size_t)tilee[tile0 + u.pm] * bstride; }
};
#ifndef LB_WAVES
#define LB_WAVES 2
#endif
constexpr int N_PHASES_C = 29;
__global__ void __launch_bounds__(NTHR, LB_WAVES) fwd_kernel(Args args) {
    extern __shared__ __attribute__((aligned(16))) unsigned char lds_raw[];
    LAS unsigned char* lds = (LAS unsigned char*)lds_raw;
    const int tid0 = threadIdx.x;
    const int G = gridDim.x, NGW = G * NWAVES;
    unsigned char* ws = args.ws;
    gu32* ctl = (gu32*)(ws + WS_CTL);
    volatile LAS unsigned* MISC = (volatile LAS unsigned*)(lds + MISC_OFF);
    for (int u = tid0; u < (LDS_BYTES - LDSCTL_OFF) / 4; u += NTHR) ((LAS unsigned*)(lds + LDSCTL_OFF))[u] = 0u;
#ifdef DIAG
#ifndef DIAG_WG
#define DIAG_WG 0
#endif
#ifndef DIAG_PH
#define DIAG_PH 0
#endif
#ifndef DIAG_DIV
#define DIAG_DIV 1
#endif
    static_assert(MISC_OFF == 155712, "diag pointer slot");
    if (tid0 == 0) ((LAS unsigned long long*)(lds + MISC_OFF))[0] = (unsigned long long)(ws + WS_CTL + 512 * 1024);
#endif
    __syncthreads();
    XcdBarrier bar; bar.bar = (unsigned*)(ctl + CW_BAR); bar.x = 0; bar.st = nullptr;
    if (args.use_bar) bar = xcd_barrier_post((unsigned*)(ctl + CW_BAR), MISC + 8);
    const int lo = args.ph_lo, hi = args.ph_hi;
    int ph = 0;
#ifndef PHMASK
#define PHMASK 0xffffffffu
#endif
#define EN(k) (((PHMASK) >> (k)) & 1u)
#define PH_ON() (ph >= lo && ph < hi)
#define LOCAL_IDS() const int tid = opq_tid(), lane = tid & 63, wave = __builtin_amdgcn_readfirstlane(tid >> 6), gw = blockIdx.x * NWAVES + wave; (void)lane; (void)gw
#ifndef DUPMASK
#define DUPMASK 0u
#endif
#define RES_DST(k) ((NREP(k) > 1 && rep_ + 1 < NREP(k)) ? (bf16*)args.out : HB)
#ifndef DUPN
#define DUPN 2
#endif
#define NREP(k) ((((DUPMASK) >> (k)) & 1u) ? DUPN : 1)
#ifdef DIAG
#define PH_END_K(k) do { if (args.use_bar && (ph + 1 < hi || rep_ + 1 < NREP(k))) { const unsigned long long tb_ = wall_clock64(); xcd_barrier(bar); if (threadIdx.x == 0) { unsigned long long* dg = (unsigned long long*)(ws + WS_CTL + 512 * 1024); const unsigned long long w_ = wall_clock64() - tb_; atomicAdd(dg + 5, w_); if (ph == DIAG_PH) atomicAdd(dg + 6, w_); } } } while (0)
#else
#define PH_END_K(k) do { if (args.use_bar && (ph + 1 < hi || rep_ + 1 < NREP(k))) xcd_barrier(bar); } while (0)
#endif

    float* cosT = (float*)(ws + WS_COS); float* sinT = (float*)(ws + WS_SIN); float* H2 = (float*)(ws + WS_H2);
    int* toke = (int*)(ws + WS_TOKE); float* tokw = (float*)(ws + WS_TOKW); int* tokp = (int*)(ws + WS_TOKP); int* rowtok = (int*)(ws + WS_ROWTOK);
    int* tilee = (int*)(ws + WS_TILEE); int* wgcnt = (int*)(ws + WS_WGCNT); int* meta = (int*)(ws + WS_META); float* rsrow = (float*)(ws + WS_RSROW);
    bf16* WINA = (bf16*)(ws + WS_WINA); bf16* WINB = (bf16*)(ws + WS_WINB); bf16* WOUT = (bf16*)(ws + WS_WOUT); bf16* XQ = (bf16*)(ws + WS_XQ); bf16* XK = (bf16*)(ws + WS_XK);
    bf16* XV = (bf16*)(ws + WS_XV); bf16* XO = (bf16*)(ws + WS_XO); bf16* FGU = (bf16*)(ws + WS_FGU); bf16* FDN = (bf16*)(ws + WS_FDN); bf16* MGU = (bf16*)(ws + WS_MGU); bf16* MDN = (bf16*)(ws + WS_MDN);
    float* KF = (float*)(ws + WS_KFILT); bf16* MB = (bf16*)(ws + WS_MB); bf16* KMEM = (bf16*)(ws + WS_KMEM); bf16* VMEMT = (bf16*)(ws + WS_VMEMT); bf16* HB = (bf16*)(ws + WS_HB);
    bf16* QB = (bf16*)(ws + WS_QB); bf16* KB = (bf16*)(ws + WS_KB); bf16* VB = (bf16*)(ws + WS_VB); bf16* UT = (bf16*)(ws + WS_UT); bf16* AB = (bf16*)(ws + WS_AB); bf16* YT = (bf16*)(ws + WS_YT);
    bf16* MIXED = (bf16*)(ws + WS_MIXED); float* SS = (float*)(ws + WS_SS);
    bf16* XQB = (bf16*)(ws + WS_XQB); bf16* XOB = (bf16*)(ws + WS_XOB); bf16* ACT = (bf16*)(ws + WS_ACT); unsigned char* XG8 = ws + WS_XG; bf16* YB = (bf16*)(ws + WS_YB); unsigned char* MGU8 = ws + WS_MGU; bf16* MACT = (bf16*)(ws + WS_MACT);
    const float* const* in = args.in;

    if (EN(0) && PH_ON()) for (int rep_ = 0; rep_ < NREP(0); ++rep_) { asm volatile("; PHASE_MARK 0"); LOCAL_IDS();
        LAS float* scr = (LAS float*)(lds + wave * 8704);
        constexpr int IT_L = 384 + 768 + 512 + 4 * 256, IT_D = 3 * 1408, IT_E = 3 * 1792, IT_ALL = 2 * IT_L + IT_D + NE * IT_E;
#pragma unroll 1
        for (int it = gw; it < IT_ALL; it += NGW) {
            const float* W; int ldw, K, col0 = 0, ncols, mode = 0; bf16* WT; const float* gk = nullptr; int r = it;
            if (r < 2 * IT_L) { const int l = r / IT_L; r -= l * IT_L;
                if (r < 384) { W = in[I_WIN] + (size_t)l * D * INC; ldw = INC; K = D; ncols = 768; WT = WINA + (size_t)l * 768 * D; mode = 1; gk = in[I_MIXNORM] + l * D; }
                else if ((r -= 384) < 768) { W = in[I_WIN] + (size_t)l * D * INC; ldw = INC; K = D; col0 = 768; ncols = C3; WT = WINB + (size_t)l * C3 * D; gk = in[I_MIXNORM] + l * D; }
                else if ((r -= 768) < 512) { W = in[I_WOUT] + (size_t)l * D * D; ldw = D; K = D; ncols = D; WT = WOUT + (size_t)l * D * D; }
                else if ((r -= 512) < 256) { W = in[I_XWQ] + (size_t)l * D * XW; ldw = XW; K = D; ncols = XW; WT = XQ + (size_t)l * XW * D; gk = in[I_XNORM] + l * D; }
                else if ((r -= 256) < 256) { W = in[I_XWK] + (size_t)l * D * XW; ldw = XW; K = D; ncols = XW; WT = XK + (size_t)l * XW * D; }
                else if ((r -= 256) < 256) { W = in[I_XWV] + (size_t)l * D * XW; ldw = XW; K = D; ncols = XW; WT = XV + (size_t)l * XW * D; }
                else { r -= 256; W = in[I_XWO] + (size_t)l * XW * D; ldw = D; K = XW; ncols = D; WT = XO + (size_t)l * D * XW; }
            } else if ((r -= 2 * IT_L) < IT_D) {
                if (r < 1408) { W = in[I_FGATE]; ldw = FF; K = D; ncols = FF; WT = FGU; mode = 2; gk = in[I_FNORM]; }
                else if ((r -= 1408) < 1408) { W = in[I_FUP]; ldw = FF; K = D; ncols = FF; WT = FGU; mode = 3; gk = in[I_FNORM]; }
                else { r -= 1408; W = in[I_FDOWN]; ldw = D; K = FF; ncols = D; WT = FDN; }
            } else { r -= IT_D; const int e = r / IT_E; r -= e * IT_E;
                if (r < 2 * 1792) { const bool up = r >= 1792; if (up) r -= 1792;
                    tr_item8(in[up ? I_MUP : I_MGATE] + (size_t)e * D * FFE, FFE, D, FFE, MGU8 + (size_t)e * 2 * FFE * D, up ? 3 : 2, 32.0f, r, scr, lane); continue; }
                else { r -= 2 * 1792; tr_item8(in[I_MDOWN] + (size_t)e * FFE * D, D, FFE, D, (unsigned char*)MDN + (size_t)e * D * FFE, 0, 32.0f, r, scr, lane); continue; }
            }
            tr_item(W, ldw, K, col0, ncols, WT, mode, gk, r, scr, lane);
        }
        for (int i = blockIdx.x * NTHR + tid; i < SEQ * 32; i += G * NTHR) { const int pos = i >> 5, f = i & 31;
            const float inv = (float)pow(10000.0, -(double)f / 32.0); const float ang = (float)pos * inv;
            cosT[i] = (float)cos((double)ang); sinT[i] = (float)sin((double)ang); }
        h2_rows(args, H2, gw, NGW, lane);
        norm_rows(in[I_MEM], in[I_MEMNORM], MB, MROWS, gw, NGW, lane);
        xb_rows(in[I_X], HB, SS, M, gw, NGW, lane);
        PH_END_K(0);
    }
    ++ph;
    if (EN(1) && PH_ON()) for (int rep_ = 0; rep_ < NREP(1); ++rep_) { asm volatile("; PHASE_MARK 1"); LOCAL_IDS();
        kfilt_phase(lds, H2, in[I_FW3], KF, G);
        PH_END_K(1);
    }
    ++ph;

#pragma unroll 1
    for (int l = 0; l < 2; ++l) {
        if (EN(2) && PH_ON()) for (int rep_ = 0; rep_ < NREP(2); ++rep_) { asm volatile("; PHASE_MARK 2"); LOCAL_IDS();
            if (l == 0) {
                kspec_phase(lds, KF, (float*)(ws + WS_KSPEC), G);
                { pg8::Gemm g{MB, XK, MROWS, 1024, D}; pg8::StaticOrder S; S.init(MROWS, 1024, G, (int)blockIdx.x); pg8::EpiBf16 E{KMEM, 1024, nullptr, 1.0f};
                  pg8::gemm_phase<pg8::EpiBf16, pg8::StaticOrder, PG8_ALIGN, PG8_SP2>(lds, g, S, E); }
                { pg8::Gemm g{MB, XV, MROWS, 1024, D}; pg8::StaticOrder S; S.init(MROWS, 1024, G, G >= 128 ? (int)((blockIdx.x + G - 64) % G) : (int)blockIdx.x); pg8::EpiT E{VMEMT, 1024, 12, nullptr};
                  pg8::gemm_phase<pg8::EpiT, pg8::StaticOrder, PG8_ALIGN, PG8_SP2>(lds, g, S, E); }
            }
            { pg8::Gemm g{HB, WINA + (size_t)l * 768 * D, M, 768, D}; pg8::StaticOrder S; S.init(M, 768, G, (int)blockIdx.x); pg8::EpiQKV E{QB, KB, VB, cosT, sinT, SS + (size_t)(3 * l) * SS_STRIDE};
              pg8::gemm_phase<pg8::EpiQKV, pg8::StaticOrder, PG8_ALIGN, PG8_SP2>(lds, g, S, E); }
            { pg8::Gemm g{HB, WINB + (size_t)l * C3 * D, M, C3, D}; pg8::StaticOrder S; S.init(M, C3, G, (int)blockIdx.x); pg8::EpiT E{UT, C3, 12, SS + (size_t)(3 * l) * SS_STRIDE};
              pg8::gemm_phase<pg8::EpiT, pg8::StaticOrder, PG8_ALIGN, PG8_SP2>(lds, g, S, E); }
            PH_END_K(2);
        }
        ++ph;
        if (EN(3) && PH_ON()) for (int rep_ = 0; rep_ < NREP(3); ++rep_) { asm volatile("; PHASE_MARK 3"); LOCAL_IDS();
#ifndef BA_REP
#define BA_REP 1
#endif
#ifndef HY_REP
#define HY_REP 1
#endif
#pragma unroll 1
            for (int r_ = 0; r_ < BA_REP; ++r_) band_attention_phase(lds, QB, KB, VB, AB, in[I_SINK] + l * NH, G);
#pragma unroll 1
            for (int r_ = 0; r_ < HY_REP; ++r_) hyena_phase(lds, args, l, UT, (const float*)(ws + WS_KSPEC), YT, G);
            PH_END_K(3);
        }
        ++ph;
        if (EN(4) && PH_ON()) for (int rep_ = 0; rep_ < NREP(4); ++rep_) { asm volatile("; PHASE_MARK 4"); LOCAL_IDS(); mixnorm_phase(lds, AB, YT, in[I_ANORM] + l * AW, in[I_YNORM] + l * HYW, MIXED, G); PH_END_K(4); }
        ++ph;
        if (EN(5) && PH_ON()) for (int rep_ = 0; rep_ < NREP(5); ++rep_) { asm volatile("; PHASE_MARK 5"); LOCAL_IDS();
            pg8::Gemm g{MIXED, WOUT + (size_t)l * D * D, M, D, D}; pg8::StaticOrder S; S.init(M, D, G, (int)blockIdx.x); pg8::EpiResB E{HB, D, SS + (size_t)(3 * l + 1) * SS_STRIDE, RES_DST(5)};
            pg8::gemm_phase<pg8::EpiResB, pg8::StaticOrder, PG8_ALIGN, PG8_SP2>(lds, g, S, E);
            PH_END_K(5);
        }
        ++ph;
        if (EN(7) && PH_ON()) for (int rep_ = 0; rep_ < NREP(7); ++rep_) { asm volatile("; PHASE_MARK 7"); LOCAL_IDS();
            pg8::Gemm g{HB, XQ + (size_t)l * XW * D, M, XW, D}; pg8::StaticOrder S; S.init(M, XW, G, (int)blockIdx.x); pg8::EpiBf16 E{XQB, XW, SS + (size_t)(3 * l + 1) * SS_STRIDE, 1.0f};
            pg8::gemm_phase<pg8::EpiBf16, pg8::StaticOrder, PG8_ALIGN, PG8_SP2>(lds, g, S, E);
            PH_END_K(7);
        }
        ++ph;
        if (EN(8) && PH_ON()) for (int rep_ = 0; rep_ < NREP(8); ++rep_) { asm volatile("; PHASE_MARK 8"); LOCAL_IDS(); cross_attention_phase(lds, XQB, KMEM, VMEMT, XOB, l, G); PH_END_K(8); }
        ++ph;
        if (EN(9) && PH_ON()) for (int rep_ = 0; rep_ < NREP(9); ++rep_) { asm volatile("; PHASE_MARK 9"); LOCAL_IDS();
            pg8::Gemm g{XOB, XO + (size_t)l * D * XW, M, D, XW}; pg8::StaticOrder S; S.init(M, D, G, (int)blockIdx.x); pg8::EpiResB E{HB, D, l == 0 ? SS + (size_t)2 * SS_STRIDE : nullptr, RES_DST(9)};
            pg8::gemm_phase<pg8::EpiResB, pg8::StaticOrder, PG8_ALIGN, PG8_SP2>(lds, g, S, E);
            PH_END_K(9);
        }
        ++ph;
        if (l == 0) {
            if (EN(11) && PH_ON()) for (int rep_ = 0; rep_ < NREP(11); ++rep_) { asm volatile("; PHASE_MARK 11"); LOCAL_IDS();
                pg8::Gemm g{HB, FGU, M, 2 * FF, D}; pg8::StaticOrder S; S.init(M, 2 * FF, G, (int)blockIdx.x); pg8::EpiSwiglu<true> E{ACT, FF, SS + (size_t)2 * SS_STRIDE};
                pg8::gemm_phase<pg8::EpiSwiglu<true>, pg8::StaticOrder, PG8_ALIGN, PG8_SP2>(lds, g, S, E);
                PH_END_K(11);
            }
            ++ph;
            if (EN(12) && PH_ON()) for (int rep_ = 0; rep_ < NREP(12); ++rep_) { asm volatile("; PHASE_MARK 12"); LOCAL_IDS();
                pg8::Gemm g{ACT, FDN, M, D, FF}; pg8::StaticOrder S; S.init(M, D, G, (int)blockIdx.x); pg8::EpiResB E{HB, D, SS + (size_t)3 * SS_STRIDE, RES_DST(12)};
                pg8::gemm_phase<pg8::EpiResB, pg8::StaticOrder, PG8_ALIGN, PG8_SP2>(lds, g, S, E);
                PH_END_K(12);
            }
            ++ph;
        } else {
            if (EN(14) && PH_ON()) for (int rep_ = 0; rep_ < NREP(14); ++rep_) { asm volatile("; PHASE_MARK 14"); LOCAL_IDS(); moe_norm_router_phase(lds, HB, in[I_FNORM] + D, in[I_ROUTER], rsrow, toke, tokw, wgcnt, G); PH_END_K(14); }
            ++ph;
            if (EN(15) && PH_ON()) for (int rep_ = 0; rep_ < NREP(15); ++rep_) { asm volatile("; PHASE_MARK 15"); LOCAL_IDS(); moe_slot_phase(lds, toke, wgcnt, tokp, tilee, meta, HB, rsrow, in[I_FNORM] + D, XG8, G); PH_END_K(15); }
            ++ph;
#pragma unroll 1
            for (int ci = 0; ci < MOE_NCHUNK; ++ci) {
                if (EN(17) && PH_ON()) for (int rep_ = 0; rep_ < NREP(17); ++rep_) { asm volatile("; PHASE_MARK 17"); LOCAL_IDS();
                    const int ntiles = meta[0], tile0 = ci * MOE_CH_TILES, nt = ci < MOE_NCHUNK - 1 ? MOE_CH_TILES : ntiles - (MOE_NCHUNK - 1) * MOE_CH_TILES;
                    int k8 = D / 2; asm volatile("" : "+s"(k8));
                    pg8::Gemm g{(const bf16*)(XG8 + (size_t)tile0 * 256 * D), (const bf16*)MGU8, nt * 256, 2 * FFE, k8};
                    MoeOrder S; S.init(nt * 256, 2 * FFE, G, (int)blockIdx.x); S.tilee = tilee; S.tile0 = tile0; S.bstride = (size_t)2 * FFE * D;
                    pg8::EpiSwiglu<false, true, true> E{MACT, FFE, nullptr};
                    pg8::gemm_phase<pg8::EpiSwiglu<false, true, true>, MoeOrder, PG8_ALIGN, PG8_SP2>(lds, g, S, E);
                    PH_END_K(17);
                }
                ++ph;
                if (EN(18) && PH_ON()) for (int rep_ = 0; rep_ < NREP(18); ++rep_) { asm volatile("; PHASE_MARK 18"); LOCAL_IDS();
                    const int ntiles = meta[0], tile0 = ci * MOE_CH_TILES, nt = ci < MOE_NCHUNK - 1 ? MOE_CH_TILES : ntiles - (MOE_NCHUNK - 1) * MOE_CH_TILES;
                    int k8 = FFE / 2; asm volatile("" : "+s"(k8));
                    pg8::Gemm g{MACT, MDN, nt * 256, D, k8};
                    MoeOrder S; S.init(nt * 256, D, G, (int)blockIdx.x); S.tilee = tilee; S.tile0 = tile0; S.bstride = (size_t)D * FFE;
                    pg8::EpiBf16T<true> E{YB + (size_t)tile0 * 256 * D, D, nullptr, 1.0f / 128.0f};
                    pg8::gemm_phase<pg8::EpiBf16T<true>, MoeOrder, PG8_ALIGN, PG8_SP2>(lds, g, S, E);
                    PH_END_K(18);
                }
                ++ph;
            }
            if (EN(19) && PH_ON()) for (int rep_ = 0; rep_ < NREP(19); ++rep_) { asm volatile("; PHASE_MARK 19"); LOCAL_IDS(); moe_combine_final_phase(HB, args.out, YB, tokp, tokw, in[I_FINAL], gw, NGW, lane); PH_END_K(19); }
            ++ph;
        }
    }
#ifdef DIAG
    if (blockIdx.x == DIAG_WG && tid0 == 0 && hi == N_PHASES_C) { const unsigned long long v = ((unsigned long long*)(ws + WS_CTL + 512 * 1024))[DIAG_SEL] * DIAG_MULT / DIAG_DIV; const unsigned long long t0 = wall_clock64(); while (wall_clock64() - t0 < v) __builtin_amdgcn_s_sleep(8); }
#endif
#undef PH_ON
}
constexpr int N_PHASES = 2 + 7 + 2 + 7 + 2 + 2 * MOE_NCHUNK + 1;

#ifndef MK_PER_PHASE
#define MK_PER_PHASE 0
#endif
extern "C" void kernel_launch(void* const* d_in, const int* in_sizes, int n_in, void* d_out, int out_size, void* d_ws, size_t ws_size, hipStream_t stream) {
    static int grid = 0;
    if (grid == 0) {
        if (n_in != 33 || in_sizes[0] != M * D || out_size != M * D || ws_size < WS_END) {
            fprintf(stderr, "kernel_launch: unexpected problem: n_in %d in0 %d out %d ws %zu (need %zu); nothing launched\n", n_in, n_in > 0 ? in_sizes[0] : -1, out_size, ws_size, (size_t)WS_END); grid = -1; return; }
        int dev = 0, cus = 0, per_cu = 0;
        if (hipGetDevice(&dev) != hipSuccess || hipDeviceGetAttribute(&cus, hipDeviceAttributeMultiprocessorCount, dev) != hipSuccess) { fprintf(stderr, "kernel_launch: device query failed\n"); grid = -1; return; }
        if (hipFuncSetAttribute((const void*)fwd_kernel, hipFuncAttributeMaxDynamicSharedMemorySize, LDS_BYTES) != hipSuccess) { fprintf(stderr, "kernel_launch: hipFuncSetAttribute failed\n"); grid = -1; return; }
        if (hipOccupancyMaxActiveBlocksPerMultiprocessor(&per_cu, (const void*)fwd_kernel, NTHR, LDS_BYTES) != hipSuccess || per_cu < 1) { fprintf(stderr, "kernel_launch: occupancy query reports %d\n", per_cu); }
        (void)hipGetLastError();
        grid = cus;
        if (grid > 256) grid = 256;
        while (grid > 1 && (M % grid != 0 || M / grid > 256)) --grid;
        if (grid != 256) fprintf(stderr, "kernel_launch: note: grid %d\n", grid);
    }
    if (grid < 0) return;
    if (hipMemsetAsync((char*)d_ws + WS_CTL, 0, CTL_ZERO_BYTES, stream) != hipSuccess) { fprintf(stderr, "kernel_launch: memset failed\n"); return; }
    Args a{};
    for (int i = 0; i < 33; ++i) a.in[i] = (const float*)d_in[i];
    a.out = (float*)d_out; a.ws = (unsigned char*)d_ws;
#if MK_PER_PHASE
    for (int p = 0; p < N_PHASES; ++p) { a.ph_lo = p; a.ph_hi = p + 1; a.use_bar = 0; a.pad = 0; hipLaunchKernelGGL(fwd_kernel, dim3(grid), dim3(NTHR), LDS_BYTES, stream, a); }
#else
    a.ph_lo = 0; a.ph_hi = N_PHASES; a.use_bar = 1; a.pad = 0;
    hipLaunchKernelGGL(fwd_kernel, dim3(grid), dim3(NTHR), LDS_BYTES, stream, a);
#endif
    const hipError_t le = hipPeekAtLastError();
    if (le != hipSuccess) fprintf(stderr, "kernel_launch: launch failed: %s\n", hipGetErrorName(le));
}
```
